# Optimizing an MI355X kernel written in HIP

```python
import math
import jax, jax.numpy as jnp
from jax import lax
import numpy as np

D_MODEL = 2048
BATCH = 4
SEQ = 4096
DEPTH = 1

GRID_W = 64
CTX_LEN = 256
EPS = 1e-6
N_MOD = 6

ATTN_HEADS = 8
ATTN_KV_HEADS = 2
HEAD_DIM = 128
ATTN_GROUP = ATTN_HEADS // ATTN_KV_HEADS
Q_BLOCK = 128
ROPE_THETA = 10000.0
ROPE_AXIS_DIM = HEAD_DIM // 2
ROPE_FREQS = ROPE_AXIS_DIM // 2

DN_HEADS = 8
DN_KEY_DIM = 128
DN_VAL_DIM = 128
DN_CONV = 5
DN_CHUNK = 64

ATTN_Q_W = ATTN_HEADS * HEAD_DIM
ATTN_KV_W = ATTN_KV_HEADS * HEAD_DIM
DN_QK_W = DN_HEADS * DN_KEY_DIM
DN_V_W = DN_HEADS * DN_VAL_DIM
DN_CONV_W = 2 * DN_QK_W + DN_V_W
N_BRANCH = 2
IN_SIZES = (ATTN_Q_W, ATTN_KV_W, ATTN_KV_W, DN_CONV_W, DN_V_W, 2 * DN_HEADS, 2 * DN_HEADS, N_BRANCH * D_MODEL)
IN_W = sum(IN_SIZES)

PEER_HEADS = 8
PEER_N_KEYS = 128
PEER_EXPERTS = PEER_N_KEYS * PEER_N_KEYS
PEER_KEY_DIM = 256
PEER_HALF = PEER_KEY_DIM // 2
PEER_TOPK = 16
PEER_BLOCK = 128

kernel_name = 'hybrid_gqa_gdn_peer_dit_block'


def rms_norm(x, w):
    xf = x.astype(jnp.float32)
    y = xf * lax.rsqrt(jnp.mean(xf * xf, axis=-1, keepdims=True) + EPS)
    return (y * w.astype(jnp.float32)).astype(x.dtype)


def split_cols(t, sizes):
    out, start = [], 0
    for s in sizes:
        out.append(t[..., start:start + s])
        start += s
    return out


def l2_normalize(t):
    tf = t.astype(jnp.float32)
    return tf * lax.rsqrt(jnp.sum(tf * tf, axis=-1, keepdims=True) + EPS)


def axial_rope_angles(rows):
    row = jnp.repeat(jnp.arange(rows), GRID_W)
    col = jnp.tile(jnp.arange(GRID_W), rows)
    inv = ROPE_THETA ** (-jnp.arange(ROPE_FREQS, dtype=jnp.float32) / ROPE_FREQS)
    pos = jnp.stack([row, col], axis=-1).astype(jnp.float32)
    ang = pos[:, :, None] * inv
    return jnp.cos(ang), jnp.sin(ang)


def apply_axial_rope(t, cos, sin):
    B, T, H, D = t.shape
    tf = t.astype(jnp.float32).reshape(B, T, H, 2, 2, ROPE_FREQS)
    x1, x2 = tf[..., 0, :], tf[..., 1, :]
    cs, sn = cos[None, :, None], sin[None, :, None]
    out = jnp.stack([x1 * cs - x2 * sn, x2 * cs + x1 * sn], axis=-2)
    return out.reshape(B, T, H, D).astype(t.dtype)


def short_conv(t, w):
    C = t.shape[-1]
    y = lax.conv_general_dilated(t, w[:, None, :].astype(t.dtype), window_strides=(1,), padding='SAME',
                                 dimension_numbers=('NWC', 'WIO', 'NWC'), feature_group_count=C)
    return jax.nn.silu(y)


def block_attention(q, k, v):
    B, T, _, D = q.shape
    n_blk = T // Q_BLOCK
    qb = q.reshape(B, n_blk, Q_BLOCK, ATTN_KV_HEADS, ATTN_GROUP, D).transpose(1, 0, 2, 3, 4, 5)
    scale = D ** -0.5

    def one_block(q_blk):
        s = jnp.einsum('bqhgd,bkhd->bhgqk', q_blk, k, preferred_element_type=jnp.float32) * scale
        p = jax.nn.softmax(s, axis=-1).astype(v.dtype)
        return jnp.einsum('bhgqk,bkhd->bqhgd', p, v)

    o = lax.map(one_block, qb)
    return o.transpose(1, 0, 2, 3, 4, 5).reshape(B, T, ATTN_HEADS * D)


def gated_delta_rule(q, k, v, log_a, beta, state0):
    B, T, H, Dk = q.shape
    C = DN_CHUNK
    N = T // C
    q = q * (Dk ** -0.5)

    def chunks(t):
        return t.reshape(B, N, C, H, -1).transpose(0, 3, 1, 2, 4)

    q, k, v = chunks(q), chunks(k), chunks(v)
    g = jnp.cumsum(log_a.reshape(B, N, C, H).transpose(0, 3, 1, 2), axis=-1)
    bt = beta.reshape(B, N, C, H).transpose(0, 3, 1, 2)
    tri_incl = jnp.tril(jnp.ones((C, C), dtype=bool))
    tri_strict = jnp.tril(jnp.ones((C, C), dtype=bool), -1)
    decay = jnp.exp(jnp.where(tri_incl, g[..., :, None] - g[..., None, :], -jnp.inf))
    kb = k * bt[..., None]
    vb = v * bt[..., None]
    a_mat = jnp.where(tri_strict, jnp.einsum('bhncd,bhnsd->bhncs', kb, k) * decay, 0.0)
    t_mat = a_mat + jnp.eye(C, dtype=a_mat.dtype)
    u = lax.linalg.triangular_solve(t_mat, vb, left_side=True, lower=True, unit_diagonal=True)
    w = lax.linalg.triangular_solve(t_mat, kb * jnp.exp(g)[..., None], left_side=True, lower=True,
                                    unit_diagonal=True)
    qk = jnp.where(tri_incl, jnp.einsum('bhncd,bhnsd->bhncs', q, k) * decay, 0.0)

    def step(S, xs):
        q_c, k_c, u_c, w_c, qk_c, g_c = xs
        v_new = u_c - jnp.einsum('bhcd,bhde->bhce', w_c, S)
        o = jnp.einsum('bhcd,bhde->bhce', q_c * jnp.exp(g_c)[..., None], S) + jnp.einsum('bhcs,bhse->bhce', qk_c, v_new)
        g_last = g_c[..., -1]
        S = S * jnp.exp(g_last)[..., None, None] + jnp.einsum(
            'bhcd,bhce->bhde', k_c * jnp.exp(g_last[..., None] - g_c)[..., None], v_new)
        return S, o

    xs = tuple(jnp.moveaxis(t, 2, 0) for t in (q, k, u, w, qk, g))
    S, o = lax.scan(step, state0, xs)
    o = o.transpose(1, 0, 3, 2, 4).reshape(B, T, H, -1)
    return o, S


def stream_features(h, w_in, q_norm_w, k_norm_w, conv_w, a_log, dt_bias, rope):
    B, T, _ = h.shape
    proj = h @ w_in
    aq, ak, av, dn_qkv, dn_z, dn_b, dn_a, gate_logits = split_cols(proj, IN_SIZES)
    aq = rms_norm(aq.reshape(B, T, ATTN_HEADS, HEAD_DIM), q_norm_w)
    ak = rms_norm(ak.reshape(B, T, ATTN_KV_HEADS, HEAD_DIM), k_norm_w)
    av = av.reshape(B, T, ATTN_KV_HEADS, HEAD_DIM)
    if rope is not None:
        aq = apply_axial_rope(aq, *rope)
        ak = apply_axial_rope(ak, *rope)
    dq, dk, dv = split_cols(short_conv(dn_qkv, conv_w), (DN_QK_W, DN_QK_W, DN_V_W))
    dq = l2_normalize(dq.reshape(B, T, DN_HEADS, DN_KEY_DIM))
    dk = l2_normalize(dk.reshape(B, T, DN_HEADS, DN_KEY_DIM))
    dv = dv.reshape(B, T, DN_HEADS, DN_VAL_DIM).astype(jnp.float32)
    beta = jax.nn.sigmoid(dn_b.astype(jnp.float32)).reshape(B, T, 2, DN_HEADS)
    log_a = -jnp.exp(a_log) * jax.nn.softplus(dn_a.astype(jnp.float32).reshape(B, T, 2, DN_HEADS) + dt_bias)
    return {'aq': aq, 'ak': ak, 'av': av, 'dq': dq, 'dk': dk, 'dv': dv, 'z': dn_z,
            'beta': beta, 'log_a': log_a, 'gates': gate_logits}


def bidirectional_delta(lat, ctx):
    B, _, H, Dk = lat['dq'].shape
    Dv = lat['dv'].shape[-1]
    outs_lat, outs_ctx = [], []
    for d in range(2):
        rev = d == 1

        def prep(f):
            ts = (f['dq'], f['dk'], f['dv'], f['log_a'][:, :, d], f['beta'][:, :, d])
            return tuple(jnp.flip(t, axis=1) for t in ts) if rev else ts

        zero = jnp.zeros((B, H, Dk, Dv), jnp.float32)
        o_c, s_c = gated_delta_rule(*prep(ctx), zero)
        o_l, _ = gated_delta_rule(*prep(lat), s_c)
        outs_lat.append(jnp.flip(o_l, axis=1) if rev else o_l)
        outs_ctx.append(jnp.flip(o_c, axis=1) if rev else o_c)
    return outs_lat[0] + outs_lat[1], outs_ctx[0] + outs_ctx[1]


def merge_branches(o_attn, o_dn, z, gate_logits, dn_norm_w, w_b_attn, w_b_dn, w_out):
    B, T, _ = z.shape
    zf = z.reshape(B, T, DN_HEADS, DN_VAL_DIM).astype(jnp.float32)
    o_dn = (rms_norm(o_dn, dn_norm_w) * jax.nn.silu(zf)).reshape(B, T, DN_V_W).astype(z.dtype)
    g_attn, g_dn = split_cols(jax.nn.sigmoid(gate_logits), (D_MODEL, D_MODEL))
    y = g_attn * (o_attn @ w_b_attn) + g_dn * (o_dn @ w_b_dn)
    return y @ w_out


def peer_ffn(h, w_q, sub_keys, u, v):
    B, T, D = h.shape
    tokens = h.reshape(-1, D)
    n_blk = tokens.shape[0] // PEER_BLOCK

    def one_block(xb):
        nt = xb.shape[0]
        q = (xb @ w_q).reshape(nt, PEER_HEADS, 2, PEER_HALF)
        s = jnp.einsum('thpd,hpkd->thpk', q, sub_keys, preferred_element_type=jnp.float32)
        s_top, i_top = lax.top_k(s, PEER_TOPK)
        cand_s = (s_top[..., 0, :, None] + s_top[..., 1, None, :]).reshape(nt, PEER_HEADS, PEER_TOPK * PEER_TOPK)
        cand_i = (i_top[..., 0, :, None] * PEER_N_KEYS + i_top[..., 1, None, :]).reshape(nt, PEER_HEADS, PEER_TOPK * PEER_TOPK)
        best_s, pos = lax.top_k(cand_s, PEER_TOPK)
        experts = jnp.take_along_axis(cand_i, pos, axis=-1).reshape(nt, PEER_HEADS * PEER_TOPK)
        gates = jax.nn.softmax(best_s, axis=-1).reshape(nt, PEER_HEADS * PEER_TOPK)
        hid = jnp.einsum('ted,td->te', u[experts], xb, preferred_element_type=jnp.float32)
        act = (jax.nn.gelu(hid, approximate=False) * gates).astype(xb.dtype)
        return jnp.einsum('te,ted->td', act, v[experts])

    y = lax.map(one_block, tokens.reshape(n_blk, PEER_BLOCK, D))
    return y.reshape(B, T, D)


def setup_inputs(seed: int = 0) -> dict:
    key = jax.random.key(seed)
    ks = jax.random.split(key, 23)
    f32 = jnp.float32
    D = D_MODEL

    def nrm(k, shape, scale):
        return jax.random.normal(k, shape, f32) * scale

    dt = jnp.exp(jax.random.uniform(ks[13], (DEPTH, 2, DN_HEADS), f32, math.log(1e-3), math.log(1e-1)))
    return {
        'x': nrm(ks[0], (BATCH, SEQ, D), 1.0),
        'c': nrm(ks[1], (BATCH, D), 1.0),
        'ctx': nrm(ks[2], (BATCH, CTX_LEN, D), 1.0),
        'c_ctx': nrm(ks[3], (D,), 1.0),
        'ada_w': nrm(ks[4], (DEPTH, D, N_MOD * D), D ** -0.5),
        'ada_b': nrm(ks[5], (DEPTH, N_MOD * D), 0.02),
        'norm1_w': 1.0 + nrm(ks[6], (DEPTH, D), 0.02),
        'norm2_w': 1.0 + nrm(ks[7], (DEPTH, D), 0.02),
        'w_in': nrm(ks[8], (DEPTH, D, IN_W), D ** -0.5),
        'attn_q_norm': 1.0 + nrm(ks[9], (DEPTH, HEAD_DIM), 0.02),
        'attn_k_norm': 1.0 + nrm(ks[10], (DEPTH, HEAD_DIM), 0.02),
        'dn_conv_w': nrm(ks[11], (DEPTH, DN_CONV, DN_CONV_W), DN_CONV ** -0.5),
        'dn_a_log': jnp.log(jax.random.uniform(ks[12], (DEPTH, 2, DN_HEADS), f32, 1.0, 16.0)),
        'dn_dt_bias': dt + jnp.log(-jnp.expm1(-dt)),
        'dn_norm_w': 1.0 + nrm(ks[14], (DEPTH, DN_VAL_DIM), 0.02),
        'w_branch_attn': nrm(ks[15], (DEPTH, ATTN_Q_W, D), ATTN_Q_W ** -0.5),
        'w_branch_dn': nrm(ks[16], (DEPTH, DN_V_W, D), DN_V_W ** -0.5),
        'w_out': nrm(ks[17], (DEPTH, D, D), D ** -0.5),
        'peer_w_q': nrm(ks[18], (DEPTH, D, PEER_HEADS * PEER_KEY_DIM), D ** -0.5),
        'peer_sub_keys': nrm(ks[19], (DEPTH, PEER_HEADS, 2, PEER_N_KEYS, PEER_HALF), PEER_HALF ** -0.5),
        'peer_u': nrm(ks[20], (DEPTH, PEER_EXPERTS, D), D ** -0.5),
        'peer_v': nrm(ks[21], (DEPTH, PEER_EXPERTS, D), 0.5),
        'final_norm_w': 1.0 + nrm(ks[22], (D,), 0.02),
    }


def reference(x, c, ctx, c_ctx, ada_w, ada_b, norm1_w, norm2_w, w_in, attn_q_norm, attn_k_norm,
              dn_conv_w, dn_a_log, dn_dt_bias, dn_norm_w, w_branch_attn, w_branch_dn, w_out,
              peer_w_q, peer_sub_keys, peer_u, peer_v, final_norm_w):
    ROWS = x.shape[1] // GRID_W
    rope = axial_rope_angles(ROWS)
    silu_c = jax.nn.silu(c)
    silu_cc = jax.nn.silu(c_ctx)
    mod_sizes = (D_MODEL,) * N_MOD
    for layer in range(DEPTH):
        update_ctx = layer < DEPTH - 1
        sh1, sc1, g1, sh2, sc2, g2 = [m[:, None, :] for m in split_cols(silu_c @ ada_w[layer] + ada_b[layer], mod_sizes)]
        csh1, csc1, cg1, csh2, csc2, cg2 = split_cols(silu_cc @ ada_w[layer] + ada_b[layer], mod_sizes)

        h = rms_norm(x, norm1_w[layer]) * (1.0 + sc1) + sh1
        hc = rms_norm(ctx, norm1_w[layer]) * (1.0 + csc1) + csh1
        lat = stream_features(h, w_in[layer], attn_q_norm[layer], attn_k_norm[layer], dn_conv_w[layer],
                              dn_a_log[layer], dn_dt_bias[layer], rope)
        cf = stream_features(hc, w_in[layer], attn_q_norm[layer], attn_k_norm[layer], dn_conv_w[layer],
                             dn_a_log[layer], dn_dt_bias[layer], None)
        k_all = jnp.concatenate([lat['ak'], cf['ak']], axis=1)
        v_all = jnp.concatenate([lat['av'], cf['av']], axis=1)
        o_attn = block_attention(lat['aq'], k_all, v_all)
        o_dn_lat, o_dn_ctx = bidirectional_delta(lat, cf)
        mix = merge_branches(o_attn, o_dn_lat, lat['z'], lat['gates'], dn_norm_w[layer],
                             w_branch_attn[layer], w_branch_dn[layer], w_out[layer])
        x = x + g1 * mix
        if update_ctx:
            o_attn_c = block_attention(cf['aq'], cf['ak'], cf['av'])
            mix_c = merge_branches(o_attn_c, o_dn_ctx, cf['z'], cf['gates'], dn_norm_w[layer],
                                   w_branch_attn[layer], w_branch_dn[layer], w_out[layer])
            ctx = ctx + cg1 * mix_c

        h2 = rms_norm(x, norm2_w[layer]) * (1.0 + sc2) + sh2
        x = x + g2 * peer_ffn(h2, peer_w_q[layer], peer_sub_keys[layer], peer_u[layer], peer_v[layer])
        if update_ctx:
            hc2 = rms_norm(ctx, norm2_w[layer]) * (1.0 + csc2) + csh2
            ctx = ctx + cg2 * peer_ffn(hc2, peer_w_q[layer], peer_sub_keys[layer], peer_u[layer], peer_v[layer])
    return rms_norm(x, final_norm_w)
```

```cpp
#define DN_SLEEP 0

#include <hip/hip_runtime.h>
#include <hip/hip_cooperative_groups.h>
#include <cstdio>
#include <cstdint>
namespace cg = cooperative_groups;

#ifndef MK_N_LAUNCHES
#define MK_N_LAUNCHES 1
#endif
namespace pg8 {
#define PG8_LAS __attribute__((address_space(3)))
typedef unsigned short bf16_t;
typedef short bf16x8 __attribute__((ext_vector_type(8)));
typedef float f32x4 __attribute__((ext_vector_type(4)));
typedef int pg8_v4i __attribute__((ext_vector_type(4)));
typedef int pg8_v8i __attribute__((ext_vector_type(8)));
typedef unsigned u32x4 __attribute__((ext_vector_type(4)));
constexpr int BM = 256, BK = 64, HALF = 128, HTB = HALF * BK * 2  , STAGE_BYTES = 8 * HTB, NXCD = 8, WGM = 8;

__host__ __device__ __forceinline__ int lds_byte(int r, int c) { const int st = (r >> 4) * 2 + (c >> 5), rr = r & 15, cc = c & 31, ob = rr * 64 + cc * 2; return st * 1024 + (ob ^ (((ob >> 9) & 1) << 5)); }
__host__ __device__ __forceinline__ void stage_rc(int b, int& R, int& C) { const int st = b / 1024, sb = b % 1024, swz = sb ^ (((sb >> 9) & 1) << 5); R = (st >> 1) * 16 + swz / 64; C = (st & 1) * 32 + (swz % 64) / 2; }
__host__ __device__ __forceinline__ int perm32(int rho) { const int n = rho >> 4, i = rho & 15; return 8 * (i >> 2) + 4 * n + (i & 3); }

struct Unit { int pm, pn; };
struct Gemm { const bf16_t* A; const bf16_t* Bt; int M, N, K; };

struct StaticOrder {
    int nM, nN, nwg, G, c;
    __host__ __device__ void init(int M, int N, int G_, int c_) { nM = M / BM; nN = N / BM; nwg = nM * nN; G = G_; c = c_; }
    __host__ __device__ bool next(int i, Unit& u) const {
        const long L = (long)i * G + c; if (L >= nwg) return false;
        int wgid = (int)L; { const int q = nwg / NXCD, r = nwg % NXCD, xcd = wgid % NXCD, off = wgid / NXCD; wgid = (xcd < r ? xcd * (q + 1) : r * (q + 1) + (xcd - r) * q) + off; }
        const int nig = WGM * nN, gid = wgid / nig, fm = gid * WGM, gsz = (nM - fm) < WGM ? (nM - fm) : WGM;
        u.pm = fm + ((wgid % nig) % gsz); u.pn = (wgid % nig) / gsz; return true;
    }
    __device__ __forceinline__ void a_ready(const Unit&) const {}
    __device__ __forceinline__ void done(const Unit&) const {}
};

__device__ __forceinline__ unsigned cvt_pk_bf16(float lo, float hi) { unsigned r; asm volatile("v_cvt_pk_bf16_f32 %0, %1, %2" : "=v"(r) : "v"(lo), "v"(hi)); return r; }
typedef float f32x2 __attribute__((ext_vector_type(2)));
template <class Epi, class Sched, bool ALIGN_EPI = false, bool SP2 = false, bool F8 = false>
__device__ __forceinline__ void gemm_phase(PG8_LAS unsigned char* lds, const Gemm g, const Sched& S, const Epi& E) {
    const int tid = threadIdx.x, wid = __builtin_amdgcn_readfirstlane(tid >> 6), lane = tid & 63, wr = wid >> 2, wc = wid & 3, fr = lane & 15, fq = lane >> 4;
    const int K = g.K, nt = K / BK;
    unsigned voffA[2], voffB[2];
#pragma unroll
    for (int i = 0; i < 2; ++i) { int R, C; stage_rc(tid * 16 + i * 8192, R, C); const int Rb = Epi::PERM ? ((R & ~31) + perm32(R & 31)) : R;
        voffA[i] = (unsigned)(R * K + C) * 2u; voffB[i] = (unsigned)(Rb * K + C) * 2u; }
    const size_t kstep = (size_t)(BK * 2);
    const size_t hstep = (size_t)HALF * K * 2;
    const size_t tstep = 2 * hstep;
    const unsigned ldsw = (unsigned)wid * 1024u;
    const int aoff = lds_byte(wr * 64 + fr, fq * 8), boff = lds_byte(wc * 32 + fr, fq * 8);
#define PG8_SA(b, h) (((b) * 2 + (h)) * HTB)
#define PG8_SB(b, h) ((4 + (b) * 2 + (h)) * HTB)
#define PG8_STAGE(bufoff, gbase, voff) do { _Pragma("unroll") for (int _i = 0; _i < 2; ++_i) \
        __builtin_amdgcn_global_load_lds((const unsigned*)((const char*)(gbase) + (voff)[_i]), (PG8_LAS unsigned*)(lds + (bufoff) + ldsw + _i * 8192), 16, 0, 0); } while (0)
#define PG8_LDA(dst, b, h) do { _Pragma("unroll") for (int m = 0; m < 4; ++m) { \
        if constexpr (F8) { const pg8_v4i t0_ = *(const PG8_LAS pg8_v4i*)(lds + PG8_SA(b, h) + aoff + m * 2048), t1_ = *(const PG8_LAS pg8_v4i*)(lds + PG8_SA(b, h) + aoff + m * 2048 + 1024); \
            dst##8[m] = __builtin_shufflevector(t0_, t1_, 0, 1, 2, 3, 4, 5, 6, 7); } \
        else { _Pragma("unroll") for (int k = 0; k < 2; ++k) dst[m][k] = *(const PG8_LAS bf16x8*)(lds + PG8_SA(b, h) + aoff + m * 2048 + k * 1024); } } } while (0)
#define PG8_LDB(dst, b, h) do { _Pragma("unroll") for (int n = 0; n < 2; ++n) { \
        if constexpr (F8) { const pg8_v4i t0_ = *(const PG8_LAS pg8_v4i*)(lds + PG8_SB(b, h) + boff + n * 2048), t1_ = *(const PG8_LAS pg8_v4i*)(lds + PG8_SB(b, h) + boff + n * 2048 + 1024); \
            dst##8[n] = __builtin_shufflevector(t0_, t1_, 0, 1, 2, 3, 4, 5, 6, 7); } \
        else { _Pragma("unroll") for (int k = 0; k < 2; ++k) dst[n][k] = *(const PG8_LAS bf16x8*)(lds + PG8_SB(b, h) + boff + n * 2048 + k * 1024); } } } while (0)
#define PG8_MMA(ai, bj, At, Bt) do { __builtin_amdgcn_s_setprio(1); _Pragma("unroll") for (int m = 0; m < 4; ++m) _Pragma("unroll") for (int n = 0; n < 2; ++n) { \
        if constexpr (F8) { asm volatile("v_mfma_scale_f32_16x16x128_f8f6f4 %0, %1, %2, %0, %3, %3 op_sel_hi:[0,0,0]" : "+v"(acc[ai][bj][m][n]) : "v"(Bt##8[n]), "v"(At##8[m]), "v"(0x7F7F7F7F)); } \
        else { _Pragma("unroll") for (int k = 0; k < 2; ++k) acc[ai][bj][m][n] = __builtin_amdgcn_mfma_f32_16x16x32_bf16(Bt[n][k], At[m][k], acc[ai][bj][m][n], 0, 0, 0); } } \
        __builtin_amdgcn_s_setprio(0); } while (0)
#define PG8_WAIT_V(n) asm volatile("s_waitcnt vmcnt(" #n ")" ::: "memory")
#define PG8_WAIT_L(n) asm volatile("s_waitcnt lgkmcnt(" #n ")" ::: "memory")
#define PG8_BAR __builtin_amdgcn_s_barrier()
#define PG8_SCHED __builtin_amdgcn_sched_barrier(0)
    Unit cur, nxt; int ui = 0;
    if (!S.next(0, cur)) return;
    f32x4 acc[2][2][4][2];
#pragma unroll
    for (int a = 0; a < 2; ++a)
#pragma unroll
        for (int b = 0; b < 2; ++b)
#pragma unroll
            for (int m = 0; m < 4; ++m)
#pragma unroll
                for (int n = 0; n < 2; ++n) acc[a][b][m][n] = (f32x4){0.f, 0.f, 0.f, 0.f};
    bf16x8 At[4][2], B0[2][2], B1[2][2];
    pg8_v8i At8[4], B08[2], B18[2];
    const char* cA = (const char*)g.A + (size_t)cur.pm * tstep; const char* cB = (const char*)g.Bt + (size_t)cur.pn * tstep;
    S.a_ready(cur);
    if constexpr (SP2) {
        PG8_STAGE(PG8_SB(0, 0), cB, voffB); PG8_STAGE(PG8_SB(0, 1), cB + hstep, voffB); PG8_STAGE(PG8_SA(0, 0), cA, voffA); PG8_STAGE(PG8_SA(0, 1), cA + hstep, voffA);
        if (wr == 1) PG8_BAR;
        PG8_WAIT_V(2); PG8_BAR;
        PG8_STAGE(PG8_SB(1, 0), cB + kstep, voffB); PG8_STAGE(PG8_SA(1, 0), cA + kstep, voffA); PG8_STAGE(PG8_SB(1, 1), cB + hstep + kstep, voffB);
        PG8_WAIT_V(6); PG8_BAR;
    } else {
        PG8_STAGE(PG8_SB(0, 0), cB, voffB); PG8_STAGE(PG8_SA(0, 0), cA, voffA); PG8_STAGE(PG8_SB(0, 1), cB + hstep, voffB); PG8_STAGE(PG8_SA(0, 1), cA + hstep, voffA);
        if (wr == 1) PG8_BAR;
        PG8_WAIT_V(4); PG8_BAR;
        PG8_STAGE(PG8_SB(1, 0), cB + kstep, voffB); PG8_STAGE(PG8_SA(1, 0), cA + kstep, voffA); PG8_STAGE(PG8_SB(1, 1), cB + hstep + kstep, voffB);
        PG8_WAIT_V(6); PG8_BAR;
    }
    for (;;) {
        const bool has_next = S.next(ui + 1, nxt);
        const char* nA = has_next ? (const char*)g.A + (size_t)nxt.pm * tstep : cA; const char* nB = has_next ? (const char*)g.Bt + (size_t)nxt.pn * tstep : cB;
        for (int t = 0; t < nt; t += 2) {
            const bool last = (t == nt - 2);
            const char* a1 = cA + (size_t)(t + 1) * kstep;
            const char* a2 = last ? nA : cA + (size_t)(t + 2) * kstep; const char* b2 = last ? nB : cB + (size_t)(t + 2) * kstep;
            const char* a3 = a2 + kstep; const char* b3 = b2 + kstep;
            if (last && has_next) S.a_ready(nxt);
            if constexpr (SP2) {
            PG8_LDB(B0, 0, 0); PG8_LDB(B1, 0, 1); PG8_SCHED; PG8_LDA(At, 0, 0); PG8_STAGE(PG8_SA(1, 1), a1 + hstep, voffA);
            PG8_WAIT_V(8); PG8_WAIT_L(0); PG8_BAR; PG8_MMA(0, 0, At, B0); PG8_MMA(0, 1, At, B1); PG8_BAR; PG8_SCHED;
            PG8_LDA(At, 0, 1); PG8_STAGE(PG8_SB(0, 0), b2, voffB); PG8_STAGE(PG8_SB(0, 1), b2 + hstep, voffB); PG8_STAGE(PG8_SA(0, 0), a2, voffA);
            PG8_WAIT_V(8); PG8_WAIT_L(0); PG8_BAR; PG8_MMA(1, 0, At, B0); PG8_MMA(1, 1, At, B1); PG8_BAR; PG8_SCHED;
            PG8_LDB(B0, 1, 0); PG8_LDB(B1, 1, 1); PG8_SCHED; PG8_LDA(At, 1, 0); PG8_STAGE(PG8_SA(0, 1), a2 + hstep, voffA);
            PG8_WAIT_V(8); PG8_WAIT_L(0); PG8_BAR; PG8_MMA(0, 0, At, B0); PG8_MMA(0, 1, At, B1); PG8_BAR; PG8_SCHED;
            PG8_LDA(At, 1, 1); PG8_STAGE(PG8_SB(1, 0), b3, voffB); PG8_STAGE(PG8_SB(1, 1), b3 + hstep, voffB); PG8_STAGE(PG8_SA(1, 0), a3, voffA);
            PG8_WAIT_V(8); PG8_WAIT_L(0); PG8_BAR; PG8_MMA(1, 0, At, B0); PG8_MMA(1, 1, At, B1); PG8_BAR; PG8_SCHED;
            } else {
            PG8_LDB(B0, 0, 0); PG8_SCHED; PG8_LDA(At, 0, 0); PG8_STAGE(PG8_SA(1, 1), a1 + hstep, voffA);
            PG8_WAIT_L(8); PG8_BAR; PG8_WAIT_L(0); PG8_MMA(0, 0, At, B0); PG8_BAR; PG8_SCHED;
            PG8_LDB(B1, 0, 1); PG8_STAGE(PG8_SB(0, 0), b2, voffB);
            PG8_BAR; PG8_WAIT_L(0); PG8_MMA(0, 1, At, B1); PG8_BAR;
            PG8_LDA(At, 0, 1); PG8_STAGE(PG8_SA(0, 0), a2, voffA);
            PG8_BAR; PG8_WAIT_L(0); PG8_MMA(1, 0, At, B0); PG8_BAR; PG8_SCHED;
            PG8_STAGE(PG8_SB(0, 1), b2 + hstep, voffB);
            PG8_WAIT_V(6); PG8_BAR; PG8_MMA(1, 1, At, B1); PG8_BAR;
            PG8_LDB(B0, 1, 0); PG8_SCHED; PG8_LDA(At, 1, 0); PG8_STAGE(PG8_SA(0, 1), a2 + hstep, voffA);
            PG8_WAIT_L(8); PG8_BAR; PG8_WAIT_L(0); PG8_MMA(0, 0, At, B0); PG8_BAR; PG8_SCHED;
            PG8_LDB(B1, 1, 1); PG8_STAGE(PG8_SB(1, 0), b3, voffB);
            PG8_BAR; PG8_WAIT_L(0); PG8_MMA(0, 1, At, B1); PG8_BAR;
            PG8_LDA(At, 1, 1); PG8_STAGE(PG8_SA(1, 0), a3, voffA);
            PG8_BAR; PG8_WAIT_L(0); PG8_MMA(1, 0, At, B0); PG8_BAR; PG8_SCHED;
            PG8_STAGE(PG8_SB(1, 1), b3 + hstep, voffB);
            PG8_WAIT_V(6); PG8_BAR; PG8_MMA(1, 1, At, B1); PG8_BAR;
            }
        }
        if constexpr (ALIGN_EPI) { if (wr == 0) PG8_BAR; }
        if constexpr (!Epi::AFTER_DRAIN) { E(acc, cur, wr, wc, fr, fq); S.done(cur); }
        if (!has_next) break;
#pragma unroll
        for (int a = 0; a < 2; ++a)
#pragma unroll
            for (int b = 0; b < 2; ++b)
#pragma unroll
                for (int m = 0; m < 4; ++m)
#pragma unroll
                    for (int n = 0; n < 2; ++n) acc[a][b][m][n] = (f32x4){0.f, 0.f, 0.f, 0.f};
        cur = nxt; cA = nA; cB = nB; ++ui;
        if constexpr (ALIGN_EPI) { if (wr == 1) PG8_BAR; }
    }
    PG8_WAIT_V(0);
    if constexpr (!ALIGN_EPI) { if (wr == 0) PG8_BAR; }
    PG8_BAR;
    if constexpr (Epi::AFTER_DRAIN) { E.fused(acc, cur, wr, wc, fr, fq, lds, wid, lane); S.done(cur); }
#undef PG8_SA
#undef PG8_SB
#undef PG8_STAGE
#undef PG8_LDA
#undef PG8_LDB
#undef PG8_MMA
#undef PG8_WAIT_V
#undef PG8_WAIT_L
#undef PG8_BAR
#undef PG8_SCHED
}
}
namespace attn {
using bf16 = unsigned short;
constexpr int D = 128, NW = 8, QBLK = 32, KVBLK = 64;
constexpr float SCALE = 0.088388347648318440f;
constexpr float THR = 8.f;
constexpr int SDEPTH = 2;
constexpr int LDQ = 1024, LDK = 256, LDO = 1024;
constexpr size_t SHM_V = KVBLK * D * 2, SHM_K = KVBLK * D * 2, SHM_ATTN = 2 * SHM_V + 2 * SHM_K + NW * 64 * 4;
__device__ __forceinline__ unsigned short f2bf_rne(float f) { unsigned u = __float_as_uint(f); return (unsigned short)((u + 0x7fffu + ((u >> 16) & 1u)) >> 16); }
using bf16x8 = __attribute__((ext_vector_type(8))) short;
using s16x4  = __attribute__((ext_vector_type(4))) short;
using f32x16 = __attribute__((ext_vector_type(16))) float;
using f32x8  = __attribute__((ext_vector_type(8))) float;
using u32x4  = __attribute__((ext_vector_type(4))) unsigned;
#define KSWZ(row, colB) ((row) * 256 + ((colB) ^ (((row) & 7) << 4)))
#define SBAR() __builtin_amdgcn_sched_barrier(0)
__device__ __forceinline__ int crow(int r, int hi) { return (r & 3) + 8 * (r >> 2) + 4 * hi; }
__device__ __forceinline__ unsigned cvtpk(float lo, float hi) {
  unsigned r; asm volatile("v_cvt_pk_bf16_f32 %0, %1, %2" : "=v"(r) : "v"(lo), "v"(hi)); return r;
}
template <typename TIn> struct Stage;
template <> struct Stage<bf16>  { using T = bf16x8;
  __device__ static __forceinline__ T ld8(const bf16* p) { return *reinterpret_cast<const bf16x8*>(p); }
  __device__ static __forceinline__ bf16x8 tobf(T x) { return x; } };
template <> struct Stage<float> { using T = f32x8;
  __device__ static __forceinline__ T ld8(const float* p) { return *reinterpret_cast<const f32x8*>(p); }
  __device__ static __forceinline__ bf16x8 tobf(T x) {
    u32x4 w = {cvtpk(x[0], x[1]), cvtpk(x[2], x[3]), cvtpk(x[4], x[5]), cvtpk(x[6], x[7])}; return *reinterpret_cast<bf16x8*>(&w); } };

__device__ __forceinline__ void partialSM(f32x16& p0, f32x16& p1, float& m_reg, float& mn, float& alpha) {
  constexpr float C = SCALE * 1.4426950408889634f;
  float pmax = p0[0]; for (int r = 1; r < 16; ++r) pmax = fmaxf(pmax, p0[r]); for (int r = 0; r < 16; ++r) pmax = fmaxf(pmax, p1[r]);
  { auto rr = __builtin_amdgcn_permlane32_swap(__float_as_uint(pmax), __float_as_uint(pmax), false, false);
    pmax = fmaxf(__uint_as_float(rr[0]), __uint_as_float(rr[1])); }
  if (__builtin_expect(__all(pmax - m_reg <= THR / SCALE), 1)) { mn = m_reg; alpha = 1.f; }
  else { mn = fmaxf(m_reg, pmax); alpha = __builtin_amdgcn_exp2f((m_reg - mn) * C); m_reg = mn; }
  float mnC = -mn * C;
  for (int r = 0; r < 16; ++r) p0[r] = fmaf(p0[r], C, mnC); for (int r = 0; r < 16; ++r) p1[r] = fmaf(p1[r], C, mnC);
  for (int r = 0; r < 16; ++r) p0[r] = __builtin_amdgcn_exp2f(p0[r]);
}
__device__ __forceinline__ void finishSM(f32x16& p0, f32x16& p1, float alpha, float& l_reg, bf16x8& pa0, bf16x8& pa1, bf16x8& pa2, bf16x8& pa3) {
  for (int r = 0; r < 16; ++r) p1[r] = __builtin_amdgcn_exp2f(p1[r]);
  float ps = 0; for (int r = 0; r < 16; ++r) ps += p0[r]; for (int r = 0; r < 16; ++r) ps += p1[r];
  { auto rr = __builtin_amdgcn_permlane32_swap(__float_as_uint(ps), __float_as_uint(ps), false, false);
    ps = __uint_as_float(rr[0]) + __uint_as_float(rr[1]); }
  l_reg = l_reg * alpha + ps;
#define PK4(P, BASE, OUT) do { unsigned a0 = cvtpk(P[BASE + 0], P[BASE + 1]), a1 = cvtpk(P[BASE + 2], P[BASE + 3]);   \
    unsigned b0 = cvtpk(P[BASE + 4], P[BASE + 5]), b1 = cvtpk(P[BASE + 6], P[BASE + 7]);                              \
    auto r0 = __builtin_amdgcn_permlane32_swap(a0, b0, false, false); auto r1 = __builtin_amdgcn_permlane32_swap(a1, b1, false, false); \
    u32x4 w = {r0[0], r1[0], r0[1], r1[1]}; OUT = *reinterpret_cast<bf16x8*>(&w); } while (0)
  PK4(p0, 0, pa0); PK4(p0, 8, pa1); PK4(p1, 0, pa2); PK4(p1, 8, pa3);
#undef PK4
}
__device__ __forceinline__ void qkt(f32x16& p0, f32x16& p1, const bf16* Ks, const bf16x8* qr, int r32, int hi) {
  p0 = f32x16{}; p1 = f32x16{};
  for (int d0 = 0; d0 < 8; ++d0) { int cb = (d0 * 16 + hi * 8) * 2;
    bf16x8 b0 = *reinterpret_cast<const bf16x8*>((const char*)Ks + KSWZ(r32, cb));
    bf16x8 b1 = *reinterpret_cast<const bf16x8*>((const char*)Ks + KSWZ(32 + r32, cb));
    p0 = __builtin_amdgcn_mfma_f32_32x32x16_bf16(b0, qr[d0], p0, 0, 0, 0);
    p1 = __builtin_amdgcn_mfma_f32_32x32x16_bf16(b1, qr[d0], p1, 0, 0, 0); }
}
__device__ __forceinline__ int v_st(int k, int c) { const int kk = (k & ~0xC) | ((k & 4) << 1) | ((k & 8) >> 1); return ((kk >> 3) * 4 + (c >> 5)) * 512 + ((kk & 7) * 32 + (c & 31)) * 2; }
__device__ __forceinline__ int v_rd_base(int lane) { return ((lane & 3) << 3) | (((lane >> 2) & 3) << 6) | (((lane >> 4) & 1) << 5) | (((lane >> 5) & 1) << 8); }
constexpr int v_rd_off(int d0, int ks, int half) { return d0 * 512 + ks * 4096 + half * 2048; }
template <int OFF> __device__ __forceinline__ s16x4 tr_read(int vb) {
  s16x4 r; asm volatile("ds_read_b64_tr_b16 %0, %1 offset:%2" : "=&v"(r) : "v"(vb), "i"(OFF) : "memory"); return r;
}
template <int D0> __device__ __forceinline__ void pv_one(f32x16& od, int vb, bf16x8 pa0, bf16x8 pa1, bf16x8 pa2, bf16x8 pa3) {
  const s16x4 l0 = tr_read<v_rd_off(D0, 0, 0)>(vb), h0 = tr_read<v_rd_off(D0, 0, 1)>(vb), l1 = tr_read<v_rd_off(D0, 1, 0)>(vb), h1 = tr_read<v_rd_off(D0, 1, 1)>(vb);
  const s16x4 l2 = tr_read<v_rd_off(D0, 2, 0)>(vb), h2 = tr_read<v_rd_off(D0, 2, 1)>(vb), l3 = tr_read<v_rd_off(D0, 3, 0)>(vb), h3 = tr_read<v_rd_off(D0, 3, 1)>(vb);
  asm volatile("s_waitcnt lgkmcnt(0)" ::: "memory"); SBAR();
#define PK(L, H) (bf16x8){L[0], L[1], L[2], L[3], H[0], H[1], H[2], H[3]}
  od = __builtin_amdgcn_mfma_f32_32x32x16_bf16(pa0, PK(l0, h0), od, 0, 0, 0);
  od = __builtin_amdgcn_mfma_f32_32x32x16_bf16(pa1, PK(l1, h1), od, 0, 0, 0);
  od = __builtin_amdgcn_mfma_f32_32x32x16_bf16(pa2, PK(l2, h2), od, 0, 0, 0);
  od = __builtin_amdgcn_mfma_f32_32x32x16_bf16(pa3, PK(l3, h3), od, 0, 0, 0);
#undef PK
}
__device__ __forceinline__ void pv_d0(f32x16* o, int vb, bf16x8 pa0, bf16x8 pa1, bf16x8 pa2, bf16x8 pa3) {
  pv_one<0>(o[0], vb, pa0, pa1, pa2, pa3); pv_one<1>(o[1], vb, pa0, pa1, pa2, pa3); pv_one<2>(o[2], vb, pa0, pa1, pa2, pa3); pv_one<3>(o[3], vb, pa0, pa1, pa2, pa3);
}

template <typename TQ>
__device__ __forceinline__ void attn_dense_body(const TQ* __restrict__ Qb, const bf16* __restrict__ Kh, const bf16* __restrict__ Vh,
                                                bf16* __restrict__ Ob, int seq, char* lds) {
  using St = Stage<bf16>; using SQ = Stage<TQ>;
  const int tid = threadIdx.x, wid = tid >> 6, lane = tid & 63, r32 = lane & 31, hi = lane >> 5;
  bf16* V_lds = (bf16*)lds; bf16* K_lds = (bf16*)(lds + 2 * SHM_V);
  float* ws = (float*)(lds + 2 * SHM_V + 2 * SHM_K) + wid * 64; float* li_l = ws; float* al_l = ws + 32;
  float m_reg = -1e30f, l_reg = 0; f32x16 o[4] = {}; bf16x8 qr[8];
  const TQ* Qw = Qb + (long)(wid * QBLK + r32) * LDQ + hi * 8;
#pragma unroll
  for (int d0 = 0; d0 < 8; ++d0) qr[d0] = SQ::tobf(SQ::ld8(Qw + d0 * 16));
  const int sr = tid >> 4, sc = (tid & 15) * 8, vst0 = v_st(sr, sc), vst1 = v_st(32 + sr, sc);
  const int vb0 = (int)(uintptr_t)V_lds + v_rd_base(lane);
  struct { typename St::T vs0, vs1, ks0, ks1; } sr_[SDEPTH];
#define SLOAD(i, k0) do { sr_[i].vs0 = St::ld8(&Vh[(long)((k0) + sr) * LDK + sc]); sr_[i].vs1 = St::ld8(&Vh[(long)((k0) + 32 + sr) * LDK + sc]); \
    sr_[i].ks0 = St::ld8(&Kh[(long)((k0) + sr) * LDK + sc]); sr_[i].ks1 = St::ld8(&Kh[(long)((k0) + 32 + sr) * LDK + sc]); } while (0)
#define SWRITE(b, i) do { *(bf16x8*)((char*)V_lds + (b) * SHM_V + vst0) = St::tobf(sr_[i].vs0);          \
    *(bf16x8*)((char*)V_lds + (b) * SHM_V + vst1) = St::tobf(sr_[i].vs1); int kc = sc * 2;               \
    *(bf16x8*)((char*)K_lds + (b) * SHM_K + KSWZ(sr, kc)) = St::tobf(sr_[i].ks0);                       \
    *(bf16x8*)((char*)K_lds + (b) * SHM_K + KSWZ(32 + sr, kc)) = St::tobf(sr_[i].ks1); } while (0)
#define SWAIT() do { if constexpr (SDEPTH == 2) asm volatile("s_waitcnt vmcnt(4)" ::: "memory"); else asm volatile("s_waitcnt vmcnt(0)" ::: "memory"); } while (0)
#define RESC(a) do { if (__any((a) < 1.f)) { if (hi == 0) al_l[r32] = (a); asm volatile("s_waitcnt lgkmcnt(0)" ::: "memory"); \
    for (int d = 0; d < 4; ++d) for (int r = 0; r < 16; ++r) o[d][r] *= al_l[crow(r, hi)]; } } while (0)
  f32x16 pA0, pA1, pB0, pB1; float mnA, mnB, alA, alB; bf16x8 pa0, pa1, pa2, pa3; const int NT = seq / KVBLK;
  constexpr int SE = 0, SO = SDEPTH - 1;
  SLOAD(SE, 0); asm volatile("s_waitcnt vmcnt(0)" ::: "memory"); SWRITE(0, SE); __syncthreads();
  qkt(pA0, pA1, K_lds, qr, r32, hi); partialSM(pA0, pA1, m_reg, mnA, alA);
  SLOAD(SO, KVBLK); if constexpr (SDEPTH == 2) { if (2 < NT) SLOAD(SE, 2 * KVBLK); }
  SWAIT(); SWRITE(1, SO); __syncthreads();
  for (int j = 1; j + 1 < NT; j += 2) {
    SBAR(); qkt(pB0, pB1, (bf16*)((char*)K_lds + SHM_K), qr, r32, hi);
    finishSM(pA0, pA1, alA, l_reg, pa0, pa1, pa2, pa3); SBAR();
    SLOAD(SO, (j + SDEPTH) * KVBLK); SBAR();
    pv_d0(o, vb0, pa0, pa1, pa2, pa3); partialSM(pB0, pB1, m_reg, mnB, alB);
    __syncthreads(); SWAIT(); SWRITE(0, SE);
    RESC(alB); __syncthreads();
    SBAR(); qkt(pA0, pA1, K_lds, qr, r32, hi);
    finishSM(pB0, pB1, alB, l_reg, pa0, pa1, pa2, pa3); SBAR();
    if (SDEPTH == 1 || j + 3 < NT) SLOAD(SE, (j + 1 + SDEPTH) * KVBLK); SBAR();
    pv_d0(o, vb0 + (int)SHM_V, pa0, pa1, pa2, pa3); partialSM(pA0, pA1, m_reg, mnA, alA);
    __syncthreads(); SWAIT(); SWRITE(1, SO);
    RESC(alA); __syncthreads();
  }
  SBAR(); qkt(pB0, pB1, (bf16*)((char*)K_lds + SHM_K), qr, r32, hi);
  finishSM(pA0, pA1, alA, l_reg, pa0, pa1, pa2, pa3); SBAR();
  pv_d0(o, vb0, pa0, pa1, pa2, pa3); partialSM(pB0, pB1, m_reg, mnB, alB);
  __syncthreads(); RESC(alB);
  finishSM(pB0, pB1, alB, l_reg, pa0, pa1, pa2, pa3); SBAR();
  pv_d0(o, vb0 + (int)SHM_V, pa0, pa1, pa2, pa3);
  if (hi == 0) li_l[r32] = l_reg; asm volatile("s_waitcnt lgkmcnt(0)" ::: "memory");
  float rli[16];
#pragma unroll
  for (int r = 0; r < 16; ++r) rli[r] = __builtin_amdgcn_rcpf(li_l[crow(r, hi)]);
  bf16* Ow = Ob + (long)(wid * QBLK) * LDO;
#pragma unroll
  for (int r = 0; r < 16; ++r) { int orow = crow(r, hi);
    for (int d0 = 0; d0 < 4; ++d0) Ow[(long)orow * LDO + d0 * 32 + r32] = f2bf_rne(o[d0][r] * rli[r]); }
#undef SLOAD
#undef SWRITE
#undef SWAIT
#undef RESC
}
#undef KSWZ
#undef SBAR
}

constexpr int DM = 2048, NB = 4, TS = 4096, NT = NB * TS, CL = 256, NC = NB * CL, MTOT = NT + NC, LKV = TS + CL;
constexpr int NPROJ = 9984;
constexpr int INW = 9760;
constexpr int NEXP = 16384;
constexpr float EPS = 1e-6f;
constexpr int NWAVES = 8;
constexpr int NPHASE = 14;

constexpr size_t MiB = 1u << 20;
constexpr size_t WS_CTL = 0, WS_MOD = 1 * MiB, WS_MODP = 2 * MiB, WS_SUBK = 10 * MiB, WS_WBA = 11 * MiB, WS_WBD = 15 * MiB, WS_WOUT = 19 * MiB, WS_WQ = 27 * MiB;
constexpr size_t WS_BETA = 35 * MiB, WS_LOGA = 37 * MiB, WS_EXPI = 39 * MiB, WS_EXPG = 47 * MiB;
constexpr size_t WS_A = 56 * MiB;
constexpr size_t WS_WIN = WS_A, WS_H = WS_A + 39 * MiB;
constexpr size_t WS_DQ = WS_A, WS_DK = WS_A + 34 * MiB, WS_DV = WS_A + 68 * MiB;
constexpr size_t WS_Y = WS_A, WS_H2 = WS_A;
constexpr size_t WS_B = 164 * MiB;
constexpr size_t WS_QN = WS_B, WS_Z = WS_B + 32 * MiB, WS_PQ = WS_B;
constexpr size_t WS_KB = 228 * MiB, WS_VB = 237 * MiB;
constexpr size_t WS_C = 246 * MiB;
constexpr size_t WS_DNRAW = WS_C, WS_U8 = WS_C, WS_V8 = WS_C + 32 * MiB, WS_SU = WS_C + 64 * MiB, WS_SV = WS_C + 65 * MiB, WS_U4 = WS_C + 66 * MiB;
constexpr size_t WS_KT = WS_C, WS_TINV = WS_C + 34 * MiB, WS_QKO = WS_C + 68 * MiB, WS_VEC = WS_C + 102 * MiB;
constexpr size_t WS_D = 374 * MiB;
constexpr size_t WS_G = WS_D, WS_X1 = WS_D;
constexpr size_t WS_ODN = 502 * MiB;
constexpr size_t WS_END = 566 * MiB;
static_assert((size_t)NPROJ * DM * 2 <= 39 * MiB && (size_t)MTOT * DM * 2 <= 69 * MiB && (size_t)MTOT * 1024 * 2 <= 34 * MiB && (size_t)MTOT * 3072 * 2 <= 128 * MiB, "ws map");
static_assert((size_t)NB * LKV * 256 * 2 <= 9 * MiB && (size_t)NT * 4096 * 2 <= 128 * MiB && (size_t)NEXP * DM * 2 <= 64 * MiB, "ws map");

constexpr int LDS_BYTES = 163840;

#define DI __device__ __forceinline__
#define LAS __attribute__((address_space(3)))
typedef unsigned short bf16;
typedef float f32x4 __attribute__((ext_vector_type(4)));
typedef float f32x2 __attribute__((ext_vector_type(2)));
typedef unsigned u32x4 __attribute__((ext_vector_type(4)));
typedef unsigned u32x2 __attribute__((ext_vector_type(2)));

typedef __bf16 bf16x2_n __attribute__((ext_vector_type(2)));
DI unsigned pk2(float lo, float hi) { const f32x2 v = {lo, hi}; return __builtin_bit_cast(unsigned, __builtin_convertvector(v, bf16x2_n)); }
DI unsigned f2bf(float f) { return pk2(f, f) & 0xffffu; }
DI float bflo(unsigned w) { return __uint_as_float(w << 16); }
DI float bfhi(unsigned w) { return __uint_as_float(w & 0xffff0000u); }
DI float bf2f(bf16 h) { return __uint_as_float((unsigned)h << 16); }
DI float wave_sum(float v) {
#pragma unroll
    for (int o = 1; o < 64; o <<= 1) v += __shfl_xor(v, o);
    return v;
}
DI unsigned wave_max_u32(unsigned v) {
#pragma unroll
    for (int o = 1; o < 64; o <<= 1) { const unsigned t = (unsigned)__shfl_xor((int)v, o); v = t > v ? t : v; }
    return v;
}
DI float sigm(float x) { return __builtin_amdgcn_rcpf(1.f + __expf(-x)); }
DI float silu(float x) { return x * __builtin_amdgcn_rcpf(1.f + __expf(-x)); }
DI float softplus(float x) { return x > 20.f ? x : log1pf(__expf(x)); }
DI float gelu_erf(float v) {
    const float av = fabsf(v), t = __builtin_amdgcn_rcpf(av * 0.2316418882f + 1.0f);
    float q = t * 0.5307027145f + (-0.7265760135f); q = q * t + 0.7107068705f; q = q * t + (-0.142248368f); q = q * t + 0.127414796f; q = q * t;
    const float e = __builtin_amdgcn_exp2f((v * v) * (-0.72134752044f));
    const float mm = v * (q * e);
    return v < 0.f ? mm : v - mm;
}
DI unsigned okey(float f) { const unsigned u = __float_as_uint(f); return (u & 0x80000000u) ? ~u : (u | 0x80000000u); }
DI unsigned rdlane(unsigned v, int l) { return (unsigned)__builtin_amdgcn_readlane((int)v, l); }
DI float rdlanef(float v, int l) { return __uint_as_float((unsigned)__builtin_amdgcn_readlane((int)__float_as_uint(v), l)); }

#define XB_TMO      128
#define XB_XCNT(j)  (256  + 64 * (j))
#define XB_XSUB(j)  (1280 + 64 * (j))
#define XB_XGEN(j)  (2304 + 64 * (j))
#define XB_TOP      3328
#define XB_TOPGEN   3392
#define XCD_BAR_WORDS 3456
#define XB_SPIN_CAP (1u << 18)

__device__ __forceinline__ unsigned xb_ld(unsigned* p)              { return __hip_atomic_load(p, __ATOMIC_RELAXED, __HIP_MEMORY_SCOPE_AGENT); }
__device__ __forceinline__ unsigned xb_add(unsigned* p, unsigned v) { return __hip_atomic_fetch_add(p, v, __ATOMIC_RELAXED, __HIP_MEMORY_SCOPE_AGENT); }
__device__ __forceinline__ unsigned xb_xcc_id() { return (unsigned)__builtin_amdgcn_s_getreg((3 << 11) | 20) & 0xFu; }
#define XB_SPIN(cond, bar) do { unsigned _sp = 0; while (cond) { __builtin_amdgcn_s_sleep(1); \
    if ((++_sp & 255u) == 0u) { if (xb_ld(&(bar)[XB_TMO])) break; if (_sp > XB_SPIN_CAP) { atomicAdd(&(bar)[XB_TMO], 1u); break; } } } } while (0)

struct XcdBarrier {
    unsigned* bar; unsigned x;
    volatile LAS unsigned* st;
};

__device__ __forceinline__ XcdBarrier xcd_barrier_post(unsigned* bar, volatile LAS unsigned* st) {
    XcdBarrier b; b.bar = bar; b.x = xb_xcc_id(); b.st = st;
    if (threadIdx.x == 0) (void)xb_add(&bar[XB_XCNT(b.x)], 1u);
    return b;
}
__device__ __forceinline__ void xcd_barrier_complete(unsigned* bar, unsigned x, unsigned& nloc, unsigned& nx) {
    const unsigned G = gridDim.x * gridDim.y * gridDim.z;
    unsigned sum, cnt, mine, sp = 0u;
    for (;;) {
        sum = 0u; cnt = 0u; mine = 0u;
#pragma unroll
        for (unsigned j = 0; j < 16; ++j) { const unsigned c = xb_ld(&bar[XB_XCNT(j)]); sum += c; cnt += (c > 0u) ? 1u : 0u; mine = (j == x) ? c : mine; }
        if (sum == G) break;
        __builtin_amdgcn_s_sleep(1);
        if ((++sp & 255u) == 0u) { if (xb_ld(&bar[XB_TMO])) break; if (sp > XB_SPIN_CAP) { atomicAdd(&bar[XB_TMO], 1u); break; } }
    }
    nloc = mine > 0u ? mine : 1u; nx = cnt > 0u ? cnt : 1u;
}

__device__ __forceinline__ void xcd_barrier(const XcdBarrier& b) {
    asm volatile("s_waitcnt vmcnt(0)" ::: "memory");
    __syncthreads();
    if (threadIdx.x == 0) {
        unsigned* bar = b.bar;
        __builtin_amdgcn_s_waitcnt(0);
        unsigned nloc = b.st[0], nx = b.st[1];
        if (nloc == 0u) { xcd_barrier_complete(bar, b.x, nloc, nx); b.st[0] = nloc; b.st[1] = nx; }
        const unsigned old = xb_add(&bar[XB_XSUB(b.x)], 1u);
        const unsigned gen = old / nloc;
        if (old + 1u == (gen + 1u) * nloc) {
            __builtin_amdgcn_fence(__ATOMIC_RELEASE, "agent");
            asm volatile("s_waitcnt vmcnt(0)" ::: "memory");
            const unsigned og = xb_add(&bar[XB_TOP], 1u);
            const unsigned tg = og / nx;
            if (og + 1u == (tg + 1u) * nx) xb_add(&bar[XB_TOPGEN], 1u);
            else XB_SPIN(xb_ld(&bar[XB_TOPGEN]) == tg, bar);
            __builtin_amdgcn_fence(__ATOMIC_ACQUIRE, "agent");
            xb_add(&bar[XB_XGEN(b.x)], 1u);
            asm volatile("s_waitcnt vmcnt(0)" ::: "memory");
        } else {
            XB_SPIN(xb_ld(&bar[XB_XGEN(b.x)]) == gen, bar);
            __builtin_amdgcn_fence(__ATOMIC_ACQUIRE, "agent");
            asm volatile("s_waitcnt vmcnt(0)" ::: "memory");
        }
    }
    __syncthreads();
}

#define RAW_BAR() do { asm volatile("s_waitcnt lgkmcnt(0)" ::: "memory"); __builtin_amdgcn_s_barrier(); asm volatile("" ::: "memory"); } while (0)

DI unsigned pk4_fp8(float a, float b, float c, float d) { int w = __builtin_amdgcn_cvt_pk_fp8_f32(a, b, 0, false); w = __builtin_amdgcn_cvt_pk_fp8_f32(c, d, w, true); return (unsigned)w; }
constexpr float WIN_SCALE = 64.f;

struct Frame {
    LAS unsigned char* lds;
    unsigned char* ws;
    const float* in[23];
    float* out;
    int tid, lane, wave, vcu, G, gw, NGW;
};

DI size_t dn_off(int m, int h) {
    int b, pos; if (m < NT) { b = m >> 12; pos = 256 + (m & 4095); } else { const int mm = m - NT; b = mm >> 8; pos = mm & 255; }
    return ((size_t)(b * 8 + h) * 4352 + pos) * 128;
}

struct EpiInProj {
    static constexpr bool PERM = true, AFTER_DRAIN = false;
    unsigned char* ws; const float* a_log; const float* dt_bias;
    DI void operator()(const pg8::f32x4 (&acc)[2][2][4][2], const pg8::Unit& u, int wr, int wc, int fr, int fq) const {
        asm volatile("" : "+v"(fr), "+v"(fq));
        const int pn = u.pn, pm = u.pm; const bool isctx = pm >= 64;
        if (pn == 38) {
            if (wc != 0) return;
            float* dstf = (float*)(ws + (fq < 2 ? WS_BETA : WS_LOGA));
            const int c8 = (fq & 1) * 8;
#pragma unroll
            for (int ai = 0; ai < 2; ++ai)
#pragma unroll
                for (int m = 0; m < 4; ++m) {
                    const int row = pm * 256 + ai * 128 + wr * 64 + m * 16 + fr;
#pragma unroll
                    for (int n = 0; n < 2; ++n) {
                        f32x4 v = acc[ai][0][m][n] * (1.f / WIN_SCALE), o;
#pragma unroll
                        for (int i = 0; i < 4; ++i) {
                            const int c = c8 + 4 * n + i;
                            o[i] = (fq < 2) ? sigm(v[i]) : -__expf(a_log[c]) * softplus(v[i] + dt_bias[c]);
                        }
                        *(f32x4*)(dstf + (size_t)row * 16 + c8 + 4 * n) = o;
                    }
                }
            return;
        }
        bf16* dst; int ld, coloff, rowoff = 0; bool sg = false;
        if (pn < 4) { if (isctx) return; dst = (bf16*)(ws + WS_QN); ld = 1024; coloff = pn * 256; }
        else if (pn < 6) { dst = (bf16*)(ws + (pn == 4 ? WS_KB : WS_VB)); ld = 256; coloff = 0; rowoff = isctx ? (-12288 + (pm - 64) * 4096) : (pm >> 4) * 256; }
        else if (pn < 18) { dst = (bf16*)(ws + WS_DNRAW); ld = 3072; coloff = (pn - 6) * 256; }
        else if (pn < 22) { if (isctx) return; dst = (bf16*)(ws + WS_Z); ld = 1024; coloff = (pn - 18) * 256; }
        else { if (isctx) return; dst = (bf16*)(ws + WS_G); ld = 4096; coloff = (pn - 22) * 256; sg = true; }
        const int row0 = pm * 256 + rowoff + wr * 64 + fr, col0 = coloff + wc * 32 + 8 * fq;
#pragma unroll
        for (int ai = 0; ai < 2; ++ai)
#pragma unroll
            for (int m = 0; m < 4; ++m) {
                bf16* rowp = dst + (size_t)(row0 + ai * 128 + m * 16) * ld + col0;
#pragma unroll
                for (int bj = 0; bj < 2; ++bj) {
                    f32x4 v0 = acc[ai][bj][m][0] * (1.f / WIN_SCALE), v1 = acc[ai][bj][m][1] * (1.f / WIN_SCALE);
                    if (sg) {
                        u32x2 gb; gb.x = 0u; gb.y = 0u;
#pragma unroll
                        for (int i = 0; i < 4; ++i) { gb.x |= (unsigned)(sigm(v0[i]) * 255.f + 0.5f) << (8 * i); gb.y |= (unsigned)(sigm(v1[i]) * 255.f + 0.5f) << (8 * i); }
                        __builtin_nontemporal_store(gb, (u32x2*)((unsigned char*)dst + (size_t)(row0 + ai * 128 + m * 16) * 4096 + col0 + bj * 128));
                        continue;
                    }
                    u32x4 w; w.x = pg8::cvt_pk_bf16(v0[0], v0[1]); w.y = pg8::cvt_pk_bf16(v0[2], v0[3]); w.z = pg8::cvt_pk_bf16(v1[0], v1[1]); w.w = pg8::cvt_pk_bf16(v1[2], v1[3]);
                    __builtin_nontemporal_store(w, (u32x4*)(rowp + bj * 128));
                }
            }
    }
};


struct InProjOrder {
    pg8::StaticOrder lat; int G, c;
    static constexpr int NLAT = 64 * 39, NCTX = 4 * 15;
    DI void init(int G_, int c_) { lat.init(NT, NPROJ, G_, c_); G = G_; c = c_; }
    DI bool next(int i, pg8::Unit& u) const {
        const int L = i * G + c;
        if (L < NLAT) return lat.next(i, u);
        const int x = L - NLAT; if (x >= NCTX) return false;
        const int j = x % 15; u.pm = 64 + x / 15; u.pn = j < 2 ? 4 + j : (j < 14 ? 4 + j : 38); return true;
    }
    DI void a_ready(const pg8::Unit&) const {}
    DI void done(const pg8::Unit&) const {}
};

struct EpiPlain {
    static constexpr bool PERM = true, AFTER_DRAIN = false;
    bf16* O; int ldc;
    DI void operator()(const pg8::f32x4 (&acc)[2][2][4][2], const pg8::Unit& u, int wr, int wc, int fr, int fq) const {
        const int row0 = u.pm * 256 + wr * 64 + fr, col0 = u.pn * 256 + wc * 32 + 8 * fq;
#pragma unroll
        for (int ai = 0; ai < 2; ++ai)
#pragma unroll
            for (int m = 0; m < 4; ++m) {
                bf16* rowp = O + (size_t)(row0 + ai * 128 + m * 16) * ldc + col0;
#pragma unroll
                for (int bj = 0; bj < 2; ++bj) {
                    const f32x4 v0 = acc[ai][bj][m][0], v1 = acc[ai][bj][m][1];
                    u32x4 w; w.x = pg8::cvt_pk_bf16(v0[0], v0[1]); w.y = pg8::cvt_pk_bf16(v0[2], v0[3]); w.z = pg8::cvt_pk_bf16(v1[0], v1[1]); w.w = pg8::cvt_pk_bf16(v1[2], v1[3]);
                    *(u32x4*)(rowp + bj * 128) = w;
                }
            }
    }
};

template <bool ADD> struct EpiMerge {
    static constexpr bool PERM = true, AFTER_DRAIN = false;
    bf16* Y; const unsigned char* G; int goff;
    DI void operator()(const pg8::f32x4 (&acc)[2][2][4][2], const pg8::Unit& u, int wr, int wc, int fr, int fq) const {
        const int row0 = u.pm * 256 + wr * 64 + fr, col0 = u.pn * 256 + wc * 32 + 8 * fq;
#pragma unroll
        for (int ai = 0; ai < 2; ++ai)
#pragma unroll
            for (int m = 0; m < 4; ++m) {
                const size_t row = (size_t)(row0 + ai * 128 + m * 16);
#pragma unroll
                for (int bj = 0; bj < 2; ++bj) {
                    const f32x4 v0 = acc[ai][bj][m][0], v1 = acc[ai][bj][m][1];
                    const u32x2 g = __builtin_nontemporal_load((const u32x2*)(G + row * 4096 + goff + col0 + bj * 128));
                    float r[8];
#pragma unroll
                    for (int i = 0; i < 4; ++i) { r[i] = (float)((g.x >> (8 * i)) & 0xffu) * (1.f / 255.f) * v0[i]; r[4 + i] = (float)((g.y >> (8 * i)) & 0xffu) * (1.f / 255.f) * v1[i]; }
                    bf16* yp = Y + row * 2048 + col0 + bj * 128;
                    if (ADD) {
                        const u32x4 y = *(const u32x4*)yp;
                        r[0] += bflo(y.x); r[1] += bfhi(y.x); r[2] += bflo(y.y); r[3] += bfhi(y.y); r[4] += bflo(y.z); r[5] += bfhi(y.z); r[6] += bflo(y.w); r[7] += bfhi(y.w);
                    }
                    u32x4 w; w.x = pg8::cvt_pk_bf16(r[0], r[1]); w.y = pg8::cvt_pk_bf16(r[2], r[3]); w.z = pg8::cvt_pk_bf16(r[4], r[5]); w.w = pg8::cvt_pk_bf16(r[6], r[7]);
                    *(u32x4*)yp = w;
                }
            }
    }
};

struct EpiResid {
    static constexpr bool PERM = true, AFTER_DRAIN = false;
    const float* x; bf16* X1; const float* mod;
    DI void operator()(const pg8::f32x4 (&acc)[2][2][4][2], const pg8::Unit& u, int wr, int wc, int fr, int fq) const {
        const int row0 = u.pm * 256 + wr * 64 + fr, col0 = u.pn * 256 + wc * 32 + 8 * fq;
        const float* g1 = mod + (size_t)(u.pm >> 4) * 12288 + 2 * 2048;
        f32x4 gv[2][2];
#pragma unroll
        for (int bj = 0; bj < 2; ++bj)
#pragma unroll
            for (int n = 0; n < 2; ++n) gv[bj][n] = *(const f32x4*)(g1 + col0 + bj * 128 + n * 4);
#pragma unroll
        for (int ai = 0; ai < 2; ++ai)
#pragma unroll
            for (int m = 0; m < 4; ++m) {
                const size_t off = (size_t)(row0 + ai * 128 + m * 16) * 2048 + col0;
#pragma unroll
                for (int bj = 0; bj < 2; ++bj) {
                    const f32x4 x0 = __builtin_nontemporal_load((const f32x4*)(x + off + bj * 128)), x1 = __builtin_nontemporal_load((const f32x4*)(x + off + bj * 128 + 4));
                    const f32x4 v0 = x0 + gv[bj][0] * acc[ai][bj][m][0], v1 = x1 + gv[bj][1] * acc[ai][bj][m][1];
                    u32x4 w; w.x = pk2(v0[0], v0[1]); w.y = pk2(v0[2], v0[3]); w.z = pk2(v1[0], v1[1]); w.w = pk2(v1[2], v1[3]);
                    *(u32x4*)(X1 + off + bj * 128) = w;
                }
            }
    }
};

DI void transpose_item(const float* W, int K, int Nsrc, int sn0, bf16* WT, int dn0, int k0, LAS float* scr, int lane) {
    if (sn0 >= 0) {
        float t[32];
#pragma unroll
        for (int i = 0; i < 32; ++i) t[i] = __builtin_nontemporal_load(&W[(size_t)(k0 + 2 * i + (lane >> 5)) * Nsrc + sn0 + (lane & 31)]);
#pragma unroll
        for (int i = 0; i < 32; ++i) scr[(2 * i + (lane >> 5)) * 33 + (lane & 31)] = t[i];
    } else {
#pragma unroll 8
        for (int i = 0; i < 32; ++i) { const int kk = 2 * i + (lane >> 5); scr[kk * 33 + (lane & 31)] = 0.f; }
    }
    asm volatile("s_waitcnt lgkmcnt(0)" ::: "memory");
    const int c = lane & 7;
#pragma unroll
    for (int j = 0; j < 4; ++j) {
        const int n = (lane >> 3) + 8 * j; const LAS float* s = scr + (8 * c) * 33 + n;
        u32x4 o; o.x = pk2(s[0 * 33], s[1 * 33]); o.y = pk2(s[2 * 33], s[3 * 33]); o.z = pk2(s[4 * 33], s[5 * 33]); o.w = pk2(s[6 * 33], s[7 * 33]);
        *(u32x4*)(WT + (size_t)(dn0 + n) * K + k0 + 8 * c) = o;
    }
    asm volatile("s_waitcnt lgkmcnt(0)" ::: "memory");
}

DI void transpose_item_fp8(const float* W, int K, int Nsrc, int sn0, unsigned char* WT, int dn0, int k0, float scale, LAS float* scr, int lane) {
    if (sn0 >= 0) {
        float t[32];
#pragma unroll
        for (int i = 0; i < 32; ++i) t[i] = __builtin_nontemporal_load(&W[(size_t)(k0 + 2 * i + (lane >> 5)) * Nsrc + sn0 + (lane & 31)]);
#pragma unroll
        for (int i = 0; i < 32; ++i) scr[(2 * i + (lane >> 5)) * 33 + (lane & 31)] = t[i] * scale;
    } else {
#pragma unroll 8
        for (int i = 0; i < 32; ++i) { const int kk = 2 * i + (lane >> 5); scr[kk * 33 + (lane & 31)] = 0.f; }
    }
    asm volatile("s_waitcnt lgkmcnt(0)" ::: "memory");
    const int c = lane & 7;
#pragma unroll
    for (int j = 0; j < 4; ++j) {
        const int n = (lane >> 3) + 8 * j; const LAS float* s = scr + (8 * c) * 33 + n;
        u32x2 o; o.x = pk4_fp8(s[0 * 33], s[1 * 33], s[2 * 33], s[3 * 33]); o.y = pk4_fp8(s[4 * 33], s[5 * 33], s[6 * 33], s[7 * 33]);
        *(u32x2*)(WT + (size_t)(dn0 + n) * K + k0 + 8 * c) = o;
    }
    asm volatile("s_waitcnt lgkmcnt(0)" ::: "memory");
}

DI void cvt_bf16_stream(const float* src, bf16* dst, size_t n8, size_t gtid, size_t nthr) {
    for (size_t i = gtid; i < n8; i += nthr) {
        const f32x4 a = *(const f32x4*)(src + i * 8), b = *(const f32x4*)(src + i * 8 + 4);
        u32x4 w; w.x = pk2(a[0], a[1]); w.y = pk2(a[2], a[3]); w.z = pk2(b[0], b[1]); w.w = pk2(b[2], b[3]);
        *(u32x4*)(dst + i * 8) = w;
    }
}

DI void phase_prologue(Frame& F) {
    LAS float* scr = (LAS float*)(F.lds + F.wave * 16384);
    constexpr int I_WIN = 32 * 312, I_WB = 16 * 64, I_WO = 32 * 64;
    constexpr int NITEMS = I_WIN + 2 * I_WB + 2 * I_WO;
    for (int it = F.gw; it < NITEMS; it += F.NGW) {
        int r = it;
        if (r < I_WIN) { const int kb = r / 312, nb = r % 312; const int snb = nb < 176 ? nb : (nb < 304 ? nb + 1 : (nb == 304 ? 176 : -1));
            transpose_item_fp8(F.in[8], DM, INW, snb < 0 ? -1 : snb * 32, F.ws + WS_WIN, nb * 32, kb * 64, WIN_SCALE, scr, F.lane); continue; }
        r -= I_WIN;
        if (r < I_WB) { transpose_item(F.in[15], 1024, DM, (r % 64) * 32, (bf16*)(F.ws + WS_WBA), (r % 64) * 32, (r / 64) * 64, scr, F.lane); continue; }
        r -= I_WB;
        if (r < I_WB) { transpose_item(F.in[16], 1024, DM, (r % 64) * 32, (bf16*)(F.ws + WS_WBD), (r % 64) * 32, (r / 64) * 64, scr, F.lane); continue; }
        r -= I_WB;
        if (r < I_WO) { transpose_item(F.in[17], DM, DM, (r % 64) * 32, (bf16*)(F.ws + WS_WOUT), (r % 64) * 32, (r / 64) * 64, scr, F.lane); continue; }
        r -= I_WO;
        transpose_item(F.in[18], DM, DM, (r % 64) * 32, (bf16*)(F.ws + WS_WQ), (r % 64) * 32, (r / 64) * 64, scr, F.lane);
    }
    cvt_bf16_stream(F.in[19], (bf16*)(F.ws + WS_SUBK), (size_t)8 * 2 * 128 * 128 / 8, (size_t)blockIdx.x * 512 + F.tid, (size_t)F.G * 512);
    LAS float* sc = (LAS float*)(F.lds + 131072);
    const float* ada_w = F.in[4];
    float* MODP = (float*)(F.ws + WS_MODP);
    for (int it = blockIdx.x; it < 32 * 24; it += F.G) {
        const int kc = it / 24, nb = it % 24, n = nb * 512 + F.tid;
        __syncthreads();
        if (F.tid < 320) { const int r = F.tid >> 6, kk = F.tid & 63, k = kc * 64 + kk; const float cv = (r < 4) ? F.in[1][r * DM + k] : F.in[3][k]; sc[r * 64 + kk] = silu(cv); }
        __syncthreads();
        float a0 = 0.f, a1 = 0.f, a2 = 0.f, a3 = 0.f, a4 = 0.f;
#pragma unroll 32
        for (int kk = 0; kk < 64; ++kk) {
            const float w = __builtin_nontemporal_load(&ada_w[(size_t)(kc * 64 + kk) * 12288 + n]);
            a0 += sc[kk] * w; a1 += sc[64 + kk] * w; a2 += sc[128 + kk] * w; a3 += sc[192 + kk] * w; a4 += sc[256 + kk] * w;
        }
        float* o = MODP + (size_t)kc * 5 * 12288 + n;
        o[0] = a0; o[12288] = a1; o[2 * 12288] = a2; o[3 * 12288] = a3; o[4 * 12288] = a4;
    }
}

DI void phase_modreduce(Frame& F) {
    const float* MODP = (const float*)(F.ws + WS_MODP); float* MOD = (float*)(F.ws + WS_MOD); const float* ada_b = F.in[5];
    for (int i = blockIdx.x * 512 + F.tid; i < 5 * 12288; i += F.G * 512) {
        const int n = i % 12288; float s = ada_b[n];
#pragma unroll 8
        for (int kc = 0; kc < 32; ++kc) s += MODP[(size_t)kc * 5 * 12288 + i];
        MOD[i] = s;
    }
}

DI void modnorm_row(const float* xrow, bf16* orow, const float* nw, const float* sc, const float* sh, int lane) {
    f32x4 v[8]; float ss = 0.f;
#pragma unroll
    for (int j = 0; j < 8; ++j) { v[j] = *((const f32x4*)xrow + lane + 64 * j); ss += (v[j][0] * v[j][0] + v[j][1] * v[j][1]) + (v[j][2] * v[j][2] + v[j][3] * v[j][3]); }
    const float rstd = rsqrtf(wave_sum(ss) * (1.f / DM) + EPS);
#pragma unroll
    for (int j = 0; j < 8; ++j) {
        const int c = (lane + 64 * j) * 4;
        const f32x4 w = *(const f32x4*)(nw + c), s = *(const f32x4*)(sc + c), h = *(const f32x4*)(sh + c);
        f32x4 o;
#pragma unroll
        for (int i = 0; i < 4; ++i) o[i] = (v[j][i] * rstd * w[i]) * (1.f + s[i]) + h[i];
        u32x2 p; p.x = pk2(o[0], o[1]); p.y = pk2(o[2], o[3]);
        *(u32x2*)(orow + c) = p;
    }
}

DI void modnorm_row_bf(const bf16* xrow, bf16* orow, const float* nw, const float* sc, const float* sh, int lane) {
    f32x4 v[8]; float ss = 0.f;
#pragma unroll
    for (int j = 0; j < 8; ++j) { const u32x2 w = *((const u32x2*)xrow + lane + 64 * j); v[j] = (f32x4){bflo(w.x), bfhi(w.x), bflo(w.y), bfhi(w.y)}; ss += (v[j][0] * v[j][0] + v[j][1] * v[j][1]) + (v[j][2] * v[j][2] + v[j][3] * v[j][3]); }
    const float rstd = rsqrtf(wave_sum(ss) * (1.f / DM) + EPS);
#pragma unroll
    for (int j = 0; j < 8; ++j) {
        const int c = (lane + 64 * j) * 4;
        const f32x4 w = *(const f32x4*)(nw + c), s = *(const f32x4*)(sc + c), h = *(const f32x4*)(sh + c);
        f32x4 o;
#pragma unroll
        for (int i = 0; i < 4; ++i) o[i] = (v[j][i] * rstd * w[i]) * (1.f + s[i]) + h[i];
        u32x2 p; p.x = pk2(o[0], o[1]); p.y = pk2(o[2], o[3]);
        *(u32x2*)(orow + c) = p;
    }
}

DI void modnorm_row_fp8(const float* xrow, unsigned char* orow, const float* nw, const float* sc, const float* sh, int lane) {
    f32x4 v[8]; float ss = 0.f;
#pragma unroll
    for (int j = 0; j < 8; ++j) { v[j] = __builtin_nontemporal_load((const f32x4*)xrow + lane + 64 * j); ss += (v[j][0] * v[j][0] + v[j][1] * v[j][1]) + (v[j][2] * v[j][2] + v[j][3] * v[j][3]); }
    const float rstd = rsqrtf(wave_sum(ss) * (1.f / DM) + EPS);
#pragma unroll
    for (int j = 0; j < 8; ++j) {
        const int c = (lane + 64 * j) * 4;
        const f32x4 w = *(const f32x4*)(nw + c), s = *(const f32x4*)(sc + c), h = *(const f32x4*)(sh + c);
        f32x4 o;
#pragma unroll
        for (int i = 0; i < 4; ++i) o[i] = (v[j][i] * rstd * w[i]) * (1.f + s[i]) + h[i];
        *(unsigned*)(orow + c) = pk4_fp8(o[0], o[1], o[2], o[3]);
    }
}

DI void phase_h1(Frame& F) {
    const float* MOD = (const float*)(F.ws + WS_MOD); unsigned char* H = F.ws + WS_H;
    for (int m = F.gw; m < MTOT; m += F.NGW) {
        const bool isl = m < NT; const int r = isl ? (m >> 12) : 4;
        const float* xrow = isl ? F.in[0] + (size_t)m * DM : F.in[2] + (size_t)(m - NT) * DM;
        modnorm_row_fp8(xrow, H + (size_t)m * DM, F.in[6], MOD + (size_t)r * 12288 + 2048, MOD + (size_t)r * 12288, F.lane);
    }
}

DI void phase_postproj(Frame& F) {
    const int lane = F.lane, tid = F.tid;
    LAS float* tcs = (LAS float*)F.lds;
    for (int i = tid; i < 2048; i += 512) { const int pos = i >> 5, f = i & 31; float sn, cs; sincosf((float)pos * exp2f(-(float)f * (13.287712379549449f / 32.f)), &sn, &cs); tcs[i] = cs; tcs[2048 + i] = sn; }
    __syncthreads();
    {
        bf16* QN = (bf16*)(F.ws + WS_QN); bf16* KB = (bf16*)(F.ws + WS_KB);
        const int j = lane & 7, axis = j >> 2, fg = j & 3, d1 = axis * 64 + 8 * fg;
        f32x4 qw[4], kw[4];
        qw[0] = *(const f32x4*)(F.in[9] + d1); qw[1] = *(const f32x4*)(F.in[9] + d1 + 4); qw[2] = *(const f32x4*)(F.in[9] + d1 + 32); qw[3] = *(const f32x4*)(F.in[9] + d1 + 36);
        kw[0] = *(const f32x4*)(F.in[10] + d1); kw[1] = *(const f32x4*)(F.in[10] + d1 + 4); kw[2] = *(const f32x4*)(F.in[10] + d1 + 32); kw[3] = *(const f32x4*)(F.in[10] + d1 + 36);
        constexpr int NQI = NT, NKI = NB * LKV / 4;
        for (int it = F.gw; it < NQI + NKI; it += F.NGW) {
            bf16* p; int t; bool rope; const bool isq = it < NQI;
            if (isq) { p = QN + (size_t)it * 1024 + (lane >> 3) * 128; t = it & 4095; rope = true; }
            else { const int row = (it - NQI) * 4 + (lane >> 4), pp = row % LKV; p = KB + (size_t)row * 256 + ((lane >> 3) & 1) * 128; t = pp; rope = pp < TS; }
            const u32x4 w1 = *(const u32x4*)(p + d1), w2 = *(const u32x4*)(p + d1 + 32);
            float x1[8], x2[8];
            x1[0] = bflo(w1.x); x1[1] = bfhi(w1.x); x1[2] = bflo(w1.y); x1[3] = bfhi(w1.y); x1[4] = bflo(w1.z); x1[5] = bfhi(w1.z); x1[6] = bflo(w1.w); x1[7] = bfhi(w1.w);
            x2[0] = bflo(w2.x); x2[1] = bfhi(w2.x); x2[2] = bflo(w2.y); x2[3] = bfhi(w2.y); x2[4] = bflo(w2.z); x2[5] = bfhi(w2.z); x2[6] = bflo(w2.w); x2[7] = bfhi(w2.w);
            float ss = 0.f;
#pragma unroll
            for (int i = 0; i < 8; ++i) ss += x1[i] * x1[i] + x2[i] * x2[i];
            ss += __shfl_xor(ss, 1); ss += __shfl_xor(ss, 2); ss += __shfl_xor(ss, 4);
            const float rstd = rsqrtf(ss * (1.f / 128.f) + EPS);
            const int pos = axis == 0 ? (t >> 6) : (t & 63);
            float o1[8], o2[8];
#pragma unroll
            for (int i = 0; i < 8; ++i) {
                const float wa = isq ? qw[i >> 2][i & 3] : kw[i >> 2][i & 3], wb = isq ? qw[2 + (i >> 2)][i & 3] : kw[2 + (i >> 2)][i & 3];
                const float y1 = x1[i] * rstd * wa, y2 = x2[i] * rstd * wb;
                const float cs = rope ? tcs[pos * 32 + 8 * fg + i] : 1.f, sn = rope ? tcs[2048 + pos * 32 + 8 * fg + i] : 0.f;
                o1[i] = y1 * cs - y2 * sn; o2[i] = y2 * cs + y1 * sn;
            }
            u32x4 r1, r2;
            r1.x = pk2(o1[0], o1[1]); r1.y = pk2(o1[2], o1[3]); r1.z = pk2(o1[4], o1[5]); r1.w = pk2(o1[6], o1[7]);
            r2.x = pk2(o2[0], o2[1]); r2.y = pk2(o2[2], o2[3]); r2.z = pk2(o2[4], o2[5]); r2.w = pk2(o2[6], o2[7]);
            *(u32x4*)(p + d1) = r1; *(u32x4*)(p + d1 + 32) = r2;
        }
    }
    {
        const bf16* RAW = (const bf16*)(F.ws + WS_DNRAW); const float* cw = F.in[11];
        for (int it = F.gw; it < (MTOT / 16) * 6; it += F.NGW) {
            const int tc = it / 6, grp = it % 6, m0 = tc * 16, part = grp >> 1;
            int start, len; if (m0 < NT) { start = m0 & ~4095; len = TS; } else { start = NT + ((m0 - NT) & ~255); len = CL; }
            const int pos0 = m0 - start, c = grp * 512 + 8 * lane;
            float wv[5][8];
#pragma unroll
            for (int jj = 0; jj < 5; ++jj) { const f32x4 a = *(const f32x4*)(cw + jj * 3072 + c), b = *(const f32x4*)(cw + jj * 3072 + c + 4);
                wv[jj][0] = a[0]; wv[jj][1] = a[1]; wv[jj][2] = a[2]; wv[jj][3] = a[3]; wv[jj][4] = b[0]; wv[jj][5] = b[1]; wv[jj][6] = b[2]; wv[jj][7] = b[3]; }
            u32x4 rows[20];
#pragma unroll
            for (int r = 0; r < 20; ++r) { const int pp = pos0 + r - 2; rows[r] = (pp >= 0 && pp < len) ? *(const u32x4*)(RAW + (size_t)(start + pp) * 3072 + c) : (u32x4){0u, 0u, 0u, 0u}; }
            bf16* dst = (bf16*)(F.ws + (part == 0 ? WS_DQ : (part == 1 ? WS_DK : WS_DV))) + dn_off(m0, (grp & 1) * 4 + (lane >> 4)) + 8 * (lane & 15);
#pragma unroll
            for (int tk = 0; tk < 16; ++tk) {
                float a[8];
#pragma unroll
                for (int i = 0; i < 8; ++i) a[i] = 0.f;
#pragma unroll
                for (int jj = 0; jj < 5; ++jj) { const u32x4 w = rows[tk + jj];
                    a[0] += wv[jj][0] * bflo(w.x); a[1] += wv[jj][1] * bfhi(w.x); a[2] += wv[jj][2] * bflo(w.y); a[3] += wv[jj][3] * bfhi(w.y);
                    a[4] += wv[jj][4] * bflo(w.z); a[5] += wv[jj][5] * bfhi(w.z); a[6] += wv[jj][6] * bflo(w.w); a[7] += wv[jj][7] * bfhi(w.w); }
                float ss = 0.f;
#pragma unroll
                for (int i = 0; i < 8; ++i) { a[i] = silu(a[i]); ss += a[i] * a[i]; }
                if (part < 2) {
                    ss += __shfl_xor(ss, 1); ss += __shfl_xor(ss, 2); ss += __shfl_xor(ss, 4); ss += __shfl_xor(ss, 8);
                    const float r = rsqrtf(ss + EPS) * (part == 0 ? 0.088388347648318440f : 1.f);
#pragma unroll
                    for (int i = 0; i < 8; ++i) a[i] *= r;
                }
                u32x4 o; o.x = pk2(a[0], a[1]); o.y = pk2(a[2], a[3]); o.z = pk2(a[4], a[5]); o.w = pk2(a[6], a[7]);
                *(u32x4*)(dst + tk * 128) = o;
            }
        }
    }
}

DI void phase_dn_naive(Frame& F) {
    if (F.wave != 0 || blockIdx.x >= 128) return;
    const int item = blockIdx.x, dir = item >> 6, b = (item >> 4) & 3, h = (item >> 1) & 7, half = item & 1, lane = F.lane;
    const bf16* DQ = (const bf16*)(F.ws + WS_DQ); const bf16* DK = (const bf16*)(F.ws + WS_DK); const bf16* DV = (const bf16*)(F.ws + WS_DV);
    const float* BETA = (const float*)(F.ws + WS_BETA); const float* LOGA = (const float*)(F.ws + WS_LOGA);
    bf16* ODN = (bf16*)(F.ws + WS_ODN);
    float S[128];
#pragma unroll
    for (int i = 0; i < 128; ++i) S[i] = 0.f;
    for (int step = 0; step < LKV; ++step) {
        const bool isl = step >= CL; const int p = isl ? step - CL : step, len = isl ? TS : CL, pos = dir ? len - 1 - p : p;
        const int m = isl ? b * TS + pos : NT + b * CL + pos;
        const unsigned kw = *(const unsigned*)(DK + dn_off(m, h) + 2 * lane);
        const unsigned qw = *(const unsigned*)(DQ + dn_off(m, h) + 2 * lane);
        const float vj = bf2f(DV[dn_off(m, h) + half * 64 + lane]);
        const float a = __expf(LOGA[(size_t)m * 16 + dir * 8 + h]), bt = BETA[(size_t)m * 16 + dir * 8 + h];
        float k0 = 0.f, k1 = 0.f, k2 = 0.f, k3 = 0.f;
#pragma unroll
        for (int i = 0; i < 64; i += 2) {
            const unsigned w0 = rdlane(kw, i), w1 = rdlane(kw, i + 1);
            k0 += bflo(w0) * S[2 * i]; k1 += bfhi(w0) * S[2 * i + 1]; k2 += bflo(w1) * S[2 * i + 2]; k3 += bfhi(w1) * S[2 * i + 3];
        }
        const float kS = (k0 + k1) + (k2 + k3);
        const float coef = bt * (vj - a * kS);
#pragma unroll
        for (int i = 0; i < 64; ++i) { const unsigned w0 = rdlane(kw, i); S[2 * i] = a * S[2 * i] + coef * bflo(w0); S[2 * i + 1] = a * S[2 * i + 1] + coef * bfhi(w0); }
        if (isl) {
            float o0 = 0.f, o1 = 0.f, o2 = 0.f, o3 = 0.f;
#pragma unroll
            for (int i = 0; i < 64; i += 2) {
                const unsigned w0 = rdlane(qw, i), w1 = rdlane(qw, i + 1);
                o0 += bflo(w0) * S[2 * i]; o1 += bfhi(w0) * S[2 * i + 1]; o2 += bflo(w1) * S[2 * i + 2]; o3 += bfhi(w1) * S[2 * i + 3];
            }
            ODN[((size_t)dir * NT + m) * 1024 + h * 128 + half * 64 + lane] = (bf16)f2bf((o0 + o1) + (o2 + o3));
        }
    }
}

DI int dn_row0(int b, int cc) { return cc < 4 ? NT + b * CL + 64 * cc : b * TS + 64 * (cc - 4); }
typedef short bf16x8_t __attribute__((ext_vector_type(8)));
#define MFMA16(a, b, c) __builtin_amdgcn_mfma_f32_16x16x32_bf16((a), (b), (c), 0, 0, 0)

DI bf16x8_t dn_afrag(const LAS unsigned char* p) {
    const u32x2 lo = *(const LAS u32x2*)p, hi = *(const LAS u32x2*)(p + 32);
    u32x4 v; v.x = lo.x; v.y = lo.y; v.z = hi.x; v.w = hi.y; return __builtin_bit_cast(bf16x8_t, v);
}
DI bf16x8_t dn_bpack(const f32x4 t0, const f32x4 t1) {
    u32x4 v; v.x = pk2(t0[0], t0[1]); v.y = pk2(t0[2], t0[3]); v.z = pk2(t1[0], t1[1]); v.w = pk2(t1[2], t1[3]); return __builtin_bit_cast(bf16x8_t, v);
}
DI void phase_dn_prep(Frame& F) {
    LAS unsigned char* L = F.lds;
    constexpr int KS = 0, QS = 17408, VC = 34816, AP = 35840;
    constexpr int NITEM = NB * 8 * 68, NBATCH = (NITEM + 2) / 3;
    const bf16* DQ = (const bf16*)(F.ws + WS_DQ); const bf16* DK = (const bf16*)(F.ws + WS_DK);
    const float* BETA = (const float*)(F.ws + WS_BETA); const float* LOGA = (const float*)(F.ws + WS_LOGA);
    bf16* KT = (bf16*)(F.ws + WS_KT); bf16* TINV = (bf16*)(F.ws + WS_TINV); bf16* QKO = (bf16*)(F.ws + WS_QKO); float* VEC = (float*)(F.ws + WS_VEC);
    const int tid = F.tid, wave = F.wave;
    LAS float* vg = (LAS float*)(L + VC); LAS float* vb = vg + 128;
    for (int batch = F.vcu; batch < NBATCH; batch += F.G) {
        int lane = F.lane; asm volatile("" : "+v"(lane));
        const int fr = lane & 15, fq = lane >> 4;
#pragma unroll 1
        for (int c3 = 0; c3 < 3; ++c3) {
            const int item = batch * 3 + c3;
            if (item >= NITEM) break;
            const int b = item / 544, h = (item % 544) / 68, cc = item % 68, row0 = dn_row0(b, cc);
#pragma unroll
            for (int k = 0; k < 4; ++k) {
                const int c = tid + 512 * k, which = c >> 10, c2 = c & 1023, row = c2 >> 4, c16 = c2 & 15;
                const u32x4 v = *(const u32x4*)((which ? DQ : DK) + (size_t)item * 8192 + c2 * 8);
                *(LAS u32x4*)(L + (which ? QS : KS) + row * 272 + c16 * 16) = v;
            }
            if (wave < 2) {
                const int d = wave, i = lane;
                const float la = LOGA[(size_t)(row0 + i) * 16 + d * 8 + h], bt = BETA[(size_t)(row0 + i) * 16 + d * 8 + h];
                float x = la;
                if (d == 0) {
#pragma unroll
                    for (int o = 1; o < 64; o <<= 1) { const float y = __shfl_up(x, o); if (i >= o) x += y; }
                } else {
#pragma unroll
                    for (int o = 1; o < 64; o <<= 1) { const float y = __shfl_down(x, o); if (i + o < 64) x += y; }
                }
                const float glast = __shfl(x, d == 0 ? 63 : 0);
                vg[d * 64 + i] = x; vb[d * 64 + i] = bt;
                float* ve = VEC + (size_t)(item * 2 + d) * 320;
                const float eg = __expf(x);
                ve[i] = bt; ve[64 + i] = eg; ve[128 + i] = bt * eg; ve[192 + i] = __expf(glast - x); ve[256 + i] = __expf(glast);
            }
            __syncthreads();
            {
                bf16* kt = KT + (size_t)item * 8192;
#pragma unroll
                for (int k = 0; k < 2; ++k) {
                    const int c = tid + 512 * k, dk = c >> 3, t8 = c & 7;
                    unsigned short e[8];
#pragma unroll
                    for (int q = 0; q < 8; ++q) e[q] = *(const LAS unsigned short*)(L + KS + (8 * t8 + q) * 272 + dk * 2);
                    u32x4 w; w.x = e[0] | ((unsigned)e[1] << 16); w.y = e[2] | ((unsigned)e[3] << 16); w.z = e[4] | ((unsigned)e[5] << 16); w.w = e[6] | ((unsigned)e[7] << 16);
                    *(u32x4*)(kt + dk * 64 + 8 * t8) = w;
                }
            }
            {
                const int it = wave & 3, mat = wave >> 2;
                f32x4 acc[4];
#pragma unroll
                for (int j = 0; j < 4; ++j) acc[j] = (f32x4){0.f, 0.f, 0.f, 0.f};
#pragma unroll
                for (int s = 0; s < 4; ++s) {
                    const bf16x8_t a = *(const LAS bf16x8_t*)(L + (mat ? QS : KS) + (16 * it + fr) * 272 + (32 * s + 8 * fq) * 2);
#pragma unroll
                    for (int jt = 0; jt < 4; ++jt) {
                        const bf16x8_t bb = *(const LAS bf16x8_t*)(L + KS + (16 * jt + fr) * 272 + (32 * s + 8 * fq) * 2);
                        acc[jt] = MFMA16(a, bb, acc[jt]);
                    }
                }
#pragma unroll
                for (int d = 0; d < 2; ++d) {
                    LAS float* ap = (LAS float*)(L + AP + (c3 * 2 + d) * 17408);
                    bf16* qo = QKO + (size_t)(item * 2 + d) * 4096;
#pragma unroll
                    for (int jt = 0; jt < 4; ++jt)
#pragma unroll
                        for (int r = 0; r < 4; ++r) {
                            const int i = 16 * it + 4 * fq + r, j = 16 * jt + fr, ip = d ? 63 - i : i, jp = d ? 63 - j : j;
                            const float dg = vg[d * 64 + i] - vg[d * 64 + j];
                            if (mat == 0) { ap[ip * 68 + jp] = (jp < ip) ? vb[d * 64 + i] * acc[jt][r] * __expf(dg) : 0.f; }
                            else { qo[i * 64 + j] = (bf16)f2bf((jp <= ip) ? acc[jt][r] * __expf(dg) : 0.f); }
                        }
                }
            }
            __syncthreads();
        }
        if (wave < 6 && batch * 3 + (wave >> 1) < NITEM) {
            const int item = batch * 3 + (wave >> 1), d = wave & 1, c = lane;
            const LAS float* ap = (const LAS float*)(L + AP + wave * 17408);
            float x[64];
#pragma unroll
            for (int ip = 0; ip < 64; ++ip) {
                float a0 = (ip == c) ? 1.f : 0.f, a1 = 0.f;
#pragma unroll
                for (int q = 0; q < (ip + 3) / 4; ++q) {
                    const f32x4 av = *(const LAS f32x4*)(ap + ip * 68 + 4 * q);
#pragma unroll
                    for (int e = 0; e < 4; ++e) { const int jp = 4 * q + e; if (jp < ip) { if (e & 1) a1 -= av[e] * x[jp]; else a0 -= av[e] * x[jp]; } }
                }
                x[ip] = a0 + a1;
                __builtin_amdgcn_sched_barrier(0);
            }
            bf16* ti = TINV + (size_t)(item * 2 + d) * 4096;
            const int j = d ? 63 - c : c;
#pragma unroll
            for (int ip = 0; ip < 64; ++ip) { const int i = d ? 63 - ip : ip; ti[i * 64 + j] = (bf16)f2bf(x[ip]); }
        }
        __syncthreads();
    }
}

DI int dn_perm(int m, int t) { return 32 * (t >> 1) + 8 * (m >> 2) + 4 * (t & 1) + (m & 3); }
DI int dn_swz16(int row, int chunk) { return row * 272 + (chunk << 4); }
DI int dn_swz8(int row, int chunk) { return row * 144 + (chunk << 4); }
#define DN_BAR() do { asm volatile("s_waitcnt lgkmcnt(0)" ::: "memory"); __builtin_amdgcn_s_barrier(); asm volatile("" ::: "memory"); } while (0)
DI void phase_dn_scan(Frame& F) {
    LAS unsigned char* L = F.lds;
    constexpr int KS = 0, QS = 17408, KTS = 34816, TIS = 53248, VS = 62464, VCS = 66560, BUF = 68096;
    constexpr int PUBS = 2 * BUF, PUBV = PUBS + 16384;
    static_assert(PUBV + 8192 <= LDS_BYTES - 64, "scan LDS map");
    const int G8 = F.G >> 3;
    const int li = blockIdx.x >> 3, chain = (blockIdx.x & 7) * (G8 >> 2) + (li >> 2), qd = li & 3;
    if (F.G != 256 || chain >= 64) return;
    const int dir = chain >> 5, b = (chain >> 3) & 3, h = chain & 7;
    const bf16* DQ = (const bf16*)(F.ws + WS_DQ); const bf16* DK = (const bf16*)(F.ws + WS_DK); const bf16* DV = (const bf16*)(F.ws + WS_DV);
    const bf16* KT = (const bf16*)(F.ws + WS_KT); const bf16* TINV = (const bf16*)(F.ws + WS_TINV); const bf16* QKO = (const bf16*)(F.ws + WS_QKO); const float* VEC = (const float*)(F.ws + WS_VEC);
    bf16* ODN = (bf16*)(F.ws + WS_ODN);
    const int tid = F.tid, lane = F.lane, w = F.wave, fr = lane & 15, fq = lane >> 4;
#ifndef DN_NSTEP
#define DN_NSTEP 68
#endif
#define DN_CC1(st) (dir == 0 ? (st) : ((st) < 4 ? 3 - (st) : 71 - (st)))
#define DN_CC(step) DN_CC1((step) % 68)
#define AF16(base, row, kchunk) (*(const LAS bf16x8_t*)(Lb + (base) + dn_swz16((row), (kchunk))))
#define AF8(base, row, kchunk) (*(const LAS bf16x8_t*)(Lb + (base) + dn_swz8((row), (kchunk))))
    if (w >= 4) {
        const int lt = tid - 256;
        u32x4 preA[16], preB[16];
#define DN_LOAD(pre, cc_) do { const int cc__ = (cc_); const int item__ = (b * 8 + h) * 68 + cc__, cd__ = item__ * 2 + dir; \
        _Pragma("unroll") for (int k = 0; k < 16; ++k) { const bf16* src; \
            if (k < 4)       { const int q = lt + 256 * k;        src = DK + (size_t)item__ * 8192 + q * 8; } \
            else if (k < 8)  { const int q = lt + 256 * (k - 4);  src = DQ + (size_t)item__ * 8192 + q * 8; } \
            else if (k < 12) { const int q = lt + 256 * (k - 8);  src = KT + (size_t)item__ * 8192 + q * 8; } \
            else if (k < 14) { const int q = lt + 256 * (k - 12); src = TINV + (size_t)cd__ * 4096 + q * 8; } \
            else if (k == 14) { src = DV + (size_t)item__ * 8192 + (lt >> 2) * 128 + qd * 32 + (lt & 3) * 8; } \
            else { src = (const bf16*)(VEC + (size_t)cd__ * 320 + (lt < 80 ? lt : 0) * 4); } \
            pre[k] = *(const u32x4*)src; } } while (0)
#define DN_STORE(pre, bufo_) do { const int bo__ = (bufo_); _Pragma("unroll") for (int k = 0; k < 16; ++k) { int dst; \
            if (k < 4)       { const int q = lt + 256 * k;        dst = KS + dn_swz16(q >> 4, q & 15); } \
            else if (k < 8)  { const int q = lt + 256 * (k - 4);  dst = QS + dn_swz16(q >> 4, q & 15); } \
            else if (k < 12) { const int q = lt + 256 * (k - 8);  dst = KTS + dn_swz8(q >> 3, q & 7); } \
            else if (k < 14) { const int q = lt + 256 * (k - 12); dst = TIS + dn_swz8(q >> 3, q & 7); } \
            else if (k == 14) { dst = VS + lt * 16; } \
            else { dst = VCS + (lt < 80 ? lt : 0) * 16; } \
            *(LAS u32x4*)(L + bo__ + dst) = pre[k]; } } while (0)
#ifdef DN_SKIP_LOAD
#define DN_CLAMP(ds) ((ds) < DN_NSTEP - 70 ? 0 : (ds) < DN_NSTEP ? (ds) : DN_NSTEP - 1)
#else
#define DN_CLAMP(ds) ((ds) < DN_NSTEP ? (ds) : DN_NSTEP - 1)
#endif
#ifndef DN_SLEEP
#define DN_SLEEP 8
#endif
#define DN_LDELAY() __builtin_amdgcn_s_sleep(DN_SLEEP)
        DN_LOAD(preA, DN_CC(0)); DN_STORE(preA, 0); DN_LOAD(preA, DN_CC(1)); DN_LOAD(preB, DN_CC(2));
        DN_BAR();
        for (int step = 0; step < DN_NSTEP; step += 2) {
            DN_LDELAY(); DN_STORE(preA, BUF); DN_LOAD(preA, DN_CC(DN_CLAMP(step + 3)));
            DN_BAR();
            DN_LDELAY(); DN_STORE(preB, 0); DN_LOAD(preB, DN_CC(DN_CLAMP(step + 4)));
            DN_BAR();
        }
#undef DN_CLAMP
#undef DN_LOAD
#undef DN_STORE
    } else if (w >= 2) {
        const int pw = w - 2;
        bf16x8_t qkA[2][4], qkB[2][4];
        f32x4 O[4];
#define DN_QKLOAD(dst, st_) do { const int cd__ = ((b * 8 + h) * 68 + DN_CC(st_)) * 2 + dir; \
        _Pragma("unroll") for (int s = 0; s < 2; ++s) _Pragma("unroll") for (int mt = 0; mt < 4; ++mt) \
            dst[s][mt] = *(const bf16x8_t*)(QKO + (size_t)cd__ * 4096 + dn_perm(fr, mt) * 64 + (4 * s + fq) * 8); } while (0)
#define DN_OFIN(qk, st_) do { const int st__ = (st_); const LAS unsigned char* pv = L + PUBV + (st__ & 1) * 4096 + pw * 2048 + lane * 16; \
        const bf16x8_t vb0 = *(const LAS bf16x8_t*)pv, vb1 = *(const LAS bf16x8_t*)(pv + 1024); \
        _Pragma("unroll") for (int mt = 0; mt < 4; ++mt) { O[mt] = MFMA16(vb0, qk[0][mt], O[mt]); O[mt] = MFMA16(vb1, qk[1][mt], O[mt]); } \
        const int cc__ = DN_CC(st__); \
        if (cc__ >= 4) { bf16* orow = ODN + ((size_t)dir * NT + dn_row0(b, cc__)) * 1024 + h * 128 + qd * 32 + 16 * pw + 4 * fq; \
            _Pragma("unroll") for (int mt = 0; mt < 4; ++mt) { u32x2 w2; w2.x = pk2(O[mt][0], O[mt][1]); w2.y = pk2(O[mt][2], O[mt][3]); \
                *(u32x2*)(orow + (size_t)dn_perm(fr, mt) * 1024) = w2; } } } while (0)
#define DN_OBEG(st_) do { const int st__ = (st_); const LAS unsigned char* Lb = L + (st__ & 1) * BUF; const LAS unsigned char* ps = L + PUBS + (st__ & 1) * 8192 + pw * 4096 + lane * 16; \
        bf16x8_t sb[4], qa[4][4]; \
        _Pragma("unroll") for (int s = 0; s < 4; ++s) sb[s] = *(const LAS bf16x8_t*)(ps + s * 1024); \
        _Pragma("unroll") for (int s = 0; s < 4; ++s) _Pragma("unroll") for (int mt = 0; mt < 4; ++mt) qa[s][mt] = AF16(QS, dn_perm(fr, mt), 4 * s + fq); \
        _Pragma("unroll") for (int mt = 0; mt < 4; ++mt) O[mt] = (f32x4){0.f, 0.f, 0.f, 0.f}; \
        _Pragma("unroll") for (int s = 0; s < 4; ++s) _Pragma("unroll") for (int mt = 0; mt < 4; ++mt) O[mt] = MFMA16(sb[s], qa[s][mt], O[mt]); \
        const LAS float* vc = (const LAS float*)(Lb + VCS); \
        _Pragma("unroll") for (int mt = 0; mt < 4; ++mt) { const float eg = vc[64 + dn_perm(fr, mt)]; O[mt] = O[mt] * eg; } } while (0)
        DN_QKLOAD(qkA, 0); DN_QKLOAD(qkB, 1);
        DN_BAR();
        DN_OBEG(0);
        DN_BAR();
        for (int step = 0; step < DN_NSTEP - 2; step += 2) {
#ifdef DN_SKIP_OUT
            if (step < DN_NSTEP - 70) { DN_BAR(); DN_BAR(); continue; }
#endif
            DN_OFIN(qkA, step); DN_QKLOAD(qkA, step + 2);
            DN_OBEG(step + 1);
            DN_BAR();
            DN_OFIN(qkB, step + 1); DN_QKLOAD(qkB, step + 3);
            DN_OBEG(step + 2);
            DN_BAR();
        }
        DN_OFIN(qkA, DN_NSTEP - 2);
        DN_OBEG(DN_NSTEP - 1);
        DN_BAR();
        DN_OFIN(qkB, DN_NSTEP - 1);
#undef DN_QKLOAD
#undef DN_OFIN
#undef DN_OBEG
    } else {
        f32x4 S[8];
#pragma unroll
        for (int j = 0; j < 8; ++j) S[j] = (f32x4){0.f, 0.f, 0.f, 0.f};
        bf16x8_t sb[4];
#pragma unroll
        for (int s = 0; s < 4; ++s) { sb[s] = dn_bpack(S[2 * s], S[2 * s + 1]); *(LAS bf16x8_t*)(L + PUBS + w * 4096 + s * 1024 + lane * 16) = sb[s]; }
        DN_BAR();
        for (int step = 0; step < DN_NSTEP; ++step) {
#ifdef DN_SKIP_COMP
            if (step < DN_NSTEP - 69) { DN_BAR(); continue; }
#endif
            const LAS unsigned char* Lb = L + (step & 1) * BUF;
            f32x4 P[4];
#pragma unroll
            for (int mt = 0; mt < 4; ++mt) P[mt] = (f32x4){0.f, 0.f, 0.f, 0.f};
            {
                bf16x8_t ka[4][4];
#pragma unroll
                for (int s = 0; s < 4; ++s)
#pragma unroll
                    for (int mt = 0; mt < 4; ++mt) ka[s][mt] = AF16(KS, dn_perm(fr, mt), 4 * s + fq);
                __builtin_amdgcn_sched_barrier(0);
#pragma unroll
                for (int s = 0; s < 4; ++s)
#pragma unroll
                    for (int mt = 0; mt < 4; ++mt) P[mt] = MFMA16(ka[s][mt], sb[s], P[mt]);
            }
            bf16x8_t tia[2][4];
#pragma unroll
            for (int s = 0; s < 2; ++s)
#pragma unroll
                for (int mt = 0; mt < 4; ++mt) tia[s][mt] = AF8(TIS, dn_perm(fr, mt), 4 * s + fq);
            const LAS float* vc = (const LAS float*)(Lb + VCS);
            f32x4 R[4];
#pragma unroll
            for (int mt = 0; mt < 4; ++mt) {
                const int tk0 = 32 * (mt >> 1) + 8 * fq + 4 * (mt & 1);
                const f32x4 bt = *(const LAS f32x4*)(vc + tk0), bg = *(const LAS f32x4*)(vc + 128 + tk0);
#pragma unroll
                for (int r = 0; r < 4; ++r) {
                    const float v = bf2f(*(const LAS unsigned short*)(Lb + VS + (tk0 + r) * 64 + (16 * w + fr) * 2));
                    R[mt][r] = v * bt[r] - bg[r] * P[mt][r];
                }
            }
            const bf16x8_t rb0 = dn_bpack(R[0], R[1]), rb1 = dn_bpack(R[2], R[3]);
            f32x4 VN[4];
#pragma unroll
            for (int mt = 0; mt < 4; ++mt) {
                VN[mt] = (f32x4){0.f, 0.f, 0.f, 0.f};
                VN[mt] = MFMA16(tia[0][mt], rb0, VN[mt]);
                VN[mt] = MFMA16(tia[1][mt], rb1, VN[mt]);
            }
            bf16x8_t kta[2][8];
#pragma unroll
            for (int s = 0; s < 2; ++s)
#pragma unroll
                for (int jt = 0; jt < 8; ++jt) kta[s][jt] = AF8(KTS, dn_perm(fr, jt), 4 * s + fq);
            {
                const bf16x8_t vb0 = dn_bpack(VN[0], VN[1]), vb1 = dn_bpack(VN[2], VN[3]);
                LAS unsigned char* pv = L + PUBV + (step & 1) * 4096 + w * 2048 + lane * 16;
                *(LAS bf16x8_t*)pv = vb0; *(LAS bf16x8_t*)(pv + 1024) = vb1;
            }
#pragma unroll
            for (int mt = 0; mt < 4; ++mt) { const f32x4 ek = *(const LAS f32x4*)(vc + 192 + 32 * (mt >> 1) + 8 * fq + 4 * (mt & 1)); VN[mt] = VN[mt] * ek; }
            const bf16x8_t vs0 = dn_bpack(VN[0], VN[1]), vs1 = dn_bpack(VN[2], VN[3]);
            const float egl = vc[256];
#pragma unroll
            for (int jt = 0; jt < 8; ++jt) {
                S[jt] = S[jt] * egl;
                S[jt] = MFMA16(kta[0][jt], vs0, S[jt]);
                S[jt] = MFMA16(kta[1][jt], vs1, S[jt]);
            }
            if (DN_NSTEP > 68 && step % 68 == 67) {
#pragma unroll
                for (int j = 0; j < 8; ++j) S[j] = (f32x4){0.f, 0.f, 0.f, 0.f};
            }
#pragma unroll
            for (int s = 0; s < 4; ++s) { sb[s] = dn_bpack(S[2 * s], S[2 * s + 1]); *(LAS bf16x8_t*)(L + PUBS + ((step + 1) & 1) * 8192 + w * 4096 + s * 1024 + lane * 16) = sb[s]; }
            DN_BAR();
        }
    }
#undef AF16
#undef AF8
#undef DN_CC
#undef DN_CC1
}

DI void phase_attention(Frame& F, char* lds_generic) {
    bf16* QN = (bf16*)(F.ws + WS_QN); const bf16* KB = (const bf16*)(F.ws + WS_KB); const bf16* VB = (const bf16*)(F.ws + WS_VB);
    for (int it = F.vcu; it < 512; it += F.G) {
        const int b = it >> 7, kvh = (it >> 6) & 1, g = (it >> 4) & 3, qb = it & 15, h = kvh * 4 + g;
        bf16* Qb = QN + ((size_t)(b * TS + qb * 256) * 1024 + h * 128);
        const bf16* Kh = KB + ((size_t)b * LKV * 256 + kvh * 128); const bf16* Vh = VB + ((size_t)b * LKV * 256 + kvh * 128);
#ifdef ATTN_PROBE
#pragma nounroll
        for (int rep_ = 0; rep_ < 2; ++rep_) {
            bf16* Ob = rep_ == 0 ? (bf16*)(F.ws + WS_END) + ((size_t)(b * TS + qb * 256) * 1024 + h * 128) : Qb;
            attn::attn_dense_body<attn::bf16>(Qb, Kh, Vh, Ob, LKV, lds_generic);
            __syncthreads();
        }
#else
        attn::attn_dense_body<attn::bf16>(Qb, Kh, Vh, Qb, LKV, lds_generic);
        __syncthreads();
#endif
    }
}

DI void phase_mergeprep(Frame& F) {
    const bf16* ODN = (const bf16*)(F.ws + WS_ODN); bf16* Z = (bf16*)(F.ws + WS_Z); const int lane = F.lane;
    float nw[16];
#pragma unroll
    for (int k = 0; k < 4; ++k) { const f32x4 v = *(const f32x4*)(F.in[14] + (lane & 7) * 16 + 4 * k); nw[4 * k] = v[0]; nw[4 * k + 1] = v[1]; nw[4 * k + 2] = v[2]; nw[4 * k + 3] = v[3]; }
    for (int t = F.gw; t < NT; t += F.NGW) {
        const size_t off = (size_t)t * 1024 + 16 * lane;
        u32x4 a[2], c[2], z[2];
#pragma unroll
        for (int k = 0; k < 2; ++k) { a[k] = __builtin_nontemporal_load((const u32x4*)(ODN + off + 8 * k)); c[k] = __builtin_nontemporal_load((const u32x4*)(ODN + (size_t)NT * 1024 + off + 8 * k)); z[k] = __builtin_nontemporal_load((const u32x4*)(Z + off + 8 * k)); }
        float o[16]; float ss = 0.f;
#pragma unroll
        for (int k = 0; k < 2; ++k)
#pragma unroll
            for (int i = 0; i < 4; ++i) { o[8 * k + 2 * i] = bflo(a[k][i]) + bflo(c[k][i]); o[8 * k + 2 * i + 1] = bfhi(a[k][i]) + bfhi(c[k][i]); }
#pragma unroll
        for (int i = 0; i < 16; ++i) ss += o[i] * o[i];
        ss += __shfl_xor(ss, 1); ss += __shfl_xor(ss, 2); ss += __shfl_xor(ss, 4);
        const float rstd = rsqrtf(ss * (1.f / 128.f) + EPS);
#pragma unroll
        for (int k = 0; k < 2; ++k) {
            u32x4 w;
#pragma unroll
            for (int i = 0; i < 4; ++i) w[i] = pk2(o[8 * k + 2 * i] * rstd * nw[8 * k + 2 * i] * silu(bflo(z[k][i])), o[8 * k + 2 * i + 1] * rstd * nw[8 * k + 2 * i + 1] * silu(bfhi(z[k][i])));
            *(u32x4*)(Z + off + 8 * k) = w;
        }
    }
}

DI void tk_insert(unsigned (&a)[16], unsigned x) {
#pragma unroll
    for (int i = 0; i < 16; ++i) { const unsigned hi = a[i] > x ? a[i] : x; x = a[i] > x ? x : a[i]; a[i] = hi; }
}
template <int N> DI void tk_sort_desc(unsigned (&a)[N]) {
#pragma unroll
    for (int k = 2; k <= N; k <<= 1)
#pragma unroll
        for (int j = k >> 1; j > 0; j >>= 1)
#pragma unroll
            for (int i = 0; i < N; ++i) {
                const int l = i ^ j;
                if (l > i) {
                    const unsigned lo = a[i] < a[l] ? a[i] : a[l], hi = a[i] < a[l] ? a[l] : a[i];
                    if ((i & k) == 0) { a[i] = hi; a[l] = lo; } else { a[i] = lo; a[l] = hi; }
                }
            }
}
DI void tk_sort_bitonic(unsigned (&c)[16]) {
#pragma unroll
    for (int s = 8; s >= 1; s >>= 1)
#pragma unroll
        for (int i = 0; i < 16; ++i) if ((i & s) == 0) { const unsigned lo = c[i] < c[i + s] ? c[i] : c[i + s], hi = c[i] < c[i + s] ? c[i + s] : c[i]; c[i] = hi; c[i + s] = lo; }
}
template <bool SORT> DI void tk_merge(unsigned (&a)[16], int m) {
    unsigned b[16];
#pragma unroll
    for (int i = 0; i < 16; ++i) b[i] = (unsigned)__shfl_xor((int)a[15 - i], m);
#pragma unroll
    for (int i = 0; i < 16; ++i) a[i] = a[i] > b[i] ? a[i] : b[i];
    if (SORT) tk_sort_bitonic(a);
}
DI float tk_unkey(unsigned k) { const unsigned u = (k & 0x80000000u) ? (k & 0x7fffffffu) : ~k; return __uint_as_float(u); }

DI void phase_peer_topk(Frame& F) {
    LAS unsigned char* L = F.lds;
    constexpr int KS = 0, QS = 69632, SC = 69632, TOP = 137216, FIN = 139264, PT = 140288;
    const bf16* PQ = (const bf16*)(F.ws + WS_PQ); const bf16* SUBK = (const bf16*)(F.ws + WS_SUBK);
    int* EXPI = (int*)(F.ws + WS_EXPI); float* EXPG = (float*)(F.ws + WS_EXPG);
    const int tid = F.tid, lane = F.lane, w = F.wave, fr = lane & 15, fq = lane >> 4;
    LAS float* sc = (LAS float*)(L + SC); LAS unsigned char* top = L + TOP; LAS unsigned char* finb = L + FIN; LAS int* pt = (LAS int*)(L + PT);
    if (tid < 56) {
        int n = tid, pi = -1;
#pragma unroll
        for (int i = 0; i < 16; ++i) { const int cnt = 16 / (i + 1); if (pi < 0) { if (n < cnt) pi = i * 16 + n; else n -= cnt; } }
        pt[tid] = tid < 50 ? pi : -1;
    }
    int hcur = -1;
    u32x4 qpre[4];
    if (F.vcu < (NT / 64) * 8) {
        const int h0 = F.vcu & 7, tq = (F.vcu >> 3) * 64;
#pragma unroll
        for (int k = 0; k < 4; ++k) { const int c = tid + 512 * k; qpre[k] = __builtin_nontemporal_load((const u32x4*)(PQ + (size_t)(tq + (c >> 5)) * 2048 + h0 * 256 + (c & 31) * 8)); }
    }
    for (int it = F.vcu; it < (NT / 64) * 8; it += F.G) {
        const int h = it & 7, tile = it >> 3, t0 = tile * 64;
        RAW_BAR();
        if (h != hcur) {
#pragma unroll
            for (int k = 0; k < 8; ++k) { const int c = tid + 512 * k, row = c >> 4, c16 = c & 15;
                *(LAS u32x4*)(L + KS + row * 272 + c16 * 16) = *(const u32x4*)(SUBK + (size_t)h * 32768 + row * 128 + c16 * 8); }
            hcur = h;
        }
#pragma unroll
        for (int k = 0; k < 4; ++k) { const int c = tid + 512 * k, row = c >> 5, c16 = c & 31; *(LAS u32x4*)(L + QS + row * 528 + c16 * 16) = qpre[k]; }
        if (it + F.G < (NT / 64) * 8) {
            const int itn = it + F.G, hn = itn & 7, tn = (itn >> 3) * 64;
#pragma unroll
            for (int k = 0; k < 4; ++k) { const int c = tid + 512 * k; qpre[k] = __builtin_nontemporal_load((const u32x4*)(PQ + (size_t)(tn + (c >> 5)) * 2048 + hn * 256 + (c & 31) * 8)); }
        }
        RAW_BAR();
        const int p = w >> 2, n0 = (w & 3) * 32;
        f32x4 acc[4][2];
#pragma unroll
        for (int mt = 0; mt < 4; ++mt) { acc[mt][0] = (f32x4){0.f, 0.f, 0.f, 0.f}; acc[mt][1] = (f32x4){0.f, 0.f, 0.f, 0.f}; }
#pragma unroll
        for (int s = 0; s < 4; ++s) {
            const bf16x8_t b0 = *(const LAS bf16x8_t*)(L + KS + (p * 128 + n0 + fr) * 272 + (32 * s + 8 * fq) * 2);
            const bf16x8_t b1 = *(const LAS bf16x8_t*)(L + KS + (p * 128 + n0 + 16 + fr) * 272 + (32 * s + 8 * fq) * 2);
#pragma unroll
            for (int mt = 0; mt < 4; ++mt) {
                const bf16x8_t a = *(const LAS bf16x8_t*)(L + QS + (16 * mt + fr) * 528 + (p * 128 + 32 * s + 8 * fq) * 2);
                acc[mt][0] = MFMA16(a, b0, acc[mt][0]); acc[mt][1] = MFMA16(a, b1, acc[mt][1]);
            }
        }
        RAW_BAR();
#pragma unroll
        for (int mt = 0; mt < 4; ++mt)
#pragma unroll
            for (int nt = 0; nt < 2; ++nt)
#pragma unroll
                for (int r = 0; r < 4; ++r) sc[((16 * mt + 4 * fq + r) * 2 + p) * 132 + (w & 3) * 33 + 16 * nt + fr] = acc[mt][nt][r];
        RAW_BAR();
        {
            const int list = tid >> 2, q = tid & 3;
            unsigned a32[32];
            const LAS float* sp = sc + list * 132 + q * 33;
#pragma unroll
            for (int i = 0; i < 32; ++i) a32[i] = (okey(sp[i]) & ~0x7Fu) | (unsigned)(q * 32 + i);
            tk_sort_desc<32>(a32);
            unsigned a[16];
#pragma unroll
            for (int i = 0; i < 16; ++i) a[i] = a32[i];
            tk_merge<true>(a, 1); tk_merge<true>(a, 2);
            if (q == 0) {
                u32x4 v;
#pragma unroll
                for (int k = 0; k < 4; ++k) v[k] = (a[4 * k] & 127u) | ((a[4 * k + 1] & 127u) << 8) | ((a[4 * k + 2] & 127u) << 16) | ((a[4 * k + 3] & 127u) << 24);
                *(LAS u32x4*)(top + list * 16) = v;
            }
        }
        RAW_BAR();
        {
            const int tok = tid >> 3, r8 = tid & 7;
            unsigned c8[8]; c8[7] = 0u;
#pragma unroll
            for (int m = 0; m < 7; ++m) {
                const int pr = pt[r8 + 8 * m];
                unsigned ck = 0u;
                if (pr >= 0) {
                    const int ia = top[(tok * 2) * 16 + (pr >> 4)], ib = top[(tok * 2 + 1) * 16 + (pr & 15)];
                    const float cs = sc[(tok * 2) * 132 + (ia >> 5) * 33 + (ia & 31)] + sc[(tok * 2 + 1) * 132 + (ib >> 5) * 33 + (ib & 31)];
                    ck = (okey(cs) & ~0xFFu) | (unsigned)pr;
                }
                c8[m] = ck;
            }
            tk_sort_desc<8>(c8);
            unsigned a[16];
#pragma unroll
            for (int i = 0; i < 16; ++i) a[i] = i < 8 ? c8[i] : 0u;
            tk_merge<true>(a, 1); tk_merge<true>(a, 2); tk_merge<true>(a, 4);
            LAS unsigned char* fin = finb + tok * 16;
            if (r8 == 0) {
                u32x4 v;
#pragma unroll
                for (int k = 0; k < 4; ++k) v[k] = (a[4 * k] & 255u) | ((a[4 * k + 1] & 255u) << 8) | ((a[4 * k + 2] & 255u) << 16) | ((a[4 * k + 3] & 255u) << 24);
                *(LAS u32x4*)fin = v;
            }
            asm volatile("s_waitcnt lgkmcnt(0)" ::: "memory");
            float bs[2]; int ex[2];
#pragma unroll
            for (int e = 0; e < 2; ++e) {
                const unsigned pr = fin[2 * r8 + e];
                const int ia = top[(tok * 2) * 16 + (pr >> 4)], ib = top[(tok * 2 + 1) * 16 + (pr & 15u)];
                bs[e] = sc[(tok * 2) * 132 + (ia >> 5) * 33 + (ia & 31)] + sc[(tok * 2 + 1) * 132 + (ib >> 5) * 33 + (ib & 31)];
                ex[e] = ia * 128 + ib;
            }
            float mx = fmaxf(bs[0], bs[1]);
            mx = fmaxf(mx, __shfl_xor(mx, 1)); mx = fmaxf(mx, __shfl_xor(mx, 2)); mx = fmaxf(mx, __shfl_xor(mx, 4));
            const float e0 = __expf(bs[0] - mx), e1 = __expf(bs[1] - mx);
            float sm = e0 + e1; sm += __shfl_xor(sm, 1); sm += __shfl_xor(sm, 2); sm += __shfl_xor(sm, 4);
            const float rs = 1.f / sm;
            const size_t o = (size_t)(t0 + tok) * 128 + h * 16 + 2 * r8;
            *(int2*)(EXPI + o) = make_int2(ex[0], ex[1]);
            *(float2*)(EXPG + o) = make_float2(e0 * rs, e1 * rs);
        }
    }
}

DI float ub0(unsigned w) { float r; asm("v_cvt_f32_ubyte0 %0, %1" : "=v"(r) : "v"(w)); return r; }
DI float ub1(unsigned w) { float r; asm("v_cvt_f32_ubyte1 %0, %1" : "=v"(r) : "v"(w)); return r; }
DI float ub2(unsigned w) { float r; asm("v_cvt_f32_ubyte2 %0, %1" : "=v"(r) : "v"(w)); return r; }
DI float ub3(unsigned w) { float r; asm("v_cvt_f32_ubyte3 %0, %1" : "=v"(r) : "v"(w)); return r; }
DI float wave_maxf(float v) {
#pragma unroll
    for (int o = 1; o < 64; o <<= 1) v = fmaxf(v, __shfl_xor(v, o));
    return v;
}
template <int BIAS> DI void quant_rows(const float* src, unsigned char* dst, float* scale, int gw, int NGW, int lane) {
    for (int row = gw; row < NEXP; row += NGW) {
        f32x4 v[8]; float am = 0.f;
#pragma unroll
        for (int j = 0; j < 8; ++j) { v[j] = __builtin_nontemporal_load((const f32x4*)(src + (size_t)row * DM) + lane + 64 * j); am = fmaxf(am, fmaxf(fmaxf(fabsf(v[j][0]), fabsf(v[j][1])), fmaxf(fabsf(v[j][2]), fabsf(v[j][3])))); }
        am = wave_maxf(am);
        const float inv = am > 0.f ? 127.f / am : 0.f;
#pragma unroll
        for (int j = 0; j < 8; ++j) {
            unsigned w = 0;
#pragma unroll
            for (int i = 0; i < 4; ++i) { const int q = (int)rintf(v[j][i] * inv) + BIAS; w |= ((unsigned)q & 0xffu) << (8 * i); }
            *((unsigned*)(dst + (size_t)row * DM) + lane + 64 * j) = w;
        }
        if (lane == 0) scale[row] = am * (1.f / 127.f);
    }
}


constexpr int V4_ROW = 1152;
DI void quant_rows_i4(const float* __restrict__ src, unsigned char* __restrict__ dst, int gw, int NGW, int lane) {
#pragma unroll 2
    for (int row = gw; row < NEXP; row += NGW) {
        f32x4 vv[8];
#pragma unroll
        for (int j = 0; j < 8; ++j) vv[j] = __builtin_nontemporal_load((const f32x4*)(src + (size_t)row * DM) + lane + 64 * j);
#pragma unroll
        for (int j = 0; j < 8; ++j) {
            const f32x4 v = vv[j];
            float am = fmaxf(fmaxf(fabsf(v[0]), fabsf(v[1])), fmaxf(fabsf(v[2]), fabsf(v[3])));
            am = fmaxf(am, __shfl_xor(am, 1)); am = fmaxf(am, __shfl_xor(am, 2)); am = fmaxf(am, __shfl_xor(am, 4));
            const unsigned sb = f2bf(am * (1.f / 7.f)); const float s = __uint_as_float(sb << 16), inv = s > 0.f ? __builtin_amdgcn_rcpf(s) : 0.f;
            unsigned w = 0;
#pragma unroll
            for (int i = 0; i < 4; ++i) { const int q = (int)fminf(fmaxf(rintf(v[i] * inv), -7.f), 7.f) + 8; w |= (unsigned)q << (4 * i); }
            const int grp = j * 8 + (lane >> 3);
            *(unsigned short*)(dst + (size_t)row * V4_ROW + grp * 16 + (lane & 7) * 2) = (unsigned short)w;
            if ((lane & 7) == 0) *(unsigned short*)(dst + (size_t)row * V4_ROW + 1024 + grp * 2) = (unsigned short)sb;
        }
    }
}

DI void quant_u_both(const float* __restrict__ src, unsigned char* __restrict__ d8, float* __restrict__ scale, unsigned char* __restrict__ d4, int gw, int NGW, int lane) {
#pragma unroll 2
    for (int row = gw; row < NEXP; row += NGW) {
        f32x4 v[8]; float am = 0.f;
#pragma unroll
        for (int j = 0; j < 8; ++j) { v[j] = __builtin_nontemporal_load((const f32x4*)(src + (size_t)row * DM) + lane + 64 * j); am = fmaxf(am, fmaxf(fmaxf(fabsf(v[j][0]), fabsf(v[j][1])), fmaxf(fabsf(v[j][2]), fabsf(v[j][3])))); }
        const float rowmax = wave_maxf(am), inv8 = rowmax > 0.f ? 127.f / rowmax : 0.f;
#pragma unroll
        for (int j = 0; j < 8; ++j) {
            unsigned w8 = 0;
#pragma unroll
            for (int i = 0; i < 4; ++i) { const int q = (int)rintf(v[j][i] * inv8); w8 |= ((unsigned)q & 0xffu) << (8 * i); }
            *((unsigned*)(d8 + (size_t)row * DM) + lane + 64 * j) = w8;
            float gm = fmaxf(fmaxf(fabsf(v[j][0]), fabsf(v[j][1])), fmaxf(fabsf(v[j][2]), fabsf(v[j][3])));
            gm = fmaxf(gm, __shfl_xor(gm, 1)); gm = fmaxf(gm, __shfl_xor(gm, 2)); gm = fmaxf(gm, __shfl_xor(gm, 4));
            const unsigned sb = f2bf(gm * (1.f / 7.f)); const float s = __uint_as_float(sb << 16), inv = s > 0.f ? __builtin_amdgcn_rcpf(s) : 0.f;
            unsigned w = 0;
#pragma unroll
            for (int i = 0; i < 4; ++i) { const int q = (int)fminf(fmaxf(rintf(v[j][i] * inv), -7.f), 7.f) + 8; w |= (unsigned)q << (4 * i); }
            const int grp = j * 8 + (lane >> 3);
            *(unsigned short*)(d4 + (size_t)row * V4_ROW + grp * 16 + (lane & 7) * 2) = (unsigned short)w;
            if ((lane & 7) == 0) *(unsigned short*)(d4 + (size_t)row * V4_ROW + 1024 + grp * 2) = (unsigned short)sb;
        }
        if (lane == 0) scale[row] = rowmax * (1.f / 127.f);
    }
}

DI void phase_peer_gather(Frame& F, int emask = 0x3fff, int vmask = 0x3fff) {
    const bf16* H2 = (const bf16*)(F.ws + WS_H2);
    const unsigned char* U8 = F.ws + WS_U8; const unsigned char* U4 = F.ws + WS_U4; const unsigned char* V4 = F.ws + WS_V8; const float* SU = (const float*)(F.ws + WS_SU);
    const int* EXPI = (const int*)(F.ws + WS_EXPI); const float* EXPG = (const float*)(F.ws + WS_EXPG);
    const bf16* X1 = (const bf16*)(F.ws + WS_X1); const float* MOD = (const float*)(F.ws + WS_MOD); const int lane = F.lane;
    LAS float* la = (LAS float*)(F.lds + F.wave * 1024);
    LAS int* li = (LAS int*)(F.lds + F.wave * 1024 + 512);
    const int eloc = ((lane >> 5) & 1) * 4 + ((lane >> 4) & 1) * 2 + ((lane >> 3) & 1);
#ifdef GATHER_SUBSET
    if ((blockIdx.x >> 3) % GATHER_SUBSET != 0) return;
    const int gw_ = ((blockIdx.x >> 3) / GATHER_SUBSET * 8 + (blockIdx.x & 7)) * NWAVES + F.wave, ngw_ = F.NGW / GATHER_SUBSET;
#else
    const int gw_ = F.gw, ngw_ = F.NGW;
#endif
    for (int t = gw_; t < NT; t += ngw_) {
        float xf[2][16]; float am = 0.f;
#pragma unroll
        for (int j = 0; j < 2; ++j) {
            const u32x4 w0 = *((const u32x4*)(H2 + (size_t)t * DM) + 2 * (lane + 64 * j)), w1 = *((const u32x4*)(H2 + (size_t)t * DM) + 2 * (lane + 64 * j) + 1);
            xf[j][0] = bflo(w0.x); xf[j][1] = bfhi(w0.x); xf[j][2] = bflo(w0.y); xf[j][3] = bfhi(w0.y); xf[j][4] = bflo(w0.z); xf[j][5] = bfhi(w0.z); xf[j][6] = bflo(w0.w); xf[j][7] = bfhi(w0.w);
            xf[j][8] = bflo(w1.x); xf[j][9] = bfhi(w1.x); xf[j][10] = bflo(w1.y); xf[j][11] = bfhi(w1.y); xf[j][12] = bflo(w1.z); xf[j][13] = bfhi(w1.z); xf[j][14] = bflo(w1.w); xf[j][15] = bfhi(w1.w);
#pragma unroll
            for (int i = 0; i < 16; ++i) am = fmaxf(am, fabsf(xf[j][i]));
        }
        am = wave_maxf(am);
        const float inv = am > 0.f ? 127.f / am : 0.f, sx = am * (1.f / 127.f);
        int xq[2][4];
#pragma unroll
        for (int j = 0; j < 2; ++j)
#pragma unroll
            for (int k = 0; k < 4; ++k) {
                unsigned w = 0;
#pragma unroll
                for (int i = 0; i < 4; ++i) w |= ((unsigned)(int)rintf(xf[j][4 * k + i] * inv) & 0xffu) << (8 * i);
                xq[j][k] = (int)w;
            }
        int xe[4], xo[4], xsum4 = 0;
#pragma unroll
        for (int d = 0; d < 4; ++d) {
            const u32x4 w = *((const u32x4*)(H2 + (size_t)t * DM + 32 * lane) + d);
            int q[8];
#pragma unroll
            for (int i = 0; i < 4; ++i) { q[2 * i] = (int)rintf(bflo(w[i]) * inv); q[2 * i + 1] = (int)rintf(bfhi(w[i]) * inv); }
            xe[d] = (int)(((unsigned)q[0] & 0xffu) | (((unsigned)q[2] & 0xffu) << 8) | (((unsigned)q[4] & 0xffu) << 16) | (((unsigned)q[6] & 0xffu) << 24));
            xo[d] = (int)(((unsigned)q[1] & 0xffu) | (((unsigned)q[3] & 0xffu) << 8) | (((unsigned)q[5] & 0xffu) << 16) | (((unsigned)q[7] & 0xffu) << 24));
#pragma unroll
            for (int i = 0; i < 8; ++i) xsum4 += q[i];
        }
        float asum = 0.f;
        const int ei0 = EXPI[(size_t)t * 128 + lane] & emask, ei1 = EXPI[(size_t)t * 128 + 64 + lane] & emask;
        const float eg0 = EXPG[(size_t)t * 128 + lane], eg1 = EXPG[(size_t)t * 128 + 64 + lane];
        u32x4 wa0[8], wa1[8], wb[8]; unsigned short sbh[8];
#define ULOADA(hd_) do { const int eis_ = (hd_) < 4 ? ei0 : ei1, base_ = ((hd_) & 3) * 16; \
            _Pragma("unroll") for (int e = 0; e < 8; ++e) { const int idx_ = __builtin_amdgcn_readlane(eis_, base_ + e); const u32x4* ur_ = (const u32x4*)(U8 + (size_t)idx_ * DM); wa0[e] = ur_[lane]; wa1[e] = ur_[lane + 64]; } } while (0)
#define ULOADB(hd_) do { const int eis_ = (hd_) < 4 ? ei0 : ei1, base_ = ((hd_) & 3) * 16 + 8; \
            _Pragma("unroll") for (int e = 0; e < 8; ++e) { const int idx_ = __builtin_amdgcn_readlane(eis_, base_ + e); const unsigned char* u4_ = U4 + (size_t)idx_ * V4_ROW; wb[e] = *(const u32x4*)(u4_ + 16 * lane); sbh[e] = *(const unsigned short*)(u4_ + 1024 + 2 * lane); } } while (0)
        ULOADA(0);
#pragma unroll 1
        for (int hd = 0; hd < 8; ++hd) {
            const int eisel = hd < 4 ? ei0 : ei1; const float egsel = hd < 4 ? eg0 : eg1;
            const int base = (hd & 3) * 16;
            const int myidxA = __shfl(eisel, base + eloc), myidxB = __shfl(eisel, base + 8 + eloc);
            const float mygA = __shfl(egsel, base + eloc), mygB = __shfl(egsel, base + 8 + eloc);
            const float mysu = SU[myidxA];
            ULOADB(hd);
            float accA[8], accB[8];
#pragma unroll
            for (int e = 0; e < 8; ++e) {
                int a = __builtin_amdgcn_sdot4((int)wa0[e].x, xq[0][0], 0, false); a = __builtin_amdgcn_sdot4((int)wa0[e].y, xq[0][1], a, false);
                a = __builtin_amdgcn_sdot4((int)wa0[e].z, xq[0][2], a, false); a = __builtin_amdgcn_sdot4((int)wa0[e].w, xq[0][3], a, false);
                a = __builtin_amdgcn_sdot4((int)wa1[e].x, xq[1][0], a, false); a = __builtin_amdgcn_sdot4((int)wa1[e].y, xq[1][1], a, false);
                a = __builtin_amdgcn_sdot4((int)wa1[e].z, xq[1][2], a, false); a = __builtin_amdgcn_sdot4((int)wa1[e].w, xq[1][3], a, false);
                accA[e] = (float)a;
            }
            __builtin_amdgcn_sched_barrier(0);
            if (hd + 1 < 8) ULOADA(hd + 1);
#pragma unroll
            for (int e = 0; e < 8; ++e) {
                int b = 0;
#pragma unroll
                for (int d = 0; d < 4; ++d) { b = __builtin_amdgcn_sdot4((int)(wb[e][d] & 0x0F0F0F0Fu), xe[d], b, false); b = __builtin_amdgcn_sdot4((int)((wb[e][d] >> 4) & 0x0F0F0F0Fu), xo[d], b, false); }
                accB[e] = (float)(b - 8 * xsum4) * bf2f(sbh[e]);
            }
            float rA, rB;
            {
                float r4[4], r2[2], s4[4], s2[2];
#pragma unroll
                for (int i = 0; i < 4; ++i) {
                    const float sndA = (lane & 32) ? accA[i] : accA[i + 4], kpA = (lane & 32) ? accA[i + 4] : accA[i]; r4[i] = kpA + __shfl_xor(sndA, 32);
                    const float sndB = (lane & 32) ? accB[i] : accB[i + 4], kpB = (lane & 32) ? accB[i + 4] : accB[i]; s4[i] = kpB + __shfl_xor(sndB, 32); }
#pragma unroll
                for (int i = 0; i < 2; ++i) {
                    const float sndA = (lane & 16) ? r4[i] : r4[i + 2], kpA = (lane & 16) ? r4[i + 2] : r4[i]; r2[i] = kpA + __shfl_xor(sndA, 16);
                    const float sndB = (lane & 16) ? s4[i] : s4[i + 2], kpB = (lane & 16) ? s4[i + 2] : s4[i]; s2[i] = kpB + __shfl_xor(sndB, 16); }
                { const float sndA = (lane & 8) ? r2[0] : r2[1], kpA = (lane & 8) ? r2[1] : r2[0]; rA = kpA + __shfl_xor(sndA, 8);
                  const float sndB = (lane & 8) ? s2[0] : s2[1], kpB = (lane & 8) ? s2[1] : s2[0]; rB = kpB + __shfl_xor(sndB, 8); }
                rA += __shfl_xor(rA, 4); rA += __shfl_xor(rA, 2); rA += __shfl_xor(rA, 1);
                rB += __shfl_xor(rB, 4); rB += __shfl_xor(rB, 2); rB += __shfl_xor(rB, 1);
            }
            const float aA = gelu_erf(rA * mysu * sx) * mygA, aB = gelu_erf(rB * sx) * mygB;
            if ((lane & 7) == 0) { la[hd * 16 + eloc] = aA; li[hd * 16 + eloc] = myidxA & vmask; la[hd * 16 + 8 + eloc] = aB; li[hd * 16 + 8 + eloc] = myidxB & vmask; asum += aA + aB; }
        }
#undef ULOADA
#undef ULOADB
        asum = wave_sum(asum);
        asm volatile("s_waitcnt lgkmcnt(0)" ::: "memory");
        f32x2 o2[16]; float csum = 0.f;
#pragma unroll
        for (int i = 0; i < 16; ++i) o2[i] = (f32x2){0.f, 0.f};
#pragma unroll 16
        for (int e = 0; e < 128; ++e) {
            const int idx = __builtin_amdgcn_readfirstlane(li[e]); const float a = __uint_as_float((unsigned)__builtin_amdgcn_readfirstlane((int)__float_as_uint(la[e])));
            const unsigned char* vr = V4 + (size_t)idx * V4_ROW;
            const u32x4 w = *(const u32x4*)(vr + 16 * lane);
            const float as = a * bf2f(*(const unsigned short*)(vr + 1024 + 2 * lane));
            csum += as;
            const f32x2 as2 = {as, as};
#pragma unroll
            for (int d = 0; d < 4; ++d) {
                const unsigned lo = w[d] & 0x0F0F0F0Fu, hi = (w[d] >> 4) & 0x0F0F0F0Fu;
                o2[4 * d + 0] = __builtin_elementwise_fma(as2, (f32x2){ub0(lo), ub0(hi)}, o2[4 * d + 0]); o2[4 * d + 1] = __builtin_elementwise_fma(as2, (f32x2){ub1(lo), ub1(hi)}, o2[4 * d + 1]);
                o2[4 * d + 2] = __builtin_elementwise_fma(as2, (f32x2){ub2(lo), ub2(hi)}, o2[4 * d + 2]); o2[4 * d + 3] = __builtin_elementwise_fma(as2, (f32x2){ub3(lo), ub3(hi)}, o2[4 * d + 3]);
            }
        }
        float o[32];
#pragma unroll
        for (int i = 0; i < 16; ++i) { o[2 * i] = o2[i][0]; o[2 * i + 1] = o2[i][1]; }
        LAS float* tp = (LAS float*)(F.lds + 8192 + F.wave * 9216);
        const float corr = 8.f * csum;
#pragma unroll
        for (int k = 0; k < 8; ++k) { f32x4 v; v[0] = o[4 * k] - corr; v[1] = o[4 * k + 1] - corr; v[2] = o[4 * k + 2] - corr; v[3] = o[4 * k + 3] - corr; *(LAS f32x4*)(tp + lane * 36 + 4 * k) = v; }
        asm volatile("s_waitcnt lgkmcnt(0)" ::: "memory");
        const float* g2 = MOD + (size_t)(t >> 12) * 12288 + 5 * 2048;
        f32x4 x2[8]; float ss = 0.f;
#pragma unroll
        for (int j = 0; j < 8; ++j) {
            const int ch = lane + 64 * j;
            const f32x4 pv = *(const LAS f32x4*)(tp + (ch >> 3) * 36 + 4 * (ch & 7));
            const u32x2 xw = __builtin_nontemporal_load((const u32x2*)(X1 + (size_t)t * DM) + ch); const f32x4 xa = {bflo(xw.x), bfhi(xw.x), bflo(xw.y), bfhi(xw.y)}, ga = *((const f32x4*)g2 + ch);
            x2[j] = xa + ga * pv;
            ss += (x2[j][0] * x2[j][0] + x2[j][1] * x2[j][1]) + (x2[j][2] * x2[j][2] + x2[j][3] * x2[j][3]);
        }
        const float rstd = rsqrtf(wave_sum(ss) * (1.f / DM) + EPS);
        const float* fw = F.in[22];
#pragma unroll
        for (int j = 0; j < 8; ++j) { const int ch = lane + 64 * j; const f32x4 wa = *((const f32x4*)fw + ch); __builtin_nontemporal_store(x2[j] * rstd * wa, (f32x4*)(F.out + (size_t)t * DM) + ch); }
        asm volatile("s_waitcnt lgkmcnt(0)" ::: "memory");
    }
}

DI void phase_h2(Frame& F) {
    const float* MOD = (const float*)(F.ws + WS_MOD); bf16* H2 = (bf16*)(F.ws + WS_H2); const bf16* X1 = (const bf16*)(F.ws + WS_X1);
    for (int m = F.gw; m < NT; m += F.NGW) {
        const int r = m >> 12;
        modnorm_row_bf(X1 + (size_t)m * DM, H2 + (size_t)m * DM, F.in[7], MOD + (size_t)r * 12288 + 4 * 2048, MOD + (size_t)r * 12288 + 3 * 2048, F.lane);
    }
}


DI void phase_quant(Frame& F) {
#ifndef REP_QUANT
#define REP_QUANT 1
#endif
#pragma nounroll
    for (int rq = 0; rq < REP_QUANT; ++rq) {
    quant_u_both(F.in[20], F.ws + WS_U8, (float*)(F.ws + WS_SU), F.ws + WS_U4, F.gw, F.NGW, F.lane);
    quant_rows_i4(F.in[21], F.ws + WS_V8, F.gw, F.NGW, F.lane);
    }
}

struct Args { const float* in[23]; float* out; unsigned char* ws; int ph_lo, ph_hi; };
static_assert(sizeof(Args) == 23 * 8 + 8 + 8 + 8, "Args has no padding");

__global__ void __launch_bounds__(NWAVES * 64, 2) mk_fwd(Args args) {
    extern __shared__ __attribute__((aligned(16))) unsigned char lds[];
    Frame F;
    F.lds = (LAS unsigned char*)lds; F.ws = args.ws; F.out = args.out;
#pragma unroll
    for (int i = 0; i < 23; ++i) F.in[i] = args.in[i];
    F.tid = threadIdx.x; F.lane = F.tid & 63; F.wave = __builtin_amdgcn_readfirstlane(F.tid >> 6);
    F.G = gridDim.x; { const int bx = blockIdx.x; F.vcu = (F.G % 8 == 0) ? (bx % 8) * (F.G / 8) + bx / 8 : bx; }
    F.gw = F.vcu * NWAVES + F.wave; F.NGW = F.G * NWAVES;
    const int lo = args.ph_lo, hi = args.ph_hi;
#ifndef REP_PHASE
#define REP_PHASE (-1)
#endif
#define IN(k) (lo <= (k) && (k) < hi)
#ifndef REP_MASK
#define REP_MASK 0
#endif
#define RP(k) _Pragma("nounroll") for (int rep_ = 0; rep_ < ((REP_PHASE == (k) || ((REP_MASK >> (k)) & 1)) ? 2 : 1); ++rep_)
    constexpr int CW_BAR = 4096;
    volatile LAS unsigned* bst = (volatile LAS unsigned*)(F.lds + LDS_BYTES - 64);
    if (F.tid < 16) bst[F.tid] = 0u;
    __syncthreads();
    XcdBarrier bar; bar.bar = (unsigned*)(F.ws + WS_CTL) + CW_BAR; bar.x = 0; bar.st = nullptr;
    if (hi - lo > 1) bar = xcd_barrier_post((unsigned*)(F.ws + WS_CTL) + CW_BAR, bst);
#define SEAM(k) do { if (IN(k) && IN((k) + 1)) { if ((k) == 0) cg::this_grid().sync(); else xcd_barrier(bar); } } while (0)

    if (IN(0)) RP(0) { phase_prologue(F); __syncthreads(); }
    SEAM(0);
    if (IN(1)) RP(1) phase_modreduce(F);
    SEAM(1);
    if (IN(2)) RP(2) phase_h1(F);
    SEAM(2);
    if (IN(3)) RP(3) {
        pg8::Gemm g{(const bf16*)(F.ws + WS_H), (const bf16*)(F.ws + WS_WIN), MTOT, NPROJ, DM / 2}; InProjOrder S; S.init(F.G, (int)blockIdx.x);
        EpiInProj E{F.ws, F.in[12], F.in[13]};
        pg8::gemm_phase<EpiInProj, InProjOrder, true, true, true>(F.lds, g, S, E);
    }
    SEAM(3);
    if (IN(4)) phase_postproj(F);
    SEAM(4);
#ifdef DN_NAIVE
    if (IN(5)) phase_dn_naive(F);
    SEAM(5);
    if (IN(6)) phase_attention(F, (char*)lds);
#else
    if (IN(5)) RP(5) phase_dn_prep(F);
    SEAM(5);
    if (IN(6)) { RP(14) { phase_dn_scan(F); __syncthreads(); } phase_attention(F, (char*)lds); }
#endif
    SEAM(6);
    if (IN(7)) phase_mergeprep(F);
    SEAM(7);
    if (IN(8)) RP(8) {
        pg8::StaticOrder S; S.init(NT, DM, F.G, (int)blockIdx.x);
        { pg8::Gemm g{(const bf16*)(F.ws + WS_QN), (const bf16*)(F.ws + WS_WBA), NT, DM, 1024};
          EpiMerge<false> E{(bf16*)(F.ws + WS_Y), (const unsigned char*)(F.ws + WS_G), 0};
          pg8::gemm_phase<EpiMerge<false>, pg8::StaticOrder, true, true>(F.lds, g, S, E); }
        __syncthreads();
        { pg8::Gemm g{(const bf16*)(F.ws + WS_Z), (const bf16*)(F.ws + WS_WBD), NT, DM, 1024};
          EpiMerge<true> E{(bf16*)(F.ws + WS_Y), (const unsigned char*)(F.ws + WS_G), 2048};
          pg8::gemm_phase<EpiMerge<true>, pg8::StaticOrder, true, true>(F.lds, g, S, E); }
    }
    SEAM(8);
    if (IN(9)) RP(9) {
        pg8::Gemm g{(const bf16*)(F.ws + WS_Y), (const bf16*)(F.ws + WS_WOUT), NT, DM, DM}; pg8::StaticOrder S; S.init(NT, DM, F.G, (int)blockIdx.x);
        EpiResid E{F.in[0], (bf16*)(F.ws + WS_X1), (const float*)(F.ws + WS_MOD)};
        pg8::gemm_phase<EpiResid, pg8::StaticOrder, true, true>(F.lds, g, S, E);
    }
    SEAM(9);
    if (IN(10)) RP(10) phase_h2(F);
    SEAM(10);
    if (IN(11)) RP(11) {
        pg8::Gemm g{(const bf16*)(F.ws + WS_H2), (const bf16*)(F.ws + WS_WQ), NT, DM, DM}; pg8::StaticOrder S; S.init(NT, DM, F.G, (int)blockIdx.x);
        EpiPlain E{(bf16*)(F.ws + WS_PQ), 2048};
        pg8::gemm_phase<EpiPlain, pg8::StaticOrder, true, true>(F.lds, g, S, E);
    }
    SEAM(11);
    if (IN(12)) { RP(12) { phase_peer_topk(F); __syncthreads(); } phase_quant(F); }
    SEAM(12);
#ifdef GATHER_PROBE_MASK
    if (IN(13)) {
#pragma nounroll
        for (int rep_ = 0; rep_ < 2; ++rep_) { phase_peer_gather(F, rep_ == 0 ? GATHER_PROBE_MASK : 0x3fff, rep_ == 0 ? GATHER_PROBE_VMASK : 0x3fff); __syncthreads(); }
    }
#else
    if (IN(13)) RP(13) phase_peer_gather(F);
#endif
#undef IN
#undef SEAM
}

extern "C" void kernel_launch(void* const* d_in, const int* in_sizes, int n_in, void* d_out, int out_size, void* d_ws, size_t ws_size, hipStream_t stream) {
    static int grid = 0;
    if (grid == 0) {
        if (n_in != 23 || in_sizes[0] != NT * DM || out_size != NT * DM || ws_size < WS_END) {
            fprintf(stderr, "kernel_launch: unexpected shapes (n_in %d, in0 %d, out %d, ws %zu < %zu); nothing launched\n", n_in, n_in > 0 ? in_sizes[0] : -1, out_size, ws_size, (size_t)WS_END);
            grid = -1; return; }
        int dev = 0, cus = 0, per_cu = 0;
        if (hipGetDevice(&dev) != hipSuccess || hipDeviceGetAttribute(&cus, hipDeviceAttributeMultiprocessorCount, dev) != hipSuccess) { grid = -1; return; }
        if (hipFuncSetAttribute((const void*)mk_fwd, hipFuncAttributeMaxDynamicSharedMemorySize, LDS_BYTES) != hipSuccess) { fprintf(stderr, "kernel_launch: hipFuncSetAttribute failed\n"); grid = -1; return; }
        if (hipOccupancyMaxActiveBlocksPerMultiprocessor(&per_cu, (const void*)mk_fwd, NWAVES * 64, LDS_BYTES) != hipSuccess || per_cu < 1) { fprintf(stderr, "kernel_launch: occupancy query says %d blocks per CU\n", per_cu); (void)hipGetLastError(); grid = -1; return; }
        grid = cus;
    }
    if (grid < 0) return;
    (void)hipMemsetAsync((char*)d_ws + WS_CTL, 0, 1 * MiB, stream);
    Args a{};
    for (int i = 0; i < 23; ++i) a.in[i] = (const float*)d_in[i];
    a.out = (float*)d_out; a.ws = (unsigned char*)d_ws;
#if MK_N_LAUNCHES == 1
    a.ph_lo = 0; a.ph_hi = NPHASE;
    void* kargs[] = {(void*)&a};
    const hipError_t e = hipLaunchCooperativeKernel((const void*)mk_fwd, dim3(grid), dim3(NWAVES * 64), kargs, LDS_BYTES, stream);
    if (e != hipSuccess) fprintf(stderr, "kernel_launch: cooperative launch failed: %s (grid %d)\n", hipGetErrorString(e), grid);
#else
    for (int p = 0; p < NPHASE; ++p) {
        a.ph_lo = p; a.ph_hi = p + 1;
        hipLaunchKernelGGL(mk_fwd, dim3(grid), dim3(NWAVES * 64), LDS_BYTES, stream, a);
    }
    const hipError_t le = hipPeekAtLastError();
    if (le != hipSuccess) fprintf(stderr, "kernel_launch: launch failed: %s\n", hipGetErrorName(le));
#endif
}
```

```cpp
#define DN_SLEEP 0

#include <hip/hip_runtime.h>
#include <hip/hip_cooperative_groups.h>
#include <cstdio>
#include <cstdint>
namespace cg = cooperative_groups;

#ifndef MK_N_LAUNCHES
#define MK_N_LAUNCHES 1
#endif
namespace pg8 {
#define PG8_LAS __attribute__((address_space(3)))
typedef unsigned short bf16_t;
typedef short bf16x8 __attribute__((ext_vector_type(8)));
typedef float f32x4 __attribute__((ext_vector_type(4)));
typedef int pg8_v4i __attribute__((ext_vector_type(4)));
typedef int pg8_v8i __attribute__((ext_vector_type(8)));
typedef unsigned u32x4 __attribute__((ext_vector_type(4)));
constexpr int BM = 256, BK = 64, HALF = 128, HTB = HALF * BK * 2  , STAGE_BYTES = 8 * HTB, NXCD = 8, WGM = 8;

__host__ __device__ __forceinline__ int lds_byte(int r, int c) { const int st = (r >> 4) * 2 + (c >> 5), rr = r & 15, cc = c & 31, ob = rr * 64 + cc * 2; return st * 1024 + (ob ^ (((ob >> 9) & 1) << 5)); }
__host__ __device__ __forceinline__ void stage_rc(int b, int& R, int& C) { const int st = b / 1024, sb = b % 1024, swz = sb ^ (((sb >> 9) & 1) << 5); R = (st >> 1) * 16 + swz / 64; C = (st & 1) * 32 + (swz % 64) / 2; }
__host__ __device__ __forceinline__ int perm32(int rho) { const int n = rho >> 4, i = rho & 15; return 8 * (i >> 2) + 4 * n + (i & 3); }

struct Unit { int pm, pn, sel; };
struct Gemm { const bf16_t* A; const bf16_t* Bt; int M, N, K; const bf16_t* A2 = nullptr; const bf16_t* Bt2 = nullptr; };

struct StaticOrder {
    int nM, nN, nwg, G, c;
    __host__ __device__ void init(int M, int N, int G_, int c_) { nM = M / BM; nN = N / BM; nwg = nM * nN; G = G_; c = c_; }
    __host__ __device__ bool next(int i, Unit& u) const {
        const long L = (long)i * G + c; if (L >= nwg) return false;
        int wgid = (int)L; { const int q = nwg / NXCD, r = nwg % NXCD, xcd = wgid % NXCD, off = wgid / NXCD; wgid = (xcd < r ? xcd * (q + 1) : r * (q + 1) + (xcd - r) * q) + off; }
        const int nig = WGM * nN, gid = wgid / nig, fm = gid * WGM, gsz = (nM - fm) < WGM ? (nM - fm) : WGM;
        u.pm = fm + ((wgid % nig) % gsz); u.pn = (wgid % nig) / gsz; return true;
    }
    __device__ __forceinline__ void a_ready(const Unit&) const {}
    __device__ __forceinline__ void done(const Unit&) const {}
};
struct TwoStageOrder {
    StaticOrder base;
    __host__ __device__ void init(int M, int N, int G_, int c_) { base.init(M, N, G_, c_); }
    __host__ __device__ bool next(int i, Unit& u) const { if (!base.next(i >> 1, u)) return false; u.sel = i & 1; return true; }
    __device__ __forceinline__ void a_ready(const Unit&) const {}
    __device__ __forceinline__ void done(const Unit&) const {}
};

__device__ __forceinline__ unsigned cvt_pk_bf16(float lo, float hi) { unsigned r; asm volatile("v_cvt_pk_bf16_f32 %0, %1, %2" : "=v"(r) : "v"(lo), "v"(hi)); return r; }
typedef float f32x2 __attribute__((ext_vector_type(2)));
template <class Epi, class Sched, bool ALIGN_EPI = false, bool SP2 = false, bool F8 = false>
__device__ __forceinline__ void gemm_phase(PG8_LAS unsigned char* lds, const Gemm g, const Sched& S, const Epi& E) {
    const int tid = threadIdx.x, wid = __builtin_amdgcn_readfirstlane(tid >> 6), lane = tid & 63, wr = wid >> 2, wc = wid & 3, fr = lane & 15, fq = lane >> 4;
    const int K = g.K, nt = K / BK;
    unsigned voffA[2], voffB[2];
#pragma unroll
    for (int i = 0; i < 2; ++i) { int R, C; stage_rc(tid * 16 + i * 8192, R, C); const int Rb = Epi::PERM ? ((R & ~31) + perm32(R & 31)) : R;
        voffA[i] = (unsigned)(R * K + C) * 2u; voffB[i] = (unsigned)(Rb * K + C) * 2u; }
    const size_t kstep = (size_t)(BK * 2);
    const size_t hstep = (size_t)HALF * K * 2;
    const size_t tstep = 2 * hstep;
    const unsigned ldsw = (unsigned)wid * 1024u;
    const int aoff = lds_byte(wr * 64 + fr, fq * 8), boff = lds_byte(wc * 32 + fr, fq * 8);
#define PG8_SA(b, h) (((b) * 2 + (h)) * HTB)
#define PG8_SB(b, h) ((4 + (b) * 2 + (h)) * HTB)
#define PG8_STAGE(bufoff, gbase, voff) do { _Pragma("unroll") for (int _i = 0; _i < 2; ++_i) \
        __builtin_amdgcn_global_load_lds((const unsigned*)((const char*)(gbase) + (voff)[_i]), (PG8_LAS unsigned*)(lds + (bufoff) + ldsw + _i * 8192), 16, 0, 0); } while (0)
#define PG8_LDA(dst, b, h) do { _Pragma("unroll") for (int m = 0; m < 4; ++m) { \
        if constexpr (F8) { const pg8_v4i t0_ = *(const PG8_LAS pg8_v4i*)(lds + PG8_SA(b, h) + aoff + m * 2048), t1_ = *(const PG8_LAS pg8_v4i*)(lds + PG8_SA(b, h) + aoff + m * 2048 + 1024); \
            dst##8[m] = __builtin_shufflevector(t0_, t1_, 0, 1, 2, 3, 4, 5, 6, 7); } \
        else { _Pragma("unroll") for (int k = 0; k < 2; ++k) dst[m][k] = *(const PG8_LAS bf16x8*)(lds + PG8_SA(b, h) + aoff + m * 2048 + k * 1024); } } } while (0)
#define PG8_LDB(dst, b, h) do { _Pragma("unroll") for (int n = 0; n < 2; ++n) { \
        if constexpr (F8) { const pg8_v4i t0_ = *(const PG8_LAS pg8_v4i*)(lds + PG8_SB(b, h) + boff + n * 2048), t1_ = *(const PG8_LAS pg8_v4i*)(lds + PG8_SB(b, h) + boff + n * 2048 + 1024); \
            dst##8[n] = __builtin_shufflevector(t0_, t1_, 0, 1, 2, 3, 4, 5, 6, 7); } \
        else { _Pragma("unroll") for (int k = 0; k < 2; ++k) dst[n][k] = *(const PG8_LAS bf16x8*)(lds + PG8_SB(b, h) + boff + n * 2048 + k * 1024); } } } while (0)
#define PG8_MMA(ai, bj, At, Bt) do { __builtin_amdgcn_s_setprio(1); _Pragma("unroll") for (int m = 0; m < 4; ++m) _Pragma("unroll") for (int n = 0; n < 2; ++n) { \
        if constexpr (F8) { asm volatile("v_mfma_scale_f32_16x16x128_f8f6f4 %0, %1, %2, %0, %3, %3 op_sel_hi:[0,0,0]" : "+v"(acc[ai][bj][m][n]) : "v"(Bt##8[n]), "v"(At##8[m]), "v"(0x7F7F7F7F)); } \
        else { _Pragma("unroll") for (int k = 0; k < 2; ++k) acc[ai][bj][m][n] = __builtin_amdgcn_mfma_f32_16x16x32_bf16(Bt[n][k], At[m][k], acc[ai][bj][m][n], 0, 0, 0); } } \
        __builtin_amdgcn_s_setprio(0); } while (0)
#define PG8_WAIT_V(n) asm volatile("s_waitcnt vmcnt(" #n ")" ::: "memory")
#define PG8_WAIT_L(n) asm volatile("s_waitcnt lgkmcnt(" #n ")" ::: "memory")
#define PG8_BAR __builtin_amdgcn_s_barrier()
#define PG8_SCHED __builtin_amdgcn_sched_barrier(0)
    Unit cur, nxt; int ui = 0;
    if (!S.next(0, cur)) return;
    f32x4 acc[2][2][4][2];
#pragma unroll
    for (int a = 0; a < 2; ++a)
#pragma unroll
        for (int b = 0; b < 2; ++b)
#pragma unroll
            for (int m = 0; m < 4; ++m)
#pragma unroll
                for (int n = 0; n < 2; ++n) acc[a][b][m][n] = (f32x4){0.f, 0.f, 0.f, 0.f};
    bf16x8 At[4][2], B0[2][2], B1[2][2];
    pg8_v8i At8[4], B08[2], B18[2];
    const char* cA = (const char*)g.A + (size_t)cur.pm * tstep; const char* cB = (const char*)g.Bt + (size_t)cur.pn * tstep;
    S.a_ready(cur);
    if constexpr (SP2) {
        PG8_STAGE(PG8_SB(0, 0), cB, voffB); PG8_STAGE(PG8_SB(0, 1), cB + hstep, voffB); PG8_STAGE(PG8_SA(0, 0), cA, voffA); PG8_STAGE(PG8_SA(0, 1), cA + hstep, voffA);
        if (wr == 1) PG8_BAR;
        PG8_WAIT_V(2); PG8_BAR;
        PG8_STAGE(PG8_SB(1, 0), cB + kstep, voffB); PG8_STAGE(PG8_SA(1, 0), cA + kstep, voffA); PG8_STAGE(PG8_SB(1, 1), cB + hstep + kstep, voffB);
        PG8_WAIT_V(6); PG8_BAR;
    } else {
        PG8_STAGE(PG8_SB(0, 0), cB, voffB); PG8_STAGE(PG8_SA(0, 0), cA, voffA); PG8_STAGE(PG8_SB(0, 1), cB + hstep, voffB); PG8_STAGE(PG8_SA(0, 1), cA + hstep, voffA);
        if (wr == 1) PG8_BAR;
        PG8_WAIT_V(4); PG8_BAR;
        PG8_STAGE(PG8_SB(1, 0), cB + kstep, voffB); PG8_STAGE(PG8_SA(1, 0), cA + kstep, voffA); PG8_STAGE(PG8_SB(1, 1), cB + hstep + kstep, voffB);
        PG8_WAIT_V(6); PG8_BAR;
    }
    for (;;) {
        const bool has_next = S.next(ui + 1, nxt);
        const bf16_t* gA = g.A; const bf16_t* gB = g.Bt;
        if constexpr (Epi::TWO_STAGE) { if (has_next && nxt.sel) { gA = g.A2; gB = g.Bt2; } }
        const char* nA = has_next ? (const char*)gA + (size_t)nxt.pm * tstep : cA; const char* nB = has_next ? (const char*)gB + (size_t)nxt.pn * tstep : cB;
        for (int t = 0; t < nt; t += 2) {
            const bool last = (t == nt - 2);
            const char* a1 = cA + (size_t)(t + 1) * kstep;
            const char* a2 = last ? nA : cA + (size_t)(t + 2) * kstep; const char* b2 = last ? nB : cB + (size_t)(t + 2) * kstep;
            const char* a3 = a2 + kstep; const char* b3 = b2 + kstep;
            if (last && has_next) S.a_ready(nxt);
            if constexpr (SP2) {
            PG8_LDB(B0, 0, 0); PG8_LDB(B1, 0, 1); PG8_SCHED; PG8_LDA(At, 0, 0); PG8_STAGE(PG8_SA(1, 1), a1 + hstep, voffA);
            PG8_WAIT_V(8); PG8_WAIT_L(0); PG8_BAR; PG8_MMA(0, 0, At, B0); PG8_MMA(0, 1, At, B1); PG8_BAR; PG8_SCHED;
            PG8_LDA(At, 0, 1); PG8_STAGE(PG8_SB(0, 0), b2, voffB); PG8_STAGE(PG8_SB(0, 1), b2 + hstep, voffB); PG8_STAGE(PG8_SA(0, 0), a2, voffA);
            PG8_WAIT_V(8); PG8_WAIT_L(0); PG8_BAR; PG8_MMA(1, 0, At, B0); PG8_MMA(1, 1, At, B1); PG8_BAR; PG8_SCHED;
            PG8_LDB(B0, 1, 0); PG8_LDB(B1, 1, 1); PG8_SCHED; PG8_LDA(At, 1, 0); PG8_STAGE(PG8_SA(0, 1), a2 + hstep, voffA);
            PG8_WAIT_V(8); PG8_WAIT_L(0); PG8_BAR; PG8_MMA(0, 0, At, B0); PG8_MMA(0, 1, At, B1); PG8_BAR; PG8_SCHED;
            PG8_LDA(At, 1, 1); PG8_STAGE(PG8_SB(1, 0), b3, voffB); PG8_STAGE(PG8_SB(1, 1), b3 + hstep, voffB); PG8_STAGE(PG8_SA(1, 0), a3, voffA);
            PG8_WAIT_V(8); PG8_WAIT_L(0); PG8_BAR; PG8_MMA(1, 0, At, B0); PG8_MMA(1, 1, At, B1); PG8_BAR; PG8_SCHED;
            } else {
            PG8_LDB(B0, 0, 0); PG8_SCHED; PG8_LDA(At, 0, 0); PG8_STAGE(PG8_SA(1, 1), a1 + hstep, voffA);
            PG8_WAIT_L(8); PG8_BAR; PG8_WAIT_L(0); PG8_MMA(0, 0, At, B0); PG8_BAR; PG8_SCHED;
            PG8_LDB(B1, 0, 1); PG8_STAGE(PG8_SB(0, 0), b2, voffB);
            PG8_BAR; PG8_WAIT_L(0); PG8_MMA(0, 1, At, B1); PG8_BAR;
            PG8_LDA(At, 0, 1); PG8_STAGE(PG8_SA(0, 0), a2, voffA);
            PG8_BAR; PG8_WAIT_L(0); PG8_MMA(1, 0, At, B0); PG8_BAR; PG8_SCHED;
            PG8_STAGE(PG8_SB(0, 1), b2 + hstep, voffB);
            PG8_WAIT_V(6); PG8_BAR; PG8_MMA(1, 1, At, B1); PG8_BAR;
            PG8_LDB(B0, 1, 0); PG8_SCHED; PG8_LDA(At, 1, 0); PG8_STAGE(PG8_SA(0, 1), a2 + hstep, voffA);
            PG8_WAIT_L(8); PG8_BAR; PG8_WAIT_L(0); PG8_MMA(0, 0, At, B0); PG8_BAR; PG8_SCHED;
            PG8_LDB(B1, 1, 1); PG8_STAGE(PG8_SB(1, 0), b3, voffB);
            PG8_BAR; PG8_WAIT_L(0); PG8_MMA(0, 1, At, B1); PG8_BAR;
            PG8_LDA(At, 1, 1); PG8_STAGE(PG8_SA(1, 0), a3, voffA);
            PG8_BAR; PG8_WAIT_L(0); PG8_MMA(1, 0, At, B0); PG8_BAR; PG8_SCHED;
            PG8_STAGE(PG8_SB(1, 1), b3 + hstep, voffB);
            PG8_WAIT_V(6); PG8_BAR; PG8_MMA(1, 1, At, B1); PG8_BAR;
            }
        }
        if constexpr (ALIGN_EPI) { if (wr == 0) PG8_BAR; }
        bool keep = false;
        if constexpr (Epi::TWO_STAGE) keep = (cur.sel == 0);
        if constexpr (!Epi::AFTER_DRAIN) {
            if constexpr (Epi::TWO_STAGE) { if (keep) E.mid(acc, cur, wr, wc, fr, fq); else E(acc, cur, wr, wc, fr, fq); }
            else E(acc, cur, wr, wc, fr, fq);
            S.done(cur); }
        if (!has_next) break;
        if (!keep)
#pragma unroll
        for (int a = 0; a < 2; ++a)
#pragma unroll
            for (int b = 0; b < 2; ++b)
#pragma unroll
                for (int m = 0; m < 4; ++m)
#pragma unroll
                    for (int n = 0; n < 2; ++n) acc[a][b][m][n] = (f32x4){0.f, 0.f, 0.f, 0.f};
        cur = nxt; cA = nA; cB = nB; ++ui;
        if constexpr (ALIGN_EPI) { if (wr == 1) PG8_BAR; }
    }
    PG8_WAIT_V(0);
    if constexpr (!ALIGN_EPI) { if (wr == 0) PG8_BAR; }
    PG8_BAR;
    if constexpr (Epi::AFTER_DRAIN) { E.fused(acc, cur, wr, wc, fr, fq, lds, wid, lane); S.done(cur); }
#undef PG8_SA
#undef PG8_SB
#undef PG8_STAGE
#undef PG8_LDA
#undef PG8_LDB
#undef PG8_MMA
#undef PG8_WAIT_V
#undef PG8_WAIT_L
#undef PG8_BAR
#undef PG8_SCHED
}
}
namespace attn {
using bf16 = unsigned short;
constexpr int D = 128, NW = 8, QBLK = 32, KVBLK = 64;
constexpr float SCALE = 0.088388347648318440f;
constexpr float THR = 8.f;
constexpr int SDEPTH = 2;
constexpr int LDQ = 1024, LDK = 256, LDO = 1024;
constexpr size_t SHM_V = KVBLK * D * 2, SHM_K = KVBLK * D * 2, SHM_ATTN = 2 * SHM_V + 2 * SHM_K + NW * 64 * 4;
__device__ __forceinline__ unsigned short f2bf_rne(float f) { unsigned u = __float_as_uint(f); return (unsigned short)((u + 0x7fffu + ((u >> 16) & 1u)) >> 16); }
using bf16x8 = __attribute__((ext_vector_type(8))) short;
using s16x4  = __attribute__((ext_vector_type(4))) short;
using f32x16 = __attribute__((ext_vector_type(16))) float;
using f32x8  = __attribute__((ext_vector_type(8))) float;
using u32x4  = __attribute__((ext_vector_type(4))) unsigned;
#define KSWZ(row, colB) ((row) * 256 + ((colB) ^ (((row) & 7) << 4)))
#define SBAR() __builtin_amdgcn_sched_barrier(0)
__device__ __forceinline__ int crow(int r, int hi) { return (r & 3) + 8 * (r >> 2) + 4 * hi; }
__device__ __forceinline__ unsigned cvtpk(float lo, float hi) {
  unsigned r; asm volatile("v_cvt_pk_bf16_f32 %0, %1, %2" : "=v"(r) : "v"(lo), "v"(hi)); return r;
}
template <typename TIn> struct Stage;
template <> struct Stage<bf16>  { using T = bf16x8;
  __device__ static __forceinline__ T ld8(const bf16* p) { return *reinterpret_cast<const bf16x8*>(p); }
  __device__ static __forceinline__ bf16x8 tobf(T x) { return x; } };
template <> struct Stage<float> { using T = f32x8;
  __device__ static __forceinline__ T ld8(const float* p) { return *reinterpret_cast<const f32x8*>(p); }
  __device__ static __forceinline__ bf16x8 tobf(T x) {
    u32x4 w = {cvtpk(x[0], x[1]), cvtpk(x[2], x[3]), cvtpk(x[4], x[5]), cvtpk(x[6], x[7])}; return *reinterpret_cast<bf16x8*>(&w); } };

__device__ __forceinline__ void partialSM(f32x16& p0, f32x16& p1, float& m_reg, float& mn, float& alpha) {
  constexpr float C = SCALE * 1.4426950408889634f;
  float pmax = p0[0]; for (int r = 1; r < 16; ++r) pmax = fmaxf(pmax, p0[r]); for (int r = 0; r < 16; ++r) pmax = fmaxf(pmax, p1[r]);
  { auto rr = __builtin_amdgcn_permlane32_swap(__float_as_uint(pmax), __float_as_uint(pmax), false, false);
    pmax = fmaxf(__uint_as_float(rr[0]), __uint_as_float(rr[1])); }
  if (__builtin_expect(__all(pmax - m_reg <= THR / SCALE), 1)) { mn = m_reg; alpha = 1.f; }
  else { mn = fmaxf(m_reg, pmax); alpha = __builtin_amdgcn_exp2f((m_reg - mn) * C); m_reg = mn; }
  float mnC = -mn * C;
  for (int r = 0; r < 16; ++r) p0[r] = fmaf(p0[r], C, mnC); for (int r = 0; r < 16; ++r) p1[r] = fmaf(p1[r], C, mnC);
  for (int r = 0; r < 16; ++r) p0[r] = __builtin_amdgcn_exp2f(p0[r]);
}
__device__ __forceinline__ void finishSM(f32x16& p0, f32x16& p1, float alpha, float& l_reg, bf16x8& pa0, bf16x8& pa1, bf16x8& pa2, bf16x8& pa3) {
  for (int r = 0; r < 16; ++r) p1[r] = __builtin_amdgcn_exp2f(p1[r]);
  float ps = 0; for (int r = 0; r < 16; ++r) ps += p0[r]; for (int r = 0; r < 16; ++r) ps += p1[r];
  { auto rr = __builtin_amdgcn_permlane32_swap(__float_as_uint(ps), __float_as_uint(ps), false, false);
    ps = __uint_as_float(rr[0]) + __uint_as_float(rr[1]); }
  l_reg = l_reg * alpha + ps;
#define PK4(P, BASE, OUT) do { unsigned a0 = cvtpk(P[BASE + 0], P[BASE + 1]), a1 = cvtpk(P[BASE + 2], P[BASE + 3]);   \
    unsigned b0 = cvtpk(P[BASE + 4], P[BASE + 5]), b1 = cvtpk(P[BASE + 6], P[BASE + 7]);                              \
    auto r0 = __builtin_amdgcn_permlane32_swap(a0, b0, false, false); auto r1 = __builtin_amdgcn_permlane32_swap(a1, b1, false, false); \
    u32x4 w = {r0[0], r1[0], r0[1], r1[1]}; OUT = *reinterpret_cast<bf16x8*>(&w); } while (0)
  PK4(p0, 0, pa0); PK4(p0, 8, pa1); PK4(p1, 0, pa2); PK4(p1, 8, pa3);
#undef PK4
}
__device__ __forceinline__ void qkt(f32x16& p0, f32x16& p1, const bf16* Ks, const bf16x8* qr, int r32, int hi) {
  p0 = f32x16{}; p1 = f32x16{};
  for (int d0 = 0; d0 < 8; ++d0) { int cb = (d0 * 16 + hi * 8) * 2;
    bf16x8 b0 = *reinterpret_cast<const bf16x8*>((const char*)Ks + KSWZ(r32, cb));
    bf16x8 b1 = *reinterpret_cast<const bf16x8*>((const char*)Ks + KSWZ(32 + r32, cb));
    p0 = __builtin_amdgcn_mfma_f32_32x32x16_bf16(b0, qr[d0], p0, 0, 0, 0);
    p1 = __builtin_amdgcn_mfma_f32_32x32x16_bf16(b1, qr[d0], p1, 0, 0, 0); }
}
__device__ __forceinline__ int v_st(int k, int c) { const int kk = (k & ~0xC) | ((k & 4) << 1) | ((k & 8) >> 1); return ((kk >> 3) * 4 + (c >> 5)) * 512 + ((kk & 7) * 32 + (c & 31)) * 2; }
__device__ __forceinline__ int v_rd_base(int lane) { return ((lane & 3) << 3) | (((lane >> 2) & 3) << 6) | (((lane >> 4) & 1) << 5) | (((lane >> 5) & 1) << 8); }
constexpr int v_rd_off(int d0, int ks, int half) { return d0 * 512 + ks * 4096 + half * 2048; }
template <int OFF> __device__ __forceinline__ s16x4 tr_read(int vb) {
  s16x4 r; asm volatile("ds_read_b64_tr_b16 %0, %1 offset:%2" : "=&v"(r) : "v"(vb), "i"(OFF) : "memory"); return r;
}
template <int D0> __device__ __forceinline__ void pv_one(f32x16& od, int vb, bf16x8 pa0, bf16x8 pa1, bf16x8 pa2, bf16x8 pa3) {
  const s16x4 l0 = tr_read<v_rd_off(D0, 0, 0)>(vb), h0 = tr_read<v_rd_off(D0, 0, 1)>(vb), l1 = tr_read<v_rd_off(D0, 1, 0)>(vb), h1 = tr_read<v_rd_off(D0, 1, 1)>(vb);
  const s16x4 l2 = tr_read<v_rd_off(D0, 2, 0)>(vb), h2 = tr_read<v_rd_off(D0, 2, 1)>(vb), l3 = tr_read<v_rd_off(D0, 3, 0)>(vb), h3 = tr_read<v_rd_off(D0, 3, 1)>(vb);
  asm volatile("s_waitcnt lgkmcnt(0)" ::: "memory"); SBAR();
#define PK(L, H) (bf16x8){L[0], L[1], L[2], L[3], H[0], H[1], H[2], H[3]}
  od = __builtin_amdgcn_mfma_f32_32x32x16_bf16(pa0, PK(l0, h0), od, 0, 0, 0);
  od = __builtin_amdgcn_mfma_f32_32x32x16_bf16(pa1, PK(l1, h1), od, 0, 0, 0);
  od = __builtin_amdgcn_mfma_f32_32x32x16_bf16(pa2, PK(l2, h2), od, 0, 0, 0);
  od = __builtin_amdgcn_mfma_f32_32x32x16_bf16(pa3, PK(l3, h3), od, 0, 0, 0);
#undef PK
}
__device__ __forceinline__ void pv_d0(f32x16* o, int vb, bf16x8 pa0, bf16x8 pa1, bf16x8 pa2, bf16x8 pa3) {
  pv_one<0>(o[0], vb, pa0, pa1, pa2, pa3); pv_one<1>(o[1], vb, pa0, pa1, pa2, pa3); pv_one<2>(o[2], vb, pa0, pa1, pa2, pa3); pv_one<3>(o[3], vb, pa0, pa1, pa2, pa3);
}

template <typename TQ>
__device__ __forceinline__ void attn_dense_body(const TQ* __restrict__ Qb, const bf16* __restrict__ Kh, const bf16* __restrict__ Vh,
                                                bf16* __restrict__ Ob, int seq, char* lds) {
  using St = Stage<bf16>; using SQ = Stage<TQ>;
  const int tid = threadIdx.x, wid = tid >> 6, lane = tid & 63, r32 = lane & 31, hi = lane >> 5;
  bf16* V_lds = (bf16*)lds; bf16* K_lds = (bf16*)(lds + 2 * SHM_V);
  float* ws = (float*)(lds + 2 * SHM_V + 2 * SHM_K) + wid * 64; float* li_l = ws; float* al_l = ws + 32;
  float m_reg = -1e30f, l_reg = 0; f32x16 o[4] = {}; bf16x8 qr[8];
  const TQ* Qw = Qb + (long)(wid * QBLK + r32) * LDQ + hi * 8;
#pragma unroll
  for (int d0 = 0; d0 < 8; ++d0) qr[d0] = SQ::tobf(SQ::ld8(Qw + d0 * 16));
  const int sr = tid >> 4, sc = (tid & 15) * 8, vst0 = v_st(sr, sc), vst1 = v_st(32 + sr, sc);
  const int vb0 = (int)(uintptr_t)V_lds + v_rd_base(lane);
  struct { typename St::T vs0, vs1, ks0, ks1; } sr_[SDEPTH];
#define SLOAD(i, k0) do { sr_[i].vs0 = St::ld8(&Vh[(long)((k0) + sr) * LDK + sc]); sr_[i].vs1 = St::ld8(&Vh[(long)((k0) + 32 + sr) * LDK + sc]); \
    sr_[i].ks0 = St::ld8(&Kh[(long)((k0) + sr) * LDK + sc]); sr_[i].ks1 = St::ld8(&Kh[(long)((k0) + 32 + sr) * LDK + sc]); } while (0)
#define SWRITE(b, i) do { *(bf16x8*)((char*)V_lds + (b) * SHM_V + vst0) = St::tobf(sr_[i].vs0);          \
    *(bf16x8*)((char*)V_lds + (b) * SHM_V + vst1) = St::tobf(sr_[i].vs1); int kc = sc * 2;               \
    *(bf16x8*)((char*)K_lds + (b) * SHM_K + KSWZ(sr, kc)) = St::tobf(sr_[i].ks0);                       \
    *(bf16x8*)((char*)K_lds + (b) * SHM_K + KSWZ(32 + sr, kc)) = St::tobf(sr_[i].ks1); } while (0)
#define SWAIT() do { if constexpr (SDEPTH == 2) asm volatile("s_waitcnt vmcnt(4)" ::: "memory"); else asm volatile("s_waitcnt vmcnt(0)" ::: "memory"); } while (0)
#define RESC(a) do { if (__any((a) < 1.f)) { if (hi == 0) al_l[r32] = (a); asm volatile("s_waitcnt lgkmcnt(0)" ::: "memory"); \
    for (int d = 0; d < 4; ++d) for (int r = 0; r < 16; ++r) o[d][r] *= al_l[crow(r, hi)]; } } while (0)
  f32x16 pA0, pA1, pB0, pB1; float mnA, mnB, alA, alB; bf16x8 pa0, pa1, pa2, pa3; const int NT = seq / KVBLK;
  constexpr int SE = 0, SO = SDEPTH - 1;
  SLOAD(SE, 0); asm volatile("s_waitcnt vmcnt(0)" ::: "memory"); SWRITE(0, SE); __syncthreads();
  qkt(pA0, pA1, K_lds, qr, r32, hi); partialSM(pA0, pA1, m_reg, mnA, alA);
  SLOAD(SO, KVBLK); if constexpr (SDEPTH == 2) { if (2 < NT) SLOAD(SE, 2 * KVBLK); }
  SWAIT(); SWRITE(1, SO); __syncthreads();
  for (int j = 1; j + 1 < NT; j += 2) {
    SBAR(); qkt(pB0, pB1, (bf16*)((char*)K_lds + SHM_K), qr, r32, hi);
    finishSM(pA0, pA1, alA, l_reg, pa0, pa1, pa2, pa3); SBAR();
    SLOAD(SO, (j + SDEPTH) * KVBLK); SBAR();
    pv_d0(o, vb0, pa0, pa1, pa2, pa3); partialSM(pB0, pB1, m_reg, mnB, alB);
    __syncthreads(); SWAIT(); SWRITE(0, SE);
    RESC(alB); __syncthreads();
    SBAR(); qkt(pA0, pA1, K_lds, qr, r32, hi);
    finishSM(pB0, pB1, alB, l_reg, pa0, pa1, pa2, pa3); SBAR();
    if (SDEPTH == 1 || j + 3 < NT) SLOAD(SE, (j + 1 + SDEPTH) * KVBLK); SBAR();
    pv_d0(o, vb0 + (int)SHM_V, pa0, pa1, pa2, pa3); partialSM(pA0, pA1, m_reg, mnA, alA);
    __syncthreads(); SWAIT(); SWRITE(1, SO);
    RESC(alA); __syncthreads();
  }
  SBAR(); qkt(pB0, pB1, (bf16*)((char*)K_lds + SHM_K), qr, r32, hi);
  finishSM(pA0, pA1, alA, l_reg, pa0, pa1, pa2, pa3); SBAR();
  pv_d0(o, vb0, pa0, pa1, pa2, pa3); partialSM(pB0, pB1, m_reg, mnB, alB);
  __syncthreads(); RESC(alB);
  finishSM(pB0, pB1, alB, l_reg, pa0, pa1, pa2, pa3); SBAR();
  pv_d0(o, vb0 + (int)SHM_V, pa0, pa1, pa2, pa3);
  if (hi == 0) li_l[r32] = l_reg; asm volatile("s_waitcnt lgkmcnt(0)" ::: "memory");
  float rli[16];
#pragma unroll
  for (int r = 0; r < 16; ++r) rli[r] = __builtin_amdgcn_rcpf(li_l[crow(r, hi)]);
  bf16* Ow = Ob + (long)(wid * QBLK) * LDO;
#pragma unroll
  for (int r = 0; r < 16; ++r) { int orow = crow(r, hi);
    for (int d0 = 0; d0 < 4; ++d0) Ow[(long)orow * LDO + d0 * 32 + r32] = f2bf_rne(o[d0][r] * rli[r]); }
#undef SLOAD
#undef SWRITE
#undef SWAIT
#undef RESC
}
#undef KSWZ
#undef SBAR
}

constexpr int DM = 2048, NB = 4, TS = 4096, NT = NB * TS, CL = 256, NC = NB * CL, MTOT = NT + NC, LKV = TS + CL;
constexpr int NPROJ = 9984;
constexpr int INW = 9760;
constexpr int NEXP = 16384;
constexpr float EPS = 1e-6f;
constexpr int NWAVES = 8;
constexpr int NPHASE = 14;

constexpr size_t MiB = 1u << 20;
constexpr size_t WS_CTL = 0, WS_MOD = 1 * MiB, WS_MODP = 2 * MiB, WS_SUBK = 10 * MiB, WS_WBA = 11 * MiB, WS_WBD = 15 * MiB, WS_WOUT = 19 * MiB, WS_WQ = 27 * MiB;
constexpr size_t WS_BETA = 35 * MiB, WS_LOGA = 37 * MiB, WS_EXPI = 39 * MiB, WS_EXPG = 47 * MiB;
constexpr size_t WS_A = 56 * MiB;
constexpr size_t WS_WIN = WS_A, WS_H = WS_A + 39 * MiB;
constexpr size_t WS_DQ = WS_A, WS_DK = WS_A + 34 * MiB, WS_DV = WS_A + 68 * MiB;
constexpr size_t WS_Y = WS_A, WS_H2 = WS_A;
constexpr size_t WS_B = 164 * MiB;
constexpr size_t WS_QN = WS_B, WS_Z = WS_B + 32 * MiB, WS_PQ = WS_B;
constexpr size_t WS_KB = 228 * MiB, WS_VB = 237 * MiB;
constexpr size_t WS_C = 246 * MiB;
constexpr size_t WS_DNRAW = WS_C, WS_U8 = WS_C, WS_V8 = WS_C + 32 * MiB, WS_SU = WS_C + 64 * MiB, WS_SV = WS_C + 65 * MiB, WS_U4 = WS_C + 66 * MiB;
constexpr size_t WS_KT = WS_C, WS_TINV = WS_C + 34 * MiB, WS_QKO = WS_C + 68 * MiB, WS_VEC = WS_C + 102 * MiB;
constexpr size_t WS_D = 374 * MiB;
constexpr size_t WS_G = WS_D, WS_X1 = WS_D;
constexpr size_t WS_OATT8 = WS_D + 64 * MiB, WS_ODNN8 = WS_D + 80 * MiB;
#ifndef MERGE_F8_A
#define MERGE_F8_A 0
#endif
#ifndef MERGE_F8_B
#define MERGE_F8_B 0
#endif
constexpr float WB_SCALE = 64.f, OATT_SCALE = 16.f, ODNN_SCALE = 2.f;
constexpr size_t WS_ODN = 502 * MiB;
constexpr size_t WS_END = 566 * MiB;
static_assert((size_t)NPROJ * DM * 2 <= 39 * MiB && (size_t)MTOT * DM * 2 <= 69 * MiB && (size_t)MTOT * 1024 * 2 <= 34 * MiB && (size_t)MTOT * 3072 * 2 <= 128 * MiB, "ws map");
static_assert((size_t)NB * LKV * 256 * 2 <= 9 * MiB && (size_t)NT * 4096 * 2 <= 128 * MiB && (size_t)NEXP * DM * 2 <= 64 * MiB, "ws map");

constexpr int LDS_BYTES = 163840;

#define DI __device__ __forceinline__
#define LAS __attribute__((address_space(3)))
typedef unsigned short bf16;
typedef float f32x4 __attribute__((ext_vector_type(4)));
typedef float f32x2 __attribute__((ext_vector_type(2)));
typedef unsigned u32x4 __attribute__((ext_vector_type(4)));
typedef unsigned u32x2 __attribute__((ext_vector_type(2)));

typedef __bf16 bf16x2_n __attribute__((ext_vector_type(2)));
DI unsigned pk2(float lo, float hi) { const f32x2 v = {lo, hi}; return __builtin_bit_cast(unsigned, __builtin_convertvector(v, bf16x2_n)); }
DI unsigned f2bf(float f) { return pk2(f, f) & 0xffffu; }
DI float bflo(unsigned w) { return __uint_as_float(w << 16); }
DI float bfhi(unsigned w) { return __uint_as_float(w & 0xffff0000u); }
DI float bf2f(bf16 h) { return __uint_as_float((unsigned)h << 16); }
DI float wave_sum(float v) {
#pragma unroll
    for (int o = 1; o < 64; o <<= 1) v += __shfl_xor(v, o);
    return v;
}
DI unsigned wave_max_u32(unsigned v) {
#pragma unroll
    for (int o = 1; o < 64; o <<= 1) { const unsigned t = (unsigned)__shfl_xor((int)v, o); v = t > v ? t : v; }
    return v;
}
DI float sigm(float x) { return __builtin_amdgcn_rcpf(1.f + __expf(-x)); }
DI float silu(float x) { return x * __builtin_amdgcn_rcpf(1.f + __expf(-x)); }
DI float softplus(float x) { return x > 20.f ? x : log1pf(__expf(x)); }
DI float gelu_erf(float v) {
    const float av = fabsf(v), t = __builtin_amdgcn_rcpf(av * 0.2316418882f + 1.0f);
    float q = t * 0.5307027145f + (-0.7265760135f); q = q * t + 0.7107068705f; q = q * t + (-0.142248368f); q = q * t + 0.127414796f; q = q * t;
    const float e = __builtin_amdgcn_exp2f((v * v) * (-0.72134752044f));
    const float mm = v * (q * e);
    return v < 0.f ? mm : v - mm;
}
DI unsigned okey(float f) { const unsigned u = __float_as_uint(f); return (u & 0x80000000u) ? ~u : (u | 0x80000000u); }
DI unsigned rdlane(unsigned v, int l) { return (unsigned)__builtin_amdgcn_readlane((int)v, l); }
DI float rdlanef(float v, int l) { return __uint_as_float((unsigned)__builtin_amdgcn_readlane((int)__float_as_uint(v), l)); }

#define XB_TMO      128
#define XB_XCNT(j)  (256  + 64 * (j))
#define XB_XSUB(j)  (1280 + 64 * (j))
#define XB_XGEN(j)  (2304 + 64 * (j))
#define XB_TOP      3328
#define XB_TOPGEN   3392
#define XCD_BAR_WORDS 3456
#define XB_SPIN_CAP (1u << 18)

__device__ __forceinline__ unsigned xb_ld(unsigned* p)              { return __hip_atomic_load(p, __ATOMIC_RELAXED, __HIP_MEMORY_SCOPE_AGENT); }
__device__ __forceinline__ unsigned xb_add(unsigned* p, unsigned v) { return __hip_atomic_fetch_add(p, v, __ATOMIC_RELAXED, __HIP_MEMORY_SCOPE_AGENT); }
__device__ __forceinline__ unsigned xb_xcc_id() { return (unsigned)__builtin_amdgcn_s_getreg((3 << 11) | 20) & 0xFu; }
#define XB_SPIN(cond, bar) do { unsigned _sp = 0; while (cond) { __builtin_amdgcn_s_sleep(1); \
    if ((++_sp & 255u) == 0u) { if (xb_ld(&(bar)[XB_TMO])) break; if (_sp > XB_SPIN_CAP) { atomicAdd(&(bar)[XB_TMO], 1u); break; } } } } while (0)

struct XcdBarrier {
    unsigned* bar; unsigned x;
    volatile LAS unsigned* st;
};

__device__ __forceinline__ XcdBarrier xcd_barrier_post(unsigned* bar, volatile LAS unsigned* st) {
    XcdBarrier b; b.bar = bar; b.x = xb_xcc_id(); b.st = st;
    if (threadIdx.x == 0) (void)xb_add(&bar[XB_XCNT(b.x)], 1u);
    return b;
}
__device__ __forceinline__ void xcd_barrier_complete(unsigned* bar, unsigned x, unsigned& nloc, unsigned& nx) {
    const unsigned G = gridDim.x * gridDim.y * gridDim.z;
    unsigned sum, cnt, mine, sp = 0u;
    for (;;) {
        sum = 0u; cnt = 0u; mine = 0u;
#pragma unroll
        for (unsigned j = 0; j < 16; ++j) { const unsigned c = xb_ld(&bar[XB_XCNT(j)]); sum += c; cnt += (c > 0u) ? 1u : 0u; mine = (j == x) ? c : mine; }
        if (sum == G) break;
        __builtin_amdgcn_s_sleep(1);
        if ((++sp & 255u) == 0u) { if (xb_ld(&bar[XB_TMO])) break; if (sp > XB_SPIN_CAP) { atomicAdd(&bar[XB_TMO], 1u); break; } }
    }
    nloc = mine > 0u ? mine : 1u; nx = cnt > 0u ? cnt : 1u;
}

__device__ __forceinline__ void xcd_barrier(const XcdBarrier& b) {
    asm volatile("s_waitcnt vmcnt(0)" ::: "memory");
    __syncthreads();
    if (threadIdx.x == 0) {
        unsigned* bar = b.bar;
        __builtin_amdgcn_s_waitcnt(0);
        unsigned nloc = b.st[0], nx = b.st[1];
        if (nloc == 0u) { xcd_barrier_complete(bar, b.x, nloc, nx); b.st[0] = nloc; b.st[1] = nx; }
        const unsigned old = xb_add(&bar[XB_XSUB(b.x)], 1u);
        const unsigned gen = old / nloc;
        if (old + 1u == (gen + 1u) * nloc) {
            __builtin_amdgcn_fence(__ATOMIC_RELEASE, "agent");
            asm volatile("s_waitcnt vmcnt(0)" ::: "memory");
            const unsigned og = xb_add(&bar[XB_TOP], 1u);
            const unsigned tg = og / nx;
            if (og + 1u == (tg + 1u) * nx) xb_add(&bar[XB_TOPGEN], 1u);
            else XB_SPIN(xb_ld(&bar[XB_TOPGEN]) == tg, bar);
            __builtin_amdgcn_fence(__ATOMIC_ACQUIRE, "agent");
            xb_add(&bar[XB_XGEN(b.x)], 1u);
            asm volatile("s_waitcnt vmcnt(0)" ::: "memory");
        } else {
            XB_SPIN(xb_ld(&bar[XB_XGEN(b.x)]) == gen, bar);
            __builtin_amdgcn_fence(__ATOMIC_ACQUIRE, "agent");
            asm volatile("s_waitcnt vmcnt(0)" ::: "memory");
        }
    }
    __syncthreads();
}

#define RAW_BAR() do { asm volatile("s_waitcnt lgkmcnt(0)" ::: "memory"); __builtin_amdgcn_s_barrier(); asm volatile("" ::: "memory"); } while (0)

DI unsigned pk4_fp8(float a, float b, float c, float d) { int w = __builtin_amdgcn_cvt_pk_fp8_f32(a, b, 0, false); w = __builtin_amdgcn_cvt_pk_fp8_f32(c, d, w, true); return (unsigned)w; }
DI float fp8c(float x) { return fminf(fmaxf(x, -448.f), 448.f); }
constexpr float WIN_SCALE = 64.f;

struct Frame {
    LAS unsigned char* lds;
    unsigned char* ws;
    const float* in[23];
    float* out;
    int tid, lane, wave, vcu, G, gw, NGW;
};

DI size_t dn_off(int m, int h) {
    int b, pos; if (m < NT) { b = m >> 12; pos = 256 + (m & 4095); } else { const int mm = m - NT; b = mm >> 8; pos = mm & 255; }
    return ((size_t)(b * 8 + h) * 4352 + pos) * 128;
}

struct EpiInProj {
    static constexpr bool PERM = true, AFTER_DRAIN = false, TWO_STAGE = false;
    unsigned char* ws; const float* a_log; const float* dt_bias;
    DI void operator()(const pg8::f32x4 (&acc)[2][2][4][2], const pg8::Unit& u, int wr, int wc, int fr, int fq) const {
        asm volatile("" : "+v"(fr), "+v"(fq));
        const int pn = u.pn, pm = u.pm; const bool isctx = pm >= 64;
        if (pn == 38) {
            if (wc != 0) return;
            float* dstf = (float*)(ws + (fq < 2 ? WS_BETA : WS_LOGA));
            const int c8 = (fq & 1) * 8;
#pragma unroll
            for (int ai = 0; ai < 2; ++ai)
#pragma unroll
                for (int m = 0; m < 4; ++m) {
                    const int row = pm * 256 + ai * 128 + wr * 64 + m * 16 + fr;
#pragma unroll
                    for (int n = 0; n < 2; ++n) {
                        f32x4 v = acc[ai][0][m][n] * (1.f / WIN_SCALE), o;
#pragma unroll
                        for (int i = 0; i < 4; ++i) {
                            const int c = c8 + 4 * n + i;
                            o[i] = (fq < 2) ? sigm(v[i]) : -__expf(a_log[c]) * softplus(v[i] + dt_bias[c]);
                        }
                        *(f32x4*)(dstf + (size_t)row * 16 + c8 + 4 * n) = o;
                    }
                }
            return;
        }
        bf16* dst; int ld, coloff, rowoff = 0; bool sg = false;
        if (pn < 4) { if (isctx) return; dst = (bf16*)(ws + WS_QN); ld = 1024; coloff = pn * 256; }
        else if (pn < 6) { dst = (bf16*)(ws + (pn == 4 ? WS_KB : WS_VB)); ld = 256; coloff = 0; rowoff = isctx ? (-12288 + (pm - 64) * 4096) : (pm >> 4) * 256; }
        else if (pn < 18) { dst = (bf16*)(ws + WS_DNRAW); ld = 3072; coloff = (pn - 6) * 256; }
        else if (pn < 22) { if (isctx) return; dst = (bf16*)(ws + WS_Z); ld = 1024; coloff = (pn - 18) * 256; }
        else { if (isctx) return; dst = (bf16*)(ws + WS_G); ld = 4096; coloff = (pn - 22) * 256; sg = true; }
        const int row0 = pm * 256 + rowoff + wr * 64 + fr, col0 = coloff + wc * 32 + 8 * fq;
#pragma unroll
        for (int ai = 0; ai < 2; ++ai)
#pragma unroll
            for (int m = 0; m < 4; ++m) {
                bf16* rowp = dst + (size_t)(row0 + ai * 128 + m * 16) * ld + col0;
#pragma unroll
                for (int bj = 0; bj < 2; ++bj) {
                    f32x4 v0 = acc[ai][bj][m][0] * (1.f / WIN_SCALE), v1 = acc[ai][bj][m][1] * (1.f / WIN_SCALE);
                    if (sg) {
                        u32x2 gb; gb.x = 0u; gb.y = 0u;
#pragma unroll
                        for (int i = 0; i < 4; ++i) { gb.x |= (unsigned)(sigm(v0[i]) * 255.f + 0.5f) << (8 * i); gb.y |= (unsigned)(sigm(v1[i]) * 255.f + 0.5f) << (8 * i); }
                        __builtin_nontemporal_store(gb, (u32x2*)((unsigned char*)dst + (size_t)(row0 + ai * 128 + m * 16) * 4096 + col0 + bj * 128));
                        continue;
                    }
                    u32x4 w; w.x = pg8::cvt_pk_bf16(v0[0], v0[1]); w.y = pg8::cvt_pk_bf16(v0[2], v0[3]); w.z = pg8::cvt_pk_bf16(v1[0], v1[1]); w.w = pg8::cvt_pk_bf16(v1[2], v1[3]);
                    __builtin_nontemporal_store(w, (u32x4*)(rowp + bj * 128));
                }
            }
    }
};


struct InProjOrder {
    pg8::StaticOrder lat; int G, c;
    static constexpr int NLAT = 64 * 39, NCTX = 4 * 15;
    DI void init(int G_, int c_) { lat.init(NT, NPROJ, G_, c_); G = G_; c = c_; }
    DI bool next(int i, pg8::Unit& u) const {
        const int L = i * G + c;
        if (L < NLAT) return lat.next(i, u);
        const int x = L - NLAT; if (x >= NCTX) return false;
        const int j = x % 15; u.pm = 64 + x / 15; u.pn = j < 2 ? 4 + j : (j < 14 ? 4 + j : 38); return true;
    }
    DI void a_ready(const pg8::Unit&) const {}
    DI void done(const pg8::Unit&) const {}
};

struct EpiPlain {
    static constexpr bool PERM = true, AFTER_DRAIN = false, TWO_STAGE = false;
    bf16* O; int ldc;
    DI void operator()(const pg8::f32x4 (&acc)[2][2][4][2], const pg8::Unit& u, int wr, int wc, int fr, int fq) const {
        const int row0 = u.pm * 256 + wr * 64 + fr, col0 = u.pn * 256 + wc * 32 + 8 * fq;
#pragma unroll
        for (int ai = 0; ai < 2; ++ai)
#pragma unroll
            for (int m = 0; m < 4; ++m) {
                bf16* rowp = O + (size_t)(row0 + ai * 128 + m * 16) * ldc + col0;
#pragma unroll
                for (int bj = 0; bj < 2; ++bj) {
                    const f32x4 v0 = acc[ai][bj][m][0], v1 = acc[ai][bj][m][1];
                    u32x4 w; w.x = pg8::cvt_pk_bf16(v0[0], v0[1]); w.y = pg8::cvt_pk_bf16(v0[2], v0[3]); w.z = pg8::cvt_pk_bf16(v1[0], v1[1]); w.w = pg8::cvt_pk_bf16(v1[2], v1[3]);
                    *(u32x4*)(rowp + bj * 128) = w;
                }
            }
    }
};

template <bool ADD> struct EpiMerge {
    static constexpr bool PERM = true, AFTER_DRAIN = false, TWO_STAGE = false;
    bf16* Y; const unsigned char* G; int goff; float gs;
    DI void operator()(const pg8::f32x4 (&acc)[2][2][4][2], const pg8::Unit& u, int wr, int wc, int fr, int fq) const {
        const int row0 = u.pm * 256 + wr * 64 + fr, col0 = u.pn * 256 + wc * 32 + 8 * fq;
#pragma unroll
        for (int ai = 0; ai < 2; ++ai)
#pragma unroll
            for (int m = 0; m < 4; ++m) {
                const size_t row = (size_t)(row0 + ai * 128 + m * 16);
#pragma unroll
                for (int bj = 0; bj < 2; ++bj) {
                    const f32x4 v0 = acc[ai][bj][m][0], v1 = acc[ai][bj][m][1];
                    const u32x2 g = __builtin_nontemporal_load((const u32x2*)(G + row * 4096 + goff + col0 + bj * 128));
                    float r[8];
#pragma unroll
                    for (int i = 0; i < 4; ++i) { r[i] = (float)((g.x >> (8 * i)) & 0xffu) * gs * v0[i]; r[4 + i] = (float)((g.y >> (8 * i)) & 0xffu) * gs * v1[i]; }
                    bf16* yp = Y + row * 2048 + col0 + bj * 128;
                    if (ADD) {
                        const u32x4 y = *(const u32x4*)yp;
                        r[0] += bflo(y.x); r[1] += bfhi(y.x); r[2] += bflo(y.y); r[3] += bfhi(y.y); r[4] += bflo(y.z); r[5] += bfhi(y.z); r[6] += bflo(y.w); r[7] += bfhi(y.w);
                    }
                    u32x4 w; w.x = pg8::cvt_pk_bf16(r[0], r[1]); w.y = pg8::cvt_pk_bf16(r[2], r[3]); w.z = pg8::cvt_pk_bf16(r[4], r[5]); w.w = pg8::cvt_pk_bf16(r[6], r[7]);
                    *(u32x4*)yp = w;
                }
            }
    }
};

struct EpiMerge2 {
    static constexpr bool PERM = true, AFTER_DRAIN = false, TWO_STAGE = true;
    bf16* Y; const unsigned char* G;
    DI void mid(pg8::f32x4 (&acc)[2][2][4][2], const pg8::Unit& u, int wr, int wc, int fr, int fq) const {
        const int row0 = u.pm * 256 + wr * 64 + fr, col0 = u.pn * 256 + wc * 32 + 8 * fq;
#pragma unroll
        for (int ai = 0; ai < 2; ++ai)
#pragma unroll
            for (int m = 0; m < 4; ++m) {
                const size_t row = (size_t)(row0 + ai * 128 + m * 16);
#pragma unroll
                for (int bj = 0; bj < 2; ++bj) {
                    const u32x2 ga = __builtin_nontemporal_load((const u32x2*)(G + row * 4096 + col0 + bj * 128));
                    const u32x2 gd = *(const u32x2*)(G + row * 4096 + 2048 + col0 + bj * 128);
#pragma unroll
                    for (int i = 0; i < 4; ++i) {
                        acc[ai][bj][m][0][i] *= (float)((ga.x >> (8 * i)) & 0xffu) * __builtin_amdgcn_rcpf(fmaxf((float)((gd.x >> (8 * i)) & 0xffu), 1.f));
                        acc[ai][bj][m][1][i] *= (float)((ga.y >> (8 * i)) & 0xffu) * __builtin_amdgcn_rcpf(fmaxf((float)((gd.y >> (8 * i)) & 0xffu), 1.f));
                    }
                }
            }
    }
    DI void operator()(const pg8::f32x4 (&acc)[2][2][4][2], const pg8::Unit& u, int wr, int wc, int fr, int fq) const {
        const int row0 = u.pm * 256 + wr * 64 + fr, col0 = u.pn * 256 + wc * 32 + 8 * fq;
#pragma unroll
        for (int ai = 0; ai < 2; ++ai)
#pragma unroll
            for (int m = 0; m < 4; ++m) {
                const size_t row = (size_t)(row0 + ai * 128 + m * 16);
#pragma unroll
                for (int bj = 0; bj < 2; ++bj) {
                    const f32x4 v0 = acc[ai][bj][m][0], v1 = acc[ai][bj][m][1];
                    const u32x2 g = __builtin_nontemporal_load((const u32x2*)(G + row * 4096 + 2048 + col0 + bj * 128));
                    float r[8];
#pragma unroll
                    for (int i = 0; i < 4; ++i) { r[i] = fmaxf((float)((g.x >> (8 * i)) & 0xffu), 1.f) * (1.f / 255.f) * v0[i]; r[4 + i] = fmaxf((float)((g.y >> (8 * i)) & 0xffu), 1.f) * (1.f / 255.f) * v1[i]; }
                    u32x4 w; w.x = pg8::cvt_pk_bf16(r[0], r[1]); w.y = pg8::cvt_pk_bf16(r[2], r[3]); w.z = pg8::cvt_pk_bf16(r[4], r[5]); w.w = pg8::cvt_pk_bf16(r[6], r[7]);
                    *(u32x4*)(Y + row * 2048 + col0 + bj * 128) = w;
                }
            }
    }
};

struct EpiResid {
    static constexpr bool PERM = true, AFTER_DRAIN = false, TWO_STAGE = false;
    const float* x; bf16* X1; const float* mod;
    DI void operator()(const pg8::f32x4 (&acc)[2][2][4][2], const pg8::Unit& u, int wr, int wc, int fr, int fq) const {
        const int row0 = u.pm * 256 + wr * 64 + fr, col0 = u.pn * 256 + wc * 32 + 8 * fq;
        const float* g1 = mod + (size_t)(u.pm >> 4) * 12288 + 2 * 2048;
        f32x4 gv[2][2];
#pragma unroll
        for (int bj = 0; bj < 2; ++bj)
#pragma unroll
            for (int n = 0; n < 2; ++n) gv[bj][n] = *(const f32x4*)(g1 + col0 + bj * 128 + n * 4);
#pragma unroll
        for (int ai = 0; ai < 2; ++ai)
#pragma unroll
            for (int m = 0; m < 4; ++m) {
                const size_t off = (size_t)(row0 + ai * 128 + m * 16) * 2048 + col0;
#pragma unroll
                for (int bj = 0; bj < 2; ++bj) {
                    const f32x4 x0 = __builtin_nontemporal_load((const f32x4*)(x + off + bj * 128)), x1 = __builtin_nontemporal_load((const f32x4*)(x + off + bj * 128 + 4));
                    const f32x4 v0 = x0 + gv[bj][0] * acc[ai][bj][m][0], v1 = x1 + gv[bj][1] * acc[ai][bj][m][1];
                    u32x4 w; w.x = pk2(v0[0], v0[1]); w.y = pk2(v0[2], v0[3]); w.z = pk2(v1[0], v1[1]); w.w = pk2(v1[2], v1[3]);
                    *(u32x4*)(X1 + off + bj * 128) = w;
                }
            }
    }
};

DI void transpose_item(const float* W, int K, int Nsrc, int sn0, bf16* WT, int dn0, int k0, LAS float* scr, int lane) {
    if (sn0 >= 0) {
        float t[32];
#pragma unroll
        for (int i = 0; i < 32; ++i) t[i] = __builtin_nontemporal_load(&W[(size_t)(k0 + 2 * i + (lane >> 5)) * Nsrc + sn0 + (lane & 31)]);
#pragma unroll
        for (int i = 0; i < 32; ++i) scr[(2 * i + (lane >> 5)) * 33 + (lane & 31)] = t[i];
    } else {
#pragma unroll 8
        for (int i = 0; i < 32; ++i) { const int kk = 2 * i + (lane >> 5); scr[kk * 33 + (lane & 31)] = 0.f; }
    }
    asm volatile("s_waitcnt lgkmcnt(0)" ::: "memory");
    const int c = lane & 7;
#pragma unroll
    for (int j = 0; j < 4; ++j) {
        const int n = (lane >> 3) + 8 * j; const LAS float* s = scr + (8 * c) * 33 + n;
        u32x4 o; o.x = pk2(s[0 * 33], s[1 * 33]); o.y = pk2(s[2 * 33], s[3 * 33]); o.z = pk2(s[4 * 33], s[5 * 33]); o.w = pk2(s[6 * 33], s[7 * 33]);
        *(u32x4*)(WT + (size_t)(dn0 + n) * K + k0 + 8 * c) = o;
    }
    asm volatile("s_waitcnt lgkmcnt(0)" ::: "memory");
}

DI void transpose_item_fp8(const float* W, int K, int Nsrc, int sn0, unsigned char* WT, int dn0, int k0, float scale, LAS float* scr, int lane) {
    if (sn0 >= 0) {
        float t[32];
#pragma unroll
        for (int i = 0; i < 32; ++i) t[i] = __builtin_nontemporal_load(&W[(size_t)(k0 + 2 * i + (lane >> 5)) * Nsrc + sn0 + (lane & 31)]);
#pragma unroll
        for (int i = 0; i < 32; ++i) scr[(2 * i + (lane >> 5)) * 33 + (lane & 31)] = t[i] * scale;
    } else {
#pragma unroll 8
        for (int i = 0; i < 32; ++i) { const int kk = 2 * i + (lane >> 5); scr[kk * 33 + (lane & 31)] = 0.f; }
    }
    asm volatile("s_waitcnt lgkmcnt(0)" ::: "memory");
    const int c = lane & 7;
#pragma unroll
    for (int j = 0; j < 4; ++j) {
        const int n = (lane >> 3) + 8 * j; const LAS float* s = scr + (8 * c) * 33 + n;
        u32x2 o; o.x = pk4_fp8(s[0 * 33], s[1 * 33], s[2 * 33], s[3 * 33]); o.y = pk4_fp8(s[4 * 33], s[5 * 33], s[6 * 33], s[7 * 33]);
        *(u32x2*)(WT + (size_t)(dn0 + n) * K + k0 + 8 * c) = o;
    }
    asm volatile("s_waitcnt lgkmcnt(0)" ::: "memory");
}

DI void cvt_bf16_stream(const float* src, bf16* dst, size_t n8, size_t gtid, size_t nthr) {
    for (size_t i = gtid; i < n8; i += nthr) {
        const f32x4 a = *(const f32x4*)(src + i * 8), b = *(const f32x4*)(src + i * 8 + 4);
        u32x4 w; w.x = pk2(a[0], a[1]); w.y = pk2(a[2], a[3]); w.z = pk2(b[0], b[1]); w.w = pk2(b[2], b[3]);
        *(u32x4*)(dst + i * 8) = w;
    }
}

DI void phase_prologue(Frame& F) {
    LAS float* scr = (LAS float*)(F.lds + F.wave * 16384);
    constexpr int I_WIN = 32 * 312, I_WB = 16 * 64, I_WO = 32 * 64;
    constexpr int NITEMS = I_WIN + 2 * I_WB + 2 * I_WO;
    for (int it = F.gw; it < NITEMS; it += F.NGW) {
        int r = it;
        if (r < I_WIN) { const int kb = r / 312, nb = r % 312; const int snb = nb < 176 ? nb : (nb < 304 ? nb + 1 : (nb == 304 ? 176 : -1));
            transpose_item_fp8(F.in[8], DM, INW, snb < 0 ? -1 : snb * 32, F.ws + WS_WIN, nb * 32, kb * 64, WIN_SCALE, scr, F.lane); continue; }
        r -= I_WIN;
        if (r < I_WB) {
            if (MERGE_F8_A) transpose_item_fp8(F.in[15], 1024, DM, (r % 64) * 32, F.ws + WS_WBA, (r % 64) * 32, (r / 64) * 64, WB_SCALE, scr, F.lane);
            else transpose_item(F.in[15], 1024, DM, (r % 64) * 32, (bf16*)(F.ws + WS_WBA), (r % 64) * 32, (r / 64) * 64, scr, F.lane);
            continue; }
        r -= I_WB;
        if (r < I_WB) {
            if (MERGE_F8_B) transpose_item_fp8(F.in[16], 1024, DM, (r % 64) * 32, F.ws + WS_WBD, (r % 64) * 32, (r / 64) * 64, WB_SCALE, scr, F.lane);
            else transpose_item(F.in[16], 1024, DM, (r % 64) * 32, (bf16*)(F.ws + WS_WBD), (r % 64) * 32, (r / 64) * 64, scr, F.lane);
            continue; }
        r -= I_WB;
        if (r < I_WO) { transpose_item(F.in[17], DM, DM, (r % 64) * 32, (bf16*)(F.ws + WS_WOUT), (r % 64) * 32, (r / 64) * 64, scr, F.lane); continue; }
        r -= I_WO;
        transpose_item(F.in[18], DM, DM, (r % 64) * 32, (bf16*)(F.ws + WS_WQ), (r % 64) * 32, (r / 64) * 64, scr, F.lane);
    }
    cvt_bf16_stream(F.in[19], (bf16*)(F.ws + WS_SUBK), (size_t)8 * 2 * 128 * 128 / 8, (size_t)blockIdx.x * 512 + F.tid, (size_t)F.G * 512);
    LAS float* sc = (LAS float*)(F.lds + 131072);
    const float* ada_w = F.in[4];
    float* MODP = (float*)(F.ws + WS_MODP);
    for (int it = blockIdx.x; it < 32 * 24; it += F.G) {
        const int kc = it / 24, nb = it % 24, n = nb * 512 + F.tid;
        __syncthreads();
        if (F.tid < 320) { const int r = F.tid >> 6, kk = F.tid & 63, k = kc * 64 + kk; const float cv = (r < 4) ? F.in[1][r * DM + k] : F.in[3][k]; sc[r * 64 + kk] = silu(cv); }
        __syncthreads();
        float a0 = 0.f, a1 = 0.f, a2 = 0.f, a3 = 0.f, a4 = 0.f;
#pragma unroll 32
        for (int kk = 0; kk < 64; ++kk) {
            const float w = __builtin_nontemporal_load(&ada_w[(size_t)(kc * 64 + kk) * 12288 + n]);
            a0 += sc[kk] * w; a1 += sc[64 + kk] * w; a2 += sc[128 + kk] * w; a3 += sc[192 + kk] * w; a4 += sc[256 + kk] * w;
        }
        float* o = MODP + (size_t)kc * 5 * 12288 + n;
        o[0] = a0; o[12288] = a1; o[2 * 12288] = a2; o[3 * 12288] = a3; o[4 * 12288] = a4;
    }
}

DI void phase_modreduce(Frame& F) {
    const float* MODP = (const float*)(F.ws + WS_MODP); float* MOD = (float*)(F.ws + WS_MOD); const float* ada_b = F.in[5];
    for (int i = blockIdx.x * 512 + F.tid; i < 5 * 12288; i += F.G * 512) {
        const int n = i % 12288; float s = ada_b[n];
#pragma unroll 8
        for (int kc = 0; kc < 32; ++kc) s += MODP[(size_t)kc * 5 * 12288 + i];
        MOD[i] = s;
    }
}

DI void modnorm_row(const float* xrow, bf16* orow, const float* nw, const float* sc, const float* sh, int lane) {
    f32x4 v[8]; float ss = 0.f;
#pragma unroll
    for (int j = 0; j < 8; ++j) { v[j] = *((const f32x4*)xrow + lane + 64 * j); ss += (v[j][0] * v[j][0] + v[j][1] * v[j][1]) + (v[j][2] * v[j][2] + v[j][3] * v[j][3]); }
    const float rstd = rsqrtf(wave_sum(ss) * (1.f / DM) + EPS);
#pragma unroll
    for (int j = 0; j < 8; ++j) {
        const int c = (lane + 64 * j) * 4;
        const f32x4 w = *(const f32x4*)(nw + c), s = *(const f32x4*)(sc + c), h = *(const f32x4*)(sh + c);
        f32x4 o;
#pragma unroll
        for (int i = 0; i < 4; ++i) o[i] = (v[j][i] * rstd * w[i]) * (1.f + s[i]) + h[i];
        u32x2 p; p.x = pk2(o[0], o[1]); p.y = pk2(o[2], o[3]);
        *(u32x2*)(orow + c) = p;
    }
}

DI void modnorm_row_bf(const bf16* xrow, bf16* orow, const float* nw, const float* sc, const float* sh, int lane) {
    f32x4 v[8]; float ss = 0.f;
#pragma unroll
    for (int j = 0; j < 8; ++j) { const u32x2 w = *((const u32x2*)xrow + lane + 64 * j); v[j] = (f32x4){bflo(w.x), bfhi(w.x), bflo(w.y), bfhi(w.y)}; ss += (v[j][0] * v[j][0] + v[j][1] * v[j][1]) + (v[j][2] * v[j][2] + v[j][3] * v[j][3]); }
    const float rstd = rsqrtf(wave_sum(ss) * (1.f / DM) + EPS);
#pragma unroll
    for (int j = 0; j < 8; ++j) {
        const int c = (lane + 64 * j) * 4;
        const f32x4 w = *(const f32x4*)(nw + c), s = *(const f32x4*)(sc + c), h = *(const f32x4*)(sh + c);
        f32x4 o;
#pragma unroll
        for (int i = 0; i < 4; ++i) o[i] = (v[j][i] * rstd * w[i]) * (1.f + s[i]) + h[i];
        u32x2 p; p.x = pk2(o[0], o[1]); p.y = pk2(o[2], o[3]);
        *(u32x2*)(orow + c) = p;
    }
}

DI void modnorm_row_fp8(const float* xrow, unsigned char* orow, const float* nw, const float* sc, const float* sh, int lane) {
    f32x4 v[8]; float ss = 0.f;
#pragma unroll
    for (int j = 0; j < 8; ++j) { v[j] = __builtin_nontemporal_load((const f32x4*)xrow + lane + 64 * j); ss += (v[j][0] * v[j][0] + v[j][1] * v[j][1]) + (v[j][2] * v[j][2] + v[j][3] * v[j][3]); }
    const float rstd = rsqrtf(wave_sum(ss) * (1.f / DM) + EPS);
#pragma unroll
    for (int j = 0; j < 8; ++j) {
        const int c = (lane + 64 * j) * 4;
        const f32x4 w = *(const f32x4*)(nw + c), s = *(const f32x4*)(sc + c), h = *(const f32x4*)(sh + c);
        f32x4 o;
#pragma unroll
        for (int i = 0; i < 4; ++i) o[i] = (v[j][i] * rstd * w[i]) * (1.f + s[i]) + h[i];
        *(unsigned*)(orow + c) = pk4_fp8(o[0], o[1], o[2], o[3]);
    }
}

DI void phase_h1(Frame& F) {
    const float* MOD = (const float*)(F.ws + WS_MOD); unsigned char* H = F.ws + WS_H;
    for (int m = F.gw; m < MTOT; m += F.NGW) {
        const bool isl = m < NT; const int r = isl ? (m >> 12) : 4;
        const float* xrow = isl ? F.in[0] + (size_t)m * DM : F.in[2] + (size_t)(m - NT) * DM;
        modnorm_row_fp8(xrow, H + (size_t)m * DM, F.in[6], MOD + (size_t)r * 12288 + 2048, MOD + (size_t)r * 12288, F.lane);
    }
}

DI void phase_postproj(Frame& F) {
    const int lane = F.lane, tid = F.tid;
    LAS float* tcs = (LAS float*)F.lds;
    for (int i = tid; i < 2048; i += 512) { const int pos = i >> 5, f = i & 31; float sn, cs; sincosf((float)pos * exp2f(-(float)f * (13.287712379549449f / 32.f)), &sn, &cs); tcs[i] = cs; tcs[2048 + i] = sn; }
    __syncthreads();
    {
        bf16* QN = (bf16*)(F.ws + WS_QN); bf16* KB = (bf16*)(F.ws + WS_KB);
        const int j = lane & 7, axis = j >> 2, fg = j & 3, d1 = axis * 64 + 8 * fg;
        f32x4 qw[4], kw[4];
        qw[0] = *(const f32x4*)(F.in[9] + d1); qw[1] = *(const f32x4*)(F.in[9] + d1 + 4); qw[2] = *(const f32x4*)(F.in[9] + d1 + 32); qw[3] = *(const f32x4*)(F.in[9] + d1 + 36);
        kw[0] = *(const f32x4*)(F.in[10] + d1); kw[1] = *(const f32x4*)(F.in[10] + d1 + 4); kw[2] = *(const f32x4*)(F.in[10] + d1 + 32); kw[3] = *(const f32x4*)(F.in[10] + d1 + 36);
        constexpr int NQI = NT, NKI = NB * LKV / 4;
        for (int it = F.gw; it < NQI + NKI; it += F.NGW) {
            bf16* p; int t; bool rope; const bool isq = it < NQI;
            if (isq) { p = QN + (size_t)it * 1024 + (lane >> 3) * 128; t = it & 4095; rope = true; }
            else { const int row = (it - NQI) * 4 + (lane >> 4), pp = row % LKV; p = KB + (size_t)row * 256 + ((lane >> 3) & 1) * 128; t = pp; rope = pp < TS; }
            const u32x4 w1 = *(const u32x4*)(p + d1), w2 = *(const u32x4*)(p + d1 + 32);
            float x1[8], x2[8];
            x1[0] = bflo(w1.x); x1[1] = bfhi(w1.x); x1[2] = bflo(w1.y); x1[3] = bfhi(w1.y); x1[4] = bflo(w1.z); x1[5] = bfhi(w1.z); x1[6] = bflo(w1.w); x1[7] = bfhi(w1.w);
            x2[0] = bflo(w2.x); x2[1] = bfhi(w2.x); x2[2] = bflo(w2.y); x2[3] = bfhi(w2.y); x2[4] = bflo(w2.z); x2[5] = bfhi(w2.z); x2[6] = bflo(w2.w); x2[7] = bfhi(w2.w);
            float ss = 0.f;
#pragma unroll
            for (int i = 0; i < 8; ++i) ss += x1[i] * x1[i] + x2[i] * x2[i];
            ss += __shfl_xor(ss, 1); ss += __shfl_xor(ss, 2); ss += __shfl_xor(ss, 4);
            const float rstd = rsqrtf(ss * (1.f / 128.f) + EPS);
            const int pos = axis == 0 ? (t >> 6) : (t & 63);
            float o1[8], o2[8];
#pragma unroll
            for (int i = 0; i < 8; ++i) {
                const float wa = isq ? qw[i >> 2][i & 3] : kw[i >> 2][i & 3], wb = isq ? qw[2 + (i >> 2)][i & 3] : kw[2 + (i >> 2)][i & 3];
                const float y1 = x1[i] * rstd * wa, y2 = x2[i] * rstd * wb;
                const float cs = rope ? tcs[pos * 32 + 8 * fg + i] : 1.f, sn = rope ? tcs[2048 + pos * 32 + 8 * fg + i] : 0.f;
                o1[i] = y1 * cs - y2 * sn; o2[i] = y2 * cs + y1 * sn;
            }
            u32x4 r1, r2;
            r1.x = pk2(o1[0], o1[1]); r1.y = pk2(o1[2], o1[3]); r1.z = pk2(o1[4], o1[5]); r1.w = pk2(o1[6], o1[7]);
            r2.x = pk2(o2[0], o2[1]); r2.y = pk2(o2[2], o2[3]); r2.z = pk2(o2[4], o2[5]); r2.w = pk2(o2[6], o2[7]);
            *(u32x4*)(p + d1) = r1; *(u32x4*)(p + d1 + 32) = r2;
        }
    }
    {
        const bf16* RAW = (const bf16*)(F.ws + WS_DNRAW); const float* cw = F.in[11];
        for (int it = F.gw; it < (MTOT / 16) * 6; it += F.NGW) {
            const int tc = it / 6, grp = it % 6, m0 = tc * 16, part = grp >> 1;
            int start, len; if (m0 < NT) { start = m0 & ~4095; len = TS; } else { start = NT + ((m0 - NT) & ~255); len = CL; }
            const int pos0 = m0 - start, c = grp * 512 + 8 * lane;
            float wv[5][8];
#pragma unroll
            for (int jj = 0; jj < 5; ++jj) { const f32x4 a = *(const f32x4*)(cw + jj * 3072 + c), b = *(const f32x4*)(cw + jj * 3072 + c + 4);
                wv[jj][0] = a[0]; wv[jj][1] = a[1]; wv[jj][2] = a[2]; wv[jj][3] = a[3]; wv[jj][4] = b[0]; wv[jj][5] = b[1]; wv[jj][6] = b[2]; wv[jj][7] = b[3]; }
            u32x4 rows[20];
#pragma unroll
            for (int r = 0; r < 20; ++r) { const int pp = pos0 + r - 2; rows[r] = (pp >= 0 && pp < len) ? *(const u32x4*)(RAW + (size_t)(start + pp) * 3072 + c) : (u32x4){0u, 0u, 0u, 0u}; }
            bf16* dst = (bf16*)(F.ws + (part == 0 ? WS_DQ : (part == 1 ? WS_DK : WS_DV))) + dn_off(m0, (grp & 1) * 4 + (lane >> 4)) + 8 * (lane & 15);
#pragma unroll
            for (int tk = 0; tk < 16; ++tk) {
                float a[8];
#pragma unroll
                for (int i = 0; i < 8; ++i) a[i] = 0.f;
#pragma unroll
                for (int jj = 0; jj < 5; ++jj) { const u32x4 w = rows[tk + jj];
                    a[0] += wv[jj][0] * bflo(w.x); a[1] += wv[jj][1] * bfhi(w.x); a[2] += wv[jj][2] * bflo(w.y); a[3] += wv[jj][3] * bfhi(w.y);
                    a[4] += wv[jj][4] * bflo(w.z); a[5] += wv[jj][5] * bfhi(w.z); a[6] += wv[jj][6] * bflo(w.w); a[7] += wv[jj][7] * bfhi(w.w); }
                float ss = 0.f;
#pragma unroll
                for (int i = 0; i < 8; ++i) { a[i] = silu(a[i]); ss += a[i] * a[i]; }
                if (part < 2) {
                    ss += __shfl_xor(ss, 1); ss += __shfl_xor(ss, 2); ss += __shfl_xor(ss, 4); ss += __shfl_xor(ss, 8);
                    const float r = rsqrtf(ss + EPS) * (part == 0 ? 0.088388347648318440f : 1.f);
#pragma unroll
                    for (int i = 0; i < 8; ++i) a[i] *= r;
                }
                u32x4 o; o.x = pk2(a[0], a[1]); o.y = pk2(a[2], a[3]); o.z = pk2(a[4], a[5]); o.w = pk2(a[6], a[7]);
                *(u32x4*)(dst + tk * 128) = o;
            }
        }
    }
}

DI void phase_dn_naive(Frame& F) {
    if (F.wave != 0 || blockIdx.x >= 128) return;
    const int item = blockIdx.x, dir = item >> 6, b = (item >> 4) & 3, h = (item >> 1) & 7, half = item & 1, lane = F.lane;
    const bf16* DQ = (const bf16*)(F.ws + WS_DQ); const bf16* DK = (const bf16*)(F.ws + WS_DK); const bf16* DV = (const bf16*)(F.ws + WS_DV);
    const float* BETA = (const float*)(F.ws + WS_BETA); const float* LOGA = (const float*)(F.ws + WS_LOGA);
    bf16* ODN = (bf16*)(F.ws + WS_ODN);
    float S[128];
#pragma unroll
    for (int i = 0; i < 128; ++i) S[i] = 0.f;
    for (int step = 0; step < LKV; ++step) {
        const bool isl = step >= CL; const int p = isl ? step - CL : step, len = isl ? TS : CL, pos = dir ? len - 1 - p : p;
        const int m = isl ? b * TS + pos : NT + b * CL + pos;
        const unsigned kw = *(const unsigned*)(DK + dn_off(m, h) + 2 * lane);
        const unsigned qw = *(const unsigned*)(DQ + dn_off(m, h) + 2 * lane);
        const float vj = bf2f(DV[dn_off(m, h) + half * 64 + lane]);
        const float a = __expf(LOGA[(size_t)m * 16 + dir * 8 + h]), bt = BETA[(size_t)m * 16 + dir * 8 + h];
        float k0 = 0.f, k1 = 0.f, k2 = 0.f, k3 = 0.f;
#pragma unroll
        for (int i = 0; i < 64; i += 2) {
            const unsigned w0 = rdlane(kw, i), w1 = rdlane(kw, i + 1);
            k0 += bflo(w0) * S[2 * i]; k1 += bfhi(w0) * S[2 * i + 1]; k2 += bflo(w1) * S[2 * i + 2]; k3 += bfhi(w1) * S[2 * i + 3];
        }
        const float kS = (k0 + k1) + (k2 + k3);
        const float coef = bt * (vj - a * kS);
#pragma unroll
        for (int i = 0; i < 64; ++i) { const unsigned w0 = rdlane(kw, i); S[2 * i] = a * S[2 * i] + coef * bflo(w0); S[2 * i + 1] = a * S[2 * i + 1] + coef * bfhi(w0); }
        if (isl) {
            float o0 = 0.f, o1 = 0.f, o2 = 0.f, o3 = 0.f;
#pragma unroll
            for (int i = 0; i < 64; i += 2) {
                const unsigned w0 = rdlane(qw, i), w1 = rdlane(qw, i + 1);
                o0 += bflo(w0) * S[2 * i]; o1 += bfhi(w0) * S[2 * i + 1]; o2 += bflo(w1) * S[2 * i + 2]; o3 += bfhi(w1) * S[2 * i + 3];
            }
            ODN[((size_t)dir * NT + m) * 1024 + h * 128 + half * 64 + lane] = (bf16)f2bf((o0 + o1) + (o2 + o3));
        }
    }
}

DI int dn_row0(int b, int cc) { return cc < 4 ? NT + b * CL + 64 * cc : b * TS + 64 * (cc - 4); }
typedef short bf16x8_t __attribute__((ext_vector_type(8)));
#define MFMA16(a, b, c) __builtin_amdgcn_mfma_f32_16x16x32_bf16((a), (b), (c), 0, 0, 0)

DI bf16x8_t dn_afrag(const LAS unsigned char* p) {
    const u32x2 lo = *(const LAS u32x2*)p, hi = *(const LAS u32x2*)(p + 32);
    u32x4 v; v.x = lo.x; v.y = lo.y; v.z = hi.x; v.w = hi.y; return __builtin_bit_cast(bf16x8_t, v);
}
DI bf16x8_t dn_bpack(const f32x4 t0, const f32x4 t1) {
    u32x4 v; v.x = pk2(t0[0], t0[1]); v.y = pk2(t0[2], t0[3]); v.z = pk2(t1[0], t1[1]); v.w = pk2(t1[2], t1[3]); return __builtin_bit_cast(bf16x8_t, v);
}
DI void phase_dn_prep(Frame& F) {
    LAS unsigned char* L = F.lds;
    constexpr int KS = 0, QS = 17408, VC = 34816, AP = 35840;
    constexpr int NITEM = NB * 8 * 68, NBATCH = (NITEM + 2) / 3;
    const bf16* DQ = (const bf16*)(F.ws + WS_DQ); const bf16* DK = (const bf16*)(F.ws + WS_DK);
    const float* BETA = (const float*)(F.ws + WS_BETA); const float* LOGA = (const float*)(F.ws + WS_LOGA);
    bf16* KT = (bf16*)(F.ws + WS_KT); bf16* TINV = (bf16*)(F.ws + WS_TINV); bf16* QKO = (bf16*)(F.ws + WS_QKO); float* VEC = (float*)(F.ws + WS_VEC);
    const int tid = F.tid, wave = F.wave;
    LAS float* vg = (LAS float*)(L + VC); LAS float* vb = vg + 128;
    for (int batch = F.vcu; batch < NBATCH; batch += F.G) {
        int lane = F.lane; asm volatile("" : "+v"(lane));
        const int fr = lane & 15, fq = lane >> 4;
#pragma unroll 1
        for (int c3 = 0; c3 < 3; ++c3) {
            const int item = batch * 3 + c3;
            if (item >= NITEM) break;
            const int b = item / 544, h = (item % 544) / 68, cc = item % 68, row0 = dn_row0(b, cc);
#pragma unroll
            for (int k = 0; k < 4; ++k) {
                const int c = tid + 512 * k, which = c >> 10, c2 = c & 1023, row = c2 >> 4, c16 = c2 & 15;
                const u32x4 v = *(const u32x4*)((which ? DQ : DK) + (size_t)item * 8192 + c2 * 8);
                *(LAS u32x4*)(L + (which ? QS : KS) + row * 272 + c16 * 16) = v;
            }
            if (wave < 2) {
                const int d = wave, i = lane;
                const float la = LOGA[(size_t)(row0 + i) * 16 + d * 8 + h], bt = BETA[(size_t)(row0 + i) * 16 + d * 8 + h];
                float x = la;
                if (d == 0) {
#pragma unroll
                    for (int o = 1; o < 64; o <<= 1) { const float y = __shfl_up(x, o); if (i >= o) x += y; }
                } else {
#pragma unroll
                    for (int o = 1; o < 64; o <<= 1) { const float y = __shfl_down(x, o); if (i + o < 64) x += y; }
                }
                const float glast = __shfl(x, d == 0 ? 63 : 0);
                vg[d * 64 + i] = x; vb[d * 64 + i] = bt;
                float* ve = VEC + (size_t)(item * 2 + d) * 320;
                const float eg = __expf(x);
                ve[i] = bt; ve[64 + i] = eg; ve[128 + i] = bt * eg; ve[192 + i] = __expf(glast - x); ve[256 + i] = __expf(glast);
            }
            __syncthreads();
            {
                bf16* kt = KT + (size_t)item * 8192;
#pragma unroll
                for (int k = 0; k < 2; ++k) {
                    const int c = tid + 512 * k, dk = c >> 3, t8 = c & 7;
                    unsigned short e[8];
#pragma unroll
                    for (int q = 0; q < 8; ++q) e[q] = *(const LAS unsigned short*)(L + KS + (8 * t8 + q) * 272 + dk * 2);
                    u32x4 w; w.x = e[0] | ((unsigned)e[1] << 16); w.y = e[2] | ((unsigned)e[3] << 16); w.z = e[4] | ((unsigned)e[5] << 16); w.w = e[6] | ((unsigned)e[7] << 16);
                    *(u32x4*)(kt + dk * 64 + 8 * t8) = w;
                }
            }
            {
                const int it = wave & 3, mat = wave >> 2;
                f32x4 acc[4];
#pragma unroll
                for (int j = 0; j < 4; ++j) acc[j] = (f32x4){0.f, 0.f, 0.f, 0.f};
#pragma unroll
                for (int s = 0; s < 4; ++s) {
                    const bf16x8_t a = *(const LAS bf16x8_t*)(L + (mat ? QS : KS) + (16 * it + fr) * 272 + (32 * s + 8 * fq) * 2);
#pragma unroll
                    for (int jt = 0; jt < 4; ++jt) {
                        const bf16x8_t bb = *(const LAS bf16x8_t*)(L + KS + (16 * jt + fr) * 272 + (32 * s + 8 * fq) * 2);
                        acc[jt] = MFMA16(a, bb, acc[jt]);
                    }
                }
#pragma unroll
                for (int d = 0; d < 2; ++d) {
                    LAS float* ap = (LAS float*)(L + AP + (c3 * 2 + d) * 17408);
                    bf16* qo = QKO + (size_t)(item * 2 + d) * 4096;
#pragma unroll
                    for (int jt = 0; jt < 4; ++jt)
#pragma unroll
                        for (int r = 0; r < 4; ++r) {
                            const int i = 16 * it + 4 * fq + r, j = 16 * jt + fr, ip = d ? 63 - i : i, jp = d ? 63 - j : j;
                            const float dg = vg[d * 64 + i] - vg[d * 64 + j];
                            if (mat == 0) { ap[ip * 68 + jp] = (jp < ip) ? vb[d * 64 + i] * acc[jt][r] * __expf(dg) : 0.f; }
                            else { qo[i * 64 + j] = (bf16)f2bf((jp <= ip) ? acc[jt][r] * __expf(dg) : 0.f); }
                        }
                }
            }
            __syncthreads();
        }
        if (wave < 6 && batch * 3 + (wave >> 1) < NITEM) {
            const int item = batch * 3 + (wave >> 1), d = wave & 1, c = lane;
            const LAS float* ap = (const LAS float*)(L + AP + wave * 17408);
            float x[64];
#pragma unroll
            for (int ip = 0; ip < 64; ++ip) {
                float a0 = (ip == c) ? 1.f : 0.f, a1 = 0.f;
#pragma unroll
                for (int q = 0; q < (ip + 3) / 4; ++q) {
                    const f32x4 av = *(const LAS f32x4*)(ap + ip * 68 + 4 * q);
#pragma unroll
                    for (int e = 0; e < 4; ++e) { const int jp = 4 * q + e; if (jp < ip) { if (e & 1) a1 -= av[e] * x[jp]; else a0 -= av[e] * x[jp]; } }
                }
                x[ip] = a0 + a1;
                __builtin_amdgcn_sched_barrier(0);
            }
            bf16* ti = TINV + (size_t)(item * 2 + d) * 4096;
            const int j = d ? 63 - c : c;
#pragma unroll
            for (int ip = 0; ip < 64; ++ip) { const int i = d ? 63 - ip : ip; ti[i * 64 + j] = (bf16)f2bf(x[ip]); }
        }
        __syncthreads();
    }
}

DI int dn_perm(int m, int t) { return 32 * (t >> 1) + 8 * (m >> 2) + 4 * (t & 1) + (m & 3); }
DI int dn_swz16(int row, int chunk) { return row * 272 + (chunk << 4); }
DI int dn_swz8(int row, int chunk) { return row * 144 + (chunk << 4); }
#define DN_BAR() do { asm volatile("s_waitcnt lgkmcnt(0)" ::: "memory"); __builtin_amdgcn_s_barrier(); asm volatile("" ::: "memory"); } while (0)
DI void phase_dn_scan(Frame& F) {
    LAS unsigned char* L = F.lds;
    constexpr int KS = 0, QS = 17408, KTS = 34816, TIS = 53248, VS = 62464, VCS = 66560, BUF = 68096;
    constexpr int PUBS = 2 * BUF, PUBV = PUBS + 16384;
    static_assert(PUBV + 8192 <= LDS_BYTES - 64, "scan LDS map");
    const int G8 = F.G >> 3;
    const int li = blockIdx.x >> 3, chain = (blockIdx.x & 7) * (G8 >> 2) + (li >> 2), qd = li & 3;
    if (F.G != 256 || chain >= 64) return;
    const int dir = chain >> 5, b = (chain >> 3) & 3, h = chain & 7;
    const bf16* DQ = (const bf16*)(F.ws + WS_DQ); const bf16* DK = (const bf16*)(F.ws + WS_DK); const bf16* DV = (const bf16*)(F.ws + WS_DV);
    const bf16* KT = (const bf16*)(F.ws + WS_KT); const bf16* TINV = (const bf16*)(F.ws + WS_TINV); const bf16* QKO = (const bf16*)(F.ws + WS_QKO); const float* VEC = (const float*)(F.ws + WS_VEC);
    bf16* ODN = (bf16*)(F.ws + WS_ODN);
    const int tid = F.tid, lane = F.lane, w = F.wave, fr = lane & 15, fq = lane >> 4;
#ifndef DN_NSTEP
#define DN_NSTEP 68
#endif
#define DN_CC1(st) (dir == 0 ? (st) : ((st) < 4 ? 3 - (st) : 71 - (st)))
#define DN_CC(step) DN_CC1((step) % 68)
#define AF16(base, row, kchunk) (*(const LAS bf16x8_t*)(Lb + (base) + dn_swz16((row), (kchunk))))
#define AF8(base, row, kchunk) (*(const LAS bf16x8_t*)(Lb + (base) + dn_swz8((row), (kchunk))))
    if (w >= 4) {
        const int lt = tid - 256;
        u32x4 preA[16], preB[16];
#define DN_LOAD(pre, cc_) do { const int cc__ = (cc_); const int item__ = (b * 8 + h) * 68 + cc__, cd__ = item__ * 2 + dir; \
        _Pragma("unroll") for (int k = 0; k < 16; ++k) { const bf16* src; \
            if (k < 4)       { const int q = lt + 256 * k;        src = DK + (size_t)item__ * 8192 + q * 8; } \
            else if (k < 8)  { const int q = lt + 256 * (k - 4);  src = DQ + (size_t)item__ * 8192 + q * 8; } \
            else if (k < 12) { const int q = lt + 256 * (k - 8);  src = KT + (size_t)item__ * 8192 + q * 8; } \
            else if (k < 14) { const int q = lt + 256 * (k - 12); src = TINV + (size_t)cd__ * 4096 + q * 8; } \
            else if (k == 14) { src = DV + (size_t)item__ * 8192 + (lt >> 2) * 128 + qd * 32 + (lt & 3) * 8; } \
            else { src = (const bf16*)(VEC + (size_t)cd__ * 320 + (lt < 80 ? lt : 0) * 4); } \
            pre[k] = *(const u32x4*)src; } } while (0)
#define DN_STORE(pre, bufo_) do { const int bo__ = (bufo_); _Pragma("unroll") for (int k = 0; k < 16; ++k) { int dst; \
            if (k < 4)       { const int q = lt + 256 * k;        dst = KS + dn_swz16(q >> 4, q & 15); } \
            else if (k < 8)  { const int q = lt + 256 * (k - 4);  dst = QS + dn_swz16(q >> 4, q & 15); } \
            else if (k < 12) { const int q = lt + 256 * (k - 8);  dst = KTS + dn_swz8(q >> 3, q & 7); } \
            else if (k < 14) { const int q = lt + 256 * (k - 12); dst = TIS + dn_swz8(q >> 3, q & 7); } \
            else if (k == 14) { dst = VS + lt * 16; } \
            else { dst = VCS + (lt < 80 ? lt : 0) * 16; } \
            *(LAS u32x4*)(L + bo__ + dst) = pre[k]; } } while (0)
#ifdef DN_SKIP_LOAD
#define DN_CLAMP(ds) ((ds) < DN_NSTEP - 70 ? 0 : (ds) < DN_NSTEP ? (ds) : DN_NSTEP - 1)
#else
#define DN_CLAMP(ds) ((ds) < DN_NSTEP ? (ds) : DN_NSTEP - 1)
#endif
#ifndef DN_SLEEP
#define DN_SLEEP 8
#endif
#define DN_LDELAY() __builtin_amdgcn_s_sleep(DN_SLEEP)
        DN_LOAD(preA, DN_CC(0)); DN_STORE(preA, 0); DN_LOAD(preA, DN_CC(1)); DN_LOAD(preB, DN_CC(2));
        DN_BAR();
        for (int step = 0; step < DN_NSTEP; step += 2) {
            DN_LDELAY(); DN_STORE(preA, BUF); DN_LOAD(preA, DN_CC(DN_CLAMP(step + 3)));
            DN_BAR();
            DN_LDELAY(); DN_STORE(preB, 0); DN_LOAD(preB, DN_CC(DN_CLAMP(step + 4)));
            DN_BAR();
        }
#undef DN_CLAMP
#undef DN_LOAD
#undef DN_STORE
    } else if (w >= 2) {
        const int pw = w - 2;
        bf16x8_t qkA[2][4], qkB[2][4];
        f32x4 O[4];
#define DN_QKLOAD(dst, st_) do { const int cd__ = ((b * 8 + h) * 68 + DN_CC(st_)) * 2 + dir; \
        _Pragma("unroll") for (int s = 0; s < 2; ++s) _Pragma("unroll") for (int mt = 0; mt < 4; ++mt) \
            dst[s][mt] = *(const bf16x8_t*)(QKO + (size_t)cd__ * 4096 + dn_perm(fr, mt) * 64 + (4 * s + fq) * 8); } while (0)
#define DN_OFIN(qk, st_) do { const int st__ = (st_); const LAS unsigned char* pv = L + PUBV + (st__ & 1) * 4096 + pw * 2048 + lane * 16; \
        const bf16x8_t vb0 = *(const LAS bf16x8_t*)pv, vb1 = *(const LAS bf16x8_t*)(pv + 1024); \
        _Pragma("unroll") for (int mt = 0; mt < 4; ++mt) { O[mt] = MFMA16(vb0, qk[0][mt], O[mt]); O[mt] = MFMA16(vb1, qk[1][mt], O[mt]); } \
        const int cc__ = DN_CC(st__); \
        if (cc__ >= 4) { bf16* orow = ODN + ((size_t)dir * NT + dn_row0(b, cc__)) * 1024 + h * 128 + qd * 32 + 16 * pw + 4 * fq; \
            _Pragma("unroll") for (int mt = 0; mt < 4; ++mt) { u32x2 w2; w2.x = pk2(O[mt][0], O[mt][1]); w2.y = pk2(O[mt][2], O[mt][3]); \
                *(u32x2*)(orow + (size_t)dn_perm(fr, mt) * 1024) = w2; } } } while (0)
#define DN_OBEG(st_) do { const int st__ = (st_); const LAS unsigned char* Lb = L + (st__ & 1) * BUF; const LAS unsigned char* ps = L + PUBS + (st__ & 1) * 8192 + pw * 4096 + lane * 16; \
        bf16x8_t sb[4], qa[4][4]; \
        _Pragma("unroll") for (int s = 0; s < 4; ++s) sb[s] = *(const LAS bf16x8_t*)(ps + s * 1024); \
        _Pragma("unroll") for (int s = 0; s < 4; ++s) _Pragma("unroll") for (int mt = 0; mt < 4; ++mt) qa[s][mt] = AF16(QS, dn_perm(fr, mt), 4 * s + fq); \
        _Pragma("unroll") for (int mt = 0; mt < 4; ++mt) O[mt] = (f32x4){0.f, 0.f, 0.f, 0.f}; \
        _Pragma("unroll") for (int s = 0; s < 4; ++s) _Pragma("unroll") for (int mt = 0; mt < 4; ++mt) O[mt] = MFMA16(sb[s], qa[s][mt], O[mt]); \
        const LAS float* vc = (const LAS float*)(Lb + VCS); \
        _Pragma("unroll") for (int mt = 0; mt < 4; ++mt) { const float eg = vc[64 + dn_perm(fr, mt)]; O[mt] = O[mt] * eg; } } while (0)
        DN_QKLOAD(qkA, 0); DN_QKLOAD(qkB, 1);
        DN_BAR();
        DN_OBEG(0);
        DN_BAR();
        for (int step = 0; step < DN_NSTEP - 2; step += 2) {
#ifdef DN_SKIP_OUT
            if (step < DN_NSTEP - 70) { DN_BAR(); DN_BAR(); continue; }
#endif
            DN_OFIN(qkA, step); DN_QKLOAD(qkA, step + 2);
            DN_OBEG(step + 1);
            DN_BAR();
            DN_OFIN(qkB, step + 1); DN_QKLOAD(qkB, step + 3);
            DN_OBEG(step + 2);
            DN_BAR();
        }
        DN_OFIN(qkA, DN_NSTEP - 2);
        DN_OBEG(DN_NSTEP - 1);
        DN_BAR();
        DN_OFIN(qkB, DN_NSTEP - 1);
#undef DN_QKLOAD
#undef DN_OFIN
#undef DN_OBEG
    } else {
        f32x4 S[8];
#pragma unroll
        for (int j = 0; j < 8; ++j) S[j] = (f32x4){0.f, 0.f, 0.f, 0.f};
        bf16x8_t sb[4];
#pragma unroll
        for (int s = 0; s < 4; ++s) { sb[s] = dn_bpack(S[2 * s], S[2 * s + 1]); *(LAS bf16x8_t*)(L + PUBS + w * 4096 + s * 1024 + lane * 16) = sb[s]; }
        DN_BAR();
        for (int step = 0; step < DN_NSTEP; ++step) {
#ifdef DN_SKIP_COMP
            if (step < DN_NSTEP - 69) { DN_BAR(); continue; }
#endif
            const LAS unsigned char* Lb = L + (step & 1) * BUF;
            f32x4 P[4];
#pragma unroll
            for (int mt = 0; mt < 4; ++mt) P[mt] = (f32x4){0.f, 0.f, 0.f, 0.f};
            {
                bf16x8_t ka[4][4];
#pragma unroll
                for (int s = 0; s < 4; ++s)
#pragma unroll
                    for (int mt = 0; mt < 4; ++mt) ka[s][mt] = AF16(KS, dn_perm(fr, mt), 4 * s + fq);
                __builtin_amdgcn_sched_barrier(0);
#pragma unroll
                for (int s = 0; s < 4; ++s)
#pragma unroll
                    for (int mt = 0; mt < 4; ++mt) P[mt] = MFMA16(ka[s][mt], sb[s], P[mt]);
            }
            bf16x8_t tia[2][4];
#pragma unroll
            for (int s = 0; s < 2; ++s)
#pragma unroll
                for (int mt = 0; mt < 4; ++mt) tia[s][mt] = AF8(TIS, dn_perm(fr, mt), 4 * s + fq);
            const LAS float* vc = (const LAS float*)(Lb + VCS);
            f32x4 R[4];
#pragma unroll
            for (int mt = 0; mt < 4; ++mt) {
                const int tk0 = 32 * (mt >> 1) + 8 * fq + 4 * (mt & 1);
                const f32x4 bt = *(const LAS f32x4*)(vc + tk0), bg = *(const LAS f32x4*)(vc + 128 + tk0);
#pragma unroll
                for (int r = 0; r < 4; ++r) {
                    const float v = bf2f(*(const LAS unsigned short*)(Lb + VS + (tk0 + r) * 64 + (16 * w + fr) * 2));
                    R[mt][r] = v * bt[r] - bg[r] * P[mt][r];
                }
            }
            const bf16x8_t rb0 = dn_bpack(R[0], R[1]), rb1 = dn_bpack(R[2], R[3]);
            f32x4 VN[4];
#pragma unroll
            for (int mt = 0; mt < 4; ++mt) {
                VN[mt] = (f32x4){0.f, 0.f, 0.f, 0.f};
                VN[mt] = MFMA16(tia[0][mt], rb0, VN[mt]);
                VN[mt] = MFMA16(tia[1][mt], rb1, VN[mt]);
            }
            bf16x8_t kta[2][8];
#pragma unroll
            for (int s = 0; s < 2; ++s)
#pragma unroll
                for (int jt = 0; jt < 8; ++jt) kta[s][jt] = AF8(KTS, dn_perm(fr, jt), 4 * s + fq);
            {
                const bf16x8_t vb0 = dn_bpack(VN[0], VN[1]), vb1 = dn_bpack(VN[2], VN[3]);
                LAS unsigned char* pv = L + PUBV + (step & 1) * 4096 + w * 2048 + lane * 16;
                *(LAS bf16x8_t*)pv = vb0; *(LAS bf16x8_t*)(pv + 1024) = vb1;
            }
#pragma unroll
            for (int mt = 0; mt < 4; ++mt) { const f32x4 ek = *(const LAS f32x4*)(vc + 192 + 32 * (mt >> 1) + 8 * fq + 4 * (mt & 1)); VN[mt] = VN[mt] * ek; }
            const bf16x8_t vs0 = dn_bpack(VN[0], VN[1]), vs1 = dn_bpack(VN[2], VN[3]);
            const float egl = vc[256];
#pragma unroll
            for (int jt = 0; jt < 8; ++jt) {
                S[jt] = S[jt] * egl;
                S[jt] = MFMA16(kta[0][jt], vs0, S[jt]);
                S[jt] = MFMA16(kta[1][jt], vs1, S[jt]);
            }
            if (DN_NSTEP > 68 && step % 68 == 67) {
#pragma unroll
                for (int j = 0; j < 8; ++j) S[j] = (f32x4){0.f, 0.f, 0.f, 0.f};
            }
#pragma unroll
            for (int s = 0; s < 4; ++s) { sb[s] = dn_bpack(S[2 * s], S[2 * s + 1]); *(LAS bf16x8_t*)(L + PUBS + ((step + 1) & 1) * 8192 + w * 4096 + s * 1024 + lane * 16) = sb[s]; }
            DN_BAR();
        }
    }
#undef AF16
#undef AF8
#undef DN_CC
#undef DN_CC1
}

DI void phase_attention(Frame& F, char* lds_generic) {
    bf16* QN = (bf16*)(F.ws + WS_QN); const bf16* KB = (const bf16*)(F.ws + WS_KB); const bf16* VB = (const bf16*)(F.ws + WS_VB);
    for (int it = F.vcu; it < 512; it += F.G) {
        const int b = it >> 7, kvh = (it >> 6) & 1, g = (it >> 4) & 3, qb = it & 15, h = kvh * 4 + g;
        bf16* Qb = QN + ((size_t)(b * TS + qb * 256) * 1024 + h * 128);
        const bf16* Kh = KB + ((size_t)b * LKV * 256 + kvh * 128); const bf16* Vh = VB + ((size_t)b * LKV * 256 + kvh * 128);
#ifdef ATTN_PROBE
#pragma nounroll
        for (int rep_ = 0; rep_ < 2; ++rep_) {
            bf16* Ob = rep_ == 0 ? (bf16*)(F.ws + WS_END) + ((size_t)(b * TS + qb * 256) * 1024 + h * 128) : Qb;
            attn::attn_dense_body<attn::bf16>(Qb, Kh, Vh, Ob, LKV, lds_generic);
            __syncthreads();
        }
#else
        attn::attn_dense_body<attn::bf16>(Qb, Kh, Vh, Qb, LKV, lds_generic);
        __syncthreads();
#endif
    }
}

DI void phase_mergeprep(Frame& F) {
    const bf16* ODN = (const bf16*)(F.ws + WS_ODN); bf16* Z = (bf16*)(F.ws + WS_Z); const int lane = F.lane;
    float nw[16];
#pragma unroll
    for (int k = 0; k < 4; ++k) { const f32x4 v = *(const f32x4*)(F.in[14] + (lane & 7) * 16 + 4 * k); nw[4 * k] = v[0]; nw[4 * k + 1] = v[1]; nw[4 * k + 2] = v[2]; nw[4 * k + 3] = v[3]; }
    for (int t = F.gw; t < NT; t += F.NGW) {
        const size_t off = (size_t)t * 1024 + 16 * lane;
        u32x4 a[2], c[2], z[2];
#pragma unroll
        for (int k = 0; k < 2; ++k) { a[k] = __builtin_nontemporal_load((const u32x4*)(ODN + off + 8 * k)); c[k] = __builtin_nontemporal_load((const u32x4*)(ODN + (size_t)NT * 1024 + off + 8 * k)); z[k] = __builtin_nontemporal_load((const u32x4*)(Z + off + 8 * k)); }
        float o[16]; float ss = 0.f;
#pragma unroll
        for (int k = 0; k < 2; ++k)
#pragma unroll
            for (int i = 0; i < 4; ++i) { o[8 * k + 2 * i] = bflo(a[k][i]) + bflo(c[k][i]); o[8 * k + 2 * i + 1] = bfhi(a[k][i]) + bfhi(c[k][i]); }
#pragma unroll
        for (int i = 0; i < 16; ++i) ss += o[i] * o[i];
        ss += __shfl_xor(ss, 1); ss += __shfl_xor(ss, 2); ss += __shfl_xor(ss, 4);
        const float rstd = rsqrtf(ss * (1.f / 128.f) + EPS);
        if (MERGE_F8_B) {
            float y[16];
#pragma unroll
            for (int k = 0; k < 2; ++k)
#pragma unroll
                for (int i = 0; i < 4; ++i) { y[8 * k + 2 * i] = o[8 * k + 2 * i] * rstd * nw[8 * k + 2 * i] * silu(bflo(z[k][i])); y[8 * k + 2 * i + 1] = o[8 * k + 2 * i + 1] * rstd * nw[8 * k + 2 * i + 1] * silu(bfhi(z[k][i])); }
            u32x4 w;
#pragma unroll
            for (int q = 0; q < 4; ++q) w[q] = pk4_fp8(fp8c(y[4 * q] * ODNN_SCALE), fp8c(y[4 * q + 1] * ODNN_SCALE), fp8c(y[4 * q + 2] * ODNN_SCALE), fp8c(y[4 * q + 3] * ODNN_SCALE));
            *(u32x4*)(F.ws + WS_ODNN8 + off) = w;
        } else {
#pragma unroll
        for (int k = 0; k < 2; ++k) {
            u32x4 w;
#pragma unroll
            for (int i = 0; i < 4; ++i) w[i] = pk2(o[8 * k + 2 * i] * rstd * nw[8 * k + 2 * i] * silu(bflo(z[k][i])), o[8 * k + 2 * i + 1] * rstd * nw[8 * k + 2 * i + 1] * silu(bfhi(z[k][i])));
            *(u32x4*)(Z + off + 8 * k) = w;
        }
        }
        if (MERGE_F8_A) {
            const bf16* OA = (const bf16*)(F.ws + WS_QN);
            const u32x4 a0 = __builtin_nontemporal_load((const u32x4*)(OA + off)), a1 = __builtin_nontemporal_load((const u32x4*)(OA + off + 8));
            u32x4 w;
            w[0] = pk4_fp8(fp8c(bflo(a0.x) * OATT_SCALE), fp8c(bfhi(a0.x) * OATT_SCALE), fp8c(bflo(a0.y) * OATT_SCALE), fp8c(bfhi(a0.y) * OATT_SCALE));
            w[1] = pk4_fp8(fp8c(bflo(a0.z) * OATT_SCALE), fp8c(bfhi(a0.z) * OATT_SCALE), fp8c(bflo(a0.w) * OATT_SCALE), fp8c(bfhi(a0.w) * OATT_SCALE));
            w[2] = pk4_fp8(fp8c(bflo(a1.x) * OATT_SCALE), fp8c(bfhi(a1.x) * OATT_SCALE), fp8c(bflo(a1.y) * OATT_SCALE), fp8c(bfhi(a1.y) * OATT_SCALE));
            w[3] = pk4_fp8(fp8c(bflo(a1.z) * OATT_SCALE), fp8c(bfhi(a1.z) * OATT_SCALE), fp8c(bflo(a1.w) * OATT_SCALE), fp8c(bfhi(a1.w) * OATT_SCALE));
            *(u32x4*)(F.ws + WS_OATT8 + off) = w;
        }
    }
}

DI void tk_insert(unsigned (&a)[16], unsigned x) {
#pragma unroll
    for (int i = 0; i < 16; ++i) { const unsigned hi = a[i] > x ? a[i] : x; x = a[i] > x ? x : a[i]; a[i] = hi; }
}
template <int N> DI void tk_sort_desc(unsigned (&a)[N]) {
#pragma unroll
    for (int k = 2; k <= N; k <<= 1)
#pragma unroll
        for (int j = k >> 1; j > 0; j >>= 1)
#pragma unroll
            for (int i = 0; i < N; ++i) {
                const int l = i ^ j;
                if (l > i) {
                    const unsigned lo = a[i] < a[l] ? a[i] : a[l], hi = a[i] < a[l] ? a[l] : a[i];
                    if ((i & k) == 0) { a[i] = hi; a[l] = lo; } else { a[i] = lo; a[l] = hi; }
                }
            }
}
DI void tk_sort_bitonic(unsigned (&c)[16]) {
#pragma unroll
    for (int s = 8; s >= 1; s >>= 1)
#pragma unroll
        for (int i = 0; i < 16; ++i) if ((i & s) == 0) { const unsigned lo = c[i] < c[i + s] ? c[i] : c[i + s], hi = c[i] < c[i + s] ? c[i + s] : c[i]; c[i] = hi; c[i + s] = lo; }
}
template <bool SORT> DI void tk_merge(unsigned (&a)[16], int m) {
    unsigned b[16];
#pragma unroll
    for (int i = 0; i < 16; ++i) b[i] = (unsigned)__shfl_xor((int)a[15 - i], m);
#pragma unroll
    for (int i = 0; i < 16; ++i) a[i] = a[i] > b[i] ? a[i] : b[i];
    if (SORT) tk_sort_bitonic(a);
}
DI float tk_unkey(unsigned k) { const unsigned u = (k & 0x80000000u) ? (k & 0x7fffffffu) : ~k; return __uint_as_float(u); }

DI void phase_peer_topk(Frame& F) {
    LAS unsigned char* L = F.lds;
    constexpr int KS = 0, QS = 69632, SC = 69632, TOP = 137216, FIN = 139264, PT = 140288;
    const bf16* PQ = (const bf16*)(F.ws + WS_PQ); const bf16* SUBK = (const bf16*)(F.ws + WS_SUBK);
    int* EXPI = (int*)(F.ws + WS_EXPI); float* EXPG = (float*)(F.ws + WS_EXPG);
    const int tid = F.tid, lane = F.lane, w = F.wave, fr = lane & 15, fq = lane >> 4;
    LAS float* sc = (LAS float*)(L + SC); LAS unsigned char* top = L + TOP; LAS unsigned char* finb = L + FIN; LAS int* pt = (LAS int*)(L + PT);
    if (tid < 56) {
        int n = tid, pi = -1;
#pragma unroll
        for (int i = 0; i < 16; ++i) { const int cnt = 16 / (i + 1); if (pi < 0) { if (n < cnt) pi = i * 16 + n; else n -= cnt; } }
        pt[tid] = tid < 50 ? pi : -1;
    }
    int hcur = -1;
    u32x4 qpre[4];
    if (F.vcu < (NT / 64) * 8) {
        const int h0 = F.vcu & 7, tq = (F.vcu >> 3) * 64;
#pragma unroll
        for (int k = 0; k < 4; ++k) { const int c = tid + 512 * k; qpre[k] = __builtin_nontemporal_load((const u32x4*)(PQ + (size_t)(tq + (c >> 5)) * 2048 + h0 * 256 + (c & 31) * 8)); }
    }
    for (int it = F.vcu; it < (NT / 64) * 8; it += F.G) {
        const int h = it & 7, tile = it >> 3, t0 = tile * 64;
        RAW_BAR();
        if (h != hcur) {
#pragma unroll
            for (int k = 0; k < 8; ++k) { const int c = tid + 512 * k, row = c >> 4, c16 = c & 15;
                *(LAS u32x4*)(L + KS + row * 272 + c16 * 16) = *(const u32x4*)(SUBK + (size_t)h * 32768 + row * 128 + c16 * 8); }
            hcur = h;
        }
#pragma unroll
        for (int k = 0; k < 4; ++k) { const int c = tid + 512 * k, row = c >> 5, c16 = c & 31; *(LAS u32x4*)(L + QS + row * 528 + c16 * 16) = qpre[k]; }
        if (it + F.G < (NT / 64) * 8) {
            const int itn = it + F.G, hn = itn & 7, tn = (itn >> 3) * 64;
#pragma unroll
            for (int k = 0; k < 4; ++k) { const int c = tid + 512 * k; qpre[k] = __builtin_nontemporal_load((const u32x4*)(PQ + (size_t)(tn + (c >> 5)) * 2048 + hn * 256 + (c & 31) * 8)); }
        }
        RAW_BAR();
        const int p = w >> 2, n0 = (w & 3) * 32;
        f32x4 acc[4][2];
#pragma unroll
        for (int mt = 0; mt < 4; ++mt) { acc[mt][0] = (f32x4){0.f, 0.f, 0.f, 0.f}; acc[mt][1] = (f32x4){0.f, 0.f, 0.f, 0.f}; }
#pragma unroll
        for (int s = 0; s < 4; ++s) {
            const bf16x8_t b0 = *(const LAS bf16x8_t*)(L + KS + (p * 128 + n0 + fr) * 272 + (32 * s + 8 * fq) * 2);
            const bf16x8_t b1 = *(const LAS bf16x8_t*)(L + KS + (p * 128 + n0 + 16 + fr) * 272 + (32 * s + 8 * fq) * 2);
#pragma unroll
            for (int mt = 0; mt < 4; ++mt) {
                const bf16x8_t a = *(const LAS bf16x8_t*)(L + QS + (16 * mt + fr) * 528 + (p * 128 + 32 * s + 8 * fq) * 2);
                acc[mt][0] = MFMA16(a, b0, acc[mt][0]); acc[mt][1] = MFMA16(a, b1, acc[mt][1]);
            }
        }
        RAW_BAR();
#pragma unroll
        for (int mt = 0; mt < 4; ++mt)
#pragma unroll
            for (int nt = 0; nt < 2; ++nt)
#pragma unroll
                for (int r = 0; r < 4; ++r) sc[((16 * mt + 4 * fq + r) * 2 + p) * 132 + (w & 3) * 33 + 16 * nt + fr] = acc[mt][nt][r];
        RAW_BAR();
        {
            const int list = tid >> 2, q = tid & 3;
            unsigned a32[32];
            const LAS float* sp = sc + list * 132 + q * 33;
#pragma unroll
            for (int i = 0; i < 32; ++i) a32[i] = (okey(sp[i]) & ~0x7Fu) | (unsigned)(q * 32 + i);
            tk_sort_desc<32>(a32);
            unsigned a[16];
#pragma unroll
            for (int i = 0; i < 16; ++i) a[i] = a32[i];
            tk_merge<true>(a, 1); tk_merge<true>(a, 2);
            if (q == 0) {
                u32x4 v;
#pragma unroll
                for (int k = 0; k < 4; ++k) v[k] = (a[4 * k] & 127u) | ((a[4 * k + 1] & 127u) << 8) | ((a[4 * k + 2] & 127u) << 16) | ((a[4 * k + 3] & 127u) << 24);
                *(LAS u32x4*)(top + list * 16) = v;
            }
        }
        RAW_BAR();
        {
            const int tok = tid >> 3, r8 = tid & 7;
            unsigned c8[8]; c8[7] = 0u;
#pragma unroll
            for (int m = 0; m < 7; ++m) {
                const int pr = pt[r8 + 8 * m];
                unsigned ck = 0u;
                if (pr >= 0) {
                    const int ia = top[(tok * 2) * 16 + (pr >> 4)], ib = top[(tok * 2 + 1) * 16 + (pr & 15)];
                    const float cs = sc[(tok * 2) * 132 + (ia >> 5) * 33 + (ia & 31)] + sc[(tok * 2 + 1) * 132 + (ib >> 5) * 33 + (ib & 31)];
                    ck = (okey(cs) & ~0xFFu) | (unsigned)pr;
                }
                c8[m] = ck;
            }
            tk_sort_desc<8>(c8);
            unsigned a[16];
#pragma unroll
            for (int i = 0; i < 16; ++i) a[i] = i < 8 ? c8[i] : 0u;
            tk_merge<true>(a, 1); tk_merge<true>(a, 2); tk_merge<true>(a, 4);
            LAS unsigned char* fin = finb + tok * 16;
            if (r8 == 0) {
                u32x4 v;
#pragma unroll
                for (int k = 0; k < 4; ++k) v[k] = (a[4 * k] & 255u) | ((a[4 * k + 1] & 255u) << 8) | ((a[4 * k + 2] & 255u) << 16) | ((a[4 * k + 3] & 255u) << 24);
                *(LAS u32x4*)fin = v;
            }
            asm volatile("s_waitcnt lgkmcnt(0)" ::: "memory");
            float bs[2]; int ex[2];
#pragma unroll
            for (int e = 0; e < 2; ++e) {
                const unsigned pr = fin[2 * r8 + e];
                const int ia = top[(tok * 2) * 16 + (pr >> 4)], ib = top[(tok * 2 + 1) * 16 + (pr & 15u)];
                bs[e] = sc[(tok * 2) * 132 + (ia >> 5) * 33 + (ia & 31)] + sc[(tok * 2 + 1) * 132 + (ib >> 5) * 33 + (ib & 31)];
                ex[e] = ia * 128 + ib;
            }
            float mx = fmaxf(bs[0], bs[1]);
            mx = fmaxf(mx, __shfl_xor(mx, 1)); mx = fmaxf(mx, __shfl_xor(mx, 2)); mx = fmaxf(mx, __shfl_xor(mx, 4));
            const float e0 = __expf(bs[0] - mx), e1 = __expf(bs[1] - mx);
            float sm = e0 + e1; sm += __shfl_xor(sm, 1); sm += __shfl_xor(sm, 2); sm += __shfl_xor(sm, 4);
            const float rs = 1.f / sm;
            const size_t o = (size_t)(t0 + tok) * 128 + h * 16 + 2 * r8;
            *(int2*)(EXPI + o) = make_int2(ex[0], ex[1]);
            *(float2*)(EXPG + o) = make_float2(e0 * rs, e1 * rs);
        }
    }
}

DI float ub0(unsigned w) { float r; asm("v_cvt_f32_ubyte0 %0, %1" : "=v"(r) : "v"(w)); return r; }
DI float ub1(unsigned w) { float r; asm("v_cvt_f32_ubyte1 %0, %1" : "=v"(r) : "v"(w)); return r; }
DI float ub2(unsigned w) { float r; asm("v_cvt_f32_ubyte2 %0, %1" : "=v"(r) : "v"(w)); return r; }
DI float ub3(unsigned w) { float r; asm("v_cvt_f32_ubyte3 %0, %1" : "=v"(r) : "v"(w)); return r; }
DI float wave_maxf(float v) {
#pragma unroll
    for (int o = 1; o < 64; o <<= 1) v = fmaxf(v, __shfl_xor(v, o));
    return v;
}
template <int BIAS> DI void quant_rows(const float* src, unsigned char* dst, float* scale, int gw, int NGW, int lane) {
    for (int row = gw; row < NEXP; row += NGW) {
        f32x4 v[8]; float am = 0.f;
#pragma unroll
        for (int j = 0; j < 8; ++j) { v[j] = __builtin_nontemporal_load((const f32x4*)(src + (size_t)row * DM) + lane + 64 * j); am = fmaxf(am, fmaxf(fmaxf(fabsf(v[j][0]), fabsf(v[j][1])), fmaxf(fabsf(v[j][2]), fabsf(v[j][3])))); }
        am = wave_maxf(am);
        const float inv = am > 0.f ? 127.f / am : 0.f;
#pragma unroll
        for (int j = 0; j < 8; ++j) {
            unsigned w = 0;
#pragma unroll
            for (int i = 0; i < 4; ++i) { const int q = (int)rintf(v[j][i] * inv) + BIAS; w |= ((unsigned)q & 0xffu) << (8 * i); }
            *((unsigned*)(dst + (size_t)row * DM) + lane + 64 * j) = w;
        }
        if (lane == 0) scale[row] = am * (1.f / 127.f);
    }
}


constexpr int V4_ROW = 1152;
DI void quant_rows_i4(const float* __restrict__ src, unsigned char* __restrict__ dst, int gw, int NGW, int lane) {
#pragma unroll 2
    for (int row = gw; row < NEXP; row += NGW) {
        f32x4 vv[8];
#pragma unroll
        for (int j = 0; j < 8; ++j) vv[j] = __builtin_nontemporal_load((const f32x4*)(src + (size_t)row * DM) + lane + 64 * j);
#pragma unroll
        for (int j = 0; j < 8; ++j) {
            const f32x4 v = vv[j];
            float am = fmaxf(fmaxf(fabsf(v[0]), fabsf(v[1])), fmaxf(fabsf(v[2]), fabsf(v[3])));
            am = fmaxf(am, __shfl_xor(am, 1)); am = fmaxf(am, __shfl_xor(am, 2)); am = fmaxf(am, __shfl_xor(am, 4));
            const unsigned sb = f2bf(am * (1.f / 7.f)); const float s = __uint_as_float(sb << 16), inv = s > 0.f ? __builtin_amdgcn_rcpf(s) : 0.f;
            unsigned w = 0;
#pragma unroll
            for (int i = 0; i < 4; ++i) { const int q = (int)fminf(fmaxf(rintf(v[i] * inv), -7.f), 7.f) + 8; w |= (unsigned)q << (4 * i); }
            const int grp = j * 8 + (lane >> 3);
            *(unsigned short*)(dst + (size_t)row * V4_ROW + grp * 16 + (lane & 7) * 2) = (unsigned short)w;
            if ((lane & 7) == 0) *(unsigned short*)(dst + (size_t)row * V4_ROW + 1024 + grp * 2) = (unsigned short)sb;
        }
    }
}

DI void quant_u_both(const float* __restrict__ src, unsigned char* __restrict__ d8, float* __restrict__ scale, unsigned char* __restrict__ d4, int gw, int NGW, int lane) {
#pragma unroll 2
    for (int row = gw; row < NEXP; row += NGW) {
        f32x4 v[8]; float am = 0.f;
#pragma unroll
        for (int j = 0; j < 8; ++j) { v[j] = __builtin_nontemporal_load((const f32x4*)(src + (size_t)row * DM) + lane + 64 * j); am = fmaxf(am, fmaxf(fmaxf(fabsf(v[j][0]), fabsf(v[j][1])), fmaxf(fabsf(v[j][2]), fabsf(v[j][3])))); }
        const float rowmax = wave_maxf(am), inv8 = rowmax > 0.f ? 127.f / rowmax : 0.f;
#pragma unroll
        for (int j = 0; j < 8; ++j) {
            unsigned w8 = 0;
#pragma unroll
            for (int i = 0; i < 4; ++i) { const int q = (int)rintf(v[j][i] * inv8); w8 |= ((unsigned)q & 0xffu) << (8 * i); }
            *((unsigned*)(d8 + (size_t)row * DM) + lane + 64 * j) = w8;
            float gm = fmaxf(fmaxf(fabsf(v[j][0]), fabsf(v[j][1])), fmaxf(fabsf(v[j][2]), fabsf(v[j][3])));
            gm = fmaxf(gm, __shfl_xor(gm, 1)); gm = fmaxf(gm, __shfl_xor(gm, 2)); gm = fmaxf(gm, __shfl_xor(gm, 4));
            const unsigned sb = f2bf(gm * (1.f / 7.f)); const float s = __uint_as_float(sb << 16), inv = s > 0.f ? __builtin_amdgcn_rcpf(s) : 0.f;
            unsigned w = 0;
#pragma unroll
            for (int i = 0; i < 4; ++i) { const int q = (int)fminf(fmaxf(rintf(v[j][i] * inv), -7.f), 7.f) + 8; w |= (unsigned)q << (4 * i); }
            const int grp = j * 8 + (lane >> 3);
            *(unsigned short*)(d4 + (size_t)row * V4_ROW + grp * 16 + (lane & 7) * 2) = (unsigned short)w;
            if ((lane & 7) == 0) *(unsigned short*)(d4 + (size_t)row * V4_ROW + 1024 + grp * 2) = (unsigned short)sb;
        }
        if (lane == 0) scale[row] = rowmax * (1.f / 127.f);
    }
}

DI void phase_peer_gather(Frame& F, int emask = 0x3fff, int vmask = 0x3fff) {
    const bf16* H2 = (const bf16*)(F.ws + WS_H2);
    const unsigned char* U8 = F.ws + WS_U8; const unsigned char* U4 = F.ws + WS_U4; const unsigned char* V4 = F.ws + WS_V8; const float* SU = (const float*)(F.ws + WS_SU);
    const int* EXPI = (const int*)(F.ws + WS_EXPI); const float* EXPG = (const float*)(F.ws + WS_EXPG);
    const bf16* X1 = (const bf16*)(F.ws + WS_X1); const float* MOD = (const float*)(F.ws + WS_MOD); const int lane = F.lane;
    LAS float* la = (LAS float*)(F.lds + F.wave * 1024);
    LAS int* li = (LAS int*)(F.lds + F.wave * 1024 + 512);
    const int eloc = ((lane >> 5) & 1) * 4 + ((lane >> 4) & 1) * 2 + ((lane >> 3) & 1);
#ifdef GATHER_SUBSET
    if ((blockIdx.x >> 3) % GATHER_SUBSET != 0) return;
    const int gw_ = ((blockIdx.x >> 3) / GATHER_SUBSET * 8 + (blockIdx.x & 7)) * NWAVES + F.wave, ngw_ = F.NGW / GATHER_SUBSET;
#else
    const int gw_ = F.gw, ngw_ = F.NGW;
#endif
    for (int t = gw_; t < NT; t += ngw_) {
        float xf[2][16]; float am = 0.f;
#pragma unroll
        for (int j = 0; j < 2; ++j) {
            const u32x4 w0 = *((const u32x4*)(H2 + (size_t)t * DM) + 2 * (lane + 64 * j)), w1 = *((const u32x4*)(H2 + (size_t)t * DM) + 2 * (lane + 64 * j) + 1);
            xf[j][0] = bflo(w0.x); xf[j][1] = bfhi(w0.x); xf[j][2] = bflo(w0.y); xf[j][3] = bfhi(w0.y); xf[j][4] = bflo(w0.z); xf[j][5] = bfhi(w0.z); xf[j][6] = bflo(w0.w); xf[j][7] = bfhi(w0.w);
            xf[j][8] = bflo(w1.x); xf[j][9] = bfhi(w1.x); xf[j][10] = bflo(w1.y); xf[j][11] = bfhi(w1.y); xf[j][12] = bflo(w1.z); xf[j][13] = bfhi(w1.z); xf[j][14] = bflo(w1.w); xf[j][15] = bfhi(w1.w);
#pragma unroll
            for (int i = 0; i < 16; ++i) am = fmaxf(am, fabsf(xf[j][i]));
        }
        am = wave_maxf(am);
        const float inv = am > 0.f ? 127.f / am : 0.f, sx = am * (1.f / 127.f);
        int xq[2][4];
#pragma unroll
        for (int j = 0; j < 2; ++j)
#pragma unroll
            for (int k = 0; k < 4; ++k) {
                unsigned w = 0;
#pragma unroll
                for (int i = 0; i < 4; ++i) w |= ((unsigned)(int)rintf(xf[j][4 * k + i] * inv) & 0xffu) << (8 * i);
                xq[j][k] = (int)w;
            }
        int xe[4], xo[4], xsum4 = 0;
#pragma unroll
        for (int d = 0; d < 4; ++d) {
            const u32x4 w = *((const u32x4*)(H2 + (size_t)t * DM + 32 * lane) + d);
            int q[8];
#pragma unroll
            for (int i = 0; i < 4; ++i) { q[2 * i] = (int)rintf(bflo(w[i]) * inv); q[2 * i + 1] = (int)rintf(bfhi(w[i]) * inv); }
            xe[d] = (int)(((unsigned)q[0] & 0xffu) | (((unsigned)q[2] & 0xffu) << 8) | (((unsigned)q[4] & 0xffu) << 16) | (((unsigned)q[6] & 0xffu) << 24));
            xo[d] = (int)(((unsigned)q[1] & 0xffu) | (((unsigned)q[3] & 0xffu) << 8) | (((unsigned)q[5] & 0xffu) << 16) | (((unsigned)q[7] & 0xffu) << 24));
#pragma unroll
            for (int i = 0; i < 8; ++i) xsum4 += q[i];
        }
        float asum = 0.f;
        const int ei0 = EXPI[(size_t)t * 128 + lane] & emask, ei1 = EXPI[(size_t)t * 128 + 64 + lane] & emask;
        const float eg0 = EXPG[(size_t)t * 128 + lane], eg1 = EXPG[(size_t)t * 128 + 64 + lane];
        u32x4 wa0[8], wa1[8], wb[8]; unsigned short sbh[8];
#define ULOADA(hd_) do { const int eis_ = (hd_) < 4 ? ei0 : ei1, base_ = ((hd_) & 3) * 16; \
            _Pragma("unroll") for (int e = 0; e < 8; ++e) { const int idx_ = __builtin_amdgcn_readlane(eis_, base_ + e); const u32x4* ur_ = (const u32x4*)(U8 + (size_t)idx_ * DM); wa0[e] = ur_[lane]; wa1[e] = ur_[lane + 64]; } } while (0)
#define ULOADB(hd_) do { const int eis_ = (hd_) < 4 ? ei0 : ei1, base_ = ((hd_) & 3) * 16 + 8; \
            _Pragma("unroll") for (int e = 0; e < 8; ++e) { const int idx_ = __builtin_amdgcn_readlane(eis_, base_ + e); const unsigned char* u4_ = U4 + (size_t)idx_ * V4_ROW; wb[e] = *(const u32x4*)(u4_ + 16 * lane); sbh[e] = *(const unsigned short*)(u4_ + 1024 + 2 * lane); } } while (0)
#define ULOADA_NEXT(hd_) do { const int h_ = (hd_); const int eis_ = (h_ & 4) ? ei1 : ei0, base_ = (h_ & 3) * 16, msk_ = h_ < 8 ? -1 : 0; \
            _Pragma("unroll") for (int e = 0; e < 8; ++e) { const int idx_ = __builtin_amdgcn_readlane(eis_, base_ + e) & msk_; const u32x4* ur_ = (const u32x4*)(U8 + (size_t)idx_ * DM); wa0[e] = ur_[lane]; wa1[e] = ur_[lane + 64]; } } while (0)
        ULOADA(0);
#pragma unroll 1
        for (int hd = 0; hd < 8; ++hd) {
            const int eisel = hd < 4 ? ei0 : ei1; const float egsel = hd < 4 ? eg0 : eg1;
            const int base = (hd & 3) * 16;
            const int myidxA = __shfl(eisel, base + eloc), myidxB = __shfl(eisel, base + 8 + eloc);
            const float mygA = __shfl(egsel, base + eloc), mygB = __shfl(egsel, base + 8 + eloc);
            const float mysu = SU[myidxA];
            ULOADB(hd);
            float accA[8], accB[8];
#pragma unroll
            for (int e = 0; e < 8; ++e) {
                int a = __builtin_amdgcn_sdot4((int)wa0[e].x, xq[0][0], 0, false); a = __builtin_amdgcn_sdot4((int)wa0[e].y, xq[0][1], a, false);
                a = __builtin_amdgcn_sdot4((int)wa0[e].z, xq[0][2], a, false); a = __builtin_amdgcn_sdot4((int)wa0[e].w, xq[0][3], a, false);
                a = __builtin_amdgcn_sdot4((int)wa1[e].x, xq[1][0], a, false); a = __builtin_amdgcn_sdot4((int)wa1[e].y, xq[1][1], a, false);
                a = __builtin_amdgcn_sdot4((int)wa1[e].z, xq[1][2], a, false); a = __builtin_amdgcn_sdot4((int)wa1[e].w, xq[1][3], a, false);
                accA[e] = (float)a;
            }
            __builtin_amdgcn_sched_barrier(0);
            ULOADA_NEXT(hd + 1);
#pragma unroll
            for (int e = 0; e < 8; ++e) {
                int b = 0;
#pragma unroll
                for (int d = 0; d < 4; ++d) { b = __builtin_amdgcn_sdot4((int)(wb[e][d] & 0x0F0F0F0Fu), xe[d], b, false); b = __builtin_amdgcn_sdot4((int)((wb[e][d] >> 4) & 0x0F0F0F0Fu), xo[d], b, false); }
                accB[e] = (float)(b - 8 * xsum4) * bf2f(sbh[e]);
            }
            float rA, rB;
            {
                float r4[4], r2[2], s4[4], s2[2];
#pragma unroll
                for (int i = 0; i < 4; ++i) {
                    const float sndA = (lane & 32) ? accA[i] : accA[i + 4], kpA = (lane & 32) ? accA[i + 4] : accA[i]; r4[i] = kpA + __shfl_xor(sndA, 32);
                    const float sndB = (lane & 32) ? accB[i] : accB[i + 4], kpB = (lane & 32) ? accB[i + 4] : accB[i]; s4[i] = kpB + __shfl_xor(sndB, 32); }
#pragma unroll
                for (int i = 0; i < 2; ++i) {
                    const float sndA = (lane & 16) ? r4[i] : r4[i + 2], kpA = (lane & 16) ? r4[i + 2] : r4[i]; r2[i] = kpA + __shfl_xor(sndA, 16);
                    const float sndB = (lane & 16) ? s4[i] : s4[i + 2], kpB = (lane & 16) ? s4[i + 2] : s4[i]; s2[i] = kpB + __shfl_xor(sndB, 16); }
                { const float sndA = (lane & 8) ? r2[0] : r2[1], kpA = (lane & 8) ? r2[1] : r2[0]; rA = kpA + __shfl_xor(sndA, 8);
                  const float sndB = (lane & 8) ? s2[0] : s2[1], kpB = (lane & 8) ? s2[1] : s2[0]; rB = kpB + __shfl_xor(sndB, 8); }
                rA += __shfl_xor(rA, 4); rA += __shfl_xor(rA, 2); rA += __shfl_xor(rA, 1);
                rB += __shfl_xor(rB, 4); rB += __shfl_xor(rB, 2); rB += __shfl_xor(rB, 1);
            }
            const float aA = gelu_erf(rA * mysu * sx) * mygA, aB = gelu_erf(rB * sx) * mygB;
            if ((lane & 7) == 0) { la[hd * 16 + eloc] = aA; li[hd * 16 + eloc] = myidxA & vmask; la[hd * 16 + 8 + eloc] = aB; li[hd * 16 + 8 + eloc] = myidxB & vmask; asum += aA + aB; }
        }
#undef ULOADA
#undef ULOADA_NEXT
#undef ULOADB
        asum = wave_sum(asum);
        asm volatile("s_waitcnt lgkmcnt(0)" ::: "memory");
        f32x2 o2[16]; float csum = 0.f;
#pragma unroll
        for (int i = 0; i < 16; ++i) o2[i] = (f32x2){0.f, 0.f};
#pragma unroll 16
        for (int e = 0; e < 128; ++e) {
            const int idx = __builtin_amdgcn_readfirstlane(li[e]); const float a = __uint_as_float((unsigned)__builtin_amdgcn_readfirstlane((int)__float_as_uint(la[e])));
            const unsigned char* vr = V4 + (size_t)idx * V4_ROW;
            const u32x4 w = *(const u32x4*)(vr + 16 * lane);
            const float as = a * bf2f(*(const unsigned short*)(vr + 1024 + 2 * lane));
            csum += as;
            const f32x2 as2 = {as, as};
#pragma unroll
            for (int d = 0; d < 4; ++d) {
                const unsigned lo = w[d] & 0x0F0F0F0Fu, hi = (w[d] >> 4) & 0x0F0F0F0Fu;
                o2[4 * d + 0] = __builtin_elementwise_fma(as2, (f32x2){ub0(lo), ub0(hi)}, o2[4 * d + 0]); o2[4 * d + 1] = __builtin_elementwise_fma(as2, (f32x2){ub1(lo), ub1(hi)}, o2[4 * d + 1]);
                o2[4 * d + 2] = __builtin_elementwise_fma(as2, (f32x2){ub2(lo), ub2(hi)}, o2[4 * d + 2]); o2[4 * d + 3] = __builtin_elementwise_fma(as2, (f32x2){ub3(lo), ub3(hi)}, o2[4 * d + 3]);
            }
        }
        float o[32];
#pragma unroll
        for (int i = 0; i < 16; ++i) { o[2 * i] = o2[i][0]; o[2 * i + 1] = o2[i][1]; }
        LAS float* tp = (LAS float*)(F.lds + 8192 + F.wave * 9216);
        const float corr = 8.f * csum;
#pragma unroll
        for (int k = 0; k < 8; ++k) { f32x4 v; v[0] = o[4 * k] - corr; v[1] = o[4 * k + 1] - corr; v[2] = o[4 * k + 2] - corr; v[3] = o[4 * k + 3] - corr; *(LAS f32x4*)(tp + lane * 36 + 4 * k) = v; }
        asm volatile("s_waitcnt lgkmcnt(0)" ::: "memory");
        const float* g2 = MOD + (size_t)(t >> 12) * 12288 + 5 * 2048;
        f32x4 x2[8]; float ss = 0.f;
#pragma unroll
        for (int j = 0; j < 8; ++j) {
            const int ch = lane + 64 * j;
            const f32x4 pv = *(const LAS f32x4*)(tp + (ch >> 3) * 36 + 4 * (ch & 7));
            const u32x2 xw = __builtin_nontemporal_load((const u32x2*)(X1 + (size_t)t * DM) + ch); const f32x4 xa = {bflo(xw.x), bfhi(xw.x), bflo(xw.y), bfhi(xw.y)}, ga = *((const f32x4*)g2 + ch);
            x2[j] = xa + ga * pv;
            ss += (x2[j][0] * x2[j][0] + x2[j][1] * x2[j][1]) + (x2[j][2] * x2[j][2] + x2[j][3] * x2[j][3]);
        }
        const float rstd = rsqrtf(wave_sum(ss) * (1.f / DM) + EPS);
        const float* fw = F.in[22];
#pragma unroll
        for (int j = 0; j < 8; ++j) { const int ch = lane + 64 * j; const f32x4 wa = *((const f32x4*)fw + ch); __builtin_nontemporal_store(x2[j] * rstd * wa, (f32x4*)(F.out + (size_t)t * DM) + ch); }
        asm volatile("s_waitcnt lgkmcnt(0)" ::: "memory");
    }
}

DI void phase_h2(Frame& F) {
    const float* MOD = (const float*)(F.ws + WS_MOD); bf16* H2 = (bf16*)(F.ws + WS_H2); const bf16* X1 = (const bf16*)(F.ws + WS_X1);
    for (int m = F.gw; m < NT; m += F.NGW) {
        const int r = m >> 12;
        modnorm_row_bf(X1 + (size_t)m * DM, H2 + (size_t)m * DM, F.in[7], MOD + (size_t)r * 12288 + 4 * 2048, MOD + (size_t)r * 12288 + 3 * 2048, F.lane);
    }
}


DI void phase_quant(Frame& F) {
#ifndef REP_QUANT
#define REP_QUANT 1
#endif
#pragma nounroll
    for (int rq = 0; rq < REP_QUANT; ++rq) {
    quant_u_both(F.in[20], F.ws + WS_U8, (float*)(F.ws + WS_SU), F.ws + WS_U4, F.gw, F.NGW, F.lane);
    quant_rows_i4(F.in[21], F.ws + WS_V8, F.gw, F.NGW, F.lane);
    }
}

struct Args { const float* in[23]; float* out; unsigned char* ws; int ph_lo, ph_hi; };
static_assert(sizeof(Args) == 23 * 8 + 8 + 8 + 8, "Args has no padding");

__global__ void __launch_bounds__(NWAVES * 64, 2) mk_fwd(Args args) {
    extern __shared__ __attribute__((aligned(16))) unsigned char lds[];
    Frame F;
    F.lds = (LAS unsigned char*)lds; F.ws = args.ws; F.out = args.out;
#pragma unroll
    for (int i = 0; i < 23; ++i) F.in[i] = args.in[i];
    F.tid = threadIdx.x; F.lane = F.tid & 63; F.wave = __builtin_amdgcn_readfirstlane(F.tid >> 6);
    F.G = gridDim.x; { const int bx = blockIdx.x; F.vcu = (F.G % 8 == 0) ? (bx % 8) * (F.G / 8) + bx / 8 : bx; }
    F.gw = F.vcu * NWAVES + F.wave; F.NGW = F.G * NWAVES;
    const int lo = args.ph_lo, hi = args.ph_hi;
#ifndef REP_PHASE
#define REP_PHASE (-1)
#endif
#define IN(k) (lo <= (k) && (k) < hi)
#ifndef REP_MASK
#define REP_MASK 0
#endif
#define RP(k) _Pragma("nounroll") for (int rep_ = 0; rep_ < ((REP_PHASE == (k) || ((REP_MASK >> (k)) & 1)) ? 2 : 1); ++rep_)
    constexpr int CW_BAR = 4096;
    volatile LAS unsigned* bst = (volatile LAS unsigned*)(F.lds + LDS_BYTES - 64);
    if (F.tid < 16) bst[F.tid] = 0u;
    __syncthreads();
    XcdBarrier bar; bar.bar = (unsigned*)(F.ws + WS_CTL) + CW_BAR; bar.x = 0; bar.st = nullptr;
    if (hi - lo > 1) bar = xcd_barrier_post((unsigned*)(F.ws + WS_CTL) + CW_BAR, bst);
#define SEAM(k) do { if (IN(k) && IN((k) + 1)) { if ((k) == 0) cg::this_grid().sync(); else xcd_barrier(bar); } } while (0)

    if (IN(0)) RP(0) { phase_prologue(F); __syncthreads(); }
    SEAM(0);
    if (IN(1)) RP(1) phase_modreduce(F);
    SEAM(1);
    if (IN(2)) RP(2) phase_h1(F);
    SEAM(2);
    if (IN(3)) RP(3) {
        pg8::Gemm g{(const bf16*)(F.ws + WS_H), (const bf16*)(F.ws + WS_WIN), MTOT, NPROJ, DM / 2}; InProjOrder S; S.init(F.G, (int)blockIdx.x);
        EpiInProj E{F.ws, F.in[12], F.in[13]};
        pg8::gemm_phase<EpiInProj, InProjOrder, true, true, true>(F.lds, g, S, E);
    }
    SEAM(3);
    if (IN(4)) phase_postproj(F);
    SEAM(4);
#ifdef DN_NAIVE
    if (IN(5)) phase_dn_naive(F);
    SEAM(5);
    if (IN(6)) phase_attention(F, (char*)lds);
#else
    if (IN(5)) RP(5) phase_dn_prep(F);
    SEAM(5);
    if (IN(6)) { RP(14) { phase_dn_scan(F); __syncthreads(); } phase_attention(F, (char*)lds); }
#endif
    SEAM(6);
    if (IN(7)) phase_mergeprep(F);
    SEAM(7);
    if (IN(8)) RP(8) {
#if MERGE_F8_A || MERGE_F8_B || defined(MERGE_TWO_PASS)
        pg8::StaticOrder S; S.init(NT, DM, F.G, (int)blockIdx.x);
        { pg8::Gemm g{(const bf16*)(F.ws + (MERGE_F8_A ? WS_OATT8 : WS_QN)), (const bf16*)(F.ws + WS_WBA), NT, DM, MERGE_F8_A ? 512 : 1024};
          EpiMerge<false> E{(bf16*)(F.ws + WS_Y), (const unsigned char*)(F.ws + WS_G), 0, MERGE_F8_A ? 1.f / (255.f * WB_SCALE * OATT_SCALE) : 1.f / 255.f};
          pg8::gemm_phase<EpiMerge<false>, pg8::StaticOrder, true, true, MERGE_F8_A != 0>(F.lds, g, S, E); }
        __syncthreads();
        { pg8::Gemm g{(const bf16*)(F.ws + (MERGE_F8_B ? WS_ODNN8 : WS_Z)), (const bf16*)(F.ws + WS_WBD), NT, DM, MERGE_F8_B ? 512 : 1024};
          EpiMerge<true> E{(bf16*)(F.ws + WS_Y), (const unsigned char*)(F.ws + WS_G), 2048, MERGE_F8_B ? 1.f / (255.f * WB_SCALE * ODNN_SCALE) : 1.f / 255.f};
          pg8::gemm_phase<EpiMerge<true>, pg8::StaticOrder, true, true, MERGE_F8_B != 0>(F.lds, g, S, E); }
#else
        pg8::TwoStageOrder S; S.init(NT, DM, F.G, (int)blockIdx.x);
        pg8::Gemm g{(const bf16*)(F.ws + WS_QN), (const bf16*)(F.ws + WS_WBA), NT, DM, 1024, (const bf16*)(F.ws + WS_Z), (const bf16*)(F.ws + WS_WBD)};
        EpiMerge2 E{(bf16*)(F.ws + WS_Y), (const unsigned char*)(F.ws + WS_G)};
        pg8::gemm_phase<EpiMerge2, pg8::TwoStageOrder, true, true>(F.lds, g, S, E);
#endif
    }
    SEAM(8);
    if (IN(9)) RP(9) {
        pg8::Gemm g{(const bf16*)(F.ws + WS_Y), (const bf16*)(F.ws + WS_WOUT), NT, DM, DM}; pg8::StaticOrder S; S.init(NT, DM, F.G, (int)blockIdx.x);
        EpiResid E{F.in[0], (bf16*)(F.ws + WS_X1), (const float*)(F.ws + WS_MOD)};
        pg8::gemm_phase<EpiResid, pg8::StaticOrder, true, true>(F.lds, g, S, E);
    }
    SEAM(9);
    if (IN(10)) RP(10) phase_h2(F);
    SEAM(10);
    if (IN(11)) RP(11) {
        pg8::Gemm g{(const bf16*)(F.ws + WS_H2), (const bf16*)(F.ws + WS_WQ), NT, DM, DM}; pg8::StaticOrder S; S.init(NT, DM, F.G, (int)blockIdx.x);
        EpiPlain E{(bf16*)(F.ws + WS_PQ), 2048};
        pg8::gemm_phase<EpiPlain, pg8::StaticOrder, true, true>(F.lds, g, S, E);
    }
    SEAM(11);
    if (IN(12)) { RP(12) { phase_peer_topk(F); __syncthreads(); } phase_quant(F); }
    SEAM(12);
#ifdef GATHER_PROBE_MASK
    if (IN(13)) {
#pragma nounroll
        for (int rep_ = 0; rep_ < 2; ++rep_) { phase_peer_gather(F, rep_ == 0 ? GATHER_PROBE_MASK : 0x3fff, rep_ == 0 ? GATHER_PROBE_VMASK : 0x3fff); __syncthreads(); }
    }
#else
    if (IN(13)) RP(13) phase_peer_gather(F);
#endif
#undef IN
#undef SEAM
}

extern "C" void kernel_launch(void* const* d_in, const int* in_sizes, int n_in, void* d_out, int out_size, void* d_ws, size_t ws_size, hipStream_t stream) {
    static int grid = 0;
    if (grid == 0) {
        if (n_in != 23 || in_sizes[0] != NT * DM || out_size != NT * DM || ws_size < WS_END) {
            fprintf(stderr, "kernel_launch: unexpected shapes (n_in %d, in0 %d, out %d, ws %zu < %zu); nothing launched\n", n_in, n_in > 0 ? in_sizes[0] : -1, out_size, ws_size, (size_t)WS_END);
            grid = -1; return; }
        int dev = 0, cus = 0, per_cu = 0;
        if (hipGetDevice(&dev) != hipSuccess || hipDeviceGetAttribute(&cus, hipDeviceAttributeMultiprocessorCount, dev) != hipSuccess) { grid = -1; return; }
        if (hipFuncSetAttribute((const void*)mk_fwd, hipFuncAttributeMaxDynamicSharedMemorySize, LDS_BYTES) != hipSuccess) { fprintf(stderr, "kernel_launch: hipFuncSetAttribute failed\n"); grid = -1; return; }
        if (hipOccupancyMaxActiveBlocksPerMultiprocessor(&per_cu, (const void*)mk_fwd, NWAVES * 64, LDS_BYTES) != hipSuccess || per_cu < 1) { fprintf(stderr, "kernel_launch: occupancy query says %d blocks per CU\n", per_cu); (void)hipGetLastError(); grid = -1; return; }
        grid = cus;
    }
    if (grid < 0) return;
    (void)hipMemsetAsync((char*)d_ws + WS_CTL, 0, 1 * MiB, stream);
    Args a{};
    for (int i = 0; i < 23; ++i) a.in[i] = (const float*)d_in[i];
    a.out = (float*)d_out; a.ws = (unsigned char*)d_ws;
#if MK_N_LAUNCHES == 1
    a.ph_lo = 0; a.ph_hi = NPHASE;
    void* kargs[] = {(void*)&a};
    const hipError_t e = hipLaunchCooperativeKernel((const void*)mk_fwd, dim3(grid), dim3(NWAVES * 64), kargs, LDS_BYTES, stream);
    if (e != hipSuccess) fprintf(stderr, "kernel_launch: cooperative launch failed: %s (grid %d)\n", hipGetErrorString(e), grid);
#else
    for (int p = 0; p < NPHASE; ++p) {
        a.ph_lo = p; a.ph_hi = p + 1;
        hipLaunchKernelGGL(mk_fwd, dim3(grid), dim3(NWAVES * 64), LDS_BYTES, stream, a);
    }
    const hipError_t le = hipPeekAtLastError();
    if (le != hipSuccess) fprintf(stderr, "kernel_launch: launch failed: %s\n", hipGetErrorName(le));
#endif
}
```

```cpp
#define DN_SLEEP 0

#include <hip/hip_runtime.h>
#include <hip/hip_cooperative_groups.h>
#include <cstdio>
#include <cstdint>
namespace cg = cooperative_groups;

#ifndef MK_N_LAUNCHES
#define MK_N_LAUNCHES 1
#endif
namespace pg8 {
#define PG8_LAS __attribute__((address_space(3)))
typedef unsigned short bf16_t;
typedef short bf16x8 __attribute__((ext_vector_type(8)));
typedef float f32x4 __attribute__((ext_vector_type(4)));
typedef int pg8_v4i __attribute__((ext_vector_type(4)));
typedef int pg8_v8i __attribute__((ext_vector_type(8)));
typedef unsigned u32x4 __attribute__((ext_vector_type(4)));
constexpr int BM = 256, BK = 64, HALF = 128, HTB = HALF * BK * 2  , STAGE_BYTES = 8 * HTB, NXCD = 8, WGM = 8;

__host__ __device__ __forceinline__ int lds_byte(int r, int c) { const int st = (r >> 4) * 2 + (c >> 5), rr = r & 15, cc = c & 31, ob = rr * 64 + cc * 2; return st * 1024 + (ob ^ (((ob >> 9) & 1) << 5)); }
__host__ __device__ __forceinline__ void stage_rc(int b, int& R, int& C) { const int st = b / 1024, sb = b % 1024, swz = sb ^ (((sb >> 9) & 1) << 5); R = (st >> 1) * 16 + swz / 64; C = (st & 1) * 32 + (swz % 64) / 2; }
__host__ __device__ __forceinline__ int perm32(int rho) { const int n = rho >> 4, i = rho & 15; return 8 * (i >> 2) + 4 * n + (i & 3); }

struct Unit { int pm, pn, sel; };
struct Gemm { const bf16_t* A; const bf16_t* Bt; int M, N, K; const bf16_t* A2 = nullptr; const bf16_t* Bt2 = nullptr; };

struct StaticOrder {
    int nM, nN, nwg, G, c;
    __host__ __device__ void init(int M, int N, int G_, int c_) { nM = M / BM; nN = N / BM; nwg = nM * nN; G = G_; c = c_; }
    __host__ __device__ bool next(int i, Unit& u) const {
        const long L = (long)i * G + c; if (L >= nwg) return false;
        int wgid = (int)L; { const int q = nwg / NXCD, r = nwg % NXCD, xcd = wgid % NXCD, off = wgid / NXCD; wgid = (xcd < r ? xcd * (q + 1) : r * (q + 1) + (xcd - r) * q) + off; }
        const int nig = WGM * nN, gid = wgid / nig, fm = gid * WGM, gsz = (nM - fm) < WGM ? (nM - fm) : WGM;
        u.pm = fm + ((wgid % nig) % gsz); u.pn = (wgid % nig) / gsz; return true;
    }
    __device__ __forceinline__ void a_ready(const Unit&) const {}
    __device__ __forceinline__ void done(const Unit&) const {}
};
struct TwoStageOrder {
    StaticOrder base;
    __host__ __device__ void init(int M, int N, int G_, int c_) { base.init(M, N, G_, c_); }
    __host__ __device__ bool next(int i, Unit& u) const { if (!base.next(i >> 1, u)) return false; u.sel = i & 1; return true; }
    __device__ __forceinline__ void a_ready(const Unit&) const {}
    __device__ __forceinline__ void done(const Unit&) const {}
};

__device__ __forceinline__ unsigned cvt_pk_bf16(float lo, float hi) { unsigned r; asm volatile("v_cvt_pk_bf16_f32 %0, %1, %2" : "=v"(r) : "v"(lo), "v"(hi)); return r; }
typedef float f32x2 __attribute__((ext_vector_type(2)));
template <class Epi, class Sched, bool ALIGN_EPI = false, bool SP2 = false, bool F8 = false>
__device__ __forceinline__ void gemm_phase(PG8_LAS unsigned char* lds, const Gemm g, const Sched& S, const Epi& E) {
    const int tid = threadIdx.x, wid = __builtin_amdgcn_readfirstlane(tid >> 6), lane = tid & 63, wr = wid >> 2, wc = wid & 3, fr = lane & 15, fq = lane >> 4;
    const int K = g.K, nt = K / BK;
    unsigned voffA[2], voffB[2];
#pragma unroll
    for (int i = 0; i < 2; ++i) { int R, C; stage_rc(tid * 16 + i * 8192, R, C); const int Rb = Epi::PERM ? ((R & ~31) + perm32(R & 31)) : R;
        voffA[i] = (unsigned)(R * K + C) * 2u; voffB[i] = (unsigned)(Rb * K + C) * 2u; }
    const size_t kstep = (size_t)(BK * 2);
    const size_t hstep = (size_t)HALF * K * 2;
    const size_t tstep = 2 * hstep;
    const unsigned ldsw = (unsigned)wid * 1024u;
    const int aoff = lds_byte(wr * 64 + fr, fq * 8), boff = lds_byte(wc * 32 + fr, fq * 8);
#define PG8_SA(b, h) (((b) * 2 + (h)) * HTB)
#define PG8_SB(b, h) ((4 + (b) * 2 + (h)) * HTB)
#define PG8_STAGE(bufoff, gbase, voff) do { _Pragma("unroll") for (int _i = 0; _i < 2; ++_i) \
        __builtin_amdgcn_global_load_lds((const unsigned*)((const char*)(gbase) + (voff)[_i]), (PG8_LAS unsigned*)(lds + (bufoff) + ldsw + _i * 8192), 16, 0, 0); } while (0)
#define PG8_LDA(dst, b, h) do { _Pragma("unroll") for (int m = 0; m < 4; ++m) { \
        if constexpr (F8) { const pg8_v4i t0_ = *(const PG8_LAS pg8_v4i*)(lds + PG8_SA(b, h) + aoff + m * 2048), t1_ = *(const PG8_LAS pg8_v4i*)(lds + PG8_SA(b, h) + aoff + m * 2048 + 1024); \
            dst##8[m] = __builtin_shufflevector(t0_, t1_, 0, 1, 2, 3, 4, 5, 6, 7); } \
        else { _Pragma("unroll") for (int k = 0; k < 2; ++k) dst[m][k] = *(const PG8_LAS bf16x8*)(lds + PG8_SA(b, h) + aoff + m * 2048 + k * 1024); } } } while (0)
#define PG8_LDB(dst, b, h) do { _Pragma("unroll") for (int n = 0; n < 2; ++n) { \
        if constexpr (F8) { const pg8_v4i t0_ = *(const PG8_LAS pg8_v4i*)(lds + PG8_SB(b, h) + boff + n * 2048), t1_ = *(const PG8_LAS pg8_v4i*)(lds + PG8_SB(b, h) + boff + n * 2048 + 1024); \
            dst##8[n] = __builtin_shufflevector(t0_, t1_, 0, 1, 2, 3, 4, 5, 6, 7); } \
        else { _Pragma("unroll") for (int k = 0; k < 2; ++k) dst[n][k] = *(const PG8_LAS bf16x8*)(lds + PG8_SB(b, h) + boff + n * 2048 + k * 1024); } } } while (0)
#define PG8_MMA(ai, bj, At, Bt) do { __builtin_amdgcn_s_setprio(1); _Pragma("unroll") for (int m = 0; m < 4; ++m) _Pragma("unroll") for (int n = 0; n < 2; ++n) { \
        if constexpr (F8) { asm volatile("v_mfma_scale_f32_16x16x128_f8f6f4 %0, %1, %2, %0, %3, %3 op_sel_hi:[0,0,0]" : "+v"(acc[ai][bj][m][n]) : "v"(Bt##8[n]), "v"(At##8[m]), "v"(0x7F7F7F7F)); } \
        else { _Pragma("unroll") for (int k = 0; k < 2; ++k) acc[ai][bj][m][n] = __builtin_amdgcn_mfma_f32_16x16x32_bf16(Bt[n][k], At[m][k], acc[ai][bj][m][n], 0, 0, 0); } } \
        __builtin_amdgcn_s_setprio(0); } while (0)
#define PG8_WAIT_V(n) asm volatile("s_waitcnt vmcnt(" #n ")" ::: "memory")
#define PG8_WAIT_L(n) asm volatile("s_waitcnt lgkmcnt(" #n ")" ::: "memory")
#define PG8_BAR __builtin_amdgcn_s_barrier()
#define PG8_SCHED __builtin_amdgcn_sched_barrier(0)
    Unit cur, nxt; int ui = 0;
    if (!S.next(0, cur)) return;
    f32x4 acc[2][2][4][2];
#pragma unroll
    for (int a = 0; a < 2; ++a)
#pragma unroll
        for (int b = 0; b < 2; ++b)
#pragma unroll
            for (int m = 0; m < 4; ++m)
#pragma unroll
                for (int n = 0; n < 2; ++n) acc[a][b][m][n] = (f32x4){0.f, 0.f, 0.f, 0.f};
    bf16x8 At[4][2], B0[2][2], B1[2][2];
    pg8_v8i At8[4], B08[2], B18[2];
    const char* cA = (const char*)g.A + (size_t)cur.pm * tstep; const char* cB = (const char*)g.Bt + (size_t)cur.pn * tstep;
    S.a_ready(cur);
    if constexpr (SP2) {
        PG8_STAGE(PG8_SB(0, 0), cB, voffB); PG8_STAGE(PG8_SB(0, 1), cB + hstep, voffB); PG8_STAGE(PG8_SA(0, 0), cA, voffA); PG8_STAGE(PG8_SA(0, 1), cA + hstep, voffA);
        if (wr == 1) PG8_BAR;
        PG8_WAIT_V(2); PG8_BAR;
        PG8_STAGE(PG8_SB(1, 0), cB + kstep, voffB); PG8_STAGE(PG8_SA(1, 0), cA + kstep, voffA); PG8_STAGE(PG8_SB(1, 1), cB + hstep + kstep, voffB);
        PG8_WAIT_V(6); PG8_BAR;
    } else {
        PG8_STAGE(PG8_SB(0, 0), cB, voffB); PG8_STAGE(PG8_SA(0, 0), cA, voffA); PG8_STAGE(PG8_SB(0, 1), cB + hstep, voffB); PG8_STAGE(PG8_SA(0, 1), cA + hstep, voffA);
        if (wr == 1) PG8_BAR;
        PG8_WAIT_V(4); PG8_BAR;
        PG8_STAGE(PG8_SB(1, 0), cB + kstep, voffB); PG8_STAGE(PG8_SA(1, 0), cA + kstep, voffA); PG8_STAGE(PG8_SB(1, 1), cB + hstep + kstep, voffB);
        PG8_WAIT_V(6); PG8_BAR;
    }
    for (;;) {
        const bool has_next = S.next(ui + 1, nxt);
        const bf16_t* gA = g.A; const bf16_t* gB = g.Bt;
        if constexpr (Epi::TWO_STAGE) { if (has_next && nxt.sel) { gA = g.A2; gB = g.Bt2; } }
        const char* nA = has_next ? (const char*)gA + (size_t)nxt.pm * tstep : cA; const char* nB = has_next ? (const char*)gB + (size_t)nxt.pn * tstep : cB;
        for (int t = 0; t < nt; t += 2) {
            const bool last = (t == nt - 2);
            const char* a1 = cA + (size_t)(t + 1) * kstep;
            const char* a2 = last ? nA : cA + (size_t)(t + 2) * kstep; const char* b2 = last ? nB : cB + (size_t)(t + 2) * kstep;
            const char* a3 = a2 + kstep; const char* b3 = b2 + kstep;
            if (last && has_next) S.a_ready(nxt);
            if constexpr (SP2) {
            PG8_LDB(B0, 0, 0); PG8_LDB(B1, 0, 1); PG8_SCHED; PG8_LDA(At, 0, 0); PG8_STAGE(PG8_SA(1, 1), a1 + hstep, voffA);
            PG8_WAIT_V(8); PG8_WAIT_L(0); PG8_BAR; PG8_MMA(0, 0, At, B0); PG8_MMA(0, 1, At, B1); PG8_BAR; PG8_SCHED;
            PG8_LDA(At, 0, 1); PG8_STAGE(PG8_SB(0, 0), b2, voffB); PG8_STAGE(PG8_SB(0, 1), b2 + hstep, voffB); PG8_STAGE(PG8_SA(0, 0), a2, voffA);
            PG8_WAIT_V(8); PG8_WAIT_L(0); PG8_BAR; PG8_MMA(1, 0, At, B0); PG8_MMA(1, 1, At, B1); PG8_BAR; PG8_SCHED;
            PG8_LDB(B0, 1, 0); PG8_LDB(B1, 1, 1); PG8_SCHED; PG8_LDA(At, 1, 0); PG8_STAGE(PG8_SA(0, 1), a2 + hstep, voffA);
            PG8_WAIT_V(8); PG8_WAIT_L(0); PG8_BAR; PG8_MMA(0, 0, At, B0); PG8_MMA(0, 1, At, B1); PG8_BAR; PG8_SCHED;
            PG8_LDA(At, 1, 1); PG8_STAGE(PG8_SB(1, 0), b3, voffB); PG8_STAGE(PG8_SB(1, 1), b3 + hstep, voffB); PG8_STAGE(PG8_SA(1, 0), a3, voffA);
            PG8_WAIT_V(8); PG8_WAIT_L(0); PG8_BAR; PG8_MMA(1, 0, At, B0); PG8_MMA(1, 1, At, B1); PG8_BAR; PG8_SCHED;
            } else {
            PG8_LDB(B0, 0, 0); PG8_SCHED; PG8_LDA(At, 0, 0); PG8_STAGE(PG8_SA(1, 1), a1 + hstep, voffA);
            PG8_WAIT_L(8); PG8_BAR; PG8_WAIT_L(0); PG8_MMA(0, 0, At, B0); PG8_BAR; PG8_SCHED;
            PG8_LDB(B1, 0, 1); PG8_STAGE(PG8_SB(0, 0), b2, voffB);
            PG8_BAR; PG8_WAIT_L(0); PG8_MMA(0, 1, At, B1); PG8_BAR;
            PG8_LDA(At, 0, 1); PG8_STAGE(PG8_SA(0, 0), a2, voffA);
            PG8_BAR; PG8_WAIT_L(0); PG8_MMA(1, 0, At, B0); PG8_BAR; PG8_SCHED;
            PG8_STAGE(PG8_SB(0, 1), b2 + hstep, voffB);
            PG8_WAIT_V(6); PG8_BAR; PG8_MMA(1, 1, At, B1); PG8_BAR;
            PG8_LDB(B0, 1, 0); PG8_SCHED; PG8_LDA(At, 1, 0); PG8_STAGE(PG8_SA(0, 1), a2 + hstep, voffA);
            PG8_WAIT_L(8); PG8_BAR; PG8_WAIT_L(0); PG8_MMA(0, 0, At, B0); PG8_BAR; PG8_SCHED;
            PG8_LDB(B1, 1, 1); PG8_STAGE(PG8_SB(1, 0), b3, voffB);
            PG8_BAR; PG8_WAIT_L(0); PG8_MMA(0, 1, At, B1); PG8_BAR;
            PG8_LDA(At, 1, 1); PG8_STAGE(PG8_SA(1, 0), a3, voffA);
            PG8_BAR; PG8_WAIT_L(0); PG8_MMA(1, 0, At, B0); PG8_BAR; PG8_SCHED;
            PG8_STAGE(PG8_SB(1, 1), b3 + hstep, voffB);
            PG8_WAIT_V(6); PG8_BAR; PG8_MMA(1, 1, At, B1); PG8_BAR;
            }
        }
        if constexpr (ALIGN_EPI) { if (wr == 0) PG8_BAR; }
        bool keep = false;
        if constexpr (Epi::TWO_STAGE) keep = (cur.sel == 0);
        if constexpr (!Epi::AFTER_DRAIN) {
            if constexpr (Epi::TWO_STAGE) { if (keep) E.mid(acc, cur, wr, wc, fr, fq); else E(acc, cur, wr, wc, fr, fq); }
            else E(acc, cur, wr, wc, fr, fq);
            S.done(cur); }
        if (!has_next) break;
        if (!keep)
#pragma unroll
        for (int a = 0; a < 2; ++a)
#pragma unroll
            for (int b = 0; b < 2; ++b)
#pragma unroll
                for (int m = 0; m < 4; ++m)
#pragma unroll
                    for (int n = 0; n < 2; ++n) acc[a][b][m][n] = (f32x4){0.f, 0.f, 0.f, 0.f};
        cur = nxt; cA = nA; cB = nB; ++ui;
        if constexpr (ALIGN_EPI) { if (wr == 1) PG8_BAR; }
    }
    PG8_WAIT_V(0);
    if constexpr (!ALIGN_EPI) { if (wr == 0) PG8_BAR; }
    PG8_BAR;
    if constexpr (Epi::AFTER_DRAIN) { E.fused(acc, cur, wr, wc, fr, fq, lds, wid, lane); S.done(cur); }
#undef PG8_SA
#undef PG8_SB
#undef PG8_STAGE
#undef PG8_LDA
#undef PG8_LDB
#undef PG8_MMA
#undef PG8_WAIT_V
#undef PG8_WAIT_L
#undef PG8_BAR
#undef PG8_SCHED
}
}
namespace attn {
using bf16 = unsigned short;
constexpr int D = 128, NW = 8, QBLK = 32, KVBLK = 64;
constexpr float SCALE = 0.088388347648318440f;
constexpr float THR = 8.f;
constexpr int SDEPTH = 2;
constexpr int LDQ = 1024, LDK = 256, LDO = 1024;
constexpr size_t SHM_V = KVBLK * D * 2, SHM_K = KVBLK * D * 2, SHM_ATTN = 2 * SHM_V + 2 * SHM_K + NW * 64 * 4;
__device__ __forceinline__ unsigned short f2bf_rne(float f) { unsigned u = __float_as_uint(f); return (unsigned short)((u + 0x7fffu + ((u >> 16) & 1u)) >> 16); }
using bf16x8 = __attribute__((ext_vector_type(8))) short;
using s16x4  = __attribute__((ext_vector_type(4))) short;
using f32x16 = __attribute__((ext_vector_type(16))) float;
using f32x8  = __attribute__((ext_vector_type(8))) float;
using u32x4  = __attribute__((ext_vector_type(4))) unsigned;
#define KSWZ(row, colB) ((row) * 256 + ((colB) ^ (((row) & 7) << 4)))
#define SBAR() __builtin_amdgcn_sched_barrier(0)
__device__ __forceinline__ int crow(int r, int hi) { return (r & 3) + 8 * (r >> 2) + 4 * hi; }
__device__ __forceinline__ unsigned cvtpk(float lo, float hi) {
  unsigned r; asm volatile("v_cvt_pk_bf16_f32 %0, %1, %2" : "=v"(r) : "v"(lo), "v"(hi)); return r;
}
template <typename TIn> struct Stage;
template <> struct Stage<bf16>  { using T = bf16x8;
  __device__ static __forceinline__ T ld8(const bf16* p) { return *reinterpret_cast<const bf16x8*>(p); }
  __device__ static __forceinline__ bf16x8 tobf(T x) { return x; } };
template <> struct Stage<float> { using T = f32x8;
  __device__ static __forceinline__ T ld8(const float* p) { return *reinterpret_cast<const f32x8*>(p); }
  __device__ static __forceinline__ bf16x8 tobf(T x) {
    u32x4 w = {cvtpk(x[0], x[1]), cvtpk(x[2], x[3]), cvtpk(x[4], x[5]), cvtpk(x[6], x[7])}; return *reinterpret_cast<bf16x8*>(&w); } };

__device__ __forceinline__ void partialSM(f32x16& p0, f32x16& p1, float& m_reg, float& mn, float& alpha) {
  constexpr float C = SCALE * 1.4426950408889634f;
  float pmax = p0[0]; for (int r = 1; r < 16; ++r) pmax = fmaxf(pmax, p0[r]); for (int r = 0; r < 16; ++r) pmax = fmaxf(pmax, p1[r]);
  { auto rr = __builtin_amdgcn_permlane32_swap(__float_as_uint(pmax), __float_as_uint(pmax), false, false);
    pmax = fmaxf(__uint_as_float(rr[0]), __uint_as_float(rr[1])); }
  if (__builtin_expect(__all(pmax - m_reg <= THR / SCALE), 1)) { mn = m_reg; alpha = 1.f; }
  else { mn = fmaxf(m_reg, pmax); alpha = __builtin_amdgcn_exp2f((m_reg - mn) * C); m_reg = mn; }
  float mnC = -mn * C;
  for (int r = 0; r < 16; ++r) p0[r] = fmaf(p0[r], C, mnC); for (int r = 0; r < 16; ++r) p1[r] = fmaf(p1[r], C, mnC);
  for (int r = 0; r < 16; ++r) p0[r] = __builtin_amdgcn_exp2f(p0[r]);
}
__device__ __forceinline__ void finishSM(f32x16& p0, f32x16& p1, float alpha, float& l_reg, bf16x8& pa0, bf16x8& pa1, bf16x8& pa2, bf16x8& pa3) {
  for (int r = 0; r < 16; ++r) p1[r] = __builtin_amdgcn_exp2f(p1[r]);
  float ps = 0; for (int r = 0; r < 16; ++r) ps += p0[r]; for (int r = 0; r < 16; ++r) ps += p1[r];
  { auto rr = __builtin_amdgcn_permlane32_swap(__float_as_uint(ps), __float_as_uint(ps), false, false);
    ps = __uint_as_float(rr[0]) + __uint_as_float(rr[1]); }
  l_reg = l_reg * alpha + ps;
#define PK4(P, BASE, OUT) do { unsigned a0 = cvtpk(P[BASE + 0], P[BASE + 1]), a1 = cvtpk(P[BASE + 2], P[BASE + 3]);   \
    unsigned b0 = cvtpk(P[BASE + 4], P[BASE + 5]), b1 = cvtpk(P[BASE + 6], P[BASE + 7]);                              \
    auto r0 = __builtin_amdgcn_permlane32_swap(a0, b0, false, false); auto r1 = __builtin_amdgcn_permlane32_swap(a1, b1, false, false); \
    u32x4 w = {r0[0], r1[0], r0[1], r1[1]}; OUT = *reinterpret_cast<bf16x8*>(&w); } while (0)
  PK4(p0, 0, pa0); PK4(p0, 8, pa1); PK4(p1, 0, pa2); PK4(p1, 8, pa3);
#undef PK4
}
__device__ __forceinline__ void qkt(f32x16& p0, f32x16& p1, const bf16* Ks, const bf16x8* qr, int r32, int hi) {
  p0 = f32x16{}; p1 = f32x16{};
  for (int d0 = 0; d0 < 8; ++d0) { int cb = (d0 * 16 + hi * 8) * 2;
    bf16x8 b0 = *reinterpret_cast<const bf16x8*>((const char*)Ks + KSWZ(r32, cb));
    bf16x8 b1 = *reinterpret_cast<const bf16x8*>((const char*)Ks + KSWZ(32 + r32, cb));
    p0 = __builtin_amdgcn_mfma_f32_32x32x16_bf16(b0, qr[d0], p0, 0, 0, 0);
    p1 = __builtin_amdgcn_mfma_f32_32x32x16_bf16(b1, qr[d0], p1, 0, 0, 0); }
}
__device__ __forceinline__ int v_st(int k, int c) { const int kk = (k & ~0xC) | ((k & 4) << 1) | ((k & 8) >> 1); return ((kk >> 3) * 4 + (c >> 5)) * 512 + ((kk & 7) * 32 + (c & 31)) * 2; }
__device__ __forceinline__ int v_rd_base(int lane) { return ((lane & 3) << 3) | (((lane >> 2) & 3) << 6) | (((lane >> 4) & 1) << 5) | (((lane >> 5) & 1) << 8); }
constexpr int v_rd_off(int d0, int ks, int half) { return d0 * 512 + ks * 4096 + half * 2048; }
template <int OFF> __device__ __forceinline__ s16x4 tr_read(int vb) {
  s16x4 r; asm volatile("ds_read_b64_tr_b16 %0, %1 offset:%2" : "=&v"(r) : "v"(vb), "i"(OFF) : "memory"); return r;
}
template <int D0> __device__ __forceinline__ void pv_one(f32x16& od, int vb, bf16x8 pa0, bf16x8 pa1, bf16x8 pa2, bf16x8 pa3) {
  const s16x4 l0 = tr_read<v_rd_off(D0, 0, 0)>(vb), h0 = tr_read<v_rd_off(D0, 0, 1)>(vb), l1 = tr_read<v_rd_off(D0, 1, 0)>(vb), h1 = tr_read<v_rd_off(D0, 1, 1)>(vb);
  const s16x4 l2 = tr_read<v_rd_off(D0, 2, 0)>(vb), h2 = tr_read<v_rd_off(D0, 2, 1)>(vb), l3 = tr_read<v_rd_off(D0, 3, 0)>(vb), h3 = tr_read<v_rd_off(D0, 3, 1)>(vb);
  asm volatile("s_waitcnt lgkmcnt(0)" ::: "memory"); SBAR();
#define PK(L, H) (bf16x8){L[0], L[1], L[2], L[3], H[0], H[1], H[2], H[3]}
  od = __builtin_amdgcn_mfma_f32_32x32x16_bf16(pa0, PK(l0, h0), od, 0, 0, 0);
  od = __builtin_amdgcn_mfma_f32_32x32x16_bf16(pa1, PK(l1, h1), od, 0, 0, 0);
  od = __builtin_amdgcn_mfma_f32_32x32x16_bf16(pa2, PK(l2, h2), od, 0, 0, 0);
  od = __builtin_amdgcn_mfma_f32_32x32x16_bf16(pa3, PK(l3, h3), od, 0, 0, 0);
#undef PK
}
__device__ __forceinline__ void pv_d0(f32x16* o, int vb, bf16x8 pa0, bf16x8 pa1, bf16x8 pa2, bf16x8 pa3) {
  pv_one<0>(o[0], vb, pa0, pa1, pa2, pa3); pv_one<1>(o[1], vb, pa0, pa1, pa2, pa3); pv_one<2>(o[2], vb, pa0, pa1, pa2, pa3); pv_one<3>(o[3], vb, pa0, pa1, pa2, pa3);
}

template <typename TQ>
__device__ __forceinline__ void attn_dense_body(const TQ* __restrict__ Qb, const bf16* __restrict__ Kh, const bf16* __restrict__ Vh,
                                                bf16* __restrict__ Ob, int seq, char* lds) {
  using St = Stage<bf16>; using SQ = Stage<TQ>;
  const int tid = threadIdx.x, wid = tid >> 6, lane = tid & 63, r32 = lane & 31, hi = lane >> 5;
  bf16* V_lds = (bf16*)lds; bf16* K_lds = (bf16*)(lds + 2 * SHM_V);
  float* ws = (float*)(lds + 2 * SHM_V + 2 * SHM_K) + wid * 64; float* li_l = ws; float* al_l = ws + 32;
  float m_reg = -1e30f, l_reg = 0; f32x16 o[4] = {}; bf16x8 qr[8];
  const TQ* Qw = Qb + (long)(wid * QBLK + r32) * LDQ + hi * 8;
#pragma unroll
  for (int d0 = 0; d0 < 8; ++d0) qr[d0] = SQ::tobf(SQ::ld8(Qw + d0 * 16));
  const int sr = tid >> 4, sc = (tid & 15) * 8, vst0 = v_st(sr, sc), vst1 = v_st(32 + sr, sc);
  const int vb0 = (int)(uintptr_t)V_lds + v_rd_base(lane);
  struct { typename St::T vs0, vs1, ks0, ks1; } sr_[SDEPTH];
#define SLOAD(i, k0) do { sr_[i].vs0 = St::ld8(&Vh[(long)((k0) + sr) * LDK + sc]); sr_[i].vs1 = St::ld8(&Vh[(long)((k0) + 32 + sr) * LDK + sc]); \
    sr_[i].ks0 = St::ld8(&Kh[(long)((k0) + sr) * LDK + sc]); sr_[i].ks1 = St::ld8(&Kh[(long)((k0) + 32 + sr) * LDK + sc]); } while (0)
#define SWRITE(b, i) do { *(bf16x8*)((char*)V_lds + (b) * SHM_V + vst0) = St::tobf(sr_[i].vs0);          \
    *(bf16x8*)((char*)V_lds + (b) * SHM_V + vst1) = St::tobf(sr_[i].vs1); int kc = sc * 2;               \
    *(bf16x8*)((char*)K_lds + (b) * SHM_K + KSWZ(sr, kc)) = St::tobf(sr_[i].ks0);                       \
    *(bf16x8*)((char*)K_lds + (b) * SHM_K + KSWZ(32 + sr, kc)) = St::tobf(sr_[i].ks1); } while (0)
#define SWAIT() do { if constexpr (SDEPTH == 2) asm volatile("s_waitcnt vmcnt(4)" ::: "memory"); else asm volatile("s_waitcnt vmcnt(0)" ::: "memory"); } while (0)
#define RESC(a) do { if (__any((a) < 1.f)) { if (hi == 0) al_l[r32] = (a); asm volatile("s_waitcnt lgkmcnt(0)" ::: "memory"); \
    for (int d = 0; d < 4; ++d) for (int r = 0; r < 16; ++r) o[d][r] *= al_l[crow(r, hi)]; } } while (0)
  f32x16 pA0, pA1, pB0, pB1; float mnA, mnB, alA, alB; bf16x8 pa0, pa1, pa2, pa3; const int NT = seq / KVBLK;
  constexpr int SE = 0, SO = SDEPTH - 1;
  SLOAD(SE, 0); asm volatile("s_waitcnt vmcnt(0)" ::: "memory"); SWRITE(0, SE); __syncthreads();
  qkt(pA0, pA1, K_lds, qr, r32, hi); partialSM(pA0, pA1, m_reg, mnA, alA);
  SLOAD(SO, KVBLK); if constexpr (SDEPTH == 2) { if (2 < NT) SLOAD(SE, 2 * KVBLK); }
  SWAIT(); SWRITE(1, SO); __syncthreads();
  for (int j = 1; j + 1 < NT; j += 2) {
    SBAR(); qkt(pB0, pB1, (bf16*)((char*)K_lds + SHM_K), qr, r32, hi);
    finishSM(pA0, pA1, alA, l_reg, pa0, pa1, pa2, pa3); SBAR();
    SLOAD(SO, (j + SDEPTH) * KVBLK); SBAR();
    pv_d0(o, vb0, pa0, pa1, pa2, pa3); partialSM(pB0, pB1, m_reg, mnB, alB);
    __syncthreads(); SWAIT(); SWRITE(0, SE);
    RESC(alB); __syncthreads();
    SBAR(); qkt(pA0, pA1, K_lds, qr, r32, hi);
    finishSM(pB0, pB1, alB, l_reg, pa0, pa1, pa2, pa3); SBAR();
    if (SDEPTH == 1 || j + 3 < NT) SLOAD(SE, (j + 1 + SDEPTH) * KVBLK); SBAR();
    pv_d0(o, vb0 + (int)SHM_V, pa0, pa1, pa2, pa3); partialSM(pA0, pA1, m_reg, mnA, alA);
    __syncthreads(); SWAIT(); SWRITE(1, SO);
    RESC(alA); __syncthreads();
  }
  SBAR(); qkt(pB0, pB1, (bf16*)((char*)K_lds + SHM_K), qr, r32, hi);
  finishSM(pA0, pA1, alA, l_reg, pa0, pa1, pa2, pa3); SBAR();
  pv_d0(o, vb0, pa0, pa1, pa2, pa3); partialSM(pB0, pB1, m_reg, mnB, alB);
  __syncthreads(); RESC(alB);
  finishSM(pB0, pB1, alB, l_reg, pa0, pa1, pa2, pa3); SBAR();
  pv_d0(o, vb0 + (int)SHM_V, pa0, pa1, pa2, pa3);
  if (hi == 0) li_l[r32] = l_reg; asm volatile("s_waitcnt lgkmcnt(0)" ::: "memory");
  float rli[16];
#pragma unroll
  for (int r = 0; r < 16; ++r) rli[r] = __builtin_amdgcn_rcpf(li_l[crow(r, hi)]);
  bf16* Ow = Ob + (long)(wid * QBLK) * LDO;
#pragma unroll
  for (int r = 0; r < 16; ++r) { int orow = crow(r, hi);
    for (int d0 = 0; d0 < 4; ++d0) Ow[(long)orow * LDO + d0 * 32 + r32] = f2bf_rne(o[d0][r] * rli[r]); }
#undef SLOAD
#undef SWRITE
#undef SWAIT
#undef RESC
}
#undef KSWZ
#undef SBAR
}

constexpr int DM = 2048, NB = 4, TS = 4096, NT = NB * TS, CL = 256, NC = NB * CL, MTOT = NT + NC, LKV = TS + CL;
constexpr int NPROJ = 9984;
constexpr int INW = 9760;
constexpr int NEXP = 16384;
constexpr float EPS = 1e-6f;
constexpr int NWAVES = 8;
constexpr int NPHASE = 14;

constexpr size_t MiB = 1u << 20;
constexpr size_t WS_CTL = 0, WS_MOD = 1 * MiB, WS_MODP = 2 * MiB, WS_SUBK = 10 * MiB, WS_WBA = 11 * MiB, WS_WBD = 15 * MiB, WS_WOUT = 19 * MiB, WS_WQ = 27 * MiB;
constexpr size_t WS_BETA = 35 * MiB, WS_LOGA = 37 * MiB, WS_EXPI = 39 * MiB, WS_EXPG = 47 * MiB;
constexpr size_t WS_A = 56 * MiB;
constexpr size_t WS_WIN = WS_A, WS_H = WS_A + 39 * MiB;
constexpr size_t WS_DQ = WS_A, WS_DK = WS_A + 34 * MiB, WS_DV = WS_A + 68 * MiB;
constexpr size_t WS_Y = WS_A, WS_H2 = WS_A;
constexpr size_t WS_B = 164 * MiB;
constexpr size_t WS_QN = WS_B, WS_Z = WS_B + 32 * MiB, WS_PQ = WS_B;
constexpr size_t WS_KB = 228 * MiB, WS_VB = 237 * MiB;
constexpr size_t WS_C = 246 * MiB;
constexpr size_t WS_DNRAW = WS_C, WS_U8 = WS_C, WS_V8 = WS_C + 32 * MiB, WS_SU = WS_C + 64 * MiB, WS_SV = WS_C + 65 * MiB, WS_U4 = WS_C + 66 * MiB;
constexpr size_t WS_KT = WS_C, WS_TINV = WS_C + 34 * MiB, WS_QKO = WS_C + 68 * MiB, WS_VEC = WS_C + 102 * MiB;
constexpr size_t WS_D = 374 * MiB;
constexpr size_t WS_G = WS_D, WS_X1 = WS_D;
constexpr size_t WS_OATT8 = WS_D + 64 * MiB, WS_ODNN8 = WS_D + 80 * MiB;
#ifndef MERGE_F8_A
#define MERGE_F8_A 0
#endif
#ifndef MERGE_F8_B
#define MERGE_F8_B 0
#endif
constexpr float WB_SCALE = 64.f, OATT_SCALE = 16.f, ODNN_SCALE = 2.f;
constexpr size_t WS_ODN = 502 * MiB;
constexpr size_t WS_END = 566 * MiB;
static_assert((size_t)NPROJ * DM * 2 <= 39 * MiB && (size_t)MTOT * DM * 2 <= 69 * MiB && (size_t)MTOT * 1024 * 2 <= 34 * MiB && (size_t)MTOT * 3072 * 2 <= 128 * MiB, "ws map");
static_assert((size_t)NB * LKV * 256 * 2 <= 9 * MiB && (size_t)NT * 4096 * 2 <= 128 * MiB && (size_t)NEXP * DM * 2 <= 64 * MiB, "ws map");

constexpr int LDS_BYTES = 163840;

#define DI __device__ __forceinline__
#define LAS __attribute__((address_space(3)))
typedef unsigned short bf16;
typedef float f32x4 __attribute__((ext_vector_type(4)));
typedef float f32x2 __attribute__((ext_vector_type(2)));
typedef unsigned u32x4 __attribute__((ext_vector_type(4)));
typedef unsigned u32x2 __attribute__((ext_vector_type(2)));

typedef __bf16 bf16x2_n __attribute__((ext_vector_type(2)));
DI unsigned pk2(float lo, float hi) { const f32x2 v = {lo, hi}; return __builtin_bit_cast(unsigned, __builtin_convertvector(v, bf16x2_n)); }
DI unsigned f2bf(float f) { return pk2(f, f) & 0xffffu; }
DI float bflo(unsigned w) { return __uint_as_float(w << 16); }
DI float bfhi(unsigned w) { return __uint_as_float(w & 0xffff0000u); }
DI float bf2f(bf16 h) { return __uint_as_float((unsigned)h << 16); }
DI float wave_sum(float v) {
#pragma unroll
    for (int o = 1; o < 64; o <<= 1) v += __shfl_xor(v, o);
    return v;
}
DI unsigned wave_max_u32(unsigned v) {
#pragma unroll
    for (int o = 1; o < 64; o <<= 1) { const unsigned t = (unsigned)__shfl_xor((int)v, o); v = t > v ? t : v; }
    return v;
}
DI float sigm(float x) { return __builtin_amdgcn_rcpf(1.f + __expf(-x)); }
DI float silu(float x) { return x * __builtin_amdgcn_rcpf(1.f + __expf(-x)); }
DI float softplus(float x) { return x > 20.f ? x : log1pf(__expf(x)); }
DI float gelu_erf(float v) {
    const float av = fabsf(v), t = __builtin_amdgcn_rcpf(av * 0.2316418882f + 1.0f);
    float q = t * 0.5307027145f + (-0.7265760135f); q = q * t + 0.7107068705f; q = q * t + (-0.142248368f); q = q * t + 0.127414796f; q = q * t;
    const float e = __builtin_amdgcn_exp2f((v * v) * (-0.72134752044f));
    const float mm = v * (q * e);
    return v < 0.f ? mm : v - mm;
}
DI unsigned okey(float f) { const unsigned u = __float_as_uint(f); return (u & 0x80000000u) ? ~u : (u | 0x80000000u); }
DI unsigned rdlane(unsigned v, int l) { return (unsigned)__builtin_amdgcn_readlane((int)v, l); }
DI float rdlanef(float v, int l) { return __uint_as_float((unsigned)__builtin_amdgcn_readlane((int)__float_as_uint(v), l)); }

#define XB_TMO      128
#define XB_XCNT(j)  (256  + 64 * (j))
#define XB_XSUB(j)  (1280 + 64 * (j))
#define XB_XGEN(j)  (2304 + 64 * (j))
#define XB_TOP      3328
#define XB_TOPGEN   3392
#define XCD_BAR_WORDS 3456
#define XB_SPIN_CAP (1u << 18)

__device__ __forceinline__ unsigned xb_ld(unsigned* p)              { return __hip_atomic_load(p, __ATOMIC_RELAXED, __HIP_MEMORY_SCOPE_AGENT); }
__device__ __forceinline__ unsigned xb_add(unsigned* p, unsigned v) { return __hip_atomic_fetch_add(p, v, __ATOMIC_RELAXED, __HIP_MEMORY_SCOPE_AGENT); }
__device__ __forceinline__ unsigned xb_xcc_id() { return (unsigned)__builtin_amdgcn_s_getreg((3 << 11) | 20) & 0xFu; }
#define XB_SPIN(cond, bar) do { unsigned _sp = 0; while (cond) { __builtin_amdgcn_s_sleep(1); \
    if ((++_sp & 255u) == 0u) { if (xb_ld(&(bar)[XB_TMO])) break; if (_sp > XB_SPIN_CAP) { atomicAdd(&(bar)[XB_TMO], 1u); break; } } } } while (0)

struct XcdBarrier {
    unsigned* bar; unsigned x;
    volatile LAS unsigned* st;
};

__device__ __forceinline__ XcdBarrier xcd_barrier_post(unsigned* bar, volatile LAS unsigned* st) {
    XcdBarrier b; b.bar = bar; b.x = xb_xcc_id(); b.st = st;
    if (threadIdx.x == 0) (void)xb_add(&bar[XB_XCNT(b.x)], 1u);
    return b;
}
__device__ __forceinline__ void xcd_barrier_complete(unsigned* bar, unsigned x, unsigned& nloc, unsigned& nx) {
    const unsigned G = gridDim.x * gridDim.y * gridDim.z;
    unsigned sum, cnt, mine, sp = 0u;
    for (;;) {
        sum = 0u; cnt = 0u; mine = 0u;
#pragma unroll
        for (unsigned j = 0; j < 16; ++j) { const unsigned c = xb_ld(&bar[XB_XCNT(j)]); sum += c; cnt += (c > 0u) ? 1u : 0u; mine = (j == x) ? c : mine; }
        if (sum == G) break;
        __builtin_amdgcn_s_sleep(1);
        if ((++sp & 255u) == 0u) { if (xb_ld(&bar[XB_TMO])) break; if (sp > XB_SPIN_CAP) { atomicAdd(&bar[XB_TMO], 1u); break; } }
    }
    nloc = mine > 0u ? mine : 1u; nx = cnt > 0u ? cnt : 1u;
}

__device__ __forceinline__ void xcd_barrier(const XcdBarrier& b) {
    asm volatile("s_waitcnt vmcnt(0)" ::: "memory");
    __syncthreads();
    if (threadIdx.x == 0) {
        unsigned* bar = b.bar;
        __builtin_amdgcn_s_waitcnt(0);
        unsigned nloc = b.st[0], nx = b.st[1];
        if (nloc == 0u) { xcd_barrier_complete(bar, b.x, nloc, nx); b.st[0] = nloc; b.st[1] = nx; }
        const unsigned old = xb_add(&bar[XB_XSUB(b.x)], 1u);
        const unsigned gen = old / nloc;
        if (old + 1u == (gen + 1u) * nloc) {
            __builtin_amdgcn_fence(__ATOMIC_RELEASE, "agent");
            asm volatile("s_waitcnt vmcnt(0)" ::: "memory");
            const unsigned og = xb_add(&bar[XB_TOP], 1u);
            const unsigned tg = og / nx;
            if (og + 1u == (tg + 1u) * nx) xb_add(&bar[XB_TOPGEN], 1u);
            else XB_SPIN(xb_ld(&bar[XB_TOPGEN]) == tg, bar);
            __builtin_amdgcn_fence(__ATOMIC_ACQUIRE, "agent");
            xb_add(&bar[XB_XGEN(b.x)], 1u);
            asm volatile("s_waitcnt vmcnt(0)" ::: "memory");
        } else {
            XB_SPIN(xb_ld(&bar[XB_XGEN(b.x)]) == gen, bar);
            __builtin_amdgcn_fence(__ATOMIC_ACQUIRE, "agent");
            asm volatile("s_waitcnt vmcnt(0)" ::: "memory");
        }
    }
    __syncthreads();
}

#define RAW_BAR() do { asm volatile("s_waitcnt lgkmcnt(0)" ::: "memory"); __builtin_amdgcn_s_barrier(); asm volatile("" ::: "memory"); } while (0)

DI unsigned pk4_fp8(float a, float b, float c, float d) { int w = __builtin_amdgcn_cvt_pk_fp8_f32(a, b, 0, false); w = __builtin_amdgcn_cvt_pk_fp8_f32(c, d, w, true); return (unsigned)w; }
DI float fp8c(float x) { return fminf(fmaxf(x, -448.f), 448.f); }
constexpr float WIN_SCALE = 64.f;

struct Frame {
    LAS unsigned char* lds;
    unsigned char* ws;
    const float* in[23];
    float* out;
    int tid, lane, wave, vcu, G, gw, NGW;
};

DI size_t dn_off(int m, int h) {
    int b, pos; if (m < NT) { b = m >> 12; pos = 256 + (m & 4095); } else { const int mm = m - NT; b = mm >> 8; pos = mm & 255; }
    return ((size_t)(b * 8 + h) * 4352 + pos) * 128;
}

struct EpiInProj {
    static constexpr bool PERM = true, AFTER_DRAIN = false, TWO_STAGE = false;
    unsigned char* ws; const float* a_log; const float* dt_bias;
    DI void operator()(const pg8::f32x4 (&acc)[2][2][4][2], const pg8::Unit& u, int wr, int wc, int fr, int fq) const {
        asm volatile("" : "+v"(fr), "+v"(fq));
        const int pn = u.pn, pm = u.pm; const bool isctx = pm >= 64;
        if (pn == 38) {
            if (wc != 0) return;
            float* dstf = (float*)(ws + (fq < 2 ? WS_BETA : WS_LOGA));
            const int c8 = (fq & 1) * 8;
#pragma unroll
            for (int ai = 0; ai < 2; ++ai)
#pragma unroll
                for (int m = 0; m < 4; ++m) {
                    const int row = pm * 256 + ai * 128 + wr * 64 + m * 16 + fr;
#pragma unroll
                    for (int n = 0; n < 2; ++n) {
                        f32x4 v = acc[ai][0][m][n] * (1.f / WIN_SCALE), o;
#pragma unroll
                        for (int i = 0; i < 4; ++i) {
                            const int c = c8 + 4 * n + i;
                            o[i] = (fq < 2) ? sigm(v[i]) : -__expf(a_log[c]) * softplus(v[i] + dt_bias[c]);
                        }
                        *(f32x4*)(dstf + (size_t)row * 16 + c8 + 4 * n) = o;
                    }
                }
            return;
        }
        bf16* dst; int ld, coloff, rowoff = 0; bool sg = false;
        if (pn < 4) { if (isctx) return; dst = (bf16*)(ws + WS_QN); ld = 1024; coloff = pn * 256; }
        else if (pn < 6) { dst = (bf16*)(ws + (pn == 4 ? WS_KB : WS_VB)); ld = 256; coloff = 0; rowoff = isctx ? (-12288 + (pm - 64) * 4096) : (pm >> 4) * 256; }
        else if (pn < 18) { dst = (bf16*)(ws + WS_DNRAW); ld = 3072; coloff = (pn - 6) * 256; }
        else if (pn < 22) { if (isctx) return; dst = (bf16*)(ws + WS_Z); ld = 1024; coloff = (pn - 18) * 256; }
        else { if (isctx) return; dst = (bf16*)(ws + WS_G); ld = 4096; coloff = (pn - 22) * 256; sg = true; }
        const int row0 = pm * 256 + rowoff + wr * 64 + fr, col0 = coloff + wc * 32 + 8 * fq;
#pragma unroll
        for (int ai = 0; ai < 2; ++ai)
#pragma unroll
            for (int m = 0; m < 4; ++m) {
                bf16* rowp = dst + (size_t)(row0 + ai * 128 + m * 16) * ld + col0;
#pragma unroll
                for (int bj = 0; bj < 2; ++bj) {
                    f32x4 v0 = acc[ai][bj][m][0] * (1.f / WIN_SCALE), v1 = acc[ai][bj][m][1] * (1.f / WIN_SCALE);
                    if (sg) {
                        u32x2 gb; gb.x = 0u; gb.y = 0u;
#pragma unroll
                        for (int i = 0; i < 4; ++i) { gb.x |= (unsigned)(sigm(v0[i]) * 255.f + 0.5f) << (8 * i); gb.y |= (unsigned)(sigm(v1[i]) * 255.f + 0.5f) << (8 * i); }
                        __builtin_nontemporal_store(gb, (u32x2*)((unsigned char*)dst + (size_t)(row0 + ai * 128 + m * 16) * 4096 + col0 + bj * 128));
                        continue;
                    }
                    u32x4 w; w.x = pg8::cvt_pk_bf16(v0[0], v0[1]); w.y = pg8::cvt_pk_bf16(v0[2], v0[3]); w.z = pg8::cvt_pk_bf16(v1[0], v1[1]); w.w = pg8::cvt_pk_bf16(v1[2], v1[3]);
                    __builtin_nontemporal_store(w, (u32x4*)(rowp + bj * 128));
                }
            }
    }
};


struct InProjOrder {
    pg8::StaticOrder lat; int G, c;
    static constexpr int NLAT = 64 * 39, NCTX = 4 * 15;
    DI void init(int G_, int c_) { lat.init(NT, NPROJ, G_, c_); G = G_; c = c_; }
    DI bool next(int i, pg8::Unit& u) const {
        const int L = i * G + c;
        if (L < NLAT) return lat.next(i, u);
        const int x = L - NLAT; if (x >= NCTX) return false;
        const int j = x % 15; u.pm = 64 + x / 15; u.pn = j < 2 ? 4 + j : (j < 14 ? 4 + j : 38); return true;
    }
    DI void a_ready(const pg8::Unit&) const {}
    DI void done(const pg8::Unit&) const {}
};

struct EpiPlain {
    static constexpr bool PERM = true, AFTER_DRAIN = false, TWO_STAGE = false;
    bf16* O; int ldc;
    DI void operator()(const pg8::f32x4 (&acc)[2][2][4][2], const pg8::Unit& u, int wr, int wc, int fr, int fq) const {
        const int row0 = u.pm * 256 + wr * 64 + fr, col0 = u.pn * 256 + wc * 32 + 8 * fq;
#pragma unroll
        for (int ai = 0; ai < 2; ++ai)
#pragma unroll
            for (int m = 0; m < 4; ++m) {
                bf16* rowp = O + (size_t)(row0 + ai * 128 + m * 16) * ldc + col0;
#pragma unroll
                for (int bj = 0; bj < 2; ++bj) {
                    const f32x4 v0 = acc[ai][bj][m][0], v1 = acc[ai][bj][m][1];
                    u32x4 w; w.x = pg8::cvt_pk_bf16(v0[0], v0[1]); w.y = pg8::cvt_pk_bf16(v0[2], v0[3]); w.z = pg8::cvt_pk_bf16(v1[0], v1[1]); w.w = pg8::cvt_pk_bf16(v1[2], v1[3]);
                    *(u32x4*)(rowp + bj * 128) = w;
                }
            }
    }
};

template <bool ADD> struct EpiMerge {
    static constexpr bool PERM = true, AFTER_DRAIN = false, TWO_STAGE = false;
    bf16* Y; const unsigned char* G; int goff; float gs;
    DI void operator()(const pg8::f32x4 (&acc)[2][2][4][2], const pg8::Unit& u, int wr, int wc, int fr, int fq) const {
        const int row0 = u.pm * 256 + wr * 64 + fr, col0 = u.pn * 256 + wc * 32 + 8 * fq;
#pragma unroll
        for (int ai = 0; ai < 2; ++ai)
#pragma unroll
            for (int m = 0; m < 4; ++m) {
                const size_t row = (size_t)(row0 + ai * 128 + m * 16);
#pragma unroll
                for (int bj = 0; bj < 2; ++bj) {
                    const f32x4 v0 = acc[ai][bj][m][0], v1 = acc[ai][bj][m][1];
                    const u32x2 g = __builtin_nontemporal_load((const u32x2*)(G + row * 4096 + goff + col0 + bj * 128));
                    float r[8];
#pragma unroll
                    for (int i = 0; i < 4; ++i) { r[i] = (float)((g.x >> (8 * i)) & 0xffu) * gs * v0[i]; r[4 + i] = (float)((g.y >> (8 * i)) & 0xffu) * gs * v1[i]; }
                    bf16* yp = Y + row * 2048 + col0 + bj * 128;
                    if (ADD) {
                        const u32x4 y = *(const u32x4*)yp;
                        r[0] += bflo(y.x); r[1] += bfhi(y.x); r[2] += bflo(y.y); r[3] += bfhi(y.y); r[4] += bflo(y.z); r[5] += bfhi(y.z); r[6] += bflo(y.w); r[7] += bfhi(y.w);
                    }
                    u32x4 w; w.x = pg8::cvt_pk_bf16(r[0], r[1]); w.y = pg8::cvt_pk_bf16(r[2], r[3]); w.z = pg8::cvt_pk_bf16(r[4], r[5]); w.w = pg8::cvt_pk_bf16(r[6], r[7]);
                    *(u32x4*)yp = w;
                }
            }
    }
};

struct EpiMerge2 {
    static constexpr bool PERM = true, AFTER_DRAIN = false, TWO_STAGE = true;
    bf16* Y; const unsigned char* G;
    DI void mid(pg8::f32x4 (&acc)[2][2][4][2], const pg8::Unit& u, int wr, int wc, int fr, int fq) const {
        const int row0 = u.pm * 256 + wr * 64 + fr, col0 = u.pn * 256 + wc * 32 + 8 * fq;
#pragma unroll
        for (int ai = 0; ai < 2; ++ai)
#pragma unroll
            for (int m = 0; m < 4; ++m) {
                const size_t row = (size_t)(row0 + ai * 128 + m * 16);
#pragma unroll
                for (int bj = 0; bj < 2; ++bj) {
                    const u32x2 ga = __builtin_nontemporal_load((const u32x2*)(G + row * 4096 + col0 + bj * 128));
                    const u32x2 gd = *(const u32x2*)(G + row * 4096 + 2048 + col0 + bj * 128);
#pragma unroll
                    for (int i = 0; i < 4; ++i) {
                        acc[ai][bj][m][0][i] *= (float)((ga.x >> (8 * i)) & 0xffu) * __builtin_amdgcn_rcpf(fmaxf((float)((gd.x >> (8 * i)) & 0xffu), 1.f));
                        acc[ai][bj][m][1][i] *= (float)((ga.y >> (8 * i)) & 0xffu) * __builtin_amdgcn_rcpf(fmaxf((float)((gd.y >> (8 * i)) & 0xffu), 1.f));
                    }
                }
            }
    }
    DI void operator()(const pg8::f32x4 (&acc)[2][2][4][2], const pg8::Unit& u, int wr, int wc, int fr, int fq) const {
        const int row0 = u.pm * 256 + wr * 64 + fr, col0 = u.pn * 256 + wc * 32 + 8 * fq;
#pragma unroll
        for (int ai = 0; ai < 2; ++ai)
#pragma unroll
            for (int m = 0; m < 4; ++m) {
                const size_t row = (size_t)(row0 + ai * 128 + m * 16);
#pragma unroll
                for (int bj = 0; bj < 2; ++bj) {
                    const f32x4 v0 = acc[ai][bj][m][0], v1 = acc[ai][bj][m][1];
                    const u32x2 g = __builtin_nontemporal_load((const u32x2*)(G + row * 4096 + 2048 + col0 + bj * 128));
                    float r[8];
#pragma unroll
                    for (int i = 0; i < 4; ++i) { r[i] = fmaxf((float)((g.x >> (8 * i)) & 0xffu), 1.f) * (1.f / 255.f) * v0[i]; r[4 + i] = fmaxf((float)((g.y >> (8 * i)) & 0xffu), 1.f) * (1.f / 255.f) * v1[i]; }
                    u32x4 w; w.x = pg8::cvt_pk_bf16(r[0], r[1]); w.y = pg8::cvt_pk_bf16(r[2], r[3]); w.z = pg8::cvt_pk_bf16(r[4], r[5]); w.w = pg8::cvt_pk_bf16(r[6], r[7]);
                    *(u32x4*)(Y + row * 2048 + col0 + bj * 128) = w;
                }
            }
    }
};

struct EpiResid {
    static constexpr bool PERM = true, AFTER_DRAIN = false, TWO_STAGE = false;
    const float* x; bf16* X1; const float* mod;
    DI void operator()(const pg8::f32x4 (&acc)[2][2][4][2], const pg8::Unit& u, int wr, int wc, int fr, int fq) const {
        const int row0 = u.pm * 256 + wr * 64 + fr, col0 = u.pn * 256 + wc * 32 + 8 * fq;
        const float* g1 = mod + (size_t)(u.pm >> 4) * 12288 + 2 * 2048;
        f32x4 gv[2][2];
#pragma unroll
        for (int bj = 0; bj < 2; ++bj)
#pragma unroll
            for (int n = 0; n < 2; ++n) gv[bj][n] = *(const f32x4*)(g1 + col0 + bj * 128 + n * 4);
#pragma unroll
        for (int ai = 0; ai < 2; ++ai)
#pragma unroll
            for (int m = 0; m < 4; ++m) {
                const size_t off = (size_t)(row0 + ai * 128 + m * 16) * 2048 + col0;
#pragma unroll
                for (int bj = 0; bj < 2; ++bj) {
                    const f32x4 x0 = __builtin_nontemporal_load((const f32x4*)(x + off + bj * 128)), x1 = __builtin_nontemporal_load((const f32x4*)(x + off + bj * 128 + 4));
                    const f32x4 v0 = x0 + gv[bj][0] * acc[ai][bj][m][0], v1 = x1 + gv[bj][1] * acc[ai][bj][m][1];
                    u32x4 w; w.x = pk2(v0[0], v0[1]); w.y = pk2(v0[2], v0[3]); w.z = pk2(v1[0], v1[1]); w.w = pk2(v1[2], v1[3]);
                    *(u32x4*)(X1 + off + bj * 128) = w;
                }
            }
    }
};

DI void transpose_item(const float* W, int K, int Nsrc, int sn0, bf16* WT, int dn0, int k0, LAS float* scr, int lane) {
    if (sn0 >= 0) {
        float t[32];
#pragma unroll
        for (int i = 0; i < 32; ++i) t[i] = __builtin_nontemporal_load(&W[(size_t)(k0 + 2 * i + (lane >> 5)) * Nsrc + sn0 + (lane & 31)]);
#pragma unroll
        for (int i = 0; i < 32; ++i) scr[(2 * i + (lane >> 5)) * 33 + (lane & 31)] = t[i];
    } else {
#pragma unroll 8
        for (int i = 0; i < 32; ++i) { const int kk = 2 * i + (lane >> 5); scr[kk * 33 + (lane & 31)] = 0.f; }
    }
    asm volatile("s_waitcnt lgkmcnt(0)" ::: "memory");
    const int c = lane & 7;
#pragma unroll
    for (int j = 0; j < 4; ++j) {
        const int n = (lane >> 3) + 8 * j; const LAS float* s = scr + (8 * c) * 33 + n;
        u32x4 o; o.x = pk2(s[0 * 33], s[1 * 33]); o.y = pk2(s[2 * 33], s[3 * 33]); o.z = pk2(s[4 * 33], s[5 * 33]); o.w = pk2(s[6 * 33], s[7 * 33]);
        *(u32x4*)(WT + (size_t)(dn0 + n) * K + k0 + 8 * c) = o;
    }
    asm volatile("s_waitcnt lgkmcnt(0)" ::: "memory");
}

DI void transpose_item_fp8(const float* W, int K, int Nsrc, int sn0, unsigned char* WT, int dn0, int k0, float scale, LAS float* scr, int lane) {
    if (sn0 >= 0) {
        float t[32];
#pragma unroll
        for (int i = 0; i < 32; ++i) t[i] = __builtin_nontemporal_load(&W[(size_t)(k0 + 2 * i + (lane >> 5)) * Nsrc + sn0 + (lane & 31)]);
#pragma unroll
        for (int i = 0; i < 32; ++i) scr[(2 * i + (lane >> 5)) * 33 + (lane & 31)] = t[i] * scale;
    } else {
#pragma unroll 8
        for (int i = 0; i < 32; ++i) { const int kk = 2 * i + (lane >> 5); scr[kk * 33 + (lane & 31)] = 0.f; }
    }
    asm volatile("s_waitcnt lgkmcnt(0)" ::: "memory");
    const int c = lane & 7;
#pragma unroll
    for (int j = 0; j < 4; ++j) {
        const int n = (lane >> 3) + 8 * j; const LAS float* s = scr + (8 * c) * 33 + n;
        u32x2 o; o.x = pk4_fp8(s[0 * 33], s[1 * 33], s[2 * 33], s[3 * 33]); o.y = pk4_fp8(s[4 * 33], s[5 * 33], s[6 * 33], s[7 * 33]);
        *(u32x2*)(WT + (size_t)(dn0 + n) * K + k0 + 8 * c) = o;
    }
    asm volatile("s_waitcnt lgkmcnt(0)" ::: "memory");
}

DI void cvt_bf16_stream(const float* src, bf16* dst, size_t n8, size_t gtid, size_t nthr) {
    for (size_t i = gtid; i < n8; i += nthr) {
        const f32x4 a = *(const f32x4*)(src + i * 8), b = *(const f32x4*)(src + i * 8 + 4);
        u32x4 w; w.x = pk2(a[0], a[1]); w.y = pk2(a[2], a[3]); w.z = pk2(b[0], b[1]); w.w = pk2(b[2], b[3]);
        *(u32x4*)(dst + i * 8) = w;
    }
}

DI void phase_prologue(Frame& F) {
    LAS float* scr = (LAS float*)(F.lds + F.wave * 16384);
    constexpr int I_WIN = 32 * 312, I_WB = 16 * 64, I_WO = 32 * 64;
    constexpr int NITEMS = I_WIN + 2 * I_WB + 2 * I_WO;
#ifndef PRO_REP_T
#define PRO_REP_T 1
#endif
#ifndef PRO_REP_G
#define PRO_REP_G 1
#endif
#pragma nounroll
    for (int rep_t = 0; rep_t < PRO_REP_T; ++rep_t)
    for (int it = F.gw; it < NITEMS; it += F.NGW) {
        int r = it;
        if (r < I_WIN) { const int kb = r / 312, nb = r % 312; const int snb = nb < 176 ? nb : (nb < 304 ? nb + 1 : (nb == 304 ? 176 : -1));
            transpose_item_fp8(F.in[8], DM, INW, snb < 0 ? -1 : snb * 32, F.ws + WS_WIN, nb * 32, kb * 64, WIN_SCALE, scr, F.lane); continue; }
        r -= I_WIN;
        if (r < I_WB) {
            if (MERGE_F8_A) transpose_item_fp8(F.in[15], 1024, DM, (r % 64) * 32, F.ws + WS_WBA, (r % 64) * 32, (r / 64) * 64, WB_SCALE, scr, F.lane);
            else transpose_item(F.in[15], 1024, DM, (r % 64) * 32, (bf16*)(F.ws + WS_WBA), (r % 64) * 32, (r / 64) * 64, scr, F.lane);
            continue; }
        r -= I_WB;
        if (r < I_WB) {
            if (MERGE_F8_B) transpose_item_fp8(F.in[16], 1024, DM, (r % 64) * 32, F.ws + WS_WBD, (r % 64) * 32, (r / 64) * 64, WB_SCALE, scr, F.lane);
            else transpose_item(F.in[16], 1024, DM, (r % 64) * 32, (bf16*)(F.ws + WS_WBD), (r % 64) * 32, (r / 64) * 64, scr, F.lane);
            continue; }
        r -= I_WB;
        if (r < I_WO) { transpose_item(F.in[17], DM, DM, (r % 64) * 32, (bf16*)(F.ws + WS_WOUT), (r % 64) * 32, (r / 64) * 64, scr, F.lane); continue; }
        r -= I_WO;
        transpose_item(F.in[18], DM, DM, (r % 64) * 32, (bf16*)(F.ws + WS_WQ), (r % 64) * 32, (r / 64) * 64, scr, F.lane);
    }
    cvt_bf16_stream(F.in[19], (bf16*)(F.ws + WS_SUBK), (size_t)8 * 2 * 128 * 128 / 8, (size_t)blockIdx.x * 512 + F.tid, (size_t)F.G * 512);
    LAS float* sc = (LAS float*)(F.lds + 131072);
    const float* ada_w = F.in[4];
    float* MODP = (float*)(F.ws + WS_MODP);
#pragma nounroll
    for (int rep_g = 0; rep_g < PRO_REP_G; ++rep_g)
    for (int it = blockIdx.x; it < 32 * 24; it += F.G) {
        const int kc = it / 24, nb = it % 24, n = nb * 512 + F.tid;
        __syncthreads();
        if (F.tid < 320) { const int r = F.tid >> 6, kk = F.tid & 63, k = kc * 64 + kk; const float cv = (r < 4) ? F.in[1][r * DM + k] : F.in[3][k]; sc[r * 64 + kk] = silu(cv); }
        __syncthreads();
        float a0 = 0.f, a1 = 0.f, a2 = 0.f, a3 = 0.f, a4 = 0.f;
#pragma unroll 32
        for (int kk = 0; kk < 64; ++kk) {
            const float w = __builtin_nontemporal_load(&ada_w[(size_t)(kc * 64 + kk) * 12288 + n]);
            a0 += sc[kk] * w; a1 += sc[64 + kk] * w; a2 += sc[128 + kk] * w; a3 += sc[192 + kk] * w; a4 += sc[256 + kk] * w;
        }
        float* o = MODP + (size_t)kc * 5 * 12288 + n;
        o[0] = a0; o[12288] = a1; o[2 * 12288] = a2; o[3 * 12288] = a3; o[4 * 12288] = a4;
    }
}

DI void phase_modreduce(Frame& F) {
    const float* MODP = (const float*)(F.ws + WS_MODP); float* MOD = (float*)(F.ws + WS_MOD); const float* ada_b = F.in[5];
    for (int i = blockIdx.x * 512 + F.tid; i < 5 * 12288; i += F.G * 512) {
        const int n = i % 12288; float s = ada_b[n];
#pragma unroll 8
        for (int kc = 0; kc < 32; ++kc) s += MODP[(size_t)kc * 5 * 12288 + i];
        MOD[i] = s;
    }
}

DI void modnorm_row(const float* xrow, bf16* orow, const float* nw, const float* sc, const float* sh, int lane) {
    f32x4 v[8]; float ss = 0.f;
#pragma unroll
    for (int j = 0; j < 8; ++j) { v[j] = *((const f32x4*)xrow + lane + 64 * j); ss += (v[j][0] * v[j][0] + v[j][1] * v[j][1]) + (v[j][2] * v[j][2] + v[j][3] * v[j][3]); }
    const float rstd = rsqrtf(wave_sum(ss) * (1.f / DM) + EPS);
#pragma unroll
    for (int j = 0; j < 8; ++j) {
        const int c = (lane + 64 * j) * 4;
        const f32x4 w = *(const f32x4*)(nw + c), s = *(const f32x4*)(sc + c), h = *(const f32x4*)(sh + c);
        f32x4 o;
#pragma unroll
        for (int i = 0; i < 4; ++i) o[i] = (v[j][i] * rstd * w[i]) * (1.f + s[i]) + h[i];
        u32x2 p; p.x = pk2(o[0], o[1]); p.y = pk2(o[2], o[3]);
        *(u32x2*)(orow + c) = p;
    }
}

DI void modnorm_row_bf(const bf16* xrow, bf16* orow, const float* nw, const float* sc, const float* sh, int lane) {
    f32x4 v[8]; float ss = 0.f;
#pragma unroll
    for (int j = 0; j < 8; ++j) { const u32x2 w = *((const u32x2*)xrow + lane + 64 * j); v[j] = (f32x4){bflo(w.x), bfhi(w.x), bflo(w.y), bfhi(w.y)}; ss += (v[j][0] * v[j][0] + v[j][1] * v[j][1]) + (v[j][2] * v[j][2] + v[j][3] * v[j][3]); }
    const float rstd = rsqrtf(wave_sum(ss) * (1.f / DM) + EPS);
#pragma unroll
    for (int j = 0; j < 8; ++j) {
        const int c = (lane + 64 * j) * 4;
        const f32x4 w = *(const f32x4*)(nw + c), s = *(const f32x4*)(sc + c), h = *(const f32x4*)(sh + c);
        f32x4 o;
#pragma unroll
        for (int i = 0; i < 4; ++i) o[i] = (v[j][i] * rstd * w[i]) * (1.f + s[i]) + h[i];
        u32x2 p; p.x = pk2(o[0], o[1]); p.y = pk2(o[2], o[3]);
        *(u32x2*)(orow + c) = p;
    }
}

DI void modnorm_row_fp8(const float* xrow, unsigned char* orow, const float* nw, const float* sc, const float* sh, int lane) {
    f32x4 v[8]; float ss = 0.f;
#pragma unroll
    for (int j = 0; j < 8; ++j) { v[j] = __builtin_nontemporal_load((const f32x4*)xrow + lane + 64 * j); ss += (v[j][0] * v[j][0] + v[j][1] * v[j][1]) + (v[j][2] * v[j][2] + v[j][3] * v[j][3]); }
    const float rstd = rsqrtf(wave_sum(ss) * (1.f / DM) + EPS);
#pragma unroll
    for (int j = 0; j < 8; ++j) {
        const int c = (lane + 64 * j) * 4;
        const f32x4 w = *(const f32x4*)(nw + c), s = *(const f32x4*)(sc + c), h = *(const f32x4*)(sh + c);
        f32x4 o;
#pragma unroll
        for (int i = 0; i < 4; ++i) o[i] = (v[j][i] * rstd * w[i]) * (1.f + s[i]) + h[i];
        *(unsigned*)(orow + c) = pk4_fp8(o[0], o[1], o[2], o[3]);
    }
}

struct ModPar { f32x4 a[8], h[8]; };
DI void modpar_load(ModPar& P, const float* nw, const float* sc, const float* sh, int lane) {
#pragma unroll
    for (int j = 0; j < 8; ++j) { const int c = (lane + 64 * j) * 4; const f32x4 w = *(const f32x4*)(nw + c), s = *(const f32x4*)(sc + c); P.a[j] = w * (1.f + s); P.h[j] = *(const f32x4*)(sh + c); }
}
DI void modnorm_rows_fp8(const float* x0, unsigned char* o0, int nrows, const ModPar& P, int lane) {
    f32x4 v[8];
#pragma unroll
    for (int j = 0; j < 8; ++j) v[j] = __builtin_nontemporal_load((const f32x4*)x0 + lane + 64 * j);
    for (int r = 0; r < nrows; ++r) {
        float ss = 0.f;
#pragma unroll
        for (int j = 0; j < 8; ++j) ss += (v[j][0] * v[j][0] + v[j][1] * v[j][1]) + (v[j][2] * v[j][2] + v[j][3] * v[j][3]);
        const float rstd = rsqrtf(wave_sum(ss) * (1.f / DM) + EPS);
        unsigned char* orow = o0 + (size_t)r * DM;
        const float* xn = x0 + (size_t)(r + 1 < nrows ? r + 1 : r) * DM;
#pragma unroll
        for (int j = 0; j < 8; ++j) {
            const f32x4 o = (v[j] * rstd) * P.a[j] + P.h[j];
            v[j] = __builtin_nontemporal_load((const f32x4*)xn + lane + 64 * j);
            *(unsigned*)(orow + (lane + 64 * j) * 4) = pk4_fp8(o[0], o[1], o[2], o[3]);
        }
    }
}
DI void modnorm_rows_bf(const bf16* x0, bf16* o0, int nrows, const ModPar& P, int lane) {
    u32x2 w[8];
#pragma unroll
    for (int j = 0; j < 8; ++j) w[j] = *((const u32x2*)x0 + lane + 64 * j);
    for (int r = 0; r < nrows; ++r) {
        f32x4 v[8]; float ss = 0.f;
#pragma unroll
        for (int j = 0; j < 8; ++j) { v[j] = (f32x4){bflo(w[j].x), bfhi(w[j].x), bflo(w[j].y), bfhi(w[j].y)}; ss += (v[j][0] * v[j][0] + v[j][1] * v[j][1]) + (v[j][2] * v[j][2] + v[j][3] * v[j][3]); }
        const float rstd = rsqrtf(wave_sum(ss) * (1.f / DM) + EPS);
        bf16* orow = o0 + (size_t)r * DM;
        const bf16* xn = x0 + (size_t)(r + 1 < nrows ? r + 1 : r) * DM;
#pragma unroll
        for (int j = 0; j < 8; ++j) {
            const f32x4 o = (v[j] * rstd) * P.a[j] + P.h[j];
            w[j] = *((const u32x2*)xn + lane + 64 * j);
            u32x2 p; p.x = pk2(o[0], o[1]); p.y = pk2(o[2], o[3]);
            *(u32x2*)(orow + (lane + 64 * j) * 4) = p;
        }
    }
}

DI void phase_h1(Frame& F) {
    const float* MOD = (const float*)(F.ws + WS_MOD); unsigned char* H = F.ws + WS_H;
    ModPar P;
    {
        constexpr int RPW = NT / (256 * NWAVES);
        const int m0 = F.gw * RPW, r = m0 >> 12;
        if (F.NGW == 256 * NWAVES) {
            modpar_load(P, F.in[6], MOD + (size_t)r * 12288 + 2048, MOD + (size_t)r * 12288, F.lane);
            modnorm_rows_fp8(F.in[0] + (size_t)m0 * DM, H + (size_t)m0 * DM, RPW, P, F.lane);
        } else {
            for (int m = F.gw; m < NT; m += F.NGW) { modpar_load(P, F.in[6], MOD + (size_t)(m >> 12) * 12288 + 2048, MOD + (size_t)(m >> 12) * 12288, F.lane); modnorm_rows_fp8(F.in[0] + (size_t)m * DM, H + (size_t)m * DM, 1, P, F.lane); }
        }
    }
    if (F.gw < NC) {
        modpar_load(P, F.in[6], MOD + (size_t)4 * 12288 + 2048, MOD + (size_t)4 * 12288, F.lane);
        for (int m = F.gw; m < NC; m += F.NGW) modnorm_rows_fp8(F.in[2] + (size_t)m * DM, H + (size_t)(NT + m) * DM, 1, P, F.lane);
    }
}

DI void phase_postproj(Frame& F) {
    const int lane = F.lane, tid = F.tid;
    LAS float* tcs = (LAS float*)F.lds;
    for (int i = tid; i < 2048; i += 512) { const int pos = i >> 5, f = i & 31; float sn, cs; sincosf((float)pos * exp2f(-(float)f * (13.287712379549449f / 32.f)), &sn, &cs); tcs[i] = cs; tcs[2048 + i] = sn; }
    __syncthreads();
    {
        bf16* QN = (bf16*)(F.ws + WS_QN); bf16* KB = (bf16*)(F.ws + WS_KB);
        const int j = lane & 7, axis = j >> 2, fg = j & 3, d1 = axis * 64 + 8 * fg;
        f32x4 qw[4], kw[4];
        qw[0] = *(const f32x4*)(F.in[9] + d1); qw[1] = *(const f32x4*)(F.in[9] + d1 + 4); qw[2] = *(const f32x4*)(F.in[9] + d1 + 32); qw[3] = *(const f32x4*)(F.in[9] + d1 + 36);
        kw[0] = *(const f32x4*)(F.in[10] + d1); kw[1] = *(const f32x4*)(F.in[10] + d1 + 4); kw[2] = *(const f32x4*)(F.in[10] + d1 + 32); kw[3] = *(const f32x4*)(F.in[10] + d1 + 36);
        constexpr int NQI = NT, NKI = NB * LKV / 4;
        for (int it = F.gw; it < NQI + NKI; it += F.NGW) {
            bf16* p; int t; bool rope; const bool isq = it < NQI;
            if (isq) { p = QN + (size_t)it * 1024 + (lane >> 3) * 128; t = it & 4095; rope = true; }
            else { const int row = (it - NQI) * 4 + (lane >> 4), pp = row % LKV; p = KB + (size_t)row * 256 + ((lane >> 3) & 1) * 128; t = pp; rope = pp < TS; }
            const u32x4 w1 = *(const u32x4*)(p + d1), w2 = *(const u32x4*)(p + d1 + 32);
            float x1[8], x2[8];
            x1[0] = bflo(w1.x); x1[1] = bfhi(w1.x); x1[2] = bflo(w1.y); x1[3] = bfhi(w1.y); x1[4] = bflo(w1.z); x1[5] = bfhi(w1.z); x1[6] = bflo(w1.w); x1[7] = bfhi(w1.w);
            x2[0] = bflo(w2.x); x2[1] = bfhi(w2.x); x2[2] = bflo(w2.y); x2[3] = bfhi(w2.y); x2[4] = bflo(w2.z); x2[5] = bfhi(w2.z); x2[6] = bflo(w2.w); x2[7] = bfhi(w2.w);
            float ss = 0.f;
#pragma unroll
            for (int i = 0; i < 8; ++i) ss += x1[i] * x1[i] + x2[i] * x2[i];
            ss += __shfl_xor(ss, 1); ss += __shfl_xor(ss, 2); ss += __shfl_xor(ss, 4);
            const float rstd = rsqrtf(ss * (1.f / 128.f) + EPS);
            const int pos = axis == 0 ? (t >> 6) : (t & 63);
            float o1[8], o2[8];
#pragma unroll
            for (int i = 0; i < 8; ++i) {
                const float wa = isq ? qw[i >> 2][i & 3] : kw[i >> 2][i & 3], wb = isq ? qw[2 + (i >> 2)][i & 3] : kw[2 + (i >> 2)][i & 3];
                const float y1 = x1[i] * rstd * wa, y2 = x2[i] * rstd * wb;
                const float cs = rope ? tcs[pos * 32 + 8 * fg + i] : 1.f, sn = rope ? tcs[2048 + pos * 32 + 8 * fg + i] : 0.f;
                o1[i] = y1 * cs - y2 * sn; o2[i] = y2 * cs + y1 * sn;
            }
            u32x4 r1, r2;
            r1.x = pk2(o1[0], o1[1]); r1.y = pk2(o1[2], o1[3]); r1.z = pk2(o1[4], o1[5]); r1.w = pk2(o1[6], o1[7]);
            r2.x = pk2(o2[0], o2[1]); r2.y = pk2(o2[2], o2[3]); r2.z = pk2(o2[4], o2[5]); r2.w = pk2(o2[6], o2[7]);
            *(u32x4*)(p + d1) = r1; *(u32x4*)(p + d1 + 32) = r2;
        }
    }
    {
        const bf16* RAW = (const bf16*)(F.ws + WS_DNRAW); const float* cw = F.in[11];
        for (int it = F.gw; it < (MTOT / 16) * 6; it += F.NGW) {
            const int tc = it / 6, grp = it % 6, m0 = tc * 16, part = grp >> 1;
            int start, len; if (m0 < NT) { start = m0 & ~4095; len = TS; } else { start = NT + ((m0 - NT) & ~255); len = CL; }
            const int pos0 = m0 - start, c = grp * 512 + 8 * lane;
            float wv[5][8];
#pragma unroll
            for (int jj = 0; jj < 5; ++jj) { const f32x4 a = *(const f32x4*)(cw + jj * 3072 + c), b = *(const f32x4*)(cw + jj * 3072 + c + 4);
                wv[jj][0] = a[0]; wv[jj][1] = a[1]; wv[jj][2] = a[2]; wv[jj][3] = a[3]; wv[jj][4] = b[0]; wv[jj][5] = b[1]; wv[jj][6] = b[2]; wv[jj][7] = b[3]; }
            u32x4 rows[20];
#pragma unroll
            for (int r = 0; r < 20; ++r) { const int pp = pos0 + r - 2; rows[r] = (pp >= 0 && pp < len) ? *(const u32x4*)(RAW + (size_t)(start + pp) * 3072 + c) : (u32x4){0u, 0u, 0u, 0u}; }
            bf16* dst = (bf16*)(F.ws + (part == 0 ? WS_DQ : (part == 1 ? WS_DK : WS_DV))) + dn_off(m0, (grp & 1) * 4 + (lane >> 4)) + 8 * (lane & 15);
#pragma unroll
            for (int tk = 0; tk < 16; ++tk) {
                float a[8];
#pragma unroll
                for (int i = 0; i < 8; ++i) a[i] = 0.f;
#pragma unroll
                for (int jj = 0; jj < 5; ++jj) { const u32x4 w = rows[tk + jj];
                    a[0] += wv[jj][0] * bflo(w.x); a[1] += wv[jj][1] * bfhi(w.x); a[2] += wv[jj][2] * bflo(w.y); a[3] += wv[jj][3] * bfhi(w.y);
                    a[4] += wv[jj][4] * bflo(w.z); a[5] += wv[jj][5] * bfhi(w.z); a[6] += wv[jj][6] * bflo(w.w); a[7] += wv[jj][7] * bfhi(w.w); }
                float ss = 0.f;
#pragma unroll
                for (int i = 0; i < 8; ++i) { a[i] = silu(a[i]); ss += a[i] * a[i]; }
                if (part < 2) {
                    ss += __shfl_xor(ss, 1); ss += __shfl_xor(ss, 2); ss += __shfl_xor(ss, 4); ss += __shfl_xor(ss, 8);
                    const float r = rsqrtf(ss + EPS) * (part == 0 ? 0.088388347648318440f : 1.f);
#pragma unroll
                    for (int i = 0; i < 8; ++i) a[i] *= r;
                }
                u32x4 o; o.x = pk2(a[0], a[1]); o.y = pk2(a[2], a[3]); o.z = pk2(a[4], a[5]); o.w = pk2(a[6], a[7]);
                *(u32x4*)(dst + tk * 128) = o;
            }
        }
    }
}

DI void phase_dn_naive(Frame& F) {
    if (F.wave != 0 || blockIdx.x >= 128) return;
    const int item = blockIdx.x, dir = item >> 6, b = (item >> 4) & 3, h = (item >> 1) & 7, half = item & 1, lane = F.lane;
    const bf16* DQ = (const bf16*)(F.ws + WS_DQ); const bf16* DK = (const bf16*)(F.ws + WS_DK); const bf16* DV = (const bf16*)(F.ws + WS_DV);
    const float* BETA = (const float*)(F.ws + WS_BETA); const float* LOGA = (const float*)(F.ws + WS_LOGA);
    bf16* ODN = (bf16*)(F.ws + WS_ODN);
    float S[128];
#pragma unroll
    for (int i = 0; i < 128; ++i) S[i] = 0.f;
    for (int step = 0; step < LKV; ++step) {
        const bool isl = step >= CL; const int p = isl ? step - CL : step, len = isl ? TS : CL, pos = dir ? len - 1 - p : p;
        const int m = isl ? b * TS + pos : NT + b * CL + pos;
        const unsigned kw = *(const unsigned*)(DK + dn_off(m, h) + 2 * lane);
        const unsigned qw = *(const unsigned*)(DQ + dn_off(m, h) + 2 * lane);
        const float vj = bf2f(DV[dn_off(m, h) + half * 64 + lane]);
        const float a = __expf(LOGA[(size_t)m * 16 + dir * 8 + h]), bt = BETA[(size_t)m * 16 + dir * 8 + h];
        float k0 = 0.f, k1 = 0.f, k2 = 0.f, k3 = 0.f;
#pragma unroll
        for (int i = 0; i < 64; i += 2) {
            const unsigned w0 = rdlane(kw, i), w1 = rdlane(kw, i + 1);
            k0 += bflo(w0) * S[2 * i]; k1 += bfhi(w0) * S[2 * i + 1]; k2 += bflo(w1) * S[2 * i + 2]; k3 += bfhi(w1) * S[2 * i + 3];
        }
        const float kS = (k0 + k1) + (k2 + k3);
        const float coef = bt * (vj - a * kS);
#pragma unroll
        for (int i = 0; i < 64; ++i) { const unsigned w0 = rdlane(kw, i); S[2 * i] = a * S[2 * i] + coef * bflo(w0); S[2 * i + 1] = a * S[2 * i + 1] + coef * bfhi(w0); }
        if (isl) {
            float o0 = 0.f, o1 = 0.f, o2 = 0.f, o3 = 0.f;
#pragma unroll
            for (int i = 0; i < 64; i += 2) {
                const unsigned w0 = rdlane(qw, i), w1 = rdlane(qw, i + 1);
                o0 += bflo(w0) * S[2 * i]; o1 += bfhi(w0) * S[2 * i + 1]; o2 += bflo(w1) * S[2 * i + 2]; o3 += bfhi(w1) * S[2 * i + 3];
            }
            ODN[((size_t)dir * NT + m) * 1024 + h * 128 + half * 64 + lane] = (bf16)f2bf((o0 + o1) + (o2 + o3));
        }
    }
}

DI int dn_row0(int b, int cc) { return cc < 4 ? NT + b * CL + 64 * cc : b * TS + 64 * (cc - 4); }
typedef short bf16x8_t __attribute__((ext_vector_type(8)));
#define MFMA16(a, b, c) __builtin_amdgcn_mfma_f32_16x16x32_bf16((a), (b), (c), 0, 0, 0)

DI bf16x8_t dn_afrag(const LAS unsigned char* p) {
    const u32x2 lo = *(const LAS u32x2*)p, hi = *(const LAS u32x2*)(p + 32);
    u32x4 v; v.x = lo.x; v.y = lo.y; v.z = hi.x; v.w = hi.y; return __builtin_bit_cast(bf16x8_t, v);
}
DI bf16x8_t dn_bpack(const f32x4 t0, const f32x4 t1) {
    u32x4 v; v.x = pk2(t0[0], t0[1]); v.y = pk2(t0[2], t0[3]); v.z = pk2(t1[0], t1[1]); v.w = pk2(t1[2], t1[3]); return __builtin_bit_cast(bf16x8_t, v);
}
DI void phase_dn_prep(Frame& F) {
    LAS unsigned char* L = F.lds;
    constexpr int KS = 0, QS = 17408, VC = 34816, AP = 35840;
    constexpr int NITEM = NB * 8 * 68, NBATCH = (NITEM + 2) / 3;
    const bf16* DQ = (const bf16*)(F.ws + WS_DQ); const bf16* DK = (const bf16*)(F.ws + WS_DK);
    const float* BETA = (const float*)(F.ws + WS_BETA); const float* LOGA = (const float*)(F.ws + WS_LOGA);
    bf16* KT = (bf16*)(F.ws + WS_KT); bf16* TINV = (bf16*)(F.ws + WS_TINV); bf16* QKO = (bf16*)(F.ws + WS_QKO); float* VEC = (float*)(F.ws + WS_VEC);
    const int tid = F.tid, wave = F.wave;
    LAS float* vg = (LAS float*)(L + VC); LAS float* vb = vg + 128;
    for (int batch = F.vcu; batch < NBATCH; batch += F.G) {
        int lane = F.lane; asm volatile("" : "+v"(lane));
        const int fr = lane & 15, fq = lane >> 4;
#pragma unroll 1
        for (int c3 = 0; c3 < 3; ++c3) {
            const int item = batch * 3 + c3;
            if (item >= NITEM) break;
            const int b = item / 544, h = (item % 544) / 68, cc = item % 68, row0 = dn_row0(b, cc);
#pragma unroll
            for (int k = 0; k < 4; ++k) {
                const int c = tid + 512 * k, which = c >> 10, c2 = c & 1023, row = c2 >> 4, c16 = c2 & 15;
                const u32x4 v = *(const u32x4*)((which ? DQ : DK) + (size_t)item * 8192 + c2 * 8);
                *(LAS u32x4*)(L + (which ? QS : KS) + row * 272 + c16 * 16) = v;
            }
            if (wave < 2) {
                const int d = wave, i = lane;
                const float la = LOGA[(size_t)(row0 + i) * 16 + d * 8 + h], bt = BETA[(size_t)(row0 + i) * 16 + d * 8 + h];
                float x = la;
                if (d == 0) {
#pragma unroll
                    for (int o = 1; o < 64; o <<= 1) { const float y = __shfl_up(x, o); if (i >= o) x += y; }
                } else {
#pragma unroll
                    for (int o = 1; o < 64; o <<= 1) { const float y = __shfl_down(x, o); if (i + o < 64) x += y; }
                }
                const float glast = __shfl(x, d == 0 ? 63 : 0);
                vg[d * 64 + i] = x; vb[d * 64 + i] = bt;
                float* ve = VEC + (size_t)(item * 2 + d) * 320;
                const float eg = __expf(x);
                ve[i] = bt; ve[64 + i] = eg; ve[128 + i] = bt * eg; ve[192 + i] = __expf(glast - x); ve[256 + i] = __expf(glast);
            }
            __syncthreads();
            {
                bf16* kt = KT + (size_t)item * 8192;
#pragma unroll
                for (int k = 0; k < 2; ++k) {
                    const int c = tid + 512 * k, dk = c >> 3, t8 = c & 7;
                    unsigned short e[8];
#pragma unroll
                    for (int q = 0; q < 8; ++q) e[q] = *(const LAS unsigned short*)(L + KS + (8 * t8 + q) * 272 + dk * 2);
                    u32x4 w; w.x = e[0] | ((unsigned)e[1] << 16); w.y = e[2] | ((unsigned)e[3] << 16); w.z = e[4] | ((unsigned)e[5] << 16); w.w = e[6] | ((unsigned)e[7] << 16);
                    *(u32x4*)(kt + dk * 64 + 8 * t8) = w;
                }
            }
            {
                const int it = wave & 3, mat = wave >> 2;
                f32x4 acc[4];
#pragma unroll
                for (int j = 0; j < 4; ++j) acc[j] = (f32x4){0.f, 0.f, 0.f, 0.f};
#pragma unroll
                for (int s = 0; s < 4; ++s) {
                    const bf16x8_t a = *(const LAS bf16x8_t*)(L + (mat ? QS : KS) + (16 * it + fr) * 272 + (32 * s + 8 * fq) * 2);
#pragma unroll
                    for (int jt = 0; jt < 4; ++jt) {
                        const bf16x8_t bb = *(const LAS bf16x8_t*)(L + KS + (16 * jt + fr) * 272 + (32 * s + 8 * fq) * 2);
                        acc[jt] = MFMA16(a, bb, acc[jt]);
                    }
                }
#pragma unroll
                for (int d = 0; d < 2; ++d) {
                    LAS float* ap = (LAS float*)(L + AP + (c3 * 2 + d) * 17408);
                    bf16* qo = QKO + (size_t)(item * 2 + d) * 4096;
#pragma unroll
                    for (int jt = 0; jt < 4; ++jt)
#pragma unroll
                        for (int r = 0; r < 4; ++r) {
                            const int i = 16 * it + 4 * fq + r, j = 16 * jt + fr, ip = d ? 63 - i : i, jp = d ? 63 - j : j;
                            const float dg = vg[d * 64 + i] - vg[d * 64 + j];
                            if (mat == 0) { ap[ip * 68 + jp] = (jp < ip) ? vb[d * 64 + i] * acc[jt][r] * __expf(dg) : 0.f; }
                            else { qo[i * 64 + j] = (bf16)f2bf((jp <= ip) ? acc[jt][r] * __expf(dg) : 0.f); }
                        }
                }
            }
            __syncthreads();
        }
        if (wave < 6 && batch * 3 + (wave >> 1) < NITEM) {
            const int item = batch * 3 + (wave >> 1), d = wave & 1, c = lane;
            const LAS float* ap = (const LAS float*)(L + AP + wave * 17408);
            float x[64];
#pragma unroll
            for (int ip = 0; ip < 64; ++ip) {
                float a0 = (ip == c) ? 1.f : 0.f, a1 = 0.f;
#pragma unroll
                for (int q = 0; q < (ip + 3) / 4; ++q) {
                    const f32x4 av = *(const LAS f32x4*)(ap + ip * 68 + 4 * q);
#pragma unroll
                    for (int e = 0; e < 4; ++e) { const int jp = 4 * q + e; if (jp < ip) { if (e & 1) a1 -= av[e] * x[jp]; else a0 -= av[e] * x[jp]; } }
                }
                x[ip] = a0 + a1;
                __builtin_amdgcn_sched_barrier(0);
            }
            bf16* ti = TINV + (size_t)(item * 2 + d) * 4096;
            const int j = d ? 63 - c : c;
#pragma unroll
            for (int ip = 0; ip < 64; ++ip) { const int i = d ? 63 - ip : ip; ti[i * 64 + j] = (bf16)f2bf(x[ip]); }
        }
        __syncthreads();
    }
}

DI int dn_perm(int m, int t) { return 32 * (t >> 1) + 8 * (m >> 2) + 4 * (t & 1) + (m & 3); }
DI int dn_swz16(int row, int chunk) { return row * 272 + (chunk << 4); }
DI int dn_swz8(int row, int chunk) { return row * 144 + (chunk << 4); }
#define DN_BAR() do { asm volatile("s_waitcnt lgkmcnt(0)" ::: "memory"); __builtin_amdgcn_s_barrier(); asm volatile("" ::: "memory"); } while (0)
DI void phase_dn_scan(Frame& F) {
    LAS unsigned char* L = F.lds;
    constexpr int KS = 0, QS = 17408, KTS = 34816, TIS = 53248, VS = 62464, VCS = 66560, BUF = 68096;
    constexpr int PUBS = 2 * BUF, PUBV = PUBS + 16384;
    static_assert(PUBV + 8192 <= LDS_BYTES - 64, "scan LDS map");
    const int G8 = F.G >> 3;
    const int li = blockIdx.x >> 3, chain = (blockIdx.x & 7) * (G8 >> 2) + (li >> 2), qd = li & 3;
    if (F.G != 256 || chain >= 64) return;
    const int dir = chain >> 5, b = (chain >> 3) & 3, h = chain & 7;
    const bf16* DQ = (const bf16*)(F.ws + WS_DQ); const bf16* DK = (const bf16*)(F.ws + WS_DK); const bf16* DV = (const bf16*)(F.ws + WS_DV);
    const bf16* KT = (const bf16*)(F.ws + WS_KT); const bf16* TINV = (const bf16*)(F.ws + WS_TINV); const bf16* QKO = (const bf16*)(F.ws + WS_QKO); const float* VEC = (const float*)(F.ws + WS_VEC);
    bf16* ODN = (bf16*)(F.ws + WS_ODN);
    const int tid = F.tid, lane = F.lane, w = F.wave, fr = lane & 15, fq = lane >> 4;
#ifndef DN_NSTEP
#define DN_NSTEP 68
#endif
#define DN_CC1(st) (dir == 0 ? (st) : ((st) < 4 ? 3 - (st) : 71 - (st)))
#define DN_CC(step) DN_CC1((step) % 68)
#define AF16(base, row, kchunk) (*(const LAS bf16x8_t*)(Lb + (base) + dn_swz16((row), (kchunk))))
#define AF8(base, row, kchunk) (*(const LAS bf16x8_t*)(Lb + (base) + dn_swz8((row), (kchunk))))
    if (w >= 4) {
        const int lt = tid - 256;
        u32x4 preA[16], preB[16];
#define DN_LOAD(pre, cc_) do { const int cc__ = (cc_); const int item__ = (b * 8 + h) * 68 + cc__, cd__ = item__ * 2 + dir; \
        _Pragma("unroll") for (int k = 0; k < 16; ++k) { const bf16* src; \
            if (k < 4)       { const int q = lt + 256 * k;        src = DK + (size_t)item__ * 8192 + q * 8; } \
            else if (k < 8)  { const int q = lt + 256 * (k - 4);  src = DQ + (size_t)item__ * 8192 + q * 8; } \
            else if (k < 12) { const int q = lt + 256 * (k - 8);  src = KT + (size_t)item__ * 8192 + q * 8; } \
            else if (k < 14) { const int q = lt + 256 * (k - 12); src = TINV + (size_t)cd__ * 4096 + q * 8; } \
            else if (k == 14) { src = DV + (size_t)item__ * 8192 + (lt >> 2) * 128 + qd * 32 + (lt & 3) * 8; } \
            else { src = (const bf16*)(VEC + (size_t)cd__ * 320 + (lt < 80 ? lt : 0) * 4); } \
            pre[k] = *(const u32x4*)src; } } while (0)
#define DN_STORE(pre, bufo_) do { const int bo__ = (bufo_); _Pragma("unroll") for (int k = 0; k < 16; ++k) { int dst; \
            if (k < 4)       { const int q = lt + 256 * k;        dst = KS + dn_swz16(q >> 4, q & 15); } \
            else if (k < 8)  { const int q = lt + 256 * (k - 4);  dst = QS + dn_swz16(q >> 4, q & 15); } \
            else if (k < 12) { const int q = lt + 256 * (k - 8);  dst = KTS + dn_swz8(q >> 3, q & 7); } \
            else if (k < 14) { const int q = lt + 256 * (k - 12); dst = TIS + dn_swz8(q >> 3, q & 7); } \
            else if (k == 14) { dst = VS + lt * 16; } \
            else { dst = VCS + (lt < 80 ? lt : 0) * 16; } \
            *(LAS u32x4*)(L + bo__ + dst) = pre[k]; } } while (0)
#ifdef DN_SKIP_LOAD
#define DN_CLAMP(ds) ((ds) < DN_NSTEP - 70 ? 0 : (ds) < DN_NSTEP ? (ds) : DN_NSTEP - 1)
#else
#define DN_CLAMP(ds) ((ds) < DN_NSTEP ? (ds) : DN_NSTEP - 1)
#endif
#ifndef DN_SLEEP
#define DN_SLEEP 8
#endif
#define DN_LDELAY() __builtin_amdgcn_s_sleep(DN_SLEEP)
        DN_LOAD(preA, DN_CC(0)); DN_STORE(preA, 0); DN_LOAD(preA, DN_CC(1)); DN_LOAD(preB, DN_CC(2));
        DN_BAR();
        for (int step = 0; step < DN_NSTEP; step += 2) {
            DN_LDELAY(); DN_STORE(preA, BUF); DN_LOAD(preA, DN_CC(DN_CLAMP(step + 3)));
            DN_BAR();
            DN_LDELAY(); DN_STORE(preB, 0); DN_LOAD(preB, DN_CC(DN_CLAMP(step + 4)));
            DN_BAR();
        }
#undef DN_CLAMP
#undef DN_LOAD
#undef DN_STORE
    } else if (w >= 2) {
        const int pw = w - 2;
        bf16x8_t qkA[2][4], qkB[2][4];
        f32x4 O[4];
#define DN_QKLOAD(dst, st_) do { const int cd__ = ((b * 8 + h) * 68 + DN_CC(st_)) * 2 + dir; \
        _Pragma("unroll") for (int s = 0; s < 2; ++s) _Pragma("unroll") for (int mt = 0; mt < 4; ++mt) \
            dst[s][mt] = *(const bf16x8_t*)(QKO + (size_t)cd__ * 4096 + dn_perm(fr, mt) * 64 + (4 * s + fq) * 8); } while (0)
#define DN_OFIN(qk, st_) do { const int st__ = (st_); const LAS unsigned char* pv = L + PUBV + (st__ & 1) * 4096 + pw * 2048 + lane * 16; \
        const bf16x8_t vb0 = *(const LAS bf16x8_t*)pv, vb1 = *(const LAS bf16x8_t*)(pv + 1024); \
        _Pragma("unroll") for (int mt = 0; mt < 4; ++mt) { O[mt] = MFMA16(vb0, qk[0][mt], O[mt]); O[mt] = MFMA16(vb1, qk[1][mt], O[mt]); } \
        const int cc__ = DN_CC(st__); \
        if (cc__ >= 4) { bf16* orow = ODN + ((size_t)dir * NT + dn_row0(b, cc__)) * 1024 + h * 128 + qd * 32 + 16 * pw + 4 * fq; \
            _Pragma("unroll") for (int mt = 0; mt < 4; ++mt) { u32x2 w2; w2.x = pk2(O[mt][0], O[mt][1]); w2.y = pk2(O[mt][2], O[mt][3]); \
                *(u32x2*)(orow + (size_t)dn_perm(fr, mt) * 1024) = w2; } } } while (0)
#define DN_OBEG(st_) do { const int st__ = (st_); const LAS unsigned char* Lb = L + (st__ & 1) * BUF; const LAS unsigned char* ps = L + PUBS + (st__ & 1) * 8192 + pw * 4096 + lane * 16; \
        bf16x8_t sb[4], qa[4][4]; \
        _Pragma("unroll") for (int s = 0; s < 4; ++s) sb[s] = *(const LAS bf16x8_t*)(ps + s * 1024); \
        _Pragma("unroll") for (int s = 0; s < 4; ++s) _Pragma("unroll") for (int mt = 0; mt < 4; ++mt) qa[s][mt] = AF16(QS, dn_perm(fr, mt), 4 * s + fq); \
        _Pragma("unroll") for (int mt = 0; mt < 4; ++mt) O[mt] = (f32x4){0.f, 0.f, 0.f, 0.f}; \
        _Pragma("unroll") for (int s = 0; s < 4; ++s) _Pragma("unroll") for (int mt = 0; mt < 4; ++mt) O[mt] = MFMA16(sb[s], qa[s][mt], O[mt]); \
        const LAS float* vc = (const LAS float*)(Lb + VCS); \
        _Pragma("unroll") for (int mt = 0; mt < 4; ++mt) { const float eg = vc[64 + dn_perm(fr, mt)]; O[mt] = O[mt] * eg; } } while (0)
        DN_QKLOAD(qkA, 0); DN_QKLOAD(qkB, 1);
        DN_BAR();
        DN_OBEG(0);
        DN_BAR();
        for (int step = 0; step < DN_NSTEP - 2; step += 2) {
#ifdef DN_SKIP_OUT
            if (step < DN_NSTEP - 70) { DN_BAR(); DN_BAR(); continue; }
#endif
            DN_OFIN(qkA, step); DN_QKLOAD(qkA, step + 2);
            DN_OBEG(step + 1);
            DN_BAR();
            DN_OFIN(qkB, step + 1); DN_QKLOAD(qkB, step + 3);
            DN_OBEG(step + 2);
            DN_BAR();
        }
        DN_OFIN(qkA, DN_NSTEP - 2);
        DN_OBEG(DN_NSTEP - 1);
        DN_BAR();
        DN_OFIN(qkB, DN_NSTEP - 1);
#undef DN_QKLOAD
#undef DN_OFIN
#undef DN_OBEG
    } else {
        f32x4 S[8];
#pragma unroll
        for (int j = 0; j < 8; ++j) S[j] = (f32x4){0.f, 0.f, 0.f, 0.f};
        bf16x8_t sb[4];
#pragma unroll
        for (int s = 0; s < 4; ++s) { sb[s] = dn_bpack(S[2 * s], S[2 * s + 1]); *(LAS bf16x8_t*)(L + PUBS + w * 4096 + s * 1024 + lane * 16) = sb[s]; }
        DN_BAR();
        for (int step = 0; step < DN_NSTEP; ++step) {
#ifdef DN_SKIP_COMP
            if (step < DN_NSTEP - 69) { DN_BAR(); continue; }
#endif
            const LAS unsigned char* Lb = L + (step & 1) * BUF;
            f32x4 P[4];
#pragma unroll
            for (int mt = 0; mt < 4; ++mt) P[mt] = (f32x4){0.f, 0.f, 0.f, 0.f};
            {
                bf16x8_t ka[4][4];
#pragma unroll
                for (int s = 0; s < 4; ++s)
#pragma unroll
                    for (int mt = 0; mt < 4; ++mt) ka[s][mt] = AF16(KS, dn_perm(fr, mt), 4 * s + fq);
                __builtin_amdgcn_sched_barrier(0);
#pragma unroll
                for (int s = 0; s < 4; ++s)
#pragma unroll
                    for (int mt = 0; mt < 4; ++mt) P[mt] = MFMA16(ka[s][mt], sb[s], P[mt]);
            }
            bf16x8_t tia[2][4];
#pragma unroll
            for (int s = 0; s < 2; ++s)
#pragma unroll
                for (int mt = 0; mt < 4; ++mt) tia[s][mt] = AF8(TIS, dn_perm(fr, mt), 4 * s + fq);
            const LAS float* vc = (const LAS float*)(Lb + VCS);
            f32x4 R[4];
#pragma unroll
            for (int mt = 0; mt < 4; ++mt) {
                const int tk0 = 32 * (mt >> 1) + 8 * fq + 4 * (mt & 1);
                const f32x4 bt = *(const LAS f32x4*)(vc + tk0), bg = *(const LAS f32x4*)(vc + 128 + tk0);
#pragma unroll
                for (int r = 0; r < 4; ++r) {
                    const float v = bf2f(*(const LAS unsigned short*)(Lb + VS + (tk0 + r) * 64 + (16 * w + fr) * 2));
                    R[mt][r] = v * bt[r] - bg[r] * P[mt][r];
                }
            }
            const bf16x8_t rb0 = dn_bpack(R[0], R[1]), rb1 = dn_bpack(R[2], R[3]);
            f32x4 VN[4];
#pragma unroll
            for (int mt = 0; mt < 4; ++mt) {
                VN[mt] = (f32x4){0.f, 0.f, 0.f, 0.f};
                VN[mt] = MFMA16(tia[0][mt], rb0, VN[mt]);
                VN[mt] = MFMA16(tia[1][mt], rb1, VN[mt]);
            }
            bf16x8_t kta[2][8];
#pragma unroll
            for (int s = 0; s < 2; ++s)
#pragma unroll
                for (int jt = 0; jt < 8; ++jt) kta[s][jt] = AF8(KTS, dn_perm(fr, jt), 4 * s + fq);
            {
                const bf16x8_t vb0 = dn_bpack(VN[0], VN[1]), vb1 = dn_bpack(VN[2], VN[3]);
                LAS unsigned char* pv = L + PUBV + (step & 1) * 4096 + w * 2048 + lane * 16;
                *(LAS bf16x8_t*)pv = vb0; *(LAS bf16x8_t*)(pv + 1024) = vb1;
            }
#pragma unroll
            for (int mt = 0; mt < 4; ++mt) { const f32x4 ek = *(const LAS f32x4*)(vc + 192 + 32 * (mt >> 1) + 8 * fq + 4 * (mt & 1)); VN[mt] = VN[mt] * ek; }
            const bf16x8_t vs0 = dn_bpack(VN[0], VN[1]), vs1 = dn_bpack(VN[2], VN[3]);
            const float egl = vc[256];
#pragma unroll
            for (int jt = 0; jt < 8; ++jt) {
                S[jt] = S[jt] * egl;
                S[jt] = MFMA16(kta[0][jt], vs0, S[jt]);
                S[jt] = MFMA16(kta[1][jt], vs1, S[jt]);
            }
            if (DN_NSTEP > 68 && step % 68 == 67) {
#pragma unroll
                for (int j = 0; j < 8; ++j) S[j] = (f32x4){0.f, 0.f, 0.f, 0.f};
            }
#pragma unroll
            for (int s = 0; s < 4; ++s) { sb[s] = dn_bpack(S[2 * s], S[2 * s + 1]); *(LAS bf16x8_t*)(L + PUBS + ((step + 1) & 1) * 8192 + w * 4096 + s * 1024 + lane * 16) = sb[s]; }
            DN_BAR();
        }
    }
#undef AF16
#undef AF8
#undef DN_CC
#undef DN_CC1
}

DI void phase_attention(Frame& F, char* lds_generic) {
    bf16* QN = (bf16*)(F.ws + WS_QN); const bf16* KB = (const bf16*)(F.ws + WS_KB); const bf16* VB = (const bf16*)(F.ws + WS_VB);
    for (int it = F.vcu; it < 512; it += F.G) {
        const int b = it >> 7, kvh = (it >> 6) & 1, g = (it >> 4) & 3, qb = it & 15, h = kvh * 4 + g;
        bf16* Qb = QN + ((size_t)(b * TS + qb * 256) * 1024 + h * 128);
        const bf16* Kh = KB + ((size_t)b * LKV * 256 + kvh * 128); const bf16* Vh = VB + ((size_t)b * LKV * 256 + kvh * 128);
#ifdef ATTN_PROBE
#pragma nounroll
        for (int rep_ = 0; rep_ < 2; ++rep_) {
            bf16* Ob = rep_ == 0 ? (bf16*)(F.ws + WS_END) + ((size_t)(b * TS + qb * 256) * 1024 + h * 128) : Qb;
            attn::attn_dense_body<attn::bf16>(Qb, Kh, Vh, Ob, LKV, lds_generic);
            __syncthreads();
        }
#else
        attn::attn_dense_body<attn::bf16>(Qb, Kh, Vh, Qb, LKV, lds_generic);
        __syncthreads();
#endif
    }
}

DI void phase_mergeprep(Frame& F) {
    const bf16* ODN = (const bf16*)(F.ws + WS_ODN); bf16* Z = (bf16*)(F.ws + WS_Z); const int lane = F.lane;
    float nw[16];
#pragma unroll
    for (int k = 0; k < 4; ++k) { const f32x4 v = *(const f32x4*)(F.in[14] + (lane & 7) * 16 + 4 * k); nw[4 * k] = v[0]; nw[4 * k + 1] = v[1]; nw[4 * k + 2] = v[2]; nw[4 * k + 3] = v[3]; }
    for (int t = F.gw; t < NT; t += F.NGW) {
        const size_t off = (size_t)t * 1024 + 16 * lane;
        u32x4 a[2], c[2], z[2];
#pragma unroll
        for (int k = 0; k < 2; ++k) { a[k] = __builtin_nontemporal_load((const u32x4*)(ODN + off + 8 * k)); c[k] = __builtin_nontemporal_load((const u32x4*)(ODN + (size_t)NT * 1024 + off + 8 * k)); z[k] = __builtin_nontemporal_load((const u32x4*)(Z + off + 8 * k)); }
        float o[16]; float ss = 0.f;
#pragma unroll
        for (int k = 0; k < 2; ++k)
#pragma unroll
            for (int i = 0; i < 4; ++i) { o[8 * k + 2 * i] = bflo(a[k][i]) + bflo(c[k][i]); o[8 * k + 2 * i + 1] = bfhi(a[k][i]) + bfhi(c[k][i]); }
#pragma unroll
        for (int i = 0; i < 16; ++i) ss += o[i] * o[i];
        ss += __shfl_xor(ss, 1); ss += __shfl_xor(ss, 2); ss += __shfl_xor(ss, 4);
        const float rstd = rsqrtf(ss * (1.f / 128.f) + EPS);
        if (MERGE_F8_B) {
            float y[16];
#pragma unroll
            for (int k = 0; k < 2; ++k)
#pragma unroll
                for (int i = 0; i < 4; ++i) { y[8 * k + 2 * i] = o[8 * k + 2 * i] * rstd * nw[8 * k + 2 * i] * silu(bflo(z[k][i])); y[8 * k + 2 * i + 1] = o[8 * k + 2 * i + 1] * rstd * nw[8 * k + 2 * i + 1] * silu(bfhi(z[k][i])); }
            u32x4 w;
#pragma unroll
            for (int q = 0; q < 4; ++q) w[q] = pk4_fp8(fp8c(y[4 * q] * ODNN_SCALE), fp8c(y[4 * q + 1] * ODNN_SCALE), fp8c(y[4 * q + 2] * ODNN_SCALE), fp8c(y[4 * q + 3] * ODNN_SCALE));
            *(u32x4*)(F.ws + WS_ODNN8 + off) = w;
        } else {
#pragma unroll
        for (int k = 0; k < 2; ++k) {
            u32x4 w;
#pragma unroll
            for (int i = 0; i < 4; ++i) w[i] = pk2(o[8 * k + 2 * i] * rstd * nw[8 * k + 2 * i] * silu(bflo(z[k][i])), o[8 * k + 2 * i + 1] * rstd * nw[8 * k + 2 * i + 1] * silu(bfhi(z[k][i])));
            *(u32x4*)(Z + off + 8 * k) = w;
        }
        }
        if (MERGE_F8_A) {
            const bf16* OA = (const bf16*)(F.ws + WS_QN);
            const u32x4 a0 = __builtin_nontemporal_load((const u32x4*)(OA + off)), a1 = __builtin_nontemporal_load((const u32x4*)(OA + off + 8));
            u32x4 w;
            w[0] = pk4_fp8(fp8c(bflo(a0.x) * OATT_SCALE), fp8c(bfhi(a0.x) * OATT_SCALE), fp8c(bflo(a0.y) * OATT_SCALE), fp8c(bfhi(a0.y) * OATT_SCALE));
            w[1] = pk4_fp8(fp8c(bflo(a0.z) * OATT_SCALE), fp8c(bfhi(a0.z) * OATT_SCALE), fp8c(bflo(a0.w) * OATT_SCALE), fp8c(bfhi(a0.w) * OATT_SCALE));
            w[2] = pk4_fp8(fp8c(bflo(a1.x) * OATT_SCALE), fp8c(bfhi(a1.x) * OATT_SCALE), fp8c(bflo(a1.y) * OATT_SCALE), fp8c(bfhi(a1.y) * OATT_SCALE));
            w[3] = pk4_fp8(fp8c(bflo(a1.z) * OATT_SCALE), fp8c(bfhi(a1.z) * OATT_SCALE), fp8c(bflo(a1.w) * OATT_SCALE), fp8c(bfhi(a1.w) * OATT_SCALE));
            *(u32x4*)(F.ws + WS_OATT8 + off) = w;
        }
    }
}

DI void tk_insert(unsigned (&a)[16], unsigned x) {
#pragma unroll
    for (int i = 0; i < 16; ++i) { const unsigned hi = a[i] > x ? a[i] : x; x = a[i] > x ? x : a[i]; a[i] = hi; }
}
template <int N> DI void tk_sort_desc(unsigned (&a)[N]) {
#pragma unroll
    for (int k = 2; k <= N; k <<= 1)
#pragma unroll
        for (int j = k >> 1; j > 0; j >>= 1)
#pragma unroll
            for (int i = 0; i < N; ++i) {
                const int l = i ^ j;
                if (l > i) {
                    const unsigned lo = a[i] < a[l] ? a[i] : a[l], hi = a[i] < a[l] ? a[l] : a[i];
                    if ((i & k) == 0) { a[i] = hi; a[l] = lo; } else { a[i] = lo; a[l] = hi; }
                }
            }
}
DI void tk_sort_bitonic(unsigned (&c)[16]) {
#pragma unroll
    for (int s = 8; s >= 1; s >>= 1)
#pragma unroll
        for (int i = 0; i < 16; ++i) if ((i & s) == 0) { const unsigned lo = c[i] < c[i + s] ? c[i] : c[i + s], hi = c[i] < c[i + s] ? c[i + s] : c[i]; c[i] = hi; c[i + s] = lo; }
}
template <bool SORT> DI void tk_merge(unsigned (&a)[16], int m) {
    unsigned b[16];
#pragma unroll
    for (int i = 0; i < 16; ++i) b[i] = (unsigned)__shfl_xor((int)a[15 - i], m);
#pragma unroll
    for (int i = 0; i < 16; ++i) a[i] = a[i] > b[i] ? a[i] : b[i];
    if (SORT) tk_sort_bitonic(a);
}
DI float tk_unkey(unsigned k) { const unsigned u = (k & 0x80000000u) ? (k & 0x7fffffffu) : ~k; return __uint_as_float(u); }

DI void phase_peer_topk(Frame& F) {
    LAS unsigned char* L = F.lds;
    constexpr int KS = 0, QS = 69632, SC = 69632, TOP = 137216, FIN = 139264, PT = 140288;
    const bf16* PQ = (const bf16*)(F.ws + WS_PQ); const bf16* SUBK = (const bf16*)(F.ws + WS_SUBK);
    int* EXPI = (int*)(F.ws + WS_EXPI); float* EXPG = (float*)(F.ws + WS_EXPG);
    const int tid = F.tid, lane = F.lane, w = F.wave, fr = lane & 15, fq = lane >> 4;
    LAS float* sc = (LAS float*)(L + SC); LAS unsigned char* top = L + TOP; LAS unsigned char* finb = L + FIN; LAS int* pt = (LAS int*)(L + PT);
    if (tid < 56) {
        int n = tid, pi = -1;
#pragma unroll
        for (int i = 0; i < 16; ++i) { const int cnt = 16 / (i + 1); if (pi < 0) { if (n < cnt) pi = i * 16 + n; else n -= cnt; } }
        pt[tid] = tid < 50 ? pi : -1;
    }
    int hcur = -1;
    u32x4 qpre[4];
    if (F.vcu < (NT / 64) * 8) {
        const int h0 = F.vcu & 7, tq = (F.vcu >> 3) * 64;
#pragma unroll
        for (int k = 0; k < 4; ++k) { const int c = tid + 512 * k; qpre[k] = __builtin_nontemporal_load((const u32x4*)(PQ + (size_t)(tq + (c >> 5)) * 2048 + h0 * 256 + (c & 31) * 8)); }
    }
    for (int it = F.vcu; it < (NT / 64) * 8; it += F.G) {
        const int h = it & 7, tile = it >> 3, t0 = tile * 64;
        RAW_BAR();
        if (h != hcur) {
#pragma unroll
            for (int k = 0; k < 8; ++k) { const int c = tid + 512 * k, row = c >> 4, c16 = c & 15;
                *(LAS u32x4*)(L + KS + row * 272 + c16 * 16) = *(const u32x4*)(SUBK + (size_t)h * 32768 + row * 128 + c16 * 8); }
            hcur = h;
        }
#pragma unroll
        for (int k = 0; k < 4; ++k) { const int c = tid + 512 * k, row = c >> 5, c16 = c & 31; *(LAS u32x4*)(L + QS + row * 528 + c16 * 16) = qpre[k]; }
        if (it + F.G < (NT / 64) * 8) {
            const int itn = it + F.G, hn = itn & 7, tn = (itn >> 3) * 64;
#pragma unroll
            for (int k = 0; k < 4; ++k) { const int c = tid + 512 * k; qpre[k] = __builtin_nontemporal_load((const u32x4*)(PQ + (size_t)(tn + (c >> 5)) * 2048 + hn * 256 + (c & 31) * 8)); }
        }
        RAW_BAR();
        const int p = w >> 2, n0 = (w & 3) * 32;
        f32x4 acc[4][2];
#pragma unroll
        for (int mt = 0; mt < 4; ++mt) { acc[mt][0] = (f32x4){0.f, 0.f, 0.f, 0.f}; acc[mt][1] = (f32x4){0.f, 0.f, 0.f, 0.f}; }
#pragma unroll
        for (int s = 0; s < 4; ++s) {
            const bf16x8_t b0 = *(const LAS bf16x8_t*)(L + KS + (p * 128 + n0 + fr) * 272 + (32 * s + 8 * fq) * 2);
            const bf16x8_t b1 = *(const LAS bf16x8_t*)(L + KS + (p * 128 + n0 + 16 + fr) * 272 + (32 * s + 8 * fq) * 2);
#pragma unroll
            for (int mt = 0; mt < 4; ++mt) {
                const bf16x8_t a = *(const LAS bf16x8_t*)(L + QS + (16 * mt + fr) * 528 + (p * 128 + 32 * s + 8 * fq) * 2);
                acc[mt][0] = MFMA16(a, b0, acc[mt][0]); acc[mt][1] = MFMA16(a, b1, acc[mt][1]);
            }
        }
        RAW_BAR();
#pragma unroll
        for (int mt = 0; mt < 4; ++mt)
#pragma unroll
            for (int nt = 0; nt < 2; ++nt)
#pragma unroll
                for (int r = 0; r < 4; ++r) sc[((16 * mt + 4 * fq + r) * 2 + p) * 132 + (w & 3) * 33 + 16 * nt + fr] = acc[mt][nt][r];
        RAW_BAR();
        {
            const int list = tid >> 2, q = tid & 3;
            unsigned a32[32];
            const LAS float* sp = sc + list * 132 + q * 33;
#pragma unroll
            for (int i = 0; i < 32; ++i) a32[i] = (okey(sp[i]) & ~0x7Fu) | (unsigned)(q * 32 + i);
            tk_sort_desc<32>(a32);
            unsigned a[16];
#pragma unroll
            for (int i = 0; i < 16; ++i) a[i] = a32[i];
            tk_merge<true>(a, 1); tk_merge<true>(a, 2);
            if (q == 0) {
                u32x4 v;
#pragma unroll
                for (int k = 0; k < 4; ++k) v[k] = (a[4 * k] & 127u) | ((a[4 * k + 1] & 127u) << 8) | ((a[4 * k + 2] & 127u) << 16) | ((a[4 * k + 3] & 127u) << 24);
                *(LAS u32x4*)(top + list * 16) = v;
            }
        }
        RAW_BAR();
        {
            const int tok = tid >> 3, r8 = tid & 7;
            unsigned c8[8]; c8[7] = 0u;
#pragma unroll
            for (int m = 0; m < 7; ++m) {
                const int pr = pt[r8 + 8 * m];
                unsigned ck = 0u;
                if (pr >= 0) {
                    const int ia = top[(tok * 2) * 16 + (pr >> 4)], ib = top[(tok * 2 + 1) * 16 + (pr & 15)];
                    const float cs = sc[(tok * 2) * 132 + (ia >> 5) * 33 + (ia & 31)] + sc[(tok * 2 + 1) * 132 + (ib >> 5) * 33 + (ib & 31)];
                    ck = (okey(cs) & ~0xFFu) | (unsigned)pr;
                }
                c8[m] = ck;
            }
            tk_sort_desc<8>(c8);
            unsigned a[16];
#pragma unroll
            for (int i = 0; i < 16; ++i) a[i] = i < 8 ? c8[i] : 0u;
            tk_merge<true>(a, 1); tk_merge<true>(a, 2); tk_merge<true>(a, 4);
            LAS unsigned char* fin = finb + tok * 16;
            if (r8 == 0) {
                u32x4 v;
#pragma unroll
                for (int k = 0; k < 4; ++k) v[k] = (a[4 * k] & 255u) | ((a[4 * k + 1] & 255u) << 8) | ((a[4 * k + 2] & 255u) << 16) | ((a[4 * k + 3] & 255u) << 24);
                *(LAS u32x4*)fin = v;
            }
            asm volatile("s_waitcnt lgkmcnt(0)" ::: "memory");
            float bs[2]; int ex[2];
#pragma unroll
            for (int e = 0; e < 2; ++e) {
                const unsigned pr = fin[2 * r8 + e];
                const int ia = top[(tok * 2) * 16 + (pr >> 4)], ib = top[(tok * 2 + 1) * 16 + (pr & 15u)];
                bs[e] = sc[(tok * 2) * 132 + (ia >> 5) * 33 + (ia & 31)] + sc[(tok * 2 + 1) * 132 + (ib >> 5) * 33 + (ib & 31)];
                ex[e] = ia * 128 + ib;
            }
            float mx = fmaxf(bs[0], bs[1]);
            mx = fmaxf(mx, __shfl_xor(mx, 1)); mx = fmaxf(mx, __shfl_xor(mx, 2)); mx = fmaxf(mx, __shfl_xor(mx, 4));
            const float e0 = __expf(bs[0] - mx), e1 = __expf(bs[1] - mx);
            float sm = e0 + e1; sm += __shfl_xor(sm, 1); sm += __shfl_xor(sm, 2); sm += __shfl_xor(sm, 4);
            const float rs = 1.f / sm;
            const size_t o = (size_t)(t0 + tok) * 128 + h * 16 + 2 * r8;
            *(int2*)(EXPI + o) = make_int2(ex[0], ex[1]);
            *(float2*)(EXPG + o) = make_float2(e0 * rs, e1 * rs);
        }
    }
}

DI float ub0(unsigned w) { float r; asm("v_cvt_f32_ubyte0 %0, %1" : "=v"(r) : "v"(w)); return r; }
DI float ub1(unsigned w) { float r; asm("v_cvt_f32_ubyte1 %0, %1" : "=v"(r) : "v"(w)); return r; }
DI float ub2(unsigned w) { float r; asm("v_cvt_f32_ubyte2 %0, %1" : "=v"(r) : "v"(w)); return r; }
DI float ub3(unsigned w) { float r; asm("v_cvt_f32_ubyte3 %0, %1" : "=v"(r) : "v"(w)); return r; }
DI float wave_maxf(float v) {
#pragma unroll
    for (int o = 1; o < 64; o <<= 1) v = fmaxf(v, __shfl_xor(v, o));
    return v;
}
template <int BIAS> DI void quant_rows(const float* src, unsigned char* dst, float* scale, int gw, int NGW, int lane) {
    for (int row = gw; row < NEXP; row += NGW) {
        f32x4 v[8]; float am = 0.f;
#pragma unroll
        for (int j = 0; j < 8; ++j) { v[j] = __builtin_nontemporal_load((const f32x4*)(src + (size_t)row * DM) + lane + 64 * j); am = fmaxf(am, fmaxf(fmaxf(fabsf(v[j][0]), fabsf(v[j][1])), fmaxf(fabsf(v[j][2]), fabsf(v[j][3])))); }
        am = wave_maxf(am);
        const float inv = am > 0.f ? 127.f / am : 0.f;
#pragma unroll
        for (int j = 0; j < 8; ++j) {
            unsigned w = 0;
#pragma unroll
            for (int i = 0; i < 4; ++i) { const int q = (int)rintf(v[j][i] * inv) + BIAS; w |= ((unsigned)q & 0xffu) << (8 * i); }
            *((unsigned*)(dst + (size_t)row * DM) + lane + 64 * j) = w;
        }
        if (lane == 0) scale[row] = am * (1.f / 127.f);
    }
}


constexpr int V4_ROW = 1152;
DI void quant_rows_i4(const float* __restrict__ src, unsigned char* __restrict__ dst, int gw, int NGW, int lane) {
#pragma unroll 2
    for (int row = gw; row < NEXP; row += NGW) {
        f32x4 vv[8];
#pragma unroll
        for (int j = 0; j < 8; ++j) vv[j] = __builtin_nontemporal_load((const f32x4*)(src + (size_t)row * DM) + lane + 64 * j);
#pragma unroll
        for (int j = 0; j < 8; ++j) {
            const f32x4 v = vv[j];
            float am = fmaxf(fmaxf(fabsf(v[0]), fabsf(v[1])), fmaxf(fabsf(v[2]), fabsf(v[3])));
            am = fmaxf(am, __shfl_xor(am, 1)); am = fmaxf(am, __shfl_xor(am, 2)); am = fmaxf(am, __shfl_xor(am, 4));
            const unsigned sb = f2bf(am * (1.f / 7.f)); const float s = __uint_as_float(sb << 16), inv = s > 0.f ? __builtin_amdgcn_rcpf(s) : 0.f;
            unsigned w = 0;
#pragma unroll
            for (int i = 0; i < 4; ++i) { const int q = (int)fminf(fmaxf(rintf(v[i] * inv), -7.f), 7.f) + 8; w |= (unsigned)q << (4 * i); }
            const int grp = j * 8 + (lane >> 3);
            *(unsigned short*)(dst + (size_t)row * V4_ROW + grp * 16 + (lane & 7) * 2) = (unsigned short)w;
            if ((lane & 7) == 0) *(unsigned short*)(dst + (size_t)row * V4_ROW + 1024 + grp * 2) = (unsigned short)sb;
        }
    }
}

DI void quant_u_both(const float* __restrict__ src, unsigned char* __restrict__ d8, float* __restrict__ scale, unsigned char* __restrict__ d4, int gw, int NGW, int lane) {
#pragma unroll 2
    for (int row = gw; row < NEXP; row += NGW) {
        f32x4 v[8]; float am = 0.f;
#pragma unroll
        for (int j = 0; j < 8; ++j) { v[j] = __builtin_nontemporal_load((const f32x4*)(src + (size_t)row * DM) + lane + 64 * j); am = fmaxf(am, fmaxf(fmaxf(fabsf(v[j][0]), fabsf(v[j][1])), fmaxf(fabsf(v[j][2]), fabsf(v[j][3])))); }
        const float rowmax = wave_maxf(am), inv8 = rowmax > 0.f ? 127.f / rowmax : 0.f;
#pragma unroll
        for (int j = 0; j < 8; ++j) {
            unsigned w8 = 0;
#pragma unroll
            for (int i = 0; i < 4; ++i) { const int q = (int)rintf(v[j][i] * inv8); w8 |= ((unsigned)q & 0xffu) << (8 * i); }
            *((unsigned*)(d8 + (size_t)row * DM) + lane + 64 * j) = w8;
            float gm = fmaxf(fmaxf(fabsf(v[j][0]), fabsf(v[j][1])), fmaxf(fabsf(v[j][2]), fabsf(v[j][3])));
            gm = fmaxf(gm, __shfl_xor(gm, 1)); gm = fmaxf(gm, __shfl_xor(gm, 2)); gm = fmaxf(gm, __shfl_xor(gm, 4));
            const unsigned sb = f2bf(gm * (1.f / 7.f)); const float s = __uint_as_float(sb << 16), inv = s > 0.f ? __builtin_amdgcn_rcpf(s) : 0.f;
            unsigned w = 0;
#pragma unroll
            for (int i = 0; i < 4; ++i) { const int q = (int)fminf(fmaxf(rintf(v[j][i] * inv), -7.f), 7.f) + 8; w |= (unsigned)q << (4 * i); }
            const int grp = j * 8 + (lane >> 3);
            *(unsigned short*)(d4 + (size_t)row * V4_ROW + grp * 16 + (lane & 7) * 2) = (unsigned short)w;
            if ((lane & 7) == 0) *(unsigned short*)(d4 + (size_t)row * V4_ROW + 1024 + grp * 2) = (unsigned short)sb;
        }
        if (lane == 0) scale[row] = rowmax * (1.f / 127.f);
    }
}

DI void phase_peer_gather(Frame& F, int emask = 0x3fff, int vmask = 0x3fff) {
    const bf16* H2 = (const bf16*)(F.ws + WS_H2);
    const unsigned char* U8 = F.ws + WS_U8; const unsigned char* U4 = F.ws + WS_U4; const unsigned char* V4 = F.ws + WS_V8; const float* SU = (const float*)(F.ws + WS_SU);
    const int* EXPI = (const int*)(F.ws + WS_EXPI); const float* EXPG = (const float*)(F.ws + WS_EXPG);
    const bf16* X1 = (const bf16*)(F.ws + WS_X1); const float* MOD = (const float*)(F.ws + WS_MOD); const int lane = F.lane;
    LAS float* la = (LAS float*)(F.lds + F.wave * 1024);
    LAS int* li = (LAS int*)(F.lds + F.wave * 1024 + 512);
    const int eloc = ((lane >> 5) & 1) * 4 + ((lane >> 4) & 1) * 2 + ((lane >> 3) & 1);
#ifdef GATHER_SUBSET
    if ((blockIdx.x >> 3) % GATHER_SUBSET != 0) return;
    const int gw_ = ((blockIdx.x >> 3) / GATHER_SUBSET * 8 + (blockIdx.x & 7)) * NWAVES + F.wave, ngw_ = F.NGW / GATHER_SUBSET;
#else
    const int gw_ = F.gw, ngw_ = F.NGW;
#endif
    for (int t = gw_; t < NT; t += ngw_) {
        float xf[2][16]; float am = 0.f;
#pragma unroll
        for (int j = 0; j < 2; ++j) {
            const u32x4 w0 = *((const u32x4*)(H2 + (size_t)t * DM) + 2 * (lane + 64 * j)), w1 = *((const u32x4*)(H2 + (size_t)t * DM) + 2 * (lane + 64 * j) + 1);
            xf[j][0] = bflo(w0.x); xf[j][1] = bfhi(w0.x); xf[j][2] = bflo(w0.y); xf[j][3] = bfhi(w0.y); xf[j][4] = bflo(w0.z); xf[j][5] = bfhi(w0.z); xf[j][6] = bflo(w0.w); xf[j][7] = bfhi(w0.w);
            xf[j][8] = bflo(w1.x); xf[j][9] = bfhi(w1.x); xf[j][10] = bflo(w1.y); xf[j][11] = bfhi(w1.y); xf[j][12] = bflo(w1.z); xf[j][13] = bfhi(w1.z); xf[j][14] = bflo(w1.w); xf[j][15] = bfhi(w1.w);
#pragma unroll
            for (int i = 0; i < 16; ++i) am = fmaxf(am, fabsf(xf[j][i]));
        }
        am = wave_maxf(am);
        const float inv = am > 0.f ? 127.f / am : 0.f, sx = am * (1.f / 127.f);
        int xq[2][4];
#pragma unroll
        for (int j = 0; j < 2; ++j)
#pragma unroll
            for (int k = 0; k < 4; ++k) {
                unsigned w = 0;
#pragma unroll
                for (int i = 0; i < 4; ++i) w |= ((unsigned)(int)rintf(xf[j][4 * k + i] * inv) & 0xffu) << (8 * i);
                xq[j][k] = (int)w;
            }
        int xe[4], xo[4], xsum4 = 0;
#pragma unroll
        for (int d = 0; d < 4; ++d) {
            const u32x4 w = *((const u32x4*)(H2 + (size_t)t * DM + 32 * lane) + d);
            int q[8];
#pragma unroll
            for (int i = 0; i < 4; ++i) { q[2 * i] = (int)rintf(bflo(w[i]) * inv); q[2 * i + 1] = (int)rintf(bfhi(w[i]) * inv); }
            xe[d] = (int)(((unsigned)q[0] & 0xffu) | (((unsigned)q[2] & 0xffu) << 8) | (((unsigned)q[4] & 0xffu) << 16) | (((unsigned)q[6] & 0xffu) << 24));
            xo[d] = (int)(((unsigned)q[1] & 0xffu) | (((unsigned)q[3] & 0xffu) << 8) | (((unsigned)q[5] & 0xffu) << 16) | (((unsigned)q[7] & 0xffu) << 24));
#pragma unroll
            for (int i = 0; i < 8; ++i) xsum4 += q[i];
        }
        float asum = 0.f;
        const int ei0 = EXPI[(size_t)t * 128 + lane] & emask, ei1 = EXPI[(size_t)t * 128 + 64 + lane] & emask;
        const float eg0 = EXPG[(size_t)t * 128 + lane], eg1 = EXPG[(size_t)t * 128 + 64 + lane];
        u32x4 wa0[8], wa1[8], wb[8]; unsigned short sbh[8];
#define ULOADA(hd_) do { const int eis_ = (hd_) < 4 ? ei0 : ei1, base_ = ((hd_) & 3) * 16; \
            _Pragma("unroll") for (int e = 0; e < 8; ++e) { const int idx_ = __builtin_amdgcn_readlane(eis_, base_ + e); const u32x4* ur_ = (const u32x4*)(U8 + (size_t)idx_ * DM); wa0[e] = ur_[lane]; wa1[e] = ur_[lane + 64]; } } while (0)
#define ULOADB(hd_) do { const int eis_ = (hd_) < 4 ? ei0 : ei1, base_ = ((hd_) & 3) * 16 + 8; \
            _Pragma("unroll") for (int e = 0; e < 8; ++e) { const int idx_ = __builtin_amdgcn_readlane(eis_, base_ + e); const unsigned char* u4_ = U4 + (size_t)idx_ * V4_ROW; wb[e] = *(const u32x4*)(u4_ + 16 * lane); sbh[e] = *(const unsigned short*)(u4_ + 1024 + 2 * lane); } } while (0)
#define ULOADA_NEXT(hd_) do { const int h_ = (hd_); const int eis_ = (h_ & 4) ? ei1 : ei0, base_ = (h_ & 3) * 16, msk_ = h_ < 8 ? -1 : 0; \
            _Pragma("unroll") for (int e = 0; e < 8; ++e) { const int idx_ = __builtin_amdgcn_readlane(eis_, base_ + e) & msk_; const u32x4* ur_ = (const u32x4*)(U8 + (size_t)idx_ * DM); wa0[e] = ur_[lane]; wa1[e] = ur_[lane + 64]; } } while (0)
        ULOADA(0);
#pragma unroll 1
        for (int hd = 0; hd < 8; ++hd) {
            const int eisel = hd < 4 ? ei0 : ei1; const float egsel = hd < 4 ? eg0 : eg1;
            const int base = (hd & 3) * 16;
            const int myidxA = __shfl(eisel, base + eloc), myidxB = __shfl(eisel, base + 8 + eloc);
            const float mygA = __shfl(egsel, base + eloc), mygB = __shfl(egsel, base + 8 + eloc);
            const float mysu = SU[myidxA];
            ULOADB(hd);
            float accA[8], accB[8];
#pragma unroll
            for (int e = 0; e < 8; ++e) {
                int a = __builtin_amdgcn_sdot4((int)wa0[e].x, xq[0][0], 0, false); a = __builtin_amdgcn_sdot4((int)wa0[e].y, xq[0][1], a, false);
                a = __builtin_amdgcn_sdot4((int)wa0[e].z, xq[0][2], a, false); a = __builtin_amdgcn_sdot4((int)wa0[e].w, xq[0][3], a, false);
                a = __builtin_amdgcn_sdot4((int)wa1[e].x, xq[1][0], a, false); a = __builtin_amdgcn_sdot4((int)wa1[e].y, xq[1][1], a, false);
                a = __builtin_amdgcn_sdot4((int)wa1[e].z, xq[1][2], a, false); a = __builtin_amdgcn_sdot4((int)wa1[e].w, xq[1][3], a, false);
                accA[e] = (float)a;
            }
            __builtin_amdgcn_sched_barrier(0);
            ULOADA_NEXT(hd + 1);
#pragma unroll
            for (int e = 0; e < 8; ++e) {
                int b = 0;
#pragma unroll
                for (int d = 0; d < 4; ++d) { b = __builtin_amdgcn_sdot4((int)(wb[e][d] & 0x0F0F0F0Fu), xe[d], b, false); b = __builtin_amdgcn_sdot4((int)((wb[e][d] >> 4) & 0x0F0F0F0Fu), xo[d], b, false); }
                accB[e] = (float)(b - 8 * xsum4) * bf2f(sbh[e]);
            }
            float rA, rB;
            {
                float r4[4], r2[2], s4[4], s2[2];
#pragma unroll
                for (int i = 0; i < 4; ++i) {
                    const float sndA = (lane & 32) ? accA[i] : accA[i + 4], kpA = (lane & 32) ? accA[i + 4] : accA[i]; r4[i] = kpA + __shfl_xor(sndA, 32);
                    const float sndB = (lane & 32) ? accB[i] : accB[i + 4], kpB = (lane & 32) ? accB[i + 4] : accB[i]; s4[i] = kpB + __shfl_xor(sndB, 32); }
#pragma unroll
                for (int i = 0; i < 2; ++i) {
                    const float sndA = (lane & 16) ? r4[i] : r4[i + 2], kpA = (lane & 16) ? r4[i + 2] : r4[i]; r2[i] = kpA + __shfl_xor(sndA, 16);
                    const float sndB = (lane & 16) ? s4[i] : s4[i + 2], kpB = (lane & 16) ? s4[i + 2] : s4[i]; s2[i] = kpB + __shfl_xor(sndB, 16); }
                { const float sndA = (lane & 8) ? r2[0] : r2[1], kpA = (lane & 8) ? r2[1] : r2[0]; rA = kpA + __shfl_xor(sndA, 8);
                  const float sndB = (lane & 8) ? s2[0] : s2[1], kpB = (lane & 8) ? s2[1] : s2[0]; rB = kpB + __shfl_xor(sndB, 8); }
                rA += __shfl_xor(rA, 4); rA += __shfl_xor(rA, 2); rA += __shfl_xor(rA, 1);
                rB += __shfl_xor(rB, 4); rB += __shfl_xor(rB, 2); rB += __shfl_xor(rB, 1);
            }
            const float aA = gelu_erf(rA * mysu * sx) * mygA, aB = gelu_erf(rB * sx) * mygB;
            if ((lane & 7) == 0) { la[hd * 16 + eloc] = aA; li[hd * 16 + eloc] = myidxA & vmask; la[hd * 16 + 8 + eloc] = aB; li[hd * 16 + 8 + eloc] = myidxB & vmask; asum += aA + aB; }
        }
#undef ULOADA
#undef ULOADA_NEXT
#undef ULOADB
        asum = wave_sum(asum);
        asm volatile("s_waitcnt lgkmcnt(0)" ::: "memory");
        f32x2 o2[16]; float csum = 0.f;
#pragma unroll
        for (int i = 0; i < 16; ++i) o2[i] = (f32x2){0.f, 0.f};
#pragma unroll 16
        for (int e = 0; e < 128; ++e) {
            const int idx = __builtin_amdgcn_readfirstlane(li[e]); const float a = __uint_as_float((unsigned)__builtin_amdgcn_readfirstlane((int)__float_as_uint(la[e])));
            const unsigned char* vr = V4 + (size_t)idx * V4_ROW;
            const u32x4 w = *(const u32x4*)(vr + 16 * lane);
            const float as = a * bf2f(*(const unsigned short*)(vr + 1024 + 2 * lane));
            csum += as;
            const f32x2 as2 = {as, as};
#pragma unroll
            for (int d = 0; d < 4; ++d) {
                const unsigned lo = w[d] & 0x0F0F0F0Fu, hi = (w[d] >> 4) & 0x0F0F0F0Fu;
                o2[4 * d + 0] = __builtin_elementwise_fma(as2, (f32x2){ub0(lo), ub0(hi)}, o2[4 * d + 0]); o2[4 * d + 1] = __builtin_elementwise_fma(as2, (f32x2){ub1(lo), ub1(hi)}, o2[4 * d + 1]);
                o2[4 * d + 2] = __builtin_elementwise_fma(as2, (f32x2){ub2(lo), ub2(hi)}, o2[4 * d + 2]); o2[4 * d + 3] = __builtin_elementwise_fma(as2, (f32x2){ub3(lo), ub3(hi)}, o2[4 * d + 3]);
            }
        }
        float o[32];
#pragma unroll
        for (int i = 0; i < 16; ++i) { o[2 * i] = o2[i][0]; o[2 * i + 1] = o2[i][1]; }
        LAS float* tp = (LAS float*)(F.lds + 8192 + F.wave * 9216);
        const float corr = 8.f * csum;
#pragma unroll
        for (int k = 0; k < 8; ++k) { f32x4 v; v[0] = o[4 * k] - corr; v[1] = o[4 * k + 1] - corr; v[2] = o[4 * k + 2] - corr; v[3] = o[4 * k + 3] - corr; *(LAS f32x4*)(tp + lane * 36 + 4 * k) = v; }
        asm volatile("s_waitcnt lgkmcnt(0)" ::: "memory");
        const float* g2 = MOD + (size_t)(t >> 12) * 12288 + 5 * 2048;
        f32x4 x2[8]; float ss = 0.f;
#pragma unroll
        for (int j = 0; j < 8; ++j) {
            const int ch = lane + 64 * j;
            const f32x4 pv = *(const LAS f32x4*)(tp + (ch >> 3) * 36 + 4 * (ch & 7));
            const u32x2 xw = __builtin_nontemporal_load((const u32x2*)(X1 + (size_t)t * DM) + ch); const f32x4 xa = {bflo(xw.x), bfhi(xw.x), bflo(xw.y), bfhi(xw.y)}, ga = *((const f32x4*)g2 + ch);
            x2[j] = xa + ga * pv;
            ss += (x2[j][0] * x2[j][0] + x2[j][1] * x2[j][1]) + (x2[j][2] * x2[j][2] + x2[j][3] * x2[j][3]);
        }
        const float rstd = rsqrtf(wave_sum(ss) * (1.f / DM) + EPS);
        const float* fw = F.in[22];
#pragma unroll
        for (int j = 0; j < 8; ++j) { const int ch = lane + 64 * j; const f32x4 wa = *((const f32x4*)fw + ch); __builtin_nontemporal_store(x2[j] * rstd * wa, (f32x4*)(F.out + (size_t)t * DM) + ch); }
        asm volatile("s_waitcnt lgkmcnt(0)" ::: "memory");
    }
}

DI void phase_h2(Frame& F) {
    const float* MOD = (const float*)(F.ws + WS_MOD); bf16* H2 = (bf16*)(F.ws + WS_H2); const bf16* X1 = (const bf16*)(F.ws + WS_X1);
    ModPar P;
    constexpr int RPW = NT / (256 * NWAVES);
    if (F.NGW == 256 * NWAVES) {
        const int m0 = F.gw * RPW, r = m0 >> 12;
        modpar_load(P, F.in[7], MOD + (size_t)r * 12288 + 4 * 2048, MOD + (size_t)r * 12288 + 3 * 2048, F.lane);
        modnorm_rows_bf(X1 + (size_t)m0 * DM, H2 + (size_t)m0 * DM, RPW, P, F.lane);
    } else {
        for (int m = F.gw; m < NT; m += F.NGW) { const int r = m >> 12; modpar_load(P, F.in[7], MOD + (size_t)r * 12288 + 4 * 2048, MOD + (size_t)r * 12288 + 3 * 2048, F.lane); modnorm_rows_bf(X1 + (size_t)m * DM, H2 + (size_t)m * DM, 1, P, F.lane); }
    }
}


DI void phase_quant(Frame& F) {
#ifndef REP_QUANT
#define REP_QUANT 1
#endif
#pragma nounroll
    for (int rq = 0; rq < REP_QUANT; ++rq) {
    quant_u_both(F.in[20], F.ws + WS_U8, (float*)(F.ws + WS_SU), F.ws + WS_U4, F.gw, F.NGW, F.lane);
    quant_rows_i4(F.in[21], F.ws + WS_V8, F.gw, F.NGW, F.lane);
    }
}

struct Args { const float* in[23]; float* out; unsigned char* ws; int ph_lo, ph_hi; };
static_assert(sizeof(Args) == 23 * 8 + 8 + 8 + 8, "Args has no padding");

__global__ void __launch_bounds__(NWAVES * 64, 2) mk_fwd(Args args) {
    extern __shared__ __attribute__((aligned(16))) unsigned char lds[];
    Frame F;
    F.lds = (LAS unsigned char*)lds; F.ws = args.ws; F.out = args.out;
#pragma unroll
    for (int i = 0; i < 23; ++i) F.in[i] = args.in[i];
    F.tid = threadIdx.x; F.lane = F.tid & 63; F.wave = __builtin_amdgcn_readfirstlane(F.tid >> 6);
    F.G = gridDim.x; { const int bx = blockIdx.x; F.vcu = (F.G % 8 == 0) ? (bx % 8) * (F.G / 8) + bx / 8 : bx; }
    F.gw = F.vcu * NWAVES + F.wave; F.NGW = F.G * NWAVES;
    const int lo = args.ph_lo, hi = args.ph_hi;
#ifndef REP_PHASE
#define REP_PHASE (-1)
#endif
#define IN(k) (lo <= (k) && (k) < hi)
#ifndef REP_MASK
#define REP_MASK 0
#endif
#define RP(k) _Pragma("nounroll") for (int rep_ = 0; rep_ < ((REP_PHASE == (k) || ((REP_MASK >> (k)) & 1)) ? 2 : 1); ++rep_)
    constexpr int CW_BAR = 4096;
    volatile LAS unsigned* bst = (volatile LAS unsigned*)(F.lds + LDS_BYTES - 64);
    if (F.tid < 16) bst[F.tid] = 0u;
    __syncthreads();
    XcdBarrier bar; bar.bar = (unsigned*)(F.ws + WS_CTL) + CW_BAR; bar.x = 0; bar.st = nullptr;
    if (hi - lo > 1) bar = xcd_barrier_post((unsigned*)(F.ws + WS_CTL) + CW_BAR, bst);
#define SEAM(k) do { if (IN(k) && IN((k) + 1)) { if ((k) == 0) cg::this_grid().sync(); else xcd_barrier(bar); } } while (0)

    if (IN(0)) RP(0) { phase_prologue(F); __syncthreads(); }
    SEAM(0);
    if (IN(1)) RP(1) phase_modreduce(F);
    SEAM(1);
    if (IN(2)) RP(2) phase_h1(F);
    SEAM(2);
    if (IN(3)) RP(3) {
        pg8::Gemm g{(const bf16*)(F.ws + WS_H), (const bf16*)(F.ws + WS_WIN), MTOT, NPROJ, DM / 2}; InProjOrder S; S.init(F.G, (int)blockIdx.x);
        EpiInProj E{F.ws, F.in[12], F.in[13]};
        pg8::gemm_phase<EpiInProj, InProjOrder, true, true, true>(F.lds, g, S, E);
    }
    SEAM(3);
    if (IN(4)) phase_postproj(F);
    SEAM(4);
#ifdef DN_NAIVE
    if (IN(5)) phase_dn_naive(F);
    SEAM(5);
    if (IN(6)) phase_attention(F, (char*)lds);
#else
    if (IN(5)) RP(5) phase_dn_prep(F);
    SEAM(5);
    if (IN(6)) { RP(14) { phase_dn_scan(F); __syncthreads(); } phase_attention(F, (char*)lds); }
#endif
    SEAM(6);
    if (IN(7)) phase_mergeprep(F);
    SEAM(7);
    if (IN(8)) RP(8) {
#if MERGE_F8_A || MERGE_F8_B || defined(MERGE_TWO_PASS)
        pg8::StaticOrder S; S.init(NT, DM, F.G, (int)blockIdx.x);
        { pg8::Gemm g{(const bf16*)(F.ws + (MERGE_F8_A ? WS_OATT8 : WS_QN)), (const bf16*)(F.ws + WS_WBA), NT, DM, MERGE_F8_A ? 512 : 1024};
          EpiMerge<false> E{(bf16*)(F.ws + WS_Y), (const unsigned char*)(F.ws + WS_G), 0, MERGE_F8_A ? 1.f / (255.f * WB_SCALE * OATT_SCALE) : 1.f / 255.f};
          pg8::gemm_phase<EpiMerge<false>, pg8::StaticOrder, true, true, MERGE_F8_A != 0>(F.lds, g, S, E); }
        __syncthreads();
        { pg8::Gemm g{(const bf16*)(F.ws + (MERGE_F8_B ? WS_ODNN8 : WS_Z)), (const bf16*)(F.ws + WS_WBD), NT, DM, MERGE_F8_B ? 512 : 1024};
          EpiMerge<true> E{(bf16*)(F.ws + WS_Y), (const unsigned char*)(F.ws + WS_G), 2048, MERGE_F8_B ? 1.f / (255.f * WB_SCALE * ODNN_SCALE) : 1.f / 255.f};
          pg8::gemm_phase<EpiMerge<true>, pg8::StaticOrder, true, true, MERGE_F8_B != 0>(F.lds, g, S, E); }
#else
        pg8::TwoStageOrder S; S.init(NT, DM, F.G, (int)blockIdx.x);
        pg8::Gemm g{(const bf16*)(F.ws + WS_QN), (const bf16*)(F.ws + WS_WBA), NT, DM, 1024, (const bf16*)(F.ws + WS_Z), (const bf16*)(F.ws + WS_WBD)};
        EpiMerge2 E{(bf16*)(F.ws + WS_Y), (const unsigned char*)(F.ws + WS_G)};
        pg8::gemm_phase<EpiMerge2, pg8::TwoStageOrder, true, true>(F.lds, g, S, E);
#endif
    }
    SEAM(8);
    if (IN(9)) RP(9) {
        pg8::Gemm g{(const bf16*)(F.ws + WS_Y), (const bf16*)(F.ws + WS_WOUT), NT, DM, DM}; pg8::StaticOrder S; S.init(NT, DM, F.G, (int)blockIdx.x);
        EpiResid E{F.in[0], (bf16*)(F.ws + WS_X1), (const float*)(F.ws + WS_MOD)};
        pg8::gemm_phase<EpiResid, pg8::StaticOrder, true, true>(F.lds, g, S, E);
    }
    SEAM(9);
    if (IN(10)) RP(10) phase_h2(F);
    SEAM(10);
    if (IN(11)) RP(11) {
        pg8::Gemm g{(const bf16*)(F.ws + WS_H2), (const bf16*)(F.ws + WS_WQ), NT, DM, DM}; pg8::StaticOrder S; S.init(NT, DM, F.G, (int)blockIdx.x);
        EpiPlain E{(bf16*)(F.ws + WS_PQ), 2048};
        pg8::gemm_phase<EpiPlain, pg8::StaticOrder, true, true>(F.lds, g, S, E);
    }
    SEAM(11);
    if (IN(12)) { RP(12) { phase_peer_topk(F); __syncthreads(); } phase_quant(F); }
    SEAM(12);
#ifdef GATHER_PROBE_MASK
    if (IN(13)) {
#pragma nounroll
        for (int rep_ = 0; rep_ < 2; ++rep_) { phase_peer_gather(F, rep_ == 0 ? GATHER_PROBE_MASK : 0x3fff, rep_ == 0 ? GATHER_PROBE_VMASK : 0x3fff); __syncthreads(); }
    }
#else
    if (IN(13)) RP(13) phase_peer_gather(F);
#endif
#undef IN
#undef SEAM
}

extern "C" void kernel_launch(void* const* d_in, const int* in_sizes, int n_in, void* d_out, int out_size, void* d_ws, size_t ws_size, hipStream_t stream) {
    static int grid = 0;
    if (grid == 0) {
        if (n_in != 23 || in_sizes[0] != NT * DM || out_size != NT * DM || ws_size < WS_END) {
            fprintf(stderr, "kernel_launch: unexpected shapes (n_in %d, in0 %d, out %d, ws %zu < %zu); nothing launched\n", n_in, n_in > 0 ? in_sizes[0] : -1, out_size, ws_size, (size_t)WS_END);
            grid = -1; return; }
        int dev = 0, cus = 0, per_cu = 0;
        if (hipGetDevice(&dev) != hipSuccess || hipDeviceGetAttribute(&cus, hipDeviceAttributeMultiprocessorCount, dev) != hipSuccess) { grid = -1; return; }
        if (hipFuncSetAttribute((const void*)mk_fwd, hipFuncAttributeMaxDynamicSharedMemorySize, LDS_BYTES) != hipSuccess) { fprintf(stderr, "kernel_launch: hipFuncSetAttribute failed\n"); grid = -1; return; }
        if (hipOccupancyMaxActiveBlocksPerMultiprocessor(&per_cu, (const void*)mk_fwd, NWAVES * 64, LDS_BYTES) != hipSuccess || per_cu < 1) { fprintf(stderr, "kernel_launch: occupancy query says %d blocks per CU\n", per_cu); (void)hipGetLastError(); grid = -1; return; }
        grid = cus;
    }
    if (grid < 0) return;
    (void)hipMemsetAsync((char*)d_ws + WS_CTL, 0, 1 * MiB, stream);
    Args a{};
    for (int i = 0; i < 23; ++i) a.in[i] = (const float*)d_in[i];
    a.out = (float*)d_out; a.ws = (unsigned char*)d_ws;
#if MK_N_LAUNCHES == 1
    a.ph_lo = 0; a.ph_hi = NPHASE;
    void* kargs[] = {(void*)&a};
    const hipError_t e = hipLaunchCooperativeKernel((const void*)mk_fwd, dim3(grid), dim3(NWAVES * 64), kargs, LDS_BYTES, stream);
    if (e != hipSuccess) fprintf(stderr, "kernel_launch: cooperative launch failed: %s (grid %d)\n", hipGetErrorString(e), grid);
#else
    for (int p = 0; p < NPHASE; ++p) {
        a.ph_lo = p; a.ph_hi = p + 1;
        hipLaunchKernelGGL(mk_fwd, dim3(grid), dim3(NWAVES * 64), LDS_BYTES, stream, a);
    }
    const hipError_t le = hipPeekAtLastError();
    if (le != hipSuccess) fprintf(stderr, "kernel_launch: launch failed: %s\n", hipGetErrorName(le));
#endif
}
```

```cpp
#define DN_SLEEP 0

#include <hip/hip_runtime.h>
#include <hip/hip_cooperative_groups.h>
#include <cstdio>
#include <cstdint>
namespace cg = cooperative_groups;

#ifndef MK_N_LAUNCHES
#define MK_N_LAUNCHES 1
#endif
namespace pg8 {
#define PG8_LAS __attribute__((address_space(3)))
typedef unsigned short bf16_t;
typedef short bf16x8 __attribute__((ext_vector_type(8)));
typedef float f32x4 __attribute__((ext_vector_type(4)));
typedef int pg8_v4i __attribute__((ext_vector_type(4)));
typedef int pg8_v8i __attribute__((ext_vector_type(8)));
typedef unsigned u32x4 __attribute__((ext_vector_type(4)));
constexpr int BM = 256, BK = 64, HALF = 128, HTB = HALF * BK * 2  , STAGE_BYTES = 8 * HTB, NXCD = 8, WGM = 8;

__host__ __device__ __forceinline__ int lds_byte(int r, int c) { const int st = (r >> 4) * 2 + (c >> 5), rr = r & 15, cc = c & 31, ob = rr * 64 + cc * 2; return st * 1024 + (ob ^ (((ob >> 9) & 1) << 5)); }
__host__ __device__ __forceinline__ void stage_rc(int b, int& R, int& C) { const int st = b / 1024, sb = b % 1024, swz = sb ^ (((sb >> 9) & 1) << 5); R = (st >> 1) * 16 + swz / 64; C = (st & 1) * 32 + (swz % 64) / 2; }
__host__ __device__ __forceinline__ int perm32(int rho) { const int n = rho >> 4, i = rho & 15; return 8 * (i >> 2) + 4 * n + (i & 3); }

struct Unit { int pm, pn, sel; };
struct Gemm { const bf16_t* A; const bf16_t* Bt; int M, N, K; const bf16_t* A2 = nullptr; const bf16_t* Bt2 = nullptr; };

struct StaticOrder {
    int nM, nN, nwg, G, c;
    __host__ __device__ void init(int M, int N, int G_, int c_) { nM = M / BM; nN = N / BM; nwg = nM * nN; G = G_; c = c_; }
    __host__ __device__ bool next(int i, Unit& u) const {
        const long L = (long)i * G + c; if (L >= nwg) return false;
        int wgid = (int)L; { const int q = nwg / NXCD, r = nwg % NXCD, xcd = wgid % NXCD, off = wgid / NXCD; wgid = (xcd < r ? xcd * (q + 1) : r * (q + 1) + (xcd - r) * q) + off; }
        const int nig = WGM * nN, gid = wgid / nig, fm = gid * WGM, gsz = (nM - fm) < WGM ? (nM - fm) : WGM;
        u.pm = fm + ((wgid % nig) % gsz); u.pn = (wgid % nig) / gsz; return true;
    }
    __device__ __forceinline__ void a_ready(const Unit&) const {}
    __device__ __forceinline__ void done(const Unit&) const {}
};
struct TwoStageOrder {
    StaticOrder base;
    __host__ __device__ void init(int M, int N, int G_, int c_) { base.init(M, N, G_, c_); }
    __host__ __device__ bool next(int i, Unit& u) const { if (!base.next(i >> 1, u)) return false; u.sel = i & 1; return true; }
    __device__ __forceinline__ void a_ready(const Unit&) const {}
    __device__ __forceinline__ void done(const Unit&) const {}
};

__device__ __forceinline__ unsigned cvt_pk_bf16(float lo, float hi) { unsigned r; asm volatile("v_cvt_pk_bf16_f32 %0, %1, %2" : "=v"(r) : "v"(lo), "v"(hi)); return r; }
typedef float f32x2 __attribute__((ext_vector_type(2)));
template <class Epi, class Sched, bool ALIGN_EPI = false, bool SP2 = false, bool F8 = false>
__device__ __forceinline__ void gemm_phase(PG8_LAS unsigned char* lds, const Gemm g, const Sched& S, const Epi& E) {
    const int tid = threadIdx.x, wid = __builtin_amdgcn_readfirstlane(tid >> 6), lane = tid & 63, wr = wid >> 2, wc = wid & 3, fr = lane & 15, fq = lane >> 4;
    const int K = g.K, nt = K / BK;
    unsigned voffA[2], voffB[2];
#pragma unroll
    for (int i = 0; i < 2; ++i) { int R, C; stage_rc(tid * 16 + i * 8192, R, C); const int Rb = Epi::PERM ? ((R & ~31) + perm32(R & 31)) : R;
        voffA[i] = (unsigned)(R * K + C) * 2u; voffB[i] = (unsigned)(Rb * K + C) * 2u; }
    const size_t kstep = (size_t)(BK * 2);
    const size_t hstep = (size_t)HALF * K * 2;
    const size_t tstep = 2 * hstep;
    const unsigned ldsw = (unsigned)wid * 1024u;
    const int aoff = lds_byte(wr * 64 + fr, fq * 8), boff = lds_byte(wc * 32 + fr, fq * 8);
#define PG8_SA(b, h) (((b) * 2 + (h)) * HTB)
#define PG8_SB(b, h) ((4 + (b) * 2 + (h)) * HTB)
#define PG8_STAGE(bufoff, gbase, voff) do { _Pragma("unroll") for (int _i = 0; _i < 2; ++_i) \
        __builtin_amdgcn_global_load_lds((const unsigned*)((const char*)(gbase) + (voff)[_i]), (PG8_LAS unsigned*)(lds + (bufoff) + ldsw + _i * 8192), 16, 0, 0); } while (0)
#define PG8_LDA(dst, b, h) do { _Pragma("unroll") for (int m = 0; m < 4; ++m) { \
        if constexpr (F8) { const pg8_v4i t0_ = *(const PG8_LAS pg8_v4i*)(lds + PG8_SA(b, h) + aoff + m * 2048), t1_ = *(const PG8_LAS pg8_v4i*)(lds + PG8_SA(b, h) + aoff + m * 2048 + 1024); \
            dst##8[m] = __builtin_shufflevector(t0_, t1_, 0, 1, 2, 3, 4, 5, 6, 7); } \
        else { _Pragma("unroll") for (int k = 0; k < 2; ++k) dst[m][k] = *(const PG8_LAS bf16x8*)(lds + PG8_SA(b, h) + aoff + m * 2048 + k * 1024); } } } while (0)
#define PG8_LDB(dst, b, h) do { _Pragma("unroll") for (int n = 0; n < 2; ++n) { \
        if constexpr (F8) { const pg8_v4i t0_ = *(const PG8_LAS pg8_v4i*)(lds + PG8_SB(b, h) + boff + n * 2048), t1_ = *(const PG8_LAS pg8_v4i*)(lds + PG8_SB(b, h) + boff + n * 2048 + 1024); \
            dst##8[n] = __builtin_shufflevector(t0_, t1_, 0, 1, 2, 3, 4, 5, 6, 7); } \
        else { _Pragma("unroll") for (int k = 0; k < 2; ++k) dst[n][k] = *(const PG8_LAS bf16x8*)(lds + PG8_SB(b, h) + boff + n * 2048 + k * 1024); } } } while (0)
#define PG8_MMA(ai, bj, At, Bt) do { __builtin_amdgcn_s_setprio(1); _Pragma("unroll") for (int m = 0; m < 4; ++m) _Pragma("unroll") for (int n = 0; n < 2; ++n) { \
        if constexpr (F8) { asm volatile("v_mfma_scale_f32_16x16x128_f8f6f4 %0, %1, %2, %0, %3, %3 op_sel_hi:[0,0,0]" : "+v"(acc[ai][bj][m][n]) : "v"(Bt##8[n]), "v"(At##8[m]), "v"(0x7F7F7F7F)); } \
        else { _Pragma("unroll") for (int k = 0; k < 2; ++k) acc[ai][bj][m][n] = __builtin_amdgcn_mfma_f32_16x16x32_bf16(Bt[n][k], At[m][k], acc[ai][bj][m][n], 0, 0, 0); } } \
        __builtin_amdgcn_s_setprio(0); } while (0)
#define PG8_WAIT_V(n) asm volatile("s_waitcnt vmcnt(" #n ")" ::: "memory")
#define PG8_WAIT_L(n) asm volatile("s_waitcnt lgkmcnt(" #n ")" ::: "memory")
#define PG8_BAR __builtin_amdgcn_s_barrier()
#define PG8_SCHED __builtin_amdgcn_sched_barrier(0)
    Unit cur, nxt; int ui = 0;
    if (!S.next(0, cur)) return;
    f32x4 acc[2][2][4][2];
#pragma unroll
    for (int a = 0; a < 2; ++a)
#pragma unroll
        for (int b = 0; b < 2; ++b)
#pragma unroll
            for (int m = 0; m < 4; ++m)
#pragma unroll
                for (int n = 0; n < 2; ++n) acc[a][b][m][n] = (f32x4){0.f, 0.f, 0.f, 0.f};
    bf16x8 At[4][2], B0[2][2], B1[2][2];
    pg8_v8i At8[4], B08[2], B18[2];
    const char* cA = (const char*)g.A + (size_t)cur.pm * tstep; const char* cB = (const char*)g.Bt + (size_t)cur.pn * tstep;
    S.a_ready(cur);
    if constexpr (SP2) {
        PG8_STAGE(PG8_SB(0, 0), cB, voffB); PG8_STAGE(PG8_SB(0, 1), cB + hstep, voffB); PG8_STAGE(PG8_SA(0, 0), cA, voffA); PG8_STAGE(PG8_SA(0, 1), cA + hstep, voffA);
        if (wr == 1) PG8_BAR;
        PG8_WAIT_V(2); PG8_BAR;
        PG8_STAGE(PG8_SB(1, 0), cB + kstep, voffB); PG8_STAGE(PG8_SA(1, 0), cA + kstep, voffA); PG8_STAGE(PG8_SB(1, 1), cB + hstep + kstep, voffB);
        PG8_WAIT_V(6); PG8_BAR;
    } else {
        PG8_STAGE(PG8_SB(0, 0), cB, voffB); PG8_STAGE(PG8_SA(0, 0), cA, voffA); PG8_STAGE(PG8_SB(0, 1), cB + hstep, voffB); PG8_STAGE(PG8_SA(0, 1), cA + hstep, voffA);
        if (wr == 1) PG8_BAR;
        PG8_WAIT_V(4); PG8_BAR;
        PG8_STAGE(PG8_SB(1, 0), cB + kstep, voffB); PG8_STAGE(PG8_SA(1, 0), cA + kstep, voffA); PG8_STAGE(PG8_SB(1, 1), cB + hstep + kstep, voffB);
        PG8_WAIT_V(6); PG8_BAR;
    }
    for (;;) {
        const bool has_next = S.next(ui + 1, nxt);
        const bf16_t* gA = g.A; const bf16_t* gB = g.Bt;
        if constexpr (Epi::TWO_STAGE) { if (has_next && nxt.sel) { gA = g.A2; gB = g.Bt2; } }
        const char* nA = has_next ? (const char*)gA + (size_t)nxt.pm * tstep : cA; const char* nB = has_next ? (const char*)gB + (size_t)nxt.pn * tstep : cB;
        for (int t = 0; t < nt; t += 2) {
            const bool last = (t == nt - 2);
            const char* a1 = cA + (size_t)(t + 1) * kstep;
            const char* a2 = last ? nA : cA + (size_t)(t + 2) * kstep; const char* b2 = last ? nB : cB + (size_t)(t + 2) * kstep;
            const char* a3 = a2 + kstep; const char* b3 = b2 + kstep;
            if (last && has_next) S.a_ready(nxt);
            if constexpr (SP2) {
            PG8_LDB(B0, 0, 0); PG8_LDB(B1, 0, 1); PG8_SCHED; PG8_LDA(At, 0, 0); PG8_STAGE(PG8_SA(1, 1), a1 + hstep, voffA);
            PG8_WAIT_V(8); PG8_WAIT_L(0); PG8_BAR; PG8_MMA(0, 0, At, B0); PG8_MMA(0, 1, At, B1); PG8_BAR; PG8_SCHED;
            PG8_LDA(At, 0, 1); PG8_STAGE(PG8_SB(0, 0), b2, voffB); PG8_STAGE(PG8_SB(0, 1), b2 + hstep, voffB); PG8_STAGE(PG8_SA(0, 0), a2, voffA);
            PG8_WAIT_V(8); PG8_WAIT_L(0); PG8_BAR; PG8_MMA(1, 0, At, B0); PG8_MMA(1, 1, At, B1); PG8_BAR; PG8_SCHED;
            PG8_LDB(B0, 1, 0); PG8_LDB(B1, 1, 1); PG8_SCHED; PG8_LDA(At, 1, 0); PG8_STAGE(PG8_SA(0, 1), a2 + hstep, voffA);
            PG8_WAIT_V(8); PG8_WAIT_L(0); PG8_BAR; PG8_MMA(0, 0, At, B0); PG8_MMA(0, 1, At, B1); PG8_BAR; PG8_SCHED;
            PG8_LDA(At, 1, 1); PG8_STAGE(PG8_SB(1, 0), b3, voffB); PG8_STAGE(PG8_SB(1, 1), b3 + hstep, voffB); PG8_STAGE(PG8_SA(1, 0), a3, voffA);
            PG8_WAIT_V(8); PG8_WAIT_L(0); PG8_BAR; PG8_MMA(1, 0, At, B0); PG8_MMA(1, 1, At, B1); PG8_BAR; PG8_SCHED;
            } else {
            PG8_LDB(B0, 0, 0); PG8_SCHED; PG8_LDA(At, 0, 0); PG8_STAGE(PG8_SA(1, 1), a1 + hstep, voffA);
            PG8_WAIT_L(8); PG8_BAR; PG8_WAIT_L(0); PG8_MMA(0, 0, At, B0); PG8_BAR; PG8_SCHED;
            PG8_LDB(B1, 0, 1); PG8_STAGE(PG8_SB(0, 0), b2, voffB);
            PG8_BAR; PG8_WAIT_L(0); PG8_MMA(0, 1, At, B1); PG8_BAR;
            PG8_LDA(At, 0, 1); PG8_STAGE(PG8_SA(0, 0), a2, voffA);
            PG8_BAR; PG8_WAIT_L(0); PG8_MMA(1, 0, At, B0); PG8_BAR; PG8_SCHED;
            PG8_STAGE(PG8_SB(0, 1), b2 + hstep, voffB);
            PG8_WAIT_V(6); PG8_BAR; PG8_MMA(1, 1, At, B1); PG8_BAR;
            PG8_LDB(B0, 1, 0); PG8_SCHED; PG8_LDA(At, 1, 0); PG8_STAGE(PG8_SA(0, 1), a2 + hstep, voffA);
            PG8_WAIT_L(8); PG8_BAR; PG8_WAIT_L(0); PG8_MMA(0, 0, At, B0); PG8_BAR; PG8_SCHED;
            PG8_LDB(B1, 1, 1); PG8_STAGE(PG8_SB(1, 0), b3, voffB);
            PG8_BAR; PG8_WAIT_L(0); PG8_MMA(0, 1, At, B1); PG8_BAR;
            PG8_LDA(At, 1, 1); PG8_STAGE(PG8_SA(1, 0), a3, voffA);
            PG8_BAR; PG8_WAIT_L(0); PG8_MMA(1, 0, At, B0); PG8_BAR; PG8_SCHED;
            PG8_STAGE(PG8_SB(1, 1), b3 + hstep, voffB);
            PG8_WAIT_V(6); PG8_BAR; PG8_MMA(1, 1, At, B1); PG8_BAR;
            }
        }
        if constexpr (ALIGN_EPI) { if (wr == 0) PG8_BAR; }
        bool keep = false;
        if constexpr (Epi::TWO_STAGE) keep = (cur.sel == 0);
        if constexpr (!Epi::AFTER_DRAIN) {
            if constexpr (Epi::TWO_STAGE) { if (keep) E.mid(acc, cur, wr, wc, fr, fq); else E(acc, cur, wr, wc, fr, fq); }
            else E(acc, cur, wr, wc, fr, fq);
            S.done(cur); }
        if (!has_next) break;
        if (!keep)
#pragma unroll
        for (int a = 0; a < 2; ++a)
#pragma unroll
            for (int b = 0; b < 2; ++b)
#pragma unroll
                for (int m = 0; m < 4; ++m)
#pragma unroll
                    for (int n = 0; n < 2; ++n) acc[a][b][m][n] = (f32x4){0.f, 0.f, 0.f, 0.f};
        cur = nxt; cA = nA; cB = nB; ++ui;
        if constexpr (ALIGN_EPI) { if (wr == 1) PG8_BAR; }
    }
    PG8_WAIT_V(0);
    if constexpr (!ALIGN_EPI) { if (wr == 0) PG8_BAR; }
    PG8_BAR;
    if constexpr (Epi::AFTER_DRAIN) { E.fused(acc, cur, wr, wc, fr, fq, lds, wid, lane); S.done(cur); }
#undef PG8_SA
#undef PG8_SB
#undef PG8_STAGE
#undef PG8_LDA
#undef PG8_LDB
#undef PG8_MMA
#undef PG8_WAIT_V
#undef PG8_WAIT_L
#undef PG8_BAR
#undef PG8_SCHED
}
}
namespace attn {
using bf16 = unsigned short;
constexpr int D = 128, NW = 8, QBLK = 32, KVBLK = 64;
constexpr float SCALE = 0.088388347648318440f;
constexpr float THR = 8.f;
constexpr int SDEPTH = 2;
constexpr int LDQ = 1024, LDK = 256, LDO = 1024;
constexpr size_t SHM_V = KVBLK * D * 2, SHM_K = KVBLK * D * 2, SHM_ATTN = 2 * SHM_V + 2 * SHM_K + NW * 64 * 4;
__device__ __forceinline__ unsigned short f2bf_rne(float f) { unsigned u = __float_as_uint(f); return (unsigned short)((u + 0x7fffu + ((u >> 16) & 1u)) >> 16); }
using bf16x8 = __attribute__((ext_vector_type(8))) short;
using s16x4  = __attribute__((ext_vector_type(4))) short;
using f32x16 = __attribute__((ext_vector_type(16))) float;
using f32x8  = __attribute__((ext_vector_type(8))) float;
using u32x4  = __attribute__((ext_vector_type(4))) unsigned;
#define KSWZ(row, colB) ((row) * 256 + ((colB) ^ (((row) & 7) << 4)))
#define SBAR() __builtin_amdgcn_sched_barrier(0)
__device__ __forceinline__ int crow(int r, int hi) { return (r & 3) + 8 * (r >> 2) + 4 * hi; }
__device__ __forceinline__ unsigned cvtpk(float lo, float hi) {
  unsigned r; asm volatile("v_cvt_pk_bf16_f32 %0, %1, %2" : "=v"(r) : "v"(lo), "v"(hi)); return r;
}
template <typename TIn> struct Stage;
template <> struct Stage<bf16>  { using T = bf16x8;
  __device__ static __forceinline__ T ld8(const bf16* p) { return *reinterpret_cast<const bf16x8*>(p); }
  __device__ static __forceinline__ bf16x8 tobf(T x) { return x; } };
template <> struct Stage<float> { using T = f32x8;
  __device__ static __forceinline__ T ld8(const float* p) { return *reinterpret_cast<const f32x8*>(p); }
  __device__ static __forceinline__ bf16x8 tobf(T x) {
    u32x4 w = {cvtpk(x[0], x[1]), cvtpk(x[2], x[3]), cvtpk(x[4], x[5]), cvtpk(x[6], x[7])}; return *reinterpret_cast<bf16x8*>(&w); } };

__device__ __forceinline__ void partialSM(f32x16& p0, f32x16& p1, float& m_reg, float& mn, float& alpha) {
  constexpr float C = SCALE * 1.4426950408889634f;
  float pmax = p0[0]; for (int r = 1; r < 16; ++r) pmax = fmaxf(pmax, p0[r]); for (int r = 0; r < 16; ++r) pmax = fmaxf(pmax, p1[r]);
  { auto rr = __builtin_amdgcn_permlane32_swap(__float_as_uint(pmax), __float_as_uint(pmax), false, false);
    pmax = fmaxf(__uint_as_float(rr[0]), __uint_as_float(rr[1])); }
  if (__builtin_expect(__all(pmax - m_reg <= THR / SCALE), 1)) { mn = m_reg; alpha = 1.f; }
  else { mn = fmaxf(m_reg, pmax); alpha = __builtin_amdgcn_exp2f((m_reg - mn) * C); m_reg = mn; }
  float mnC = -mn * C;
  for (int r = 0; r < 16; ++r) p0[r] = fmaf(p0[r], C, mnC); for (int r = 0; r < 16; ++r) p1[r] = fmaf(p1[r], C, mnC);
  for (int r = 0; r < 16; ++r) p0[r] = __builtin_amdgcn_exp2f(p0[r]);
}
__device__ __forceinline__ void finishSM(f32x16& p0, f32x16& p1, float alpha, float& l_reg, bf16x8& pa0, bf16x8& pa1, bf16x8& pa2, bf16x8& pa3) {
  for (int r = 0; r < 16; ++r) p1[r] = __builtin_amdgcn_exp2f(p1[r]);
  float ps = 0; for (int r = 0; r < 16; ++r) ps += p0[r]; for (int r = 0; r < 16; ++r) ps += p1[r];
  { auto rr = __builtin_amdgcn_permlane32_swap(__float_as_uint(ps), __float_as_uint(ps), false, false);
    ps = __uint_as_float(rr[0]) + __uint_as_float(rr[1]); }
  l_reg = l_reg * alpha + ps;
#define PK4(P, BASE, OUT) do { unsigned a0 = cvtpk(P[BASE + 0], P[BASE + 1]), a1 = cvtpk(P[BASE + 2], P[BASE + 3]);   \
    unsigned b0 = cvtpk(P[BASE + 4], P[BASE + 5]), b1 = cvtpk(P[BASE + 6], P[BASE + 7]);                              \
    auto r0 = __builtin_amdgcn_permlane32_swap(a0, b0, false, false); auto r1 = __builtin_amdgcn_permlane32_swap(a1, b1, false, false); \
    u32x4 w = {r0[0], r1[0], r0[1], r1[1]}; OUT = *reinterpret_cast<bf16x8*>(&w); } while (0)
  PK4(p0, 0, pa0); PK4(p0, 8, pa1); PK4(p1, 0, pa2); PK4(p1, 8, pa3);
#undef PK4
}
__device__ __forceinline__ void qkt(f32x16& p0, f32x16& p1, const bf16* Ks, const bf16x8* qr, int r32, int hi) {
  p0 = f32x16{}; p1 = f32x16{};
  for (int d0 = 0; d0 < 8; ++d0) { int cb = (d0 * 16 + hi * 8) * 2;
    bf16x8 b0 = *reinterpret_cast<const bf16x8*>((const char*)Ks + KSWZ(r32, cb));
    bf16x8 b1 = *reinterpret_cast<const bf16x8*>((const char*)Ks + KSWZ(32 + r32, cb));
    p0 = __builtin_amdgcn_mfma_f32_32x32x16_bf16(b0, qr[d0], p0, 0, 0, 0);
    p1 = __builtin_amdgcn_mfma_f32_32x32x16_bf16(b1, qr[d0], p1, 0, 0, 0); }
}
__device__ __forceinline__ int v_st(int k, int c) { const int kk = (k & ~0xC) | ((k & 4) << 1) | ((k & 8) >> 1); return ((kk >> 3) * 4 + (c >> 5)) * 512 + ((kk & 7) * 32 + (c & 31)) * 2; }
__device__ __forceinline__ int v_rd_base(int lane) { return ((lane & 3) << 3) | (((lane >> 2) & 3) << 6) | (((lane >> 4) & 1) << 5) | (((lane >> 5) & 1) << 8); }
constexpr int v_rd_off(int d0, int ks, int half) { return d0 * 512 + ks * 4096 + half * 2048; }
template <int OFF> __device__ __forceinline__ s16x4 tr_read(int vb) {
  s16x4 r; asm volatile("ds_read_b64_tr_b16 %0, %1 offset:%2" : "=&v"(r) : "v"(vb), "i"(OFF) : "memory"); return r;
}
template <int D0> __device__ __forceinline__ void pv_one(f32x16& od, int vb, bf16x8 pa0, bf16x8 pa1, bf16x8 pa2, bf16x8 pa3) {
  const s16x4 l0 = tr_read<v_rd_off(D0, 0, 0)>(vb), h0 = tr_read<v_rd_off(D0, 0, 1)>(vb), l1 = tr_read<v_rd_off(D0, 1, 0)>(vb), h1 = tr_read<v_rd_off(D0, 1, 1)>(vb);
  const s16x4 l2 = tr_read<v_rd_off(D0, 2, 0)>(vb), h2 = tr_read<v_rd_off(D0, 2, 1)>(vb), l3 = tr_read<v_rd_off(D0, 3, 0)>(vb), h3 = tr_read<v_rd_off(D0, 3, 1)>(vb);
  asm volatile("s_waitcnt lgkmcnt(0)" ::: "memory"); SBAR();
#define PK(L, H) (bf16x8){L[0], L[1], L[2], L[3], H[0], H[1], H[2], H[3]}
  od = __builtin_amdgcn_mfma_f32_32x32x16_bf16(pa0, PK(l0, h0), od, 0, 0, 0);
  od = __builtin_amdgcn_mfma_f32_32x32x16_bf16(pa1, PK(l1, h1), od, 0, 0, 0);
  od = __builtin_amdgcn_mfma_f32_32x32x16_bf16(pa2, PK(l2, h2), od, 0, 0, 0);
  od = __builtin_amdgcn_mfma_f32_32x32x16_bf16(pa3, PK(l3, h3), od, 0, 0, 0);
#undef PK
}
__device__ __forceinline__ void pv_d0(f32x16* o, int vb, bf16x8 pa0, bf16x8 pa1, bf16x8 pa2, bf16x8 pa3) {
  pv_one<0>(o[0], vb, pa0, pa1, pa2, pa3); pv_one<1>(o[1], vb, pa0, pa1, pa2, pa3); pv_one<2>(o[2], vb, pa0, pa1, pa2, pa3); pv_one<3>(o[3], vb, pa0, pa1, pa2, pa3);
}

template <typename TQ>
__device__ __forceinline__ void attn_dense_body(const TQ* __restrict__ Qb, const bf16* __restrict__ Kh, const bf16* __restrict__ Vh,
                                                bf16* __restrict__ Ob, int seq, char* lds) {
  using St = Stage<bf16>; using SQ = Stage<TQ>;
  const int tid = threadIdx.x, wid = tid >> 6, lane = tid & 63, r32 = lane & 31, hi = lane >> 5;
  bf16* V_lds = (bf16*)lds; bf16* K_lds = (bf16*)(lds + 2 * SHM_V);
  float* ws = (float*)(lds + 2 * SHM_V + 2 * SHM_K) + wid * 64; float* li_l = ws; float* al_l = ws + 32;
  float m_reg = -1e30f, l_reg = 0; f32x16 o[4] = {}; bf16x8 qr[8];
  const TQ* Qw = Qb + (long)(wid * QBLK + r32) * LDQ + hi * 8;
#pragma unroll
  for (int d0 = 0; d0 < 8; ++d0) qr[d0] = SQ::tobf(SQ::ld8(Qw + d0 * 16));
  const int sr = tid >> 4, sc = (tid & 15) * 8, vst0 = v_st(sr, sc), vst1 = v_st(32 + sr, sc);
  const int vb0 = (int)(uintptr_t)V_lds + v_rd_base(lane);
  struct { typename St::T vs0, vs1, ks0, ks1; } sr_[SDEPTH];
#define SLOAD(i, k0) do { sr_[i].vs0 = St::ld8(&Vh[(long)((k0) + sr) * LDK + sc]); sr_[i].vs1 = St::ld8(&Vh[(long)((k0) + 32 + sr) * LDK + sc]); \
    sr_[i].ks0 = St::ld8(&Kh[(long)((k0) + sr) * LDK + sc]); sr_[i].ks1 = St::ld8(&Kh[(long)((k0) + 32 + sr) * LDK + sc]); } while (0)
#define SWRITE(b, i) do { *(bf16x8*)((char*)V_lds + (b) * SHM_V + vst0) = St::tobf(sr_[i].vs0);          \
    *(bf16x8*)((char*)V_lds + (b) * SHM_V + vst1) = St::tobf(sr_[i].vs1); int kc = sc * 2;               \
    *(bf16x8*)((char*)K_lds + (b) * SHM_K + KSWZ(sr, kc)) = St::tobf(sr_[i].ks0);                       \
    *(bf16x8*)((char*)K_lds + (b) * SHM_K + KSWZ(32 + sr, kc)) = St::tobf(sr_[i].ks1); } while (0)
#define SWAIT() do { if constexpr (SDEPTH == 2) asm volatile("s_waitcnt vmcnt(4)" ::: "memory"); else asm volatile("s_waitcnt vmcnt(0)" ::: "memory"); } while (0)
#define RESC(a) do { if (__any((a) < 1.f)) { if (hi == 0) al_l[r32] = (a); asm volatile("s_waitcnt lgkmcnt(0)" ::: "memory"); \
    for (int d = 0; d < 4; ++d) for (int r = 0; r < 16; ++r) o[d][r] *= al_l[crow(r, hi)]; } } while (0)
  f32x16 pA0, pA1, pB0, pB1; float mnA, mnB, alA, alB; bf16x8 pa0, pa1, pa2, pa3; const int NT = seq / KVBLK;
  constexpr int SE = 0, SO = SDEPTH - 1;
  SLOAD(SE, 0); asm volatile("s_waitcnt vmcnt(0)" ::: "memory"); SWRITE(0, SE); __syncthreads();
  qkt(pA0, pA1, K_lds, qr, r32, hi); partialSM(pA0, pA1, m_reg, mnA, alA);
  SLOAD(SO, KVBLK); if constexpr (SDEPTH == 2) { if (2 < NT) SLOAD(SE, 2 * KVBLK); }
  SWAIT(); SWRITE(1, SO); __syncthreads();
  for (int j = 1; j + 1 < NT; j += 2) {
    SBAR(); qkt(pB0, pB1, (bf16*)((char*)K_lds + SHM_K), qr, r32, hi);
    finishSM(pA0, pA1, alA, l_reg, pa0, pa1, pa2, pa3); SBAR();
    SLOAD(SO, (j + SDEPTH) * KVBLK); SBAR();
    pv_d0(o, vb0, pa0, pa1, pa2, pa3); partialSM(pB0, pB1, m_reg, mnB, alB);
    __syncthreads(); SWAIT(); SWRITE(0, SE);
    RESC(alB); __syncthreads();
    SBAR(); qkt(pA0, pA1, K_lds, qr, r32, hi);
    finishSM(pB0, pB1, alB, l_reg, pa0, pa1, pa2, pa3); SBAR();
    if (SDEPTH == 1 || j + 3 < NT) SLOAD(SE, (j + 1 + SDEPTH) * KVBLK); SBAR();
    pv_d0(o, vb0 + (int)SHM_V, pa0, pa1, pa2, pa3); partialSM(pA0, pA1, m_reg, mnA, alA);
    __syncthreads(); SWAIT(); SWRITE(1, SO);
    RESC(alA); __syncthreads();
  }
  SBAR(); qkt(pB0, pB1, (bf16*)((char*)K_lds + SHM_K), qr, r32, hi);
  finishSM(pA0, pA1, alA, l_reg, pa0, pa1, pa2, pa3); SBAR();
  pv_d0(o, vb0, pa0, pa1, pa2, pa3); partialSM(pB0, pB1, m_reg, mnB, alB);
  __syncthreads(); RESC(alB);
  finishSM(pB0, pB1, alB, l_reg, pa0, pa1, pa2, pa3); SBAR();
  pv_d0(o, vb0 + (int)SHM_V, pa0, pa1, pa2, pa3);
  if (hi == 0) li_l[r32] = l_reg; asm volatile("s_waitcnt lgkmcnt(0)" ::: "memory");
  float rli[16];
#pragma unroll
  for (int r = 0; r < 16; ++r) rli[r] = __builtin_amdgcn_rcpf(li_l[crow(r, hi)]);
  bf16* Ow = Ob + (long)(wid * QBLK) * LDO;
#pragma unroll
  for (int r = 0; r < 16; ++r) { int orow = crow(r, hi);
    for (int d0 = 0; d0 < 4; ++d0) Ow[(long)orow * LDO + d0 * 32 + r32] = f2bf_rne(o[d0][r] * rli[r]); }
#undef SLOAD
#undef SWRITE
#undef SWAIT
#undef RESC
}
#undef KSWZ
#undef SBAR
}

constexpr int DM = 2048, NB = 4, TS = 4096, NT = NB * TS, CL = 256, NC = NB * CL, MTOT = NT + NC, LKV = TS + CL;
constexpr int NPROJ = 9984;
constexpr int INW = 9760;
constexpr int NEXP = 16384;
constexpr float EPS = 1e-6f;
constexpr int NWAVES = 8;
constexpr int NPHASE = 14;

constexpr size_t MiB = 1u << 20;
constexpr size_t WS_CTL = 0, WS_MOD = 1 * MiB, WS_MODP = 2 * MiB, WS_SUBK = 10 * MiB, WS_WBA = 11 * MiB, WS_WBD = 15 * MiB, WS_WOUT = 19 * MiB, WS_WQ = 27 * MiB;
constexpr size_t WS_BETA = 35 * MiB, WS_LOGA = 37 * MiB, WS_EXPI = 39 * MiB, WS_EXPG = 47 * MiB;
constexpr size_t WS_A = 56 * MiB;
constexpr size_t WS_WIN = WS_A, WS_H = WS_A + 39 * MiB;
constexpr size_t WS_DQ = WS_A, WS_DK = WS_A + 34 * MiB, WS_DV = WS_A + 68 * MiB;
constexpr size_t WS_Y = WS_A, WS_H2 = WS_A;
constexpr size_t WS_B = 164 * MiB;
constexpr size_t WS_QN = WS_B, WS_Z = WS_B + 32 * MiB, WS_PQ = WS_B;
constexpr size_t WS_KB = 228 * MiB, WS_VB = 237 * MiB;
constexpr size_t WS_C = 246 * MiB;
constexpr size_t WS_DNRAW = WS_C, WS_U8 = WS_C, WS_V8 = WS_C + 32 * MiB, WS_SU = WS_C + 64 * MiB, WS_SV = WS_C + 65 * MiB, WS_U4 = WS_C + 66 * MiB;
constexpr size_t WS_KT = WS_C, WS_TINV = WS_C + 34 * MiB, WS_QKO = WS_C + 68 * MiB, WS_VEC = WS_C + 102 * MiB;
constexpr size_t WS_D = 374 * MiB;
constexpr size_t WS_G = WS_D, WS_X1 = WS_D;
constexpr size_t WS_OATT8 = WS_D + 64 * MiB, WS_ODNN8 = WS_D + 80 * MiB;
#ifndef MERGE_F8_A
#define MERGE_F8_A 0
#endif
#ifndef MERGE_F8_B
#define MERGE_F8_B 0
#endif
constexpr float WB_SCALE = 64.f, OATT_SCALE = 16.f, ODNN_SCALE = 2.f;
constexpr size_t WS_ODN = 502 * MiB;
constexpr size_t WS_END = 566 * MiB;
static_assert((size_t)NPROJ * DM * 2 <= 39 * MiB && (size_t)MTOT * DM * 2 <= 69 * MiB && (size_t)MTOT * 1024 * 2 <= 34 * MiB && (size_t)MTOT * 3072 * 2 <= 128 * MiB, "ws map");
static_assert((size_t)NB * LKV * 256 * 2 <= 9 * MiB && (size_t)NT * 4096 * 2 <= 128 * MiB && (size_t)NEXP * DM * 2 <= 64 * MiB, "ws map");

constexpr int LDS_BYTES = 163840;

#define DI __device__ __forceinline__
#define LAS __attribute__((address_space(3)))
typedef unsigned short bf16;
typedef float f32x4 __attribute__((ext_vector_type(4)));
typedef float f32x2 __attribute__((ext_vector_type(2)));
typedef unsigned u32x4 __attribute__((ext_vector_type(4)));
typedef unsigned u32x2 __attribute__((ext_vector_type(2)));

typedef __bf16 bf16x2_n __attribute__((ext_vector_type(2)));
DI unsigned pk2(float lo, float hi) { const f32x2 v = {lo, hi}; return __builtin_bit_cast(unsigned, __builtin_convertvector(v, bf16x2_n)); }
DI unsigned f2bf(float f) { return pk2(f, f) & 0xffffu; }
DI float bflo(unsigned w) { return __uint_as_float(w << 16); }
DI float bfhi(unsigned w) { return __uint_as_float(w & 0xffff0000u); }
DI float bf2f(bf16 h) { return __uint_as_float((unsigned)h << 16); }
DI float wave_sum(float v) {
#pragma unroll
    for (int o = 1; o < 64; o <<= 1) v += __shfl_xor(v, o);
    return v;
}
DI unsigned wave_max_u32(unsigned v) {
#pragma unroll
    for (int o = 1; o < 64; o <<= 1) { const unsigned t = (unsigned)__shfl_xor((int)v, o); v = t > v ? t : v; }
    return v;
}
DI float sigm(float x) { return __builtin_amdgcn_rcpf(1.f + __expf(-x)); }
DI float silu(float x) { return x * __builtin_amdgcn_rcpf(1.f + __expf(-x)); }
DI float softplus(float x) { return x > 20.f ? x : log1pf(__expf(x)); }
DI float gelu_erf(float v) {
    const float av = fabsf(v), t = __builtin_amdgcn_rcpf(av * 0.2316418882f + 1.0f);
    float q = t * 0.5307027145f + (-0.7265760135f); q = q * t + 0.7107068705f; q = q * t + (-0.142248368f); q = q * t + 0.127414796f; q = q * t;
    const float e = __builtin_amdgcn_exp2f((v * v) * (-0.72134752044f));
    const float mm = v * (q * e);
    return v < 0.f ? mm : v - mm;
}
DI unsigned okey(float f) { const unsigned u = __float_as_uint(f); return (u & 0x80000000u) ? ~u : (u | 0x80000000u); }
DI unsigned rdlane(unsigned v, int l) { return (unsigned)__builtin_amdgcn_readlane((int)v, l); }
DI float rdlanef(float v, int l) { return __uint_as_float((unsigned)__builtin_amdgcn_readlane((int)__float_as_uint(v), l)); }

#define XB_TMO      128
#define XB_XCNT(j)  (256  + 64 * (j))
#define XB_XSUB(j)  (1280 + 64 * (j))
#define XB_XGEN(j)  (2304 + 64 * (j))
#define XB_TOP      3328
#define XB_TOPGEN   3392
#define XCD_BAR_WORDS 3456
#define XB_SPIN_CAP (1u << 18)

__device__ __forceinline__ unsigned xb_ld(unsigned* p)              { return __hip_atomic_load(p, __ATOMIC_RELAXED, __HIP_MEMORY_SCOPE_AGENT); }
__device__ __forceinline__ unsigned xb_add(unsigned* p, unsigned v) { return __hip_atomic_fetch_add(p, v, __ATOMIC_RELAXED, __HIP_MEMORY_SCOPE_AGENT); }
__device__ __forceinline__ unsigned xb_xcc_id() { return (unsigned)__builtin_amdgcn_s_getreg((3 << 11) | 20) & 0xFu; }
#define XB_SPIN(cond, bar) do { unsigned _sp = 0; while (cond) { __builtin_amdgcn_s_sleep(1); \
    if ((++_sp & 255u) == 0u) { if (xb_ld(&(bar)[XB_TMO])) break; if (_sp > XB_SPIN_CAP) { atomicAdd(&(bar)[XB_TMO], 1u); break; } } } } while (0)

struct XcdBarrier {
    unsigned* bar; unsigned x;
    volatile LAS unsigned* st;
};

__device__ __forceinline__ XcdBarrier xcd_barrier_post(unsigned* bar, volatile LAS unsigned* st) {
    XcdBarrier b; b.bar = bar; b.x = xb_xcc_id(); b.st = st;
    if (threadIdx.x == 0) (void)xb_add(&bar[XB_XCNT(b.x)], 1u);
    return b;
}
__device__ __forceinline__ void xcd_barrier_complete(unsigned* bar, unsigned x, unsigned& nloc, unsigned& nx) {
    const unsigned G = gridDim.x * gridDim.y * gridDim.z;
    unsigned sum, cnt, mine, sp = 0u;
    for (;;) {
        sum = 0u; cnt = 0u; mine = 0u;
#pragma unroll
        for (unsigned j = 0; j < 16; ++j) { const unsigned c = xb_ld(&bar[XB_XCNT(j)]); sum += c; cnt += (c > 0u) ? 1u : 0u; mine = (j == x) ? c : mine; }
        if (sum == G) break;
        __builtin_amdgcn_s_sleep(1);
        if ((++sp & 255u) == 0u) { if (xb_ld(&bar[XB_TMO])) break; if (sp > XB_SPIN_CAP) { atomicAdd(&bar[XB_TMO], 1u); break; } }
    }
    nloc = mine > 0u ? mine : 1u; nx = cnt > 0u ? cnt : 1u;
}

__device__ __forceinline__ void xcd_barrier(const XcdBarrier& b) {
    asm volatile("s_waitcnt vmcnt(0)" ::: "memory");
    __syncthreads();
    if (threadIdx.x == 0) {
        unsigned* bar = b.bar;
        __builtin_amdgcn_s_waitcnt(0);
        unsigned nloc = b.st[0], nx = b.st[1];
        if (nloc == 0u) { xcd_barrier_complete(bar, b.x, nloc, nx); b.st[0] = nloc; b.st[1] = nx; }
        const unsigned old = xb_add(&bar[XB_XSUB(b.x)], 1u);
        const unsigned gen = old / nloc;
        if (old + 1u == (gen + 1u) * nloc) {
            __builtin_amdgcn_fence(__ATOMIC_RELEASE, "agent");
            asm volatile("s_waitcnt vmcnt(0)" ::: "memory");
            const unsigned og = xb_add(&bar[XB_TOP], 1u);
            const unsigned tg = og / nx;
            if (og + 1u == (tg + 1u) * nx) xb_add(&bar[XB_TOPGEN], 1u);
            else XB_SPIN(xb_ld(&bar[XB_TOPGEN]) == tg, bar);
            __builtin_amdgcn_fence(__ATOMIC_ACQUIRE, "agent");
            xb_add(&bar[XB_XGEN(b.x)], 1u);
            asm volatile("s_waitcnt vmcnt(0)" ::: "memory");
        } else {
            XB_SPIN(xb_ld(&bar[XB_XGEN(b.x)]) == gen, bar);
            __builtin_amdgcn_fence(__ATOMIC_ACQUIRE, "agent");
            asm volatile("s_waitcnt vmcnt(0)" ::: "memory");
        }
    }
    __syncthreads();
}

#define RAW_BAR() do { asm volatile("s_waitcnt lgkmcnt(0)" ::: "memory"); __builtin_amdgcn_s_barrier(); asm volatile("" ::: "memory"); } while (0)

DI unsigned pk4_fp8(float a, float b, float c, float d) { int w = __builtin_amdgcn_cvt_pk_fp8_f32(a, b, 0, false); w = __builtin_amdgcn_cvt_pk_fp8_f32(c, d, w, true); return (unsigned)w; }
DI float fp8c(float x) { return fminf(fmaxf(x, -448.f), 448.f); }
constexpr float WIN_SCALE = 64.f;

struct Frame {
    LAS unsigned char* lds;
    unsigned char* ws;
    const float* in[23];
    float* out;
    int tid, lane, wave, vcu, G, gw, NGW;
};

DI size_t dn_off(int m, int h) {
    int b, pos; if (m < NT) { b = m >> 12; pos = 256 + (m & 4095); } else { const int mm = m - NT; b = mm >> 8; pos = mm & 255; }
    return ((size_t)(b * 8 + h) * 4352 + pos) * 128;
}

struct EpiInProj {
    static constexpr bool PERM = true, AFTER_DRAIN = false, TWO_STAGE = false;
    unsigned char* ws; const float* a_log; const float* dt_bias;
    DI void operator()(const pg8::f32x4 (&acc)[2][2][4][2], const pg8::Unit& u, int wr, int wc, int fr, int fq) const {
        asm volatile("" : "+v"(fr), "+v"(fq));
        const int pn = u.pn, pm = u.pm; const bool isctx = pm >= 64;
        if (pn == 38) {
            if (wc != 0) return;
            float* dstf = (float*)(ws + (fq < 2 ? WS_BETA : WS_LOGA));
            const int c8 = (fq & 1) * 8;
#pragma unroll
            for (int ai = 0; ai < 2; ++ai)
#pragma unroll
                for (int m = 0; m < 4; ++m) {
                    const int row = pm * 256 + ai * 128 + wr * 64 + m * 16 + fr;
#pragma unroll
                    for (int n = 0; n < 2; ++n) {
                        f32x4 v = acc[ai][0][m][n] * (1.f / WIN_SCALE), o;
#pragma unroll
                        for (int i = 0; i < 4; ++i) {
                            const int c = c8 + 4 * n + i;
                            o[i] = (fq < 2) ? sigm(v[i]) : -__expf(a_log[c]) * softplus(v[i] + dt_bias[c]);
                        }
                        *(f32x4*)(dstf + (size_t)row * 16 + c8 + 4 * n) = o;
                    }
                }
            return;
        }
        bf16* dst; int ld, coloff, rowoff = 0; bool sg = false;
        if (pn < 4) { if (isctx) return; dst = (bf16*)(ws + WS_QN); ld = 1024; coloff = pn * 256; }
        else if (pn < 6) { dst = (bf16*)(ws + (pn == 4 ? WS_KB : WS_VB)); ld = 256; coloff = 0; rowoff = isctx ? (-12288 + (pm - 64) * 4096) : (pm >> 4) * 256; }
        else if (pn < 18) { dst = (bf16*)(ws + WS_DNRAW); ld = 3072; coloff = (pn - 6) * 256; }
        else if (pn < 22) { if (isctx) return; dst = (bf16*)(ws + WS_Z); ld = 1024; coloff = (pn - 18) * 256; }
        else { if (isctx) return; dst = (bf16*)(ws + WS_G); ld = 4096; coloff = (pn - 22) * 256; sg = true; }
        const int row0 = pm * 256 + rowoff + wr * 64 + fr, col0 = coloff + wc * 32 + 8 * fq;
#pragma unroll
        for (int ai = 0; ai < 2; ++ai)
#pragma unroll
            for (int m = 0; m < 4; ++m) {
                bf16* rowp = dst + (size_t)(row0 + ai * 128 + m * 16) * ld + col0;
#pragma unroll
                for (int bj = 0; bj < 2; ++bj) {
                    f32x4 v0 = acc[ai][bj][m][0] * (1.f / WIN_SCALE), v1 = acc[ai][bj][m][1] * (1.f / WIN_SCALE);
                    if (sg) {
                        u32x2 gb; gb.x = 0u; gb.y = 0u;
#pragma unroll
                        for (int i = 0; i < 4; ++i) { gb.x |= (unsigned)(sigm(v0[i]) * 255.f + 0.5f) << (8 * i); gb.y |= (unsigned)(sigm(v1[i]) * 255.f + 0.5f) << (8 * i); }
                        __builtin_nontemporal_store(gb, (u32x2*)((unsigned char*)dst + (size_t)(row0 + ai * 128 + m * 16) * 4096 + col0 + bj * 128));
                        continue;
                    }
                    u32x4 w; w.x = pg8::cvt_pk_bf16(v0[0], v0[1]); w.y = pg8::cvt_pk_bf16(v0[2], v0[3]); w.z = pg8::cvt_pk_bf16(v1[0], v1[1]); w.w = pg8::cvt_pk_bf16(v1[2], v1[3]);
                    __builtin_nontemporal_store(w, (u32x4*)(rowp + bj * 128));
                }
            }
    }
};


struct InProjOrder {
    pg8::StaticOrder lat; int G, c;
    static constexpr int NLAT = 64 * 39, NCTX = 4 * 15;
    DI void init(int G_, int c_) { lat.init(NT, NPROJ, G_, c_); G = G_; c = c_; }
    DI bool next(int i, pg8::Unit& u) const {
        const int L = i * G + c;
        if (L < NLAT) return lat.next(i, u);
        const int x = L - NLAT; if (x >= NCTX) return false;
        const int j = x % 15; u.pm = 64 + x / 15; u.pn = j < 2 ? 4 + j : (j < 14 ? 4 + j : 38); return true;
    }
    DI void a_ready(const pg8::Unit&) const {}
    DI void done(const pg8::Unit&) const {}
};

struct EpiPlain {
    static constexpr bool PERM = true, AFTER_DRAIN = false, TWO_STAGE = false;
    bf16* O; int ldc;
    DI void operator()(const pg8::f32x4 (&acc)[2][2][4][2], const pg8::Unit& u, int wr, int wc, int fr, int fq) const {
        const int row0 = u.pm * 256 + wr * 64 + fr, col0 = u.pn * 256 + wc * 32 + 8 * fq;
#pragma unroll
        for (int ai = 0; ai < 2; ++ai)
#pragma unroll
            for (int m = 0; m < 4; ++m) {
                bf16* rowp = O + (size_t)(row0 + ai * 128 + m * 16) * ldc + col0;
#pragma unroll
                for (int bj = 0; bj < 2; ++bj) {
                    const f32x4 v0 = acc[ai][bj][m][0], v1 = acc[ai][bj][m][1];
                    u32x4 w; w.x = pg8::cvt_pk_bf16(v0[0], v0[1]); w.y = pg8::cvt_pk_bf16(v0[2], v0[3]); w.z = pg8::cvt_pk_bf16(v1[0], v1[1]); w.w = pg8::cvt_pk_bf16(v1[2], v1[3]);
                    *(u32x4*)(rowp + bj * 128) = w;
                }
            }
    }
};

template <bool ADD> struct EpiMerge {
    static constexpr bool PERM = true, AFTER_DRAIN = false, TWO_STAGE = false;
    bf16* Y; const unsigned char* G; int goff; float gs;
    DI void operator()(const pg8::f32x4 (&acc)[2][2][4][2], const pg8::Unit& u, int wr, int wc, int fr, int fq) const {
        const int row0 = u.pm * 256 + wr * 64 + fr, col0 = u.pn * 256 + wc * 32 + 8 * fq;
#pragma unroll
        for (int ai = 0; ai < 2; ++ai)
#pragma unroll
            for (int m = 0; m < 4; ++m) {
                const size_t row = (size_t)(row0 + ai * 128 + m * 16);
#pragma unroll
                for (int bj = 0; bj < 2; ++bj) {
                    const f32x4 v0 = acc[ai][bj][m][0], v1 = acc[ai][bj][m][1];
                    const u32x2 g = __builtin_nontemporal_load((const u32x2*)(G + row * 4096 + goff + col0 + bj * 128));
                    float r[8];
#pragma unroll
                    for (int i = 0; i < 4; ++i) { r[i] = (float)((g.x >> (8 * i)) & 0xffu) * gs * v0[i]; r[4 + i] = (float)((g.y >> (8 * i)) & 0xffu) * gs * v1[i]; }
                    bf16* yp = Y + row * 2048 + col0 + bj * 128;
                    if (ADD) {
                        const u32x4 y = *(const u32x4*)yp;
                        r[0] += bflo(y.x); r[1] += bfhi(y.x); r[2] += bflo(y.y); r[3] += bfhi(y.y); r[4] += bflo(y.z); r[5] += bfhi(y.z); r[6] += bflo(y.w); r[7] += bfhi(y.w);
                    }
                    u32x4 w; w.x = pg8::cvt_pk_bf16(r[0], r[1]); w.y = pg8::cvt_pk_bf16(r[2], r[3]); w.z = pg8::cvt_pk_bf16(r[4], r[5]); w.w = pg8::cvt_pk_bf16(r[6], r[7]);
                    *(u32x4*)yp = w;
                }
            }
    }
};

struct EpiMerge2 {
    static constexpr bool PERM = true, AFTER_DRAIN = false, TWO_STAGE = true;
    bf16* Y; const unsigned char* G;
    DI void mid(pg8::f32x4 (&acc)[2][2][4][2], const pg8::Unit& u, int wr, int wc, int fr, int fq) const {
        const int row0 = u.pm * 256 + wr * 64 + fr, col0 = u.pn * 256 + wc * 32 + 8 * fq;
#pragma unroll
        for (int ai = 0; ai < 2; ++ai)
#pragma unroll
            for (int m = 0; m < 4; ++m) {
                const size_t row = (size_t)(row0 + ai * 128 + m * 16);
#pragma unroll
                for (int bj = 0; bj < 2; ++bj) {
                    const u32x2 ga = __builtin_nontemporal_load((const u32x2*)(G + row * 4096 + col0 + bj * 128));
                    const u32x2 gd = *(const u32x2*)(G + row * 4096 + 2048 + col0 + bj * 128);
#pragma unroll
                    for (int i = 0; i < 4; ++i) {
                        acc[ai][bj][m][0][i] *= (float)((ga.x >> (8 * i)) & 0xffu) * __builtin_amdgcn_rcpf(fmaxf((float)((gd.x >> (8 * i)) & 0xffu), 1.f));
                        acc[ai][bj][m][1][i] *= (float)((ga.y >> (8 * i)) & 0xffu) * __builtin_amdgcn_rcpf(fmaxf((float)((gd.y >> (8 * i)) & 0xffu), 1.f));
                    }
                }
            }
    }
    DI void operator()(const pg8::f32x4 (&acc)[2][2][4][2], const pg8::Unit& u, int wr, int wc, int fr, int fq) const {
        const int row0 = u.pm * 256 + wr * 64 + fr, col0 = u.pn * 256 + wc * 32 + 8 * fq;
#pragma unroll
        for (int ai = 0; ai < 2; ++ai)
#pragma unroll
            for (int m = 0; m < 4; ++m) {
                const size_t row = (size_t)(row0 + ai * 128 + m * 16);
#pragma unroll
                for (int bj = 0; bj < 2; ++bj) {
                    const f32x4 v0 = acc[ai][bj][m][0], v1 = acc[ai][bj][m][1];
                    const u32x2 g = __builtin_nontemporal_load((const u32x2*)(G + row * 4096 + 2048 + col0 + bj * 128));
                    float r[8];
#pragma unroll
                    for (int i = 0; i < 4; ++i) { r[i] = fmaxf((float)((g.x >> (8 * i)) & 0xffu), 1.f) * (1.f / 255.f) * v0[i]; r[4 + i] = fmaxf((float)((g.y >> (8 * i)) & 0xffu), 1.f) * (1.f / 255.f) * v1[i]; }
                    u32x4 w; w.x = pg8::cvt_pk_bf16(r[0], r[1]); w.y = pg8::cvt_pk_bf16(r[2], r[3]); w.z = pg8::cvt_pk_bf16(r[4], r[5]); w.w = pg8::cvt_pk_bf16(r[6], r[7]);
                    *(u32x4*)(Y + row * 2048 + col0 + bj * 128) = w;
                }
            }
    }
};

struct EpiResid {
    static constexpr bool PERM = true, AFTER_DRAIN = false, TWO_STAGE = false;
    const float* x; bf16* X1; const float* mod;
    DI void operator()(const pg8::f32x4 (&acc)[2][2][4][2], const pg8::Unit& u, int wr, int wc, int fr, int fq) const {
        const int row0 = u.pm * 256 + wr * 64 + fr, col0 = u.pn * 256 + wc * 32 + 8 * fq;
        const float* g1 = mod + (size_t)(u.pm >> 4) * 12288 + 2 * 2048;
        f32x4 gv[2][2];
#pragma unroll
        for (int bj = 0; bj < 2; ++bj)
#pragma unroll
            for (int n = 0; n < 2; ++n) gv[bj][n] = *(const f32x4*)(g1 + col0 + bj * 128 + n * 4);
#pragma unroll
        for (int ai = 0; ai < 2; ++ai)
#pragma unroll
            for (int m = 0; m < 4; ++m) {
                const size_t off = (size_t)(row0 + ai * 128 + m * 16) * 2048 + col0;
#pragma unroll
                for (int bj = 0; bj < 2; ++bj) {
                    const f32x4 x0 = __builtin_nontemporal_load((const f32x4*)(x + off + bj * 128)), x1 = __builtin_nontemporal_load((const f32x4*)(x + off + bj * 128 + 4));
                    const f32x4 v0 = x0 + gv[bj][0] * acc[ai][bj][m][0], v1 = x1 + gv[bj][1] * acc[ai][bj][m][1];
                    u32x4 w; w.x = pk2(v0[0], v0[1]); w.y = pk2(v0[2], v0[3]); w.z = pk2(v1[0], v1[1]); w.w = pk2(v1[2], v1[3]);
                    *(u32x4*)(X1 + off + bj * 128) = w;
                }
            }
    }
};

DI void transpose_item(const float* W, int K, int Nsrc, int sn0, bf16* WT, int dn0, int k0, LAS float* scr, int lane) {
    if (sn0 >= 0) {
        float t[32];
#pragma unroll
        for (int i = 0; i < 32; ++i) t[i] = __builtin_nontemporal_load(&W[(size_t)(k0 + 2 * i + (lane >> 5)) * Nsrc + sn0 + (lane & 31)]);
#pragma unroll
        for (int i = 0; i < 32; ++i) scr[(2 * i + (lane >> 5)) * 33 + (lane & 31)] = t[i];
    } else {
#pragma unroll 8
        for (int i = 0; i < 32; ++i) { const int kk = 2 * i + (lane >> 5); scr[kk * 33 + (lane & 31)] = 0.f; }
    }
    asm volatile("s_waitcnt lgkmcnt(0)" ::: "memory");
    const int c = lane & 7;
#pragma unroll
    for (int j = 0; j < 4; ++j) {
        const int n = (lane >> 3) + 8 * j; const LAS float* s = scr + (8 * c) * 33 + n;
        u32x4 o; o.x = pk2(s[0 * 33], s[1 * 33]); o.y = pk2(s[2 * 33], s[3 * 33]); o.z = pk2(s[4 * 33], s[5 * 33]); o.w = pk2(s[6 * 33], s[7 * 33]);
        *(u32x4*)(WT + (size_t)(dn0 + n) * K + k0 + 8 * c) = o;
    }
    asm volatile("s_waitcnt lgkmcnt(0)" ::: "memory");
}

DI void transpose_item_fp8(const float* W, int K, int Nsrc, int sn0, unsigned char* WT, int dn0, int k0, float scale, LAS float* scr, int lane) {
    if (sn0 >= 0) {
        float t[32];
#pragma unroll
        for (int i = 0; i < 32; ++i) t[i] = __builtin_nontemporal_load(&W[(size_t)(k0 + 2 * i + (lane >> 5)) * Nsrc + sn0 + (lane & 31)]);
#pragma unroll
        for (int i = 0; i < 32; ++i) scr[(2 * i + (lane >> 5)) * 33 + (lane & 31)] = t[i] * scale;
    } else {
#pragma unroll 8
        for (int i = 0; i < 32; ++i) { const int kk = 2 * i + (lane >> 5); scr[kk * 33 + (lane & 31)] = 0.f; }
    }
    asm volatile("s_waitcnt lgkmcnt(0)" ::: "memory");
    const int c = lane & 7;
#pragma unroll
    for (int j = 0; j < 4; ++j) {
        const int n = (lane >> 3) + 8 * j; const LAS float* s = scr + (8 * c) * 33 + n;
        u32x2 o; o.x = pk4_fp8(s[0 * 33], s[1 * 33], s[2 * 33], s[3 * 33]); o.y = pk4_fp8(s[4 * 33], s[5 * 33], s[6 * 33], s[7 * 33]);
        *(u32x2*)(WT + (size_t)(dn0 + n) * K + k0 + 8 * c) = o;
    }
    asm volatile("s_waitcnt lgkmcnt(0)" ::: "memory");
}

DI void cvt_bf16_stream(const float* src, bf16* dst, size_t n8, size_t gtid, size_t nthr) {
    for (size_t i = gtid; i < n8; i += nthr) {
        const f32x4 a = *(const f32x4*)(src + i * 8), b = *(const f32x4*)(src + i * 8 + 4);
        u32x4 w; w.x = pk2(a[0], a[1]); w.y = pk2(a[2], a[3]); w.z = pk2(b[0], b[1]); w.w = pk2(b[2], b[3]);
        *(u32x4*)(dst + i * 8) = w;
    }
}

DI void phase_prologue(Frame& F) {
    LAS float* scr = (LAS float*)(F.lds + F.wave * 16384);
    constexpr int I_WIN = 32 * 312, I_WB = 16 * 64, I_WO = 32 * 64;
    constexpr int NITEMS = I_WIN + 2 * I_WB + 2 * I_WO;
#ifndef PRO_REP_T
#define PRO_REP_T 1
#endif
#ifndef PRO_REP_G
#define PRO_REP_G 1
#endif
#pragma nounroll
    for (int rep_t = 0; rep_t < PRO_REP_T; ++rep_t)
    for (int it = F.gw; it < NITEMS; it += F.NGW) {
        int r = it;
        if (r < I_WIN) { const int kb = r / 312, nb = r % 312; const int snb = nb < 176 ? nb : (nb < 304 ? nb + 1 : (nb == 304 ? 176 : -1));
            transpose_item_fp8(F.in[8], DM, INW, snb < 0 ? -1 : snb * 32, F.ws + WS_WIN, nb * 32, kb * 64, WIN_SCALE, scr, F.lane); continue; }
        r -= I_WIN;
        if (r < I_WB) {
            if (MERGE_F8_A) transpose_item_fp8(F.in[15], 1024, DM, (r % 64) * 32, F.ws + WS_WBA, (r % 64) * 32, (r / 64) * 64, WB_SCALE, scr, F.lane);
            else transpose_item(F.in[15], 1024, DM, (r % 64) * 32, (bf16*)(F.ws + WS_WBA), (r % 64) * 32, (r / 64) * 64, scr, F.lane);
            continue; }
        r -= I_WB;
        if (r < I_WB) {
            if (MERGE_F8_B) transpose_item_fp8(F.in[16], 1024, DM, (r % 64) * 32, F.ws + WS_WBD, (r % 64) * 32, (r / 64) * 64, WB_SCALE, scr, F.lane);
            else transpose_item(F.in[16], 1024, DM, (r % 64) * 32, (bf16*)(F.ws + WS_WBD), (r % 64) * 32, (r / 64) * 64, scr, F.lane);
            continue; }
        r -= I_WB;
        if (r < I_WO) { transpose_item(F.in[17], DM, DM, (r % 64) * 32, (bf16*)(F.ws + WS_WOUT), (r % 64) * 32, (r / 64) * 64, scr, F.lane); continue; }
        r -= I_WO;
        transpose_item(F.in[18], DM, DM, (r % 64) * 32, (bf16*)(F.ws + WS_WQ), (r % 64) * 32, (r / 64) * 64, scr, F.lane);
    }
    cvt_bf16_stream(F.in[19], (bf16*)(F.ws + WS_SUBK), (size_t)8 * 2 * 128 * 128 / 8, (size_t)blockIdx.x * 512 + F.tid, (size_t)F.G * 512);
    LAS float* sc = (LAS float*)(F.lds + 131072);
    const float* ada_w = F.in[4];
    float* MODP = (float*)(F.ws + WS_MODP);
#pragma nounroll
    for (int rep_g = 0; rep_g < PRO_REP_G; ++rep_g)
    for (int it = blockIdx.x; it < 32 * 24; it += F.G) {
        const int kc = it / 24, nb = it % 24, n = nb * 512 + F.tid;
        __syncthreads();
        if (F.tid < 320) { const int r = F.tid >> 6, kk = F.tid & 63, k = kc * 64 + kk; const float cv = (r < 4) ? F.in[1][r * DM + k] : F.in[3][k]; sc[r * 64 + kk] = silu(cv); }
        __syncthreads();
        float a0 = 0.f, a1 = 0.f, a2 = 0.f, a3 = 0.f, a4 = 0.f;
#pragma unroll 32
        for (int kk = 0; kk < 64; ++kk) {
            const float w = __builtin_nontemporal_load(&ada_w[(size_t)(kc * 64 + kk) * 12288 + n]);
            a0 += sc[kk] * w; a1 += sc[64 + kk] * w; a2 += sc[128 + kk] * w; a3 += sc[192 + kk] * w; a4 += sc[256 + kk] * w;
        }
        float* o = MODP + (size_t)kc * 5 * 12288 + n;
        o[0] = a0; o[12288] = a1; o[2 * 12288] = a2; o[3 * 12288] = a3; o[4 * 12288] = a4;
    }
}

DI void phase_modreduce(Frame& F) {
    const float* MODP = (const float*)(F.ws + WS_MODP); float* MOD = (float*)(F.ws + WS_MOD); const float* ada_b = F.in[5];
    for (int i = blockIdx.x * 512 + F.tid; i < 5 * 12288; i += F.G * 512) {
        const int n = i % 12288; float s = ada_b[n];
#pragma unroll 8
        for (int kc = 0; kc < 32; ++kc) s += MODP[(size_t)kc * 5 * 12288 + i];
        MOD[i] = s;
    }
}

DI void modnorm_row(const float* xrow, bf16* orow, const float* nw, const float* sc, const float* sh, int lane) {
    f32x4 v[8]; float ss = 0.f;
#pragma unroll
    for (int j = 0; j < 8; ++j) { v[j] = *((const f32x4*)xrow + lane + 64 * j); ss += (v[j][0] * v[j][0] + v[j][1] * v[j][1]) + (v[j][2] * v[j][2] + v[j][3] * v[j][3]); }
    const float rstd = rsqrtf(wave_sum(ss) * (1.f / DM) + EPS);
#pragma unroll
    for (int j = 0; j < 8; ++j) {
        const int c = (lane + 64 * j) * 4;
        const f32x4 w = *(const f32x4*)(nw + c), s = *(const f32x4*)(sc + c), h = *(const f32x4*)(sh + c);
        f32x4 o;
#pragma unroll
        for (int i = 0; i < 4; ++i) o[i] = (v[j][i] * rstd * w[i]) * (1.f + s[i]) + h[i];
        u32x2 p; p.x = pk2(o[0], o[1]); p.y = pk2(o[2], o[3]);
        *(u32x2*)(orow + c) = p;
    }
}

DI void modnorm_row_bf(const bf16* xrow, bf16* orow, const float* nw, const float* sc, const float* sh, int lane) {
    f32x4 v[8]; float ss = 0.f;
#pragma unroll
    for (int j = 0; j < 8; ++j) { const u32x2 w = *((const u32x2*)xrow + lane + 64 * j); v[j] = (f32x4){bflo(w.x), bfhi(w.x), bflo(w.y), bfhi(w.y)}; ss += (v[j][0] * v[j][0] + v[j][1] * v[j][1]) + (v[j][2] * v[j][2] + v[j][3] * v[j][3]); }
    const float rstd = rsqrtf(wave_sum(ss) * (1.f / DM) + EPS);
#pragma unroll
    for (int j = 0; j < 8; ++j) {
        const int c = (lane + 64 * j) * 4;
        const f32x4 w = *(const f32x4*)(nw + c), s = *(const f32x4*)(sc + c), h = *(const f32x4*)(sh + c);
        f32x4 o;
#pragma unroll
        for (int i = 0; i < 4; ++i) o[i] = (v[j][i] * rstd * w[i]) * (1.f + s[i]) + h[i];
        u32x2 p; p.x = pk2(o[0], o[1]); p.y = pk2(o[2], o[3]);
        *(u32x2*)(orow + c) = p;
    }
}

DI void modnorm_row_fp8(const float* xrow, unsigned char* orow, const float* nw, const float* sc, const float* sh, int lane) {
    f32x4 v[8]; float ss = 0.f;
#pragma unroll
    for (int j = 0; j < 8; ++j) { v[j] = __builtin_nontemporal_load((const f32x4*)xrow + lane + 64 * j); ss += (v[j][0] * v[j][0] + v[j][1] * v[j][1]) + (v[j][2] * v[j][2] + v[j][3] * v[j][3]); }
    const float rstd = rsqrtf(wave_sum(ss) * (1.f / DM) + EPS);
#pragma unroll
    for (int j = 0; j < 8; ++j) {
        const int c = (lane + 64 * j) * 4;
        const f32x4 w = *(const f32x4*)(nw + c), s = *(const f32x4*)(sc + c), h = *(const f32x4*)(sh + c);
        f32x4 o;
#pragma unroll
        for (int i = 0; i < 4; ++i) o[i] = (v[j][i] * rstd * w[i]) * (1.f + s[i]) + h[i];
        *(unsigned*)(orow + c) = pk4_fp8(o[0], o[1], o[2], o[3]);
    }
}

struct ModPar { f32x4 a[8], h[8]; };
DI void modpar_load(ModPar& P, const float* nw, const float* sc, const float* sh, int lane) {
#pragma unroll
    for (int j = 0; j < 8; ++j) { const int c = (lane + 64 * j) * 4; const f32x4 w = *(const f32x4*)(nw + c), s = *(const f32x4*)(sc + c); P.a[j] = w * (1.f + s); P.h[j] = *(const f32x4*)(sh + c); }
}
DI void modnorm_rows_fp8(const float* x0, unsigned char* o0, int nrows, const ModPar& P, int lane) {
    f32x4 v[8];
#pragma unroll
    for (int j = 0; j < 8; ++j) v[j] = __builtin_nontemporal_load((const f32x4*)x0 + lane + 64 * j);
    for (int r = 0; r < nrows; ++r) {
        float ss = 0.f;
#pragma unroll
        for (int j = 0; j < 8; ++j) ss += (v[j][0] * v[j][0] + v[j][1] * v[j][1]) + (v[j][2] * v[j][2] + v[j][3] * v[j][3]);
        const float rstd = rsqrtf(wave_sum(ss) * (1.f / DM) + EPS);
        unsigned char* orow = o0 + (size_t)r * DM;
        const float* xn = x0 + (size_t)(r + 1 < nrows ? r + 1 : r) * DM;
#pragma unroll
        for (int j = 0; j < 8; ++j) {
            const f32x4 o = (v[j] * rstd) * P.a[j] + P.h[j];
            v[j] = __builtin_nontemporal_load((const f32x4*)xn + lane + 64 * j);
            *(unsigned*)(orow + (lane + 64 * j) * 4) = pk4_fp8(o[0], o[1], o[2], o[3]);
        }
    }
}
DI void modnorm_rows_bf(const bf16* x0, bf16* o0, int nrows, const ModPar& P, int lane) {
    u32x2 w[8];
#pragma unroll
    for (int j = 0; j < 8; ++j) w[j] = *((const u32x2*)x0 + lane + 64 * j);
    for (int r = 0; r < nrows; ++r) {
        f32x4 v[8]; float ss = 0.f;
#pragma unroll
        for (int j = 0; j < 8; ++j) { v[j] = (f32x4){bflo(w[j].x), bfhi(w[j].x), bflo(w[j].y), bfhi(w[j].y)}; ss += (v[j][0] * v[j][0] + v[j][1] * v[j][1]) + (v[j][2] * v[j][2] + v[j][3] * v[j][3]); }
        const float rstd = rsqrtf(wave_sum(ss) * (1.f / DM) + EPS);
        bf16* orow = o0 + (size_t)r * DM;
        const bf16* xn = x0 + (size_t)(r + 1 < nrows ? r + 1 : r) * DM;
#pragma unroll
        for (int j = 0; j < 8; ++j) {
            const f32x4 o = (v[j] * rstd) * P.a[j] + P.h[j];
            w[j] = *((const u32x2*)xn + lane + 64 * j);
            u32x2 p; p.x = pk2(o[0], o[1]); p.y = pk2(o[2], o[3]);
            *(u32x2*)(orow + (lane + 64 * j) * 4) = p;
        }
    }
}

DI void phase_h1(Frame& F) {
    const float* MOD = (const float*)(F.ws + WS_MOD); unsigned char* H = F.ws + WS_H;
    ModPar P;
    {
        constexpr int RPW = NT / (256 * NWAVES);
        const int m0 = F.gw * RPW, r = m0 >> 12;
        if (F.NGW == 256 * NWAVES) {
            modpar_load(P, F.in[6], MOD + (size_t)r * 12288 + 2048, MOD + (size_t)r * 12288, F.lane);
            modnorm_rows_fp8(F.in[0] + (size_t)m0 * DM, H + (size_t)m0 * DM, RPW, P, F.lane);
        } else {
            for (int m = F.gw; m < NT; m += F.NGW) { modpar_load(P, F.in[6], MOD + (size_t)(m >> 12) * 12288 + 2048, MOD + (size_t)(m >> 12) * 12288, F.lane); modnorm_rows_fp8(F.in[0] + (size_t)m * DM, H + (size_t)m * DM, 1, P, F.lane); }
        }
    }
    if (F.gw < NC) {
        modpar_load(P, F.in[6], MOD + (size_t)4 * 12288 + 2048, MOD + (size_t)4 * 12288, F.lane);
        for (int m = F.gw; m < NC; m += F.NGW) modnorm_rows_fp8(F.in[2] + (size_t)m * DM, H + (size_t)(NT + m) * DM, 1, P, F.lane);
    }
}

DI void phase_postproj(Frame& F) {
    const int lane = F.lane, tid = F.tid;
    LAS float* tcs = (LAS float*)F.lds;
    for (int i = tid; i < 2048; i += 512) { const int pos = i >> 5, f = i & 31; float sn, cs; sincosf((float)pos * exp2f(-(float)f * (13.287712379549449f / 32.f)), &sn, &cs); tcs[i] = cs; tcs[2048 + i] = sn; }
    __syncthreads();
    {
        bf16* QN = (bf16*)(F.ws + WS_QN); bf16* KB = (bf16*)(F.ws + WS_KB);
        const int j = lane & 7, axis = j >> 2, fg = j & 3, d1 = axis * 64 + 8 * fg;
        f32x4 qw[4], kw[4];
        qw[0] = *(const f32x4*)(F.in[9] + d1); qw[1] = *(const f32x4*)(F.in[9] + d1 + 4); qw[2] = *(const f32x4*)(F.in[9] + d1 + 32); qw[3] = *(const f32x4*)(F.in[9] + d1 + 36);
        kw[0] = *(const f32x4*)(F.in[10] + d1); kw[1] = *(const f32x4*)(F.in[10] + d1 + 4); kw[2] = *(const f32x4*)(F.in[10] + d1 + 32); kw[3] = *(const f32x4*)(F.in[10] + d1 + 36);
        constexpr int NQI = NT, NKI = NB * LKV / 4;
        for (int it = F.gw; it < NQI + NKI; it += F.NGW) {
            bf16* p; int t; bool rope; const bool isq = it < NQI;
            if (isq) { p = QN + (size_t)it * 1024 + (lane >> 3) * 128; t = it & 4095; rope = true; }
            else { const int row = (it - NQI) * 4 + (lane >> 4), pp = row % LKV; p = KB + (size_t)row * 256 + ((lane >> 3) & 1) * 128; t = pp; rope = pp < TS; }
            const u32x4 w1 = *(const u32x4*)(p + d1), w2 = *(const u32x4*)(p + d1 + 32);
            float x1[8], x2[8];
            x1[0] = bflo(w1.x); x1[1] = bfhi(w1.x); x1[2] = bflo(w1.y); x1[3] = bfhi(w1.y); x1[4] = bflo(w1.z); x1[5] = bfhi(w1.z); x1[6] = bflo(w1.w); x1[7] = bfhi(w1.w);
            x2[0] = bflo(w2.x); x2[1] = bfhi(w2.x); x2[2] = bflo(w2.y); x2[3] = bfhi(w2.y); x2[4] = bflo(w2.z); x2[5] = bfhi(w2.z); x2[6] = bflo(w2.w); x2[7] = bfhi(w2.w);
            float ss = 0.f;
#pragma unroll
            for (int i = 0; i < 8; ++i) ss += x1[i] * x1[i] + x2[i] * x2[i];
            ss += __shfl_xor(ss, 1); ss += __shfl_xor(ss, 2); ss += __shfl_xor(ss, 4);
            const float rstd = rsqrtf(ss * (1.f / 128.f) + EPS);
            const int pos = axis == 0 ? (t >> 6) : (t & 63);
            float o1[8], o2[8];
#pragma unroll
            for (int i = 0; i < 8; ++i) {
                const float wa = isq ? qw[i >> 2][i & 3] : kw[i >> 2][i & 3], wb = isq ? qw[2 + (i >> 2)][i & 3] : kw[2 + (i >> 2)][i & 3];
                const float y1 = x1[i] * rstd * wa, y2 = x2[i] * rstd * wb;
                const float cs = rope ? tcs[pos * 32 + 8 * fg + i] : 1.f, sn = rope ? tcs[2048 + pos * 32 + 8 * fg + i] : 0.f;
                o1[i] = y1 * cs - y2 * sn; o2[i] = y2 * cs + y1 * sn;
            }
            u32x4 r1, r2;
            r1.x = pk2(o1[0], o1[1]); r1.y = pk2(o1[2], o1[3]); r1.z = pk2(o1[4], o1[5]); r1.w = pk2(o1[6], o1[7]);
            r2.x = pk2(o2[0], o2[1]); r2.y = pk2(o2[2], o2[3]); r2.z = pk2(o2[4], o2[5]); r2.w = pk2(o2[6], o2[7]);
            *(u32x4*)(p + d1) = r1; *(u32x4*)(p + d1 + 32) = r2;
        }
    }
    {
        const bf16* RAW = (const bf16*)(F.ws + WS_DNRAW); const float* cw = F.in[11];
        for (int it = F.gw; it < (MTOT / 16) * 6; it += F.NGW) {
            const int tc = it / 6, grp = it % 6, m0 = tc * 16, part = grp >> 1;
            int start, len; if (m0 < NT) { start = m0 & ~4095; len = TS; } else { start = NT + ((m0 - NT) & ~255); len = CL; }
            const int pos0 = m0 - start, c = grp * 512 + 8 * lane;
            float wv[5][8];
#pragma unroll
            for (int jj = 0; jj < 5; ++jj) { const f32x4 a = *(const f32x4*)(cw + jj * 3072 + c), b = *(const f32x4*)(cw + jj * 3072 + c + 4);
                wv[jj][0] = a[0]; wv[jj][1] = a[1]; wv[jj][2] = a[2]; wv[jj][3] = a[3]; wv[jj][4] = b[0]; wv[jj][5] = b[1]; wv[jj][6] = b[2]; wv[jj][7] = b[3]; }
            u32x4 rows[20];
#pragma unroll
            for (int r = 0; r < 20; ++r) { const int pp = pos0 + r - 2; rows[r] = (pp >= 0 && pp < len) ? *(const u32x4*)(RAW + (size_t)(start + pp) * 3072 + c) : (u32x4){0u, 0u, 0u, 0u}; }
            bf16* dst = (bf16*)(F.ws + (part == 0 ? WS_DQ : (part == 1 ? WS_DK : WS_DV))) + dn_off(m0, (grp & 1) * 4 + (lane >> 4)) + 8 * (lane & 15);
#pragma unroll
            for (int tk = 0; tk < 16; ++tk) {
                float a[8];
#pragma unroll
                for (int i = 0; i < 8; ++i) a[i] = 0.f;
#pragma unroll
                for (int jj = 0; jj < 5; ++jj) { const u32x4 w = rows[tk + jj];
                    a[0] += wv[jj][0] * bflo(w.x); a[1] += wv[jj][1] * bfhi(w.x); a[2] += wv[jj][2] * bflo(w.y); a[3] += wv[jj][3] * bfhi(w.y);
                    a[4] += wv[jj][4] * bflo(w.z); a[5] += wv[jj][5] * bfhi(w.z); a[6] += wv[jj][6] * bflo(w.w); a[7] += wv[jj][7] * bfhi(w.w); }
                float ss = 0.f;
#pragma unroll
                for (int i = 0; i < 8; ++i) { a[i] = silu(a[i]); ss += a[i] * a[i]; }
                if (part < 2) {
                    ss += __shfl_xor(ss, 1); ss += __shfl_xor(ss, 2); ss += __shfl_xor(ss, 4); ss += __shfl_xor(ss, 8);
                    const float r = rsqrtf(ss + EPS) * (part == 0 ? 0.088388347648318440f : 1.f);
#pragma unroll
                    for (int i = 0; i < 8; ++i) a[i] *= r;
                }
                u32x4 o; o.x = pk2(a[0], a[1]); o.y = pk2(a[2], a[3]); o.z = pk2(a[4], a[5]); o.w = pk2(a[6], a[7]);
                *(u32x4*)(dst + tk * 128) = o;
            }
        }
    }
}

DI void phase_dn_naive(Frame& F) {
    if (F.wave != 0 || blockIdx.x >= 128) return;
    const int item = blockIdx.x, dir = item >> 6, b = (item >> 4) & 3, h = (item >> 1) & 7, half = item & 1, lane = F.lane;
    const bf16* DQ = (const bf16*)(F.ws + WS_DQ); const bf16* DK = (const bf16*)(F.ws + WS_DK); const bf16* DV = (const bf16*)(F.ws + WS_DV);
    const float* BETA = (const float*)(F.ws + WS_BETA); const float* LOGA = (const float*)(F.ws + WS_LOGA);
    bf16* ODN = (bf16*)(F.ws + WS_ODN);
    float S[128];
#pragma unroll
    for (int i = 0; i < 128; ++i) S[i] = 0.f;
    for (int step = 0; step < LKV; ++step) {
        const bool isl = step >= CL; const int p = isl ? step - CL : step, len = isl ? TS : CL, pos = dir ? len - 1 - p : p;
        const int m = isl ? b * TS + pos : NT + b * CL + pos;
        const unsigned kw = *(const unsigned*)(DK + dn_off(m, h) + 2 * lane);
        const unsigned qw = *(const unsigned*)(DQ + dn_off(m, h) + 2 * lane);
        const float vj = bf2f(DV[dn_off(m, h) + half * 64 + lane]);
        const float a = __expf(LOGA[(size_t)m * 16 + dir * 8 + h]), bt = BETA[(size_t)m * 16 + dir * 8 + h];
        float k0 = 0.f, k1 = 0.f, k2 = 0.f, k3 = 0.f;
#pragma unroll
        for (int i = 0; i < 64; i += 2) {
            const unsigned w0 = rdlane(kw, i), w1 = rdlane(kw, i + 1);
            k0 += bflo(w0) * S[2 * i]; k1 += bfhi(w0) * S[2 * i + 1]; k2 += bflo(w1) * S[2 * i + 2]; k3 += bfhi(w1) * S[2 * i + 3];
        }
        const float kS = (k0 + k1) + (k2 + k3);
        const float coef = bt * (vj - a * kS);
#pragma unroll
        for (int i = 0; i < 64; ++i) { const unsigned w0 = rdlane(kw, i); S[2 * i] = a * S[2 * i] + coef * bflo(w0); S[2 * i + 1] = a * S[2 * i + 1] + coef * bfhi(w0); }
        if (isl) {
            float o0 = 0.f, o1 = 0.f, o2 = 0.f, o3 = 0.f;
#pragma unroll
            for (int i = 0; i < 64; i += 2) {
                const unsigned w0 = rdlane(qw, i), w1 = rdlane(qw, i + 1);
                o0 += bflo(w0) * S[2 * i]; o1 += bfhi(w0) * S[2 * i + 1]; o2 += bflo(w1) * S[2 * i + 2]; o3 += bfhi(w1) * S[2 * i + 3];
            }
            ODN[((size_t)dir * NT + m) * 1024 + h * 128 + half * 64 + lane] = (bf16)f2bf((o0 + o1) + (o2 + o3));
        }
    }
}

DI int dn_row0(int b, int cc) { return cc < 4 ? NT + b * CL + 64 * cc : b * TS + 64 * (cc - 4); }
typedef short bf16x8_t __attribute__((ext_vector_type(8)));
#define MFMA16(a, b, c) __builtin_amdgcn_mfma_f32_16x16x32_bf16((a), (b), (c), 0, 0, 0)

DI bf16x8_t dn_afrag(const LAS unsigned char* p) {
    const u32x2 lo = *(const LAS u32x2*)p, hi = *(const LAS u32x2*)(p + 32);
    u32x4 v; v.x = lo.x; v.y = lo.y; v.z = hi.x; v.w = hi.y; return __builtin_bit_cast(bf16x8_t, v);
}
DI bf16x8_t dn_bpack(const f32x4 t0, const f32x4 t1) {
    u32x4 v; v.x = pk2(t0[0], t0[1]); v.y = pk2(t0[2], t0[3]); v.z = pk2(t1[0], t1[1]); v.w = pk2(t1[2], t1[3]); return __builtin_bit_cast(bf16x8_t, v);
}
DI void phase_dn_prep(Frame& F) {
    LAS unsigned char* L = F.lds;
    constexpr int KS = 0, QS = 17408, VC = 34816, AP = 35840;
    constexpr int NITEM = NB * 8 * 68, NBATCH = (NITEM + 2) / 3;
    const bf16* DQ = (const bf16*)(F.ws + WS_DQ); const bf16* DK = (const bf16*)(F.ws + WS_DK);
    const float* BETA = (const float*)(F.ws + WS_BETA); const float* LOGA = (const float*)(F.ws + WS_LOGA);
    bf16* KT = (bf16*)(F.ws + WS_KT); bf16* TINV = (bf16*)(F.ws + WS_TINV); bf16* QKO = (bf16*)(F.ws + WS_QKO); float* VEC = (float*)(F.ws + WS_VEC);
    const int tid = F.tid, wave = F.wave;
    LAS float* vg = (LAS float*)(L + VC); LAS float* vb = vg + 128;
    for (int batch = F.vcu; batch < NBATCH; batch += F.G) {
        int lane = F.lane; asm volatile("" : "+v"(lane));
        const int fr = lane & 15, fq = lane >> 4;
#pragma unroll 1
        for (int c3 = 0; c3 < 3; ++c3) {
            const int item = batch * 3 + c3;
            if (item >= NITEM) break;
            const int b = item / 544, h = (item % 544) / 68, cc = item % 68, row0 = dn_row0(b, cc);
#pragma unroll
            for (int k = 0; k < 4; ++k) {
                const int c = tid + 512 * k, which = c >> 10, c2 = c & 1023, row = c2 >> 4, c16 = c2 & 15;
                const u32x4 v = *(const u32x4*)((which ? DQ : DK) + (size_t)item * 8192 + c2 * 8);
                *(LAS u32x4*)(L + (which ? QS : KS) + row * 272 + c16 * 16) = v;
            }
            if (wave < 2) {
                const int d = wave, i = lane;
                const float la = LOGA[(size_t)(row0 + i) * 16 + d * 8 + h], bt = BETA[(size_t)(row0 + i) * 16 + d * 8 + h];
                float x = la;
                if (d == 0) {
#pragma unroll
                    for (int o = 1; o < 64; o <<= 1) { const float y = __shfl_up(x, o); if (i >= o) x += y; }
                } else {
#pragma unroll
                    for (int o = 1; o < 64; o <<= 1) { const float y = __shfl_down(x, o); if (i + o < 64) x += y; }
                }
                const float glast = __shfl(x, d == 0 ? 63 : 0);
                vg[d * 64 + i] = x; vb[d * 64 + i] = bt;
                float* ve = VEC + (size_t)(item * 2 + d) * 320;
                const float eg = __expf(x);
                ve[i] = bt; ve[64 + i] = eg; ve[128 + i] = bt * eg; ve[192 + i] = __expf(glast - x); ve[256 + i] = __expf(glast);
            }
            __syncthreads();
            {
                bf16* kt = KT + (size_t)item * 8192;
#pragma unroll
                for (int k = 0; k < 2; ++k) {
                    const int c = tid + 512 * k, dk = c >> 3, t8 = c & 7;
                    unsigned short e[8];
#pragma unroll
                    for (int q = 0; q < 8; ++q) e[q] = *(const LAS unsigned short*)(L + KS + (8 * t8 + q) * 272 + dk * 2);
                    u32x4 w; w.x = e[0] | ((unsigned)e[1] << 16); w.y = e[2] | ((unsigned)e[3] << 16); w.z = e[4] | ((unsigned)e[5] << 16); w.w = e[6] | ((unsigned)e[7] << 16);
                    *(u32x4*)(kt + dk * 64 + 8 * t8) = w;
                }
            }
            {
                const int it = wave & 3, mat = wave >> 2;
                f32x4 acc[4];
#pragma unroll
                for (int j = 0; j < 4; ++j) acc[j] = (f32x4){0.f, 0.f, 0.f, 0.f};
#pragma unroll
                for (int s = 0; s < 4; ++s) {
                    const bf16x8_t a = *(const LAS bf16x8_t*)(L + (mat ? QS : KS) + (16 * it + fr) * 272 + (32 * s + 8 * fq) * 2);
#pragma unroll
                    for (int jt = 0; jt < 4; ++jt) {
                        const bf16x8_t bb = *(const LAS bf16x8_t*)(L + KS + (16 * jt + fr) * 272 + (32 * s + 8 * fq) * 2);
                        acc[jt] = MFMA16(a, bb, acc[jt]);
                    }
                }
                f32x4 gi[2], bi[2]; float gj[2][4];
#pragma unroll
                for (int d = 0; d < 2; ++d) {
                    gi[d] = *(const LAS f32x4*)(vg + d * 64 + 16 * it + 4 * fq); bi[d] = *(const LAS f32x4*)(vb + d * 64 + 16 * it + 4 * fq);
#pragma unroll
                    for (int jt = 0; jt < 4; ++jt) gj[d][jt] = vg[d * 64 + 16 * jt + fr];
                }
                if (mat == 0) {
#pragma unroll
                    for (int d = 0; d < 2; ++d) {
                        LAS float* ap = (LAS float*)(L + AP + (c3 * 2 + d) * 17408);
#pragma unroll
                        for (int jt = 0; jt < 4; ++jt)
#pragma unroll
                            for (int r = 0; r < 4; ++r) {
                                const int i = 16 * it + 4 * fq + r, j = 16 * jt + fr, ip = d ? 63 - i : i, jp = d ? 63 - j : j;
                                ap[ip * 68 + jp] = (jp < ip) ? bi[d][r] * acc[jt][r] * __expf(gi[d][r] - gj[d][jt]) : 0.f;
                            }
                    }
                } else {
#pragma unroll
                    for (int d = 0; d < 2; ++d) {
                        bf16* qo = QKO + (size_t)(item * 2 + d) * 4096;
#pragma unroll
                        for (int jt = 0; jt < 4; ++jt)
#pragma unroll
                            for (int r = 0; r < 4; ++r) {
                                const int i = 16 * it + 4 * fq + r, j = 16 * jt + fr, ip = d ? 63 - i : i, jp = d ? 63 - j : j;
                                qo[i * 64 + j] = (bf16)f2bf((jp <= ip) ? acc[jt][r] * __expf(gi[d][r] - gj[d][jt]) : 0.f);
                            }
                    }
                }
            }
            __syncthreads();
        }
        if (wave < 6 && batch * 3 + (wave >> 1) < NITEM) {
            const int item = batch * 3 + (wave >> 1), d = wave & 1, c = lane;
            const LAS float* ap = (const LAS float*)(L + AP + wave * 17408);
            float x[64];
#pragma unroll
            for (int ip = 0; ip < 64; ++ip) {
                float a0 = (ip == c) ? 1.f : 0.f, a1 = 0.f;
#pragma unroll
                for (int q = 0; q < (ip + 3) / 4; ++q) {
                    const f32x4 av = *(const LAS f32x4*)(ap + ip * 68 + 4 * q);
#pragma unroll
                    for (int e = 0; e < 4; ++e) { const int jp = 4 * q + e; if (jp < ip) { if (e & 1) a1 -= av[e] * x[jp]; else a0 -= av[e] * x[jp]; } }
                }
                x[ip] = a0 + a1;
                __builtin_amdgcn_sched_barrier(0);
            }
            bf16* ti = TINV + (size_t)(item * 2 + d) * 4096;
            const int j = d ? 63 - c : c;
#pragma unroll
            for (int ip = 0; ip < 64; ++ip) { const int i = d ? 63 - ip : ip; ti[i * 64 + j] = (bf16)f2bf(x[ip]); }
        }
        __syncthreads();
    }
}

DI int dn_perm(int m, int t) { return 32 * (t >> 1) + 8 * (m >> 2) + 4 * (t & 1) + (m & 3); }
DI int dn_swz16(int row, int chunk) { return row * 272 + (chunk << 4); }
DI int dn_swz8(int row, int chunk) { return row * 144 + (chunk << 4); }
#define DN_BAR() do { asm volatile("s_waitcnt lgkmcnt(0)" ::: "memory"); __builtin_amdgcn_s_barrier(); asm volatile("" ::: "memory"); } while (0)
DI void phase_dn_scan(Frame& F) {
    LAS unsigned char* L = F.lds;
    constexpr int KS = 0, QS = 17408, KTS = 34816, TIS = 53248, VS = 62464, VCS = 66560, BUF = 68096;
    constexpr int PUBS = 2 * BUF, PUBV = PUBS + 16384;
    static_assert(PUBV + 8192 <= LDS_BYTES - 64, "scan LDS map");
    const int G8 = F.G >> 3;
    const int li = blockIdx.x >> 3, chain = (blockIdx.x & 7) * (G8 >> 2) + (li >> 2), qd = li & 3;
    if (F.G != 256 || chain >= 64) return;
    const int dir = chain >> 5, b = (chain >> 3) & 3, h = chain & 7;
    const bf16* DQ = (const bf16*)(F.ws + WS_DQ); const bf16* DK = (const bf16*)(F.ws + WS_DK); const bf16* DV = (const bf16*)(F.ws + WS_DV);
    const bf16* KT = (const bf16*)(F.ws + WS_KT); const bf16* TINV = (const bf16*)(F.ws + WS_TINV); const bf16* QKO = (const bf16*)(F.ws + WS_QKO); const float* VEC = (const float*)(F.ws + WS_VEC);
    bf16* ODN = (bf16*)(F.ws + WS_ODN);
    const int tid = F.tid, lane = F.lane, w = F.wave, fr = lane & 15, fq = lane >> 4;
#ifndef DN_NSTEP
#define DN_NSTEP 68
#endif
#define DN_CC1(st) (dir == 0 ? (st) : ((st) < 4 ? 3 - (st) : 71 - (st)))
#define DN_CC(step) DN_CC1((step) % 68)
#define AF16(base, row, kchunk) (*(const LAS bf16x8_t*)(Lb + (base) + dn_swz16((row), (kchunk))))
#define AF8(base, row, kchunk) (*(const LAS bf16x8_t*)(Lb + (base) + dn_swz8((row), (kchunk))))
    if (w >= 4) {
        const int lt = tid - 256;
        u32x4 preA[16], preB[16];
#define DN_LOAD(pre, cc_) do { const int cc__ = (cc_); const int item__ = (b * 8 + h) * 68 + cc__, cd__ = item__ * 2 + dir; \
        _Pragma("unroll") for (int k = 0; k < 16; ++k) { const bf16* src; \
            if (k < 4)       { const int q = lt + 256 * k;        src = DK + (size_t)item__ * 8192 + q * 8; } \
            else if (k < 8)  { const int q = lt + 256 * (k - 4);  src = DQ + (size_t)item__ * 8192 + q * 8; } \
            else if (k < 12) { const int q = lt + 256 * (k - 8);  src = KT + (size_t)item__ * 8192 + q * 8; } \
            else if (k < 14) { const int q = lt + 256 * (k - 12); src = TINV + (size_t)cd__ * 4096 + q * 8; } \
            else if (k == 14) { src = DV + (size_t)item__ * 8192 + (lt >> 2) * 128 + qd * 32 + (lt & 3) * 8; } \
            else { src = (const bf16*)(VEC + (size_t)cd__ * 320 + (lt < 80 ? lt : 0) * 4); } \
            pre[k] = *(const u32x4*)src; } } while (0)
#define DN_STORE(pre, bufo_) do { const int bo__ = (bufo_); _Pragma("unroll") for (int k = 0; k < 16; ++k) { int dst; \
            if (k < 4)       { const int q = lt + 256 * k;        dst = KS + dn_swz16(q >> 4, q & 15); } \
            else if (k < 8)  { const int q = lt + 256 * (k - 4);  dst = QS + dn_swz16(q >> 4, q & 15); } \
            else if (k < 12) { const int q = lt + 256 * (k - 8);  dst = KTS + dn_swz8(q >> 3, q & 7); } \
            else if (k < 14) { const int q = lt + 256 * (k - 12); dst = TIS + dn_swz8(q >> 3, q & 7); } \
            else if (k == 14) { dst = VS + lt * 16; } \
            else { dst = VCS + (lt < 80 ? lt : 0) * 16; } \
            *(LAS u32x4*)(L + bo__ + dst) = pre[k]; } } while (0)
#ifdef DN_SKIP_LOAD
#define DN_CLAMP(ds) ((ds) < DN_NSTEP - 70 ? 0 : (ds) < DN_NSTEP ? (ds) : DN_NSTEP - 1)
#else
#define DN_CLAMP(ds) ((ds) < DN_NSTEP ? (ds) : DN_NSTEP - 1)
#endif
#ifndef DN_SLEEP
#define DN_SLEEP 8
#endif
#define DN_LDELAY() __builtin_amdgcn_s_sleep(DN_SLEEP)
        DN_LOAD(preA, DN_CC(0)); DN_STORE(preA, 0); DN_LOAD(preA, DN_CC(1)); DN_LOAD(preB, DN_CC(2));
        DN_BAR();
        for (int step = 0; step < DN_NSTEP; step += 2) {
            DN_LDELAY(); DN_STORE(preA, BUF); DN_LOAD(preA, DN_CC(DN_CLAMP(step + 3)));
            DN_BAR();
            DN_LDELAY(); DN_STORE(preB, 0); DN_LOAD(preB, DN_CC(DN_CLAMP(step + 4)));
            DN_BAR();
        }
#undef DN_CLAMP
#undef DN_LOAD
#undef DN_STORE
    } else if (w >= 2) {
        const int pw = w - 2;
        bf16x8_t qkA[2][4], qkB[2][4];
        f32x4 O[4];
#define DN_QKLOAD(dst, st_) do { const int cd__ = ((b * 8 + h) * 68 + DN_CC(st_)) * 2 + dir; \
        _Pragma("unroll") for (int s = 0; s < 2; ++s) _Pragma("unroll") for (int mt = 0; mt < 4; ++mt) \
            dst[s][mt] = *(const bf16x8_t*)(QKO + (size_t)cd__ * 4096 + dn_perm(fr, mt) * 64 + (4 * s + fq) * 8); } while (0)
#define DN_OFIN(qk, st_) do { const int st__ = (st_); const LAS unsigned char* pv = L + PUBV + (st__ & 1) * 4096 + pw * 2048 + lane * 16; \
        const bf16x8_t vb0 = *(const LAS bf16x8_t*)pv, vb1 = *(const LAS bf16x8_t*)(pv + 1024); \
        _Pragma("unroll") for (int mt = 0; mt < 4; ++mt) { O[mt] = MFMA16(vb0, qk[0][mt], O[mt]); O[mt] = MFMA16(vb1, qk[1][mt], O[mt]); } \
        const int cc__ = DN_CC(st__); \
        if (cc__ >= 4) { bf16* orow = ODN + ((size_t)dir * NT + dn_row0(b, cc__)) * 1024 + h * 128 + qd * 32 + 16 * pw + 4 * fq; \
            _Pragma("unroll") for (int mt = 0; mt < 4; ++mt) { u32x2 w2; w2.x = pk2(O[mt][0], O[mt][1]); w2.y = pk2(O[mt][2], O[mt][3]); \
                *(u32x2*)(orow + (size_t)dn_perm(fr, mt) * 1024) = w2; } } } while (0)
#define DN_OBEG(st_) do { const int st__ = (st_); const LAS unsigned char* Lb = L + (st__ & 1) * BUF; const LAS unsigned char* ps = L + PUBS + (st__ & 1) * 8192 + pw * 4096 + lane * 16; \
        bf16x8_t sb[4], qa[4][4]; \
        _Pragma("unroll") for (int s = 0; s < 4; ++s) sb[s] = *(const LAS bf16x8_t*)(ps + s * 1024); \
        _Pragma("unroll") for (int s = 0; s < 4; ++s) _Pragma("unroll") for (int mt = 0; mt < 4; ++mt) qa[s][mt] = AF16(QS, dn_perm(fr, mt), 4 * s + fq); \
        _Pragma("unroll") for (int mt = 0; mt < 4; ++mt) O[mt] = (f32x4){0.f, 0.f, 0.f, 0.f}; \
        _Pragma("unroll") for (int s = 0; s < 4; ++s) _Pragma("unroll") for (int mt = 0; mt < 4; ++mt) O[mt] = MFMA16(sb[s], qa[s][mt], O[mt]); \
        const LAS float* vc = (const LAS float*)(Lb + VCS); \
        _Pragma("unroll") for (int mt = 0; mt < 4; ++mt) { const float eg = vc[64 + dn_perm(fr, mt)]; O[mt] = O[mt] * eg; } } while (0)
        DN_QKLOAD(qkA, 0); DN_QKLOAD(qkB, 1);
        DN_BAR();
        DN_OBEG(0);
        DN_BAR();
        for (int step = 0; step < DN_NSTEP - 2; step += 2) {
#ifdef DN_SKIP_OUT
            if (step < DN_NSTEP - 70) { DN_BAR(); DN_BAR(); continue; }
#endif
            DN_OFIN(qkA, step); DN_QKLOAD(qkA, step + 2);
            DN_OBEG(step + 1);
            DN_BAR();
            DN_OFIN(qkB, step + 1); DN_QKLOAD(qkB, step + 3);
            DN_OBEG(step + 2);
            DN_BAR();
        }
        DN_OFIN(qkA, DN_NSTEP - 2);
        DN_OBEG(DN_NSTEP - 1);
        DN_BAR();
        DN_OFIN(qkB, DN_NSTEP - 1);
#undef DN_QKLOAD
#undef DN_OFIN
#undef DN_OBEG
    } else {
        f32x4 S[8];
#pragma unroll
        for (int j = 0; j < 8; ++j) S[j] = (f32x4){0.f, 0.f, 0.f, 0.f};
        bf16x8_t sb[4];
#pragma unroll
        for (int s = 0; s < 4; ++s) { sb[s] = dn_bpack(S[2 * s], S[2 * s + 1]); *(LAS bf16x8_t*)(L + PUBS + w * 4096 + s * 1024 + lane * 16) = sb[s]; }
        DN_BAR();
        for (int step = 0; step < DN_NSTEP; ++step) {
#ifdef DN_SKIP_COMP
            if (step < DN_NSTEP - 69) { DN_BAR(); continue; }
#endif
            const LAS unsigned char* Lb = L + (step & 1) * BUF;
            f32x4 P[4];
#pragma unroll
            for (int mt = 0; mt < 4; ++mt) P[mt] = (f32x4){0.f, 0.f, 0.f, 0.f};
            {
                bf16x8_t ka[4][4];
#pragma unroll
                for (int s = 0; s < 4; ++s)
#pragma unroll
                    for (int mt = 0; mt < 4; ++mt) ka[s][mt] = AF16(KS, dn_perm(fr, mt), 4 * s + fq);
                __builtin_amdgcn_sched_barrier(0);
#pragma unroll
                for (int s = 0; s < 4; ++s)
#pragma unroll
                    for (int mt = 0; mt < 4; ++mt) P[mt] = MFMA16(ka[s][mt], sb[s], P[mt]);
            }
            bf16x8_t tia[2][4];
#pragma unroll
            for (int s = 0; s < 2; ++s)
#pragma unroll
                for (int mt = 0; mt < 4; ++mt) tia[s][mt] = AF8(TIS, dn_perm(fr, mt), 4 * s + fq);
            const LAS float* vc = (const LAS float*)(Lb + VCS);
            f32x4 R[4];
#pragma unroll
            for (int mt = 0; mt < 4; ++mt) {
                const int tk0 = 32 * (mt >> 1) + 8 * fq + 4 * (mt & 1);
                const f32x4 bt = *(const LAS f32x4*)(vc + tk0), bg = *(const LAS f32x4*)(vc + 128 + tk0);
#pragma unroll
                for (int r = 0; r < 4; ++r) {
                    const float v = bf2f(*(const LAS unsigned short*)(Lb + VS + (tk0 + r) * 64 + (16 * w + fr) * 2));
                    R[mt][r] = v * bt[r] - bg[r] * P[mt][r];
                }
            }
            const bf16x8_t rb0 = dn_bpack(R[0], R[1]), rb1 = dn_bpack(R[2], R[3]);
            f32x4 VN[4];
#pragma unroll
            for (int mt = 0; mt < 4; ++mt) {
                VN[mt] = (f32x4){0.f, 0.f, 0.f, 0.f};
                VN[mt] = MFMA16(tia[0][mt], rb0, VN[mt]);
                VN[mt] = MFMA16(tia[1][mt], rb1, VN[mt]);
            }
            bf16x8_t kta[2][8];
#pragma unroll
            for (int s = 0; s < 2; ++s)
#pragma unroll
                for (int jt = 0; jt < 8; ++jt) kta[s][jt] = AF8(KTS, dn_perm(fr, jt), 4 * s + fq);
            {
                const bf16x8_t vb0 = dn_bpack(VN[0], VN[1]), vb1 = dn_bpack(VN[2], VN[3]);
                LAS unsigned char* pv = L + PUBV + (step & 1) * 4096 + w * 2048 + lane * 16;
                *(LAS bf16x8_t*)pv = vb0; *(LAS bf16x8_t*)(pv + 1024) = vb1;
            }
#pragma unroll
            for (int mt = 0; mt < 4; ++mt) { const f32x4 ek = *(const LAS f32x4*)(vc + 192 + 32 * (mt >> 1) + 8 * fq + 4 * (mt & 1)); VN[mt] = VN[mt] * ek; }
            const bf16x8_t vs0 = dn_bpack(VN[0], VN[1]), vs1 = dn_bpack(VN[2], VN[3]);
            const float egl = vc[256];
#pragma unroll
            for (int jt = 0; jt < 8; ++jt) {
                S[jt] = S[jt] * egl;
                S[jt] = MFMA16(kta[0][jt], vs0, S[jt]);
                S[jt] = MFMA16(kta[1][jt], vs1, S[jt]);
            }
            if (DN_NSTEP > 68 && step % 68 == 67) {
#pragma unroll
                for (int j = 0; j < 8; ++j) S[j] = (f32x4){0.f, 0.f, 0.f, 0.f};
            }
#pragma unroll
            for (int s = 0; s < 4; ++s) { sb[s] = dn_bpack(S[2 * s], S[2 * s + 1]); *(LAS bf16x8_t*)(L + PUBS + ((step + 1) & 1) * 8192 + w * 4096 + s * 1024 + lane * 16) = sb[s]; }
            DN_BAR();
        }
    }
#undef AF16
#undef AF8
#undef DN_CC
#undef DN_CC1
}

DI void phase_attention(Frame& F, char* lds_generic) {
    bf16* QN = (bf16*)(F.ws + WS_QN); const bf16* KB = (const bf16*)(F.ws + WS_KB); const bf16* VB = (const bf16*)(F.ws + WS_VB);
    for (int it = F.vcu; it < 512; it += F.G) {
        const int b = it >> 7, kvh = (it >> 6) & 1, g = (it >> 4) & 3, qb = it & 15, h = kvh * 4 + g;
        bf16* Qb = QN + ((size_t)(b * TS + qb * 256) * 1024 + h * 128);
        const bf16* Kh = KB + ((size_t)b * LKV * 256 + kvh * 128); const bf16* Vh = VB + ((size_t)b * LKV * 256 + kvh * 128);
#ifdef ATTN_PROBE
#pragma nounroll
        for (int rep_ = 0; rep_ < 2; ++rep_) {
            bf16* Ob = rep_ == 0 ? (bf16*)(F.ws + WS_END) + ((size_t)(b * TS + qb * 256) * 1024 + h * 128) : Qb;
            attn::attn_dense_body<attn::bf16>(Qb, Kh, Vh, Ob, LKV, lds_generic);
            __syncthreads();
        }
#else
        attn::attn_dense_body<attn::bf16>(Qb, Kh, Vh, Qb, LKV, lds_generic);
        __syncthreads();
#endif
    }
}

DI void phase_mergeprep(Frame& F) {
    const bf16* ODN = (const bf16*)(F.ws + WS_ODN); bf16* Z = (bf16*)(F.ws + WS_Z); const int lane = F.lane;
    float nw[16];
#pragma unroll
    for (int k = 0; k < 4; ++k) { const f32x4 v = *(const f32x4*)(F.in[14] + (lane & 7) * 16 + 4 * k); nw[4 * k] = v[0]; nw[4 * k + 1] = v[1]; nw[4 * k + 2] = v[2]; nw[4 * k + 3] = v[3]; }
    for (int t = F.gw; t < NT; t += F.NGW) {
        const size_t off = (size_t)t * 1024 + 16 * lane;
        u32x4 a[2], c[2], z[2];
#pragma unroll
        for (int k = 0; k < 2; ++k) { a[k] = __builtin_nontemporal_load((const u32x4*)(ODN + off + 8 * k)); c[k] = __builtin_nontemporal_load((const u32x4*)(ODN + (size_t)NT * 1024 + off + 8 * k)); z[k] = __builtin_nontemporal_load((const u32x4*)(Z + off + 8 * k)); }
        float o[16]; float ss = 0.f;
#pragma unroll
        for (int k = 0; k < 2; ++k)
#pragma unroll
            for (int i = 0; i < 4; ++i) { o[8 * k + 2 * i] = bflo(a[k][i]) + bflo(c[k][i]); o[8 * k + 2 * i + 1] = bfhi(a[k][i]) + bfhi(c[k][i]); }
#pragma unroll
        for (int i = 0; i < 16; ++i) ss += o[i] * o[i];
        ss += __shfl_xor(ss, 1); ss += __shfl_xor(ss, 2); ss += __shfl_xor(ss, 4);
        const float rstd = rsqrtf(ss * (1.f / 128.f) + EPS);
        if (MERGE_F8_B) {
            float y[16];
#pragma unroll
            for (int k = 0; k < 2; ++k)
#pragma unroll
                for (int i = 0; i < 4; ++i) { y[8 * k + 2 * i] = o[8 * k + 2 * i] * rstd * nw[8 * k + 2 * i] * silu(bflo(z[k][i])); y[8 * k + 2 * i + 1] = o[8 * k + 2 * i + 1] * rstd * nw[8 * k + 2 * i + 1] * silu(bfhi(z[k][i])); }
            u32x4 w;
#pragma unroll
            for (int q = 0; q < 4; ++q) w[q] = pk4_fp8(fp8c(y[4 * q] * ODNN_SCALE), fp8c(y[4 * q + 1] * ODNN_SCALE), fp8c(y[4 * q + 2] * ODNN_SCALE), fp8c(y[4 * q + 3] * ODNN_SCALE));
            *(u32x4*)(F.ws + WS_ODNN8 + off) = w;
        } else {
#pragma unroll
        for (int k = 0; k < 2; ++k) {
            u32x4 w;
#pragma unroll
            for (int i = 0; i < 4; ++i) w[i] = pk2(o[8 * k + 2 * i] * rstd * nw[8 * k + 2 * i] * silu(bflo(z[k][i])), o[8 * k + 2 * i + 1] * rstd * nw[8 * k + 2 * i + 1] * silu(bfhi(z[k][i])));
            *(u32x4*)(Z + off + 8 * k) = w;
        }
        }
        if (MERGE_F8_A) {
            const bf16* OA = (const bf16*)(F.ws + WS_QN);
            const u32x4 a0 = __builtin_nontemporal_load((const u32x4*)(OA + off)), a1 = __builtin_nontemporal_load((const u32x4*)(OA + off + 8));
            u32x4 w;
            w[0] = pk4_fp8(fp8c(bflo(a0.x) * OATT_SCALE), fp8c(bfhi(a0.x) * OATT_SCALE), fp8c(bflo(a0.y) * OATT_SCALE), fp8c(bfhi(a0.y) * OATT_SCALE));
            w[1] = pk4_fp8(fp8c(bflo(a0.z) * OATT_SCALE), fp8c(bfhi(a0.z) * OATT_SCALE), fp8c(bflo(a0.w) * OATT_SCALE), fp8c(bfhi(a0.w) * OATT_SCALE));
            w[2] = pk4_fp8(fp8c(bflo(a1.x) * OATT_SCALE), fp8c(bfhi(a1.x) * OATT_SCALE), fp8c(bflo(a1.y) * OATT_SCALE), fp8c(bfhi(a1.y) * OATT_SCALE));
            w[3] = pk4_fp8(fp8c(bflo(a1.z) * OATT_SCALE), fp8c(bfhi(a1.z) * OATT_SCALE), fp8c(bflo(a1.w) * OATT_SCALE), fp8c(bfhi(a1.w) * OATT_SCALE));
            *(u32x4*)(F.ws + WS_OATT8 + off) = w;
        }
    }
}

DI void tk_insert(unsigned (&a)[16], unsigned x) {
#pragma unroll
    for (int i = 0; i < 16; ++i) { const unsigned hi = a[i] > x ? a[i] : x; x = a[i] > x ? x : a[i]; a[i] = hi; }
}
template <int N> DI void tk_sort_desc(unsigned (&a)[N]) {
#pragma unroll
    for (int k = 2; k <= N; k <<= 1)
#pragma unroll
        for (int j = k >> 1; j > 0; j >>= 1)
#pragma unroll
            for (int i = 0; i < N; ++i) {
                const int l = i ^ j;
                if (l > i) {
                    const unsigned lo = a[i] < a[l] ? a[i] : a[l], hi = a[i] < a[l] ? a[l] : a[i];
                    if ((i & k) == 0) { a[i] = hi; a[l] = lo; } else { a[i] = lo; a[l] = hi; }
                }
            }
}
DI void tk_sort_bitonic(unsigned (&c)[16]) {
#pragma unroll
    for (int s = 8; s >= 1; s >>= 1)
#pragma unroll
        for (int i = 0; i < 16; ++i) if ((i & s) == 0) { const unsigned lo = c[i] < c[i + s] ? c[i] : c[i + s], hi = c[i] < c[i + s] ? c[i + s] : c[i]; c[i] = hi; c[i + s] = lo; }
}
template <bool SORT> DI void tk_merge(unsigned (&a)[16], int m) {
    unsigned b[16];
#pragma unroll
    for (int i = 0; i < 16; ++i) b[i] = (unsigned)__shfl_xor((int)a[15 - i], m);
#pragma unroll
    for (int i = 0; i < 16; ++i) a[i] = a[i] > b[i] ? a[i] : b[i];
    if (SORT) tk_sort_bitonic(a);
}
DI float tk_unkey(unsigned k) { const unsigned u = (k & 0x80000000u) ? (k & 0x7fffffffu) : ~k; return __uint_as_float(u); }

DI void phase_peer_topk(Frame& F) {
    LAS unsigned char* L = F.lds;
    constexpr int KS = 0, QS = 69632, SC = 69632, TOP = 137216, FIN = 139264, PT = 140288;
    const bf16* PQ = (const bf16*)(F.ws + WS_PQ); const bf16* SUBK = (const bf16*)(F.ws + WS_SUBK);
    int* EXPI = (int*)(F.ws + WS_EXPI); float* EXPG = (float*)(F.ws + WS_EXPG);
    const int tid = F.tid, lane = F.lane, w = F.wave, fr = lane & 15, fq = lane >> 4;
    LAS float* sc = (LAS float*)(L + SC); LAS unsigned char* top = L + TOP; LAS unsigned char* finb = L + FIN; LAS int* pt = (LAS int*)(L + PT);
    if (tid < 56) {
        int n = tid, pi = -1;
#pragma unroll
        for (int i = 0; i < 16; ++i) { const int cnt = 16 / (i + 1); if (pi < 0) { if (n < cnt) pi = i * 16 + n; else n -= cnt; } }
        pt[tid] = tid < 50 ? pi : -1;
    }
    int hcur = -1;
    u32x4 qpre[4];
    if (F.vcu < (NT / 64) * 8) {
        const int h0 = F.vcu & 7, tq = (F.vcu >> 3) * 64;
#pragma unroll
        for (int k = 0; k < 4; ++k) { const int c = tid + 512 * k; qpre[k] = __builtin_nontemporal_load((const u32x4*)(PQ + (size_t)(tq + (c >> 5)) * 2048 + h0 * 256 + (c & 31) * 8)); }
    }
    for (int it = F.vcu; it < (NT / 64) * 8; it += F.G) {
        const int h = it & 7, tile = it >> 3, t0 = tile * 64;
        RAW_BAR();
        if (h != hcur) {
#pragma unroll
            for (int k = 0; k < 8; ++k) { const int c = tid + 512 * k, row = c >> 4, c16 = c & 15;
                *(LAS u32x4*)(L + KS + row * 272 + c16 * 16) = *(const u32x4*)(SUBK + (size_t)h * 32768 + row * 128 + c16 * 8); }
            hcur = h;
        }
#pragma unroll
        for (int k = 0; k < 4; ++k) { const int c = tid + 512 * k, row = c >> 5, c16 = c & 31; *(LAS u32x4*)(L + QS + row * 528 + c16 * 16) = qpre[k]; }
        if (it + F.G < (NT / 64) * 8) {
            const int itn = it + F.G, hn = itn & 7, tn = (itn >> 3) * 64;
#pragma unroll
            for (int k = 0; k < 4; ++k) { const int c = tid + 512 * k; qpre[k] = __builtin_nontemporal_load((const u32x4*)(PQ + (size_t)(tn + (c >> 5)) * 2048 + hn * 256 + (c & 31) * 8)); }
        }
        RAW_BAR();
        const int p = w >> 2, n0 = (w & 3) * 32;
        f32x4 acc[4][2];
#pragma unroll
        for (int mt = 0; mt < 4; ++mt) { acc[mt][0] = (f32x4){0.f, 0.f, 0.f, 0.f}; acc[mt][1] = (f32x4){0.f, 0.f, 0.f, 0.f}; }
#pragma unroll
        for (int s = 0; s < 4; ++s) {
            const bf16x8_t b0 = *(const LAS bf16x8_t*)(L + KS + (p * 128 + n0 + fr) * 272 + (32 * s + 8 * fq) * 2);
            const bf16x8_t b1 = *(const LAS bf16x8_t*)(L + KS + (p * 128 + n0 + 16 + fr) * 272 + (32 * s + 8 * fq) * 2);
#pragma unroll
            for (int mt = 0; mt < 4; ++mt) {
                const bf16x8_t a = *(const LAS bf16x8_t*)(L + QS + (16 * mt + fr) * 528 + (p * 128 + 32 * s + 8 * fq) * 2);
                acc[mt][0] = MFMA16(a, b0, acc[mt][0]); acc[mt][1] = MFMA16(a, b1, acc[mt][1]);
            }
        }
        RAW_BAR();
#pragma unroll
        for (int mt = 0; mt < 4; ++mt)
#pragma unroll
            for (int nt = 0; nt < 2; ++nt)
#pragma unroll
                for (int r = 0; r < 4; ++r) sc[((16 * mt + 4 * fq + r) * 2 + p) * 132 + (w & 3) * 33 + 16 * nt + fr] = acc[mt][nt][r];
        RAW_BAR();
        {
            const int list = tid >> 2, q = tid & 3;
            unsigned a32[32];
            const LAS float* sp = sc + list * 132 + q * 33;
#pragma unroll
            for (int i = 0; i < 32; ++i) a32[i] = (okey(sp[i]) & ~0x7Fu) | (unsigned)(q * 32 + i);
            tk_sort_desc<32>(a32);
            unsigned a[16];
#pragma unroll
            for (int i = 0; i < 16; ++i) a[i] = a32[i];
            tk_merge<true>(a, 1); tk_merge<true>(a, 2);
            if (q == 0) {
                u32x4 v;
#pragma unroll
                for (int k = 0; k < 4; ++k) v[k] = (a[4 * k] & 127u) | ((a[4 * k + 1] & 127u) << 8) | ((a[4 * k + 2] & 127u) << 16) | ((a[4 * k + 3] & 127u) << 24);
                *(LAS u32x4*)(top + list * 16) = v;
            }
        }
        RAW_BAR();
        {
            const int tok = tid >> 3, r8 = tid & 7;
            unsigned c8[8]; c8[7] = 0u;
#pragma unroll
            for (int m = 0; m < 7; ++m) {
                const int pr = pt[r8 + 8 * m];
                unsigned ck = 0u;
                if (pr >= 0) {
                    const int ia = top[(tok * 2) * 16 + (pr >> 4)], ib = top[(tok * 2 + 1) * 16 + (pr & 15)];
                    const float cs = sc[(tok * 2) * 132 + (ia >> 5) * 33 + (ia & 31)] + sc[(tok * 2 + 1) * 132 + (ib >> 5) * 33 + (ib & 31)];
                    ck = (okey(cs) & ~0xFFu) | (unsigned)pr;
                }
                c8[m] = ck;
            }
            tk_sort_desc<8>(c8);
            unsigned a[16];
#pragma unroll
            for (int i = 0; i < 16; ++i) a[i] = i < 8 ? c8[i] : 0u;
            tk_merge<true>(a, 1); tk_merge<true>(a, 2); tk_merge<true>(a, 4);
            LAS unsigned char* fin = finb + tok * 16;
            if (r8 == 0) {
                u32x4 v;
#pragma unroll
                for (int k = 0; k < 4; ++k) v[k] = (a[4 * k] & 255u) | ((a[4 * k + 1] & 255u) << 8) | ((a[4 * k + 2] & 255u) << 16) | ((a[4 * k + 3] & 255u) << 24);
                *(LAS u32x4*)fin = v;
            }
            asm volatile("s_waitcnt lgkmcnt(0)" ::: "memory");
            float bs[2]; int ex[2];
#pragma unroll
            for (int e = 0; e < 2; ++e) {
                const unsigned pr = fin[2 * r8 + e];
                const int ia = top[(tok * 2) * 16 + (pr >> 4)], ib = top[(tok * 2 + 1) * 16 + (pr & 15u)];
                bs[e] = sc[(tok * 2) * 132 + (ia >> 5) * 33 + (ia & 31)] + sc[(tok * 2 + 1) * 132 + (ib >> 5) * 33 + (ib & 31)];
                ex[e] = ia * 128 + ib;
            }
            float mx = fmaxf(bs[0], bs[1]);
            mx = fmaxf(mx, __shfl_xor(mx, 1)); mx = fmaxf(mx, __shfl_xor(mx, 2)); mx = fmaxf(mx, __shfl_xor(mx, 4));
            const float e0 = __expf(bs[0] - mx), e1 = __expf(bs[1] - mx);
            float sm = e0 + e1; sm += __shfl_xor(sm, 1); sm += __shfl_xor(sm, 2); sm += __shfl_xor(sm, 4);
            const float rs = 1.f / sm;
            const size_t o = (size_t)(t0 + tok) * 128 + h * 16 + 2 * r8;
            *(int2*)(EXPI + o) = make_int2(ex[0], ex[1]);
            *(float2*)(EXPG + o) = make_float2(e0 * rs, e1 * rs);
        }
    }
}

DI float ub0(unsigned w) { float r; asm("v_cvt_f32_ubyte0 %0, %1" : "=v"(r) : "v"(w)); return r; }
DI float ub1(unsigned w) { float r; asm("v_cvt_f32_ubyte1 %0, %1" : "=v"(r) : "v"(w)); return r; }
DI float ub2(unsigned w) { float r; asm("v_cvt_f32_ubyte2 %0, %1" : "=v"(r) : "v"(w)); return r; }
DI float ub3(unsigned w) { float r; asm("v_cvt_f32_ubyte3 %0, %1" : "=v"(r) : "v"(w)); return r; }
DI float wave_maxf(float v) {
#pragma unroll
    for (int o = 1; o < 64; o <<= 1) v = fmaxf(v, __shfl_xor(v, o));
    return v;
}
template <int BIAS> DI void quant_rows(const float* src, unsigned char* dst, float* scale, int gw, int NGW, int lane) {
    for (int row = gw; row < NEXP; row += NGW) {
        f32x4 v[8]; float am = 0.f;
#pragma unroll
        for (int j = 0; j < 8; ++j) { v[j] = __builtin_nontemporal_load((const f32x4*)(src + (size_t)row * DM) + lane + 64 * j); am = fmaxf(am, fmaxf(fmaxf(fabsf(v[j][0]), fabsf(v[j][1])), fmaxf(fabsf(v[j][2]), fabsf(v[j][3])))); }
        am = wave_maxf(am);
        const float inv = am > 0.f ? 127.f / am : 0.f;
#pragma unroll
        for (int j = 0; j < 8; ++j) {
            unsigned w = 0;
#pragma unroll
            for (int i = 0; i < 4; ++i) { const int q = (int)rintf(v[j][i] * inv) + BIAS; w |= ((unsigned)q & 0xffu) << (8 * i); }
            *((unsigned*)(dst + (size_t)row * DM) + lane + 64 * j) = w;
        }
        if (lane == 0) scale[row] = am * (1.f / 127.f);
    }
}


constexpr int V4_ROW = 1152;
DI void quant_rows_i4(const float* __restrict__ src, unsigned char* __restrict__ dst, int gw, int NGW, int lane) {
#pragma unroll 2
    for (int row = gw; row < NEXP; row += NGW) {
        f32x4 vv[8];
#pragma unroll
        for (int j = 0; j < 8; ++j) vv[j] = __builtin_nontemporal_load((const f32x4*)(src + (size_t)row * DM) + lane + 64 * j);
#pragma unroll
        for (int j = 0; j < 8; ++j) {
            const f32x4 v = vv[j];
            float am = fmaxf(fmaxf(fabsf(v[0]), fabsf(v[1])), fmaxf(fabsf(v[2]), fabsf(v[3])));
            am = fmaxf(am, __shfl_xor(am, 1)); am = fmaxf(am, __shfl_xor(am, 2)); am = fmaxf(am, __shfl_xor(am, 4));
            const unsigned sb = f2bf(am * (1.f / 7.f)); const float s = __uint_as_float(sb << 16), inv = s > 0.f ? __builtin_amdgcn_rcpf(s) : 0.f;
            unsigned w = 0;
#pragma unroll
            for (int i = 0; i < 4; ++i) { const int q = (int)fminf(fmaxf(rintf(v[i] * inv), -7.f), 7.f) + 8; w |= (unsigned)q << (4 * i); }
            const int grp = j * 8 + (lane >> 3);
            *(unsigned short*)(dst + (size_t)row * V4_ROW + grp * 16 + (lane & 7) * 2) = (unsigned short)w;
            if ((lane & 7) == 0) *(unsigned short*)(dst + (size_t)row * V4_ROW + 1024 + grp * 2) = (unsigned short)sb;
        }
    }
}

DI void quant_u_both(const float* __restrict__ src, unsigned char* __restrict__ d8, float* __restrict__ scale, unsigned char* __restrict__ d4, int gw, int NGW, int lane) {
#pragma unroll 2
    for (int row = gw; row < NEXP; row += NGW) {
        f32x4 v[8]; float am = 0.f;
#pragma unroll
        for (int j = 0; j < 8; ++j) { v[j] = __builtin_nontemporal_load((const f32x4*)(src + (size_t)row * DM) + lane + 64 * j); am = fmaxf(am, fmaxf(fmaxf(fabsf(v[j][0]), fabsf(v[j][1])), fmaxf(fabsf(v[j][2]), fabsf(v[j][3])))); }
        const float rowmax = wave_maxf(am), inv8 = rowmax > 0.f ? 127.f / rowmax : 0.f;
#pragma unroll
        for (int j = 0; j < 8; ++j) {
            unsigned w8 = 0;
#pragma unroll
            for (int i = 0; i < 4; ++i) { const int q = (int)rintf(v[j][i] * inv8); w8 |= ((unsigned)q & 0xffu) << (8 * i); }
            *((unsigned*)(d8 + (size_t)row * DM) + lane + 64 * j) = w8;
            float gm = fmaxf(fmaxf(fabsf(v[j][0]), fabsf(v[j][1])), fmaxf(fabsf(v[j][2]), fabsf(v[j][3])));
            gm = fmaxf(gm, __shfl_xor(gm, 1)); gm = fmaxf(gm, __shfl_xor(gm, 2)); gm = fmaxf(gm, __shfl_xor(gm, 4));
            const unsigned sb = f2bf(gm * (1.f / 7.f)); const float s = __uint_as_float(sb << 16), inv = s > 0.f ? __builtin_amdgcn_rcpf(s) : 0.f;
            unsigned w = 0;
#pragma unroll
            for (int i = 0; i < 4; ++i) { const int q = (int)fminf(fmaxf(rintf(v[j][i] * inv), -7.f), 7.f) + 8; w |= (unsigned)q << (4 * i); }
            const int grp = j * 8 + (lane >> 3);
            *(unsigned short*)(d4 + (size_t)row * V4_ROW + grp * 16 + (lane & 7) * 2) = (unsigned short)w;
            if ((lane & 7) == 0) *(unsigned short*)(d4 + (size_t)row * V4_ROW + 1024 + grp * 2) = (unsigned short)sb;
        }
        if (lane == 0) scale[row] = rowmax * (1.f / 127.f);
    }
}

DI void phase_peer_gather(Frame& F, int emask = 0x3fff, int vmask = 0x3fff) {
    const bf16* H2 = (const bf16*)(F.ws + WS_H2);
    const unsigned char* U8 = F.ws + WS_U8; const unsigned char* U4 = F.ws + WS_U4; const unsigned char* V4 = F.ws + WS_V8; const float* SU = (const float*)(F.ws + WS_SU);
    const int* EXPI = (const int*)(F.ws + WS_EXPI); const float* EXPG = (const float*)(F.ws + WS_EXPG);
    const bf16* X1 = (const bf16*)(F.ws + WS_X1); const float* MOD = (const float*)(F.ws + WS_MOD); const int lane = F.lane;
    LAS float* la = (LAS float*)(F.lds + F.wave * 1024);
    LAS int* li = (LAS int*)(F.lds + F.wave * 1024 + 512);
    const int eloc = ((lane >> 5) & 1) * 4 + ((lane >> 4) & 1) * 2 + ((lane >> 3) & 1);
#ifdef GATHER_SUBSET
    if ((blockIdx.x >> 3) % GATHER_SUBSET != 0) return;
    const int gw_ = ((blockIdx.x >> 3) / GATHER_SUBSET * 8 + (blockIdx.x & 7)) * NWAVES + F.wave, ngw_ = F.NGW / GATHER_SUBSET;
#else
    const int gw_ = F.gw, ngw_ = F.NGW;
#endif
    for (int t = gw_; t < NT; t += ngw_) {
        float xf[2][16]; float am = 0.f;
#pragma unroll
        for (int j = 0; j < 2; ++j) {
            const u32x4 w0 = *((const u32x4*)(H2 + (size_t)t * DM) + 2 * (lane + 64 * j)), w1 = *((const u32x4*)(H2 + (size_t)t * DM) + 2 * (lane + 64 * j) + 1);
            xf[j][0] = bflo(w0.x); xf[j][1] = bfhi(w0.x); xf[j][2] = bflo(w0.y); xf[j][3] = bfhi(w0.y); xf[j][4] = bflo(w0.z); xf[j][5] = bfhi(w0.z); xf[j][6] = bflo(w0.w); xf[j][7] = bfhi(w0.w);
            xf[j][8] = bflo(w1.x); xf[j][9] = bfhi(w1.x); xf[j][10] = bflo(w1.y); xf[j][11] = bfhi(w1.y); xf[j][12] = bflo(w1.z); xf[j][13] = bfhi(w1.z); xf[j][14] = bflo(w1.w); xf[j][15] = bfhi(w1.w);
#pragma unroll
            for (int i = 0; i < 16; ++i) am = fmaxf(am, fabsf(xf[j][i]));
        }
        am = wave_maxf(am);
        const float inv = am > 0.f ? 127.f / am : 0.f, sx = am * (1.f / 127.f);
        int xq[2][4];
#pragma unroll
        for (int j = 0; j < 2; ++j)
#pragma unroll
            for (int k = 0; k < 4; ++k) {
                unsigned w = 0;
#pragma unroll
                for (int i = 0; i < 4; ++i) w |= ((unsigned)(int)rintf(xf[j][4 * k + i] * inv) & 0xffu) << (8 * i);
                xq[j][k] = (int)w;
            }
        int xe[4], xo[4], xsum4 = 0;
#pragma unroll
        for (int d = 0; d < 4; ++d) {
            const u32x4 w = *((const u32x4*)(H2 + (size_t)t * DM + 32 * lane) + d);
            int q[8];
#pragma unroll
            for (int i = 0; i < 4; ++i) { q[2 * i] = (int)rintf(bflo(w[i]) * inv); q[2 * i + 1] = (int)rintf(bfhi(w[i]) * inv); }
            xe[d] = (int)(((unsigned)q[0] & 0xffu) | (((unsigned)q[2] & 0xffu) << 8) | (((unsigned)q[4] & 0xffu) << 16) | (((unsigned)q[6] & 0xffu) << 24));
            xo[d] = (int)(((unsigned)q[1] & 0xffu) | (((unsigned)q[3] & 0xffu) << 8) | (((unsigned)q[5] & 0xffu) << 16) | (((unsigned)q[7] & 0xffu) << 24));
#pragma unroll
            for (int i = 0; i < 8; ++i) xsum4 += q[i];
        }
        float asum = 0.f;
        const int ei0 = EXPI[(size_t)t * 128 + lane] & emask, ei1 = EXPI[(size_t)t * 128 + 64 + lane] & emask;
        const float eg0 = EXPG[(size_t)t * 128 + lane], eg1 = EXPG[(size_t)t * 128 + 64 + lane];
        u32x4 wa0[8], wa1[8], wb[8]; unsigned short sbh[8];
#define ULOADA(hd_) do { const int eis_ = (hd_) < 4 ? ei0 : ei1, base_ = ((hd_) & 3) * 16; \
            _Pragma("unroll") for (int e = 0; e < 8; ++e) { const int idx_ = __builtin_amdgcn_readlane(eis_, base_ + e); const u32x4* ur_ = (const u32x4*)(U8 + (size_t)idx_ * DM); wa0[e] = ur_[lane]; wa1[e] = ur_[lane + 64]; } } while (0)
#define ULOADB(hd_) do { const int eis_ = (hd_) < 4 ? ei0 : ei1, base_ = ((hd_) & 3) * 16 + 8; \
            _Pragma("unroll") for (int e = 0; e < 8; ++e) { const int idx_ = __builtin_amdgcn_readlane(eis_, base_ + e); const unsigned char* u4_ = U4 + (size_t)idx_ * V4_ROW; wb[e] = *(const u32x4*)(u4_ + 16 * lane); sbh[e] = *(const unsigned short*)(u4_ + 1024 + 2 * lane); } } while (0)
#define ULOADA_NEXT(hd_) do { const int h_ = (hd_); const int eis_ = (h_ & 4) ? ei1 : ei0, base_ = (h_ & 3) * 16, msk_ = h_ < 8 ? -1 : 0; \
            _Pragma("unroll") for (int e = 0; e < 8; ++e) { const int idx_ = __builtin_amdgcn_readlane(eis_, base_ + e) & msk_; const u32x4* ur_ = (const u32x4*)(U8 + (size_t)idx_ * DM); wa0[e] = ur_[lane]; wa1[e] = ur_[lane + 64]; } } while (0)
        ULOADA(0);
#pragma unroll 1
        for (int hd = 0; hd < 8; ++hd) {
            const int eisel = hd < 4 ? ei0 : ei1; const float egsel = hd < 4 ? eg0 : eg1;
            const int base = (hd & 3) * 16;
            const int myidxA = __shfl(eisel, base + eloc), myidxB = __shfl(eisel, base + 8 + eloc);
            const float mygA = __shfl(egsel, base + eloc), mygB = __shfl(egsel, base + 8 + eloc);
            const float mysu = SU[myidxA];
            ULOADB(hd);
            float accA[8], accB[8];
#pragma unroll
            for (int e = 0; e < 8; ++e) {
                int a = __builtin_amdgcn_sdot4((int)wa0[e].x, xq[0][0], 0, false); a = __builtin_amdgcn_sdot4((int)wa0[e].y, xq[0][1], a, false);
                a = __builtin_amdgcn_sdot4((int)wa0[e].z, xq[0][2], a, false); a = __builtin_amdgcn_sdot4((int)wa0[e].w, xq[0][3], a, false);
                a = __builtin_amdgcn_sdot4((int)wa1[e].x, xq[1][0], a, false); a = __builtin_amdgcn_sdot4((int)wa1[e].y, xq[1][1], a, false);
                a = __builtin_amdgcn_sdot4((int)wa1[e].z, xq[1][2], a, false); a = __builtin_amdgcn_sdot4((int)wa1[e].w, xq[1][3], a, false);
                accA[e] = (float)a;
            }
            __builtin_amdgcn_sched_barrier(0);
            ULOADA_NEXT(hd + 1);
#pragma unroll
            for (int e = 0; e < 8; ++e) {
                int b = 0;
#pragma unroll
                for (int d = 0; d < 4; ++d) { b = __builtin_amdgcn_sdot4((int)(wb[e][d] & 0x0F0F0F0Fu), xe[d], b, false); b = __builtin_amdgcn_sdot4((int)((wb[e][d] >> 4) & 0x0F0F0F0Fu), xo[d], b, false); }
                accB[e] = (float)(b - 8 * xsum4) * bf2f(sbh[e]);
            }
            float rA, rB;
            {
                float r4[4], r2[2], s4[4], s2[2];
#pragma unroll
                for (int i = 0; i < 4; ++i) {
                    const float sndA = (lane & 32) ? accA[i] : accA[i + 4], kpA = (lane & 32) ? accA[i + 4] : accA[i]; r4[i] = kpA + __shfl_xor(sndA, 32);
                    const float sndB = (lane & 32) ? accB[i] : accB[i + 4], kpB = (lane & 32) ? accB[i + 4] : accB[i]; s4[i] = kpB + __shfl_xor(sndB, 32); }
#pragma unroll
                for (int i = 0; i < 2; ++i) {
                    const float sndA = (lane & 16) ? r4[i] : r4[i + 2], kpA = (lane & 16) ? r4[i + 2] : r4[i]; r2[i] = kpA + __shfl_xor(sndA, 16);
                    const float sndB = (lane & 16) ? s4[i] : s4[i + 2], kpB = (lane & 16) ? s4[i + 2] : s4[i]; s2[i] = kpB + __shfl_xor(sndB, 16); }
                { const float sndA = (lane & 8) ? r2[0] : r2[1], kpA = (lane & 8) ? r2[1] : r2[0]; rA = kpA + __shfl_xor(sndA, 8);
                  const float sndB = (lane & 8) ? s2[0] : s2[1], kpB = (lane & 8) ? s2[1] : s2[0]; rB = kpB + __shfl_xor(sndB, 8); }
                rA += __shfl_xor(rA, 4); rA += __shfl_xor(rA, 2); rA += __shfl_xor(rA, 1);
                rB += __shfl_xor(rB, 4); rB += __shfl_xor(rB, 2); rB += __shfl_xor(rB, 1);
            }
            const float aA = gelu_erf(rA * mysu * sx) * mygA, aB = gelu_erf(rB * sx) * mygB;
            if ((lane & 7) == 0) { la[hd * 16 + eloc] = aA; li[hd * 16 + eloc] = myidxA & vmask; la[hd * 16 + 8 + eloc] = aB; li[hd * 16 + 8 + eloc] = myidxB & vmask; asum += aA + aB; }
        }
#undef ULOADA
#undef ULOADA_NEXT
#undef ULOADB
        asum = wave_sum(asum);
        asm volatile("s_waitcnt lgkmcnt(0)" ::: "memory");
        f32x2 o2[16]; float csum = 0.f;
#pragma unroll
        for (int i = 0; i < 16; ++i) o2[i] = (f32x2){0.f, 0.f};
#pragma unroll 16
        for (int e = 0; e < 128; ++e) {
            const int idx = __builtin_amdgcn_readfirstlane(li[e]); const float a = __uint_as_float((unsigned)__builtin_amdgcn_readfirstlane((int)__float_as_uint(la[e])));
            const unsigned char* vr = V4 + (size_t)idx * V4_ROW;
            const u32x4 w = *(const u32x4*)(vr + 16 * lane);
            const float as = a * bf2f(*(const unsigned short*)(vr + 1024 + 2 * lane));
            csum += as;
            const f32x2 as2 = {as, as};
#pragma unroll
            for (int d = 0; d < 4; ++d) {
                const unsigned lo = w[d] & 0x0F0F0F0Fu, hi = (w[d] >> 4) & 0x0F0F0F0Fu;
                o2[4 * d + 0] = __builtin_elementwise_fma(as2, (f32x2){ub0(lo), ub0(hi)}, o2[4 * d + 0]); o2[4 * d + 1] = __builtin_elementwise_fma(as2, (f32x2){ub1(lo), ub1(hi)}, o2[4 * d + 1]);
                o2[4 * d + 2] = __builtin_elementwise_fma(as2, (f32x2){ub2(lo), ub2(hi)}, o2[4 * d + 2]); o2[4 * d + 3] = __builtin_elementwise_fma(as2, (f32x2){ub3(lo), ub3(hi)}, o2[4 * d + 3]);
            }
        }
        float o[32];
#pragma unroll
        for (int i = 0; i < 16; ++i) { o[2 * i] = o2[i][0]; o[2 * i + 1] = o2[i][1]; }
        LAS float* tp = (LAS float*)(F.lds + 8192 + F.wave * 9216);
        const float corr = 8.f * csum;
#pragma unroll
        for (int k = 0; k < 8; ++k) { f32x4 v; v[0] = o[4 * k] - corr; v[1] = o[4 * k + 1] - corr; v[2] = o[4 * k + 2] - corr; v[3] = o[4 * k + 3] - corr; *(LAS f32x4*)(tp + lane * 36 + 4 * k) = v; }
        asm volatile("s_waitcnt lgkmcnt(0)" ::: "memory");
        const float* g2 = MOD + (size_t)(t >> 12) * 12288 + 5 * 2048;
        f32x4 x2[8]; float ss = 0.f;
#pragma unroll
        for (int j = 0; j < 8; ++j) {
            const int ch = lane + 64 * j;
            const f32x4 pv = *(const LAS f32x4*)(tp + (ch >> 3) * 36 + 4 * (ch & 7));
            const u32x2 xw = __builtin_nontemporal_load((const u32x2*)(X1 + (size_t)t * DM) + ch); const f32x4 xa = {bflo(xw.x), bfhi(xw.x), bflo(xw.y), bfhi(xw.y)}, ga = *((const f32x4*)g2 + ch);
            x2[j] = xa + ga * pv;
            ss += (x2[j][0] * x2[j][0] + x2[j][1] * x2[j][1]) + (x2[j][2] * x2[j][2] + x2[j][3] * x2[j][3]);
        }
        const float rstd = rsqrtf(wave_sum(ss) * (1.f / DM) + EPS);
        const float* fw = F.in[22];
#pragma unroll
        for (int j = 0; j < 8; ++j) { const int ch = lane + 64 * j; const f32x4 wa = *((const f32x4*)fw + ch); __builtin_nontemporal_store(x2[j] * rstd * wa, (f32x4*)(F.out + (size_t)t * DM) + ch); }
        asm volatile("s_waitcnt lgkmcnt(0)" ::: "memory");
    }
}

DI void phase_h2(Frame& F) {
    const float* MOD = (const float*)(F.ws + WS_MOD); bf16* H2 = (bf16*)(F.ws + WS_H2); const bf16* X1 = (const bf16*)(F.ws + WS_X1);
    ModPar P;
    constexpr int RPW = NT / (256 * NWAVES);
    if (F.NGW == 256 * NWAVES) {
        const int m0 = F.gw * RPW, r = m0 >> 12;
        modpar_load(P, F.in[7], MOD + (size_t)r * 12288 + 4 * 2048, MOD + (size_t)r * 12288 + 3 * 2048, F.lane);
        modnorm_rows_bf(X1 + (size_t)m0 * DM, H2 + (size_t)m0 * DM, RPW, P, F.lane);
    } else {
        for (int m = F.gw; m < NT; m += F.NGW) { const int r = m >> 12; modpar_load(P, F.in[7], MOD + (size_t)r * 12288 + 4 * 2048, MOD + (size_t)r * 12288 + 3 * 2048, F.lane); modnorm_rows_bf(X1 + (size_t)m * DM, H2 + (size_t)m * DM, 1, P, F.lane); }
    }
}


DI void phase_quant(Frame& F) {
#ifndef REP_QUANT
#define REP_QUANT 1
#endif
#pragma nounroll
    for (int rq = 0; rq < REP_QUANT; ++rq) {
    quant_u_both(F.in[20], F.ws + WS_U8, (float*)(F.ws + WS_SU), F.ws + WS_U4, F.gw, F.NGW, F.lane);
    quant_rows_i4(F.in[21], F.ws + WS_V8, F.gw, F.NGW, F.lane);
    }
}

struct Args { const float* in[23]; float* out; unsigned char* ws; int ph_lo, ph_hi; };
static_assert(sizeof(Args) == 23 * 8 + 8 + 8 + 8, "Args has no padding");

__global__ void __launch_bounds__(NWAVES * 64, 2) mk_fwd(Args args) {
    extern __shared__ __attribute__((aligned(16))) unsigned char lds[];
    Frame F;
    F.lds = (LAS unsigned char*)lds; F.ws = args.ws; F.out = args.out;
#pragma unroll
    for (int i = 0; i < 23; ++i) F.in[i] = args.in[i];
    F.tid = threadIdx.x; F.lane = F.tid & 63; F.wave = __builtin_amdgcn_readfirstlane(F.tid >> 6);
    F.G = gridDim.x; { const int bx = blockIdx.x; F.vcu = (F.G % 8 == 0) ? (bx % 8) * (F.G / 8) + bx / 8 : bx; }
    F.gw = F.vcu * NWAVES + F.wave; F.NGW = F.G * NWAVES;
    const int lo = args.ph_lo, hi = args.ph_hi;
#ifndef REP_PHASE
#define REP_PHASE (-1)
#endif
#define IN(k) (lo <= (k) && (k) < hi)
#ifndef REP_MASK
#define REP_MASK 0
#endif
#define RP(k) _Pragma("nounroll") for (int rep_ = 0; rep_ < ((REP_PHASE == (k) || ((REP_MASK >> (k)) & 1)) ? 2 : 1); ++rep_)
    constexpr int CW_BAR = 4096;
    volatile LAS unsigned* bst = (volatile LAS unsigned*)(F.lds + LDS_BYTES - 64);
    if (F.tid < 16) bst[F.tid] = 0u;
    __syncthreads();
    XcdBarrier bar; bar.bar = (unsigned*)(F.ws + WS_CTL) + CW_BAR; bar.x = 0; bar.st = nullptr;
    if (hi - lo > 1) bar = xcd_barrier_post((unsigned*)(F.ws + WS_CTL) + CW_BAR, bst);
#define SEAM(k) do { if (IN(k) && IN((k) + 1)) { if ((k) == 0) cg::this_grid().sync(); else xcd_barrier(bar); } } while (0)

    if (IN(0)) RP(0) { phase_prologue(F); __syncthreads(); }
    SEAM(0);
    if (IN(1)) RP(1) phase_modreduce(F);
    SEAM(1);
    if (IN(2)) RP(2) phase_h1(F);
    SEAM(2);
    if (IN(3)) RP(3) {
        pg8::Gemm g{(const bf16*)(F.ws + WS_H), (const bf16*)(F.ws + WS_WIN), MTOT, NPROJ, DM / 2}; InProjOrder S; S.init(F.G, (int)blockIdx.x);
        EpiInProj E{F.ws, F.in[12], F.in[13]};
        pg8::gemm_phase<EpiInProj, InProjOrder, true, true, true>(F.lds, g, S, E);
    }
    SEAM(3);
    if (IN(4)) phase_postproj(F);
    SEAM(4);
#ifdef DN_NAIVE
    if (IN(5)) phase_dn_naive(F);
    SEAM(5);
    if (IN(6)) phase_attention(F, (char*)lds);
#else
    if (IN(5)) RP(5) phase_dn_prep(F);
    SEAM(5);
    if (IN(6)) { RP(14) { phase_dn_scan(F); __syncthreads(); } phase_attention(F, (char*)lds); }
#endif
    SEAM(6);
    if (IN(7)) phase_mergeprep(F);
    SEAM(7);
    if (IN(8)) RP(8) {
#if MERGE_F8_A || MERGE_F8_B || defined(MERGE_TWO_PASS)
        pg8::StaticOrder S; S.init(NT, DM, F.G, (int)blockIdx.x);
        { pg8::Gemm g{(const bf16*)(F.ws + (MERGE_F8_A ? WS_OATT8 : WS_QN)), (const bf16*)(F.ws + WS_WBA), NT, DM, MERGE_F8_A ? 512 : 1024};
          EpiMerge<false> E{(bf16*)(F.ws + WS_Y), (const unsigned char*)(F.ws + WS_G), 0, MERGE_F8_A ? 1.f / (255.f * WB_SCALE * OATT_SCALE) : 1.f / 255.f};
          pg8::gemm_phase<EpiMerge<false>, pg8::StaticOrder, true, true, MERGE_F8_A != 0>(F.lds, g, S, E); }
        __syncthreads();
        { pg8::Gemm g{(const bf16*)(F.ws + (MERGE_F8_B ? WS_ODNN8 : WS_Z)), (const bf16*)(F.ws + WS_WBD), NT, DM, MERGE_F8_B ? 512 : 1024};
          EpiMerge<true> E{(bf16*)(F.ws + WS_Y), (const unsigned char*)(F.ws + WS_G), 2048, MERGE_F8_B ? 1.f / (255.f * WB_SCALE * ODNN_SCALE) : 1.f / 255.f};
          pg8::gemm_phase<EpiMerge<true>, pg8::StaticOrder, true, true, MERGE_F8_B != 0>(F.lds, g, S, E); }
#else
        pg8::TwoStageOrder S; S.init(NT, DM, F.G, (int)blockIdx.x);
        pg8::Gemm g{(const bf16*)(F.ws + WS_QN), (const bf16*)(F.ws + WS_WBA), NT, DM, 1024, (const bf16*)(F.ws + WS_Z), (const bf16*)(F.ws + WS_WBD)};
        EpiMerge2 E{(bf16*)(F.ws + WS_Y), (const unsigned char*)(F.ws + WS_G)};
        pg8::gemm_phase<EpiMerge2, pg8::TwoStageOrder, true, true>(F.lds, g, S, E);
#endif
    }
    SEAM(8);
    if (IN(9)) RP(9) {
        pg8::Gemm g{(const bf16*)(F.ws + WS_Y), (const bf16*)(F.ws + WS_WOUT), NT, DM, DM}; pg8::StaticOrder S; S.init(NT, DM, F.G, (int)blockIdx.x);
        EpiResid E{F.in[0], (bf16*)(F.ws + WS_X1), (const float*)(F.ws + WS_MOD)};
        pg8::gemm_phase<EpiResid, pg8::StaticOrder, true, true>(F.lds, g, S, E);
    }
    SEAM(9);
    if (IN(10)) RP(10) phase_h2(F);
    SEAM(10);
    if (IN(11)) RP(11) {
        pg8::Gemm g{(const bf16*)(F.ws + WS_H2), (const bf16*)(F.ws + WS_WQ), NT, DM, DM}; pg8::StaticOrder S; S.init(NT, DM, F.G, (int)blockIdx.x);
        EpiPlain E{(bf16*)(F.ws + WS_PQ), 2048};
        pg8::gemm_phase<EpiPlain, pg8::StaticOrder, true, true>(F.lds, g, S, E);
    }
    SEAM(11);
    if (IN(12)) { RP(12) { phase_peer_topk(F); __syncthreads(); } phase_quant(F); }
    SEAM(12);
#ifdef GATHER_PROBE_MASK
    if (IN(13)) {
#pragma nounroll
        for (int rep_ = 0; rep_ < 2; ++rep_) { phase_peer_gather(F, rep_ == 0 ? GATHER_PROBE_MASK : 0x3fff, rep_ == 0 ? GATHER_PROBE_VMASK : 0x3fff); __syncthreads(); }
    }
#else
    if (IN(13)) RP(13) phase_peer_gather(F);
#endif
#undef IN
#undef SEAM
}

extern "C" void kernel_launch(void* const* d_in, const int* in_sizes, int n_in, void* d_out, int out_size, void* d_ws, size_t ws_size, hipStream_t stream) {
    static int grid = 0;
    if (grid == 0) {
        if (n_in != 23 || in_sizes[0] != NT * DM || out_size != NT * DM || ws_size < WS_END) {
            fprintf(stderr, "kernel_launch: unexpected shapes (n_in %d, in0 %d, out %d, ws %zu < %zu); nothing launched\n", n_in, n_in > 0 ? in_sizes[0] : -1, out_size, ws_size, (size_t)WS_END);
            grid = -1; return; }
        int dev = 0, cus = 0, per_cu = 0;
        if (hipGetDevice(&dev) != hipSuccess || hipDeviceGetAttribute(&cus, hipDeviceAttributeMultiprocessorCount, dev) != hipSuccess) { grid = -1; return; }
        if (hipFuncSetAttribute((const void*)mk_fwd, hipFuncAttributeMaxDynamicSharedMemorySize, LDS_BYTES) != hipSuccess) { fprintf(stderr, "kernel_launch: hipFuncSetAttribute failed\n"); grid = -1; return; }
        if (hipOccupancyMaxActiveBlocksPerMultiprocessor(&per_cu, (const void*)mk_fwd, NWAVES * 64, LDS_BYTES) != hipSuccess || per_cu < 1) { fprintf(stderr, "kernel_launch: occupancy query says %d blocks per CU\n", per_cu); (void)hipGetLastError(); grid = -1; return; }
        grid = cus;
    }
    if (grid < 0) return;
    (void)hipMemsetAsync((char*)d_ws + WS_CTL, 0, 1 * MiB, stream);
    Args a{};
    for (int i = 0; i < 23; ++i) a.in[i] = (const float*)d_in[i];
    a.out = (float*)d_out; a.ws = (unsigned char*)d_ws;
#if MK_N_LAUNCHES == 1
    a.ph_lo = 0; a.ph_hi = NPHASE;
    void* kargs[] = {(void*)&a};
    const hipError_t e = hipLaunchCooperativeKernel((const void*)mk_fwd, dim3(grid), dim3(NWAVES * 64), kargs, LDS_BYTES, stream);
    if (e != hipSuccess) fprintf(stderr, "kernel_launch: cooperative launch failed: %s (grid %d)\n", hipGetErrorString(e), grid);
#else
    for (int p = 0; p < NPHASE; ++p) {
        a.ph_lo = p; a.ph_hi = p + 1;
        hipLaunchKernelGGL(mk_fwd, dim3(grid), dim3(NWAVES * 64), LDS_BYTES, stream, a);
    }
    const hipError_t le = hipPeekAtLastError();
    if (le != hipSuccess) fprintf(stderr, "kernel_launch: launch failed: %s\n", hipGetErrorName(le));
#endif
}
```

```cpp
#define DN_SLEEP 0

#include <hip/hip_runtime.h>
#include <hip/hip_cooperative_groups.h>
#include <cstdio>
#include <cstdint>
namespace cg = cooperative_groups;

#ifndef MK_N_LAUNCHES
#define MK_N_LAUNCHES 1
#endif
namespace pg8 {
#define PG8_LAS __attribute__((address_space(3)))
typedef unsigned short bf16_t;
typedef short bf16x8 __attribute__((ext_vector_type(8)));
typedef float f32x4 __attribute__((ext_vector_type(4)));
typedef int pg8_v4i __attribute__((ext_vector_type(4)));
typedef int pg8_v8i __attribute__((ext_vector_type(8)));
typedef unsigned u32x4 __attribute__((ext_vector_type(4)));
constexpr int BM = 256, BK = 64, HALF = 128, HTB = HALF * BK * 2  , STAGE_BYTES = 8 * HTB, NXCD = 8, WGM = 8;

__host__ __device__ __forceinline__ int lds_byte(int r, int c) { const int st = (r >> 4) * 2 + (c >> 5), rr = r & 15, cc = c & 31, ob = rr * 64 + cc * 2; return st * 1024 + (ob ^ (((ob >> 9) & 1) << 5)); }
__host__ __device__ __forceinline__ void stage_rc(int b, int& R, int& C) { const int st = b / 1024, sb = b % 1024, swz = sb ^ (((sb >> 9) & 1) << 5); R = (st >> 1) * 16 + swz / 64; C = (st & 1) * 32 + (swz % 64) / 2; }
__host__ __device__ __forceinline__ int perm32(int rho) { const int n = rho >> 4, i = rho & 15; return 8 * (i >> 2) + 4 * n + (i & 3); }

struct Unit { int pm, pn, sel; };
struct Gemm { const bf16_t* A; const bf16_t* Bt; int M, N, K; const bf16_t* A2 = nullptr; const bf16_t* Bt2 = nullptr; };

struct StaticOrder {
    int nM, nN, nwg, G, c;
    __host__ __device__ void init(int M, int N, int G_, int c_) { nM = M / BM; nN = N / BM; nwg = nM * nN; G = G_; c = c_; }
    __host__ __device__ bool next(int i, Unit& u) const {
        const long L = (long)i * G + c; if (L >= nwg) return false;
        int wgid = (int)L; { const int q = nwg / NXCD, r = nwg % NXCD, xcd = wgid % NXCD, off = wgid / NXCD; wgid = (xcd < r ? xcd * (q + 1) : r * (q + 1) + (xcd - r) * q) + off; }
        const int nig = WGM * nN, gid = wgid / nig, fm = gid * WGM, gsz = (nM - fm) < WGM ? (nM - fm) : WGM;
        u.pm = fm + ((wgid % nig) % gsz); u.pn = (wgid % nig) / gsz; return true;
    }
    __device__ __forceinline__ void a_ready(const Unit&) const {}
    __device__ __forceinline__ void done(const Unit&) const {}
};
struct TwoStageOrder {
    StaticOrder base;
    __host__ __device__ void init(int M, int N, int G_, int c_) { base.init(M, N, G_, c_); }
    __host__ __device__ bool next(int i, Unit& u) const { if (!base.next(i >> 1, u)) return false; u.sel = i & 1; return true; }
    __device__ __forceinline__ void a_ready(const Unit&) const {}
    __device__ __forceinline__ void done(const Unit&) const {}
};

__device__ __forceinline__ unsigned cvt_pk_bf16(float lo, float hi) { unsigned r; asm volatile("v_cvt_pk_bf16_f32 %0, %1, %2" : "=v"(r) : "v"(lo), "v"(hi)); return r; }
typedef float f32x2 __attribute__((ext_vector_type(2)));
template <class Epi, class Sched, bool ALIGN_EPI = false, bool SP2 = false, bool F8 = false>
__device__ __forceinline__ void gemm_phase(PG8_LAS unsigned char* lds, const Gemm g, const Sched& S, const Epi& E) {
    const int tid = threadIdx.x, wid = __builtin_amdgcn_readfirstlane(tid >> 6), lane = tid & 63, wr = wid >> 2, wc = wid & 3, fr = lane & 15, fq = lane >> 4;
    const int K = g.K, nt = K / BK;
    unsigned voffA[2], voffB[2];
#pragma unroll
    for (int i = 0; i < 2; ++i) { int R, C; stage_rc(tid * 16 + i * 8192, R, C); const int Rb = Epi::PERM ? ((R & ~31) + perm32(R & 31)) : R;
        voffA[i] = (unsigned)(R * K + C) * 2u; voffB[i] = (unsigned)(Rb * K + C) * 2u; }
    const size_t kstep = (size_t)(BK * 2);
    const size_t hstep = (size_t)HALF * K * 2;
    const size_t tstep = 2 * hstep;
    const unsigned ldsw = (unsigned)wid * 1024u;
    const int aoff = lds_byte(wr * 64 + fr, fq * 8), boff = lds_byte(wc * 32 + fr, fq * 8);
#define PG8_SA(b, h) (((b) * 2 + (h)) * HTB)
#define PG8_SB(b, h) ((4 + (b) * 2 + (h)) * HTB)
#define PG8_STAGE(bufoff, gbase, voff) do { _Pragma("unroll") for (int _i = 0; _i < 2; ++_i) \
        __builtin_amdgcn_global_load_lds((const unsigned*)((const char*)(gbase) + (voff)[_i]), (PG8_LAS unsigned*)(lds + (bufoff) + ldsw + _i * 8192), 16, 0, 0); } while (0)
#define PG8_LDA(dst, b, h) do { _Pragma("unroll") for (int m = 0; m < 4; ++m) { \
        if constexpr (F8) { const pg8_v4i t0_ = *(const PG8_LAS pg8_v4i*)(lds + PG8_SA(b, h) + aoff + m * 2048), t1_ = *(const PG8_LAS pg8_v4i*)(lds + PG8_SA(b, h) + aoff + m * 2048 + 1024); \
            dst##8[m] = __builtin_shufflevector(t0_, t1_, 0, 1, 2, 3, 4, 5, 6, 7); } \
        else { _Pragma("unroll") for (int k = 0; k < 2; ++k) dst[m][k] = *(const PG8_LAS bf16x8*)(lds + PG8_SA(b, h) + aoff + m * 2048 + k * 1024); } } } while (0)
#define PG8_LDB(dst, b, h) do { _Pragma("unroll") for (int n = 0; n < 2; ++n) { \
        if constexpr (F8) { const pg8_v4i t0_ = *(const PG8_LAS pg8_v4i*)(lds + PG8_SB(b, h) + boff + n * 2048), t1_ = *(const PG8_LAS pg8_v4i*)(lds + PG8_SB(b, h) + boff + n * 2048 + 1024); \
            dst##8[n] = __builtin_shufflevector(t0_, t1_, 0, 1, 2, 3, 4, 5, 6, 7); } \
        else { _Pragma("unroll") for (int k = 0; k < 2; ++k) dst[n][k] = *(const PG8_LAS bf16x8*)(lds + PG8_SB(b, h) + boff + n * 2048 + k * 1024); } } } while (0)
#define PG8_MMA(ai, bj, At, Bt) do { __builtin_amdgcn_s_setprio(1); _Pragma("unroll") for (int m = 0; m < 4; ++m) _Pragma("unroll") for (int n = 0; n < 2; ++n) { \
        if constexpr (F8) { asm volatile("v_mfma_scale_f32_16x16x128_f8f6f4 %0, %1, %2, %0, %3, %3 op_sel_hi:[0,0,0]" : "+v"(acc[ai][bj][m][n]) : "v"(Bt##8[n]), "v"(At##8[m]), "v"(0x7F7F7F7F)); } \
        else { _Pragma("unroll") for (int k = 0; k < 2; ++k) acc[ai][bj][m][n] = __builtin_amdgcn_mfma_f32_16x16x32_bf16(Bt[n][k], At[m][k], acc[ai][bj][m][n], 0, 0, 0); } } \
        __builtin_amdgcn_s_setprio(0); } while (0)
#define PG8_WAIT_V(n) asm volatile("s_waitcnt vmcnt(" #n ")" ::: "memory")
#define PG8_WAIT_L(n) asm volatile("s_waitcnt lgkmcnt(" #n ")" ::: "memory")
#define PG8_BAR __builtin_amdgcn_s_barrier()
#define PG8_SCHED __builtin_amdgcn_sched_barrier(0)
    Unit cur, nxt; int ui = 0;
    if (!S.next(0, cur)) return;
    f32x4 acc[2][2][4][2];
#pragma unroll
    for (int a = 0; a < 2; ++a)
#pragma unroll
        for (int b = 0; b < 2; ++b)
#pragma unroll
            for (int m = 0; m < 4; ++m)
#pragma unroll
                for (int n = 0; n < 2; ++n) acc[a][b][m][n] = (f32x4){0.f, 0.f, 0.f, 0.f};
    bf16x8 At[4][2], B0[2][2], B1[2][2];
    pg8_v8i At8[4], B08[2], B18[2];
    const char* cA = (const char*)g.A + (size_t)cur.pm * tstep; const char* cB = (const char*)g.Bt + (size_t)cur.pn * tstep;
    S.a_ready(cur);
    if constexpr (SP2) {
        PG8_STAGE(PG8_SB(0, 0), cB, voffB); PG8_STAGE(PG8_SB(0, 1), cB + hstep, voffB); PG8_STAGE(PG8_SA(0, 0), cA, voffA); PG8_STAGE(PG8_SA(0, 1), cA + hstep, voffA);
        if (wr == 1) PG8_BAR;
        PG8_WAIT_V(2); PG8_BAR;
        PG8_STAGE(PG8_SB(1, 0), cB + kstep, voffB); PG8_STAGE(PG8_SA(1, 0), cA + kstep, voffA); PG8_STAGE(PG8_SB(1, 1), cB + hstep + kstep, voffB);
        PG8_WAIT_V(6); PG8_BAR;
    } else {
        PG8_STAGE(PG8_SB(0, 0), cB, voffB); PG8_STAGE(PG8_SA(0, 0), cA, voffA); PG8_STAGE(PG8_SB(0, 1), cB + hstep, voffB); PG8_STAGE(PG8_SA(0, 1), cA + hstep, voffA);
        if (wr == 1) PG8_BAR;
        PG8_WAIT_V(4); PG8_BAR;
        PG8_STAGE(PG8_SB(1, 0), cB + kstep, voffB); PG8_STAGE(PG8_SA(1, 0), cA + kstep, voffA); PG8_STAGE(PG8_SB(1, 1), cB + hstep + kstep, voffB);
        PG8_WAIT_V(6); PG8_BAR;
    }
    for (;;) {
        const bool has_next = S.next(ui + 1, nxt);
        const bf16_t* gA = g.A; const bf16_t* gB = g.Bt;
        if constexpr (Epi::TWO_STAGE) { if (has_next && nxt.sel) { gA = g.A2; gB = g.Bt2; } }
        const char* nA = has_next ? (const char*)gA + (size_t)nxt.pm * tstep : cA; const char* nB = has_next ? (const char*)gB + (size_t)nxt.pn * tstep : cB;
        for (int t = 0; t < nt; t += 2) {
            const bool last = (t == nt - 2);
            const char* a1 = cA + (size_t)(t + 1) * kstep;
            const char* a2 = last ? nA : cA + (size_t)(t + 2) * kstep; const char* b2 = last ? nB : cB + (size_t)(t + 2) * kstep;
            const char* a3 = a2 + kstep; const char* b3 = b2 + kstep;
            if (last && has_next) S.a_ready(nxt);
            if constexpr (SP2) {
            PG8_LDB(B0, 0, 0); PG8_LDB(B1, 0, 1); PG8_SCHED; PG8_LDA(At, 0, 0); PG8_STAGE(PG8_SA(1, 1), a1 + hstep, voffA);
            PG8_WAIT_V(8); PG8_WAIT_L(0); PG8_BAR; PG8_MMA(0, 0, At, B0); PG8_MMA(0, 1, At, B1); PG8_BAR; PG8_SCHED;
            PG8_LDA(At, 0, 1); PG8_STAGE(PG8_SB(0, 0), b2, voffB); PG8_STAGE(PG8_SB(0, 1), b2 + hstep, voffB); PG8_STAGE(PG8_SA(0, 0), a2, voffA);
            PG8_WAIT_V(8); PG8_WAIT_L(0); PG8_BAR; PG8_MMA(1, 0, At, B0); PG8_MMA(1, 1, At, B1); PG8_BAR; PG8_SCHED;
            PG8_LDB(B0, 1, 0); PG8_LDB(B1, 1, 1); PG8_SCHED; PG8_LDA(At, 1, 0); PG8_STAGE(PG8_SA(0, 1), a2 + hstep, voffA);
            PG8_WAIT_V(8); PG8_WAIT_L(0); PG8_BAR; PG8_MMA(0, 0, At, B0); PG8_MMA(0, 1, At, B1); PG8_BAR; PG8_SCHED;
            PG8_LDA(At, 1, 1); PG8_STAGE(PG8_SB(1, 0), b3, voffB); PG8_STAGE(PG8_SB(1, 1), b3 + hstep, voffB); PG8_STAGE(PG8_SA(1, 0), a3, voffA);
            PG8_WAIT_V(8); PG8_WAIT_L(0); PG8_BAR; PG8_MMA(1, 0, At, B0); PG8_MMA(1, 1, At, B1); PG8_BAR; PG8_SCHED;
            } else {
            PG8_LDB(B0, 0, 0); PG8_SCHED; PG8_LDA(At, 0, 0); PG8_STAGE(PG8_SA(1, 1), a1 + hstep, voffA);
            PG8_WAIT_L(8); PG8_BAR; PG8_WAIT_L(0); PG8_MMA(0, 0, At, B0); PG8_BAR; PG8_SCHED;
            PG8_LDB(B1, 0, 1); PG8_STAGE(PG8_SB(0, 0), b2, voffB);
            PG8_BAR; PG8_WAIT_L(0); PG8_MMA(0, 1, At, B1); PG8_BAR;
            PG8_LDA(At, 0, 1); PG8_STAGE(PG8_SA(0, 0), a2, voffA);
            PG8_BAR; PG8_WAIT_L(0); PG8_MMA(1, 0, At, B0); PG8_BAR; PG8_SCHED;
            PG8_STAGE(PG8_SB(0, 1), b2 + hstep, voffB);
            PG8_WAIT_V(6); PG8_BAR; PG8_MMA(1, 1, At, B1); PG8_BAR;
            PG8_LDB(B0, 1, 0); PG8_SCHED; PG8_LDA(At, 1, 0); PG8_STAGE(PG8_SA(0, 1), a2 + hstep, voffA);
            PG8_WAIT_L(8); PG8_BAR; PG8_WAIT_L(0); PG8_MMA(0, 0, At, B0); PG8_BAR; PG8_SCHED;
            PG8_LDB(B1, 1, 1); PG8_STAGE(PG8_SB(1, 0), b3, voffB);
            PG8_BAR; PG8_WAIT_L(0); PG8_MMA(0, 1, At, B1); PG8_BAR;
            PG8_LDA(At, 1, 1); PG8_STAGE(PG8_SA(1, 0), a3, voffA);
            PG8_BAR; PG8_WAIT_L(0); PG8_MMA(1, 0, At, B0); PG8_BAR; PG8_SCHED;
            PG8_STAGE(PG8_SB(1, 1), b3 + hstep, voffB);
            PG8_WAIT_V(6); PG8_BAR; PG8_MMA(1, 1, At, B1); PG8_BAR;
            }
        }
        if constexpr (ALIGN_EPI) { if (wr == 0) PG8_BAR; }
        bool keep = false;
        if constexpr (Epi::TWO_STAGE) keep = (cur.sel == 0);
        if constexpr (!Epi::AFTER_DRAIN) {
            if constexpr (Epi::TWO_STAGE) { if (keep) E.mid(acc, cur, wr, wc, fr, fq); else E(acc, cur, wr, wc, fr, fq); }
            else E(acc, cur, wr, wc, fr, fq);
            S.done(cur); }
        if (!has_next) break;
        if (!keep)
#pragma unroll
        for (int a = 0; a < 2; ++a)
#pragma unroll
            for (int b = 0; b < 2; ++b)
#pragma unroll
                for (int m = 0; m < 4; ++m)
#pragma unroll
                    for (int n = 0; n < 2; ++n) acc[a][b][m][n] = (f32x4){0.f, 0.f, 0.f, 0.f};
        cur = nxt; cA = nA; cB = nB; ++ui;
        if constexpr (ALIGN_EPI) { if (wr == 1) PG8_BAR; }
    }
    PG8_WAIT_V(0);
    if constexpr (!ALIGN_EPI) { if (wr == 0) PG8_BAR; }
    PG8_BAR;
    if constexpr (Epi::AFTER_DRAIN) { E.fused(acc, cur, wr, wc, fr, fq, lds, wid, lane); S.done(cur); }
#undef PG8_SA
#undef PG8_SB
#undef PG8_STAGE
#undef PG8_LDA
#undef PG8_LDB
#undef PG8_MMA
#undef PG8_WAIT_V
#undef PG8_WAIT_L
#undef PG8_BAR
#undef PG8_SCHED
}
}
namespace attn {
using bf16 = unsigned short;
constexpr int D = 128, NW = 8, QBLK = 32, KVBLK = 64;
constexpr float SCALE = 0.088388347648318440f;
constexpr float THR = 8.f;
constexpr int SDEPTH = 2;
constexpr int LDQ = 1024, LDK = 256, LDO = 1024;
constexpr size_t SHM_V = KVBLK * D * 2, SHM_K = KVBLK * D * 2, SHM_ATTN = 2 * SHM_V + 2 * SHM_K + NW * 64 * 4;
__device__ __forceinline__ unsigned short f2bf_rne(float f) { unsigned u = __float_as_uint(f); return (unsigned short)((u + 0x7fffu + ((u >> 16) & 1u)) >> 16); }
using bf16x8 = __attribute__((ext_vector_type(8))) short;
using s16x4  = __attribute__((ext_vector_type(4))) short;
using f32x16 = __attribute__((ext_vector_type(16))) float;
using f32x8  = __attribute__((ext_vector_type(8))) float;
using u32x4  = __attribute__((ext_vector_type(4))) unsigned;
#define KSWZ(row, colB) ((row) * 256 + ((colB) ^ (((row) & 7) << 4)))
#define SBAR() __builtin_amdgcn_sched_barrier(0)
__device__ __forceinline__ int crow(int r, int hi) { return (r & 3) + 8 * (r >> 2) + 4 * hi; }
__device__ __forceinline__ unsigned cvtpk(float lo, float hi) {
  unsigned r; asm volatile("v_cvt_pk_bf16_f32 %0, %1, %2" : "=v"(r) : "v"(lo), "v"(hi)); return r;
}
template <typename TIn> struct Stage;
template <> struct Stage<bf16>  { using T = bf16x8;
  __device__ static __forceinline__ T ld8(const bf16* p) { return *reinterpret_cast<const bf16x8*>(p); }
  __device__ static __forceinline__ bf16x8 tobf(T x) { return x; } };
template <> struct Stage<float> { using T = f32x8;
  __device__ static __forceinline__ T ld8(const float* p) { return *reinterpret_cast<const f32x8*>(p); }
  __device__ static __forceinline__ bf16x8 tobf(T x) {
    u32x4 w = {cvtpk(x[0], x[1]), cvtpk(x[2], x[3]), cvtpk(x[4], x[5]), cvtpk(x[6], x[7])}; return *reinterpret_cast<bf16x8*>(&w); } };

__device__ __forceinline__ void partialSM(f32x16& p0, f32x16& p1, float& m_reg, float& mn, float& alpha) {
  constexpr float C = SCALE * 1.4426950408889634f;
  float pmax = p0[0]; for (int r = 1; r < 16; ++r) pmax = fmaxf(pmax, p0[r]); for (int r = 0; r < 16; ++r) pmax = fmaxf(pmax, p1[r]);
  { auto rr = __builtin_amdgcn_permlane32_swap(__float_as_uint(pmax), __float_as_uint(pmax), false, false);
    pmax = fmaxf(__uint_as_float(rr[0]), __uint_as_float(rr[1])); }
  if (__builtin_expect(__all(pmax - m_reg <= THR / SCALE), 1)) { mn = m_reg; alpha = 1.f; }
  else { mn = fmaxf(m_reg, pmax); alpha = __builtin_amdgcn_exp2f((m_reg - mn) * C); m_reg = mn; }
  float mnC = -mn * C;
  for (int r = 0; r < 16; ++r) p0[r] = fmaf(p0[r], C, mnC); for (int r = 0; r < 16; ++r) p1[r] = fmaf(p1[r], C, mnC);
  for (int r = 0; r < 16; ++r) p0[r] = __builtin_amdgcn_exp2f(p0[r]);
}
__device__ __forceinline__ void finishSM(f32x16& p0, f32x16& p1, float alpha, float& l_reg, bf16x8& pa0, bf16x8& pa1, bf16x8& pa2, bf16x8& pa3) {
  for (int r = 0; r < 16; ++r) p1[r] = __builtin_amdgcn_exp2f(p1[r]);
  float ps = 0; for (int r = 0; r < 16; ++r) ps += p0[r]; for (int r = 0; r < 16; ++r) ps += p1[r];
  { auto rr = __builtin_amdgcn_permlane32_swap(__float_as_uint(ps), __float_as_uint(ps), false, false);
    ps = __uint_as_float(rr[0]) + __uint_as_float(rr[1]); }
  l_reg = l_reg * alpha + ps;
#define PK4(P, BASE, OUT) do { unsigned a0 = cvtpk(P[BASE + 0], P[BASE + 1]), a1 = cvtpk(P[BASE + 2], P[BASE + 3]);   \
    unsigned b0 = cvtpk(P[BASE + 4], P[BASE + 5]), b1 = cvtpk(P[BASE + 6], P[BASE + 7]);                              \
    auto r0 = __builtin_amdgcn_permlane32_swap(a0, b0, false, false); auto r1 = __builtin_amdgcn_permlane32_swap(a1, b1, false, false); \
    u32x4 w = {r0[0], r1[0], r0[1], r1[1]}; OUT = *reinterpret_cast<bf16x8*>(&w); } while (0)
  PK4(p0, 0, pa0); PK4(p0, 8, pa1); PK4(p1, 0, pa2); PK4(p1, 8, pa3);
#undef PK4
}
__device__ __forceinline__ void qkt(f32x16& p0, f32x16& p1, const bf16* Ks, const bf16x8* qr, int r32, int hi) {
  p0 = f32x16{}; p1 = f32x16{};
  for (int d0 = 0; d0 < 8; ++d0) { int cb = (d0 * 16 + hi * 8) * 2;
    bf16x8 b0 = *reinterpret_cast<const bf16x8*>((const char*)Ks + KSWZ(r32, cb));
    bf16x8 b1 = *reinterpret_cast<const bf16x8*>((const char*)Ks + KSWZ(32 + r32, cb));
    p0 = __builtin_amdgcn_mfma_f32_32x32x16_bf16(b0, qr[d0], p0, 0, 0, 0);
    p1 = __builtin_amdgcn_mfma_f32_32x32x16_bf16(b1, qr[d0], p1, 0, 0, 0); }
}
__device__ __forceinline__ int v_st(int k, int c) { const int kk = (k & ~0xC) | ((k & 4) << 1) | ((k & 8) >> 1); return ((kk >> 3) * 4 + (c >> 5)) * 512 + ((kk & 7) * 32 + (c & 31)) * 2; }
__device__ __forceinline__ int v_rd_base(int lane) { return ((lane & 3) << 3) | (((lane >> 2) & 3) << 6) | (((lane >> 4) & 1) << 5) | (((lane >> 5) & 1) << 8); }
constexpr int v_rd_off(int d0, int ks, int half) { return d0 * 512 + ks * 4096 + half * 2048; }
template <int OFF> __device__ __forceinline__ s16x4 tr_read(int vb) {
  s16x4 r; asm volatile("ds_read_b64_tr_b16 %0, %1 offset:%2" : "=&v"(r) : "v"(vb), "i"(OFF) : "memory"); return r;
}
template <int D0> __device__ __forceinline__ void pv_one(f32x16& od, int vb, bf16x8 pa0, bf16x8 pa1, bf16x8 pa2, bf16x8 pa3) {
  const s16x4 l0 = tr_read<v_rd_off(D0, 0, 0)>(vb), h0 = tr_read<v_rd_off(D0, 0, 1)>(vb), l1 = tr_read<v_rd_off(D0, 1, 0)>(vb), h1 = tr_read<v_rd_off(D0, 1, 1)>(vb);
  const s16x4 l2 = tr_read<v_rd_off(D0, 2, 0)>(vb), h2 = tr_read<v_rd_off(D0, 2, 1)>(vb), l3 = tr_read<v_rd_off(D0, 3, 0)>(vb), h3 = tr_read<v_rd_off(D0, 3, 1)>(vb);
  asm volatile("s_waitcnt lgkmcnt(0)" ::: "memory"); SBAR();
#define PK(L, H) (bf16x8){L[0], L[1], L[2], L[3], H[0], H[1], H[2], H[3]}
  od = __builtin_amdgcn_mfma_f32_32x32x16_bf16(pa0, PK(l0, h0), od, 0, 0, 0);
  od = __builtin_amdgcn_mfma_f32_32x32x16_bf16(pa1, PK(l1, h1), od, 0, 0, 0);
  od = __builtin_amdgcn_mfma_f32_32x32x16_bf16(pa2, PK(l2, h2), od, 0, 0, 0);
  od = __builtin_amdgcn_mfma_f32_32x32x16_bf16(pa3, PK(l3, h3), od, 0, 0, 0);
#undef PK
}
__device__ __forceinline__ void pv_d0(f32x16* o, int vb, bf16x8 pa0, bf16x8 pa1, bf16x8 pa2, bf16x8 pa3) {
  pv_one<0>(o[0], vb, pa0, pa1, pa2, pa3); pv_one<1>(o[1], vb, pa0, pa1, pa2, pa3); pv_one<2>(o[2], vb, pa0, pa1, pa2, pa3); pv_one<3>(o[3], vb, pa0, pa1, pa2, pa3);
}

template <typename TQ>
__device__ __forceinline__ void attn_dense_body(const TQ* __restrict__ Qb, const bf16* __restrict__ Kh, const bf16* __restrict__ Vh,
                                                bf16* __restrict__ Ob, int seq, char* lds) {
  using St = Stage<bf16>; using SQ = Stage<TQ>;
  const int tid = threadIdx.x, wid = tid >> 6, lane = tid & 63, r32 = lane & 31, hi = lane >> 5;
  bf16* V_lds = (bf16*)lds; bf16* K_lds = (bf16*)(lds + 2 * SHM_V);
  float* ws = (float*)(lds + 2 * SHM_V + 2 * SHM_K) + wid * 64; float* li_l = ws; float* al_l = ws + 32;
  float m_reg = -1e30f, l_reg = 0; f32x16 o[4] = {}; bf16x8 qr[8];
  const TQ* Qw = Qb + (long)(wid * QBLK + r32) * LDQ + hi * 8;
#pragma unroll
  for (int d0 = 0; d0 < 8; ++d0) qr[d0] = SQ::tobf(SQ::ld8(Qw + d0 * 16));
  const int sr = tid >> 4, sc = (tid & 15) * 8, vst0 = v_st(sr, sc), vst1 = v_st(32 + sr, sc);
  const int vb0 = (int)(uintptr_t)V_lds + v_rd_base(lane);
  struct { typename St::T vs0, vs1, ks0, ks1; } sr_[SDEPTH];
#define SLOAD(i, k0) do { sr_[i].vs0 = St::ld8(&Vh[(long)((k0) + sr) * LDK + sc]); sr_[i].vs1 = St::ld8(&Vh[(long)((k0) + 32 + sr) * LDK + sc]); \
    sr_[i].ks0 = St::ld8(&Kh[(long)((k0) + sr) * LDK + sc]); sr_[i].ks1 = St::ld8(&Kh[(long)((k0) + 32 + sr) * LDK + sc]); } while (0)
#define SWRITE(b, i) do { *(bf16x8*)((char*)V_lds + (b) * SHM_V + vst0) = St::tobf(sr_[i].vs0);          \
    *(bf16x8*)((char*)V_lds + (b) * SHM_V + vst1) = St::tobf(sr_[i].vs1); int kc = sc * 2;               \
    *(bf16x8*)((char*)K_lds + (b) * SHM_K + KSWZ(sr, kc)) = St::tobf(sr_[i].ks0);                       \
    *(bf16x8*)((char*)K_lds + (b) * SHM_K + KSWZ(32 + sr, kc)) = St::tobf(sr_[i].ks1); } while (0)
#define SWAIT() do { if constexpr (SDEPTH == 2) asm volatile("s_waitcnt vmcnt(4)" ::: "memory"); else asm volatile("s_waitcnt vmcnt(0)" ::: "memory"); } while (0)
#define RESC(a) do { if (__any((a) < 1.f)) { if (hi == 0) al_l[r32] = (a); asm volatile("s_waitcnt lgkmcnt(0)" ::: "memory"); \
    for (int d = 0; d < 4; ++d) for (int r = 0; r < 16; ++r) o[d][r] *= al_l[crow(r, hi)]; } } while (0)
  f32x16 pA0, pA1, pB0, pB1; float mnA, mnB, alA, alB; bf16x8 pa0, pa1, pa2, pa3; const int NT = seq / KVBLK;
  constexpr int SE = 0, SO = SDEPTH - 1;
  SLOAD(SE, 0); asm volatile("s_waitcnt vmcnt(0)" ::: "memory"); SWRITE(0, SE); __syncthreads();
  qkt(pA0, pA1, K_lds, qr, r32, hi); partialSM(pA0, pA1, m_reg, mnA, alA);
  SLOAD(SO, KVBLK); if constexpr (SDEPTH == 2) { if (2 < NT) SLOAD(SE, 2 * KVBLK); }
  SWAIT(); SWRITE(1, SO); __syncthreads();
  for (int j = 1; j + 1 < NT; j += 2) {
    SBAR(); qkt(pB0, pB1, (bf16*)((char*)K_lds + SHM_K), qr, r32, hi);
    finishSM(pA0, pA1, alA, l_reg, pa0, pa1, pa2, pa3); SBAR();
    SLOAD(SO, (j + SDEPTH) * KVBLK); SBAR();
    pv_d0(o, vb0, pa0, pa1, pa2, pa3); partialSM(pB0, pB1, m_reg, mnB, alB);
    __syncthreads(); SWAIT(); SWRITE(0, SE);
    RESC(alB); __syncthreads();
    SBAR(); qkt(pA0, pA1, K_lds, qr, r32, hi);
    finishSM(pB0, pB1, alB, l_reg, pa0, pa1, pa2, pa3); SBAR();
    if (SDEPTH == 1 || j + 3 < NT) SLOAD(SE, (j + 1 + SDEPTH) * KVBLK); SBAR();
    pv_d0(o, vb0 + (int)SHM_V, pa0, pa1, pa2, pa3); partialSM(pA0, pA1, m_reg, mnA, alA);
    __syncthreads(); SWAIT(); SWRITE(1, SO);
    RESC(alA); __syncthreads();
  }
  SBAR(); qkt(pB0, pB1, (bf16*)((char*)K_lds + SHM_K), qr, r32, hi);
  finishSM(pA0, pA1, alA, l_reg, pa0, pa1, pa2, pa3); SBAR();
  pv_d0(o, vb0, pa0, pa1, pa2, pa3); partialSM(pB0, pB1, m_reg, mnB, alB);
  __syncthreads(); RESC(alB);
  finishSM(pB0, pB1, alB, l_reg, pa0, pa1, pa2, pa3); SBAR();
  pv_d0(o, vb0 + (int)SHM_V, pa0, pa1, pa2, pa3);
  if (hi == 0) li_l[r32] = l_reg; asm volatile("s_waitcnt lgkmcnt(0)" ::: "memory");
  float rli[16];
#pragma unroll
  for (int r = 0; r < 16; ++r) rli[r] = __builtin_amdgcn_rcpf(li_l[crow(r, hi)]);
  bf16* Ow = Ob + (long)(wid * QBLK) * LDO;
#pragma unroll
  for (int r = 0; r < 16; ++r) { int orow = crow(r, hi);
    for (int d0 = 0; d0 < 4; ++d0) Ow[(long)orow * LDO + d0 * 32 + r32] = f2bf_rne(o[d0][r] * rli[r]); }
#undef SLOAD
#undef SWRITE
#undef SWAIT
#undef RESC
}
#undef KSWZ
#undef SBAR
}

constexpr int DM = 2048, NB = 4, TS = 4096, NT = NB * TS, CL = 256, NC = NB * CL, MTOT = NT + NC, LKV = TS + CL;
constexpr int NPROJ = 9984;
constexpr int INW = 9760;
constexpr int NEXP = 16384;
constexpr float EPS = 1e-6f;
constexpr int NWAVES = 8;
constexpr int NPHASE = 14;

constexpr size_t MiB = 1u << 20;
constexpr size_t WS_CTL = 0, WS_MOD = 1 * MiB, WS_MODP = 2 * MiB, WS_SUBK = 10 * MiB, WS_WBA = 11 * MiB, WS_WBD = 15 * MiB, WS_WOUT = 19 * MiB, WS_WQ = 27 * MiB;
constexpr size_t WS_BETA = 35 * MiB, WS_LOGA = 37 * MiB, WS_EXPI = 39 * MiB, WS_EXPG = 47 * MiB;
constexpr size_t WS_A = 56 * MiB;
constexpr size_t WS_WIN = WS_A, WS_H = WS_A + 39 * MiB;
constexpr size_t WS_DQ = WS_A, WS_DK = WS_A + 34 * MiB, WS_DV = WS_A + 68 * MiB;
constexpr size_t WS_Y = WS_A, WS_H2 = WS_A;
constexpr size_t WS_B = 164 * MiB;
constexpr size_t WS_QN = WS_B, WS_Z = WS_B + 32 * MiB, WS_PQ = WS_B;
constexpr size_t WS_KB = 228 * MiB, WS_VB = 237 * MiB;
constexpr size_t WS_C = 246 * MiB;
constexpr size_t WS_DNRAW = WS_C, WS_U8 = WS_C, WS_V8 = WS_C + 32 * MiB, WS_SU = WS_C + 64 * MiB, WS_SV = WS_C + 65 * MiB, WS_U4 = WS_C + 66 * MiB;
constexpr size_t WS_KT = WS_C, WS_TINV = WS_C + 34 * MiB, WS_QKO = WS_C + 68 * MiB, WS_VEC = WS_C + 102 * MiB;
constexpr size_t WS_D = 374 * MiB;
constexpr size_t WS_G = WS_D, WS_X1 = WS_D;
constexpr size_t WS_OATT8 = WS_D + 64 * MiB, WS_ODNN8 = WS_D + 80 * MiB;
#ifndef MERGE_F8_A
#define MERGE_F8_A 0
#endif
#ifndef MERGE_F8_B
#define MERGE_F8_B 0
#endif
constexpr float WB_SCALE = 64.f, OATT_SCALE = 16.f, ODNN_SCALE = 2.f;
constexpr size_t WS_ODN = 502 * MiB;
constexpr size_t WS_END = 566 * MiB;
static_assert((size_t)NPROJ * DM * 2 <= 39 * MiB && (size_t)MTOT * DM * 2 <= 69 * MiB && (size_t)MTOT * 1024 * 2 <= 34 * MiB && (size_t)MTOT * 3072 * 2 <= 128 * MiB, "ws map");
static_assert((size_t)NB * LKV * 256 * 2 <= 9 * MiB && (size_t)NT * 4096 * 2 <= 128 * MiB && (size_t)NEXP * DM * 2 <= 64 * MiB, "ws map");

constexpr int LDS_BYTES = 163840;

#define DI __device__ __forceinline__
#define LAS __attribute__((address_space(3)))
typedef unsigned short bf16;
typedef float f32x4 __attribute__((ext_vector_type(4)));
typedef float f32x2 __attribute__((ext_vector_type(2)));
typedef unsigned u32x4 __attribute__((ext_vector_type(4)));
typedef unsigned u32x2 __attribute__((ext_vector_type(2)));

typedef __bf16 bf16x2_n __attribute__((ext_vector_type(2)));
DI unsigned pk2(float lo, float hi) { const f32x2 v = {lo, hi}; return __builtin_bit_cast(unsigned, __builtin_convertvector(v, bf16x2_n)); }
DI unsigned f2bf(float f) { return pk2(f, f) & 0xffffu; }
DI float bflo(unsigned w) { return __uint_as_float(w << 16); }
DI float bfhi(unsigned w) { return __uint_as_float(w & 0xffff0000u); }
DI float bf2f(bf16 h) { return __uint_as_float((unsigned)h << 16); }
DI float wave_sum(float v) {
#pragma unroll
    for (int o = 1; o < 64; o <<= 1) v += __shfl_xor(v, o);
    return v;
}
DI unsigned wave_max_u32(unsigned v) {
#pragma unroll
    for (int o = 1; o < 64; o <<= 1) { const unsigned t = (unsigned)__shfl_xor((int)v, o); v = t > v ? t : v; }
    return v;
}
DI float sigm(float x) { return __builtin_amdgcn_rcpf(1.f + __expf(-x)); }
DI float silu(float x) { return x * __builtin_amdgcn_rcpf(1.f + __expf(-x)); }
DI float softplus(float x) { return x > 20.f ? x : log1pf(__expf(x)); }
DI float gelu_erf(float v) {
    const float av = fabsf(v), t = __builtin_amdgcn_rcpf(av * 0.2316418882f + 1.0f);
    float q = t * 0.5307027145f + (-0.7265760135f); q = q * t + 0.7107068705f; q = q * t + (-0.142248368f); q = q * t + 0.127414796f; q = q * t;
    const float e = __builtin_amdgcn_exp2f((v * v) * (-0.72134752044f));
    const float mm = v * (q * e);
    return v < 0.f ? mm : v - mm;
}
DI unsigned okey(float f) { const unsigned u = __float_as_uint(f); return (u & 0x80000000u) ? ~u : (u | 0x80000000u); }
DI unsigned rdlane(unsigned v, int l) { return (unsigned)__builtin_amdgcn_readlane((int)v, l); }
DI float rdlanef(float v, int l) { return __uint_as_float((unsigned)__builtin_amdgcn_readlane((int)__float_as_uint(v), l)); }

#define XB_TMO      128
#define XB_XCNT(j)  (256  + 64 * (j))
#define XB_XSUB(j)  (1280 + 64 * (j))
#define XB_XGEN(j)  (2304 + 64 * (j))
#define XB_TOP      3328
#define XB_TOPGEN   3392
#define XCD_BAR_WORDS 3456
#define XB_SPIN_CAP (1u << 18)

__device__ __forceinline__ unsigned xb_ld(unsigned* p)              { return __hip_atomic_load(p, __ATOMIC_RELAXED, __HIP_MEMORY_SCOPE_AGENT); }
__device__ __forceinline__ unsigned xb_add(unsigned* p, unsigned v) { return __hip_atomic_fetch_add(p, v, __ATOMIC_RELAXED, __HIP_MEMORY_SCOPE_AGENT); }
__device__ __forceinline__ unsigned xb_xcc_id() { return (unsigned)__builtin_amdgcn_s_getreg((3 << 11) | 20) & 0xFu; }
#define XB_SPIN(cond, bar) do { unsigned _sp = 0; while (cond) { __builtin_amdgcn_s_sleep(1); \
    if ((++_sp & 255u) == 0u) { if (xb_ld(&(bar)[XB_TMO])) break; if (_sp > XB_SPIN_CAP) { atomicAdd(&(bar)[XB_TMO], 1u); break; } } } } while (0)

struct XcdBarrier {
    unsigned* bar; unsigned x;
    volatile LAS unsigned* st;
};

__device__ __forceinline__ XcdBarrier xcd_barrier_post(unsigned* bar, volatile LAS unsigned* st) {
    XcdBarrier b; b.bar = bar; b.x = xb_xcc_id(); b.st = st;
    if (threadIdx.x == 0) (void)xb_add(&bar[XB_XCNT(b.x)], 1u);
    return b;
}
__device__ __forceinline__ void xcd_barrier_complete(unsigned* bar, unsigned x, unsigned& nloc, unsigned& nx) {
    const unsigned G = gridDim.x * gridDim.y * gridDim.z;
    unsigned sum, cnt, mine, sp = 0u;
    for (;;) {
        sum = 0u; cnt = 0u; mine = 0u;
#pragma unroll
        for (unsigned j = 0; j < 16; ++j) { const unsigned c = xb_ld(&bar[XB_XCNT(j)]); sum += c; cnt += (c > 0u) ? 1u : 0u; mine = (j == x) ? c : mine; }
        if (sum == G) break;
        __builtin_amdgcn_s_sleep(1);
        if ((++sp & 255u) == 0u) { if (xb_ld(&bar[XB_TMO])) break; if (sp > XB_SPIN_CAP) { atomicAdd(&bar[XB_TMO], 1u); break; } }
    }
    nloc = mine > 0u ? mine : 1u; nx = cnt > 0u ? cnt : 1u;
}

__device__ __forceinline__ void xcd_barrier(const XcdBarrier& b) {
    asm volatile("s_waitcnt vmcnt(0)" ::: "memory");
    __syncthreads();
    if (threadIdx.x == 0) {
        unsigned* bar = b.bar;
        __builtin_amdgcn_s_waitcnt(0);
        unsigned nloc = b.st[0], nx = b.st[1];
        if (nloc == 0u) { xcd_barrier_complete(bar, b.x, nloc, nx); b.st[0] = nloc; b.st[1] = nx; }
        const unsigned old = xb_add(&bar[XB_XSUB(b.x)], 1u);
        const unsigned gen = old / nloc;
        if (old + 1u == (gen + 1u) * nloc) {
            __builtin_amdgcn_fence(__ATOMIC_RELEASE, "agent");
            asm volatile("s_waitcnt vmcnt(0)" ::: "memory");
            const unsigned og = xb_add(&bar[XB_TOP], 1u);
            const unsigned tg = og / nx;
            if (og + 1u == (tg + 1u) * nx) xb_add(&bar[XB_TOPGEN], 1u);
            else XB_SPIN(xb_ld(&bar[XB_TOPGEN]) == tg, bar);
            __builtin_amdgcn_fence(__ATOMIC_ACQUIRE, "agent");
            xb_add(&bar[XB_XGEN(b.x)], 1u);
            asm volatile("s_waitcnt vmcnt(0)" ::: "memory");
        } else {
            XB_SPIN(xb_ld(&bar[XB_XGEN(b.x)]) == gen, bar);
            __builtin_amdgcn_fence(__ATOMIC_ACQUIRE, "agent");
            asm volatile("s_waitcnt vmcnt(0)" ::: "memory");
        }
    }
    __syncthreads();
}

#define RAW_BAR() do { asm volatile("s_waitcnt lgkmcnt(0)" ::: "memory"); __builtin_amdgcn_s_barrier(); asm volatile("" ::: "memory"); } while (0)

DI unsigned pk4_fp8(float a, float b, float c, float d) { int w = __builtin_amdgcn_cvt_pk_fp8_f32(a, b, 0, false); w = __builtin_amdgcn_cvt_pk_fp8_f32(c, d, w, true); return (unsigned)w; }
DI float fp8c(float x) { return fminf(fmaxf(x, -448.f), 448.f); }
constexpr float WIN_SCALE = 64.f;

struct Frame {
    LAS unsigned char* lds;
    unsigned char* ws;
    const float* in[23];
    float* out;
    int tid, lane, wave, vcu, G, gw, NGW;
};

DI size_t dn_off(int m, int h) {
    int b, pos; if (m < NT) { b = m >> 12; pos = 256 + (m & 4095); } else { const int mm = m - NT; b = mm >> 8; pos = mm & 255; }
    return ((size_t)(b * 8 + h) * 4352 + pos) * 128;
}

struct EpiInProj {
    static constexpr bool PERM = true, AFTER_DRAIN = false, TWO_STAGE = false;
    unsigned char* ws; const float* a_log; const float* dt_bias;
    DI void operator()(const pg8::f32x4 (&acc)[2][2][4][2], const pg8::Unit& u, int wr, int wc, int fr, int fq) const {
        asm volatile("" : "+v"(fr), "+v"(fq));
        const int pn = u.pn, pm = u.pm; const bool isctx = pm >= 64;
        if (pn == 38) {
            if (wc != 0) return;
            float* dstf = (float*)(ws + (fq < 2 ? WS_BETA : WS_LOGA));
            const int c8 = (fq & 1) * 8;
            f32x4 na[2], db[2];
#pragma unroll
            for (int n = 0; n < 2; ++n) { const f32x4 al = *(const f32x4*)(a_log + c8 + 4 * n); db[n] = *(const f32x4*)(dt_bias + c8 + 4 * n);
#pragma unroll
                for (int i = 0; i < 4; ++i) na[n][i] = -__expf(al[i]); }
#pragma unroll
            for (int ai = 0; ai < 2; ++ai)
#pragma unroll
                for (int m = 0; m < 4; ++m) {
                    const int row = pm * 256 + ai * 128 + wr * 64 + m * 16 + fr;
#pragma unroll
                    for (int n = 0; n < 2; ++n) {
                        f32x4 v = acc[ai][0][m][n] * (1.f / WIN_SCALE), o;
#pragma unroll
                        for (int i = 0; i < 4; ++i) {
                            const float xs = v[i] + db[n][i];
                            const float sp = fmaxf(xs, 0.f) + __logf(1.f + __expf(-fabsf(xs)));
                            const float sgm = sigm(v[i]);
                            o[i] = (fq < 2) ? sgm : na[n][i] * sp;
                        }
                        *(f32x4*)(dstf + (size_t)row * 16 + c8 + 4 * n) = o;
                    }
                }
            return;
        }
        bf16* dst; int ld, coloff, rowoff = 0; bool sg = false;
        if (pn < 4) { if (isctx) return; dst = (bf16*)(ws + WS_QN); ld = 1024; coloff = pn * 256; }
        else if (pn < 6) { dst = (bf16*)(ws + (pn == 4 ? WS_KB : WS_VB)); ld = 256; coloff = 0; rowoff = isctx ? (-12288 + (pm - 64) * 4096) : (pm >> 4) * 256; }
        else if (pn < 18) { dst = (bf16*)(ws + WS_DNRAW); ld = 3072; coloff = (pn - 6) * 256; }
        else if (pn < 22) { if (isctx) return; dst = (bf16*)(ws + WS_Z); ld = 1024; coloff = (pn - 18) * 256; }
        else { if (isctx) return; dst = (bf16*)(ws + WS_G); ld = 4096; coloff = (pn - 22) * 256; sg = true; }
        const int row0 = pm * 256 + rowoff + wr * 64 + fr, col0 = coloff + wc * 32 + 8 * fq;
#pragma unroll
        for (int ai = 0; ai < 2; ++ai)
#pragma unroll
            for (int m = 0; m < 4; ++m) {
                bf16* rowp = dst + (size_t)(row0 + ai * 128 + m * 16) * ld + col0;
#pragma unroll
                for (int bj = 0; bj < 2; ++bj) {
                    f32x4 v0 = acc[ai][bj][m][0] * (1.f / WIN_SCALE), v1 = acc[ai][bj][m][1] * (1.f / WIN_SCALE);
                    if (sg) {
                        u32x2 gb; gb.x = 0u; gb.y = 0u;
#pragma unroll
                        for (int i = 0; i < 4; ++i) { gb.x |= (unsigned)(sigm(v0[i]) * 255.f + 0.5f) << (8 * i); gb.y |= (unsigned)(sigm(v1[i]) * 255.f + 0.5f) << (8 * i); }
                        __builtin_nontemporal_store(gb, (u32x2*)((unsigned char*)dst + (size_t)(row0 + ai * 128 + m * 16) * 4096 + col0 + bj * 128));
                        continue;
                    }
                    u32x4 w; w.x = pg8::cvt_pk_bf16(v0[0], v0[1]); w.y = pg8::cvt_pk_bf16(v0[2], v0[3]); w.z = pg8::cvt_pk_bf16(v1[0], v1[1]); w.w = pg8::cvt_pk_bf16(v1[2], v1[3]);
                    __builtin_nontemporal_store(w, (u32x4*)(rowp + bj * 128));
                }
            }
    }
};


struct InProjOrder {
    pg8::StaticOrder lat; int G, c;
    static constexpr int NLAT = 64 * 39, NCTX = 4 * 15;
    DI void init(int G_, int c_) { lat.init(NT, NPROJ, G_, c_); G = G_; c = c_; }
    DI bool next(int i, pg8::Unit& u) const {
        const int L = i * G + c;
        if (L < NLAT) return lat.next(i, u);
        const int x = L - NLAT; if (x >= NCTX) return false;
        const int j = x % 15; u.pm = 64 + x / 15; u.pn = j < 2 ? 4 + j : (j < 14 ? 4 + j : 38); return true;
    }
    DI void a_ready(const pg8::Unit&) const {}
    DI void done(const pg8::Unit&) const {}
};

struct EpiPlain {
    static constexpr bool PERM = true, AFTER_DRAIN = false, TWO_STAGE = false;
    bf16* O; int ldc;
    DI void operator()(const pg8::f32x4 (&acc)[2][2][4][2], const pg8::Unit& u, int wr, int wc, int fr, int fq) const {
        const int row0 = u.pm * 256 + wr * 64 + fr, col0 = u.pn * 256 + wc * 32 + 8 * fq;
#pragma unroll
        for (int ai = 0; ai < 2; ++ai)
#pragma unroll
            for (int m = 0; m < 4; ++m) {
                bf16* rowp = O + (size_t)(row0 + ai * 128 + m * 16) * ldc + col0;
#pragma unroll
                for (int bj = 0; bj < 2; ++bj) {
                    const f32x4 v0 = acc[ai][bj][m][0], v1 = acc[ai][bj][m][1];
                    u32x4 w; w.x = pg8::cvt_pk_bf16(v0[0], v0[1]); w.y = pg8::cvt_pk_bf16(v0[2], v0[3]); w.z = pg8::cvt_pk_bf16(v1[0], v1[1]); w.w = pg8::cvt_pk_bf16(v1[2], v1[3]);
                    *(u32x4*)(rowp + bj * 128) = w;
                }
            }
    }
};

template <bool ADD> struct EpiMerge {
    static constexpr bool PERM = true, AFTER_DRAIN = false, TWO_STAGE = false;
    bf16* Y; const unsigned char* G; int goff; float gs;
    DI void operator()(const pg8::f32x4 (&acc)[2][2][4][2], const pg8::Unit& u, int wr, int wc, int fr, int fq) const {
        const int row0 = u.pm * 256 + wr * 64 + fr, col0 = u.pn * 256 + wc * 32 + 8 * fq;
#pragma unroll
        for (int ai = 0; ai < 2; ++ai)
#pragma unroll
            for (int m = 0; m < 4; ++m) {
                const size_t row = (size_t)(row0 + ai * 128 + m * 16);
#pragma unroll
                for (int bj = 0; bj < 2; ++bj) {
                    const f32x4 v0 = acc[ai][bj][m][0], v1 = acc[ai][bj][m][1];
                    const u32x2 g = __builtin_nontemporal_load((const u32x2*)(G + row * 4096 + goff + col0 + bj * 128));
                    float r[8];
#pragma unroll
                    for (int i = 0; i < 4; ++i) { r[i] = (float)((g.x >> (8 * i)) & 0xffu) * gs * v0[i]; r[4 + i] = (float)((g.y >> (8 * i)) & 0xffu) * gs * v1[i]; }
                    bf16* yp = Y + row * 2048 + col0 + bj * 128;
                    if (ADD) {
                        const u32x4 y = *(const u32x4*)yp;
                        r[0] += bflo(y.x); r[1] += bfhi(y.x); r[2] += bflo(y.y); r[3] += bfhi(y.y); r[4] += bflo(y.z); r[5] += bfhi(y.z); r[6] += bflo(y.w); r[7] += bfhi(y.w);
                    }
                    u32x4 w; w.x = pg8::cvt_pk_bf16(r[0], r[1]); w.y = pg8::cvt_pk_bf16(r[2], r[3]); w.z = pg8::cvt_pk_bf16(r[4], r[5]); w.w = pg8::cvt_pk_bf16(r[6], r[7]);
                    *(u32x4*)yp = w;
                }
            }
    }
};

struct EpiMerge2 {
    static constexpr bool PERM = true, AFTER_DRAIN = false, TWO_STAGE = true;
    bf16* Y; const unsigned char* G;
    DI void mid(pg8::f32x4 (&acc)[2][2][4][2], const pg8::Unit& u, int wr, int wc, int fr, int fq) const {
        const int row0 = u.pm * 256 + wr * 64 + fr, col0 = u.pn * 256 + wc * 32 + 8 * fq;
#pragma unroll
        for (int ai = 0; ai < 2; ++ai)
#pragma unroll
            for (int m = 0; m < 4; ++m) {
                const size_t row = (size_t)(row0 + ai * 128 + m * 16);
#pragma unroll
                for (int bj = 0; bj < 2; ++bj) {
                    const u32x2 ga = __builtin_nontemporal_load((const u32x2*)(G + row * 4096 + col0 + bj * 128));
                    const u32x2 gd = *(const u32x2*)(G + row * 4096 + 2048 + col0 + bj * 128);
#pragma unroll
                    for (int i = 0; i < 4; ++i) {
                        acc[ai][bj][m][0][i] *= (float)((ga.x >> (8 * i)) & 0xffu) * __builtin_amdgcn_rcpf(fmaxf((float)((gd.x >> (8 * i)) & 0xffu), 1.f));
                        acc[ai][bj][m][1][i] *= (float)((ga.y >> (8 * i)) & 0xffu) * __builtin_amdgcn_rcpf(fmaxf((float)((gd.y >> (8 * i)) & 0xffu), 1.f));
                    }
                }
            }
    }
    DI void operator()(const pg8::f32x4 (&acc)[2][2][4][2], const pg8::Unit& u, int wr, int wc, int fr, int fq) const {
        const int row0 = u.pm * 256 + wr * 64 + fr, col0 = u.pn * 256 + wc * 32 + 8 * fq;
#pragma unroll
        for (int ai = 0; ai < 2; ++ai)
#pragma unroll
            for (int m = 0; m < 4; ++m) {
                const size_t row = (size_t)(row0 + ai * 128 + m * 16);
#pragma unroll
                for (int bj = 0; bj < 2; ++bj) {
                    const f32x4 v0 = acc[ai][bj][m][0], v1 = acc[ai][bj][m][1];
                    const u32x2 g = __builtin_nontemporal_load((const u32x2*)(G + row * 4096 + 2048 + col0 + bj * 128));
                    float r[8];
#pragma unroll
                    for (int i = 0; i < 4; ++i) { r[i] = fmaxf((float)((g.x >> (8 * i)) & 0xffu), 1.f) * (1.f / 255.f) * v0[i]; r[4 + i] = fmaxf((float)((g.y >> (8 * i)) & 0xffu), 1.f) * (1.f / 255.f) * v1[i]; }
                    u32x4 w; w.x = pg8::cvt_pk_bf16(r[0], r[1]); w.y = pg8::cvt_pk_bf16(r[2], r[3]); w.z = pg8::cvt_pk_bf16(r[4], r[5]); w.w = pg8::cvt_pk_bf16(r[6], r[7]);
                    *(u32x4*)(Y + row * 2048 + col0 + bj * 128) = w;
                }
            }
    }
};

struct EpiResid {
    static constexpr bool PERM = true, AFTER_DRAIN = false, TWO_STAGE = false;
    const float* x; bf16* X1; const float* mod;
    DI void operator()(const pg8::f32x4 (&acc)[2][2][4][2], const pg8::Unit& u, int wr, int wc, int fr, int fq) const {
        const int row0 = u.pm * 256 + wr * 64 + fr, col0 = u.pn * 256 + wc * 32 + 8 * fq;
        const float* g1 = mod + (size_t)(u.pm >> 4) * 12288 + 2 * 2048;
        f32x4 gv[2][2];
#pragma unroll
        for (int bj = 0; bj < 2; ++bj)
#pragma unroll
            for (int n = 0; n < 2; ++n) gv[bj][n] = *(const f32x4*)(g1 + col0 + bj * 128 + n * 4);
#pragma unroll
        for (int ai = 0; ai < 2; ++ai)
#pragma unroll
            for (int m = 0; m < 4; ++m) {
                const size_t off = (size_t)(row0 + ai * 128 + m * 16) * 2048 + col0;
#pragma unroll
                for (int bj = 0; bj < 2; ++bj) {
                    const f32x4 x0 = __builtin_nontemporal_load((const f32x4*)(x + off + bj * 128)), x1 = __builtin_nontemporal_load((const f32x4*)(x + off + bj * 128 + 4));
                    const f32x4 v0 = x0 + gv[bj][0] * acc[ai][bj][m][0], v1 = x1 + gv[bj][1] * acc[ai][bj][m][1];
                    u32x4 w; w.x = pk2(v0[0], v0[1]); w.y = pk2(v0[2], v0[3]); w.z = pk2(v1[0], v1[1]); w.w = pk2(v1[2], v1[3]);
                    *(u32x4*)(X1 + off + bj * 128) = w;
                }
            }
    }
};

DI void transpose_item(const float* W, int K, int Nsrc, int sn0, bf16* WT, int dn0, int k0, LAS float* scr, int lane) {
    if (sn0 >= 0) {
        float t[32];
#pragma unroll
        for (int i = 0; i < 32; ++i) t[i] = __builtin_nontemporal_load(&W[(size_t)(k0 + 2 * i + (lane >> 5)) * Nsrc + sn0 + (lane & 31)]);
#pragma unroll
        for (int i = 0; i < 32; ++i) scr[(2 * i + (lane >> 5)) * 33 + (lane & 31)] = t[i];
    } else {
#pragma unroll 8
        for (int i = 0; i < 32; ++i) { const int kk = 2 * i + (lane >> 5); scr[kk * 33 + (lane & 31)] = 0.f; }
    }
    asm volatile("s_waitcnt lgkmcnt(0)" ::: "memory");
    const int c = lane & 7;
#pragma unroll
    for (int j = 0; j < 4; ++j) {
        const int n = (lane >> 3) + 8 * j; const LAS float* s = scr + (8 * c) * 33 + n;
        u32x4 o; o.x = pk2(s[0 * 33], s[1 * 33]); o.y = pk2(s[2 * 33], s[3 * 33]); o.z = pk2(s[4 * 33], s[5 * 33]); o.w = pk2(s[6 * 33], s[7 * 33]);
        *(u32x4*)(WT + (size_t)(dn0 + n) * K + k0 + 8 * c) = o;
    }
    asm volatile("s_waitcnt lgkmcnt(0)" ::: "memory");
}

DI void transpose_item_fp8(const float* W, int K, int Nsrc, int sn0, unsigned char* WT, int dn0, int k0, float scale, LAS float* scr, int lane) {
    if (sn0 >= 0) {
        float t[32];
#pragma unroll
        for (int i = 0; i < 32; ++i) t[i] = __builtin_nontemporal_load(&W[(size_t)(k0 + 2 * i + (lane >> 5)) * Nsrc + sn0 + (lane & 31)]);
#pragma unroll
        for (int i = 0; i < 32; ++i) scr[(2 * i + (lane >> 5)) * 33 + (lane & 31)] = t[i] * scale;
    } else {
#pragma unroll 8
        for (int i = 0; i < 32; ++i) { const int kk = 2 * i + (lane >> 5); scr[kk * 33 + (lane & 31)] = 0.f; }
    }
    asm volatile("s_waitcnt lgkmcnt(0)" ::: "memory");
    const int c = lane & 7;
#pragma unroll
    for (int j = 0; j < 4; ++j) {
        const int n = (lane >> 3) + 8 * j; const LAS float* s = scr + (8 * c) * 33 + n;
        u32x2 o; o.x = pk4_fp8(s[0 * 33], s[1 * 33], s[2 * 33], s[3 * 33]); o.y = pk4_fp8(s[4 * 33], s[5 * 33], s[6 * 33], s[7 * 33]);
        *(u32x2*)(WT + (size_t)(dn0 + n) * K + k0 + 8 * c) = o;
    }
    asm volatile("s_waitcnt lgkmcnt(0)" ::: "memory");
}

DI void cvt_bf16_stream(const float* src, bf16* dst, size_t n8, size_t gtid, size_t nthr) {
    for (size_t i = gtid; i < n8; i += nthr) {
        const f32x4 a = *(const f32x4*)(src + i * 8), b = *(const f32x4*)(src + i * 8 + 4);
        u32x4 w; w.x = pk2(a[0], a[1]); w.y = pk2(a[2], a[3]); w.z = pk2(b[0], b[1]); w.w = pk2(b[2], b[3]);
        *(u32x4*)(dst + i * 8) = w;
    }
}

DI void phase_prologue(Frame& F) {
    LAS float* scr = (LAS float*)(F.lds + F.wave * 16384);
    constexpr int I_WIN = 32 * 312, I_WB = 16 * 64, I_WO = 32 * 64;
    constexpr int NITEMS = I_WIN + 2 * I_WB + 2 * I_WO;
#ifndef PRO_REP_T
#define PRO_REP_T 1
#endif
#ifndef PRO_REP_G
#define PRO_REP_G 1
#endif
#pragma nounroll
    for (int rep_t = 0; rep_t < PRO_REP_T; ++rep_t)
    for (int it = F.gw; it < NITEMS; it += F.NGW) {
        int r = it;
        if (r < I_WIN) { const int kb = r / 312, nb = r % 312; const int snb = nb < 176 ? nb : (nb < 304 ? nb + 1 : (nb == 304 ? 176 : -1));
            transpose_item_fp8(F.in[8], DM, INW, snb < 0 ? -1 : snb * 32, F.ws + WS_WIN, nb * 32, kb * 64, WIN_SCALE, scr, F.lane); continue; }
        r -= I_WIN;
        if (r < I_WB) {
            if (MERGE_F8_A) transpose_item_fp8(F.in[15], 1024, DM, (r % 64) * 32, F.ws + WS_WBA, (r % 64) * 32, (r / 64) * 64, WB_SCALE, scr, F.lane);
            else transpose_item(F.in[15], 1024, DM, (r % 64) * 32, (bf16*)(F.ws + WS_WBA), (r % 64) * 32, (r / 64) * 64, scr, F.lane);
            continue; }
        r -= I_WB;
        if (r < I_WB) {
            if (MERGE_F8_B) transpose_item_fp8(F.in[16], 1024, DM, (r % 64) * 32, F.ws + WS_WBD, (r % 64) * 32, (r / 64) * 64, WB_SCALE, scr, F.lane);
            else transpose_item(F.in[16], 1024, DM, (r % 64) * 32, (bf16*)(F.ws + WS_WBD), (r % 64) * 32, (r / 64) * 64, scr, F.lane);
            continue; }
        r -= I_WB;
        if (r < I_WO) { transpose_item(F.in[17], DM, DM, (r % 64) * 32, (bf16*)(F.ws + WS_WOUT), (r % 64) * 32, (r / 64) * 64, scr, F.lane); continue; }
        r -= I_WO;
        transpose_item(F.in[18], DM, DM, (r % 64) * 32, (bf16*)(F.ws + WS_WQ), (r % 64) * 32, (r / 64) * 64, scr, F.lane);
    }
    cvt_bf16_stream(F.in[19], (bf16*)(F.ws + WS_SUBK), (size_t)8 * 2 * 128 * 128 / 8, (size_t)blockIdx.x * 512 + F.tid, (size_t)F.G * 512);
    LAS float* sc = (LAS float*)(F.lds + 131072);
    const float* ada_w = F.in[4];
    float* MODP = (float*)(F.ws + WS_MODP);
#pragma nounroll
    for (int rep_g = 0; rep_g < PRO_REP_G; ++rep_g)
    for (int it = blockIdx.x; it < 32 * 24; it += F.G) {
        const int kc = it / 24, nb = it % 24, n = nb * 512 + F.tid;
        __syncthreads();
        if (F.tid < 320) { const int r = F.tid >> 6, kk = F.tid & 63, k = kc * 64 + kk; const float cv = (r < 4) ? F.in[1][r * DM + k] : F.in[3][k]; sc[r * 64 + kk] = silu(cv); }
        __syncthreads();
        float a0 = 0.f, a1 = 0.f, a2 = 0.f, a3 = 0.f, a4 = 0.f;
#pragma unroll 32
        for (int kk = 0; kk < 64; ++kk) {
            const float w = __builtin_nontemporal_load(&ada_w[(size_t)(kc * 64 + kk) * 12288 + n]);
            a0 += sc[kk] * w; a1 += sc[64 + kk] * w; a2 += sc[128 + kk] * w; a3 += sc[192 + kk] * w; a4 += sc[256 + kk] * w;
        }
        float* o = MODP + (size_t)kc * 5 * 12288 + n;
        o[0] = a0; o[12288] = a1; o[2 * 12288] = a2; o[3 * 12288] = a3; o[4 * 12288] = a4;
    }
}

DI void phase_modreduce(Frame& F) {
    const float* MODP = (const float*)(F.ws + WS_MODP); float* MOD = (float*)(F.ws + WS_MOD); const float* ada_b = F.in[5];
    for (int i = blockIdx.x * 512 + F.tid; i < 5 * 12288; i += F.G * 512) {
        const int n = i % 12288; float s = ada_b[n];
#pragma unroll 8
        for (int kc = 0; kc < 32; ++kc) s += MODP[(size_t)kc * 5 * 12288 + i];
        MOD[i] = s;
    }
}

DI void modnorm_row(const float* xrow, bf16* orow, const float* nw, const float* sc, const float* sh, int lane) {
    f32x4 v[8]; float ss = 0.f;
#pragma unroll
    for (int j = 0; j < 8; ++j) { v[j] = *((const f32x4*)xrow + lane + 64 * j); ss += (v[j][0] * v[j][0] + v[j][1] * v[j][1]) + (v[j][2] * v[j][2] + v[j][3] * v[j][3]); }
    const float rstd = rsqrtf(wave_sum(ss) * (1.f / DM) + EPS);
#pragma unroll
    for (int j = 0; j < 8; ++j) {
        const int c = (lane + 64 * j) * 4;
        const f32x4 w = *(const f32x4*)(nw + c), s = *(const f32x4*)(sc + c), h = *(const f32x4*)(sh + c);
        f32x4 o;
#pragma unroll
        for (int i = 0; i < 4; ++i) o[i] = (v[j][i] * rstd * w[i]) * (1.f + s[i]) + h[i];
        u32x2 p; p.x = pk2(o[0], o[1]); p.y = pk2(o[2], o[3]);
        *(u32x2*)(orow + c) = p;
    }
}

DI void modnorm_row_bf(const bf16* xrow, bf16* orow, const float* nw, const float* sc, const float* sh, int lane) {
    f32x4 v[8]; float ss = 0.f;
#pragma unroll
    for (int j = 0; j < 8; ++j) { const u32x2 w = *((const u32x2*)xrow + lane + 64 * j); v[j] = (f32x4){bflo(w.x), bfhi(w.x), bflo(w.y), bfhi(w.y)}; ss += (v[j][0] * v[j][0] + v[j][1] * v[j][1]) + (v[j][2] * v[j][2] + v[j][3] * v[j][3]); }
    const float rstd = rsqrtf(wave_sum(ss) * (1.f / DM) + EPS);
#pragma unroll
    for (int j = 0; j < 8; ++j) {
        const int c = (lane + 64 * j) * 4;
        const f32x4 w = *(const f32x4*)(nw + c), s = *(const f32x4*)(sc + c), h = *(const f32x4*)(sh + c);
        f32x4 o;
#pragma unroll
        for (int i = 0; i < 4; ++i) o[i] = (v[j][i] * rstd * w[i]) * (1.f + s[i]) + h[i];
        u32x2 p; p.x = pk2(o[0], o[1]); p.y = pk2(o[2], o[3]);
        *(u32x2*)(orow + c) = p;
    }
}

DI void modnorm_row_fp8(const float* xrow, unsigned char* orow, const float* nw, const float* sc, const float* sh, int lane) {
    f32x4 v[8]; float ss = 0.f;
#pragma unroll
    for (int j = 0; j < 8; ++j) { v[j] = __builtin_nontemporal_load((const f32x4*)xrow + lane + 64 * j); ss += (v[j][0] * v[j][0] + v[j][1] * v[j][1]) + (v[j][2] * v[j][2] + v[j][3] * v[j][3]); }
    const float rstd = rsqrtf(wave_sum(ss) * (1.f / DM) + EPS);
#pragma unroll
    for (int j = 0; j < 8; ++j) {
        const int c = (lane + 64 * j) * 4;
        const f32x4 w = *(const f32x4*)(nw + c), s = *(const f32x4*)(sc + c), h = *(const f32x4*)(sh + c);
        f32x4 o;
#pragma unroll
        for (int i = 0; i < 4; ++i) o[i] = (v[j][i] * rstd * w[i]) * (1.f + s[i]) + h[i];
        *(unsigned*)(orow + c) = pk4_fp8(o[0], o[1], o[2], o[3]);
    }
}

struct ModPar { f32x4 a[8], h[8]; };
DI void modpar_load(ModPar& P, const float* nw, const float* sc, const float* sh, int lane) {
#pragma unroll
    for (int j = 0; j < 8; ++j) { const int c = (lane + 64 * j) * 4; const f32x4 w = *(const f32x4*)(nw + c), s = *(const f32x4*)(sc + c); P.a[j] = w * (1.f + s); P.h[j] = *(const f32x4*)(sh + c); }
}
DI void modnorm_rows_fp8(const float* x0, unsigned char* o0, int nrows, const ModPar& P, int lane) {
    f32x4 v[8];
#pragma unroll
    for (int j = 0; j < 8; ++j) v[j] = __builtin_nontemporal_load((const f32x4*)x0 + lane + 64 * j);
    for (int r = 0; r < nrows; ++r) {
        float ss = 0.f;
#pragma unroll
        for (int j = 0; j < 8; ++j) ss += (v[j][0] * v[j][0] + v[j][1] * v[j][1]) + (v[j][2] * v[j][2] + v[j][3] * v[j][3]);
        const float rstd = rsqrtf(wave_sum(ss) * (1.f / DM) + EPS);
        unsigned char* orow = o0 + (size_t)r * DM;
        const float* xn = x0 + (size_t)(r + 1 < nrows ? r + 1 : r) * DM;
#pragma unroll
        for (int j = 0; j < 8; ++j) {
            const f32x4 o = (v[j] * rstd) * P.a[j] + P.h[j];
            v[j] = __builtin_nontemporal_load((const f32x4*)xn + lane + 64 * j);
            *(unsigned*)(orow + (lane + 64 * j) * 4) = pk4_fp8(o[0], o[1], o[2], o[3]);
        }
    }
}
DI void modnorm_rows_bf(const bf16* x0, bf16* o0, int nrows, const ModPar& P, int lane) {
    u32x2 w[8];
#pragma unroll
    for (int j = 0; j < 8; ++j) w[j] = *((const u32x2*)x0 + lane + 64 * j);
    for (int r = 0; r < nrows; ++r) {
        f32x4 v[8]; float ss = 0.f;
#pragma unroll
        for (int j = 0; j < 8; ++j) { v[j] = (f32x4){bflo(w[j].x), bfhi(w[j].x), bflo(w[j].y), bfhi(w[j].y)}; ss += (v[j][0] * v[j][0] + v[j][1] * v[j][1]) + (v[j][2] * v[j][2] + v[j][3] * v[j][3]); }
        const float rstd = rsqrtf(wave_sum(ss) * (1.f / DM) + EPS);
        bf16* orow = o0 + (size_t)r * DM;
        const bf16* xn = x0 + (size_t)(r + 1 < nrows ? r + 1 : r) * DM;
#pragma unroll
        for (int j = 0; j < 8; ++j) {
            const f32x4 o = (v[j] * rstd) * P.a[j] + P.h[j];
            w[j] = *((const u32x2*)xn + lane + 64 * j);
            u32x2 p; p.x = pk2(o[0], o[1]); p.y = pk2(o[2], o[3]);
            *(u32x2*)(orow + (lane + 64 * j) * 4) = p;
        }
    }
}

DI void phase_h1(Frame& F) {
    const float* MOD = (const float*)(F.ws + WS_MOD); unsigned char* H = F.ws + WS_H;
    ModPar P;
    {
        constexpr int RPW = NT / (256 * NWAVES);
        const int m0 = F.gw * RPW, r = m0 >> 12;
        if (F.NGW == 256 * NWAVES) {
            modpar_load(P, F.in[6], MOD + (size_t)r * 12288 + 2048, MOD + (size_t)r * 12288, F.lane);
            modnorm_rows_fp8(F.in[0] + (size_t)m0 * DM, H + (size_t)m0 * DM, RPW, P, F.lane);
        } else {
            for (int m = F.gw; m < NT; m += F.NGW) { modpar_load(P, F.in[6], MOD + (size_t)(m >> 12) * 12288 + 2048, MOD + (size_t)(m >> 12) * 12288, F.lane); modnorm_rows_fp8(F.in[0] + (size_t)m * DM, H + (size_t)m * DM, 1, P, F.lane); }
        }
    }
    if (F.gw < NC) {
        modpar_load(P, F.in[6], MOD + (size_t)4 * 12288 + 2048, MOD + (size_t)4 * 12288, F.lane);
        for (int m = F.gw; m < NC; m += F.NGW) modnorm_rows_fp8(F.in[2] + (size_t)m * DM, H + (size_t)(NT + m) * DM, 1, P, F.lane);
    }
}

DI void phase_postproj(Frame& F) {
    const int lane = F.lane, tid = F.tid;
    LAS float* tcs = (LAS float*)F.lds;
    for (int i = tid; i < 2048; i += 512) { const int pos = i >> 5, f = i & 31; float sn, cs; sincosf((float)pos * exp2f(-(float)f * (13.287712379549449f / 32.f)), &sn, &cs); tcs[i] = cs; tcs[2048 + i] = sn; }
    __syncthreads();
    {
        bf16* QN = (bf16*)(F.ws + WS_QN); bf16* KB = (bf16*)(F.ws + WS_KB);
        const int j = lane & 7, axis = j >> 2, fg = j & 3, d1 = axis * 64 + 8 * fg;
        f32x4 qw[4], kw[4];
        qw[0] = *(const f32x4*)(F.in[9] + d1); qw[1] = *(const f32x4*)(F.in[9] + d1 + 4); qw[2] = *(const f32x4*)(F.in[9] + d1 + 32); qw[3] = *(const f32x4*)(F.in[9] + d1 + 36);
        kw[0] = *(const f32x4*)(F.in[10] + d1); kw[1] = *(const f32x4*)(F.in[10] + d1 + 4); kw[2] = *(const f32x4*)(F.in[10] + d1 + 32); kw[3] = *(const f32x4*)(F.in[10] + d1 + 36);
        constexpr int NQI = NT, NKI = NB * LKV / 4;
        for (int it = F.gw; it < NQI + NKI; it += F.NGW) {
            bf16* p; int t; bool rope; const bool isq = it < NQI;
            if (isq) { p = QN + (size_t)it * 1024 + (lane >> 3) * 128; t = it & 4095; rope = true; }
            else { const int row = (it - NQI) * 4 + (lane >> 4), pp = row % LKV; p = KB + (size_t)row * 256 + ((lane >> 3) & 1) * 128; t = pp; rope = pp < TS; }
            const u32x4 w1 = *(const u32x4*)(p + d1), w2 = *(const u32x4*)(p + d1 + 32);
            float x1[8], x2[8];
            x1[0] = bflo(w1.x); x1[1] = bfhi(w1.x); x1[2] = bflo(w1.y); x1[3] = bfhi(w1.y); x1[4] = bflo(w1.z); x1[5] = bfhi(w1.z); x1[6] = bflo(w1.w); x1[7] = bfhi(w1.w);
            x2[0] = bflo(w2.x); x2[1] = bfhi(w2.x); x2[2] = bflo(w2.y); x2[3] = bfhi(w2.y); x2[4] = bflo(w2.z); x2[5] = bfhi(w2.z); x2[6] = bflo(w2.w); x2[7] = bfhi(w2.w);
            float ss = 0.f;
#pragma unroll
            for (int i = 0; i < 8; ++i) ss += x1[i] * x1[i] + x2[i] * x2[i];
            ss += __shfl_xor(ss, 1); ss += __shfl_xor(ss, 2); ss += __shfl_xor(ss, 4);
            const float rstd = rsqrtf(ss * (1.f / 128.f) + EPS);
            const int pos = axis == 0 ? (t >> 6) : (t & 63);
            float o1[8], o2[8];
#pragma unroll
            for (int i = 0; i < 8; ++i) {
                const float wa = isq ? qw[i >> 2][i & 3] : kw[i >> 2][i & 3], wb = isq ? qw[2 + (i >> 2)][i & 3] : kw[2 + (i >> 2)][i & 3];
                const float y1 = x1[i] * rstd * wa, y2 = x2[i] * rstd * wb;
                const float cs = rope ? tcs[pos * 32 + 8 * fg + i] : 1.f, sn = rope ? tcs[2048 + pos * 32 + 8 * fg + i] : 0.f;
                o1[i] = y1 * cs - y2 * sn; o2[i] = y2 * cs + y1 * sn;
            }
            u32x4 r1, r2;
            r1.x = pk2(o1[0], o1[1]); r1.y = pk2(o1[2], o1[3]); r1.z = pk2(o1[4], o1[5]); r1.w = pk2(o1[6], o1[7]);
            r2.x = pk2(o2[0], o2[1]); r2.y = pk2(o2[2], o2[3]); r2.z = pk2(o2[4], o2[5]); r2.w = pk2(o2[6], o2[7]);
            *(u32x4*)(p + d1) = r1; *(u32x4*)(p + d1 + 32) = r2;
        }
    }
    {
        const bf16* RAW = (const bf16*)(F.ws + WS_DNRAW); const float* cw = F.in[11];
        for (int it = F.gw; it < (MTOT / 16) * 6; it += F.NGW) {
            const int tc = it / 6, grp = it % 6, m0 = tc * 16, part = grp >> 1;
            int start, len; if (m0 < NT) { start = m0 & ~4095; len = TS; } else { start = NT + ((m0 - NT) & ~255); len = CL; }
            const int pos0 = m0 - start, c = grp * 512 + 8 * lane;
            float wv[5][8];
#pragma unroll
            for (int jj = 0; jj < 5; ++jj) { const f32x4 a = *(const f32x4*)(cw + jj * 3072 + c), b = *(const f32x4*)(cw + jj * 3072 + c + 4);
                wv[jj][0] = a[0]; wv[jj][1] = a[1]; wv[jj][2] = a[2]; wv[jj][3] = a[3]; wv[jj][4] = b[0]; wv[jj][5] = b[1]; wv[jj][6] = b[2]; wv[jj][7] = b[3]; }
            u32x4 rows[20];
#pragma unroll
            for (int r = 0; r < 20; ++r) { const int pp = pos0 + r - 2; rows[r] = (pp >= 0 && pp < len) ? *(const u32x4*)(RAW + (size_t)(start + pp) * 3072 + c) : (u32x4){0u, 0u, 0u, 0u}; }
            bf16* dst = (bf16*)(F.ws + (part == 0 ? WS_DQ : (part == 1 ? WS_DK : WS_DV))) + dn_off(m0, (grp & 1) * 4 + (lane >> 4)) + 8 * (lane & 15);
#pragma unroll
            for (int tk = 0; tk < 16; ++tk) {
                float a[8];
#pragma unroll
                for (int i = 0; i < 8; ++i) a[i] = 0.f;
#pragma unroll
                for (int jj = 0; jj < 5; ++jj) { const u32x4 w = rows[tk + jj];
                    a[0] += wv[jj][0] * bflo(w.x); a[1] += wv[jj][1] * bfhi(w.x); a[2] += wv[jj][2] * bflo(w.y); a[3] += wv[jj][3] * bfhi(w.y);
                    a[4] += wv[jj][4] * bflo(w.z); a[5] += wv[jj][5] * bfhi(w.z); a[6] += wv[jj][6] * bflo(w.w); a[7] += wv[jj][7] * bfhi(w.w); }
                float ss = 0.f;
#pragma unroll
                for (int i = 0; i < 8; ++i) { a[i] = silu(a[i]); ss += a[i] * a[i]; }
                if (part < 2) {
                    ss += __shfl_xor(ss, 1); ss += __shfl_xor(ss, 2); ss += __shfl_xor(ss, 4); ss += __shfl_xor(ss, 8);
                    const float r = rsqrtf(ss + EPS) * (part == 0 ? 0.088388347648318440f : 1.f);
#pragma unroll
                    for (int i = 0; i < 8; ++i) a[i] *= r;
                }
                u32x4 o; o.x = pk2(a[0], a[1]); o.y = pk2(a[2], a[3]); o.z = pk2(a[4], a[5]); o.w = pk2(a[6], a[7]);
                *(u32x4*)(dst + tk * 128) = o;
            }
        }
    }
}

DI void phase_dn_naive(Frame& F) {
    if (F.wave != 0 || blockIdx.x >= 128) return;
    const int item = blockIdx.x, dir = item >> 6, b = (item >> 4) & 3, h = (item >> 1) & 7, half = item & 1, lane = F.lane;
    const bf16* DQ = (const bf16*)(F.ws + WS_DQ); const bf16* DK = (const bf16*)(F.ws + WS_DK); const bf16* DV = (const bf16*)(F.ws + WS_DV);
    const float* BETA = (const float*)(F.ws + WS_BETA); const float* LOGA = (const float*)(F.ws + WS_LOGA);
    bf16* ODN = (bf16*)(F.ws + WS_ODN);
    float S[128];
#pragma unroll
    for (int i = 0; i < 128; ++i) S[i] = 0.f;
    for (int step = 0; step < LKV; ++step) {
        const bool isl = step >= CL; const int p = isl ? step - CL : step, len = isl ? TS : CL, pos = dir ? len - 1 - p : p;
        const int m = isl ? b * TS + pos : NT + b * CL + pos;
        const unsigned kw = *(const unsigned*)(DK + dn_off(m, h) + 2 * lane);
        const unsigned qw = *(const unsigned*)(DQ + dn_off(m, h) + 2 * lane);
        const float vj = bf2f(DV[dn_off(m, h) + half * 64 + lane]);
        const float a = __expf(LOGA[(size_t)m * 16 + dir * 8 + h]), bt = BETA[(size_t)m * 16 + dir * 8 + h];
        float k0 = 0.f, k1 = 0.f, k2 = 0.f, k3 = 0.f;
#pragma unroll
        for (int i = 0; i < 64; i += 2) {
            const unsigned w0 = rdlane(kw, i), w1 = rdlane(kw, i + 1);
            k0 += bflo(w0) * S[2 * i]; k1 += bfhi(w0) * S[2 * i + 1]; k2 += bflo(w1) * S[2 * i + 2]; k3 += bfhi(w1) * S[2 * i + 3];
        }
        const float kS = (k0 + k1) + (k2 + k3);
        const float coef = bt * (vj - a * kS);
#pragma unroll
        for (int i = 0; i < 64; ++i) { const unsigned w0 = rdlane(kw, i); S[2 * i] = a * S[2 * i] + coef * bflo(w0); S[2 * i + 1] = a * S[2 * i + 1] + coef * bfhi(w0); }
        if (isl) {
            float o0 = 0.f, o1 = 0.f, o2 = 0.f, o3 = 0.f;
#pragma unroll
            for (int i = 0; i < 64; i += 2) {
                const unsigned w0 = rdlane(qw, i), w1 = rdlane(qw, i + 1);
                o0 += bflo(w0) * S[2 * i]; o1 += bfhi(w0) * S[2 * i + 1]; o2 += bflo(w1) * S[2 * i + 2]; o3 += bfhi(w1) * S[2 * i + 3];
            }
            ODN[((size_t)dir * NT + m) * 1024 + h * 128 + half * 64 + lane] = (bf16)f2bf((o0 + o1) + (o2 + o3));
        }
    }
}

DI int dn_row0(int b, int cc) { return cc < 4 ? NT + b * CL + 64 * cc : b * TS + 64 * (cc - 4); }
typedef short bf16x8_t __attribute__((ext_vector_type(8)));
#define MFMA16(a, b, c) __builtin_amdgcn_mfma_f32_16x16x32_bf16((a), (b), (c), 0, 0, 0)

DI bf16x8_t dn_afrag(const LAS unsigned char* p) {
    const u32x2 lo = *(const LAS u32x2*)p, hi = *(const LAS u32x2*)(p + 32);
    u32x4 v; v.x = lo.x; v.y = lo.y; v.z = hi.x; v.w = hi.y; return __builtin_bit_cast(bf16x8_t, v);
}
DI bf16x8_t dn_bpack(const f32x4 t0, const f32x4 t1) {
    u32x4 v; v.x = pk2(t0[0], t0[1]); v.y = pk2(t0[2], t0[3]); v.z = pk2(t1[0], t1[1]); v.w = pk2(t1[2], t1[3]); return __builtin_bit_cast(bf16x8_t, v);
}
DI void phase_dn_prep(Frame& F) {
    LAS unsigned char* L = F.lds;
    constexpr int KS = 0, QS = 17408, VC = 34816, AP = 35840;
    constexpr int NITEM = NB * 8 * 68, NBATCH = (NITEM + 2) / 3;
    const bf16* DQ = (const bf16*)(F.ws + WS_DQ); const bf16* DK = (const bf16*)(F.ws + WS_DK);
    const float* BETA = (const float*)(F.ws + WS_BETA); const float* LOGA = (const float*)(F.ws + WS_LOGA);
    bf16* KT = (bf16*)(F.ws + WS_KT); bf16* TINV = (bf16*)(F.ws + WS_TINV); bf16* QKO = (bf16*)(F.ws + WS_QKO); float* VEC = (float*)(F.ws + WS_VEC);
    const int tid = F.tid, wave = F.wave;
    LAS float* vg = (LAS float*)(L + VC); LAS float* vb = vg + 128;
    for (int batch = F.vcu; batch < NBATCH; batch += F.G) {
        int lane = F.lane; asm volatile("" : "+v"(lane));
        const int fr = lane & 15, fq = lane >> 4;
#pragma unroll 1
        for (int c3 = 0; c3 < 3; ++c3) {
            const int item = batch * 3 + c3;
            if (item >= NITEM) break;
            const int b = item / 544, h = (item % 544) / 68, cc = item % 68, row0 = dn_row0(b, cc);
#pragma unroll
            for (int k = 0; k < 4; ++k) {
                const int c = tid + 512 * k, which = c >> 10, c2 = c & 1023, row = c2 >> 4, c16 = c2 & 15;
                const u32x4 v = *(const u32x4*)((which ? DQ : DK) + (size_t)item * 8192 + c2 * 8);
                *(LAS u32x4*)(L + (which ? QS : KS) + row * 272 + c16 * 16) = v;
            }
            if (wave < 2) {
                const int d = wave, i = lane;
                const float la = LOGA[(size_t)(row0 + i) * 16 + d * 8 + h], bt = BETA[(size_t)(row0 + i) * 16 + d * 8 + h];
                float x = la;
                if (d == 0) {
#pragma unroll
                    for (int o = 1; o < 64; o <<= 1) { const float y = __shfl_up(x, o); if (i >= o) x += y; }
                } else {
#pragma unroll
                    for (int o = 1; o < 64; o <<= 1) { const float y = __shfl_down(x, o); if (i + o < 64) x += y; }
                }
                const float glast = __shfl(x, d == 0 ? 63 : 0);
                vg[d * 64 + i] = x; vb[d * 64 + i] = bt;
                float* ve = VEC + (size_t)(item * 2 + d) * 320;
                const float eg = __expf(x);
                ve[i] = bt; ve[64 + i] = eg; ve[128 + i] = bt * eg; ve[192 + i] = __expf(glast - x); ve[256 + i] = __expf(glast);
            }
            __syncthreads();
            {
                bf16* kt = KT + (size_t)item * 8192;
#pragma unroll
                for (int k = 0; k < 2; ++k) {
                    const int c = tid + 512 * k, dk = c >> 3, t8 = c & 7;
                    unsigned short e[8];
#pragma unroll
                    for (int q = 0; q < 8; ++q) e[q] = *(const LAS unsigned short*)(L + KS + (8 * t8 + q) * 272 + dk * 2);
                    u32x4 w; w.x = e[0] | ((unsigned)e[1] << 16); w.y = e[2] | ((unsigned)e[3] << 16); w.z = e[4] | ((unsigned)e[5] << 16); w.w = e[6] | ((unsigned)e[7] << 16);
                    *(u32x4*)(kt + dk * 64 + 8 * t8) = w;
                }
            }
            {
                const int it = wave & 3, mat = wave >> 2;
                f32x4 acc[4];
#pragma unroll
                for (int j = 0; j < 4; ++j) acc[j] = (f32x4){0.f, 0.f, 0.f, 0.f};
#pragma unroll
                for (int s = 0; s < 4; ++s) {
                    const bf16x8_t a = *(const LAS bf16x8_t*)(L + (mat ? QS : KS) + (16 * it + fr) * 272 + (32 * s + 8 * fq) * 2);
#pragma unroll
                    for (int jt = 0; jt < 4; ++jt) {
                        const bf16x8_t bb = *(const LAS bf16x8_t*)(L + KS + (16 * jt + fr) * 272 + (32 * s + 8 * fq) * 2);
                        acc[jt] = MFMA16(a, bb, acc[jt]);
                    }
                }
                f32x4 gi[2], bi[2]; float gj[2][4];
#pragma unroll
                for (int d = 0; d < 2; ++d) {
                    gi[d] = *(const LAS f32x4*)(vg + d * 64 + 16 * it + 4 * fq); bi[d] = *(const LAS f32x4*)(vb + d * 64 + 16 * it + 4 * fq);
#pragma unroll
                    for (int jt = 0; jt < 4; ++jt) gj[d][jt] = vg[d * 64 + 16 * jt + fr];
                }
                if (mat == 0) {
#pragma unroll
                    for (int d = 0; d < 2; ++d) {
                        LAS float* ap = (LAS float*)(L + AP + (c3 * 2 + d) * 17408);
#pragma unroll
                        for (int jt = 0; jt < 4; ++jt)
#pragma unroll
                            for (int r = 0; r < 4; ++r) {
                                const int i = 16 * it + 4 * fq + r, j = 16 * jt + fr, ip = d ? 63 - i : i, jp = d ? 63 - j : j;
                                ap[ip * 68 + jp] = (jp < ip) ? bi[d][r] * acc[jt][r] * __expf(gi[d][r] - gj[d][jt]) : 0.f;
                            }
                    }
                } else {
#pragma unroll
                    for (int d = 0; d < 2; ++d) {
                        bf16* qo = QKO + (size_t)(item * 2 + d) * 4096;
#pragma unroll
                        for (int jt = 0; jt < 4; ++jt)
#pragma unroll
                            for (int r = 0; r < 4; ++r) {
                                const int i = 16 * it + 4 * fq + r, j = 16 * jt + fr, ip = d ? 63 - i : i, jp = d ? 63 - j : j;
                                qo[i * 64 + j] = (bf16)f2bf((jp <= ip) ? acc[jt][r] * __expf(gi[d][r] - gj[d][jt]) : 0.f);
                            }
                    }
                }
            }
            __syncthreads();
        }
        if (wave < 6 && batch * 3 + (wave >> 1) < NITEM) {
            const int item = batch * 3 + (wave >> 1), d = wave & 1, c = lane;
            const LAS float* ap = (const LAS float*)(L + AP + wave * 17408);
            float x[64];
#pragma unroll
            for (int ip = 0; ip < 64; ++ip) {
                float a0 = (ip == c) ? 1.f : 0.f, a1 = 0.f;
#pragma unroll
                for (int q = 0; q < (ip + 3) / 4; ++q) {
                    const f32x4 av = *(const LAS f32x4*)(ap + ip * 68 + 4 * q);
#pragma unroll
                    for (int e = 0; e < 4; ++e) { const int jp = 4 * q + e; if (jp < ip) { if (e & 1) a1 -= av[e] * x[jp]; else a0 -= av[e] * x[jp]; } }
                }
                x[ip] = a0 + a1;
                __builtin_amdgcn_sched_barrier(0);
            }
            bf16* ti = TINV + (size_t)(item * 2 + d) * 4096;
            const int j = d ? 63 - c : c;
#pragma unroll
            for (int ip = 0; ip < 64; ++ip) { const int i = d ? 63 - ip : ip; ti[i * 64 + j] = (bf16)f2bf(x[ip]); }
        }
        __syncthreads();
    }
}

DI int dn_perm(int m, int t) { return 32 * (t >> 1) + 8 * (m >> 2) + 4 * (t & 1) + (m & 3); }
DI int dn_swz16(int row, int chunk) { return row * 272 + (chunk << 4); }
DI int dn_swz8(int row, int chunk) { return row * 144 + (chunk << 4); }
#define DN_BAR() do { asm volatile("s_waitcnt lgkmcnt(0)" ::: "memory"); __builtin_amdgcn_s_barrier(); asm volatile("" ::: "memory"); } while (0)
DI void phase_dn_scan(Frame& F) {
    LAS unsigned char* L = F.lds;
    constexpr int KS = 0, QS = 17408, KTS = 34816, TIS = 53248, VS = 62464, VCS = 66560, BUF = 68096;
    constexpr int PUBS = 2 * BUF, PUBV = PUBS + 16384;
    static_assert(PUBV + 8192 <= LDS_BYTES - 64, "scan LDS map");
    const int G8 = F.G >> 3;
    const int li = blockIdx.x >> 3, chain = (blockIdx.x & 7) * (G8 >> 2) + (li >> 2), qd = li & 3;
    if (F.G != 256 || chain >= 64) return;
    const int dir = chain >> 5, b = (chain >> 3) & 3, h = chain & 7;
    const bf16* DQ = (const bf16*)(F.ws + WS_DQ); const bf16* DK = (const bf16*)(F.ws + WS_DK); const bf16* DV = (const bf16*)(F.ws + WS_DV);
    const bf16* KT = (const bf16*)(F.ws + WS_KT); const bf16* TINV = (const bf16*)(F.ws + WS_TINV); const bf16* QKO = (const bf16*)(F.ws + WS_QKO); const float* VEC = (const float*)(F.ws + WS_VEC);
    bf16* ODN = (bf16*)(F.ws + WS_ODN);
    const int tid = F.tid, lane = F.lane, w = F.wave, fr = lane & 15, fq = lane >> 4;
#ifndef DN_NSTEP
#define DN_NSTEP 68
#endif
#define DN_CC1(st) (dir == 0 ? (st) : ((st) < 4 ? 3 - (st) : 71 - (st)))
#define DN_CC(step) DN_CC1((step) % 68)
#define AF16(base, row, kchunk) (*(const LAS bf16x8_t*)(Lb + (base) + dn_swz16((row), (kchunk))))
#define AF8(base, row, kchunk) (*(const LAS bf16x8_t*)(Lb + (base) + dn_swz8((row), (kchunk))))
    if (w >= 4) {
        const int lt = tid - 256;
        u32x4 preA[16], preB[16];
#define DN_LOAD(pre, cc_) do { const int cc__ = (cc_); const int item__ = (b * 8 + h) * 68 + cc__, cd__ = item__ * 2 + dir; \
        _Pragma("unroll") for (int k = 0; k < 16; ++k) { const bf16* src; \
            if (k < 4)       { const int q = lt + 256 * k;        src = DK + (size_t)item__ * 8192 + q * 8; } \
            else if (k < 8)  { const int q = lt + 256 * (k - 4);  src = DQ + (size_t)item__ * 8192 + q * 8; } \
            else if (k < 12) { const int q = lt + 256 * (k - 8);  src = KT + (size_t)item__ * 8192 + q * 8; } \
            else if (k < 14) { const int q = lt + 256 * (k - 12); src = TINV + (size_t)cd__ * 4096 + q * 8; } \
            else if (k == 14) { src = DV + (size_t)item__ * 8192 + (lt >> 2) * 128 + qd * 32 + (lt & 3) * 8; } \
            else { src = (const bf16*)(VEC + (size_t)cd__ * 320 + (lt < 80 ? lt : 0) * 4); } \
            pre[k] = *(const u32x4*)src; } } while (0)
#define DN_STORE(pre, bufo_) do { const int bo__ = (bufo_); _Pragma("unroll") for (int k = 0; k < 16; ++k) { int dst; \
            if (k < 4)       { const int q = lt + 256 * k;        dst = KS + dn_swz16(q >> 4, q & 15); } \
            else if (k < 8)  { const int q = lt + 256 * (k - 4);  dst = QS + dn_swz16(q >> 4, q & 15); } \
            else if (k < 12) { const int q = lt + 256 * (k - 8);  dst = KTS + dn_swz8(q >> 3, q & 7); } \
            else if (k < 14) { const int q = lt + 256 * (k - 12); dst = TIS + dn_swz8(q >> 3, q & 7); } \
            else if (k == 14) { dst = VS + lt * 16; } \
            else { dst = VCS + (lt < 80 ? lt : 0) * 16; } \
            *(LAS u32x4*)(L + bo__ + dst) = pre[k]; } } while (0)
#ifdef DN_SKIP_LOAD
#define DN_CLAMP(ds) ((ds) < DN_NSTEP - 70 ? 0 : (ds) < DN_NSTEP ? (ds) : DN_NSTEP - 1)
#else
#define DN_CLAMP(ds) ((ds) < DN_NSTEP ? (ds) : DN_NSTEP - 1)
#endif
#ifndef DN_SLEEP
#define DN_SLEEP 8
#endif
#define DN_LDELAY() __builtin_amdgcn_s_sleep(DN_SLEEP)
        DN_LOAD(preA, DN_CC(0)); DN_STORE(preA, 0); DN_LOAD(preA, DN_CC(1)); DN_LOAD(preB, DN_CC(2));
        DN_BAR();
        for (int step = 0; step < DN_NSTEP; step += 2) {
            DN_LDELAY(); DN_STORE(preA, BUF); DN_LOAD(preA, DN_CC(DN_CLAMP(step + 3)));
            DN_BAR();
            DN_LDELAY(); DN_STORE(preB, 0); DN_LOAD(preB, DN_CC(DN_CLAMP(step + 4)));
            DN_BAR();
        }
#undef DN_CLAMP
#undef DN_LOAD
#undef DN_STORE
    } else if (w >= 2) {
        const int pw = w - 2;
        bf16x8_t qkA[2][4], qkB[2][4];
        f32x4 O[4];
#define DN_QKLOAD(dst, st_) do { const int cd__ = ((b * 8 + h) * 68 + DN_CC(st_)) * 2 + dir; \
        _Pragma("unroll") for (int s = 0; s < 2; ++s) _Pragma("unroll") for (int mt = 0; mt < 4; ++mt) \
            dst[s][mt] = *(const bf16x8_t*)(QKO + (size_t)cd__ * 4096 + dn_perm(fr, mt) * 64 + (4 * s + fq) * 8); } while (0)
#define DN_OFIN(qk, st_) do { const int st__ = (st_); const LAS unsigned char* pv = L + PUBV + (st__ & 1) * 4096 + pw * 2048 + lane * 16; \
        const bf16x8_t vb0 = *(const LAS bf16x8_t*)pv, vb1 = *(const LAS bf16x8_t*)(pv + 1024); \
        _Pragma("unroll") for (int mt = 0; mt < 4; ++mt) { O[mt] = MFMA16(vb0, qk[0][mt], O[mt]); O[mt] = MFMA16(vb1, qk[1][mt], O[mt]); } \
        const int cc__ = DN_CC(st__); \
        if (cc__ >= 4) { bf16* orow = ODN + ((size_t)dir * NT + dn_row0(b, cc__)) * 1024 + h * 128 + qd * 32 + 16 * pw + 4 * fq; \
            _Pragma("unroll") for (int mt = 0; mt < 4; ++mt) { u32x2 w2; w2.x = pk2(O[mt][0], O[mt][1]); w2.y = pk2(O[mt][2], O[mt][3]); \
                *(u32x2*)(orow + (size_t)dn_perm(fr, mt) * 1024) = w2; } } } while (0)
#define DN_OBEG(st_) do { const int st__ = (st_); const LAS unsigned char* Lb = L + (st__ & 1) * BUF; const LAS unsigned char* ps = L + PUBS + (st__ & 1) * 8192 + pw * 4096 + lane * 16; \
        bf16x8_t sb[4], qa[4][4]; \
        _Pragma("unroll") for (int s = 0; s < 4; ++s) sb[s] = *(const LAS bf16x8_t*)(ps + s * 1024); \
        _Pragma("unroll") for (int s = 0; s < 4; ++s) _Pragma("unroll") for (int mt = 0; mt < 4; ++mt) qa[s][mt] = AF16(QS, dn_perm(fr, mt), 4 * s + fq); \
        _Pragma("unroll") for (int mt = 0; mt < 4; ++mt) O[mt] = (f32x4){0.f, 0.f, 0.f, 0.f}; \
        _Pragma("unroll") for (int s = 0; s < 4; ++s) _Pragma("unroll") for (int mt = 0; mt < 4; ++mt) O[mt] = MFMA16(sb[s], qa[s][mt], O[mt]); \
        const LAS float* vc = (const LAS float*)(Lb + VCS); \
        _Pragma("unroll") for (int mt = 0; mt < 4; ++mt) { const float eg = vc[64 + dn_perm(fr, mt)]; O[mt] = O[mt] * eg; } } while (0)
        DN_QKLOAD(qkA, 0); DN_QKLOAD(qkB, 1);
        DN_BAR();
        DN_OBEG(0);
        DN_BAR();
        for (int step = 0; step < DN_NSTEP - 2; step += 2) {
#ifdef DN_SKIP_OUT
            if (step < DN_NSTEP - 70) { DN_BAR(); DN_BAR(); continue; }
#endif
            DN_OFIN(qkA, step); DN_QKLOAD(qkA, step + 2);
            DN_OBEG(step + 1);
            DN_BAR();
            DN_OFIN(qkB, step + 1); DN_QKLOAD(qkB, step + 3);
            DN_OBEG(step + 2);
            DN_BAR();
        }
        DN_OFIN(qkA, DN_NSTEP - 2);
        DN_OBEG(DN_NSTEP - 1);
        DN_BAR();
        DN_OFIN(qkB, DN_NSTEP - 1);
#undef DN_QKLOAD
#undef DN_OFIN
#undef DN_OBEG
    } else {
        f32x4 S[8];
#pragma unroll
        for (int j = 0; j < 8; ++j) S[j] = (f32x4){0.f, 0.f, 0.f, 0.f};
        bf16x8_t sb[4];
#pragma unroll
        for (int s = 0; s < 4; ++s) { sb[s] = dn_bpack(S[2 * s], S[2 * s + 1]); *(LAS bf16x8_t*)(L + PUBS + w * 4096 + s * 1024 + lane * 16) = sb[s]; }
        DN_BAR();
        for (int step = 0; step < DN_NSTEP; ++step) {
#ifdef DN_SKIP_COMP
            if (step < DN_NSTEP - 69) { DN_BAR(); continue; }
#endif
            const LAS unsigned char* Lb = L + (step & 1) * BUF;
            f32x4 P[4];
#pragma unroll
            for (int mt = 0; mt < 4; ++mt) P[mt] = (f32x4){0.f, 0.f, 0.f, 0.f};
            {
                bf16x8_t ka[4][4];
#pragma unroll
                for (int s = 0; s < 4; ++s)
#pragma unroll
                    for (int mt = 0; mt < 4; ++mt) ka[s][mt] = AF16(KS, dn_perm(fr, mt), 4 * s + fq);
                __builtin_amdgcn_sched_barrier(0);
#pragma unroll
                for (int s = 0; s < 4; ++s)
#pragma unroll
                    for (int mt = 0; mt < 4; ++mt) P[mt] = MFMA16(ka[s][mt], sb[s], P[mt]);
            }
            bf16x8_t tia[2][4];
#pragma unroll
            for (int s = 0; s < 2; ++s)
#pragma unroll
                for (int mt = 0; mt < 4; ++mt) tia[s][mt] = AF8(TIS, dn_perm(fr, mt), 4 * s + fq);
            const LAS float* vc = (const LAS float*)(Lb + VCS);
            f32x4 R[4];
#pragma unroll
            for (int mt = 0; mt < 4; ++mt) {
                const int tk0 = 32 * (mt >> 1) + 8 * fq + 4 * (mt & 1);
                const f32x4 bt = *(const LAS f32x4*)(vc + tk0), bg = *(const LAS f32x4*)(vc + 128 + tk0);
#pragma unroll
                for (int r = 0; r < 4; ++r) {
                    const float v = bf2f(*(const LAS unsigned short*)(Lb + VS + (tk0 + r) * 64 + (16 * w + fr) * 2));
                    R[mt][r] = v * bt[r] - bg[r] * P[mt][r];
                }
            }
            const bf16x8_t rb0 = dn_bpack(R[0], R[1]), rb1 = dn_bpack(R[2], R[3]);
            f32x4 VN[4];
#pragma unroll
            for (int mt = 0; mt < 4; ++mt) {
                VN[mt] = (f32x4){0.f, 0.f, 0.f, 0.f};
                VN[mt] = MFMA16(tia[0][mt], rb0, VN[mt]);
                VN[mt] = MFMA16(tia[1][mt], rb1, VN[mt]);
            }
            bf16x8_t kta[2][8];
#pragma unroll
            for (int s = 0; s < 2; ++s)
#pragma unroll
                for (int jt = 0; jt < 8; ++jt) kta[s][jt] = AF8(KTS, dn_perm(fr, jt), 4 * s + fq);
            {
                const bf16x8_t vb0 = dn_bpack(VN[0], VN[1]), vb1 = dn_bpack(VN[2], VN[3]);
                LAS unsigned char* pv = L + PUBV + (step & 1) * 4096 + w * 2048 + lane * 16;
                *(LAS bf16x8_t*)pv = vb0; *(LAS bf16x8_t*)(pv + 1024) = vb1;
            }
#pragma unroll
            for (int mt = 0; mt < 4; ++mt) { const f32x4 ek = *(const LAS f32x4*)(vc + 192 + 32 * (mt >> 1) + 8 * fq + 4 * (mt & 1)); VN[mt] = VN[mt] * ek; }
            const bf16x8_t vs0 = dn_bpack(VN[0], VN[1]), vs1 = dn_bpack(VN[2], VN[3]);
            const float egl = vc[256];
#pragma unroll
            for (int jt = 0; jt < 8; ++jt) {
                S[jt] = S[jt] * egl;
                S[jt] = MFMA16(kta[0][jt], vs0, S[jt]);
                S[jt] = MFMA16(kta[1][jt], vs1, S[jt]);
            }
            if (DN_NSTEP > 68 && step % 68 == 67) {
#pragma unroll
                for (int j = 0; j < 8; ++j) S[j] = (f32x4){0.f, 0.f, 0.f, 0.f};
            }
#pragma unroll
            for (int s = 0; s < 4; ++s) { sb[s] = dn_bpack(S[2 * s], S[2 * s + 1]); *(LAS bf16x8_t*)(L + PUBS + ((step + 1) & 1) * 8192 + w * 4096 + s * 1024 + lane * 16) = sb[s]; }
            DN_BAR();
        }
    }
#undef AF16
#undef AF8
#undef DN_CC
#undef DN_CC1
}

DI void phase_attention(Frame& F, char* lds_generic) {
    bf16* QN = (bf16*)(F.ws + WS_QN); const bf16* KB = (const bf16*)(F.ws + WS_KB); const bf16* VB = (const bf16*)(F.ws + WS_VB);
    for (int it = F.vcu; it < 512; it += F.G) {
        const int b = it >> 7, kvh = (it >> 6) & 1, g = (it >> 4) & 3, qb = it & 15, h = kvh * 4 + g;
        bf16* Qb = QN + ((size_t)(b * TS + qb * 256) * 1024 + h * 128);
        const bf16* Kh = KB + ((size_t)b * LKV * 256 + kvh * 128); const bf16* Vh = VB + ((size_t)b * LKV * 256 + kvh * 128);
#ifdef ATTN_PROBE
#pragma nounroll
        for (int rep_ = 0; rep_ < 2; ++rep_) {
            bf16* Ob = rep_ == 0 ? (bf16*)(F.ws + WS_END) + ((size_t)(b * TS + qb * 256) * 1024 + h * 128) : Qb;
            attn::attn_dense_body<attn::bf16>(Qb, Kh, Vh, Ob, LKV, lds_generic);
            __syncthreads();
        }
#else
        attn::attn_dense_body<attn::bf16>(Qb, Kh, Vh, Qb, LKV, lds_generic);
        __syncthreads();
#endif
    }
}

DI void phase_mergeprep(Frame& F) {
    const bf16* ODN = (const bf16*)(F.ws + WS_ODN); bf16* Z = (bf16*)(F.ws + WS_Z); const int lane = F.lane;
    float nw[16];
#pragma unroll
    for (int k = 0; k < 4; ++k) { const f32x4 v = *(const f32x4*)(F.in[14] + (lane & 7) * 16 + 4 * k); nw[4 * k] = v[0]; nw[4 * k + 1] = v[1]; nw[4 * k + 2] = v[2]; nw[4 * k + 3] = v[3]; }
    for (int t = F.gw; t < NT; t += F.NGW) {
        const size_t off = (size_t)t * 1024 + 16 * lane;
        u32x4 a[2], c[2], z[2];
#pragma unroll
        for (int k = 0; k < 2; ++k) { a[k] = __builtin_nontemporal_load((const u32x4*)(ODN + off + 8 * k)); c[k] = __builtin_nontemporal_load((const u32x4*)(ODN + (size_t)NT * 1024 + off + 8 * k)); z[k] = __builtin_nontemporal_load((const u32x4*)(Z + off + 8 * k)); }
        float o[16]; float ss = 0.f;
#pragma unroll
        for (int k = 0; k < 2; ++k)
#pragma unroll
            for (int i = 0; i < 4; ++i) { o[8 * k + 2 * i] = bflo(a[k][i]) + bflo(c[k][i]); o[8 * k + 2 * i + 1] = bfhi(a[k][i]) + bfhi(c[k][i]); }
#pragma unroll
        for (int i = 0; i < 16; ++i) ss += o[i] * o[i];
        ss += __shfl_xor(ss, 1); ss += __shfl_xor(ss, 2); ss += __shfl_xor(ss, 4);
        const float rstd = rsqrtf(ss * (1.f / 128.f) + EPS);
        if (MERGE_F8_B) {
            float y[16];
#pragma unroll
            for (int k = 0; k < 2; ++k)
#pragma unroll
                for (int i = 0; i < 4; ++i) { y[8 * k + 2 * i] = o[8 * k + 2 * i] * rstd * nw[8 * k + 2 * i] * silu(bflo(z[k][i])); y[8 * k + 2 * i + 1] = o[8 * k + 2 * i + 1] * rstd * nw[8 * k + 2 * i + 1] * silu(bfhi(z[k][i])); }
            u32x4 w;
#pragma unroll
            for (int q = 0; q < 4; ++q) w[q] = pk4_fp8(fp8c(y[4 * q] * ODNN_SCALE), fp8c(y[4 * q + 1] * ODNN_SCALE), fp8c(y[4 * q + 2] * ODNN_SCALE), fp8c(y[4 * q + 3] * ODNN_SCALE));
            *(u32x4*)(F.ws + WS_ODNN8 + off) = w;
        } else {
#pragma unroll
        for (int k = 0; k < 2; ++k) {
            u32x4 w;
#pragma unroll
            for (int i = 0; i < 4; ++i) w[i] = pk2(o[8 * k + 2 * i] * rstd * nw[8 * k + 2 * i] * silu(bflo(z[k][i])), o[8 * k + 2 * i + 1] * rstd * nw[8 * k + 2 * i + 1] * silu(bfhi(z[k][i])));
            *(u32x4*)(Z + off + 8 * k) = w;
        }
        }
        if (MERGE_F8_A) {
            const bf16* OA = (const bf16*)(F.ws + WS_QN);
            const u32x4 a0 = __builtin_nontemporal_load((const u32x4*)(OA + off)), a1 = __builtin_nontemporal_load((const u32x4*)(OA + off + 8));
            u32x4 w;
            w[0] = pk4_fp8(fp8c(bflo(a0.x) * OATT_SCALE), fp8c(bfhi(a0.x) * OATT_SCALE), fp8c(bflo(a0.y) * OATT_SCALE), fp8c(bfhi(a0.y) * OATT_SCALE));
            w[1] = pk4_fp8(fp8c(bflo(a0.z) * OATT_SCALE), fp8c(bfhi(a0.z) * OATT_SCALE), fp8c(bflo(a0.w) * OATT_SCALE), fp8c(bfhi(a0.w) * OATT_SCALE));
            w[2] = pk4_fp8(fp8c(bflo(a1.x) * OATT_SCALE), fp8c(bfhi(a1.x) * OATT_SCALE), fp8c(bflo(a1.y) * OATT_SCALE), fp8c(bfhi(a1.y) * OATT_SCALE));
            w[3] = pk4_fp8(fp8c(bflo(a1.z) * OATT_SCALE), fp8c(bfhi(a1.z) * OATT_SCALE), fp8c(bflo(a1.w) * OATT_SCALE), fp8c(bfhi(a1.w) * OATT_SCALE));
            *(u32x4*)(F.ws + WS_OATT8 + off) = w;
        }
    }
}

DI void tk_insert(unsigned (&a)[16], unsigned x) {
#pragma unroll
    for (int i = 0; i < 16; ++i) { const unsigned hi = a[i] > x ? a[i] : x; x = a[i] > x ? x : a[i]; a[i] = hi; }
}
template <int N> DI void tk_sort_desc(unsigned (&a)[N]) {
#pragma unroll
    for (int k = 2; k <= N; k <<= 1)
#pragma unroll
        for (int j = k >> 1; j > 0; j >>= 1)
#pragma unroll
            for (int i = 0; i < N; ++i) {
                const int l = i ^ j;
                if (l > i) {
                    const unsigned lo = a[i] < a[l] ? a[i] : a[l], hi = a[i] < a[l] ? a[l] : a[i];
                    if ((i & k) == 0) { a[i] = hi; a[l] = lo; } else { a[i] = lo; a[l] = hi; }
                }
            }
}
DI void tk_sort_bitonic(unsigned (&c)[16]) {
#pragma unroll
    for (int s = 8; s >= 1; s >>= 1)
#pragma unroll
        for (int i = 0; i < 16; ++i) if ((i & s) == 0) { const unsigned lo = c[i] < c[i + s] ? c[i] : c[i + s], hi = c[i] < c[i + s] ? c[i + s] : c[i]; c[i] = hi; c[i + s] = lo; }
}
template <bool SORT> DI void tk_merge(unsigned (&a)[16], int m) {
    unsigned b[16];
#pragma unroll
    for (int i = 0; i < 16; ++i) b[i] = (unsigned)__shfl_xor((int)a[15 - i], m);
#pragma unroll
    for (int i = 0; i < 16; ++i) a[i] = a[i] > b[i] ? a[i] : b[i];
    if (SORT) tk_sort_bitonic(a);
}
DI float tk_unkey(unsigned k) { const unsigned u = (k & 0x80000000u) ? (k & 0x7fffffffu) : ~k; return __uint_as_float(u); }

DI void phase_peer_topk(Frame& F) {
    LAS unsigned char* L = F.lds;
    constexpr int KS = 0, QS = 69632, SC = 69632, TOP = 137216, FIN = 139264, PT = 140288;
    const bf16* PQ = (const bf16*)(F.ws + WS_PQ); const bf16* SUBK = (const bf16*)(F.ws + WS_SUBK);
    int* EXPI = (int*)(F.ws + WS_EXPI); float* EXPG = (float*)(F.ws + WS_EXPG);
    const int tid = F.tid, lane = F.lane, w = F.wave, fr = lane & 15, fq = lane >> 4;
    LAS float* sc = (LAS float*)(L + SC); LAS unsigned char* top = L + TOP; LAS unsigned char* finb = L + FIN; LAS int* pt = (LAS int*)(L + PT);
    if (tid < 56) {
        int n = tid, pi = -1;
#pragma unroll
        for (int i = 0; i < 16; ++i) { const int cnt = 16 / (i + 1); if (pi < 0) { if (n < cnt) pi = i * 16 + n; else n -= cnt; } }
        pt[tid] = tid < 50 ? pi : -1;
    }
    int hcur = -1;
    u32x4 qpre[4];
    if (F.vcu < (NT / 64) * 8) {
        const int h0 = F.vcu & 7, tq = (F.vcu >> 3) * 64;
#pragma unroll
        for (int k = 0; k < 4; ++k) { const int c = tid + 512 * k; qpre[k] = __builtin_nontemporal_load((const u32x4*)(PQ + (size_t)(tq + (c >> 5)) * 2048 + h0 * 256 + (c & 31) * 8)); }
    }
    for (int it = F.vcu; it < (NT / 64) * 8; it += F.G) {
        const int h = it & 7, tile = it >> 3, t0 = tile * 64;
        RAW_BAR();
        if (h != hcur) {
#pragma unroll
            for (int k = 0; k < 8; ++k) { const int c = tid + 512 * k, row = c >> 4, c16 = c & 15;
                *(LAS u32x4*)(L + KS + row * 272 + c16 * 16) = *(const u32x4*)(SUBK + (size_t)h * 32768 + row * 128 + c16 * 8); }
            hcur = h;
        }
#pragma unroll
        for (int k = 0; k < 4; ++k) { const int c = tid + 512 * k, row = c >> 5, c16 = c & 31; *(LAS u32x4*)(L + QS + row * 528 + c16 * 16) = qpre[k]; }
        if (it + F.G < (NT / 64) * 8) {
            const int itn = it + F.G, hn = itn & 7, tn = (itn >> 3) * 64;
#pragma unroll
            for (int k = 0; k < 4; ++k) { const int c = tid + 512 * k; qpre[k] = __builtin_nontemporal_load((const u32x4*)(PQ + (size_t)(tn + (c >> 5)) * 2048 + hn * 256 + (c & 31) * 8)); }
        }
        RAW_BAR();
        const int p = w >> 2, n0 = (w & 3) * 32;
        f32x4 acc[4][2];
#pragma unroll
        for (int mt = 0; mt < 4; ++mt) { acc[mt][0] = (f32x4){0.f, 0.f, 0.f, 0.f}; acc[mt][1] = (f32x4){0.f, 0.f, 0.f, 0.f}; }
#pragma unroll
        for (int s = 0; s < 4; ++s) {
            const bf16x8_t b0 = *(const LAS bf16x8_t*)(L + KS + (p * 128 + n0 + fr) * 272 + (32 * s + 8 * fq) * 2);
            const bf16x8_t b1 = *(const LAS bf16x8_t*)(L + KS + (p * 128 + n0 + 16 + fr) * 272 + (32 * s + 8 * fq) * 2);
#pragma unroll
            for (int mt = 0; mt < 4; ++mt) {
                const bf16x8_t a = *(const LAS bf16x8_t*)(L + QS + (16 * mt + fr) * 528 + (p * 128 + 32 * s + 8 * fq) * 2);
                acc[mt][0] = MFMA16(a, b0, acc[mt][0]); acc[mt][1] = MFMA16(a, b1, acc[mt][1]);
            }
        }
        RAW_BAR();
#pragma unroll
        for (int mt = 0; mt < 4; ++mt)
#pragma unroll
            for (int nt = 0; nt < 2; ++nt)
#pragma unroll
                for (int r = 0; r < 4; ++r) sc[((16 * mt + 4 * fq + r) * 2 + p) * 132 + (w & 3) * 33 + 16 * nt + fr] = acc[mt][nt][r];
        RAW_BAR();
        {
            const int list = tid >> 2, q = tid & 3;
            unsigned a32[32];
            const LAS float* sp = sc + list * 132 + q * 33;
#pragma unroll
            for (int i = 0; i < 32; ++i) a32[i] = (okey(sp[i]) & ~0x7Fu) | (unsigned)(q * 32 + i);
            tk_sort_desc<32>(a32);
            unsigned a[16];
#pragma unroll
            for (int i = 0; i < 16; ++i) a[i] = a32[i];
            tk_merge<true>(a, 1); tk_merge<true>(a, 2);
            if (q == 0) {
                u32x4 v;
#pragma unroll
                for (int k = 0; k < 4; ++k) v[k] = (a[4 * k] & 127u) | ((a[4 * k + 1] & 127u) << 8) | ((a[4 * k + 2] & 127u) << 16) | ((a[4 * k + 3] & 127u) << 24);
                *(LAS u32x4*)(top + list * 16) = v;
            }
        }
        RAW_BAR();
        {
            const int tok = tid >> 3, r8 = tid & 7;
            unsigned c8[8]; c8[7] = 0u;
#pragma unroll
            for (int m = 0; m < 7; ++m) {
                const int pr = pt[r8 + 8 * m];
                unsigned ck = 0u;
                if (pr >= 0) {
                    const int ia = top[(tok * 2) * 16 + (pr >> 4)], ib = top[(tok * 2 + 1) * 16 + (pr & 15)];
                    const float cs = sc[(tok * 2) * 132 + (ia >> 5) * 33 + (ia & 31)] + sc[(tok * 2 + 1) * 132 + (ib >> 5) * 33 + (ib & 31)];
                    ck = (okey(cs) & ~0xFFu) | (unsigned)pr;
                }
                c8[m] = ck;
            }
            tk_sort_desc<8>(c8);
            unsigned a[16];
#pragma unroll
            for (int i = 0; i < 16; ++i) a[i] = i < 8 ? c8[i] : 0u;
            tk_merge<true>(a, 1); tk_merge<true>(a, 2); tk_merge<true>(a, 4);
            LAS unsigned char* fin = finb + tok * 16;
            if (r8 == 0) {
                u32x4 v;
#pragma unroll
                for (int k = 0; k < 4; ++k) v[k] = (a[4 * k] & 255u) | ((a[4 * k + 1] & 255u) << 8) | ((a[4 * k + 2] & 255u) << 16) | ((a[4 * k + 3] & 255u) << 24);
                *(LAS u32x4*)fin = v;
            }
            asm volatile("s_waitcnt lgkmcnt(0)" ::: "memory");
            float bs[2]; int ex[2];
#pragma unroll
            for (int e = 0; e < 2; ++e) {
                const unsigned pr = fin[2 * r8 + e];
                const int ia = top[(tok * 2) * 16 + (pr >> 4)], ib = top[(tok * 2 + 1) * 16 + (pr & 15u)];
                bs[e] = sc[(tok * 2) * 132 + (ia >> 5) * 33 + (ia & 31)] + sc[(tok * 2 + 1) * 132 + (ib >> 5) * 33 + (ib & 31)];
                ex[e] = ia * 128 + ib;
            }
            float mx = fmaxf(bs[0], bs[1]);
            mx = fmaxf(mx, __shfl_xor(mx, 1)); mx = fmaxf(mx, __shfl_xor(mx, 2)); mx = fmaxf(mx, __shfl_xor(mx, 4));
            const float e0 = __expf(bs[0] - mx), e1 = __expf(bs[1] - mx);
            float sm = e0 + e1; sm += __shfl_xor(sm, 1); sm += __shfl_xor(sm, 2); sm += __shfl_xor(sm, 4);
            const float rs = 1.f / sm;
            const size_t o = (size_t)(t0 + tok) * 128 + h * 16 + 2 * r8;
            *(int2*)(EXPI + o) = make_int2(ex[0], ex[1]);
            *(float2*)(EXPG + o) = make_float2(e0 * rs, e1 * rs);
        }
    }
}

DI float ub0(unsigned w) { float r; asm("v_cvt_f32_ubyte0 %0, %1" : "=v"(r) : "v"(w)); return r; }
DI float ub1(unsigned w) { float r; asm("v_cvt_f32_ubyte1 %0, %1" : "=v"(r) : "v"(w)); return r; }
DI float ub2(unsigned w) { float r; asm("v_cvt_f32_ubyte2 %0, %1" : "=v"(r) : "v"(w)); return r; }
DI float ub3(unsigned w) { float r; asm("v_cvt_f32_ubyte3 %0, %1" : "=v"(r) : "v"(w)); return r; }
DI float wave_maxf(float v) {
#pragma unroll
    for (int o = 1; o < 64; o <<= 1) v = fmaxf(v, __shfl_xor(v, o));
    return v;
}
template <int BIAS> DI void quant_rows(const float* src, unsigned char* dst, float* scale, int gw, int NGW, int lane) {
    for (int row = gw; row < NEXP; row += NGW) {
        f32x4 v[8]; float am = 0.f;
#pragma unroll
        for (int j = 0; j < 8; ++j) { v[j] = __builtin_nontemporal_load((const f32x4*)(src + (size_t)row * DM) + lane + 64 * j); am = fmaxf(am, fmaxf(fmaxf(fabsf(v[j][0]), fabsf(v[j][1])), fmaxf(fabsf(v[j][2]), fabsf(v[j][3])))); }
        am = wave_maxf(am);
        const float inv = am > 0.f ? 127.f / am : 0.f;
#pragma unroll
        for (int j = 0; j < 8; ++j) {
            unsigned w = 0;
#pragma unroll
            for (int i = 0; i < 4; ++i) { const int q = (int)rintf(v[j][i] * inv) + BIAS; w |= ((unsigned)q & 0xffu) << (8 * i); }
            *((unsigned*)(dst + (size_t)row * DM) + lane + 64 * j) = w;
        }
        if (lane == 0) scale[row] = am * (1.f / 127.f);
    }
}


constexpr int V4_ROW = 1152;
DI void quant_rows_i4(const float* __restrict__ src, unsigned char* __restrict__ dst, int gw, int NGW, int lane) {
#pragma unroll 2
    for (int row = gw; row < NEXP; row += NGW) {
        f32x4 vv[8];
#pragma unroll
        for (int j = 0; j < 8; ++j) vv[j] = __builtin_nontemporal_load((const f32x4*)(src + (size_t)row * DM) + lane + 64 * j);
#pragma unroll
        for (int j = 0; j < 8; ++j) {
            const f32x4 v = vv[j];
            float am = fmaxf(fmaxf(fabsf(v[0]), fabsf(v[1])), fmaxf(fabsf(v[2]), fabsf(v[3])));
            am = fmaxf(am, __shfl_xor(am, 1)); am = fmaxf(am, __shfl_xor(am, 2)); am = fmaxf(am, __shfl_xor(am, 4));
            const unsigned sb = f2bf(am * (1.f / 7.f)); const float s = __uint_as_float(sb << 16), inv = s > 0.f ? __builtin_amdgcn_rcpf(s) : 0.f;
            unsigned w = 0;
#pragma unroll
            for (int i = 0; i < 4; ++i) { const int q = (int)fminf(fmaxf(rintf(v[i] * inv), -7.f), 7.f) + 8; w |= (unsigned)q << (4 * i); }
            const int grp = j * 8 + (lane >> 3);
            *(unsigned short*)(dst + (size_t)row * V4_ROW + grp * 16 + (lane & 7) * 2) = (unsigned short)w;
            if ((lane & 7) == 0) *(unsigned short*)(dst + (size_t)row * V4_ROW + 1024 + grp * 2) = (unsigned short)sb;
        }
    }
}

DI void quant_u_both(const float* __restrict__ src, unsigned char* __restrict__ d8, float* __restrict__ scale, unsigned char* __restrict__ d4, int gw, int NGW, int lane) {
#pragma unroll 2
    for (int row = gw; row < NEXP; row += NGW) {
        f32x4 v[8]; float am = 0.f;
#pragma unroll
        for (int j = 0; j < 8; ++j) { v[j] = __builtin_nontemporal_load((const f32x4*)(src + (size_t)row * DM) + lane + 64 * j); am = fmaxf(am, fmaxf(fmaxf(fabsf(v[j][0]), fabsf(v[j][1])), fmaxf(fabsf(v[j][2]), fabsf(v[j][3])))); }
        const float rowmax = wave_maxf(am), inv8 = rowmax > 0.f ? 127.f / rowmax : 0.f;
#pragma unroll
        for (int j = 0; j < 8; ++j) {
            unsigned w8 = 0;
#pragma unroll
            for (int i = 0; i < 4; ++i) { const int q = (int)rintf(v[j][i] * inv8); w8 |= ((unsigned)q & 0xffu) << (8 * i); }
            *((unsigned*)(d8 + (size_t)row * DM) + lane + 64 * j) = w8;
            float gm = fmaxf(fmaxf(fabsf(v[j][0]), fabsf(v[j][1])), fmaxf(fabsf(v[j][2]), fabsf(v[j][3])));
            gm = fmaxf(gm, __shfl_xor(gm, 1)); gm = fmaxf(gm, __shfl_xor(gm, 2)); gm = fmaxf(gm, __shfl_xor(gm, 4));
            const unsigned sb = f2bf(gm * (1.f / 7.f)); const float s = __uint_as_float(sb << 16), inv = s > 0.f ? __builtin_amdgcn_rcpf(s) : 0.f;
            unsigned w = 0;
#pragma unroll
            for (int i = 0; i < 4; ++i) { const int q = (int)fminf(fmaxf(rintf(v[j][i] * inv), -7.f), 7.f) + 8; w |= (unsigned)q << (4 * i); }
            const int grp = j * 8 + (lane >> 3);
            *(unsigned short*)(d4 + (size_t)row * V4_ROW + grp * 16 + (lane & 7) * 2) = (unsigned short)w;
            if ((lane & 7) == 0) *(unsigned short*)(d4 + (size_t)row * V4_ROW + 1024 + grp * 2) = (unsigned short)sb;
        }
        if (lane == 0) scale[row] = rowmax * (1.f / 127.f);
    }
}

DI void phase_peer_gather(Frame& F, int emask = 0x3fff, int vmask = 0x3fff) {
    const bf16* H2 = (const bf16*)(F.ws + WS_H2);
    const unsigned char* U8 = F.ws + WS_U8; const unsigned char* U4 = F.ws + WS_U4; const unsigned char* V4 = F.ws + WS_V8; const float* SU = (const float*)(F.ws + WS_SU);
    const int* EXPI = (const int*)(F.ws + WS_EXPI); const float* EXPG = (const float*)(F.ws + WS_EXPG);
    const bf16* X1 = (const bf16*)(F.ws + WS_X1); const float* MOD = (const float*)(F.ws + WS_MOD); const int lane = F.lane;
    LAS float* la = (LAS float*)(F.lds + F.wave * 1024);
    LAS int* li = (LAS int*)(F.lds + F.wave * 1024 + 512);
    const int eloc = ((lane >> 5) & 1) * 4 + ((lane >> 4) & 1) * 2 + ((lane >> 3) & 1);
#ifdef GATHER_SUBSET
    if ((blockIdx.x >> 3) % GATHER_SUBSET != 0) return;
    const int gw_ = ((blockIdx.x >> 3) / GATHER_SUBSET * 8 + (blockIdx.x & 7)) * NWAVES + F.wave, ngw_ = F.NGW / GATHER_SUBSET;
#else
    const int gw_ = F.gw, ngw_ = F.NGW;
#endif
    for (int t = gw_; t < NT; t += ngw_) {
        float xf[2][16]; float am = 0.f;
#pragma unroll
        for (int j = 0; j < 2; ++j) {
            const u32x4 w0 = *((const u32x4*)(H2 + (size_t)t * DM) + 2 * (lane + 64 * j)), w1 = *((const u32x4*)(H2 + (size_t)t * DM) + 2 * (lane + 64 * j) + 1);
            xf[j][0] = bflo(w0.x); xf[j][1] = bfhi(w0.x); xf[j][2] = bflo(w0.y); xf[j][3] = bfhi(w0.y); xf[j][4] = bflo(w0.z); xf[j][5] = bfhi(w0.z); xf[j][6] = bflo(w0.w); xf[j][7] = bfhi(w0.w);
            xf[j][8] = bflo(w1.x); xf[j][9] = bfhi(w1.x); xf[j][10] = bflo(w1.y); xf[j][11] = bfhi(w1.y); xf[j][12] = bflo(w1.z); xf[j][13] = bfhi(w1.z); xf[j][14] = bflo(w1.w); xf[j][15] = bfhi(w1.w);
#pragma unroll
            for (int i = 0; i < 16; ++i) am = fmaxf(am, fabsf(xf[j][i]));
        }
        am = wave_maxf(am);
        const float inv = am > 0.f ? 127.f / am : 0.f, sx = am * (1.f / 127.f);
        int xq[2][4];
#pragma unroll
        for (int j = 0; j < 2; ++j)
#pragma unroll
            for (int k = 0; k < 4; ++k) {
                unsigned w = 0;
#pragma unroll
                for (int i = 0; i < 4; ++i) w |= ((unsigned)(int)rintf(xf[j][4 * k + i] * inv) & 0xffu) << (8 * i);
                xq[j][k] = (int)w;
            }
        int xe[4], xo[4], xsum4 = 0;
#pragma unroll
        for (int d = 0; d < 4; ++d) {
            const u32x4 w = *((const u32x4*)(H2 + (size_t)t * DM + 32 * lane) + d);
            int q[8];
#pragma unroll
            for (int i = 0; i < 4; ++i) { q[2 * i] = (int)rintf(bflo(w[i]) * inv); q[2 * i + 1] = (int)rintf(bfhi(w[i]) * inv); }
            xe[d] = (int)(((unsigned)q[0] & 0xffu) | (((unsigned)q[2] & 0xffu) << 8) | (((unsigned)q[4] & 0xffu) << 16) | (((unsigned)q[6] & 0xffu) << 24));
            xo[d] = (int)(((unsigned)q[1] & 0xffu) | (((unsigned)q[3] & 0xffu) << 8) | (((unsigned)q[5] & 0xffu) << 16) | (((unsigned)q[7] & 0xffu) << 24));
#pragma unroll
            for (int i = 0; i < 8; ++i) xsum4 += q[i];
        }
        float asum = 0.f;
        const int ei0 = EXPI[(size_t)t * 128 + lane] & emask, ei1 = EXPI[(size_t)t * 128 + 64 + lane] & emask;
        const float eg0 = EXPG[(size_t)t * 128 + lane], eg1 = EXPG[(size_t)t * 128 + 64 + lane];
        u32x4 wa0[8], wa1[8], wb[8]; unsigned short sbh[8];
#define ULOADA(hd_) do { const int eis_ = (hd_) < 4 ? ei0 : ei1, base_ = ((hd_) & 3) * 16; \
            _Pragma("unroll") for (int e = 0; e < 8; ++e) { const int idx_ = __builtin_amdgcn_readlane(eis_, base_ + e); const u32x4* ur_ = (const u32x4*)(U8 + (size_t)idx_ * DM); wa0[e] = ur_[lane]; wa1[e] = ur_[lane + 64]; } } while (0)
#define ULOADB(hd_) do { const int eis_ = (hd_) < 4 ? ei0 : ei1, base_ = ((hd_) & 3) * 16 + 8; \
            _Pragma("unroll") for (int e = 0; e < 8; ++e) { const int idx_ = __builtin_amdgcn_readlane(eis_, base_ + e); const unsigned char* u4_ = U4 + (size_t)idx_ * V4_ROW; wb[e] = *(const u32x4*)(u4_ + 16 * lane); sbh[e] = *(const unsigned short*)(u4_ + 1024 + 2 * lane); } } while (0)
#define ULOADA_NEXT(hd_) do { const int h_ = (hd_); const int eis_ = (h_ & 4) ? ei1 : ei0, base_ = (h_ & 3) * 16, msk_ = h_ < 8 ? -1 : 0; \
            _Pragma("unroll") for (int e = 0; e < 8; ++e) { const int idx_ = __builtin_amdgcn_readlane(eis_, base_ + e) & msk_; const u32x4* ur_ = (const u32x4*)(U8 + (size_t)idx_ * DM); wa0[e] = ur_[lane]; wa1[e] = ur_[lane + 64]; } } while (0)
        ULOADA(0);
#pragma unroll 1
        for (int hd = 0; hd < 8; ++hd) {
            const int eisel = hd < 4 ? ei0 : ei1; const float egsel = hd < 4 ? eg0 : eg1;
            const int base = (hd & 3) * 16;
            const int myidxA = __shfl(eisel, base + eloc), myidxB = __shfl(eisel, base + 8 + eloc);
            const float mygA = __shfl(egsel, base + eloc), mygB = __shfl(egsel, base + 8 + eloc);
            const float mysu = SU[myidxA];
            ULOADB(hd);
            float accA[8], accB[8];
#pragma unroll
            for (int e = 0; e < 8; ++e) {
                int a = __builtin_amdgcn_sdot4((int)wa0[e].x, xq[0][0], 0, false); a = __builtin_amdgcn_sdot4((int)wa0[e].y, xq[0][1], a, false);
                a = __builtin_amdgcn_sdot4((int)wa0[e].z, xq[0][2], a, false); a = __builtin_amdgcn_sdot4((int)wa0[e].w, xq[0][3], a, false);
                a = __builtin_amdgcn_sdot4((int)wa1[e].x, xq[1][0], a, false); a = __builtin_amdgcn_sdot4((int)wa1[e].y, xq[1][1], a, false);
                a = __builtin_amdgcn_sdot4((int)wa1[e].z, xq[1][2], a, false); a = __builtin_amdgcn_sdot4((int)wa1[e].w, xq[1][3], a, false);
                accA[e] = (float)a;
            }
            __builtin_amdgcn_sched_barrier(0);
            ULOADA_NEXT(hd + 1);
#pragma unroll
            for (int e = 0; e < 8; ++e) {
                int b = 0;
#pragma unroll
                for (int d = 0; d < 4; ++d) { b = __builtin_amdgcn_sdot4((int)(wb[e][d] & 0x0F0F0F0Fu), xe[d], b, false); b = __builtin_amdgcn_sdot4((int)((wb[e][d] >> 4) & 0x0F0F0F0Fu), xo[d], b, false); }
                accB[e] = (float)(b - 8 * xsum4) * bf2f(sbh[e]);
            }
            float rA, rB;
            {
                float r4[4], r2[2], s4[4], s2[2];
#pragma unroll
                for (int i = 0; i < 4; ++i) {
                    const float sndA = (lane & 32) ? accA[i] : accA[i + 4], kpA = (lane & 32) ? accA[i + 4] : accA[i]; r4[i] = kpA + __shfl_xor(sndA, 32);
                    const float sndB = (lane & 32) ? accB[i] : accB[i + 4], kpB = (lane & 32) ? accB[i + 4] : accB[i]; s4[i] = kpB + __shfl_xor(sndB, 32); }
#pragma unroll
                for (int i = 0; i < 2; ++i) {
                    const float sndA = (lane & 16) ? r4[i] : r4[i + 2], kpA = (lane & 16) ? r4[i + 2] : r4[i]; r2[i] = kpA + __shfl_xor(sndA, 16);
                    const float sndB = (lane & 16) ? s4[i] : s4[i + 2], kpB = (lane & 16) ? s4[i + 2] : s4[i]; s2[i] = kpB + __shfl_xor(sndB, 16); }
                { const float sndA = (lane & 8) ? r2[0] : r2[1], kpA = (lane & 8) ? r2[1] : r2[0]; rA = kpA + __shfl_xor(sndA, 8);
                  const float sndB = (lane & 8) ? s2[0] : s2[1], kpB = (lane & 8) ? s2[1] : s2[0]; rB = kpB + __shfl_xor(sndB, 8); }
                rA += __shfl_xor(rA, 4); rA += __shfl_xor(rA, 2); rA += __shfl_xor(rA, 1);
                rB += __shfl_xor(rB, 4); rB += __shfl_xor(rB, 2); rB += __shfl_xor(rB, 1);
            }
            const float aA = gelu_erf(rA * mysu * sx) * mygA, aB = gelu_erf(rB * sx) * mygB;
            if ((lane & 7) == 0) { la[hd * 16 + eloc] = aA; li[hd * 16 + eloc] = myidxA & vmask; la[hd * 16 + 8 + eloc] = aB; li[hd * 16 + 8 + eloc] = myidxB & vmask; asum += aA + aB; }
        }
#undef ULOADA
#undef ULOADA_NEXT
#undef ULOADB
        asum = wave_sum(asum);
        asm volatile("s_waitcnt lgkmcnt(0)" ::: "memory");
        f32x2 o2[16]; float csum = 0.f;
#pragma unroll
        for (int i = 0; i < 16; ++i) o2[i] = (f32x2){0.f, 0.f};
#pragma unroll 16
        for (int e = 0; e < 128; ++e) {
            const int idx = __builtin_amdgcn_readfirstlane(li[e]); const float a = __uint_as_float((unsigned)__builtin_amdgcn_readfirstlane((int)__float_as_uint(la[e])));
            const unsigned char* vr = V4 + (size_t)idx * V4_ROW;
            const u32x4 w = *(const u32x4*)(vr + 16 * lane);
            const float as = a * bf2f(*(const unsigned short*)(vr + 1024 + 2 * lane));
            csum += as;
            const f32x2 as2 = {as, as};
#pragma unroll
            for (int d = 0; d < 4; ++d) {
                const unsigned lo = w[d] & 0x0F0F0F0Fu, hi = (w[d] >> 4) & 0x0F0F0F0Fu;
                o2[4 * d + 0] = __builtin_elementwise_fma(as2, (f32x2){ub0(lo), ub0(hi)}, o2[4 * d + 0]); o2[4 * d + 1] = __builtin_elementwise_fma(as2, (f32x2){ub1(lo), ub1(hi)}, o2[4 * d + 1]);
                o2[4 * d + 2] = __builtin_elementwise_fma(as2, (f32x2){ub2(lo), ub2(hi)}, o2[4 * d + 2]); o2[4 * d + 3] = __builtin_elementwise_fma(as2, (f32x2){ub3(lo), ub3(hi)}, o2[4 * d + 3]);
            }
        }
        float o[32];
#pragma unroll
        for (int i = 0; i < 16; ++i) { o[2 * i] = o2[i][0]; o[2 * i + 1] = o2[i][1]; }
        LAS float* tp = (LAS float*)(F.lds + 8192 + F.wave * 9216);
        const float corr = 8.f * csum;
#pragma unroll
        for (int k = 0; k < 8; ++k) { f32x4 v; v[0] = o[4 * k] - corr; v[1] = o[4 * k + 1] - corr; v[2] = o[4 * k + 2] - corr; v[3] = o[4 * k + 3] - corr; *(LAS f32x4*)(tp + lane * 36 + 4 * k) = v; }
        asm volatile("s_waitcnt lgkmcnt(0)" ::: "memory");
        const float* g2 = MOD + (size_t)(t >> 12) * 12288 + 5 * 2048;
        f32x4 x2[8]; float ss = 0.f;
#pragma unroll
        for (int j = 0; j < 8; ++j) {
            const int ch = lane + 64 * j;
            const f32x4 pv = *(const LAS f32x4*)(tp + (ch >> 3) * 36 + 4 * (ch & 7));
            const u32x2 xw = __builtin_nontemporal_load((const u32x2*)(X1 + (size_t)t * DM) + ch); const f32x4 xa = {bflo(xw.x), bfhi(xw.x), bflo(xw.y), bfhi(xw.y)}, ga = *((const f32x4*)g2 + ch);
            x2[j] = xa + ga * pv;
            ss += (x2[j][0] * x2[j][0] + x2[j][1] * x2[j][1]) + (x2[j][2] * x2[j][2] + x2[j][3] * x2[j][3]);
        }
        const float rstd = rsqrtf(wave_sum(ss) * (1.f / DM) + EPS);
        const float* fw = F.in[22];
#pragma unroll
        for (int j = 0; j < 8; ++j) { const int ch = lane + 64 * j; const f32x4 wa = *((const f32x4*)fw + ch); __builtin_nontemporal_store(x2[j] * rstd * wa, (f32x4*)(F.out + (size_t)t * DM) + ch); }
        asm volatile("s_waitcnt lgkmcnt(0)" ::: "memory");
    }
}

DI void phase_h2(Frame& F) {
    const float* MOD = (const float*)(F.ws + WS_MOD); bf16* H2 = (bf16*)(F.ws + WS_H2); const bf16* X1 = (const bf16*)(F.ws + WS_X1);
    ModPar P;
    constexpr int RPW = NT / (256 * NWAVES);
    if (F.NGW == 256 * NWAVES) {
        const int m0 = F.gw * RPW, r = m0 >> 12;
        modpar_load(P, F.in[7], MOD + (size_t)r * 12288 + 4 * 2048, MOD + (size_t)r * 12288 + 3 * 2048, F.lane);
        modnorm_rows_bf(X1 + (size_t)m0 * DM, H2 + (size_t)m0 * DM, RPW, P, F.lane);
    } else {
        for (int m = F.gw; m < NT; m += F.NGW) { const int r = m >> 12; modpar_load(P, F.in[7], MOD + (size_t)r * 12288 + 4 * 2048, MOD + (size_t)r * 12288 + 3 * 2048, F.lane); modnorm_rows_bf(X1 + (size_t)m * DM, H2 + (size_t)m * DM, 1, P, F.lane); }
    }
}


DI void phase_quant(Frame& F) {
#ifndef REP_QUANT
#define REP_QUANT 1
#endif
#pragma nounroll
    for (int rq = 0; rq < REP_QUANT; ++rq) {
    quant_u_both(F.in[20], F.ws + WS_U8, (float*)(F.ws + WS_SU), F.ws + WS_U4, F.gw, F.NGW, F.lane);
    quant_rows_i4(F.in[21], F.ws + WS_V8, F.gw, F.NGW, F.lane);
    }
}

struct Args { const float* in[23]; float* out; unsigned char* ws; int ph_lo, ph_hi; };
static_assert(sizeof(Args) == 23 * 8 + 8 + 8 + 8, "Args has no padding");

__global__ void __launch_bounds__(NWAVES * 64, 2) mk_fwd(Args args) {
    extern __shared__ __attribute__((aligned(16))) unsigned char lds[];
    Frame F;
    F.lds = (LAS unsigned char*)lds; F.ws = args.ws; F.out = args.out;
#pragma unroll
    for (int i = 0; i < 23; ++i) F.in[i] = args.in[i];
    F.tid = threadIdx.x; F.lane = F.tid & 63; F.wave = __builtin_amdgcn_readfirstlane(F.tid >> 6);
    F.G = gridDim.x; { const int bx = blockIdx.x; F.vcu = (F.G % 8 == 0) ? (bx % 8) * (F.G / 8) + bx / 8 : bx; }
    F.gw = F.vcu * NWAVES + F.wave; F.NGW = F.G * NWAVES;
    const int lo = args.ph_lo, hi = args.ph_hi;
#ifndef REP_PHASE
#define REP_PHASE (-1)
#endif
#define IN(k) (lo <= (k) && (k) < hi)
#ifndef REP_MASK
#define REP_MASK 0
#endif
#define RP(k) _Pragma("nounroll") for (int rep_ = 0; rep_ < ((REP_PHASE == (k) || ((REP_MASK >> (k)) & 1)) ? 2 : 1); ++rep_)
    constexpr int CW_BAR = 4096;
    volatile LAS unsigned* bst = (volatile LAS unsigned*)(F.lds + LDS_BYTES - 64);
    if (F.tid < 16) bst[F.tid] = 0u;
    __syncthreads();
    XcdBarrier bar; bar.bar = (unsigned*)(F.ws + WS_CTL) + CW_BAR; bar.x = 0; bar.st = nullptr;
    if (hi - lo > 1) bar = xcd_barrier_post((unsigned*)(F.ws + WS_CTL) + CW_BAR, bst);
#define SEAM(k) do { if (IN(k) && IN((k) + 1)) { if ((k) == 0) cg::this_grid().sync(); else xcd_barrier(bar); } } while (0)

    if (IN(0)) RP(0) { phase_prologue(F); __syncthreads(); }
    SEAM(0);
    if (IN(1)) RP(1) phase_modreduce(F);
    SEAM(1);
    if (IN(2)) RP(2) phase_h1(F);
    SEAM(2);
    if (IN(3)) RP(3) {
        pg8::Gemm g{(const bf16*)(F.ws + WS_H), (const bf16*)(F.ws + WS_WIN), MTOT, NPROJ, DM / 2}; InProjOrder S; S.init(F.G, (int)blockIdx.x);
        EpiInProj E{F.ws, F.in[12], F.in[13]};
        pg8::gemm_phase<EpiInProj, InProjOrder, true, true, true>(F.lds, g, S, E);
    }
    SEAM(3);
    if (IN(4)) phase_postproj(F);
    SEAM(4);
#ifdef DN_NAIVE
    if (IN(5)) phase_dn_naive(F);
    SEAM(5);
    if (IN(6)) phase_attention(F, (char*)lds);
#else
    if (IN(5)) RP(5) phase_dn_prep(F);
    SEAM(5);
    if (IN(6)) { RP(14) { phase_dn_scan(F); __syncthreads(); } phase_attention(F, (char*)lds); }
#endif
    SEAM(6);
    if (IN(7)) phase_mergeprep(F);
    SEAM(7);
    if (IN(8)) RP(8) {
#if MERGE_F8_A || MERGE_F8_B || defined(MERGE_TWO_PASS)
        pg8::StaticOrder S; S.init(NT, DM, F.G, (int)blockIdx.x);
        { pg8::Gemm g{(const bf16*)(F.ws + (MERGE_F8_A ? WS_OATT8 : WS_QN)), (const bf16*)(F.ws + WS_WBA), NT, DM, MERGE_F8_A ? 512 : 1024};
          EpiMerge<false> E{(bf16*)(F.ws + WS_Y), (const unsigned char*)(F.ws + WS_G), 0, MERGE_F8_A ? 1.f / (255.f * WB_SCALE * OATT_SCALE) : 1.f / 255.f};
          pg8::gemm_phase<EpiMerge<false>, pg8::StaticOrder, true, true, MERGE_F8_A != 0>(F.lds, g, S, E); }
        __syncthreads();
        { pg8::Gemm g{(const bf16*)(F.ws + (MERGE_F8_B ? WS_ODNN8 : WS_Z)), (const bf16*)(F.ws + WS_WBD), NT, DM, MERGE_F8_B ? 512 : 1024};
          EpiMerge<true> E{(bf16*)(F.ws + WS_Y), (const unsigned char*)(F.ws + WS_G), 2048, MERGE_F8_B ? 1.f / (255.f * WB_SCALE * ODNN_SCALE) : 1.f / 255.f};
          pg8::gemm_phase<EpiMerge<true>, pg8::StaticOrder, true, true, MERGE_F8_B != 0>(F.lds, g, S, E); }
#else
        pg8::TwoStageOrder S; S.init(NT, DM, F.G, (int)blockIdx.x);
        pg8::Gemm g{(const bf16*)(F.ws + WS_QN), (const bf16*)(F.ws + WS_WBA), NT, DM, 1024, (const bf16*)(F.ws + WS_Z), (const bf16*)(F.ws + WS_WBD)};
        EpiMerge2 E{(bf16*)(F.ws + WS_Y), (const unsigned char*)(F.ws + WS_G)};
        pg8::gemm_phase<EpiMerge2, pg8::TwoStageOrder, true, true>(F.lds, g, S, E);
#endif
    }
    SEAM(8);
    if (IN(9)) RP(9) {
        pg8::Gemm g{(const bf16*)(F.ws + WS_Y), (const bf16*)(F.ws + WS_WOUT), NT, DM, DM}; pg8::StaticOrder S; S.init(NT, DM, F.G, (int)blockIdx.x);
        EpiResid E{F.in[0], (bf16*)(F.ws + WS_X1), (const float*)(F.ws + WS_MOD)};
        pg8::gemm_phase<EpiResid, pg8::StaticOrder, true, true>(F.lds, g, S, E);
    }
    SEAM(9);
    if (IN(10)) RP(10) phase_h2(F);
    SEAM(10);
    if (IN(11)) RP(11) {
        pg8::Gemm g{(const bf16*)(F.ws + WS_H2), (const bf16*)(F.ws + WS_WQ), NT, DM, DM}; pg8::StaticOrder S; S.init(NT, DM, F.G, (int)blockIdx.x);
        EpiPlain E{(bf16*)(F.ws + WS_PQ), 2048};
        pg8::gemm_phase<EpiPlain, pg8::StaticOrder, true, true>(F.lds, g, S, E);
    }
    SEAM(11);
    if (IN(12)) { RP(12) { phase_peer_topk(F); __syncthreads(); } phase_quant(F); }
    SEAM(12);
#ifdef GATHER_PROBE_MASK
    if (IN(13)) {
#pragma nounroll
        for (int rep_ = 0; rep_ < 2; ++rep_) { phase_peer_gather(F, rep_ == 0 ? GATHER_PROBE_MASK : 0x3fff, rep_ == 0 ? GATHER_PROBE_VMASK : 0x3fff); __syncthreads(); }
    }
#else
    if (IN(13)) RP(13) phase_peer_gather(F);
#endif
#undef IN
#undef SEAM
}

extern "C" void kernel_launch(void* const* d_in, const int* in_sizes, int n_in, void* d_out, int out_size, void* d_ws, size_t ws_size, hipStream_t stream) {
    static int grid = 0;
    if (grid == 0) {
        if (n_in != 23 || in_sizes[0] != NT * DM || out_size != NT * DM || ws_size < WS_END) {
            fprintf(stderr, "kernel_launch: unexpected shapes (n_in %d, in0 %d, out %d, ws %zu < %zu); nothing launched\n", n_in, n_in > 0 ? in_sizes[0] : -1, out_size, ws_size, (size_t)WS_END);
            grid = -1; return; }
        int dev = 0, cus = 0, per_cu = 0;
        if (hipGetDevice(&dev) != hipSuccess || hipDeviceGetAttribute(&cus, hipDeviceAttributeMultiprocessorCount, dev) != hipSuccess) { grid = -1; return; }
        if (hipFuncSetAttribute((const void*)mk_fwd, hipFuncAttributeMaxDynamicSharedMemorySize, LDS_BYTES) != hipSuccess) { fprintf(stderr, "kernel_launch: hipFuncSetAttribute failed\n"); grid = -1; return; }
        if (hipOccupancyMaxActiveBlocksPerMultiprocessor(&per_cu, (const void*)mk_fwd, NWAVES * 64, LDS_BYTES) != hipSuccess || per_cu < 1) { fprintf(stderr, "kernel_launch: occupancy query says %d blocks per CU\n", per_cu); (void)hipGetLastError(); grid = -1; return; }
        grid = cus;
    }
    if (grid < 0) return;
    (void)hipMemsetAsync((char*)d_ws + WS_CTL, 0, 1 * MiB, stream);
    Args a{};
    for (int i = 0; i < 23; ++i) a.in[i] = (const float*)d_in[i];
    a.out = (float*)d_out; a.ws = (unsigned char*)d_ws;
#if MK_N_LAUNCHES == 1
    a.ph_lo = 0; a.ph_hi = NPHASE;
    void* kargs[] = {(void*)&a};
    const hipError_t e = hipLaunchCooperativeKernel((const void*)mk_fwd, dim3(grid), dim3(NWAVES * 64), kargs, LDS_BYTES, stream);
    if (e != hipSuccess) fprintf(stderr, "kernel_launch: cooperative launch failed: %s (grid %d)\n", hipGetErrorString(e), grid);
#else
    for (int p = 0; p < NPHASE; ++p) {
        a.ph_lo = p; a.ph_hi = p + 1;
        hipLaunchKernelGGL(mk_fwd, dim3(grid), dim3(NWAVES * 64), LDS_BYTES, stream, a);
    }
    const hipError_t le = hipPeekAtLastError();
    if (le != hipSuccess) fprintf(stderr, "kernel_launch: launch failed: %s\n", hipGetErrorName(le));
#endif
}
```

```cpp
#define DN_SLEEP 0

#include <hip/hip_runtime.h>
#include <hip/hip_cooperative_groups.h>
#include <cstdio>
#include <cstdint>
namespace cg = cooperative_groups;

#ifndef MK_N_LAUNCHES
#define MK_N_LAUNCHES 1
#endif
namespace pg8 {
#define PG8_LAS __attribute__((address_space(3)))
typedef unsigned short bf16_t;
typedef short bf16x8 __attribute__((ext_vector_type(8)));
typedef float f32x4 __attribute__((ext_vector_type(4)));
typedef int pg8_v4i __attribute__((ext_vector_type(4)));
typedef int pg8_v8i __attribute__((ext_vector_type(8)));
typedef unsigned u32x4 __attribute__((ext_vector_type(4)));
constexpr int BM = 256, BK = 64, HALF = 128, HTB = HALF * BK * 2  , STAGE_BYTES = 8 * HTB, NXCD = 8, WGM = 8;

__host__ __device__ __forceinline__ int lds_byte(int r, int c) { const int st = (r >> 4) * 2 + (c >> 5), rr = r & 15, cc = c & 31, ob = rr * 64 + cc * 2; return st * 1024 + (ob ^ (((ob >> 9) & 1) << 5)); }
__host__ __device__ __forceinline__ void stage_rc(int b, int& R, int& C) { const int st = b / 1024, sb = b % 1024, swz = sb ^ (((sb >> 9) & 1) << 5); R = (st >> 1) * 16 + swz / 64; C = (st & 1) * 32 + (swz % 64) / 2; }
__host__ __device__ __forceinline__ int perm32(int rho) { const int n = rho >> 4, i = rho & 15; return 8 * (i >> 2) + 4 * n + (i & 3); }

struct Unit { int pm, pn, sel; };
struct Gemm { const bf16_t* A; const bf16_t* Bt; int M, N, K; const bf16_t* A2 = nullptr; const bf16_t* Bt2 = nullptr; };

struct StaticOrder {
    int nM, nN, nwg, G, c;
    __host__ __device__ void init(int M, int N, int G_, int c_) { nM = M / BM; nN = N / BM; nwg = nM * nN; G = G_; c = c_; }
    __host__ __device__ bool next(int i, Unit& u) const {
        const long L = (long)i * G + c; if (L >= nwg) return false;
        int wgid = (int)L; { const int q = nwg / NXCD, r = nwg % NXCD, xcd = wgid % NXCD, off = wgid / NXCD; wgid = (xcd < r ? xcd * (q + 1) : r * (q + 1) + (xcd - r) * q) + off; }
        const int nig = WGM * nN, gid = wgid / nig, fm = gid * WGM, gsz = (nM - fm) < WGM ? (nM - fm) : WGM;
        u.pm = fm + ((wgid % nig) % gsz); u.pn = (wgid % nig) / gsz; return true;
    }
    __device__ __forceinline__ void a_ready(const Unit&) const {}
    __device__ __forceinline__ void done(const Unit&) const {}
};
struct TwoStageOrder {
    StaticOrder base;
    __host__ __device__ void init(int M, int N, int G_, int c_) { base.init(M, N, G_, c_); }
    __host__ __device__ bool next(int i, Unit& u) const { if (!base.next(i >> 1, u)) return false; u.sel = i & 1; return true; }
    __device__ __forceinline__ void a_ready(const Unit&) const {}
    __device__ __forceinline__ void done(const Unit&) const {}
};

__device__ __forceinline__ unsigned cvt_pk_bf16(float lo, float hi) { unsigned r; asm volatile("v_cvt_pk_bf16_f32 %0, %1, %2" : "=v"(r) : "v"(lo), "v"(hi)); return r; }
typedef float f32x2 __attribute__((ext_vector_type(2)));
template <class Epi, class Sched, bool ALIGN_EPI = false, bool SP2 = false, bool F8 = false>
__device__ __forceinline__ void gemm_phase(PG8_LAS unsigned char* lds, const Gemm g, const Sched& S, const Epi& E) {
    const int tid = threadIdx.x, wid = __builtin_amdgcn_readfirstlane(tid >> 6), lane = tid & 63, wr = wid >> 2, wc = wid & 3, fr = lane & 15, fq = lane >> 4;
    const int K = g.K, nt = K / BK;
    unsigned voffA[2], voffB[2];
#pragma unroll
    for (int i = 0; i < 2; ++i) { int R, C; stage_rc(tid * 16 + i * 8192, R, C); const int Rb = Epi::PERM ? ((R & ~31) + perm32(R & 31)) : R;
        voffA[i] = (unsigned)(R * K + C) * 2u; voffB[i] = (unsigned)(Rb * K + C) * 2u; }
    const size_t kstep = (size_t)(BK * 2);
    const size_t hstep = (size_t)HALF * K * 2;
    const size_t tstep = 2 * hstep;
    const unsigned ldsw = (unsigned)wid * 1024u;
    const int aoff = lds_byte(wr * 64 + fr, fq * 8), boff = lds_byte(wc * 32 + fr, fq * 8);
#define PG8_SA(b, h) (((b) * 2 + (h)) * HTB)
#define PG8_SB(b, h) ((4 + (b) * 2 + (h)) * HTB)
#define PG8_STAGE(bufoff, gbase, voff) do { _Pragma("unroll") for (int _i = 0; _i < 2; ++_i) \
        __builtin_amdgcn_global_load_lds((const unsigned*)((const char*)(gbase) + (voff)[_i]), (PG8_LAS unsigned*)(lds + (bufoff) + ldsw + _i * 8192), 16, 0, 0); } while (0)
#define PG8_LDA(dst, b, h) do { _Pragma("unroll") for (int m = 0; m < 4; ++m) { \
        if constexpr (F8) { const pg8_v4i t0_ = *(const PG8_LAS pg8_v4i*)(lds + PG8_SA(b, h) + aoff + m * 2048), t1_ = *(const PG8_LAS pg8_v4i*)(lds + PG8_SA(b, h) + aoff + m * 2048 + 1024); \
            dst##8[m] = __builtin_shufflevector(t0_, t1_, 0, 1, 2, 3, 4, 5, 6, 7); } \
        else { _Pragma("unroll") for (int k = 0; k < 2; ++k) dst[m][k] = *(const PG8_LAS bf16x8*)(lds + PG8_SA(b, h) + aoff + m * 2048 + k * 1024); } } } while (0)
#define PG8_LDB(dst, b, h) do { _Pragma("unroll") for (int n = 0; n < 2; ++n) { \
        if constexpr (F8) { const pg8_v4i t0_ = *(const PG8_LAS pg8_v4i*)(lds + PG8_SB(b, h) + boff + n * 2048), t1_ = *(const PG8_LAS pg8_v4i*)(lds + PG8_SB(b, h) + boff + n * 2048 + 1024); \
            dst##8[n] = __builtin_shufflevector(t0_, t1_, 0, 1, 2, 3, 4, 5, 6, 7); } \
        else { _Pragma("unroll") for (int k = 0; k < 2; ++k) dst[n][k] = *(const PG8_LAS bf16x8*)(lds + PG8_SB(b, h) + boff + n * 2048 + k * 1024); } } } while (0)
#define PG8_MMA(ai, bj, At, Bt) do { __builtin_amdgcn_s_setprio(1); _Pragma("unroll") for (int m = 0; m < 4; ++m) _Pragma("unroll") for (int n = 0; n < 2; ++n) { \
        if constexpr (F8) { asm volatile("v_mfma_scale_f32_16x16x128_f8f6f4 %0, %1, %2, %0, %3, %3 op_sel_hi:[0,0,0]" : "+v"(acc[ai][bj][m][n]) : "v"(Bt##8[n]), "v"(At##8[m]), "v"(0x7F7F7F7F)); } \
        else { _Pragma("unroll") for (int k = 0; k < 2; ++k) acc[ai][bj][m][n] = __builtin_amdgcn_mfma_f32_16x16x32_bf16(Bt[n][k], At[m][k], acc[ai][bj][m][n], 0, 0, 0); } } \
        __builtin_amdgcn_s_setprio(0); } while (0)
#define PG8_WAIT_V(n) asm volatile("s_waitcnt vmcnt(" #n ")" ::: "memory")
#define PG8_WAIT_L(n) asm volatile("s_waitcnt lgkmcnt(" #n ")" ::: "memory")
#define PG8_BAR __builtin_amdgcn_s_barrier()
#define PG8_SCHED __builtin_amdgcn_sched_barrier(0)
    Unit cur, nxt; int ui = 0;
    if (!S.next(0, cur)) return;
    f32x4 acc[2][2][4][2];
#pragma unroll
    for (int a = 0; a < 2; ++a)
#pragma unroll
        for (int b = 0; b < 2; ++b)
#pragma unroll
            for (int m = 0; m < 4; ++m)
#pragma unroll
                for (int n = 0; n < 2; ++n) acc[a][b][m][n] = (f32x4){0.f, 0.f, 0.f, 0.f};
    bf16x8 At[4][2], B0[2][2], B1[2][2];
    pg8_v8i At8[4], B08[2], B18[2];
    const char* cA = (const char*)g.A + (size_t)cur.pm * tstep; const char* cB = (const char*)g.Bt + (size_t)cur.pn * tstep;
    S.a_ready(cur);
    if constexpr (SP2) {
        PG8_STAGE(PG8_SB(0, 0), cB, voffB); PG8_STAGE(PG8_SB(0, 1), cB + hstep, voffB); PG8_STAGE(PG8_SA(0, 0), cA, voffA); PG8_STAGE(PG8_SA(0, 1), cA + hstep, voffA);
        if (wr == 1) PG8_BAR;
        PG8_WAIT_V(2); PG8_BAR;
        PG8_STAGE(PG8_SB(1, 0), cB + kstep, voffB); PG8_STAGE(PG8_SA(1, 0), cA + kstep, voffA); PG8_STAGE(PG8_SB(1, 1), cB + hstep + kstep, voffB);
        PG8_WAIT_V(6); PG8_BAR;
    } else {
        PG8_STAGE(PG8_SB(0, 0), cB, voffB); PG8_STAGE(PG8_SA(0, 0), cA, voffA); PG8_STAGE(PG8_SB(0, 1), cB + hstep, voffB); PG8_STAGE(PG8_SA(0, 1), cA + hstep, voffA);
        if (wr == 1) PG8_BAR;
        PG8_WAIT_V(4); PG8_BAR;
        PG8_STAGE(PG8_SB(1, 0), cB + kstep, voffB); PG8_STAGE(PG8_SA(1, 0), cA + kstep, voffA); PG8_STAGE(PG8_SB(1, 1), cB + hstep + kstep, voffB);
        PG8_WAIT_V(6); PG8_BAR;
    }
    for (;;) {
        const bool has_next = S.next(ui + 1, nxt);
        const bf16_t* gA = g.A; const bf16_t* gB = g.Bt;
        if constexpr (Epi::TWO_STAGE) { if (has_next && nxt.sel) { gA = g.A2; gB = g.Bt2; } }
        const char* nA = has_next ? (const char*)gA + (size_t)nxt.pm * tstep : cA; const char* nB = has_next ? (const char*)gB + (size_t)nxt.pn * tstep : cB;
        for (int t = 0; t < nt; t += 2) {
            const bool last = (t == nt - 2);
            const char* a1 = cA + (size_t)(t + 1) * kstep;
            const char* a2 = last ? nA : cA + (size_t)(t + 2) * kstep; const char* b2 = last ? nB : cB + (size_t)(t + 2) * kstep;
            const char* a3 = a2 + kstep; const char* b3 = b2 + kstep;
            if (last && has_next) S.a_ready(nxt);
            if constexpr (SP2) {
            PG8_LDB(B0, 0, 0); PG8_LDB(B1, 0, 1); PG8_SCHED; PG8_LDA(At, 0, 0); PG8_STAGE(PG8_SA(1, 1), a1 + hstep, voffA);
            PG8_WAIT_V(8); PG8_WAIT_L(0); PG8_BAR; PG8_MMA(0, 0, At, B0); PG8_MMA(0, 1, At, B1); PG8_BAR; PG8_SCHED;
            PG8_LDA(At, 0, 1); PG8_STAGE(PG8_SB(0, 0), b2, voffB); PG8_STAGE(PG8_SB(0, 1), b2 + hstep, voffB); PG8_STAGE(PG8_SA(0, 0), a2, voffA);
            PG8_WAIT_V(8); PG8_WAIT_L(0); PG8_BAR; PG8_MMA(1, 0, At, B0); PG8_MMA(1, 1, At, B1); PG8_BAR; PG8_SCHED;
            PG8_LDB(B0, 1, 0); PG8_LDB(B1, 1, 1); PG8_SCHED; PG8_LDA(At, 1, 0); PG8_STAGE(PG8_SA(0, 1), a2 + hstep, voffA);
            PG8_WAIT_V(8); PG8_WAIT_L(0); PG8_BAR; PG8_MMA(0, 0, At, B0); PG8_MMA(0, 1, At, B1); PG8_BAR; PG8_SCHED;
            PG8_LDA(At, 1, 1); PG8_STAGE(PG8_SB(1, 0), b3, voffB); PG8_STAGE(PG8_SB(1, 1), b3 + hstep, voffB); PG8_STAGE(PG8_SA(1, 0), a3, voffA);
            PG8_WAIT_V(8); PG8_WAIT_L(0); PG8_BAR; PG8_MMA(1, 0, At, B0); PG8_MMA(1, 1, At, B1); PG8_BAR; PG8_SCHED;
            } else {
            PG8_LDB(B0, 0, 0); PG8_SCHED; PG8_LDA(At, 0, 0); PG8_STAGE(PG8_SA(1, 1), a1 + hstep, voffA);
            PG8_WAIT_L(8); PG8_BAR; PG8_WAIT_L(0); PG8_MMA(0, 0, At, B0); PG8_BAR; PG8_SCHED;
            PG8_LDB(B1, 0, 1); PG8_STAGE(PG8_SB(0, 0), b2, voffB);
            PG8_BAR; PG8_WAIT_L(0); PG8_MMA(0, 1, At, B1); PG8_BAR;
            PG8_LDA(At, 0, 1); PG8_STAGE(PG8_SA(0, 0), a2, voffA);
            PG8_BAR; PG8_WAIT_L(0); PG8_MMA(1, 0, At, B0); PG8_BAR; PG8_SCHED;
            PG8_STAGE(PG8_SB(0, 1), b2 + hstep, voffB);
            PG8_WAIT_V(6); PG8_BAR; PG8_MMA(1, 1, At, B1); PG8_BAR;
            PG8_LDB(B0, 1, 0); PG8_SCHED; PG8_LDA(At, 1, 0); PG8_STAGE(PG8_SA(0, 1), a2 + hstep, voffA);
            PG8_WAIT_L(8); PG8_BAR; PG8_WAIT_L(0); PG8_MMA(0, 0, At, B0); PG8_BAR; PG8_SCHED;
            PG8_LDB(B1, 1, 1); PG8_STAGE(PG8_SB(1, 0), b3, voffB);
            PG8_BAR; PG8_WAIT_L(0); PG8_MMA(0, 1, At, B1); PG8_BAR;
            PG8_LDA(At, 1, 1); PG8_STAGE(PG8_SA(1, 0), a3, voffA);
            PG8_BAR; PG8_WAIT_L(0); PG8_MMA(1, 0, At, B0); PG8_BAR; PG8_SCHED;
            PG8_STAGE(PG8_SB(1, 1), b3 + hstep, voffB);
            PG8_WAIT_V(6); PG8_BAR; PG8_MMA(1, 1, At, B1); PG8_BAR;
            }
        }
        if constexpr (ALIGN_EPI) { if (wr == 0) PG8_BAR; }
        bool keep = false;
        if constexpr (Epi::TWO_STAGE) keep = (cur.sel == 0);
        if constexpr (!Epi::AFTER_DRAIN) {
            if constexpr (Epi::TWO_STAGE) { if (keep) E.mid(acc, cur, wr, wc, fr, fq); else E(acc, cur, wr, wc, fr, fq); }
            else E(acc, cur, wr, wc, fr, fq);
            S.done(cur); }
        if (!has_next) break;
        if (!keep)
#pragma unroll
        for (int a = 0; a < 2; ++a)
#pragma unroll
            for (int b = 0; b < 2; ++b)
#pragma unroll
                for (int m = 0; m < 4; ++m)
#pragma unroll
                    for (int n = 0; n < 2; ++n) acc[a][b][m][n] = (f32x4){0.f, 0.f, 0.f, 0.f};
        cur = nxt; cA = nA; cB = nB; ++ui;
        if constexpr (ALIGN_EPI) { if (wr == 1) PG8_BAR; }
    }
    PG8_WAIT_V(0);
    if constexpr (!ALIGN_EPI) { if (wr == 0) PG8_BAR; }
    PG8_BAR;
    if constexpr (Epi::AFTER_DRAIN) { E.fused(acc, cur, wr, wc, fr, fq, lds, wid, lane); S.done(cur); }
#undef PG8_SA
#undef PG8_SB
#undef PG8_STAGE
#undef PG8_LDA
#undef PG8_LDB
#undef PG8_MMA
#undef PG8_WAIT_V
#undef PG8_WAIT_L
#undef PG8_BAR
#undef PG8_SCHED
}
}
namespace attn {
using bf16 = unsigned short;
constexpr int D = 128, NW = 8, QBLK = 32, KVBLK = 64;
constexpr float SCALE = 0.088388347648318440f;
constexpr float THR = 8.f;
constexpr int SDEPTH = 2;
constexpr int LDQ = 1024, LDK = 256, LDO = 1024;
constexpr size_t SHM_V = KVBLK * D * 2, SHM_K = KVBLK * D * 2, SHM_ATTN = 2 * SHM_V + 2 * SHM_K + NW * 64 * 4;
__device__ __forceinline__ unsigned short f2bf_rne(float f) { unsigned u = __float_as_uint(f); return (unsigned short)((u + 0x7fffu + ((u >> 16) & 1u)) >> 16); }
using bf16x8 = __attribute__((ext_vector_type(8))) short;
using s16x4  = __attribute__((ext_vector_type(4))) short;
using f32x16 = __attribute__((ext_vector_type(16))) float;
using f32x8  = __attribute__((ext_vector_type(8))) float;
using u32x4  = __attribute__((ext_vector_type(4))) unsigned;
#define KSWZ(row, colB) ((row) * 256 + ((colB) ^ (((row) & 7) << 4)))
#define SBAR() __builtin_amdgcn_sched_barrier(0)
__device__ __forceinline__ int crow(int r, int hi) { return (r & 3) + 8 * (r >> 2) + 4 * hi; }
__device__ __forceinline__ unsigned cvtpk(float lo, float hi) {
  unsigned r; asm volatile("v_cvt_pk_bf16_f32 %0, %1, %2" : "=v"(r) : "v"(lo), "v"(hi)); return r;
}
template <typename TIn> struct Stage;
template <> struct Stage<bf16>  { using T = bf16x8;
  __device__ static __forceinline__ T ld8(const bf16* p) { return *reinterpret_cast<const bf16x8*>(p); }
  __device__ static __forceinline__ bf16x8 tobf(T x) { return x; } };
template <> struct Stage<float> { using T = f32x8;
  __device__ static __forceinline__ T ld8(const float* p) { return *reinterpret_cast<const f32x8*>(p); }
  __device__ static __forceinline__ bf16x8 tobf(T x) {
    u32x4 w = {cvtpk(x[0], x[1]), cvtpk(x[2], x[3]), cvtpk(x[4], x[5]), cvtpk(x[6], x[7])}; return *reinterpret_cast<bf16x8*>(&w); } };

__device__ __forceinline__ void partialSM(f32x16& p0, f32x16& p1, float& m_reg, float& mn, float& alpha) {
  constexpr float C = SCALE * 1.4426950408889634f;
  float pmax = p0[0]; for (int r = 1; r < 16; ++r) pmax = fmaxf(pmax, p0[r]); for (int r = 0; r < 16; ++r) pmax = fmaxf(pmax, p1[r]);
  { auto rr = __builtin_amdgcn_permlane32_swap(__float_as_uint(pmax), __float_as_uint(pmax), false, false);
    pmax = fmaxf(__uint_as_float(rr[0]), __uint_as_float(rr[1])); }
  if (__builtin_expect(__all(pmax - m_reg <= THR / SCALE), 1)) { mn = m_reg; alpha = 1.f; }
  else { mn = fmaxf(m_reg, pmax); alpha = __builtin_amdgcn_exp2f((m_reg - mn) * C); m_reg = mn; }
  float mnC = -mn * C;
  for (int r = 0; r < 16; ++r) p0[r] = fmaf(p0[r], C, mnC); for (int r = 0; r < 16; ++r) p1[r] = fmaf(p1[r], C, mnC);
  for (int r = 0; r < 16; ++r) p0[r] = __builtin_amdgcn_exp2f(p0[r]);
}
__device__ __forceinline__ void finishSM(f32x16& p0, f32x16& p1, float alpha, float& l_reg, bf16x8& pa0, bf16x8& pa1, bf16x8& pa2, bf16x8& pa3) {
  for (int r = 0; r < 16; ++r) p1[r] = __builtin_amdgcn_exp2f(p1[r]);
  float ps = 0; for (int r = 0; r < 16; ++r) ps += p0[r]; for (int r = 0; r < 16; ++r) ps += p1[r];
  { auto rr = __builtin_amdgcn_permlane32_swap(__float_as_uint(ps), __float_as_uint(ps), false, false);
    ps = __uint_as_float(rr[0]) + __uint_as_float(rr[1]); }
  l_reg = l_reg * alpha + ps;
#define PK4(P, BASE, OUT) do { unsigned a0 = cvtpk(P[BASE + 0], P[BASE + 1]), a1 = cvtpk(P[BASE + 2], P[BASE + 3]);   \
    unsigned b0 = cvtpk(P[BASE + 4], P[BASE + 5]), b1 = cvtpk(P[BASE + 6], P[BASE + 7]);                              \
    auto r0 = __builtin_amdgcn_permlane32_swap(a0, b0, false, false); auto r1 = __builtin_amdgcn_permlane32_swap(a1, b1, false, false); \
    u32x4 w = {r0[0], r1[0], r0[1], r1[1]}; OUT = *reinterpret_cast<bf16x8*>(&w); } while (0)
  PK4(p0, 0, pa0); PK4(p0, 8, pa1); PK4(p1, 0, pa2); PK4(p1, 8, pa3);
#undef PK4
}
__device__ __forceinline__ void qkt(f32x16& p0, f32x16& p1, const bf16* Ks, const bf16x8* qr, int r32, int hi) {
  p0 = f32x16{}; p1 = f32x16{};
  for (int d0 = 0; d0 < 8; ++d0) { int cb = (d0 * 16 + hi * 8) * 2;
    bf16x8 b0 = *reinterpret_cast<const bf16x8*>((const char*)Ks + KSWZ(r32, cb));
    bf16x8 b1 = *reinterpret_cast<const bf16x8*>((const char*)Ks + KSWZ(32 + r32, cb));
    p0 = __builtin_amdgcn_mfma_f32_32x32x16_bf16(b0, qr[d0], p0, 0, 0, 0);
    p1 = __builtin_amdgcn_mfma_f32_32x32x16_bf16(b1, qr[d0], p1, 0, 0, 0); }
}
__device__ __forceinline__ int v_st(int k, int c) { const int kk = (k & ~0xC) | ((k & 4) << 1) | ((k & 8) >> 1); return ((kk >> 3) * 4 + (c >> 5)) * 512 + ((kk & 7) * 32 + (c & 31)) * 2; }
__device__ __forceinline__ int v_rd_base(int lane) { return ((lane & 3) << 3) | (((lane >> 2) & 3) << 6) | (((lane >> 4) & 1) << 5) | (((lane >> 5) & 1) << 8); }
constexpr int v_rd_off(int d0, int ks, int half) { return d0 * 512 + ks * 4096 + half * 2048; }
template <int OFF> __device__ __forceinline__ s16x4 tr_read(int vb) {
  s16x4 r; asm volatile("ds_read_b64_tr_b16 %0, %1 offset:%2" : "=&v"(r) : "v"(vb), "i"(OFF) : "memory"); return r;
}
template <int D0> __device__ __forceinline__ void pv_one(f32x16& od, int vb, bf16x8 pa0, bf16x8 pa1, bf16x8 pa2, bf16x8 pa3) {
  const s16x4 l0 = tr_read<v_rd_off(D0, 0, 0)>(vb), h0 = tr_read<v_rd_off(D0, 0, 1)>(vb), l1 = tr_read<v_rd_off(D0, 1, 0)>(vb), h1 = tr_read<v_rd_off(D0, 1, 1)>(vb);
  const s16x4 l2 = tr_read<v_rd_off(D0, 2, 0)>(vb), h2 = tr_read<v_rd_off(D0, 2, 1)>(vb), l3 = tr_read<v_rd_off(D0, 3, 0)>(vb), h3 = tr_read<v_rd_off(D0, 3, 1)>(vb);
  asm volatile("s_waitcnt lgkmcnt(0)" ::: "memory"); SBAR();
#define PK(L, H) (bf16x8){L[0], L[1], L[2], L[3], H[0], H[1], H[2], H[3]}
  od = __builtin_amdgcn_mfma_f32_32x32x16_bf16(pa0, PK(l0, h0), od, 0, 0, 0);
  od = __builtin_amdgcn_mfma_f32_32x32x16_bf16(pa1, PK(l1, h1), od, 0, 0, 0);
  od = __builtin_amdgcn_mfma_f32_32x32x16_bf16(pa2, PK(l2, h2), od, 0, 0, 0);
  od = __builtin_amdgcn_mfma_f32_32x32x16_bf16(pa3, PK(l3, h3), od, 0, 0, 0);
#undef PK
}
__device__ __forceinline__ void pv_d0(f32x16* o, int vb, bf16x8 pa0, bf16x8 pa1, bf16x8 pa2, bf16x8 pa3) {
  pv_one<0>(o[0], vb, pa0, pa1, pa2, pa3); pv_one<1>(o[1], vb, pa0, pa1, pa2, pa3); pv_one<2>(o[2], vb, pa0, pa1, pa2, pa3); pv_one<3>(o[3], vb, pa0, pa1, pa2, pa3);
}

template <typename TQ>
__device__ __forceinline__ void attn_dense_body(const TQ* __restrict__ Qb, const bf16* __restrict__ Kh, const bf16* __restrict__ Vh,
                                                bf16* __restrict__ Ob, int seq, char* lds) {
  using St = Stage<bf16>; using SQ = Stage<TQ>;
  const int tid = threadIdx.x, wid = tid >> 6, lane = tid & 63, r32 = lane & 31, hi = lane >> 5;
  bf16* V_lds = (bf16*)lds; bf16* K_lds = (bf16*)(lds + 2 * SHM_V);
  float* ws = (float*)(lds + 2 * SHM_V + 2 * SHM_K) + wid * 64; float* li_l = ws; float* al_l = ws + 32;
  float m_reg = -1e30f, l_reg = 0; f32x16 o[4] = {}; bf16x8 qr[8];
  const TQ* Qw = Qb + (long)(wid * QBLK + r32) * LDQ + hi * 8;
#pragma unroll
  for (int d0 = 0; d0 < 8; ++d0) qr[d0] = SQ::tobf(SQ::ld8(Qw + d0 * 16));
  const int sr = tid >> 4, sc = (tid & 15) * 8, vst0 = v_st(sr, sc), vst1 = v_st(32 + sr, sc);
  const int vb0 = (int)(uintptr_t)V_lds + v_rd_base(lane);
  struct { typename St::T vs0, vs1, ks0, ks1; } sr_[SDEPTH];
#define SLOAD(i, k0) do { sr_[i].vs0 = St::ld8(&Vh[(long)((k0) + sr) * LDK + sc]); sr_[i].vs1 = St::ld8(&Vh[(long)((k0) + 32 + sr) * LDK + sc]); \
    sr_[i].ks0 = St::ld8(&Kh[(long)((k0) + sr) * LDK + sc]); sr_[i].ks1 = St::ld8(&Kh[(long)((k0) + 32 + sr) * LDK + sc]); } while (0)
#define SWRITE(b, i) do { *(bf16x8*)((char*)V_lds + (b) * SHM_V + vst0) = St::tobf(sr_[i].vs0);          \
    *(bf16x8*)((char*)V_lds + (b) * SHM_V + vst1) = St::tobf(sr_[i].vs1); int kc = sc * 2;               \
    *(bf16x8*)((char*)K_lds + (b) * SHM_K + KSWZ(sr, kc)) = St::tobf(sr_[i].ks0);                       \
    *(bf16x8*)((char*)K_lds + (b) * SHM_K + KSWZ(32 + sr, kc)) = St::tobf(sr_[i].ks1); } while (0)
#define SWAIT() do { if constexpr (SDEPTH == 2) asm volatile("s_waitcnt vmcnt(4)" ::: "memory"); else asm volatile("s_waitcnt vmcnt(0)" ::: "memory"); } while (0)
#define RESC(a) do { if (__any((a) < 1.f)) { if (hi == 0) al_l[r32] = (a); asm volatile("s_waitcnt lgkmcnt(0)" ::: "memory"); \
    for (int d = 0; d < 4; ++d) for (int r = 0; r < 16; ++r) o[d][r] *= al_l[crow(r, hi)]; } } while (0)
  f32x16 pA0, pA1, pB0, pB1; float mnA, mnB, alA, alB; bf16x8 pa0, pa1, pa2, pa3; const int NT = seq / KVBLK;
  constexpr int SE = 0, SO = SDEPTH - 1;
  SLOAD(SE, 0); asm volatile("s_waitcnt vmcnt(0)" ::: "memory"); SWRITE(0, SE); __syncthreads();
  qkt(pA0, pA1, K_lds, qr, r32, hi); partialSM(pA0, pA1, m_reg, mnA, alA);
  SLOAD(SO, KVBLK); if constexpr (SDEPTH == 2) { if (2 < NT) SLOAD(SE, 2 * KVBLK); }
  SWAIT(); SWRITE(1, SO); __syncthreads();
  for (int j = 1; j + 1 < NT; j += 2) {
    SBAR(); qkt(pB0, pB1, (bf16*)((char*)K_lds + SHM_K), qr, r32, hi);
    finishSM(pA0, pA1, alA, l_reg, pa0, pa1, pa2, pa3); SBAR();
    SLOAD(SO, (j + SDEPTH) * KVBLK); SBAR();
    pv_d0(o, vb0, pa0, pa1, pa2, pa3); partialSM(pB0, pB1, m_reg, mnB, alB);
    __syncthreads(); SWAIT(); SWRITE(0, SE);
    RESC(alB); __syncthreads();
    SBAR(); qkt(pA0, pA1, K_lds, qr, r32, hi);
    finishSM(pB0, pB1, alB, l_reg, pa0, pa1, pa2, pa3); SBAR();
    if (SDEPTH == 1 || j + 3 < NT) SLOAD(SE, (j + 1 + SDEPTH) * KVBLK); SBAR();
    pv_d0(o, vb0 + (int)SHM_V, pa0, pa1, pa2, pa3); partialSM(pA0, pA1, m_reg, mnA, alA);
    __syncthreads(); SWAIT(); SWRITE(1, SO);
    RESC(alA); __syncthreads();
  }
  SBAR(); qkt(pB0, pB1, (bf16*)((char*)K_lds + SHM_K), qr, r32, hi);
  finishSM(pA0, pA1, alA, l_reg, pa0, pa1, pa2, pa3); SBAR();
  pv_d0(o, vb0, pa0, pa1, pa2, pa3); partialSM(pB0, pB1, m_reg, mnB, alB);
  __syncthreads(); RESC(alB);
  finishSM(pB0, pB1, alB, l_reg, pa0, pa1, pa2, pa3); SBAR();
  pv_d0(o, vb0 + (int)SHM_V, pa0, pa1, pa2, pa3);
  if (hi == 0) li_l[r32] = l_reg; asm volatile("s_waitcnt lgkmcnt(0)" ::: "memory");
  float rli[16];
#pragma unroll
  for (int r = 0; r < 16; ++r) rli[r] = __builtin_amdgcn_rcpf(li_l[crow(r, hi)]);
  bf16* Ow = Ob + (long)(wid * QBLK) * LDO;
#pragma unroll
  for (int r = 0; r < 16; ++r) { int orow = crow(r, hi);
    for (int d0 = 0; d0 < 4; ++d0) Ow[(long)orow * LDO + d0 * 32 + r32] = f2bf_rne(o[d0][r] * rli[r]); }
#undef SLOAD
#undef SWRITE
#undef SWAIT
#undef RESC
}
#undef KSWZ
#undef SBAR
}

constexpr int DM = 2048, NB = 4, TS = 4096, NT = NB * TS, CL = 256, NC = NB * CL, MTOT = NT + NC, LKV = TS + CL;
constexpr int NPROJ = 9984;
constexpr int INW = 9760;
constexpr int NEXP = 16384;
constexpr float EPS = 1e-6f;
constexpr int NWAVES = 8;
constexpr int NPHASE = 14;

constexpr size_t MiB = 1u << 20;
constexpr size_t WS_CTL = 0, WS_MOD = 1 * MiB, WS_MODP = 2 * MiB, WS_SUBK = 10 * MiB, WS_WBA = 11 * MiB, WS_WBD = 15 * MiB, WS_WOUT = 19 * MiB, WS_WQ = 27 * MiB;
constexpr size_t WS_BETA = 35 * MiB, WS_LOGA = 37 * MiB, WS_EXPI = 39 * MiB, WS_EXPG = 47 * MiB;
constexpr size_t WS_A = 56 * MiB;
constexpr size_t WS_WIN = WS_A, WS_H = WS_A + 39 * MiB;
constexpr size_t WS_DQ = WS_A, WS_DK = WS_A + 34 * MiB, WS_DV = WS_A + 68 * MiB;
constexpr size_t WS_Y = WS_A, WS_H2 = WS_A;
constexpr size_t WS_B = 164 * MiB;
constexpr size_t WS_QN = WS_B, WS_Z = WS_B + 32 * MiB, WS_PQ = WS_B;
constexpr size_t WS_KB = 228 * MiB, WS_VB = 237 * MiB;
constexpr size_t WS_C = 246 * MiB;
constexpr size_t WS_DNRAW = WS_C, WS_U8 = WS_C, WS_V8 = WS_C + 32 * MiB, WS_SU = WS_C + 64 * MiB, WS_SV = WS_C + 65 * MiB, WS_U4 = WS_C + 66 * MiB;
constexpr size_t WS_KT = WS_C, WS_TINV = WS_C + 34 * MiB, WS_QKO = WS_C + 68 * MiB, WS_VEC = WS_C + 102 * MiB;
constexpr size_t WS_D = 374 * MiB;
constexpr size_t WS_G = WS_D, WS_X1 = WS_D;
constexpr size_t WS_OATT8 = WS_D + 64 * MiB, WS_ODNN8 = WS_D + 80 * MiB;
#ifndef MERGE_F8_A
#define MERGE_F8_A 0
#endif
#ifndef MERGE_F8_B
#define MERGE_F8_B 0
#endif
constexpr float WB_SCALE = 64.f, OATT_SCALE = 16.f, ODNN_SCALE = 2.f;
constexpr size_t WS_ODN = 502 * MiB;
constexpr size_t WS_END = 566 * MiB;
static_assert((size_t)NPROJ * DM * 2 <= 39 * MiB && (size_t)MTOT * DM * 2 <= 69 * MiB && (size_t)MTOT * 1024 * 2 <= 34 * MiB && (size_t)MTOT * 3072 * 2 <= 128 * MiB, "ws map");
static_assert((size_t)NB * LKV * 256 * 2 <= 9 * MiB && (size_t)NT * 4096 * 2 <= 128 * MiB && (size_t)NEXP * DM * 2 <= 64 * MiB, "ws map");

constexpr int LDS_BYTES = 163840;

#define DI __device__ __forceinline__
#define LAS __attribute__((address_space(3)))
typedef unsigned short bf16;
typedef float f32x4 __attribute__((ext_vector_type(4)));
typedef float f32x2 __attribute__((ext_vector_type(2)));
typedef unsigned u32x4 __attribute__((ext_vector_type(4)));
typedef unsigned u32x2 __attribute__((ext_vector_type(2)));

typedef __bf16 bf16x2_n __attribute__((ext_vector_type(2)));
DI unsigned pk2(float lo, float hi) { const f32x2 v = {lo, hi}; return __builtin_bit_cast(unsigned, __builtin_convertvector(v, bf16x2_n)); }
DI unsigned f2bf(float f) { return pk2(f, f) & 0xffffu; }
DI float bflo(unsigned w) { return __uint_as_float(w << 16); }
DI float bfhi(unsigned w) { return __uint_as_float(w & 0xffff0000u); }
DI float bf2f(bf16 h) { return __uint_as_float((unsigned)h << 16); }
DI float wave_sum(float v) {
#pragma unroll
    for (int o = 1; o < 64; o <<= 1) v += __shfl_xor(v, o);
    return v;
}
DI unsigned wave_max_u32(unsigned v) {
#pragma unroll
    for (int o = 1; o < 64; o <<= 1) { const unsigned t = (unsigned)__shfl_xor((int)v, o); v = t > v ? t : v; }
    return v;
}
DI float sigm(float x) { return __builtin_amdgcn_rcpf(1.f + __expf(-x)); }
DI float silu(float x) { return x * __builtin_amdgcn_rcpf(1.f + __expf(-x)); }
DI float softplus(float x) { return x > 20.f ? x : log1pf(__expf(x)); }
DI float gelu_erf(float v) {
    const float av = fabsf(v), t = __builtin_amdgcn_rcpf(av * 0.2316418882f + 1.0f);
    float q = t * 0.5307027145f + (-0.7265760135f); q = q * t + 0.7107068705f; q = q * t + (-0.142248368f); q = q * t + 0.127414796f; q = q * t;
    const float e = __builtin_amdgcn_exp2f((v * v) * (-0.72134752044f));
    const float mm = v * (q * e);
    return v < 0.f ? mm : v - mm;
}
DI unsigned okey(float f) { const unsigned u = __float_as_uint(f); return (u & 0x80000000u) ? ~u : (u | 0x80000000u); }
DI unsigned rdlane(unsigned v, int l) { return (unsigned)__builtin_amdgcn_readlane((int)v, l); }
DI float rdlanef(float v, int l) { return __uint_as_float((unsigned)__builtin_amdgcn_readlane((int)__float_as_uint(v), l)); }

#define XB_TMO      128
#define XB_XCNT(j)  (256  + 64 * (j))
#define XB_XSUB(j)  (1280 + 64 * (j))
#define XB_XGEN(j)  (2304 + 64 * (j))
#define XB_TOP      3328
#define XB_TOPGEN   3392
#define XCD_BAR_WORDS 3456
#define XB_SPIN_CAP (1u << 18)

__device__ __forceinline__ unsigned xb_ld(unsigned* p)              { return __hip_atomic_load(p, __ATOMIC_RELAXED, __HIP_MEMORY_SCOPE_AGENT); }
__device__ __forceinline__ unsigned xb_add(unsigned* p, unsigned v) { return __hip_atomic_fetch_add(p, v, __ATOMIC_RELAXED, __HIP_MEMORY_SCOPE_AGENT); }
__device__ __forceinline__ unsigned xb_xcc_id() { return (unsigned)__builtin_amdgcn_s_getreg((3 << 11) | 20) & 0xFu; }
#define XB_SPIN(cond, bar) do { unsigned _sp = 0; while (cond) { __builtin_amdgcn_s_sleep(1); \
    if ((++_sp & 255u) == 0u) { if (xb_ld(&(bar)[XB_TMO])) break; if (_sp > XB_SPIN_CAP) { atomicAdd(&(bar)[XB_TMO], 1u); break; } } } } while (0)

struct XcdBarrier {
    unsigned* bar; unsigned x;
    volatile LAS unsigned* st;
};

__device__ __forceinline__ XcdBarrier xcd_barrier_post(unsigned* bar, volatile LAS unsigned* st) {
    XcdBarrier b; b.bar = bar; b.x = xb_xcc_id(); b.st = st;
    if (threadIdx.x == 0) (void)xb_add(&bar[XB_XCNT(b.x)], 1u);
    return b;
}
__device__ __forceinline__ void xcd_barrier_complete(unsigned* bar, unsigned x, unsigned& nloc, unsigned& nx) {
    const unsigned G = gridDim.x * gridDim.y * gridDim.z;
    unsigned sum, cnt, mine, sp = 0u;
    for (;;) {
        sum = 0u; cnt = 0u; mine = 0u;
#pragma unroll
        for (unsigned j = 0; j < 16; ++j) { const unsigned c = xb_ld(&bar[XB_XCNT(j)]); sum += c; cnt += (c > 0u) ? 1u : 0u; mine = (j == x) ? c : mine; }
        if (sum == G) break;
        __builtin_amdgcn_s_sleep(1);
        if ((++sp & 255u) == 0u) { if (xb_ld(&bar[XB_TMO])) break; if (sp > XB_SPIN_CAP) { atomicAdd(&bar[XB_TMO], 1u); break; } }
    }
    nloc = mine > 0u ? mine : 1u; nx = cnt > 0u ? cnt : 1u;
}

__device__ __forceinline__ void xcd_barrier(const XcdBarrier& b) {
    asm volatile("s_waitcnt vmcnt(0)" ::: "memory");
    __syncthreads();
    if (threadIdx.x == 0) {
        unsigned* bar = b.bar;
        __builtin_amdgcn_s_waitcnt(0);
        unsigned nloc = b.st[0], nx = b.st[1];
        if (nloc == 0u) { xcd_barrier_complete(bar, b.x, nloc, nx); b.st[0] = nloc; b.st[1] = nx; }
        const unsigned old = xb_add(&bar[XB_XSUB(b.x)], 1u);
        const unsigned gen = old / nloc;
        if (old + 1u == (gen + 1u) * nloc) {
            __builtin_amdgcn_fence(__ATOMIC_RELEASE, "agent");
            asm volatile("s_waitcnt vmcnt(0)" ::: "memory");
            const unsigned og = xb_add(&bar[XB_TOP], 1u);
            const unsigned tg = og / nx;
            if (og + 1u == (tg + 1u) * nx) xb_add(&bar[XB_TOPGEN], 1u);
            else XB_SPIN(xb_ld(&bar[XB_TOPGEN]) == tg, bar);
            __builtin_amdgcn_fence(__ATOMIC_ACQUIRE, "agent");
            xb_add(&bar[XB_XGEN(b.x)], 1u);
            asm volatile("s_waitcnt vmcnt(0)" ::: "memory");
        } else {
            XB_SPIN(xb_ld(&bar[XB_XGEN(b.x)]) == gen, bar);
            __builtin_amdgcn_fence(__ATOMIC_ACQUIRE, "agent");
            asm volatile("s_waitcnt vmcnt(0)" ::: "memory");
        }
    }
    __syncthreads();
}

#define RAW_BAR() do { asm volatile("s_waitcnt lgkmcnt(0)" ::: "memory"); __builtin_amdgcn_s_barrier(); asm volatile("" ::: "memory"); } while (0)

DI unsigned pk4_fp8(float a, float b, float c, float d) { int w = __builtin_amdgcn_cvt_pk_fp8_f32(a, b, 0, false); w = __builtin_amdgcn_cvt_pk_fp8_f32(c, d, w, true); return (unsigned)w; }
DI float fp8c(float x) { return fminf(fmaxf(x, -448.f), 448.f); }
constexpr float WIN_SCALE = 64.f;

struct Frame {
    LAS unsigned char* lds;
    unsigned char* ws;
    const float* in[23];
    float* out;
    int tid, lane, wave, vcu, G, gw, NGW;
};

DI size_t dn_off(int m, int h) {
    int b, pos; if (m < NT) { b = m >> 12; pos = 256 + (m & 4095); } else { const int mm = m - NT; b = mm >> 8; pos = mm & 255; }
    return ((size_t)(b * 8 + h) * 4352 + pos) * 128;
}

struct EpiInProj {
    static constexpr bool PERM = true, AFTER_DRAIN = false, TWO_STAGE = false;
    unsigned char* ws; const float* a_log; const float* dt_bias;
    DI void operator()(const pg8::f32x4 (&acc)[2][2][4][2], const pg8::Unit& u, int wr, int wc, int fr, int fq) const {
        asm volatile("" : "+v"(fr), "+v"(fq));
        const int pn = u.pn, pm = u.pm; const bool isctx = pm >= 64;
        if (pn == 38) {
            if (wc != 0) return;
            float* dstf = (float*)(ws + (fq < 2 ? WS_BETA : WS_LOGA));
            const int c8 = (fq & 1) * 8;
            f32x4 na[2], db[2];
#pragma unroll
            for (int n = 0; n < 2; ++n) { const f32x4 al = *(const f32x4*)(a_log + c8 + 4 * n); db[n] = *(const f32x4*)(dt_bias + c8 + 4 * n);
#pragma unroll
                for (int i = 0; i < 4; ++i) na[n][i] = -__expf(al[i]); }
#pragma unroll
            for (int ai = 0; ai < 2; ++ai)
#pragma unroll
                for (int m = 0; m < 4; ++m) {
                    const int row = pm * 256 + ai * 128 + wr * 64 + m * 16 + fr;
#pragma unroll
                    for (int n = 0; n < 2; ++n) {
                        f32x4 v = acc[ai][0][m][n] * (1.f / WIN_SCALE), o;
#pragma unroll
                        for (int i = 0; i < 4; ++i) {
                            const float xs = v[i] + db[n][i];
                            const float sp = fmaxf(xs, 0.f) + __logf(1.f + __expf(-fabsf(xs)));
                            const float sgm = sigm(v[i]);
                            o[i] = (fq < 2) ? sgm : na[n][i] * sp;
                        }
                        *(f32x4*)(dstf + (size_t)row * 16 + c8 + 4 * n) = o;
                    }
                }
            return;
        }
        bf16* dst; int ld, coloff, rowoff = 0; bool sg = false;
        if (pn < 4) { if (isctx) return; dst = (bf16*)(ws + WS_QN); ld = 1024; coloff = pn * 256; }
        else if (pn < 6) { dst = (bf16*)(ws + (pn == 4 ? WS_KB : WS_VB)); ld = 256; coloff = 0; rowoff = isctx ? (-12288 + (pm - 64) * 4096) : (pm >> 4) * 256; }
        else if (pn < 18) { dst = (bf16*)(ws + WS_DNRAW); ld = 3072; coloff = (pn - 6) * 256; }
        else if (pn < 22) { if (isctx) return; dst = (bf16*)(ws + WS_Z); ld = 1024; coloff = (pn - 18) * 256; }
        else { if (isctx) return; dst = (bf16*)(ws + WS_G); ld = 4096; coloff = (pn - 22) * 256; sg = true; }
        const int row0 = pm * 256 + rowoff + wr * 64 + fr, col0 = coloff + wc * 32 + 8 * fq;
#pragma unroll
        for (int ai = 0; ai < 2; ++ai)
#pragma unroll
            for (int m = 0; m < 4; ++m) {
                bf16* rowp = dst + (size_t)(row0 + ai * 128 + m * 16) * ld + col0;
#pragma unroll
                for (int bj = 0; bj < 2; ++bj) {
                    f32x4 v0 = acc[ai][bj][m][0] * (1.f / WIN_SCALE), v1 = acc[ai][bj][m][1] * (1.f / WIN_SCALE);
                    if (sg) {
                        u32x2 gb; gb.x = 0u; gb.y = 0u;
#pragma unroll
                        for (int i = 0; i < 4; ++i) { gb.x |= (unsigned)(sigm(v0[i]) * 255.f + 0.5f) << (8 * i); gb.y |= (unsigned)(sigm(v1[i]) * 255.f + 0.5f) << (8 * i); }
                        __builtin_nontemporal_store(gb, (u32x2*)((unsigned char*)dst + (size_t)(row0 + ai * 128 + m * 16) * 4096 + col0 + bj * 128));
                        continue;
                    }
                    u32x4 w; w.x = pg8::cvt_pk_bf16(v0[0], v0[1]); w.y = pg8::cvt_pk_bf16(v0[2], v0[3]); w.z = pg8::cvt_pk_bf16(v1[0], v1[1]); w.w = pg8::cvt_pk_bf16(v1[2], v1[3]);
                    __builtin_nontemporal_store(w, (u32x4*)(rowp + bj * 128));
                }
            }
    }
};


struct InProjOrder {
    pg8::StaticOrder lat; int G, c;
    static constexpr int NLAT = 64 * 39, NCTX = 4 * 15;
    DI void init(int G_, int c_) { lat.init(NT, NPROJ, G_, c_); G = G_; c = c_; }
    DI bool next(int i, pg8::Unit& u) const {
        const int L = i * G + c;
        if (L < NLAT) return lat.next(i, u);
        const int x = L - NLAT; if (x >= NCTX) return false;
        const int j = x % 15; u.pm = 64 + x / 15; u.pn = j < 2 ? 4 + j : (j < 14 ? 4 + j : 38); return true;
    }
    DI void a_ready(const pg8::Unit&) const {}
    DI void done(const pg8::Unit&) const {}
};

struct EpiPlain {
    static constexpr bool PERM = true, AFTER_DRAIN = false, TWO_STAGE = false;
    bf16* O; int ldc;
    DI void operator()(const pg8::f32x4 (&acc)[2][2][4][2], const pg8::Unit& u, int wr, int wc, int fr, int fq) const {
        const int row0 = u.pm * 256 + wr * 64 + fr, col0 = u.pn * 256 + wc * 32 + 8 * fq;
#pragma unroll
        for (int ai = 0; ai < 2; ++ai)
#pragma unroll
            for (int m = 0; m < 4; ++m) {
                bf16* rowp = O + (size_t)(row0 + ai * 128 + m * 16) * ldc + col0;
#pragma unroll
                for (int bj = 0; bj < 2; ++bj) {
                    const f32x4 v0 = acc[ai][bj][m][0], v1 = acc[ai][bj][m][1];
                    u32x4 w; w.x = pg8::cvt_pk_bf16(v0[0], v0[1]); w.y = pg8::cvt_pk_bf16(v0[2], v0[3]); w.z = pg8::cvt_pk_bf16(v1[0], v1[1]); w.w = pg8::cvt_pk_bf16(v1[2], v1[3]);
                    *(u32x4*)(rowp + bj * 128) = w;
                }
            }
    }
};

template <bool ADD> struct EpiMerge {
    static constexpr bool PERM = true, AFTER_DRAIN = false, TWO_STAGE = false;
    bf16* Y; const unsigned char* G; int goff; float gs;
    DI void operator()(const pg8::f32x4 (&acc)[2][2][4][2], const pg8::Unit& u, int wr, int wc, int fr, int fq) const {
        const int row0 = u.pm * 256 + wr * 64 + fr, col0 = u.pn * 256 + wc * 32 + 8 * fq;
#pragma unroll
        for (int ai = 0; ai < 2; ++ai)
#pragma unroll
            for (int m = 0; m < 4; ++m) {
                const size_t row = (size_t)(row0 + ai * 128 + m * 16);
#pragma unroll
                for (int bj = 0; bj < 2; ++bj) {
                    const f32x4 v0 = acc[ai][bj][m][0], v1 = acc[ai][bj][m][1];
                    const u32x2 g = __builtin_nontemporal_load((const u32x2*)(G + row * 4096 + goff + col0 + bj * 128));
                    float r[8];
#pragma unroll
                    for (int i = 0; i < 4; ++i) { r[i] = (float)((g.x >> (8 * i)) & 0xffu) * gs * v0[i]; r[4 + i] = (float)((g.y >> (8 * i)) & 0xffu) * gs * v1[i]; }
                    bf16* yp = Y + row * 2048 + col0 + bj * 128;
                    if (ADD) {
                        const u32x4 y = *(const u32x4*)yp;
                        r[0] += bflo(y.x); r[1] += bfhi(y.x); r[2] += bflo(y.y); r[3] += bfhi(y.y); r[4] += bflo(y.z); r[5] += bfhi(y.z); r[6] += bflo(y.w); r[7] += bfhi(y.w);
                    }
                    u32x4 w; w.x = pg8::cvt_pk_bf16(r[0], r[1]); w.y = pg8::cvt_pk_bf16(r[2], r[3]); w.z = pg8::cvt_pk_bf16(r[4], r[5]); w.w = pg8::cvt_pk_bf16(r[6], r[7]);
                    *(u32x4*)yp = w;
                }
            }
    }
};

struct EpiMerge2 {
    static constexpr bool PERM = true, AFTER_DRAIN = false, TWO_STAGE = true;
    bf16* Y; const unsigned char* G;
    DI void mid(pg8::f32x4 (&acc)[2][2][4][2], const pg8::Unit& u, int wr, int wc, int fr, int fq) const {
        const int row0 = u.pm * 256 + wr * 64 + fr, col0 = u.pn * 256 + wc * 32 + 8 * fq;
#pragma unroll
        for (int ai = 0; ai < 2; ++ai)
#pragma unroll
            for (int m = 0; m < 4; ++m) {
                const size_t row = (size_t)(row0 + ai * 128 + m * 16);
#pragma unroll
                for (int bj = 0; bj < 2; ++bj) {
                    const u32x2 ga = __builtin_nontemporal_load((const u32x2*)(G + row * 4096 + col0 + bj * 128));
                    const u32x2 gd = *(const u32x2*)(G + row * 4096 + 2048 + col0 + bj * 128);
#pragma unroll
                    for (int i = 0; i < 4; ++i) {
                        acc[ai][bj][m][0][i] *= (float)((ga.x >> (8 * i)) & 0xffu) * __builtin_amdgcn_rcpf(fmaxf((float)((gd.x >> (8 * i)) & 0xffu), 1.f));
                        acc[ai][bj][m][1][i] *= (float)((ga.y >> (8 * i)) & 0xffu) * __builtin_amdgcn_rcpf(fmaxf((float)((gd.y >> (8 * i)) & 0xffu), 1.f));
                    }
                }
            }
    }
    DI void operator()(const pg8::f32x4 (&acc)[2][2][4][2], const pg8::Unit& u, int wr, int wc, int fr, int fq) const {
        const int row0 = u.pm * 256 + wr * 64 + fr, col0 = u.pn * 256 + wc * 32 + 8 * fq;
#pragma unroll
        for (int ai = 0; ai < 2; ++ai)
#pragma unroll
            for (int m = 0; m < 4; ++m) {
                const size_t row = (size_t)(row0 + ai * 128 + m * 16);
#pragma unroll
                for (int bj = 0; bj < 2; ++bj) {
                    const f32x4 v0 = acc[ai][bj][m][0], v1 = acc[ai][bj][m][1];
                    const u32x2 g = __builtin_nontemporal_load((const u32x2*)(G + row * 4096 + 2048 + col0 + bj * 128));
                    float r[8];
#pragma unroll
                    for (int i = 0; i < 4; ++i) { r[i] = fmaxf((float)((g.x >> (8 * i)) & 0xffu), 1.f) * (1.f / 255.f) * v0[i]; r[4 + i] = fmaxf((float)((g.y >> (8 * i)) & 0xffu), 1.f) * (1.f / 255.f) * v1[i]; }
                    u32x4 w; w.x = pg8::cvt_pk_bf16(r[0], r[1]); w.y = pg8::cvt_pk_bf16(r[2], r[3]); w.z = pg8::cvt_pk_bf16(r[4], r[5]); w.w = pg8::cvt_pk_bf16(r[6], r[7]);
                    *(u32x4*)(Y + row * 2048 + col0 + bj * 128) = w;
                }
            }
    }
};

struct EpiResid {
    static constexpr bool PERM = true, AFTER_DRAIN = false, TWO_STAGE = false;
    const float* x; bf16* X1; const float* mod;
    DI void operator()(const pg8::f32x4 (&acc)[2][2][4][2], const pg8::Unit& u, int wr, int wc, int fr, int fq) const {
        const int row0 = u.pm * 256 + wr * 64 + fr, col0 = u.pn * 256 + wc * 32 + 8 * fq;
        const float* g1 = mod + (size_t)(u.pm >> 4) * 12288 + 2 * 2048;
        f32x4 gv[2][2];
#pragma unroll
        for (int bj = 0; bj < 2; ++bj)
#pragma unroll
            for (int n = 0; n < 2; ++n) gv[bj][n] = *(const f32x4*)(g1 + col0 + bj * 128 + n * 4);
#pragma unroll
        for (int ai = 0; ai < 2; ++ai)
#pragma unroll
            for (int m = 0; m < 4; ++m) {
                const size_t off = (size_t)(row0 + ai * 128 + m * 16) * 2048 + col0;
#pragma unroll
                for (int bj = 0; bj < 2; ++bj) {
                    const f32x4 x0 = __builtin_nontemporal_load((const f32x4*)(x + off + bj * 128)), x1 = __builtin_nontemporal_load((const f32x4*)(x + off + bj * 128 + 4));
                    const f32x4 v0 = x0 + gv[bj][0] * acc[ai][bj][m][0], v1 = x1 + gv[bj][1] * acc[ai][bj][m][1];
                    u32x4 w; w.x = pk2(v0[0], v0[1]); w.y = pk2(v0[2], v0[3]); w.z = pk2(v1[0], v1[1]); w.w = pk2(v1[2], v1[3]);
                    *(u32x4*)(X1 + off + bj * 128) = w;
                }
            }
    }
};

DI void transpose_item(const float* W, int K, int Nsrc, int sn0, bf16* WT, int dn0, int k0, LAS float* scr, int lane) {
    if (sn0 >= 0) {
        float t[32];
#pragma unroll
        for (int i = 0; i < 32; ++i) t[i] = __builtin_nontemporal_load(&W[(size_t)(k0 + 2 * i + (lane >> 5)) * Nsrc + sn0 + (lane & 31)]);
#pragma unroll
        for (int i = 0; i < 32; ++i) scr[(2 * i + (lane >> 5)) * 33 + (lane & 31)] = t[i];
    } else {
#pragma unroll 8
        for (int i = 0; i < 32; ++i) { const int kk = 2 * i + (lane >> 5); scr[kk * 33 + (lane & 31)] = 0.f; }
    }
    asm volatile("s_waitcnt lgkmcnt(0)" ::: "memory");
    const int c = lane & 7;
#pragma unroll
    for (int j = 0; j < 4; ++j) {
        const int n = (lane >> 3) + 8 * j; const LAS float* s = scr + (8 * c) * 33 + n;
        u32x4 o; o.x = pk2(s[0 * 33], s[1 * 33]); o.y = pk2(s[2 * 33], s[3 * 33]); o.z = pk2(s[4 * 33], s[5 * 33]); o.w = pk2(s[6 * 33], s[7 * 33]);
        *(u32x4*)(WT + (size_t)(dn0 + n) * K + k0 + 8 * c) = o;
    }
    asm volatile("s_waitcnt lgkmcnt(0)" ::: "memory");
}

DI void transpose_item_fp8(const float* W, int K, int Nsrc, int sn0, unsigned char* WT, int dn0, int k0, float scale, LAS float* scr, int lane) {
    if (sn0 >= 0) {
        float t[32];
#pragma unroll
        for (int i = 0; i < 32; ++i) t[i] = __builtin_nontemporal_load(&W[(size_t)(k0 + 2 * i + (lane >> 5)) * Nsrc + sn0 + (lane & 31)]);
#pragma unroll
        for (int i = 0; i < 32; ++i) scr[(2 * i + (lane >> 5)) * 33 + (lane & 31)] = t[i] * scale;
    } else {
#pragma unroll 8
        for (int i = 0; i < 32; ++i) { const int kk = 2 * i + (lane >> 5); scr[kk * 33 + (lane & 31)] = 0.f; }
    }
    asm volatile("s_waitcnt lgkmcnt(0)" ::: "memory");
    const int c = lane & 7;
#pragma unroll
    for (int j = 0; j < 4; ++j) {
        const int n = (lane >> 3) + 8 * j; const LAS float* s = scr + (8 * c) * 33 + n;
        u32x2 o; o.x = pk4_fp8(s[0 * 33], s[1 * 33], s[2 * 33], s[3 * 33]); o.y = pk4_fp8(s[4 * 33], s[5 * 33], s[6 * 33], s[7 * 33]);
        *(u32x2*)(WT + (size_t)(dn0 + n) * K + k0 + 8 * c) = o;
    }
    asm volatile("s_waitcnt lgkmcnt(0)" ::: "memory");
}

DI void cvt_bf16_stream(const float* src, bf16* dst, size_t n8, size_t gtid, size_t nthr) {
    for (size_t i = gtid; i < n8; i += nthr) {
        const f32x4 a = *(const f32x4*)(src + i * 8), b = *(const f32x4*)(src + i * 8 + 4);
        u32x4 w; w.x = pk2(a[0], a[1]); w.y = pk2(a[2], a[3]); w.z = pk2(b[0], b[1]); w.w = pk2(b[2], b[3]);
        *(u32x4*)(dst + i * 8) = w;
    }
}

DI void phase_prologue(Frame& F) {
    LAS float* scr = (LAS float*)(F.lds + F.wave * 16384);
    constexpr int I_WIN = 32 * 312, I_WB = 16 * 64, I_WO = 32 * 64;
    constexpr int NITEMS = I_WIN + 2 * I_WB + 2 * I_WO;
#ifndef PRO_REP_T
#define PRO_REP_T 1
#endif
#ifndef PRO_REP_G
#define PRO_REP_G 1
#endif
#pragma nounroll
    for (int rep_t = 0; rep_t < PRO_REP_T; ++rep_t)
    for (int it = F.gw; it < NITEMS; it += F.NGW) {
        int r = it;
        if (r < I_WIN) { const int kb = r / 312, nb = r % 312; const int snb = nb < 176 ? nb : (nb < 304 ? nb + 1 : (nb == 304 ? 176 : -1));
            transpose_item_fp8(F.in[8], DM, INW, snb < 0 ? -1 : snb * 32, F.ws + WS_WIN, nb * 32, kb * 64, WIN_SCALE, scr, F.lane); continue; }
        r -= I_WIN;
        if (r < I_WB) {
            if (MERGE_F8_A) transpose_item_fp8(F.in[15], 1024, DM, (r % 64) * 32, F.ws + WS_WBA, (r % 64) * 32, (r / 64) * 64, WB_SCALE, scr, F.lane);
            else transpose_item(F.in[15], 1024, DM, (r % 64) * 32, (bf16*)(F.ws + WS_WBA), (r % 64) * 32, (r / 64) * 64, scr, F.lane);
            continue; }
        r -= I_WB;
        if (r < I_WB) {
            if (MERGE_F8_B) transpose_item_fp8(F.in[16], 1024, DM, (r % 64) * 32, F.ws + WS_WBD, (r % 64) * 32, (r / 64) * 64, WB_SCALE, scr, F.lane);
            else transpose_item(F.in[16], 1024, DM, (r % 64) * 32, (bf16*)(F.ws + WS_WBD), (r % 64) * 32, (r / 64) * 64, scr, F.lane);
            continue; }
        r -= I_WB;
        if (r < I_WO) { transpose_item(F.in[17], DM, DM, (r % 64) * 32, (bf16*)(F.ws + WS_WOUT), (r % 64) * 32, (r / 64) * 64, scr, F.lane); continue; }
        r -= I_WO;
        transpose_item(F.in[18], DM, DM, (r % 64) * 32, (bf16*)(F.ws + WS_WQ), (r % 64) * 32, (r / 64) * 64, scr, F.lane);
    }
    cvt_bf16_stream(F.in[19], (bf16*)(F.ws + WS_SUBK), (size_t)8 * 2 * 128 * 128 / 8, (size_t)blockIdx.x * 512 + F.tid, (size_t)F.G * 512);
    LAS float* sc = (LAS float*)(F.lds + 131072);
    const float* ada_w = F.in[4];
    float* MODP = (float*)(F.ws + WS_MODP);
#pragma nounroll
    for (int rep_g = 0; rep_g < PRO_REP_G; ++rep_g)
    for (int it = blockIdx.x; it < 32 * 24; it += F.G) {
        const int kc = it / 24, nb = it % 24, n = nb * 512 + F.tid;
        __syncthreads();
        if (F.tid < 320) { const int r = F.tid >> 6, kk = F.tid & 63, k = kc * 64 + kk; const float cv = (r < 4) ? F.in[1][r * DM + k] : F.in[3][k]; sc[r * 64 + kk] = silu(cv); }
        __syncthreads();
        float a0 = 0.f, a1 = 0.f, a2 = 0.f, a3 = 0.f, a4 = 0.f;
#pragma unroll 32
        for (int kk = 0; kk < 64; ++kk) {
            const float w = __builtin_nontemporal_load(&ada_w[(size_t)(kc * 64 + kk) * 12288 + n]);
            a0 += sc[kk] * w; a1 += sc[64 + kk] * w; a2 += sc[128 + kk] * w; a3 += sc[192 + kk] * w; a4 += sc[256 + kk] * w;
        }
        float* o = MODP + (size_t)kc * 5 * 12288 + n;
        o[0] = a0; o[12288] = a1; o[2 * 12288] = a2; o[3 * 12288] = a3; o[4 * 12288] = a4;
    }
}

DI void phase_modreduce(Frame& F) {
    const float* MODP = (const float*)(F.ws + WS_MODP); float* MOD = (float*)(F.ws + WS_MOD); const float* ada_b = F.in[5];
    for (int i = blockIdx.x * 512 + F.tid; i < 5 * 12288; i += F.G * 512) {
        const int n = i % 12288; float s = ada_b[n];
#pragma unroll 8
        for (int kc = 0; kc < 32; ++kc) s += MODP[(size_t)kc * 5 * 12288 + i];
        MOD[i] = s;
    }
}

DI void modnorm_row(const float* xrow, bf16* orow, const float* nw, const float* sc, const float* sh, int lane) {
    f32x4 v[8]; float ss = 0.f;
#pragma unroll
    for (int j = 0; j < 8; ++j) { v[j] = *((const f32x4*)xrow + lane + 64 * j); ss += (v[j][0] * v[j][0] + v[j][1] * v[j][1]) + (v[j][2] * v[j][2] + v[j][3] * v[j][3]); }
    const float rstd = rsqrtf(wave_sum(ss) * (1.f / DM) + EPS);
#pragma unroll
    for (int j = 0; j < 8; ++j) {
        const int c = (lane + 64 * j) * 4;
        const f32x4 w = *(const f32x4*)(nw + c), s = *(const f32x4*)(sc + c), h = *(const f32x4*)(sh + c);
        f32x4 o;
#pragma unroll
        for (int i = 0; i < 4; ++i) o[i] = (v[j][i] * rstd * w[i]) * (1.f + s[i]) + h[i];
        u32x2 p; p.x = pk2(o[0], o[1]); p.y = pk2(o[2], o[3]);
        *(u32x2*)(orow + c) = p;
    }
}

DI void modnorm_row_bf(const bf16* xrow, bf16* orow, const float* nw, const float* sc, const float* sh, int lane) {
    f32x4 v[8]; float ss = 0.f;
#pragma unroll
    for (int j = 0; j < 8; ++j) { const u32x2 w = *((const u32x2*)xrow + lane + 64 * j); v[j] = (f32x4){bflo(w.x), bfhi(w.x), bflo(w.y), bfhi(w.y)}; ss += (v[j][0] * v[j][0] + v[j][1] * v[j][1]) + (v[j][2] * v[j][2] + v[j][3] * v[j][3]); }
    const float rstd = rsqrtf(wave_sum(ss) * (1.f / DM) + EPS);
#pragma unroll
    for (int j = 0; j < 8; ++j) {
        const int c = (lane + 64 * j) * 4;
        const f32x4 w = *(const f32x4*)(nw + c), s = *(const f32x4*)(sc + c), h = *(const f32x4*)(sh + c);
        f32x4 o;
#pragma unroll
        for (int i = 0; i < 4; ++i) o[i] = (v[j][i] * rstd * w[i]) * (1.f + s[i]) + h[i];
        u32x2 p; p.x = pk2(o[0], o[1]); p.y = pk2(o[2], o[3]);
        *(u32x2*)(orow + c) = p;
    }
}

DI void modnorm_row_fp8(const float* xrow, unsigned char* orow, const float* nw, const float* sc, const float* sh, int lane) {
    f32x4 v[8]; float ss = 0.f;
#pragma unroll
    for (int j = 0; j < 8; ++j) { v[j] = __builtin_nontemporal_load((const f32x4*)xrow + lane + 64 * j); ss += (v[j][0] * v[j][0] + v[j][1] * v[j][1]) + (v[j][2] * v[j][2] + v[j][3] * v[j][3]); }
    const float rstd = rsqrtf(wave_sum(ss) * (1.f / DM) + EPS);
#pragma unroll
    for (int j = 0; j < 8; ++j) {
        const int c = (lane + 64 * j) * 4;
        const f32x4 w = *(const f32x4*)(nw + c), s = *(const f32x4*)(sc + c), h = *(const f32x4*)(sh + c);
        f32x4 o;
#pragma unroll
        for (int i = 0; i < 4; ++i) o[i] = (v[j][i] * rstd * w[i]) * (1.f + s[i]) + h[i];
        *(unsigned*)(orow + c) = pk4_fp8(o[0], o[1], o[2], o[3]);
    }
}

struct ModPar { f32x4 a[8], h[8]; };
DI void modpar_load(ModPar& P, const float* nw, const float* sc, const float* sh, int lane) {
#pragma unroll
    for (int j = 0; j < 8; ++j) { const int c = (lane + 64 * j) * 4; const f32x4 w = *(const f32x4*)(nw + c), s = *(const f32x4*)(sc + c); P.a[j] = w * (1.f + s); P.h[j] = *(const f32x4*)(sh + c); }
}
DI void modnorm_rows_fp8(const float* x0, unsigned char* o0, int nrows, const ModPar& P, int lane) {
    f32x4 v[8];
#pragma unroll
    for (int j = 0; j < 8; ++j) v[j] = __builtin_nontemporal_load((const f32x4*)x0 + lane + 64 * j);
    for (int r = 0; r < nrows; ++r) {
        float ss = 0.f;
#pragma unroll
        for (int j = 0; j < 8; ++j) ss += (v[j][0] * v[j][0] + v[j][1] * v[j][1]) + (v[j][2] * v[j][2] + v[j][3] * v[j][3]);
        const float rstd = rsqrtf(wave_sum(ss) * (1.f / DM) + EPS);
        unsigned char* orow = o0 + (size_t)r * DM;
        const float* xn = x0 + (size_t)(r + 1 < nrows ? r + 1 : r) * DM;
#pragma unroll
        for (int j = 0; j < 8; ++j) {
            const f32x4 o = (v[j] * rstd) * P.a[j] + P.h[j];
            v[j] = __builtin_nontemporal_load((const f32x4*)xn + lane + 64 * j);
            *(unsigned*)(orow + (lane + 64 * j) * 4) = pk4_fp8(o[0], o[1], o[2], o[3]);
        }
    }
}
DI void modnorm_rows_bf(const bf16* x0, bf16* o0, int nrows, const ModPar& P, int lane) {
    u32x2 w[8];
#pragma unroll
    for (int j = 0; j < 8; ++j) w[j] = *((const u32x2*)x0 + lane + 64 * j);
    for (int r = 0; r < nrows; ++r) {
        f32x4 v[8]; float ss = 0.f;
#pragma unroll
        for (int j = 0; j < 8; ++j) { v[j] = (f32x4){bflo(w[j].x), bfhi(w[j].x), bflo(w[j].y), bfhi(w[j].y)}; ss += (v[j][0] * v[j][0] + v[j][1] * v[j][1]) + (v[j][2] * v[j][2] + v[j][3] * v[j][3]); }
        const float rstd = rsqrtf(wave_sum(ss) * (1.f / DM) + EPS);
        bf16* orow = o0 + (size_t)r * DM;
        const bf16* xn = x0 + (size_t)(r + 1 < nrows ? r + 1 : r) * DM;
#pragma unroll
        for (int j = 0; j < 8; ++j) {
            const f32x4 o = (v[j] * rstd) * P.a[j] + P.h[j];
            w[j] = *((const u32x2*)xn + lane + 64 * j);
            u32x2 p; p.x = pk2(o[0], o[1]); p.y = pk2(o[2], o[3]);
            *(u32x2*)(orow + (lane + 64 * j) * 4) = p;
        }
    }
}

DI void phase_h1(Frame& F) {
    const float* MOD = (const float*)(F.ws + WS_MOD); unsigned char* H = F.ws + WS_H;
    ModPar P;
    {
        constexpr int RPW = NT / (256 * NWAVES);
        const int m0 = F.gw * RPW, r = m0 >> 12;
        if (F.NGW == 256 * NWAVES) {
            modpar_load(P, F.in[6], MOD + (size_t)r * 12288 + 2048, MOD + (size_t)r * 12288, F.lane);
            modnorm_rows_fp8(F.in[0] + (size_t)m0 * DM, H + (size_t)m0 * DM, RPW, P, F.lane);
        } else {
            for (int m = F.gw; m < NT; m += F.NGW) { modpar_load(P, F.in[6], MOD + (size_t)(m >> 12) * 12288 + 2048, MOD + (size_t)(m >> 12) * 12288, F.lane); modnorm_rows_fp8(F.in[0] + (size_t)m * DM, H + (size_t)m * DM, 1, P, F.lane); }
        }
    }
    if (F.gw < NC) {
        modpar_load(P, F.in[6], MOD + (size_t)4 * 12288 + 2048, MOD + (size_t)4 * 12288, F.lane);
        for (int m = F.gw; m < NC; m += F.NGW) modnorm_rows_fp8(F.in[2] + (size_t)m * DM, H + (size_t)(NT + m) * DM, 1, P, F.lane);
    }
}

DI void phase_postproj(Frame& F) {
    const int lane = F.lane, tid = F.tid;
    LAS float* tcs = (LAS float*)F.lds;
    for (int i = tid; i < 2048; i += 512) { const int pos = i >> 5, f = i & 31; float sn, cs; sincosf((float)pos * exp2f(-(float)f * (13.287712379549449f / 32.f)), &sn, &cs); tcs[i] = cs; tcs[2048 + i] = sn; }
    __syncthreads();
    {
        bf16* QN = (bf16*)(F.ws + WS_QN); bf16* KB = (bf16*)(F.ws + WS_KB);
        const int j = lane & 7, axis = j >> 2, fg = j & 3, d1 = axis * 64 + 8 * fg;
        f32x4 qw[4], kw[4];
        qw[0] = *(const f32x4*)(F.in[9] + d1); qw[1] = *(const f32x4*)(F.in[9] + d1 + 4); qw[2] = *(const f32x4*)(F.in[9] + d1 + 32); qw[3] = *(const f32x4*)(F.in[9] + d1 + 36);
        kw[0] = *(const f32x4*)(F.in[10] + d1); kw[1] = *(const f32x4*)(F.in[10] + d1 + 4); kw[2] = *(const f32x4*)(F.in[10] + d1 + 32); kw[3] = *(const f32x4*)(F.in[10] + d1 + 36);
        constexpr int NQI = NT, NKI = NB * LKV / 4;
        for (int it = F.gw; it < NQI + NKI; it += F.NGW) {
            bf16* p; int t; bool rope; const bool isq = it < NQI;
            if (isq) { p = QN + (size_t)it * 1024 + (lane >> 3) * 128; t = it & 4095; rope = true; }
            else { const int row = (it - NQI) * 4 + (lane >> 4), pp = row % LKV; p = KB + (size_t)row * 256 + ((lane >> 3) & 1) * 128; t = pp; rope = pp < TS; }
            const u32x4 w1 = *(const u32x4*)(p + d1), w2 = *(const u32x4*)(p + d1 + 32);
            float x1[8], x2[8];
            x1[0] = bflo(w1.x); x1[1] = bfhi(w1.x); x1[2] = bflo(w1.y); x1[3] = bfhi(w1.y); x1[4] = bflo(w1.z); x1[5] = bfhi(w1.z); x1[6] = bflo(w1.w); x1[7] = bfhi(w1.w);
            x2[0] = bflo(w2.x); x2[1] = bfhi(w2.x); x2[2] = bflo(w2.y); x2[3] = bfhi(w2.y); x2[4] = bflo(w2.z); x2[5] = bfhi(w2.z); x2[6] = bflo(w2.w); x2[7] = bfhi(w2.w);
            float ss = 0.f;
#pragma unroll
            for (int i = 0; i < 8; ++i) ss += x1[i] * x1[i] + x2[i] * x2[i];
            ss += __shfl_xor(ss, 1); ss += __shfl_xor(ss, 2); ss += __shfl_xor(ss, 4);
            const float rstd = rsqrtf(ss * (1.f / 128.f) + EPS);
            const int pos = axis == 0 ? (t >> 6) : (t & 63);
            float o1[8], o2[8];
#pragma unroll
            for (int i = 0; i < 8; ++i) {
                const float wa = isq ? qw[i >> 2][i & 3] : kw[i >> 2][i & 3], wb = isq ? qw[2 + (i >> 2)][i & 3] : kw[2 + (i >> 2)][i & 3];
                const float y1 = x1[i] * rstd * wa, y2 = x2[i] * rstd * wb;
                const float cs0 = tcs[(pos & 63) * 32 + 8 * fg + i], sn0 = tcs[2048 + (pos & 63) * 32 + 8 * fg + i];
                const float cs = rope ? cs0 : 1.f, sn = rope ? sn0 : 0.f;
                o1[i] = y1 * cs - y2 * sn; o2[i] = y2 * cs + y1 * sn;
            }
            u32x4 r1, r2;
            r1.x = pk2(o1[0], o1[1]); r1.y = pk2(o1[2], o1[3]); r1.z = pk2(o1[4], o1[5]); r1.w = pk2(o1[6], o1[7]);
            r2.x = pk2(o2[0], o2[1]); r2.y = pk2(o2[2], o2[3]); r2.z = pk2(o2[4], o2[5]); r2.w = pk2(o2[6], o2[7]);
            *(u32x4*)(p + d1) = r1; *(u32x4*)(p + d1 + 32) = r2;
        }
    }
    {
        const bf16* RAW = (const bf16*)(F.ws + WS_DNRAW); const float* cw = F.in[11];
        for (int it = F.gw; it < (MTOT / 16) * 6; it += F.NGW) {
            const int tc = it / 6, grp = it % 6, m0 = tc * 16, part = grp >> 1;
            int start, len; if (m0 < NT) { start = m0 & ~4095; len = TS; } else { start = NT + ((m0 - NT) & ~255); len = CL; }
            const int pos0 = m0 - start, c = grp * 512 + 8 * lane;
            float wv[5][8];
#pragma unroll
            for (int jj = 0; jj < 5; ++jj) { const f32x4 a = *(const f32x4*)(cw + jj * 3072 + c), b = *(const f32x4*)(cw + jj * 3072 + c + 4);
                wv[jj][0] = a[0]; wv[jj][1] = a[1]; wv[jj][2] = a[2]; wv[jj][3] = a[3]; wv[jj][4] = b[0]; wv[jj][5] = b[1]; wv[jj][6] = b[2]; wv[jj][7] = b[3]; }
            u32x4 rows[20];
#pragma unroll
            for (int r = 0; r < 20; ++r) { const int pp = pos0 + r - 2; const bool ok = pp >= 0 && pp < len;
                const u32x4 v = *(const u32x4*)(RAW + (size_t)(start + (ok ? pp : pos0)) * 3072 + c); rows[r] = ok ? v : (u32x4){0u, 0u, 0u, 0u}; }
            bf16* dst = (bf16*)(F.ws + (part == 0 ? WS_DQ : (part == 1 ? WS_DK : WS_DV))) + dn_off(m0, (grp & 1) * 4 + (lane >> 4)) + 8 * (lane & 15);
#pragma unroll
            for (int tk = 0; tk < 16; ++tk) {
                float a[8];
#pragma unroll
                for (int i = 0; i < 8; ++i) a[i] = 0.f;
#pragma unroll
                for (int jj = 0; jj < 5; ++jj) { const u32x4 w = rows[tk + jj];
                    a[0] += wv[jj][0] * bflo(w.x); a[1] += wv[jj][1] * bfhi(w.x); a[2] += wv[jj][2] * bflo(w.y); a[3] += wv[jj][3] * bfhi(w.y);
                    a[4] += wv[jj][4] * bflo(w.z); a[5] += wv[jj][5] * bfhi(w.z); a[6] += wv[jj][6] * bflo(w.w); a[7] += wv[jj][7] * bfhi(w.w); }
                float ss = 0.f;
#pragma unroll
                for (int i = 0; i < 8; ++i) { a[i] = silu(a[i]); ss += a[i] * a[i]; }
                if (part < 2) {
                    ss += __shfl_xor(ss, 1); ss += __shfl_xor(ss, 2); ss += __shfl_xor(ss, 4); ss += __shfl_xor(ss, 8);
                    const float r = rsqrtf(ss + EPS) * (part == 0 ? 0.088388347648318440f : 1.f);
#pragma unroll
                    for (int i = 0; i < 8; ++i) a[i] *= r;
                }
                u32x4 o; o.x = pk2(a[0], a[1]); o.y = pk2(a[2], a[3]); o.z = pk2(a[4], a[5]); o.w = pk2(a[6], a[7]);
                *(u32x4*)(dst + tk * 128) = o;
            }
        }
    }
}

DI void phase_dn_naive(Frame& F) {
    if (F.wave != 0 || blockIdx.x >= 128) return;
    const int item = blockIdx.x, dir = item >> 6, b = (item >> 4) & 3, h = (item >> 1) & 7, half = item & 1, lane = F.lane;
    const bf16* DQ = (const bf16*)(F.ws + WS_DQ); const bf16* DK = (const bf16*)(F.ws + WS_DK); const bf16* DV = (const bf16*)(F.ws + WS_DV);
    const float* BETA = (const float*)(F.ws + WS_BETA); const float* LOGA = (const float*)(F.ws + WS_LOGA);
    bf16* ODN = (bf16*)(F.ws + WS_ODN);
    float S[128];
#pragma unroll
    for (int i = 0; i < 128; ++i) S[i] = 0.f;
    for (int step = 0; step < LKV; ++step) {
        const bool isl = step >= CL; const int p = isl ? step - CL : step, len = isl ? TS : CL, pos = dir ? len - 1 - p : p;
        const int m = isl ? b * TS + pos : NT + b * CL + pos;
        const unsigned kw = *(const unsigned*)(DK + dn_off(m, h) + 2 * lane);
        const unsigned qw = *(const unsigned*)(DQ + dn_off(m, h) + 2 * lane);
        const float vj = bf2f(DV[dn_off(m, h) + half * 64 + lane]);
        const float a = __expf(LOGA[(size_t)m * 16 + dir * 8 + h]), bt = BETA[(size_t)m * 16 + dir * 8 + h];
        float k0 = 0.f, k1 = 0.f, k2 = 0.f, k3 = 0.f;
#pragma unroll
        for (int i = 0; i < 64; i += 2) {
            const unsigned w0 = rdlane(kw, i), w1 = rdlane(kw, i + 1);
            k0 += bflo(w0) * S[2 * i]; k1 += bfhi(w0) * S[2 * i + 1]; k2 += bflo(w1) * S[2 * i + 2]; k3 += bfhi(w1) * S[2 * i + 3];
        }
        const float kS = (k0 + k1) + (k2 + k3);
        const float coef = bt * (vj - a * kS);
#pragma unroll
        for (int i = 0; i < 64; ++i) { const unsigned w0 = rdlane(kw, i); S[2 * i] = a * S[2 * i] + coef * bflo(w0); S[2 * i + 1] = a * S[2 * i + 1] + coef * bfhi(w0); }
        if (isl) {
            float o0 = 0.f, o1 = 0.f, o2 = 0.f, o3 = 0.f;
#pragma unroll
            for (int i = 0; i < 64; i += 2) {
                const unsigned w0 = rdlane(qw, i), w1 = rdlane(qw, i + 1);
                o0 += bflo(w0) * S[2 * i]; o1 += bfhi(w0) * S[2 * i + 1]; o2 += bflo(w1) * S[2 * i + 2]; o3 += bfhi(w1) * S[2 * i + 3];
            }
            ODN[((size_t)dir * NT + m) * 1024 + h * 128 + half * 64 + lane] = (bf16)f2bf((o0 + o1) + (o2 + o3));
        }
    }
}

DI int dn_row0(int b, int cc) { return cc < 4 ? NT + b * CL + 64 * cc : b * TS + 64 * (cc - 4); }
typedef short bf16x8_t __attribute__((ext_vector_type(8)));
#define MFMA16(a, b, c) __builtin_amdgcn_mfma_f32_16x16x32_bf16((a), (b), (c), 0, 0, 0)

DI bf16x8_t dn_afrag(const LAS unsigned char* p) {
    const u32x2 lo = *(const LAS u32x2*)p, hi = *(const LAS u32x2*)(p + 32);
    u32x4 v; v.x = lo.x; v.y = lo.y; v.z = hi.x; v.w = hi.y; return __builtin_bit_cast(bf16x8_t, v);
}
DI bf16x8_t dn_bpack(const f32x4 t0, const f32x4 t1) {
    u32x4 v; v.x = pk2(t0[0], t0[1]); v.y = pk2(t0[2], t0[3]); v.z = pk2(t1[0], t1[1]); v.w = pk2(t1[2], t1[3]); return __builtin_bit_cast(bf16x8_t, v);
}
DI void phase_dn_prep(Frame& F) {
    LAS unsigned char* L = F.lds;
    constexpr int KS = 0, QS = 17408, VC = 34816, AP = 35840;
    constexpr int NITEM = NB * 8 * 68, NBATCH = (NITEM + 2) / 3;
    const bf16* DQ = (const bf16*)(F.ws + WS_DQ); const bf16* DK = (const bf16*)(F.ws + WS_DK);
    const float* BETA = (const float*)(F.ws + WS_BETA); const float* LOGA = (const float*)(F.ws + WS_LOGA);
    bf16* KT = (bf16*)(F.ws + WS_KT); bf16* TINV = (bf16*)(F.ws + WS_TINV); bf16* QKO = (bf16*)(F.ws + WS_QKO); float* VEC = (float*)(F.ws + WS_VEC);
    const int tid = F.tid, wave = F.wave;
    LAS float* vg = (LAS float*)(L + VC); LAS float* vb = vg + 128;
    for (int batch = F.vcu; batch < NBATCH; batch += F.G) {
        int lane = F.lane; asm volatile("" : "+v"(lane));
        const int fr = lane & 15, fq = lane >> 4;
#pragma unroll 1
        for (int c3 = 0; c3 < 3; ++c3) {
            const int item = batch * 3 + c3;
            if (item >= NITEM) break;
            const int b = item / 544, h = (item % 544) / 68, cc = item % 68, row0 = dn_row0(b, cc);
#pragma unroll
            for (int k = 0; k < 4; ++k) {
                const int c = tid + 512 * k, which = c >> 10, c2 = c & 1023, row = c2 >> 4, c16 = c2 & 15;
                const u32x4 v = *(const u32x4*)((which ? DQ : DK) + (size_t)item * 8192 + c2 * 8);
                *(LAS u32x4*)(L + (which ? QS : KS) + row * 272 + c16 * 16) = v;
            }
            if (wave < 2) {
                const int d = wave, i = lane;
                const float la = LOGA[(size_t)(row0 + i) * 16 + d * 8 + h], bt = BETA[(size_t)(row0 + i) * 16 + d * 8 + h];
                float x = la;
                if (d == 0) {
#pragma unroll
                    for (int o = 1; o < 64; o <<= 1) { const float y = __shfl_up(x, o); if (i >= o) x += y; }
                } else {
#pragma unroll
                    for (int o = 1; o < 64; o <<= 1) { const float y = __shfl_down(x, o); if (i + o < 64) x += y; }
                }
                const float glast = __shfl(x, d == 0 ? 63 : 0);
                vg[d * 64 + i] = x; vb[d * 64 + i] = bt;
                float* ve = VEC + (size_t)(item * 2 + d) * 320;
                const float eg = __expf(x);
                ve[i] = bt; ve[64 + i] = eg; ve[128 + i] = bt * eg; ve[192 + i] = __expf(glast - x); ve[256 + i] = __expf(glast);
            }
            __syncthreads();
            {
                bf16* kt = KT + (size_t)item * 8192;
#pragma unroll
                for (int k = 0; k < 2; ++k) {
                    const int c = tid + 512 * k, dk = c >> 3, t8 = c & 7;
                    unsigned short e[8];
#pragma unroll
                    for (int q = 0; q < 8; ++q) e[q] = *(const LAS unsigned short*)(L + KS + (8 * t8 + q) * 272 + dk * 2);
                    u32x4 w; w.x = e[0] | ((unsigned)e[1] << 16); w.y = e[2] | ((unsigned)e[3] << 16); w.z = e[4] | ((unsigned)e[5] << 16); w.w = e[6] | ((unsigned)e[7] << 16);
                    *(u32x4*)(kt + dk * 64 + 8 * t8) = w;
                }
            }
            {
                const int it = wave & 3, mat = wave >> 2;
                f32x4 acc[4];
#pragma unroll
                for (int j = 0; j < 4; ++j) acc[j] = (f32x4){0.f, 0.f, 0.f, 0.f};
#pragma unroll
                for (int s = 0; s < 4; ++s) {
                    const bf16x8_t a = *(const LAS bf16x8_t*)(L + (mat ? QS : KS) + (16 * it + fr) * 272 + (32 * s + 8 * fq) * 2);
#pragma unroll
                    for (int jt = 0; jt < 4; ++jt) {
                        const bf16x8_t bb = *(const LAS bf16x8_t*)(L + KS + (16 * jt + fr) * 272 + (32 * s + 8 * fq) * 2);
                        acc[jt] = MFMA16(a, bb, acc[jt]);
                    }
                }
                f32x4 gi[2], bi[2]; float gj[2][4];
#pragma unroll
                for (int d = 0; d < 2; ++d) {
                    gi[d] = *(const LAS f32x4*)(vg + d * 64 + 16 * it + 4 * fq); bi[d] = *(const LAS f32x4*)(vb + d * 64 + 16 * it + 4 * fq);
#pragma unroll
                    for (int jt = 0; jt < 4; ++jt) gj[d][jt] = vg[d * 64 + 16 * jt + fr];
                }
                if (mat == 0) {
#pragma unroll
                    for (int d = 0; d < 2; ++d) {
                        LAS float* ap = (LAS float*)(L + AP + (c3 * 2 + d) * 17408);
#pragma unroll
                        for (int jt = 0; jt < 4; ++jt)
#pragma unroll
                            for (int r = 0; r < 4; ++r) {
                                const int i = 16 * it + 4 * fq + r, j = 16 * jt + fr, ip = d ? 63 - i : i, jp = d ? 63 - j : j;
                                ap[ip * 68 + jp] = (jp < ip) ? bi[d][r] * acc[jt][r] * __expf(gi[d][r] - gj[d][jt]) : 0.f;
                            }
                    }
                } else {
#pragma unroll
                    for (int d = 0; d < 2; ++d) {
                        bf16* qo = QKO + (size_t)(item * 2 + d) * 4096;
#pragma unroll
                        for (int jt = 0; jt < 4; ++jt)
#pragma unroll
                            for (int r = 0; r < 4; ++r) {
                                const int i = 16 * it + 4 * fq + r, j = 16 * jt + fr, ip = d ? 63 - i : i, jp = d ? 63 - j : j;
                                qo[i * 64 + j] = (bf16)f2bf((jp <= ip) ? acc[jt][r] * __expf(gi[d][r] - gj[d][jt]) : 0.f);
                            }
                    }
                }
            }
            __syncthreads();
        }
        if (wave < 6 && batch * 3 + (wave >> 1) < NITEM) {
            const int item = batch * 3 + (wave >> 1), d = wave & 1, c = lane;
            const LAS float* ap = (const LAS float*)(L + AP + wave * 17408);
            float x[64];
#pragma unroll
            for (int ip = 0; ip < 64; ++ip) {
                float a0 = (ip == c) ? 1.f : 0.f, a1 = 0.f;
#pragma unroll
                for (int q = 0; q < (ip + 3) / 4; ++q) {
                    const f32x4 av = *(const LAS f32x4*)(ap + ip * 68 + 4 * q);
#pragma unroll
                    for (int e = 0; e < 4; ++e) { const int jp = 4 * q + e; if (jp < ip) { if (e & 1) a1 -= av[e] * x[jp]; else a0 -= av[e] * x[jp]; } }
                }
                x[ip] = a0 + a1;
                __builtin_amdgcn_sched_barrier(0);
            }
            bf16* ti = TINV + (size_t)(item * 2 + d) * 4096;
            const int j = d ? 63 - c : c;
#pragma unroll
            for (int ip = 0; ip < 64; ++ip) { const int i = d ? 63 - ip : ip; ti[i * 64 + j] = (bf16)f2bf(x[ip]); }
        }
        __syncthreads();
    }
}

DI int dn_perm(int m, int t) { return 32 * (t >> 1) + 8 * (m >> 2) + 4 * (t & 1) + (m & 3); }
DI int dn_swz16(int row, int chunk) { return row * 272 + (chunk << 4); }
DI int dn_swz8(int row, int chunk) { return row * 144 + (chunk << 4); }
#define DN_BAR() do { asm volatile("s_waitcnt lgkmcnt(0)" ::: "memory"); __builtin_amdgcn_s_barrier(); asm volatile("" ::: "memory"); } while (0)
DI void phase_dn_scan(Frame& F) {
    LAS unsigned char* L = F.lds;
    constexpr int KS = 0, QS = 17408, KTS = 34816, TIS = 53248, VS = 62464, VCS = 66560, BUF = 68096;
    constexpr int PUBS = 2 * BUF, PUBV = PUBS + 16384;
    static_assert(PUBV + 8192 <= LDS_BYTES - 64, "scan LDS map");
    const int G8 = F.G >> 3;
    const int li = blockIdx.x >> 3, chain = (blockIdx.x & 7) * (G8 >> 2) + (li >> 2), qd = li & 3;
    if (F.G != 256 || chain >= 64) return;
    const int dir = chain >> 5, b = (chain >> 3) & 3, h = chain & 7;
    const bf16* DQ = (const bf16*)(F.ws + WS_DQ); const bf16* DK = (const bf16*)(F.ws + WS_DK); const bf16* DV = (const bf16*)(F.ws + WS_DV);
    const bf16* KT = (const bf16*)(F.ws + WS_KT); const bf16* TINV = (const bf16*)(F.ws + WS_TINV); const bf16* QKO = (const bf16*)(F.ws + WS_QKO); const float* VEC = (const float*)(F.ws + WS_VEC);
    bf16* ODN = (bf16*)(F.ws + WS_ODN);
    const int tid = F.tid, lane = F.lane, w = F.wave, fr = lane & 15, fq = lane >> 4;
#ifndef DN_NSTEP
#define DN_NSTEP 68
#endif
#define DN_CC1(st) (dir == 0 ? (st) : ((st) < 4 ? 3 - (st) : 71 - (st)))
#define DN_CC(step) DN_CC1((step) % 68)
#define AF16(base, row, kchunk) (*(const LAS bf16x8_t*)(Lb + (base) + dn_swz16((row), (kchunk))))
#define AF8(base, row, kchunk) (*(const LAS bf16x8_t*)(Lb + (base) + dn_swz8((row), (kchunk))))
    if (w >= 4) {
        const int lt = tid - 256;
        u32x4 preA[16], preB[16];
#define DN_LOAD(pre, cc_) do { const int cc__ = (cc_); const int item__ = (b * 8 + h) * 68 + cc__, cd__ = item__ * 2 + dir; \
        _Pragma("unroll") for (int k = 0; k < 16; ++k) { const bf16* src; \
            if (k < 4)       { const int q = lt + 256 * k;        src = DK + (size_t)item__ * 8192 + q * 8; } \
            else if (k < 8)  { const int q = lt + 256 * (k - 4);  src = DQ + (size_t)item__ * 8192 + q * 8; } \
            else if (k < 12) { const int q = lt + 256 * (k - 8);  src = KT + (size_t)item__ * 8192 + q * 8; } \
            else if (k < 14) { const int q = lt + 256 * (k - 12); src = TINV + (size_t)cd__ * 4096 + q * 8; } \
            else if (k == 14) { src = DV + (size_t)item__ * 8192 + (lt >> 2) * 128 + qd * 32 + (lt & 3) * 8; } \
            else { src = (const bf16*)(VEC + (size_t)cd__ * 320 + (lt < 80 ? lt : 0) * 4); } \
            pre[k] = *(const u32x4*)src; } } while (0)
#define DN_STORE(pre, bufo_) do { const int bo__ = (bufo_); _Pragma("unroll") for (int k = 0; k < 16; ++k) { int dst; \
            if (k < 4)       { const int q = lt + 256 * k;        dst = KS + dn_swz16(q >> 4, q & 15); } \
            else if (k < 8)  { const int q = lt + 256 * (k - 4);  dst = QS + dn_swz16(q >> 4, q & 15); } \
            else if (k < 12) { const int q = lt + 256 * (k - 8);  dst = KTS + dn_swz8(q >> 3, q & 7); } \
            else if (k < 14) { const int q = lt + 256 * (k - 12); dst = TIS + dn_swz8(q >> 3, q & 7); } \
            else if (k == 14) { dst = VS + lt * 16; } \
            else { dst = VCS + (lt < 80 ? lt : 0) * 16; } \
            *(LAS u32x4*)(L + bo__ + dst) = pre[k]; } } while (0)
#ifdef DN_SKIP_LOAD
#define DN_CLAMP(ds) ((ds) < DN_NSTEP - 70 ? 0 : (ds) < DN_NSTEP ? (ds) : DN_NSTEP - 1)
#else
#define DN_CLAMP(ds) ((ds) < DN_NSTEP ? (ds) : DN_NSTEP - 1)
#endif
#ifndef DN_SLEEP
#define DN_SLEEP 8
#endif
#define DN_LDELAY() __builtin_amdgcn_s_sleep(DN_SLEEP)
        DN_LOAD(preA, DN_CC(0)); DN_STORE(preA, 0); DN_LOAD(preA, DN_CC(1)); DN_LOAD(preB, DN_CC(2));
        DN_BAR();
        for (int step = 0; step < DN_NSTEP; step += 2) {
            DN_LDELAY(); DN_STORE(preA, BUF); DN_LOAD(preA, DN_CC(DN_CLAMP(step + 3)));
            DN_BAR();
            DN_LDELAY(); DN_STORE(preB, 0); DN_LOAD(preB, DN_CC(DN_CLAMP(step + 4)));
            DN_BAR();
        }
#undef DN_CLAMP
#undef DN_LOAD
#undef DN_STORE
    } else if (w >= 2) {
        const int pw = w - 2;
        bf16x8_t qkA[2][4], qkB[2][4];
        f32x4 O[4];
#define DN_QKLOAD(dst, st_) do { const int cd__ = ((b * 8 + h) * 68 + DN_CC(st_)) * 2 + dir; \
        _Pragma("unroll") for (int s = 0; s < 2; ++s) _Pragma("unroll") for (int mt = 0; mt < 4; ++mt) \
            dst[s][mt] = *(const bf16x8_t*)(QKO + (size_t)cd__ * 4096 + dn_perm(fr, mt) * 64 + (4 * s + fq) * 8); } while (0)
#define DN_OFIN(qk, st_) do { const int st__ = (st_); const LAS unsigned char* pv = L + PUBV + (st__ & 1) * 4096 + pw * 2048 + lane * 16; \
        const bf16x8_t vb0 = *(const LAS bf16x8_t*)pv, vb1 = *(const LAS bf16x8_t*)(pv + 1024); \
        _Pragma("unroll") for (int mt = 0; mt < 4; ++mt) { O[mt] = MFMA16(vb0, qk[0][mt], O[mt]); O[mt] = MFMA16(vb1, qk[1][mt], O[mt]); } \
        const int cc__ = DN_CC(st__); \
        if (cc__ >= 4) { bf16* orow = ODN + ((size_t)dir * NT + dn_row0(b, cc__)) * 1024 + h * 128 + qd * 32 + 16 * pw + 4 * fq; \
            _Pragma("unroll") for (int mt = 0; mt < 4; ++mt) { u32x2 w2; w2.x = pk2(O[mt][0], O[mt][1]); w2.y = pk2(O[mt][2], O[mt][3]); \
                *(u32x2*)(orow + (size_t)dn_perm(fr, mt) * 1024) = w2; } } } while (0)
#define DN_OBEG(st_) do { const int st__ = (st_); const LAS unsigned char* Lb = L + (st__ & 1) * BUF; const LAS unsigned char* ps = L + PUBS + (st__ & 1) * 8192 + pw * 4096 + lane * 16; \
        bf16x8_t sb[4], qa[4][4]; \
        _Pragma("unroll") for (int s = 0; s < 4; ++s) sb[s] = *(const LAS bf16x8_t*)(ps + s * 1024); \
        _Pragma("unroll") for (int s = 0; s < 4; ++s) _Pragma("unroll") for (int mt = 0; mt < 4; ++mt) qa[s][mt] = AF16(QS, dn_perm(fr, mt), 4 * s + fq); \
        _Pragma("unroll") for (int mt = 0; mt < 4; ++mt) O[mt] = (f32x4){0.f, 0.f, 0.f, 0.f}; \
        _Pragma("unroll") for (int s = 0; s < 4; ++s) _Pragma("unroll") for (int mt = 0; mt < 4; ++mt) O[mt] = MFMA16(sb[s], qa[s][mt], O[mt]); \
        const LAS float* vc = (const LAS float*)(Lb + VCS); \
        _Pragma("unroll") for (int mt = 0; mt < 4; ++mt) { const float eg = vc[64 + dn_perm(fr, mt)]; O[mt] = O[mt] * eg; } } while (0)
        DN_QKLOAD(qkA, 0); DN_QKLOAD(qkB, 1);
        DN_BAR();
        DN_OBEG(0);
        DN_BAR();
        for (int step = 0; step < DN_NSTEP - 2; step += 2) {
#ifdef DN_SKIP_OUT
            if (step < DN_NSTEP - 70) { DN_BAR(); DN_BAR(); continue; }
#endif
            DN_OFIN(qkA, step); DN_QKLOAD(qkA, step + 2);
            DN_OBEG(step + 1);
            DN_BAR();
            DN_OFIN(qkB, step + 1); DN_QKLOAD(qkB, step + 3);
            DN_OBEG(step + 2);
            DN_BAR();
        }
        DN_OFIN(qkA, DN_NSTEP - 2);
        DN_OBEG(DN_NSTEP - 1);
        DN_BAR();
        DN_OFIN(qkB, DN_NSTEP - 1);
#undef DN_QKLOAD
#undef DN_OFIN
#undef DN_OBEG
    } else {
        f32x4 S[8];
#pragma unroll
        for (int j = 0; j < 8; ++j) S[j] = (f32x4){0.f, 0.f, 0.f, 0.f};
        bf16x8_t sb[4];
#pragma unroll
        for (int s = 0; s < 4; ++s) { sb[s] = dn_bpack(S[2 * s], S[2 * s + 1]); *(LAS bf16x8_t*)(L + PUBS + w * 4096 + s * 1024 + lane * 16) = sb[s]; }
        DN_BAR();
        for (int step = 0; step < DN_NSTEP; ++step) {
#ifdef DN_SKIP_COMP
            if (step < DN_NSTEP - 69) { DN_BAR(); continue; }
#endif
            const LAS unsigned char* Lb = L + (step & 1) * BUF;
            f32x4 P[4];
#pragma unroll
            for (int mt = 0; mt < 4; ++mt) P[mt] = (f32x4){0.f, 0.f, 0.f, 0.f};
            {
                bf16x8_t ka[4][4];
#pragma unroll
                for (int s = 0; s < 4; ++s)
#pragma unroll
                    for (int mt = 0; mt < 4; ++mt) ka[s][mt] = AF16(KS, dn_perm(fr, mt), 4 * s + fq);
                __builtin_amdgcn_sched_barrier(0);
#pragma unroll
                for (int s = 0; s < 4; ++s)
#pragma unroll
                    for (int mt = 0; mt < 4; ++mt) P[mt] = MFMA16(ka[s][mt], sb[s], P[mt]);
            }
            bf16x8_t tia[2][4];
#pragma unroll
            for (int s = 0; s < 2; ++s)
#pragma unroll
                for (int mt = 0; mt < 4; ++mt) tia[s][mt] = AF8(TIS, dn_perm(fr, mt), 4 * s + fq);
            const LAS float* vc = (const LAS float*)(Lb + VCS);
            f32x4 R[4];
#pragma unroll
            for (int mt = 0; mt < 4; ++mt) {
                const int tk0 = 32 * (mt >> 1) + 8 * fq + 4 * (mt & 1);
                const f32x4 bt = *(const LAS f32x4*)(vc + tk0), bg = *(const LAS f32x4*)(vc + 128 + tk0);
#pragma unroll
                for (int r = 0; r < 4; ++r) {
                    const float v = bf2f(*(const LAS unsigned short*)(Lb + VS + (tk0 + r) * 64 + (16 * w + fr) * 2));
                    R[mt][r] = v * bt[r] - bg[r] * P[mt][r];
                }
            }
            const bf16x8_t rb0 = dn_bpack(R[0], R[1]), rb1 = dn_bpack(R[2], R[3]);
            f32x4 VN[4];
#pragma unroll
            for (int mt = 0; mt < 4; ++mt) {
                VN[mt] = (f32x4){0.f, 0.f, 0.f, 0.f};
                VN[mt] = MFMA16(tia[0][mt], rb0, VN[mt]);
                VN[mt] = MFMA16(tia[1][mt], rb1, VN[mt]);
            }
            bf16x8_t kta[2][8];
#pragma unroll
            for (int s = 0; s < 2; ++s)
#pragma unroll
                for (int jt = 0; jt < 8; ++jt) kta[s][jt] = AF8(KTS, dn_perm(fr, jt), 4 * s + fq);
            {
                const bf16x8_t vb0 = dn_bpack(VN[0], VN[1]), vb1 = dn_bpack(VN[2], VN[3]);
                LAS unsigned char* pv = L + PUBV + (step & 1) * 4096 + w * 2048 + lane * 16;
                *(LAS bf16x8_t*)pv = vb0; *(LAS bf16x8_t*)(pv + 1024) = vb1;
            }
#pragma unroll
            for (int mt = 0; mt < 4; ++mt) { const f32x4 ek = *(const LAS f32x4*)(vc + 192 + 32 * (mt >> 1) + 8 * fq + 4 * (mt & 1)); VN[mt] = VN[mt] * ek; }
            const bf16x8_t vs0 = dn_bpack(VN[0], VN[1]), vs1 = dn_bpack(VN[2], VN[3]);
            const float egl = vc[256];
#pragma unroll
            for (int jt = 0; jt < 8; ++jt) {
                S[jt] = S[jt] * egl;
                S[jt] = MFMA16(kta[0][jt], vs0, S[jt]);
                S[jt] = MFMA16(kta[1][jt], vs1, S[jt]);
            }
            if (DN_NSTEP > 68 && step % 68 == 67) {
#pragma unroll
                for (int j = 0; j < 8; ++j) S[j] = (f32x4){0.f, 0.f, 0.f, 0.f};
            }
#pragma unroll
            for (int s = 0; s < 4; ++s) { sb[s] = dn_bpack(S[2 * s], S[2 * s + 1]); *(LAS bf16x8_t*)(L + PUBS + ((step + 1) & 1) * 8192 + w * 4096 + s * 1024 + lane * 16) = sb[s]; }
            DN_BAR();
        }
    }
#undef AF16
#undef AF8
#undef DN_CC
#undef DN_CC1
}

DI void phase_attention(Frame& F, char* lds_generic) {
    bf16* QN = (bf16*)(F.ws + WS_QN); const bf16* KB = (const bf16*)(F.ws + WS_KB); const bf16* VB = (const bf16*)(F.ws + WS_VB);
    for (int it = F.vcu; it < 512; it += F.G) {
        const int b = it >> 7, kvh = (it >> 6) & 1, g = (it >> 4) & 3, qb = it & 15, h = kvh * 4 + g;
        bf16* Qb = QN + ((size_t)(b * TS + qb * 256) * 1024 + h * 128);
        const bf16* Kh = KB + ((size_t)b * LKV * 256 + kvh * 128); const bf16* Vh = VB + ((size_t)b * LKV * 256 + kvh * 128);
#ifdef ATTN_PROBE
#pragma nounroll
        for (int rep_ = 0; rep_ < 2; ++rep_) {
            bf16* Ob = rep_ == 0 ? (bf16*)(F.ws + WS_END) + ((size_t)(b * TS + qb * 256) * 1024 + h * 128) : Qb;
            attn::attn_dense_body<attn::bf16>(Qb, Kh, Vh, Ob, LKV, lds_generic);
            __syncthreads();
        }
#else
        attn::attn_dense_body<attn::bf16>(Qb, Kh, Vh, Qb, LKV, lds_generic);
        __syncthreads();
#endif
    }
}

DI void phase_mergeprep(Frame& F) {
    const bf16* ODN = (const bf16*)(F.ws + WS_ODN); bf16* Z = (bf16*)(F.ws + WS_Z); const int lane = F.lane;
    float nw[16];
#pragma unroll
    for (int k = 0; k < 4; ++k) { const f32x4 v = *(const f32x4*)(F.in[14] + (lane & 7) * 16 + 4 * k); nw[4 * k] = v[0]; nw[4 * k + 1] = v[1]; nw[4 * k + 2] = v[2]; nw[4 * k + 3] = v[3]; }
    for (int t = F.gw; t < NT; t += F.NGW) {
        const size_t off = (size_t)t * 1024 + 16 * lane;
        u32x4 a[2], c[2], z[2];
#pragma unroll
        for (int k = 0; k < 2; ++k) { a[k] = __builtin_nontemporal_load((const u32x4*)(ODN + off + 8 * k)); c[k] = __builtin_nontemporal_load((const u32x4*)(ODN + (size_t)NT * 1024 + off + 8 * k)); z[k] = __builtin_nontemporal_load((const u32x4*)(Z + off + 8 * k)); }
        float o[16]; float ss = 0.f;
#pragma unroll
        for (int k = 0; k < 2; ++k)
#pragma unroll
            for (int i = 0; i < 4; ++i) { o[8 * k + 2 * i] = bflo(a[k][i]) + bflo(c[k][i]); o[8 * k + 2 * i + 1] = bfhi(a[k][i]) + bfhi(c[k][i]); }
#pragma unroll
        for (int i = 0; i < 16; ++i) ss += o[i] * o[i];
        ss += __shfl_xor(ss, 1); ss += __shfl_xor(ss, 2); ss += __shfl_xor(ss, 4);
        const float rstd = rsqrtf(ss * (1.f / 128.f) + EPS);
        if (MERGE_F8_B) {
            float y[16];
#pragma unroll
            for (int k = 0; k < 2; ++k)
#pragma unroll
                for (int i = 0; i < 4; ++i) { y[8 * k + 2 * i] = o[8 * k + 2 * i] * rstd * nw[8 * k + 2 * i] * silu(bflo(z[k][i])); y[8 * k + 2 * i + 1] = o[8 * k + 2 * i + 1] * rstd * nw[8 * k + 2 * i + 1] * silu(bfhi(z[k][i])); }
            u32x4 w;
#pragma unroll
            for (int q = 0; q < 4; ++q) w[q] = pk4_fp8(fp8c(y[4 * q] * ODNN_SCALE), fp8c(y[4 * q + 1] * ODNN_SCALE), fp8c(y[4 * q + 2] * ODNN_SCALE), fp8c(y[4 * q + 3] * ODNN_SCALE));
            *(u32x4*)(F.ws + WS_ODNN8 + off) = w;
        } else {
#pragma unroll
        for (int k = 0; k < 2; ++k) {
            u32x4 w;
#pragma unroll
            for (int i = 0; i < 4; ++i) w[i] = pk2(o[8 * k + 2 * i] * rstd * nw[8 * k + 2 * i] * silu(bflo(z[k][i])), o[8 * k + 2 * i + 1] * rstd * nw[8 * k + 2 * i + 1] * silu(bfhi(z[k][i])));
            *(u32x4*)(Z + off + 8 * k) = w;
        }
        }
        if (MERGE_F8_A) {
            const bf16* OA = (const bf16*)(F.ws + WS_QN);
            const u32x4 a0 = __builtin_nontemporal_load((const u32x4*)(OA + off)), a1 = __builtin_nontemporal_load((const u32x4*)(OA + off + 8));
            u32x4 w;
            w[0] = pk4_fp8(fp8c(bflo(a0.x) * OATT_SCALE), fp8c(bfhi(a0.x) * OATT_SCALE), fp8c(bflo(a0.y) * OATT_SCALE), fp8c(bfhi(a0.y) * OATT_SCALE));
            w[1] = pk4_fp8(fp8c(bflo(a0.z) * OATT_SCALE), fp8c(bfhi(a0.z) * OATT_SCALE), fp8c(bflo(a0.w) * OATT_SCALE), fp8c(bfhi(a0.w) * OATT_SCALE));
            w[2] = pk4_fp8(fp8c(bflo(a1.x) * OATT_SCALE), fp8c(bfhi(a1.x) * OATT_SCALE), fp8c(bflo(a1.y) * OATT_SCALE), fp8c(bfhi(a1.y) * OATT_SCALE));
            w[3] = pk4_fp8(fp8c(bflo(a1.z) * OATT_SCALE), fp8c(bfhi(a1.z) * OATT_SCALE), fp8c(bflo(a1.w) * OATT_SCALE), fp8c(bfhi(a1.w) * OATT_SCALE));
            *(u32x4*)(F.ws + WS_OATT8 + off) = w;
        }
    }
}

DI void tk_insert(unsigned (&a)[16], unsigned x) {
#pragma unroll
    for (int i = 0; i < 16; ++i) { const unsigned hi = a[i] > x ? a[i] : x; x = a[i] > x ? x : a[i]; a[i] = hi; }
}
template <int N> DI void tk_sort_desc(unsigned (&a)[N]) {
#pragma unroll
    for (int k = 2; k <= N; k <<= 1)
#pragma unroll
        for (int j = k >> 1; j > 0; j >>= 1)
#pragma unroll
            for (int i = 0; i < N; ++i) {
                const int l = i ^ j;
                if (l > i) {
                    const unsigned lo = a[i] < a[l] ? a[i] : a[l], hi = a[i] < a[l] ? a[l] : a[i];
                    if ((i & k) == 0) { a[i] = hi; a[l] = lo; } else { a[i] = lo; a[l] = hi; }
                }
            }
}
DI void tk_sort_bitonic(unsigned (&c)[16]) {
#pragma unroll
    for (int s = 8; s >= 1; s >>= 1)
#pragma unroll
        for (int i = 0; i < 16; ++i) if ((i & s) == 0) { const unsigned lo = c[i] < c[i + s] ? c[i] : c[i + s], hi = c[i] < c[i + s] ? c[i + s] : c[i]; c[i] = hi; c[i + s] = lo; }
}
template <bool SORT> DI void tk_merge(unsigned (&a)[16], int m) {
    unsigned b[16];
#pragma unroll
    for (int i = 0; i < 16; ++i) b[i] = (unsigned)__shfl_xor((int)a[15 - i], m);
#pragma unroll
    for (int i = 0; i < 16; ++i) a[i] = a[i] > b[i] ? a[i] : b[i];
    if (SORT) tk_sort_bitonic(a);
}
DI float tk_unkey(unsigned k) { const unsigned u = (k & 0x80000000u) ? (k & 0x7fffffffu) : ~k; return __uint_as_float(u); }

DI void phase_peer_topk(Frame& F) {
    LAS unsigned char* L = F.lds;
    constexpr int KS = 0, QS = 69632, SC = 69632, TOP = 137216, FIN = 139264, PT = 140288;
    const bf16* PQ = (const bf16*)(F.ws + WS_PQ); const bf16* SUBK = (const bf16*)(F.ws + WS_SUBK);
    int* EXPI = (int*)(F.ws + WS_EXPI); float* EXPG = (float*)(F.ws + WS_EXPG);
    const int tid = F.tid, lane = F.lane, w = F.wave, fr = lane & 15, fq = lane >> 4;
    LAS float* sc = (LAS float*)(L + SC); LAS unsigned char* top = L + TOP; LAS unsigned char* finb = L + FIN; LAS int* pt = (LAS int*)(L + PT);
    if (tid < 56) {
        int n = tid, pi = -1;
#pragma unroll
        for (int i = 0; i < 16; ++i) { const int cnt = 16 / (i + 1); if (pi < 0) { if (n < cnt) pi = i * 16 + n; else n -= cnt; } }
        pt[tid] = tid < 50 ? pi : -1;
    }
    int hcur = -1;
    u32x4 qpre[4];
    if (F.vcu < (NT / 64) * 8) {
        const int h0 = F.vcu & 7, tq = (F.vcu >> 3) * 64;
#pragma unroll
        for (int k = 0; k < 4; ++k) { const int c = tid + 512 * k; qpre[k] = __builtin_nontemporal_load((const u32x4*)(PQ + (size_t)(tq + (c >> 5)) * 2048 + h0 * 256 + (c & 31) * 8)); }
    }
    for (int it = F.vcu; it < (NT / 64) * 8; it += F.G) {
        const int h = it & 7, tile = it >> 3, t0 = tile * 64;
        RAW_BAR();
        if (h != hcur) {
#pragma unroll
            for (int k = 0; k < 8; ++k) { const int c = tid + 512 * k, row = c >> 4, c16 = c & 15;
                *(LAS u32x4*)(L + KS + row * 272 + c16 * 16) = *(const u32x4*)(SUBK + (size_t)h * 32768 + row * 128 + c16 * 8); }
            hcur = h;
        }
#pragma unroll
        for (int k = 0; k < 4; ++k) { const int c = tid + 512 * k, row = c >> 5, c16 = c & 31; *(LAS u32x4*)(L + QS + row * 528 + c16 * 16) = qpre[k]; }
        if (it + F.G < (NT / 64) * 8) {
            const int itn = it + F.G, hn = itn & 7, tn = (itn >> 3) * 64;
#pragma unroll
            for (int k = 0; k < 4; ++k) { const int c = tid + 512 * k; qpre[k] = __builtin_nontemporal_load((const u32x4*)(PQ + (size_t)(tn + (c >> 5)) * 2048 + hn * 256 + (c & 31) * 8)); }
        }
        RAW_BAR();
        const int p = w >> 2, n0 = (w & 3) * 32;
        f32x4 acc[4][2];
#pragma unroll
        for (int mt = 0; mt < 4; ++mt) { acc[mt][0] = (f32x4){0.f, 0.f, 0.f, 0.f}; acc[mt][1] = (f32x4){0.f, 0.f, 0.f, 0.f}; }
#pragma unroll
        for (int s = 0; s < 4; ++s) {
            const bf16x8_t b0 = *(const LAS bf16x8_t*)(L + KS + (p * 128 + n0 + fr) * 272 + (32 * s + 8 * fq) * 2);
            const bf16x8_t b1 = *(const LAS bf16x8_t*)(L + KS + (p * 128 + n0 + 16 + fr) * 272 + (32 * s + 8 * fq) * 2);
#pragma unroll
            for (int mt = 0; mt < 4; ++mt) {
                const bf16x8_t a = *(const LAS bf16x8_t*)(L + QS + (16 * mt + fr) * 528 + (p * 128 + 32 * s + 8 * fq) * 2);
                acc[mt][0] = MFMA16(a, b0, acc[mt][0]); acc[mt][1] = MFMA16(a, b1, acc[mt][1]);
            }
        }
        RAW_BAR();
#pragma unroll
        for (int mt = 0; mt < 4; ++mt)
#pragma unroll
            for (int nt = 0; nt < 2; ++nt)
#pragma unroll
                for (int r = 0; r < 4; ++r) sc[((16 * mt + 4 * fq + r) * 2 + p) * 132 + (w & 3) * 33 + 16 * nt + fr] = acc[mt][nt][r];
        RAW_BAR();
        {
            const int list = tid >> 2, q = tid & 3;
            unsigned a32[32];
            const LAS float* sp = sc + list * 132 + q * 33;
#pragma unroll
            for (int i = 0; i < 32; ++i) a32[i] = (okey(sp[i]) & ~0x7Fu) | (unsigned)(q * 32 + i);
            tk_sort_desc<32>(a32);
            unsigned a[16];
#pragma unroll
            for (int i = 0; i < 16; ++i) a[i] = a32[i];
            tk_merge<true>(a, 1); tk_merge<true>(a, 2);
            if (q == 0) {
                u32x4 v;
#pragma unroll
                for (int k = 0; k < 4; ++k) v[k] = (a[4 * k] & 127u) | ((a[4 * k + 1] & 127u) << 8) | ((a[4 * k + 2] & 127u) << 16) | ((a[4 * k + 3] & 127u) << 24);
                *(LAS u32x4*)(top + list * 16) = v;
            }
        }
        RAW_BAR();
        {
            const int tok = tid >> 3, r8 = tid & 7;
            unsigned c8[8]; c8[7] = 0u;
#pragma unroll
            for (int m = 0; m < 7; ++m) {
                const int pr = pt[r8 + 8 * m];
                unsigned ck = 0u;
                if (pr >= 0) {
                    const int ia = top[(tok * 2) * 16 + (pr >> 4)], ib = top[(tok * 2 + 1) * 16 + (pr & 15)];
                    const float cs = sc[(tok * 2) * 132 + (ia >> 5) * 33 + (ia & 31)] + sc[(tok * 2 + 1) * 132 + (ib >> 5) * 33 + (ib & 31)];
                    ck = (okey(cs) & ~0xFFu) | (unsigned)pr;
                }
                c8[m] = ck;
            }
            tk_sort_desc<8>(c8);
            unsigned a[16];
#pragma unroll
            for (int i = 0; i < 16; ++i) a[i] = i < 8 ? c8[i] : 0u;
            tk_merge<true>(a, 1); tk_merge<true>(a, 2); tk_merge<true>(a, 4);
            LAS unsigned char* fin = finb + tok * 16;
            if (r8 == 0) {
                u32x4 v;
#pragma unroll
                for (int k = 0; k < 4; ++k) v[k] = (a[4 * k] & 255u) | ((a[4 * k + 1] & 255u) << 8) | ((a[4 * k + 2] & 255u) << 16) | ((a[4 * k + 3] & 255u) << 24);
                *(LAS u32x4*)fin = v;
            }
            asm volatile("s_waitcnt lgkmcnt(0)" ::: "memory");
            float bs[2]; int ex[2];
#pragma unroll
            for (int e = 0; e < 2; ++e) {
                const unsigned pr = fin[2 * r8 + e];
                const int ia = top[(tok * 2) * 16 + (pr >> 4)], ib = top[(tok * 2 + 1) * 16 + (pr & 15u)];
                bs[e] = sc[(tok * 2) * 132 + (ia >> 5) * 33 + (ia & 31)] + sc[(tok * 2 + 1) * 132 + (ib >> 5) * 33 + (ib & 31)];
                ex[e] = ia * 128 + ib;
            }
            float mx = fmaxf(bs[0], bs[1]);
            mx = fmaxf(mx, __shfl_xor(mx, 1)); mx = fmaxf(mx, __shfl_xor(mx, 2)); mx = fmaxf(mx, __shfl_xor(mx, 4));
            const float e0 = __expf(bs[0] - mx), e1 = __expf(bs[1] - mx);
            float sm = e0 + e1; sm += __shfl_xor(sm, 1); sm += __shfl_xor(sm, 2); sm += __shfl_xor(sm, 4);
            const float rs = 1.f / sm;
            const size_t o = (size_t)(t0 + tok) * 128 + h * 16 + 2 * r8;
            *(int2*)(EXPI + o) = make_int2(ex[0], ex[1]);
            *(float2*)(EXPG + o) = make_float2(e0 * rs, e1 * rs);
        }
    }
}

DI float ub0(unsigned w) { float r; asm("v_cvt_f32_ubyte0 %0, %1" : "=v"(r) : "v"(w)); return r; }
DI float ub1(unsigned w) { float r; asm("v_cvt_f32_ubyte1 %0, %1" : "=v"(r) : "v"(w)); return r; }
DI float ub2(unsigned w) { float r; asm("v_cvt_f32_ubyte2 %0, %1" : "=v"(r) : "v"(w)); return r; }
DI float ub3(unsigned w) { float r; asm("v_cvt_f32_ubyte3 %0, %1" : "=v"(r) : "v"(w)); return r; }
DI float wave_maxf(float v) {
#pragma unroll
    for (int o = 1; o < 64; o <<= 1) v = fmaxf(v, __shfl_xor(v, o));
    return v;
}
template <int BIAS> DI void quant_rows(const float* src, unsigned char* dst, float* scale, int gw, int NGW, int lane) {
    for (int row = gw; row < NEXP; row += NGW) {
        f32x4 v[8]; float am = 0.f;
#pragma unroll
        for (int j = 0; j < 8; ++j) { v[j] = __builtin_nontemporal_load((const f32x4*)(src + (size_t)row * DM) + lane + 64 * j); am = fmaxf(am, fmaxf(fmaxf(fabsf(v[j][0]), fabsf(v[j][1])), fmaxf(fabsf(v[j][2]), fabsf(v[j][3])))); }
        am = wave_maxf(am);
        const float inv = am > 0.f ? 127.f / am : 0.f;
#pragma unroll
        for (int j = 0; j < 8; ++j) {
            unsigned w = 0;
#pragma unroll
            for (int i = 0; i < 4; ++i) { const int q = (int)rintf(v[j][i] * inv) + BIAS; w |= ((unsigned)q & 0xffu) << (8 * i); }
            *((unsigned*)(dst + (size_t)row * DM) + lane + 64 * j) = w;
        }
        if (lane == 0) scale[row] = am * (1.f / 127.f);
    }
}


constexpr int V4_ROW = 1152;
DI void quant_rows_i4(const float* __restrict__ src, unsigned char* __restrict__ dst, int gw, int NGW, int lane) {
#pragma unroll 2
    for (int row = gw; row < NEXP; row += NGW) {
        f32x4 vv[8];
#pragma unroll
        for (int j = 0; j < 8; ++j) vv[j] = __builtin_nontemporal_load((const f32x4*)(src + (size_t)row * DM) + lane + 64 * j);
#pragma unroll
        for (int j = 0; j < 8; ++j) {
            const f32x4 v = vv[j];
            float am = fmaxf(fmaxf(fabsf(v[0]), fabsf(v[1])), fmaxf(fabsf(v[2]), fabsf(v[3])));
            am = fmaxf(am, __shfl_xor(am, 1)); am = fmaxf(am, __shfl_xor(am, 2)); am = fmaxf(am, __shfl_xor(am, 4));
            const unsigned sb = f2bf(am * (1.f / 7.f)); const float s = __uint_as_float(sb << 16), inv = s > 0.f ? __builtin_amdgcn_rcpf(s) : 0.f;
            unsigned w = 0;
#pragma unroll
            for (int i = 0; i < 4; ++i) { const int q = (int)fminf(fmaxf(rintf(v[i] * inv), -7.f), 7.f) + 8; w |= (unsigned)q << (4 * i); }
            const int grp = j * 8 + (lane >> 3);
            *(unsigned short*)(dst + (size_t)row * V4_ROW + grp * 16 + (lane & 7) * 2) = (unsigned short)w;
            *(unsigned short*)(dst + (size_t)row * V4_ROW + 1024 + grp * 2) = (unsigned short)sb;
        }
    }
}

DI void quant_u_both(const float* __restrict__ src, unsigned char* __restrict__ d8, float* __restrict__ scale, unsigned char* __restrict__ d4, int gw, int NGW, int lane) {
#pragma unroll 2
    for (int row = gw; row < NEXP; row += NGW) {
        f32x4 v[8]; float am = 0.f;
#pragma unroll
        for (int j = 0; j < 8; ++j) { v[j] = __builtin_nontemporal_load((const f32x4*)(src + (size_t)row * DM) + lane + 64 * j); am = fmaxf(am, fmaxf(fmaxf(fabsf(v[j][0]), fabsf(v[j][1])), fmaxf(fabsf(v[j][2]), fabsf(v[j][3])))); }
        const float rowmax = wave_maxf(am), inv8 = rowmax > 0.f ? 127.f / rowmax : 0.f;
#pragma unroll
        for (int j = 0; j < 8; ++j) {
            unsigned w8 = 0;
#pragma unroll
            for (int i = 0; i < 4; ++i) { const int q = (int)rintf(v[j][i] * inv8); w8 |= ((unsigned)q & 0xffu) << (8 * i); }
            *((unsigned*)(d8 + (size_t)row * DM) + lane + 64 * j) = w8;
            float gm = fmaxf(fmaxf(fabsf(v[j][0]), fabsf(v[j][1])), fmaxf(fabsf(v[j][2]), fabsf(v[j][3])));
            gm = fmaxf(gm, __shfl_xor(gm, 1)); gm = fmaxf(gm, __shfl_xor(gm, 2)); gm = fmaxf(gm, __shfl_xor(gm, 4));
            const unsigned sb = f2bf(gm * (1.f / 7.f)); const float s = __uint_as_float(sb << 16), inv = s > 0.f ? __builtin_amdgcn_rcpf(s) : 0.f;
            unsigned w = 0;
#pragma unroll
            for (int i = 0; i < 4; ++i) { const int q = (int)fminf(fmaxf(rintf(v[j][i] * inv), -7.f), 7.f) + 8; w |= (unsigned)q << (4 * i); }
            const int grp = j * 8 + (lane >> 3);
            *(unsigned short*)(d4 + (size_t)row * V4_ROW + grp * 16 + (lane & 7) * 2) = (unsigned short)w;
            *(unsigned short*)(d4 + (size_t)row * V4_ROW + 1024 + grp * 2) = (unsigned short)sb;
        }
        if (lane == 0) scale[row] = rowmax * (1.f / 127.f);
    }
}

DI void phase_peer_gather(Frame& F, int emask = 0x3fff, int vmask = 0x3fff) {
    const bf16* H2 = (const bf16*)(F.ws + WS_H2);
    const unsigned char* U8 = F.ws + WS_U8; const unsigned char* U4 = F.ws + WS_U4; const unsigned char* V4 = F.ws + WS_V8; const float* SU = (const float*)(F.ws + WS_SU);
    const int* EXPI = (const int*)(F.ws + WS_EXPI); const float* EXPG = (const float*)(F.ws + WS_EXPG);
    const bf16* X1 = (const bf16*)(F.ws + WS_X1); const float* MOD = (const float*)(F.ws + WS_MOD); const int lane = F.lane;
    LAS float* la = (LAS float*)(F.lds + F.wave * 1024);
    LAS int* li = (LAS int*)(F.lds + F.wave * 1024 + 512);
    const int eloc = ((lane >> 5) & 1) * 4 + ((lane >> 4) & 1) * 2 + ((lane >> 3) & 1);
#ifdef GATHER_SUBSET
    if ((blockIdx.x >> 3) % GATHER_SUBSET != 0) return;
    const int gw_ = ((blockIdx.x >> 3) / GATHER_SUBSET * 8 + (blockIdx.x & 7)) * NWAVES + F.wave, ngw_ = F.NGW / GATHER_SUBSET;
#else
    const int gw_ = F.gw, ngw_ = F.NGW;
#endif
    for (int t = gw_; t < NT; t += ngw_) {
        float xf[2][16]; float am = 0.f;
#pragma unroll
        for (int j = 0; j < 2; ++j) {
            const u32x4 w0 = *((const u32x4*)(H2 + (size_t)t * DM) + 2 * (lane + 64 * j)), w1 = *((const u32x4*)(H2 + (size_t)t * DM) + 2 * (lane + 64 * j) + 1);
            xf[j][0] = bflo(w0.x); xf[j][1] = bfhi(w0.x); xf[j][2] = bflo(w0.y); xf[j][3] = bfhi(w0.y); xf[j][4] = bflo(w0.z); xf[j][5] = bfhi(w0.z); xf[j][6] = bflo(w0.w); xf[j][7] = bfhi(w0.w);
            xf[j][8] = bflo(w1.x); xf[j][9] = bfhi(w1.x); xf[j][10] = bflo(w1.y); xf[j][11] = bfhi(w1.y); xf[j][12] = bflo(w1.z); xf[j][13] = bfhi(w1.z); xf[j][14] = bflo(w1.w); xf[j][15] = bfhi(w1.w);
#pragma unroll
            for (int i = 0; i < 16; ++i) am = fmaxf(am, fabsf(xf[j][i]));
        }
        am = wave_maxf(am);
        const float inv = am > 0.f ? 127.f / am : 0.f, sx = am * (1.f / 127.f);
        int xq[2][4];
#pragma unroll
        for (int j = 0; j < 2; ++j)
#pragma unroll
            for (int k = 0; k < 4; ++k) {
                unsigned w = 0;
#pragma unroll
                for (int i = 0; i < 4; ++i) w |= ((unsigned)(int)rintf(xf[j][4 * k + i] * inv) & 0xffu) << (8 * i);
                xq[j][k] = (int)w;
            }
        int xe[4], xo[4], xsum4 = 0;
#pragma unroll
        for (int d = 0; d < 4; ++d) {
            const u32x4 w = *((const u32x4*)(H2 + (size_t)t * DM + 32 * lane) + d);
            int q[8];
#pragma unroll
            for (int i = 0; i < 4; ++i) { q[2 * i] = (int)rintf(bflo(w[i]) * inv); q[2 * i + 1] = (int)rintf(bfhi(w[i]) * inv); }
            xe[d] = (int)(((unsigned)q[0] & 0xffu) | (((unsigned)q[2] & 0xffu) << 8) | (((unsigned)q[4] & 0xffu) << 16) | (((unsigned)q[6] & 0xffu) << 24));
            xo[d] = (int)(((unsigned)q[1] & 0xffu) | (((unsigned)q[3] & 0xffu) << 8) | (((unsigned)q[5] & 0xffu) << 16) | (((unsigned)q[7] & 0xffu) << 24));
#pragma unroll
            for (int i = 0; i < 8; ++i) xsum4 += q[i];
        }
        float asum = 0.f;
        const int ei0 = EXPI[(size_t)t * 128 + lane] & emask, ei1 = EXPI[(size_t)t * 128 + 64 + lane] & emask;
        const float eg0 = EXPG[(size_t)t * 128 + lane], eg1 = EXPG[(size_t)t * 128 + 64 + lane];
        u32x4 wa0[8], wa1[8], wb[8]; unsigned short sbh[8];
#define ULOADA(hd_) do { const int eis_ = (hd_) < 4 ? ei0 : ei1, base_ = ((hd_) & 3) * 16; \
            _Pragma("unroll") for (int e = 0; e < 8; ++e) { const int idx_ = __builtin_amdgcn_readlane(eis_, base_ + e); const u32x4* ur_ = (const u32x4*)(U8 + (size_t)idx_ * DM); wa0[e] = ur_[lane]; wa1[e] = ur_[lane + 64]; } } while (0)
#define ULOADB(hd_) do { const int eis_ = (hd_) < 4 ? ei0 : ei1, base_ = ((hd_) & 3) * 16 + 8; \
            _Pragma("unroll") for (int e = 0; e < 8; ++e) { const int idx_ = __builtin_amdgcn_readlane(eis_, base_ + e); const unsigned char* u4_ = U4 + (size_t)idx_ * V4_ROW; wb[e] = *(const u32x4*)(u4_ + 16 * lane); sbh[e] = *(const unsigned short*)(u4_ + 1024 + 2 * lane); } } while (0)
#define ULOADA_NEXT(hd_) do { const int h_ = (hd_); const int eis_ = (h_ & 4) ? ei1 : ei0, base_ = (h_ & 3) * 16, msk_ = h_ < 8 ? -1 : 0; \
            _Pragma("unroll") for (int e = 0; e < 8; ++e) { const int idx_ = __builtin_amdgcn_readlane(eis_, base_ + e) & msk_; const u32x4* ur_ = (const u32x4*)(U8 + (size_t)idx_ * DM); wa0[e] = ur_[lane]; wa1[e] = ur_[lane + 64]; } } while (0)
        ULOADA(0);
#pragma unroll 1
        for (int hd = 0; hd < 8; ++hd) {
            const int eisel = hd < 4 ? ei0 : ei1; const float egsel = hd < 4 ? eg0 : eg1;
            const int base = (hd & 3) * 16;
            const int myidxA = __shfl(eisel, base + eloc), myidxB = __shfl(eisel, base + 8 + eloc);
            const float mygA = __shfl(egsel, base + eloc), mygB = __shfl(egsel, base + 8 + eloc);
            const float mysu = SU[myidxA];
            ULOADB(hd);
            float accA[8], accB[8];
#pragma unroll
            for (int e = 0; e < 8; ++e) {
                int a = __builtin_amdgcn_sdot4((int)wa0[e].x, xq[0][0], 0, false); a = __builtin_amdgcn_sdot4((int)wa0[e].y, xq[0][1], a, false);
                a = __builtin_amdgcn_sdot4((int)wa0[e].z, xq[0][2], a, false); a = __builtin_amdgcn_sdot4((int)wa0[e].w, xq[0][3], a, false);
                a = __builtin_amdgcn_sdot4((int)wa1[e].x, xq[1][0], a, false); a = __builtin_amdgcn_sdot4((int)wa1[e].y, xq[1][1], a, false);
                a = __builtin_amdgcn_sdot4((int)wa1[e].z, xq[1][2], a, false); a = __builtin_amdgcn_sdot4((int)wa1[e].w, xq[1][3], a, false);
                accA[e] = (float)a;
            }
            __builtin_amdgcn_sched_barrier(0);
            ULOADA_NEXT(hd + 1);
#pragma unroll
            for (int e = 0; e < 8; ++e) {
                int b = 0;
#pragma unroll
                for (int d = 0; d < 4; ++d) { b = __builtin_amdgcn_sdot4((int)(wb[e][d] & 0x0F0F0F0Fu), xe[d], b, false); b = __builtin_amdgcn_sdot4((int)((wb[e][d] >> 4) & 0x0F0F0F0Fu), xo[d], b, false); }
                accB[e] = (float)(b - 8 * xsum4) * bf2f(sbh[e]);
            }
            float rA, rB;
            {
                float r4[4], r2[2], s4[4], s2[2];
#pragma unroll
                for (int i = 0; i < 4; ++i) {
                    const float sndA = (lane & 32) ? accA[i] : accA[i + 4], kpA = (lane & 32) ? accA[i + 4] : accA[i]; r4[i] = kpA + __shfl_xor(sndA, 32);
                    const float sndB = (lane & 32) ? accB[i] : accB[i + 4], kpB = (lane & 32) ? accB[i + 4] : accB[i]; s4[i] = kpB + __shfl_xor(sndB, 32); }
#pragma unroll
                for (int i = 0; i < 2; ++i) {
                    const float sndA = (lane & 16) ? r4[i] : r4[i + 2], kpA = (lane & 16) ? r4[i + 2] : r4[i]; r2[i] = kpA + __shfl_xor(sndA, 16);
                    const float sndB = (lane & 16) ? s4[i] : s4[i + 2], kpB = (lane & 16) ? s4[i + 2] : s4[i]; s2[i] = kpB + __shfl_xor(sndB, 16); }
                { const float sndA = (lane & 8) ? r2[0] : r2[1], kpA = (lane & 8) ? r2[1] : r2[0]; rA = kpA + __shfl_xor(sndA, 8);
                  const float sndB = (lane & 8) ? s2[0] : s2[1], kpB = (lane & 8) ? s2[1] : s2[0]; rB = kpB + __shfl_xor(sndB, 8); }
                rA += __shfl_xor(rA, 4); rA += __shfl_xor(rA, 2); rA += __shfl_xor(rA, 1);
                rB += __shfl_xor(rB, 4); rB += __shfl_xor(rB, 2); rB += __shfl_xor(rB, 1);
            }
            const float aA = gelu_erf(rA * mysu * sx) * mygA, aB = gelu_erf(rB * sx) * mygB;
            if ((lane & 7) == 0) { la[hd * 16 + eloc] = aA; li[hd * 16 + eloc] = myidxA & vmask; la[hd * 16 + 8 + eloc] = aB; li[hd * 16 + 8 + eloc] = myidxB & vmask; asum += aA + aB; }
        }
#undef ULOADA
#undef ULOADA_NEXT
#undef ULOADB
        asum = wave_sum(asum);
        asm volatile("s_waitcnt lgkmcnt(0)" ::: "memory");
        f32x2 o2[16]; float csum = 0.f;
#pragma unroll
        for (int i = 0; i < 16; ++i) o2[i] = (f32x2){0.f, 0.f};
#pragma unroll 16
        for (int e = 0; e < 128; ++e) {
            const int idx = __builtin_amdgcn_readfirstlane(li[e]); const float a = __uint_as_float((unsigned)__builtin_amdgcn_readfirstlane((int)__float_as_uint(la[e])));
            const unsigned char* vr = V4 + (size_t)idx * V4_ROW;
            const u32x4 w = *(const u32x4*)(vr + 16 * lane);
            const float as = a * bf2f(*(const unsigned short*)(vr + 1024 + 2 * lane));
            csum += as;
            const f32x2 as2 = {as, as};
#pragma unroll
            for (int d = 0; d < 4; ++d) {
                const unsigned lo = w[d] & 0x0F0F0F0Fu, hi = (w[d] >> 4) & 0x0F0F0F0Fu;
                o2[4 * d + 0] = __builtin_elementwise_fma(as2, (f32x2){ub0(lo), ub0(hi)}, o2[4 * d + 0]); o2[4 * d + 1] = __builtin_elementwise_fma(as2, (f32x2){ub1(lo), ub1(hi)}, o2[4 * d + 1]);
                o2[4 * d + 2] = __builtin_elementwise_fma(as2, (f32x2){ub2(lo), ub2(hi)}, o2[4 * d + 2]); o2[4 * d + 3] = __builtin_elementwise_fma(as2, (f32x2){ub3(lo), ub3(hi)}, o2[4 * d + 3]);
            }
        }
        float o[32];
#pragma unroll
        for (int i = 0; i < 16; ++i) { o[2 * i] = o2[i][0]; o[2 * i + 1] = o2[i][1]; }
        LAS float* tp = (LAS float*)(F.lds + 8192 + F.wave * 9216);
        const float corr = 8.f * csum;
#pragma unroll
        for (int k = 0; k < 8; ++k) { f32x4 v; v[0] = o[4 * k] - corr; v[1] = o[4 * k + 1] - corr; v[2] = o[4 * k + 2] - corr; v[3] = o[4 * k + 3] - corr; *(LAS f32x4*)(tp + lane * 36 + 4 * k) = v; }
        asm volatile("s_waitcnt lgkmcnt(0)" ::: "memory");
        const float* g2 = MOD + (size_t)(t >> 12) * 12288 + 5 * 2048;
        f32x4 x2[8]; float ss = 0.f;
#pragma unroll
        for (int j = 0; j < 8; ++j) {
            const int ch = lane + 64 * j;
            const f32x4 pv = *(const LAS f32x4*)(tp + (ch >> 3) * 36 + 4 * (ch & 7));
            const u32x2 xw = __builtin_nontemporal_load((const u32x2*)(X1 + (size_t)t * DM) + ch); const f32x4 xa = {bflo(xw.x), bfhi(xw.x), bflo(xw.y), bfhi(xw.y)}, ga = *((const f32x4*)g2 + ch);
            x2[j] = xa + ga * pv;
            ss += (x2[j][0] * x2[j][0] + x2[j][1] * x2[j][1]) + (x2[j][2] * x2[j][2] + x2[j][3] * x2[j][3]);
        }
        const float rstd = rsqrtf(wave_sum(ss) * (1.f / DM) + EPS);
        const float* fw = F.in[22];
#pragma unroll
        for (int j = 0; j < 8; ++j) { const int ch = lane + 64 * j; const f32x4 wa = *((const f32x4*)fw + ch); __builtin_nontemporal_store(x2[j] * rstd * wa, (f32x4*)(F.out + (size_t)t * DM) + ch); }
        asm volatile("s_waitcnt lgkmcnt(0)" ::: "memory");
    }
}

DI void phase_h2(Frame& F) {
    const float* MOD = (const float*)(F.ws + WS_MOD); bf16* H2 = (bf16*)(F.ws + WS_H2); const bf16* X1 = (const bf16*)(F.ws + WS_X1);
    ModPar P;
    constexpr int RPW = NT / (256 * NWAVES);
    if (F.NGW == 256 * NWAVES) {
        const int m0 = F.gw * RPW, r = m0 >> 12;
        modpar_load(P, F.in[7], MOD + (size_t)r * 12288 + 4 * 2048, MOD + (size_t)r * 12288 + 3 * 2048, F.lane);
        modnorm_rows_bf(X1 + (size_t)m0 * DM, H2 + (size_t)m0 * DM, RPW, P, F.lane);
    } else {
        for (int m = F.gw; m < NT; m += F.NGW) { const int r = m >> 12; modpar_load(P, F.in[7], MOD + (size_t)r * 12288 + 4 * 2048, MOD + (size_t)r * 12288 + 3 * 2048, F.lane); modnorm_rows_bf(X1 + (size_t)m * DM, H2 + (size_t)m * DM, 1, P, F.lane); }
    }
}


DI void phase_quant(Frame& F) {
#ifndef REP_QUANT
#define REP_QUANT 1
#endif
#pragma nounroll
    for (int rq = 0; rq < REP_QUANT; ++rq) {
    quant_u_both(F.in[20], F.ws + WS_U8, (float*)(F.ws + WS_SU), F.ws + WS_U4, F.gw, F.NGW, F.lane);
    quant_rows_i4(F.in[21], F.ws + WS_V8, F.gw, F.NGW, F.lane);
    }
}

struct Args { const float* in[23]; float* out; unsigned char* ws; int ph_lo, ph_hi; };
static_assert(sizeof(Args) == 23 * 8 + 8 + 8 + 8, "Args has no padding");

__global__ void __launch_bounds__(NWAVES * 64, 2) mk_fwd(Args args) {
    extern __shared__ __attribute__((aligned(16))) unsigned char lds[];
    Frame F;
    F.lds = (LAS unsigned char*)lds; F.ws = args.ws; F.out = args.out;
#pragma unroll
    for (int i = 0; i < 23; ++i) F.in[i] = args.in[i];
    F.tid = threadIdx.x; F.lane = F.tid & 63; F.wave = __builtin_amdgcn_readfirstlane(F.tid >> 6);
    F.G = gridDim.x; { const int bx = blockIdx.x; F.vcu = (F.G % 8 == 0) ? (bx % 8) * (F.G / 8) + bx / 8 : bx; }
    F.gw = F.vcu * NWAVES + F.wave; F.NGW = F.G * NWAVES;
    const int lo = args.ph_lo, hi = args.ph_hi;
#ifndef REP_PHASE
#define REP_PHASE (-1)
#endif
#define IN(k) (lo <= (k) && (k) < hi)
#ifndef REP_MASK
#define REP_MASK 0
#endif
#define RP(k) _Pragma("nounroll") for (int rep_ = 0; rep_ < ((REP_PHASE == (k) || ((REP_MASK >> (k)) & 1)) ? 2 : 1); ++rep_)
    constexpr int CW_BAR = 4096;
    volatile LAS unsigned* bst = (volatile LAS unsigned*)(F.lds + LDS_BYTES - 64);
    if (F.tid < 16) bst[F.tid] = 0u;
    __syncthreads();
    XcdBarrier bar; bar.bar = (unsigned*)(F.ws + WS_CTL) + CW_BAR; bar.x = 0; bar.st = nullptr;
    if (hi - lo > 1) bar = xcd_barrier_post((unsigned*)(F.ws + WS_CTL) + CW_BAR, bst);
#define SEAM(k) do { if (IN(k) && IN((k) + 1)) { if ((k) == 0) cg::this_grid().sync(); else xcd_barrier(bar); } } while (0)

    if (IN(0)) RP(0) { phase_prologue(F); __syncthreads(); }
    SEAM(0);
    if (IN(1)) RP(1) phase_modreduce(F);
    SEAM(1);
    if (IN(2)) RP(2) phase_h1(F);
    SEAM(2);
    if (IN(3)) RP(3) {
        pg8::Gemm g{(const bf16*)(F.ws + WS_H), (const bf16*)(F.ws + WS_WIN), MTOT, NPROJ, DM / 2}; InProjOrder S; S.init(F.G, (int)blockIdx.x);
        EpiInProj E{F.ws, F.in[12], F.in[13]};
        pg8::gemm_phase<EpiInProj, InProjOrder, true, true, true>(F.lds, g, S, E);
    }
    SEAM(3);
    if (IN(4)) phase_postproj(F);
    SEAM(4);
#ifdef DN_NAIVE
    if (IN(5)) phase_dn_naive(F);
    SEAM(5);
    if (IN(6)) phase_attention(F, (char*)lds);
#else
    if (IN(5)) RP(5) phase_dn_prep(F);
    SEAM(5);
    if (IN(6)) { RP(14) { phase_dn_scan(F); __syncthreads(); } phase_attention(F, (char*)lds); }
#endif
    SEAM(6);
    if (IN(7)) phase_mergeprep(F);
    SEAM(7);
    if (IN(8)) RP(8) {
#if MERGE_F8_A || MERGE_F8_B || defined(MERGE_TWO_PASS)
        pg8::StaticOrder S; S.init(NT, DM, F.G, (int)blockIdx.x);
        { pg8::Gemm g{(const bf16*)(F.ws + (MERGE_F8_A ? WS_OATT8 : WS_QN)), (const bf16*)(F.ws + WS_WBA), NT, DM, MERGE_F8_A ? 512 : 1024};
          EpiMerge<false> E{(bf16*)(F.ws + WS_Y), (const unsigned char*)(F.ws + WS_G), 0, MERGE_F8_A ? 1.f / (255.f * WB_SCALE * OATT_SCALE) : 1.f / 255.f};
          pg8::gemm_phase<EpiMerge<false>, pg8::StaticOrder, true, true, MERGE_F8_A != 0>(F.lds, g, S, E); }
        __syncthreads();
        { pg8::Gemm g{(const bf16*)(F.ws + (MERGE_F8_B ? WS_ODNN8 : WS_Z)), (const bf16*)(F.ws + WS_WBD), NT, DM, MERGE_F8_B ? 512 : 1024};
          EpiMerge<true> E{(bf16*)(F.ws + WS_Y), (const unsigned char*)(F.ws + WS_G), 2048, MERGE_F8_B ? 1.f / (255.f * WB_SCALE * ODNN_SCALE) : 1.f / 255.f};
          pg8::gemm_phase<EpiMerge<true>, pg8::StaticOrder, true, true, MERGE_F8_B != 0>(F.lds, g, S, E); }
#else
        pg8::TwoStageOrder S; S.init(NT, DM, F.G, (int)blockIdx.x);
        pg8::Gemm g{(const bf16*)(F.ws + WS_QN), (const bf16*)(F.ws + WS_WBA), NT, DM, 1024, (const bf16*)(F.ws + WS_Z), (const bf16*)(F.ws + WS_WBD)};
        EpiMerge2 E{(bf16*)(F.ws + WS_Y), (const unsigned char*)(F.ws + WS_G)};
        pg8::gemm_phase<EpiMerge2, pg8::TwoStageOrder, true, true>(F.lds, g, S, E);
#endif
    }
    SEAM(8);
    if (IN(9)) RP(9) {
        pg8::Gemm g{(const bf16*)(F.ws + WS_Y), (const bf16*)(F.ws + WS_WOUT), NT, DM, DM}; pg8::StaticOrder S; S.init(NT, DM, F.G, (int)blockIdx.x);
        EpiResid E{F.in[0], (bf16*)(F.ws + WS_X1), (const float*)(F.ws + WS_MOD)};
        pg8::gemm_phase<EpiResid, pg8::StaticOrder, true, true>(F.lds, g, S, E);
    }
    SEAM(9);
    if (IN(10)) RP(10) phase_h2(F);
    SEAM(10);
    if (IN(11)) RP(11) {
        pg8::Gemm g{(const bf16*)(F.ws + WS_H2), (const bf16*)(F.ws + WS_WQ), NT, DM, DM}; pg8::StaticOrder S; S.init(NT, DM, F.G, (int)blockIdx.x);
        EpiPlain E{(bf16*)(F.ws + WS_PQ), 2048};
        pg8::gemm_phase<EpiPlain, pg8::StaticOrder, true, true>(F.lds, g, S, E);
    }
    SEAM(11);
    if (IN(12)) { RP(12) { phase_peer_topk(F); __syncthreads(); } phase_quant(F); }
    SEAM(12);
#ifdef GATHER_PROBE_MASK
    if (IN(13)) {
#pragma nounroll
        for (int rep_ = 0; rep_ < 2; ++rep_) { phase_peer_gather(F, rep_ == 0 ? GATHER_PROBE_MASK : 0x3fff, rep_ == 0 ? GATHER_PROBE_VMASK : 0x3fff); __syncthreads(); }
    }
#else
    if (IN(13)) RP(13) phase_peer_gather(F);
#endif
#undef IN
#undef SEAM
}

extern "C" void kernel_launch(void* const* d_in, const int* in_sizes, int n_in, void* d_out, int out_size, void* d_ws, size_t ws_size, hipStream_t stream) {
    static int grid = 0;
    if (grid == 0) {
        if (n_in != 23 || in_sizes[0] != NT * DM || out_size != NT * DM || ws_size < WS_END) {
            fprintf(stderr, "kernel_launch: unexpected shapes (n_in %d, in0 %d, out %d, ws %zu < %zu); nothing launched\n", n_in, n_in > 0 ? in_sizes[0] : -1, out_size, ws_size, (size_t)WS_END);
            grid = -1; return; }
        int dev = 0, cus = 0, per_cu = 0;
        if (hipGetDevice(&dev) != hipSuccess || hipDeviceGetAttribute(&cus, hipDeviceAttributeMultiprocessorCount, dev) != hipSuccess) { grid = -1; return; }
        if (hipFuncSetAttribute((const void*)mk_fwd, hipFuncAttributeMaxDynamicSharedMemorySize, LDS_BYTES) != hipSuccess) { fprintf(stderr, "kernel_launch: hipFuncSetAttribute failed\n"); grid = -1; return; }
        if (hipOccupancyMaxActiveBlocksPerMultiprocessor(&per_cu, (const void*)mk_fwd, NWAVES * 64, LDS_BYTES) != hipSuccess || per_cu < 1) { fprintf(stderr, "kernel_launch: occupancy query says %d blocks per CU\n", per_cu); (void)hipGetLastError(); grid = -1; return; }
        grid = cus;
    }
    if (grid < 0) return;
    (void)hipMemsetAsync((char*)d_ws + WS_CTL, 0, 1 * MiB, stream);
    Args a{};
    for (int i = 0; i < 23; ++i) a.in[i] = (const float*)d_in[i];
    a.out = (float*)d_out; a.ws = (unsigned char*)d_ws;
#if MK_N_LAUNCHES == 1
    a.ph_lo = 0; a.ph_hi = NPHASE;
    void* kargs[] = {(void*)&a};
    const hipError_t e = hipLaunchCooperativeKernel((const void*)mk_fwd, dim3(grid), dim3(NWAVES * 64), kargs, LDS_BYTES, stream);
    if (e != hipSuccess) fprintf(stderr, "kernel_launch: cooperative launch failed: %s (grid %d)\n", hipGetErrorString(e), grid);
#else
    for (int p = 0; p < NPHASE; ++p) {
        a.ph_lo = p; a.ph_hi = p + 1;
        hipLaunchKernelGGL(mk_fwd, dim3(grid), dim3(NWAVES * 64), LDS_BYTES, stream, a);
    }
    const hipError_t le = hipPeekAtLastError();
    if (le != hipSuccess) fprintf(stderr, "kernel_launch: launch failed: %s\n", hipGetErrorName(le));
#endif
}
```

```cpp
#define DN_SLEEP 0

#include <hip/hip_runtime.h>
#include <hip/hip_cooperative_groups.h>
#include <cstdio>
#include <cstdint>
namespace cg = cooperative_groups;

#ifndef MK_N_LAUNCHES
#define MK_N_LAUNCHES 1
#endif
namespace pg8 {
#define PG8_LAS __attribute__((address_space(3)))
typedef unsigned short bf16_t;
typedef short bf16x8 __attribute__((ext_vector_type(8)));
typedef float f32x4 __attribute__((ext_vector_type(4)));
typedef int pg8_v4i __attribute__((ext_vector_type(4)));
typedef int pg8_v8i __attribute__((ext_vector_type(8)));
typedef unsigned u32x4 __attribute__((ext_vector_type(4)));
constexpr int BM = 256, BK = 64, HALF = 128, HTB = HALF * BK * 2  , STAGE_BYTES = 8 * HTB, NXCD = 8, WGM = 8;

__host__ __device__ __forceinline__ int lds_byte(int r, int c) { const int st = (r >> 4) * 2 + (c >> 5), rr = r & 15, cc = c & 31, ob = rr * 64 + cc * 2; return st * 1024 + (ob ^ (((ob >> 9) & 1) << 5)); }
__host__ __device__ __forceinline__ void stage_rc(int b, int& R, int& C) { const int st = b / 1024, sb = b % 1024, swz = sb ^ (((sb >> 9) & 1) << 5); R = (st >> 1) * 16 + swz / 64; C = (st & 1) * 32 + (swz % 64) / 2; }
__host__ __device__ __forceinline__ int perm32(int rho) { const int n = rho >> 4, i = rho & 15; return 8 * (i >> 2) + 4 * n + (i & 3); }

struct Unit { int pm, pn, sel; };
struct Gemm { const bf16_t* A; const bf16_t* Bt; int M, N, K; const bf16_t* A2 = nullptr; const bf16_t* Bt2 = nullptr; };

struct StaticOrder {
    int nM, nN, nwg, G, c;
    __host__ __device__ void init(int M, int N, int G_, int c_) { nM = M / BM; nN = N / BM; nwg = nM * nN; G = G_; c = c_; }
    __host__ __device__ bool next(int i, Unit& u) const {
        const long L = (long)i * G + c; if (L >= nwg) return false;
        int wgid = (int)L; { const int q = nwg / NXCD, r = nwg % NXCD, xcd = wgid % NXCD, off = wgid / NXCD; wgid = (xcd < r ? xcd * (q + 1) : r * (q + 1) + (xcd - r) * q) + off; }
        const int nig = WGM * nN, gid = wgid / nig, fm = gid * WGM, gsz = (nM - fm) < WGM ? (nM - fm) : WGM;
        u.pm = fm + ((wgid % nig) % gsz); u.pn = (wgid % nig) / gsz; return true;
    }
    __device__ __forceinline__ void a_ready(const Unit&) const {}
    __device__ __forceinline__ void done(const Unit&) const {}
};
struct TwoStageOrder {
    StaticOrder base;
    __host__ __device__ void init(int M, int N, int G_, int c_) { base.init(M, N, G_, c_); }
    __host__ __device__ bool next(int i, Unit& u) const { if (!base.next(i >> 1, u)) return false; u.sel = i & 1; return true; }
    __device__ __forceinline__ void a_ready(const Unit&) const {}
    __device__ __forceinline__ void done(const Unit&) const {}
};

__device__ __forceinline__ unsigned cvt_pk_bf16(float lo, float hi) { unsigned r; asm volatile("v_cvt_pk_bf16_f32 %0, %1, %2" : "=v"(r) : "v"(lo), "v"(hi)); return r; }
typedef float f32x2 __attribute__((ext_vector_type(2)));
template <class Epi, class Sched, bool ALIGN_EPI = false, bool SP2 = false, bool F8 = false>
__device__ __forceinline__ void gemm_phase(PG8_LAS unsigned char* lds, const Gemm g, const Sched& S, const Epi& E) {
    const int tid = threadIdx.x, wid = __builtin_amdgcn_readfirstlane(tid >> 6), lane = tid & 63, wr = wid >> 2, wc = wid & 3, fr = lane & 15, fq = lane >> 4;
    const int K = g.K, nt = K / BK;
    unsigned voffA[2], voffB[2];
#pragma unroll
    for (int i = 0; i < 2; ++i) { int R, C; stage_rc(tid * 16 + i * 8192, R, C); const int Rb = Epi::PERM ? ((R & ~31) + perm32(R & 31)) : R;
        voffA[i] = (unsigned)(R * K + C) * 2u; voffB[i] = (unsigned)(Rb * K + C) * 2u; }
    const size_t kstep = (size_t)(BK * 2);
    const size_t hstep = (size_t)HALF * K * 2;
    const size_t tstep = 2 * hstep;
    const unsigned ldsw = (unsigned)wid * 1024u;
    const int aoff = lds_byte(wr * 64 + fr, fq * 8), boff = lds_byte(wc * 32 + fr, fq * 8);
#define PG8_SA(b, h) (((b) * 2 + (h)) * HTB)
#define PG8_SB(b, h) ((4 + (b) * 2 + (h)) * HTB)
#define PG8_STAGE(bufoff, gbase, voff) do { _Pragma("unroll") for (int _i = 0; _i < 2; ++_i) \
        __builtin_amdgcn_global_load_lds((const unsigned*)((const char*)(gbase) + (voff)[_i]), (PG8_LAS unsigned*)(lds + (bufoff) + ldsw + _i * 8192), 16, 0, 0); } while (0)
#define PG8_LDA(dst, b, h) do { _Pragma("unroll") for (int m = 0; m < 4; ++m) { \
        if constexpr (F8) { const pg8_v4i t0_ = *(const PG8_LAS pg8_v4i*)(lds + PG8_SA(b, h) + aoff + m * 2048), t1_ = *(const PG8_LAS pg8_v4i*)(lds + PG8_SA(b, h) + aoff + m * 2048 + 1024); \
            dst##8[m] = __builtin_shufflevector(t0_, t1_, 0, 1, 2, 3, 4, 5, 6, 7); } \
        else { _Pragma("unroll") for (int k = 0; k < 2; ++k) dst[m][k] = *(const PG8_LAS bf16x8*)(lds + PG8_SA(b, h) + aoff + m * 2048 + k * 1024); } } } while (0)
#define PG8_LDB(dst, b, h) do { _Pragma("unroll") for (int n = 0; n < 2; ++n) { \
        if constexpr (F8) { const pg8_v4i t0_ = *(const PG8_LAS pg8_v4i*)(lds + PG8_SB(b, h) + boff + n * 2048), t1_ = *(const PG8_LAS pg8_v4i*)(lds + PG8_SB(b, h) + boff + n * 2048 + 1024); \
            dst##8[n] = __builtin_shufflevector(t0_, t1_, 0, 1, 2, 3, 4, 5, 6, 7); } \
        else { _Pragma("unroll") for (int k = 0; k < 2; ++k) dst[n][k] = *(const PG8_LAS bf16x8*)(lds + PG8_SB(b, h) + boff + n * 2048 + k * 1024); } } } while (0)
#define PG8_MMA(ai, bj, At, Bt) do { __builtin_amdgcn_s_setprio(1); _Pragma("unroll") for (int m = 0; m < 4; ++m) _Pragma("unroll") for (int n = 0; n < 2; ++n) { \
        if constexpr (F8) { asm volatile("v_mfma_scale_f32_16x16x128_f8f6f4 %0, %1, %2, %0, %3, %3 op_sel_hi:[0,0,0]" : "+v"(acc[ai][bj][m][n]) : "v"(Bt##8[n]), "v"(At##8[m]), "v"(0x7F7F7F7F)); } \
        else { _Pragma("unroll") for (int k = 0; k < 2; ++k) acc[ai][bj][m][n] = __builtin_amdgcn_mfma_f32_16x16x32_bf16(Bt[n][k], At[m][k], acc[ai][bj][m][n], 0, 0, 0); } } \
        __builtin_amdgcn_s_setprio(0); } while (0)
#define PG8_WAIT_V(n) asm volatile("s_waitcnt vmcnt(" #n ")" ::: "memory")
#define PG8_WAIT_L(n) asm volatile("s_waitcnt lgkmcnt(" #n ")" ::: "memory")
#define PG8_BAR __builtin_amdgcn_s_barrier()
#define PG8_SCHED __builtin_amdgcn_sched_barrier(0)
    Unit cur, nxt; int ui = 0;
    if (!S.next(0, cur)) return;
    f32x4 acc[2][2][4][2];
#pragma unroll
    for (int a = 0; a < 2; ++a)
#pragma unroll
        for (int b = 0; b < 2; ++b)
#pragma unroll
            for (int m = 0; m < 4; ++m)
#pragma unroll
                for (int n = 0; n < 2; ++n) acc[a][b][m][n] = (f32x4){0.f, 0.f, 0.f, 0.f};
    bf16x8 At[4][2], B0[2][2], B1[2][2];
    pg8_v8i At8[4], B08[2], B18[2];
    const char* cA = (const char*)g.A + (size_t)cur.pm * tstep; const char* cB = (const char*)g.Bt + (size_t)cur.pn * tstep;
    S.a_ready(cur);
    if constexpr (SP2) {
        PG8_STAGE(PG8_SB(0, 0), cB, voffB); PG8_STAGE(PG8_SB(0, 1), cB + hstep, voffB); PG8_STAGE(PG8_SA(0, 0), cA, voffA); PG8_STAGE(PG8_SA(0, 1), cA + hstep, voffA);
        if (wr == 1) PG8_BAR;
        PG8_WAIT_V(2); PG8_BAR;
        PG8_STAGE(PG8_SB(1, 0), cB + kstep, voffB); PG8_STAGE(PG8_SA(1, 0), cA + kstep, voffA); PG8_STAGE(PG8_SB(1, 1), cB + hstep + kstep, voffB);
        PG8_WAIT_V(6); PG8_BAR;
    } else {
        PG8_STAGE(PG8_SB(0, 0), cB, voffB); PG8_STAGE(PG8_SA(0, 0), cA, voffA); PG8_STAGE(PG8_SB(0, 1), cB + hstep, voffB); PG8_STAGE(PG8_SA(0, 1), cA + hstep, voffA);
        if (wr == 1) PG8_BAR;
        PG8_WAIT_V(4); PG8_BAR;
        PG8_STAGE(PG8_SB(1, 0), cB + kstep, voffB); PG8_STAGE(PG8_SA(1, 0), cA + kstep, voffA); PG8_STAGE(PG8_SB(1, 1), cB + hstep + kstep, voffB);
        PG8_WAIT_V(6); PG8_BAR;
    }
    for (;;) {
        const bool has_next = S.next(ui + 1, nxt);
        const bf16_t* gA = g.A; const bf16_t* gB = g.Bt;
        if constexpr (Epi::TWO_STAGE) { if (has_next && nxt.sel) { gA = g.A2; gB = g.Bt2; } }
        const char* nA = has_next ? (const char*)gA + (size_t)nxt.pm * tstep : cA; const char* nB = has_next ? (const char*)gB + (size_t)nxt.pn * tstep : cB;
        for (int t = 0; t < nt; t += 2) {
            const bool last = (t == nt - 2);
            const char* a1 = cA + (size_t)(t + 1) * kstep;
            const char* a2 = last ? nA : cA + (size_t)(t + 2) * kstep; const char* b2 = last ? nB : cB + (size_t)(t + 2) * kstep;
            const char* a3 = a2 + kstep; const char* b3 = b2 + kstep;
            if (last && has_next) S.a_ready(nxt);
            if constexpr (SP2) {
            PG8_LDB(B0, 0, 0); PG8_LDB(B1, 0, 1); PG8_SCHED; PG8_LDA(At, 0, 0); PG8_STAGE(PG8_SA(1, 1), a1 + hstep, voffA);
            PG8_WAIT_V(8); PG8_WAIT_L(0); PG8_BAR; PG8_MMA(0, 0, At, B0); PG8_MMA(0, 1, At, B1); PG8_BAR; PG8_SCHED;
            PG8_LDA(At, 0, 1); PG8_STAGE(PG8_SB(0, 0), b2, voffB); PG8_STAGE(PG8_SB(0, 1), b2 + hstep, voffB); PG8_STAGE(PG8_SA(0, 0), a2, voffA);
            PG8_WAIT_V(8); PG8_WAIT_L(0); PG8_BAR; PG8_MMA(1, 0, At, B0); PG8_MMA(1, 1, At, B1); PG8_BAR; PG8_SCHED;
            PG8_LDB(B0, 1, 0); PG8_LDB(B1, 1, 1); PG8_SCHED; PG8_LDA(At, 1, 0); PG8_STAGE(PG8_SA(0, 1), a2 + hstep, voffA);
            PG8_WAIT_V(8); PG8_WAIT_L(0); PG8_BAR; PG8_MMA(0, 0, At, B0); PG8_MMA(0, 1, At, B1); PG8_BAR; PG8_SCHED;
            PG8_LDA(At, 1, 1); PG8_STAGE(PG8_SB(1, 0), b3, voffB); PG8_STAGE(PG8_SB(1, 1), b3 + hstep, voffB); PG8_STAGE(PG8_SA(1, 0), a3, voffA);
            PG8_WAIT_V(8); PG8_WAIT_L(0); PG8_BAR; PG8_MMA(1, 0, At, B0); PG8_MMA(1, 1, At, B1); PG8_BAR; PG8_SCHED;
            } else {
            PG8_LDB(B0, 0, 0); PG8_SCHED; PG8_LDA(At, 0, 0); PG8_STAGE(PG8_SA(1, 1), a1 + hstep, voffA);
            PG8_WAIT_L(8); PG8_BAR; PG8_WAIT_L(0); PG8_MMA(0, 0, At, B0); PG8_BAR; PG8_SCHED;
            PG8_LDB(B1, 0, 1); PG8_STAGE(PG8_SB(0, 0), b2, voffB);
            PG8_BAR; PG8_WAIT_L(0); PG8_MMA(0, 1, At, B1); PG8_BAR;
            PG8_LDA(At, 0, 1); PG8_STAGE(PG8_SA(0, 0), a2, voffA);
            PG8_BAR; PG8_WAIT_L(0); PG8_MMA(1, 0, At, B0); PG8_BAR; PG8_SCHED;
            PG8_STAGE(PG8_SB(0, 1), b2 + hstep, voffB);
            PG8_WAIT_V(6); PG8_BAR; PG8_MMA(1, 1, At, B1); PG8_BAR;
            PG8_LDB(B0, 1, 0); PG8_SCHED; PG8_LDA(At, 1, 0); PG8_STAGE(PG8_SA(0, 1), a2 + hstep, voffA);
            PG8_WAIT_L(8); PG8_BAR; PG8_WAIT_L(0); PG8_MMA(0, 0, At, B0); PG8_BAR; PG8_SCHED;
            PG8_LDB(B1, 1, 1); PG8_STAGE(PG8_SB(1, 0), b3, voffB);
            PG8_BAR; PG8_WAIT_L(0); PG8_MMA(0, 1, At, B1); PG8_BAR;
            PG8_LDA(At, 1, 1); PG8_STAGE(PG8_SA(1, 0), a3, voffA);
            PG8_BAR; PG8_WAIT_L(0); PG8_MMA(1, 0, At, B0); PG8_BAR; PG8_SCHED;
            PG8_STAGE(PG8_SB(1, 1), b3 + hstep, voffB);
            PG8_WAIT_V(6); PG8_BAR; PG8_MMA(1, 1, At, B1); PG8_BAR;
            }
        }
        if constexpr (ALIGN_EPI) { if (wr == 0) PG8_BAR; }
        bool keep = false;
        if constexpr (Epi::TWO_STAGE) keep = (cur.sel == 0);
        if constexpr (!Epi::AFTER_DRAIN) {
            if constexpr (Epi::TWO_STAGE) { if (keep) E.mid(acc, cur, wr, wc, fr, fq); else E(acc, cur, wr, wc, fr, fq); }
            else E(acc, cur, wr, wc, fr, fq);
            S.done(cur); }
        if (!has_next) break;
        if (!keep)
#pragma unroll
        for (int a = 0; a < 2; ++a)
#pragma unroll
            for (int b = 0; b < 2; ++b)
#pragma unroll
                for (int m = 0; m < 4; ++m)
#pragma unroll
                    for (int n = 0; n < 2; ++n) acc[a][b][m][n] = (f32x4){0.f, 0.f, 0.f, 0.f};
        cur = nxt; cA = nA; cB = nB; ++ui;
        if constexpr (ALIGN_EPI) { if (wr == 1) PG8_BAR; }
    }
    PG8_WAIT_V(0);
    if constexpr (!ALIGN_EPI) { if (wr == 0) PG8_BAR; }
    PG8_BAR;
    if constexpr (Epi::AFTER_DRAIN) { E.fused(acc, cur, wr, wc, fr, fq, lds, wid, lane); S.done(cur); }
#undef PG8_SA
#undef PG8_SB
#undef PG8_STAGE
#undef PG8_LDA
#undef PG8_LDB
#undef PG8_MMA
#undef PG8_WAIT_V
#undef PG8_WAIT_L
#undef PG8_BAR
#undef PG8_SCHED
}
}
namespace attn {
using bf16 = unsigned short;
constexpr int D = 128, NW = 8, QBLK = 32, KVBLK = 64;
constexpr float SCALE = 0.088388347648318440f;
constexpr float THR = 8.f;
constexpr int SDEPTH = 2;
constexpr int LDQ = 1024, LDK = 256, LDO = 1024;
constexpr size_t SHM_V = KVBLK * D * 2, SHM_K = KVBLK * D * 2, SHM_ATTN = 2 * SHM_V + 2 * SHM_K + NW * 64 * 4;
__device__ __forceinline__ unsigned short f2bf_rne(float f) { unsigned u = __float_as_uint(f); return (unsigned short)((u + 0x7fffu + ((u >> 16) & 1u)) >> 16); }
using bf16x8 = __attribute__((ext_vector_type(8))) short;
using s16x4  = __attribute__((ext_vector_type(4))) short;
using f32x16 = __attribute__((ext_vector_type(16))) float;
using f32x8  = __attribute__((ext_vector_type(8))) float;
using u32x4  = __attribute__((ext_vector_type(4))) unsigned;
#define KSWZ(row, colB) ((row) * 256 + ((colB) ^ (((row) & 7) << 4)))
#define SBAR() __builtin_amdgcn_sched_barrier(0)
__device__ __forceinline__ int crow(int r, int hi) { return (r & 3) + 8 * (r >> 2) + 4 * hi; }
__device__ __forceinline__ unsigned cvtpk(float lo, float hi) {
  unsigned r; asm volatile("v_cvt_pk_bf16_f32 %0, %1, %2" : "=v"(r) : "v"(lo), "v"(hi)); return r;
}
template <typename TIn> struct Stage;
template <> struct Stage<bf16>  { using T = bf16x8;
  __device__ static __forceinline__ T ld8(const bf16* p) { return *reinterpret_cast<const bf16x8*>(p); }
  __device__ static __forceinline__ bf16x8 tobf(T x) { return x; } };
template <> struct Stage<float> { using T = f32x8;
  __device__ static __forceinline__ T ld8(const float* p) { return *reinterpret_cast<const f32x8*>(p); }
  __device__ static __forceinline__ bf16x8 tobf(T x) {
    u32x4 w = {cvtpk(x[0], x[1]), cvtpk(x[2], x[3]), cvtpk(x[4], x[5]), cvtpk(x[6], x[7])}; return *reinterpret_cast<bf16x8*>(&w); } };

__device__ __forceinline__ void partialSM(f32x16& p0, f32x16& p1, float& m_reg, float& mn, float& alpha) {
  constexpr float C = SCALE * 1.4426950408889634f;
  float pmax = p0[0]; for (int r = 1; r < 16; ++r) pmax = fmaxf(pmax, p0[r]); for (int r = 0; r < 16; ++r) pmax = fmaxf(pmax, p1[r]);
  { auto rr = __builtin_amdgcn_permlane32_swap(__float_as_uint(pmax), __float_as_uint(pmax), false, false);
    pmax = fmaxf(__uint_as_float(rr[0]), __uint_as_float(rr[1])); }
  if (__builtin_expect(__all(pmax - m_reg <= THR / SCALE), 1)) { mn = m_reg; alpha = 1.f; }
  else { mn = fmaxf(m_reg, pmax); alpha = __builtin_amdgcn_exp2f((m_reg - mn) * C); m_reg = mn; }
  float mnC = -mn * C;
  for (int r = 0; r < 16; ++r) p0[r] = fmaf(p0[r], C, mnC); for (int r = 0; r < 16; ++r) p1[r] = fmaf(p1[r], C, mnC);
  for (int r = 0; r < 16; ++r) p0[r] = __builtin_amdgcn_exp2f(p0[r]);
}
__device__ __forceinline__ void finishSM(f32x16& p0, f32x16& p1, float alpha, float& l_reg, bf16x8& pa0, bf16x8& pa1, bf16x8& pa2, bf16x8& pa3) {
  for (int r = 0; r < 16; ++r) p1[r] = __builtin_amdgcn_exp2f(p1[r]);
  float ps = 0; for (int r = 0; r < 16; ++r) ps += p0[r]; for (int r = 0; r < 16; ++r) ps += p1[r];
  { auto rr = __builtin_amdgcn_permlane32_swap(__float_as_uint(ps), __float_as_uint(ps), false, false);
    ps = __uint_as_float(rr[0]) + __uint_as_float(rr[1]); }
  l_reg = l_reg * alpha + ps;
#define PK4(P, BASE, OUT) do { unsigned a0 = cvtpk(P[BASE + 0], P[BASE + 1]), a1 = cvtpk(P[BASE + 2], P[BASE + 3]);   \
    unsigned b0 = cvtpk(P[BASE + 4], P[BASE + 5]), b1 = cvtpk(P[BASE + 6], P[BASE + 7]);                              \
    auto r0 = __builtin_amdgcn_permlane32_swap(a0, b0, false, false); auto r1 = __builtin_amdgcn_permlane32_swap(a1, b1, false, false); \
    u32x4 w = {r0[0], r1[0], r0[1], r1[1]}; OUT = *reinterpret_cast<bf16x8*>(&w); } while (0)
  PK4(p0, 0, pa0); PK4(p0, 8, pa1); PK4(p1, 0, pa2); PK4(p1, 8, pa3);
#undef PK4
}
__device__ __forceinline__ void qkt(f32x16& p0, f32x16& p1, const bf16* Ks, const bf16x8* qr, int r32, int hi) {
  p0 = f32x16{}; p1 = f32x16{};
  for (int d0 = 0; d0 < 8; ++d0) { int cb = (d0 * 16 + hi * 8) * 2;
    bf16x8 b0 = *reinterpret_cast<const bf16x8*>((const char*)Ks + KSWZ(r32, cb));
    bf16x8 b1 = *reinterpret_cast<const bf16x8*>((const char*)Ks + KSWZ(32 + r32, cb));
    p0 = __builtin_amdgcn_mfma_f32_32x32x16_bf16(b0, qr[d0], p0, 0, 0, 0);
    p1 = __builtin_amdgcn_mfma_f32_32x32x16_bf16(b1, qr[d0], p1, 0, 0, 0); }
}
__device__ __forceinline__ int v_st(int k, int c) { const int kk = (k & ~0xC) | ((k & 4) << 1) | ((k & 8) >> 1); return ((kk >> 3) * 4 + (c >> 5)) * 512 + ((kk & 7) * 32 + (c & 31)) * 2; }
__device__ __forceinline__ int v_rd_base(int lane) { return ((lane & 3) << 3) | (((lane >> 2) & 3) << 6) | (((lane >> 4) & 1) << 5) | (((lane >> 5) & 1) << 8); }
constexpr int v_rd_off(int d0, int ks, int half) { return d0 * 512 + ks * 4096 + half * 2048; }
template <int OFF> __device__ __forceinline__ s16x4 tr_read(int vb) {
  s16x4 r; asm volatile("ds_read_b64_tr_b16 %0, %1 offset:%2" : "=&v"(r) : "v"(vb), "i"(OFF) : "memory"); return r;
}
template <int D0> __device__ __forceinline__ void pv_one(f32x16& od, int vb, bf16x8 pa0, bf16x8 pa1, bf16x8 pa2, bf16x8 pa3) {
  const s16x4 l0 = tr_read<v_rd_off(D0, 0, 0)>(vb), h0 = tr_read<v_rd_off(D0, 0, 1)>(vb), l1 = tr_read<v_rd_off(D0, 1, 0)>(vb), h1 = tr_read<v_rd_off(D0, 1, 1)>(vb);
  const s16x4 l2 = tr_read<v_rd_off(D0, 2, 0)>(vb), h2 = tr_read<v_rd_off(D0, 2, 1)>(vb), l3 = tr_read<v_rd_off(D0, 3, 0)>(vb), h3 = tr_read<v_rd_off(D0, 3, 1)>(vb);
  asm volatile("s_waitcnt lgkmcnt(0)" ::: "memory"); SBAR();
#define PK(L, H) (bf16x8){L[0], L[1], L[2], L[3], H[0], H[1], H[2], H[3]}
  od = __builtin_amdgcn_mfma_f32_32x32x16_bf16(pa0, PK(l0, h0), od, 0, 0, 0);
  od = __builtin_amdgcn_mfma_f32_32x32x16_bf16(pa1, PK(l1, h1), od, 0, 0, 0);
  od = __builtin_amdgcn_mfma_f32_32x32x16_bf16(pa2, PK(l2, h2), od, 0, 0, 0);
  od = __builtin_amdgcn_mfma_f32_32x32x16_bf16(pa3, PK(l3, h3), od, 0, 0, 0);
#undef PK
}
__device__ __forceinline__ void pv_d0(f32x16* o, int vb, bf16x8 pa0, bf16x8 pa1, bf16x8 pa2, bf16x8 pa3) {
  pv_one<0>(o[0], vb, pa0, pa1, pa2, pa3); pv_one<1>(o[1], vb, pa0, pa1, pa2, pa3); pv_one<2>(o[2], vb, pa0, pa1, pa2, pa3); pv_one<3>(o[3], vb, pa0, pa1, pa2, pa3);
}

template <typename TQ>
__device__ __forceinline__ void attn_dense_body(const TQ* __restrict__ Qb, const bf16* __restrict__ Kh, const bf16* __restrict__ Vh,
                                                bf16* __restrict__ Ob, int seq, char* lds) {
  using St = Stage<bf16>; using SQ = Stage<TQ>;
  const int tid = threadIdx.x, wid = tid >> 6, lane = tid & 63, r32 = lane & 31, hi = lane >> 5;
  bf16* V_lds = (bf16*)lds; bf16* K_lds = (bf16*)(lds + 2 * SHM_V);
  float* ws = (float*)(lds + 2 * SHM_V + 2 * SHM_K) + wid * 64; float* li_l = ws; float* al_l = ws + 32;
  float m_reg = -1e30f, l_reg = 0; f32x16 o[4] = {}; bf16x8 qr[8];
  const TQ* Qw = Qb + (long)(wid * QBLK + r32) * LDQ + hi * 8;
#pragma unroll
  for (int d0 = 0; d0 < 8; ++d0) qr[d0] = SQ::tobf(SQ::ld8(Qw + d0 * 16));
  const int sr = tid >> 4, sc = (tid & 15) * 8, vst0 = v_st(sr, sc), vst1 = v_st(32 + sr, sc);
  const int vb0 = (int)(uintptr_t)V_lds + v_rd_base(lane);
  struct { typename St::T vs0, vs1, ks0, ks1; } sr_[SDEPTH];
#define SLOAD(i, k0) do { sr_[i].vs0 = St::ld8(&Vh[(long)((k0) + sr) * LDK + sc]); sr_[i].vs1 = St::ld8(&Vh[(long)((k0) + 32 + sr) * LDK + sc]); \
    sr_[i].ks0 = St::ld8(&Kh[(long)((k0) + sr) * LDK + sc]); sr_[i].ks1 = St::ld8(&Kh[(long)((k0) + 32 + sr) * LDK + sc]); } while (0)
#define SWRITE(b, i) do { *(bf16x8*)((char*)V_lds + (b) * SHM_V + vst0) = St::tobf(sr_[i].vs0);          \
    *(bf16x8*)((char*)V_lds + (b) * SHM_V + vst1) = St::tobf(sr_[i].vs1); int kc = sc * 2;               \
    *(bf16x8*)((char*)K_lds + (b) * SHM_K + KSWZ(sr, kc)) = St::tobf(sr_[i].ks0);                       \
    *(bf16x8*)((char*)K_lds + (b) * SHM_K + KSWZ(32 + sr, kc)) = St::tobf(sr_[i].ks1); } while (0)
#define SWAIT() do { if constexpr (SDEPTH == 2) asm volatile("s_waitcnt vmcnt(4)" ::: "memory"); else asm volatile("s_waitcnt vmcnt(0)" ::: "memory"); } while (0)
#define RESC(a) do { if (__any((a) < 1.f)) { if (hi == 0) al_l[r32] = (a); asm volatile("s_waitcnt lgkmcnt(0)" ::: "memory"); \
    for (int d = 0; d < 4; ++d) for (int r = 0; r < 16; ++r) o[d][r] *= al_l[crow(r, hi)]; } } while (0)
  f32x16 pA0, pA1, pB0, pB1; float mnA, mnB, alA, alB; bf16x8 pa0, pa1, pa2, pa3; const int NT = seq / KVBLK;
  constexpr int SE = 0, SO = SDEPTH - 1;
  SLOAD(SE, 0); asm volatile("s_waitcnt vmcnt(0)" ::: "memory"); SWRITE(0, SE); __syncthreads();
  qkt(pA0, pA1, K_lds, qr, r32, hi); partialSM(pA0, pA1, m_reg, mnA, alA);
  SLOAD(SO, KVBLK); if constexpr (SDEPTH == 2) { if (2 < NT) SLOAD(SE, 2 * KVBLK); }
  SWAIT(); SWRITE(1, SO); __syncthreads();
  for (int j = 1; j + 1 < NT; j += 2) {
    SBAR(); qkt(pB0, pB1, (bf16*)((char*)K_lds + SHM_K), qr, r32, hi);
    finishSM(pA0, pA1, alA, l_reg, pa0, pa1, pa2, pa3); SBAR();
    SLOAD(SO, (j + SDEPTH) * KVBLK); SBAR();
    pv_d0(o, vb0, pa0, pa1, pa2, pa3); partialSM(pB0, pB1, m_reg, mnB, alB);
    __syncthreads(); SWAIT(); SWRITE(0, SE);
    RESC(alB); __syncthreads();
    SBAR(); qkt(pA0, pA1, K_lds, qr, r32, hi);
    finishSM(pB0, pB1, alB, l_reg, pa0, pa1, pa2, pa3); SBAR();
    if (SDEPTH == 1 || j + 3 < NT) SLOAD(SE, (j + 1 + SDEPTH) * KVBLK); SBAR();
    pv_d0(o, vb0 + (int)SHM_V, pa0, pa1, pa2, pa3); partialSM(pA0, pA1, m_reg, mnA, alA);
    __syncthreads(); SWAIT(); SWRITE(1, SO);
    RESC(alA); __syncthreads();
  }
  SBAR(); qkt(pB0, pB1, (bf16*)((char*)K_lds + SHM_K), qr, r32, hi);
  finishSM(pA0, pA1, alA, l_reg, pa0, pa1, pa2, pa3); SBAR();
  pv_d0(o, vb0, pa0, pa1, pa2, pa3); partialSM(pB0, pB1, m_reg, mnB, alB);
  __syncthreads(); RESC(alB);
  finishSM(pB0, pB1, alB, l_reg, pa0, pa1, pa2, pa3); SBAR();
  pv_d0(o, vb0 + (int)SHM_V, pa0, pa1, pa2, pa3);
  if (hi == 0) li_l[r32] = l_reg; asm volatile("s_waitcnt lgkmcnt(0)" ::: "memory");
  float rli[16];
#pragma unroll
  for (int r = 0; r < 16; ++r) rli[r] = __builtin_amdgcn_rcpf(li_l[crow(r, hi)]);
  bf16* Ow = Ob + (long)(wid * QBLK) * LDO;
#pragma unroll
  for (int r = 0; r < 16; ++r) { int orow = crow(r, hi);
    for (int d0 = 0; d0 < 4; ++d0) Ow[(long)orow * LDO + d0 * 32 + r32] = f2bf_rne(o[d0][r] * rli[r]); }
#undef SLOAD
#undef SWRITE
#undef SWAIT
#undef RESC
}
#undef KSWZ
#undef SBAR
}

constexpr int DM = 2048, NB = 4, TS = 4096, NT = NB * TS, CL = 256, NC = NB * CL, MTOT = NT + NC, LKV = TS + CL;
constexpr int NPROJ = 9984;
constexpr int INW = 9760;
constexpr int NEXP = 16384;
constexpr float EPS = 1e-6f;
constexpr int NWAVES = 8;
constexpr int NPHASE = 14;

constexpr size_t MiB = 1u << 20;
constexpr size_t WS_CTL = 0, WS_MOD = 1 * MiB, WS_MODP = 2 * MiB, WS_SUBK = 10 * MiB, WS_WBA = 11 * MiB, WS_WBD = 15 * MiB, WS_WOUT = 19 * MiB, WS_WQ = 27 * MiB;
constexpr size_t WS_BETA = 35 * MiB, WS_LOGA = 37 * MiB, WS_EXPI = 39 * MiB, WS_EXPG = 47 * MiB;
constexpr size_t WS_A = 56 * MiB;
constexpr size_t WS_WIN = WS_A, WS_H = WS_A + 39 * MiB;
constexpr size_t WS_DQ = WS_A, WS_DK = WS_A + 34 * MiB, WS_DV = WS_A + 68 * MiB;
constexpr size_t WS_Y = WS_A, WS_H2 = WS_A;
constexpr size_t WS_B = 164 * MiB;
constexpr size_t WS_QN = WS_B, WS_Z = WS_B + 32 * MiB, WS_PQ = WS_B;
constexpr size_t WS_KB = 228 * MiB, WS_VB = 237 * MiB;
constexpr size_t WS_C = 246 * MiB;
constexpr size_t WS_DNRAW = WS_C, WS_U8 = WS_C, WS_V8 = WS_C + 32 * MiB, WS_SU = WS_C + 64 * MiB, WS_SV = WS_C + 65 * MiB, WS_U4 = WS_C + 66 * MiB;
constexpr size_t WS_KT = WS_C, WS_TINV = WS_C + 34 * MiB, WS_QKO = WS_C + 68 * MiB, WS_VEC = WS_C + 102 * MiB;
constexpr size_t WS_D = 374 * MiB;
constexpr size_t WS_G = WS_D, WS_X1 = WS_D;
constexpr size_t WS_OATT8 = WS_D + 64 * MiB, WS_ODNN8 = WS_D + 80 * MiB;
#ifndef MERGE_F8_A
#define MERGE_F8_A 0
#endif
#ifndef MERGE_F8_B
#define MERGE_F8_B 0
#endif
constexpr float WB_SCALE = 64.f, OATT_SCALE = 16.f, ODNN_SCALE = 2.f;
constexpr size_t WS_ODN = 502 * MiB;
constexpr size_t WS_END = 566 * MiB;
static_assert((size_t)NPROJ * DM * 2 <= 39 * MiB && (size_t)MTOT * DM * 2 <= 69 * MiB && (size_t)MTOT * 1024 * 2 <= 34 * MiB && (size_t)MTOT * 3072 * 2 <= 128 * MiB, "ws map");
static_assert((size_t)NB * LKV * 256 * 2 <= 9 * MiB && (size_t)NT * 4096 * 2 <= 128 * MiB && (size_t)NEXP * DM * 2 <= 64 * MiB, "ws map");

constexpr int LDS_BYTES = 163840;

#define DI __device__ __forceinline__
#define LAS __attribute__((address_space(3)))
typedef unsigned short bf16;
typedef float f32x4 __attribute__((ext_vector_type(4)));
typedef float f32x2 __attribute__((ext_vector_type(2)));
typedef unsigned u32x4 __attribute__((ext_vector_type(4)));
typedef unsigned u32x2 __attribute__((ext_vector_type(2)));

typedef __bf16 bf16x2_n __attribute__((ext_vector_type(2)));
DI unsigned pk2(float lo, float hi) { const f32x2 v = {lo, hi}; return __builtin_bit_cast(unsigned, __builtin_convertvector(v, bf16x2_n)); }
DI unsigned f2bf(float f) { return pk2(f, f) & 0xffffu; }
DI float bflo(unsigned w) { return __uint_as_float(w << 16); }
DI float bfhi(unsigned w) { return __uint_as_float(w & 0xffff0000u); }
DI float bf2f(bf16 h) { return __uint_as_float((unsigned)h << 16); }
DI float wave_sum(float v) {
#pragma unroll
    for (int o = 1; o < 64; o <<= 1) v += __shfl_xor(v, o);
    return v;
}
DI unsigned wave_max_u32(unsigned v) {
#pragma unroll
    for (int o = 1; o < 64; o <<= 1) { const unsigned t = (unsigned)__shfl_xor((int)v, o); v = t > v ? t : v; }
    return v;
}
DI float sigm(float x) { return __builtin_amdgcn_rcpf(1.f + __expf(-x)); }
DI float silu(float x) { return x * __builtin_amdgcn_rcpf(1.f + __expf(-x)); }
DI float softplus(float x) { return x > 20.f ? x : log1pf(__expf(x)); }
DI float gelu_erf(float v) {
    const float av = fabsf(v), t = __builtin_amdgcn_rcpf(av * 0.2316418882f + 1.0f);
    float q = t * 0.5307027145f + (-0.7265760135f); q = q * t + 0.7107068705f; q = q * t + (-0.142248368f); q = q * t + 0.127414796f; q = q * t;
    const float e = __builtin_amdgcn_exp2f((v * v) * (-0.72134752044f));
    const float mm = v * (q * e);
    return v < 0.f ? mm : v - mm;
}
DI unsigned okey(float f) { const unsigned u = __float_as_uint(f); return (u & 0x80000000u) ? ~u : (u | 0x80000000u); }
DI unsigned rdlane(unsigned v, int l) { return (unsigned)__builtin_amdgcn_readlane((int)v, l); }
DI float rdlanef(float v, int l) { return __uint_as_float((unsigned)__builtin_amdgcn_readlane((int)__float_as_uint(v), l)); }

#define XB_TMO      128
#define XB_XCNT(j)  (256  + 64 * (j))
#define XB_XSUB(j)  (1280 + 64 * (j))
#define XB_XGEN(j)  (2304 + 64 * (j))
#define XB_TOP      3328
#define XB_TOPGEN   3392
#define XCD_BAR_WORDS 3456
#define XB_SPIN_CAP (1u << 18)

__device__ __forceinline__ unsigned xb_ld(unsigned* p)              { return __hip_atomic_load(p, __ATOMIC_RELAXED, __HIP_MEMORY_SCOPE_AGENT); }
__device__ __forceinline__ unsigned xb_add(unsigned* p, unsigned v) { return __hip_atomic_fetch_add(p, v, __ATOMIC_RELAXED, __HIP_MEMORY_SCOPE_AGENT); }
__device__ __forceinline__ unsigned xb_xcc_id() { return (unsigned)__builtin_amdgcn_s_getreg((3 << 11) | 20) & 0xFu; }
#define XB_SPIN(cond, bar) do { unsigned _sp = 0; while (cond) { __builtin_amdgcn_s_sleep(1); \
    if ((++_sp & 255u) == 0u) { if (xb_ld(&(bar)[XB_TMO])) break; if (_sp > XB_SPIN_CAP) { atomicAdd(&(bar)[XB_TMO], 1u); break; } } } } while (0)

struct XcdBarrier {
    unsigned* bar; unsigned x;
    volatile LAS unsigned* st;
};

__device__ __forceinline__ XcdBarrier xcd_barrier_post(unsigned* bar, volatile LAS unsigned* st) {
    XcdBarrier b; b.bar = bar; b.x = xb_xcc_id(); b.st = st;
    if (threadIdx.x == 0) (void)xb_add(&bar[XB_XCNT(b.x)], 1u);
    return b;
}
__device__ __forceinline__ void xcd_barrier_complete(unsigned* bar, unsigned x, unsigned& nloc, unsigned& nx) {
    const unsigned G = gridDim.x * gridDim.y * gridDim.z;
    unsigned sum, cnt, mine, sp = 0u;
    for (;;) {
        sum = 0u; cnt = 0u; mine = 0u;
#pragma unroll
        for (unsigned j = 0; j < 16; ++j) { const unsigned c = xb_ld(&bar[XB_XCNT(j)]); sum += c; cnt += (c > 0u) ? 1u : 0u; mine = (j == x) ? c : mine; }
        if (sum == G) break;
        __builtin_amdgcn_s_sleep(1);
        if ((++sp & 255u) == 0u) { if (xb_ld(&bar[XB_TMO])) break; if (sp > XB_SPIN_CAP) { atomicAdd(&bar[XB_TMO], 1u); break; } }
    }
    nloc = mine > 0u ? mine : 1u; nx = cnt > 0u ? cnt : 1u;
}

__device__ __forceinline__ void xcd_barrier(const XcdBarrier& b) {
    asm volatile("s_waitcnt vmcnt(0)" ::: "memory");
    __syncthreads();
    if (threadIdx.x == 0) {
        unsigned* bar = b.bar;
        __builtin_amdgcn_s_waitcnt(0);
        unsigned nloc = b.st[0], nx = b.st[1];
        if (nloc == 0u) { xcd_barrier_complete(bar, b.x, nloc, nx); b.st[0] = nloc; b.st[1] = nx; }
        const unsigned old = xb_add(&bar[XB_XSUB(b.x)], 1u);
        const unsigned gen = old / nloc;
        if (old + 1u == (gen + 1u) * nloc) {
            __builtin_amdgcn_fence(__ATOMIC_RELEASE, "agent");
            asm volatile("s_waitcnt vmcnt(0)" ::: "memory");
            const unsigned og = xb_add(&bar[XB_TOP], 1u);
            const unsigned tg = og / nx;
            if (og + 1u == (tg + 1u) * nx) xb_add(&bar[XB_TOPGEN], 1u);
            else XB_SPIN(xb_ld(&bar[XB_TOPGEN]) == tg, bar);
            __builtin_amdgcn_fence(__ATOMIC_ACQUIRE, "agent");
            xb_add(&bar[XB_XGEN(b.x)], 1u);
            asm volatile("s_waitcnt vmcnt(0)" ::: "memory");
        } else {
            XB_SPIN(xb_ld(&bar[XB_XGEN(b.x)]) == gen, bar);
            __builtin_amdgcn_fence(__ATOMIC_ACQUIRE, "agent");
            asm volatile("s_waitcnt vmcnt(0)" ::: "memory");
        }
    }
    __syncthreads();
}

#define RAW_BAR() do { asm volatile("s_waitcnt lgkmcnt(0)" ::: "memory"); __builtin_amdgcn_s_barrier(); asm volatile("" ::: "memory"); } while (0)

DI unsigned pk4_fp8(float a, float b, float c, float d) { int w = __builtin_amdgcn_cvt_pk_fp8_f32(a, b, 0, false); w = __builtin_amdgcn_cvt_pk_fp8_f32(c, d, w, true); return (unsigned)w; }
DI float fp8c(float x) { return fminf(fmaxf(x, -448.f), 448.f); }
constexpr float WIN_SCALE = 64.f;

struct Frame {
    LAS unsigned char* lds;
    unsigned char* ws;
    const float* in[23];
    float* out;
    int tid, lane, wave, vcu, G, gw, NGW;
};

DI size_t dn_off(int m, int h) {
    int b, pos; if (m < NT) { b = m >> 12; pos = 256 + (m & 4095); } else { const int mm = m - NT; b = mm >> 8; pos = mm & 255; }
    return ((size_t)(b * 8 + h) * 4352 + pos) * 128;
}

struct EpiInProj {
    static constexpr bool PERM = true, AFTER_DRAIN = false, TWO_STAGE = false;
    unsigned char* ws; const float* a_log; const float* dt_bias;
    DI void operator()(const pg8::f32x4 (&acc)[2][2][4][2], const pg8::Unit& u, int wr, int wc, int fr, int fq) const {
        asm volatile("" : "+v"(fr), "+v"(fq));
        const int pn = u.pn, pm = u.pm; const bool isctx = pm >= 64;
        if (pn == 38) {
            if (wc != 0) return;
            float* dstf = (float*)(ws + (fq < 2 ? WS_BETA : WS_LOGA));
            const int c8 = (fq & 1) * 8;
            f32x4 na[2], db[2];
#pragma unroll
            for (int n = 0; n < 2; ++n) { const f32x4 al = *(const f32x4*)(a_log + c8 + 4 * n); db[n] = *(const f32x4*)(dt_bias + c8 + 4 * n);
#pragma unroll
                for (int i = 0; i < 4; ++i) na[n][i] = -__expf(al[i]); }
#pragma unroll
            for (int ai = 0; ai < 2; ++ai)
#pragma unroll
                for (int m = 0; m < 4; ++m) {
                    const int row = pm * 256 + ai * 128 + wr * 64 + m * 16 + fr;
#pragma unroll
                    for (int n = 0; n < 2; ++n) {
                        f32x4 v = acc[ai][0][m][n] * (1.f / WIN_SCALE), o;
#pragma unroll
                        for (int i = 0; i < 4; ++i) {
                            const float xs = v[i] + db[n][i];
                            const float sp = fmaxf(xs, 0.f) + __logf(1.f + __expf(-fabsf(xs)));
                            const float sgm = sigm(v[i]);
                            o[i] = (fq < 2) ? sgm : na[n][i] * sp;
                        }
                        *(f32x4*)(dstf + (size_t)row * 16 + c8 + 4 * n) = o;
                    }
                }
            return;
        }
        bf16* dst; int ld, coloff, rowoff = 0; bool sg = false;
        if (pn < 4) { if (isctx) return; dst = (bf16*)(ws + WS_QN); ld = 1024; coloff = pn * 256; }
        else if (pn < 6) { dst = (bf16*)(ws + (pn == 4 ? WS_KB : WS_VB)); ld = 256; coloff = 0; rowoff = isctx ? (-12288 + (pm - 64) * 4096) : (pm >> 4) * 256; }
        else if (pn < 18) { dst = (bf16*)(ws + WS_DNRAW); ld = 3072; coloff = (pn - 6) * 256; }
        else if (pn < 22) { if (isctx) return; dst = (bf16*)(ws + WS_Z); ld = 1024; coloff = (pn - 18) * 256; }
        else { if (isctx) return; dst = (bf16*)(ws + WS_G); ld = 4096; coloff = (pn - 22) * 256; sg = true; }
        const int row0 = pm * 256 + rowoff + wr * 64 + fr, col0 = coloff + wc * 32 + 8 * fq;
#pragma unroll
        for (int ai = 0; ai < 2; ++ai)
#pragma unroll
            for (int m = 0; m < 4; ++m) {
                bf16* rowp = dst + (size_t)(row0 + ai * 128 + m * 16) * ld + col0;
#pragma unroll
                for (int bj = 0; bj < 2; ++bj) {
                    f32x4 v0 = acc[ai][bj][m][0] * (1.f / WIN_SCALE), v1 = acc[ai][bj][m][1] * (1.f / WIN_SCALE);
                    if (sg) {
                        u32x2 gb; gb.x = 0u; gb.y = 0u;
#pragma unroll
                        for (int i = 0; i < 4; ++i) { gb.x |= (unsigned)(sigm(v0[i]) * 255.f + 0.5f) << (8 * i); gb.y |= (unsigned)(sigm(v1[i]) * 255.f + 0.5f) << (8 * i); }
                        __builtin_nontemporal_store(gb, (u32x2*)((unsigned char*)dst + (size_t)(row0 + ai * 128 + m * 16) * 4096 + col0 + bj * 128));
                        continue;
                    }
                    u32x4 w; w.x = pg8::cvt_pk_bf16(v0[0], v0[1]); w.y = pg8::cvt_pk_bf16(v0[2], v0[3]); w.z = pg8::cvt_pk_bf16(v1[0], v1[1]); w.w = pg8::cvt_pk_bf16(v1[2], v1[3]);
                    __builtin_nontemporal_store(w, (u32x4*)(rowp + bj * 128));
                }
            }
    }
};


struct InProjOrder {
    pg8::StaticOrder lat; int G, c;
    static constexpr int NLAT = 64 * 39, NCTX = 4 * 15;
    DI void init(int G_, int c_) { lat.init(NT, NPROJ, G_, c_); G = G_; c = c_; }
    DI bool next(int i, pg8::Unit& u) const {
        const int L = i * G + c;
        if (L < NLAT) return lat.next(i, u);
        const int x = L - NLAT; if (x >= NCTX) return false;
        const int j = x % 15; u.pm = 64 + x / 15; u.pn = j < 2 ? 4 + j : (j < 14 ? 4 + j : 38); return true;
    }
    DI void a_ready(const pg8::Unit&) const {}
    DI void done(const pg8::Unit&) const {}
};

struct EpiPlain {
    static constexpr bool PERM = true, AFTER_DRAIN = false, TWO_STAGE = false;
    bf16* O; int ldc;
    DI void operator()(const pg8::f32x4 (&acc)[2][2][4][2], const pg8::Unit& u, int wr, int wc, int fr, int fq) const {
        const int row0 = u.pm * 256 + wr * 64 + fr, col0 = u.pn * 256 + wc * 32 + 8 * fq;
#pragma unroll
        for (int ai = 0; ai < 2; ++ai)
#pragma unroll
            for (int m = 0; m < 4; ++m) {
                bf16* rowp = O + (size_t)(row0 + ai * 128 + m * 16) * ldc + col0;
#pragma unroll
                for (int bj = 0; bj < 2; ++bj) {
                    const f32x4 v0 = acc[ai][bj][m][0], v1 = acc[ai][bj][m][1];
                    u32x4 w; w.x = pg8::cvt_pk_bf16(v0[0], v0[1]); w.y = pg8::cvt_pk_bf16(v0[2], v0[3]); w.z = pg8::cvt_pk_bf16(v1[0], v1[1]); w.w = pg8::cvt_pk_bf16(v1[2], v1[3]);
                    *(u32x4*)(rowp + bj * 128) = w;
                }
            }
    }
};

template <bool ADD> struct EpiMerge {
    static constexpr bool PERM = true, AFTER_DRAIN = false, TWO_STAGE = false;
    bf16* Y; const unsigned char* G; int goff; float gs;
    DI void operator()(const pg8::f32x4 (&acc)[2][2][4][2], const pg8::Unit& u, int wr, int wc, int fr, int fq) const {
        const int row0 = u.pm * 256 + wr * 64 + fr, col0 = u.pn * 256 + wc * 32 + 8 * fq;
#pragma unroll
        for (int ai = 0; ai < 2; ++ai)
#pragma unroll
            for (int m = 0; m < 4; ++m) {
                const size_t row = (size_t)(row0 + ai * 128 + m * 16);
#pragma unroll
                for (int bj = 0; bj < 2; ++bj) {
                    const f32x4 v0 = acc[ai][bj][m][0], v1 = acc[ai][bj][m][1];
                    const u32x2 g = __builtin_nontemporal_load((const u32x2*)(G + row * 4096 + goff + col0 + bj * 128));
                    float r[8];
#pragma unroll
                    for (int i = 0; i < 4; ++i) { r[i] = (float)((g.x >> (8 * i)) & 0xffu) * gs * v0[i]; r[4 + i] = (float)((g.y >> (8 * i)) & 0xffu) * gs * v1[i]; }
                    bf16* yp = Y + row * 2048 + col0 + bj * 128;
                    if (ADD) {
                        const u32x4 y = *(const u32x4*)yp;
                        r[0] += bflo(y.x); r[1] += bfhi(y.x); r[2] += bflo(y.y); r[3] += bfhi(y.y); r[4] += bflo(y.z); r[5] += bfhi(y.z); r[6] += bflo(y.w); r[7] += bfhi(y.w);
                    }
                    u32x4 w; w.x = pg8::cvt_pk_bf16(r[0], r[1]); w.y = pg8::cvt_pk_bf16(r[2], r[3]); w.z = pg8::cvt_pk_bf16(r[4], r[5]); w.w = pg8::cvt_pk_bf16(r[6], r[7]);
                    *(u32x4*)yp = w;
                }
            }
    }
};

struct EpiMerge2 {
    static constexpr bool PERM = true, AFTER_DRAIN = false, TWO_STAGE = true;
    bf16* Y; const unsigned char* G;
    DI void mid(pg8::f32x4 (&acc)[2][2][4][2], const pg8::Unit& u, int wr, int wc, int fr, int fq) const {
        const int row0 = u.pm * 256 + wr * 64 + fr, col0 = u.pn * 256 + wc * 32 + 8 * fq;
#pragma unroll
        for (int ai = 0; ai < 2; ++ai)
#pragma unroll
            for (int m = 0; m < 4; ++m) {
                const size_t row = (size_t)(row0 + ai * 128 + m * 16);
#pragma unroll
                for (int bj = 0; bj < 2; ++bj) {
                    const u32x2 ga = __builtin_nontemporal_load((const u32x2*)(G + row * 4096 + col0 + bj * 128));
                    const u32x2 gd = *(const u32x2*)(G + row * 4096 + 2048 + col0 + bj * 128);
#pragma unroll
                    for (int i = 0; i < 4; ++i) {
                        acc[ai][bj][m][0][i] *= (float)((ga.x >> (8 * i)) & 0xffu) * __builtin_amdgcn_rcpf(fmaxf((float)((gd.x >> (8 * i)) & 0xffu), 1.f));
                        acc[ai][bj][m][1][i] *= (float)((ga.y >> (8 * i)) & 0xffu) * __builtin_amdgcn_rcpf(fmaxf((float)((gd.y >> (8 * i)) & 0xffu), 1.f));
                    }
                }
            }
    }
    DI void operator()(const pg8::f32x4 (&acc)[2][2][4][2], const pg8::Unit& u, int wr, int wc, int fr, int fq) const {
        const int row0 = u.pm * 256 + wr * 64 + fr, col0 = u.pn * 256 + wc * 32 + 8 * fq;
#pragma unroll
        for (int ai = 0; ai < 2; ++ai)
#pragma unroll
            for (int m = 0; m < 4; ++m) {
                const size_t row = (size_t)(row0 + ai * 128 + m * 16);
#pragma unroll
                for (int bj = 0; bj < 2; ++bj) {
                    const f32x4 v0 = acc[ai][bj][m][0], v1 = acc[ai][bj][m][1];
                    const u32x2 g = __builtin_nontemporal_load((const u32x2*)(G + row * 4096 + 2048 + col0 + bj * 128));
                    float r[8];
#pragma unroll
                    for (int i = 0; i < 4; ++i) { r[i] = fmaxf((float)((g.x >> (8 * i)) & 0xffu), 1.f) * (1.f / 255.f) * v0[i]; r[4 + i] = fmaxf((float)((g.y >> (8 * i)) & 0xffu), 1.f) * (1.f / 255.f) * v1[i]; }
                    u32x4 w; w.x = pg8::cvt_pk_bf16(r[0], r[1]); w.y = pg8::cvt_pk_bf16(r[2], r[3]); w.z = pg8::cvt_pk_bf16(r[4], r[5]); w.w = pg8::cvt_pk_bf16(r[6], r[7]);
                    *(u32x4*)(Y + row * 2048 + col0 + bj * 128) = w;
                }
            }
    }
};

struct EpiResid {
    static constexpr bool PERM = true, AFTER_DRAIN = false, TWO_STAGE = false;
    const float* x; bf16* X1; const float* mod;
    DI void operator()(const pg8::f32x4 (&acc)[2][2][4][2], const pg8::Unit& u, int wr, int wc, int fr, int fq) const {
        const int row0 = u.pm * 256 + wr * 64 + fr, col0 = u.pn * 256 + wc * 32 + 8 * fq;
        const float* g1 = mod + (size_t)(u.pm >> 4) * 12288 + 2 * 2048;
        f32x4 gv[2][2];
#pragma unroll
        for (int bj = 0; bj < 2; ++bj)
#pragma unroll
            for (int n = 0; n < 2; ++n) gv[bj][n] = *(const f32x4*)(g1 + col0 + bj * 128 + n * 4);
#pragma unroll
        for (int ai = 0; ai < 2; ++ai)
#pragma unroll
            for (int m = 0; m < 4; ++m) {
                const size_t off = (size_t)(row0 + ai * 128 + m * 16) * 2048 + col0;
#pragma unroll
                for (int bj = 0; bj < 2; ++bj) {
                    const f32x4 x0 = __builtin_nontemporal_load((const f32x4*)(x + off + bj * 128)), x1 = __builtin_nontemporal_load((const f32x4*)(x + off + bj * 128 + 4));
                    const f32x4 v0 = x0 + gv[bj][0] * acc[ai][bj][m][0], v1 = x1 + gv[bj][1] * acc[ai][bj][m][1];
                    u32x4 w; w.x = pk2(v0[0], v0[1]); w.y = pk2(v0[2], v0[3]); w.z = pk2(v1[0], v1[1]); w.w = pk2(v1[2], v1[3]);
                    *(u32x4*)(X1 + off + bj * 128) = w;
                }
            }
    }
};

DI void transpose_item(const float* W, int K, int Nsrc, int sn0, bf16* WT, int dn0, int k0, LAS float* scr, int lane) {
    if (sn0 >= 0) {
        float t[32];
#pragma unroll
        for (int i = 0; i < 32; ++i) t[i] = __builtin_nontemporal_load(&W[(size_t)(k0 + 2 * i + (lane >> 5)) * Nsrc + sn0 + (lane & 31)]);
#pragma unroll
        for (int i = 0; i < 32; ++i) scr[(2 * i + (lane >> 5)) * 33 + (lane & 31)] = t[i];
    } else {
#pragma unroll 8
        for (int i = 0; i < 32; ++i) { const int kk = 2 * i + (lane >> 5); scr[kk * 33 + (lane & 31)] = 0.f; }
    }
    asm volatile("s_waitcnt lgkmcnt(0)" ::: "memory");
    const int c = lane & 7;
#pragma unroll
    for (int j = 0; j < 4; ++j) {
        const int n = (lane >> 3) + 8 * j; const LAS float* s = scr + (8 * c) * 33 + n;
        u32x4 o; o.x = pk2(s[0 * 33], s[1 * 33]); o.y = pk2(s[2 * 33], s[3 * 33]); o.z = pk2(s[4 * 33], s[5 * 33]); o.w = pk2(s[6 * 33], s[7 * 33]);
        *(u32x4*)(WT + (size_t)(dn0 + n) * K + k0 + 8 * c) = o;
    }
    asm volatile("s_waitcnt lgkmcnt(0)" ::: "memory");
}

DI void transpose_item_fp8(const float* W, int K, int Nsrc, int sn0, unsigned char* WT, int dn0, int k0, float scale, LAS float* scr, int lane) {
    if (sn0 >= 0) {
        float t[32];
#pragma unroll
        for (int i = 0; i < 32; ++i) t[i] = __builtin_nontemporal_load(&W[(size_t)(k0 + 2 * i + (lane >> 5)) * Nsrc + sn0 + (lane & 31)]);
#pragma unroll
        for (int i = 0; i < 32; ++i) scr[(2 * i + (lane >> 5)) * 33 + (lane & 31)] = t[i] * scale;
    } else {
#pragma unroll 8
        for (int i = 0; i < 32; ++i) { const int kk = 2 * i + (lane >> 5); scr[kk * 33 + (lane & 31)] = 0.f; }
    }
    asm volatile("s_waitcnt lgkmcnt(0)" ::: "memory");
    const int c = lane & 7;
#pragma unroll
    for (int j = 0; j < 4; ++j) {
        const int n = (lane >> 3) + 8 * j; const LAS float* s = scr + (8 * c) * 33 + n;
        u32x2 o; o.x = pk4_fp8(s[0 * 33], s[1 * 33], s[2 * 33], s[3 * 33]); o.y = pk4_fp8(s[4 * 33], s[5 * 33], s[6 * 33], s[7 * 33]);
        *(u32x2*)(WT + (size_t)(dn0 + n) * K + k0 + 8 * c) = o;
    }
    asm volatile("s_waitcnt lgkmcnt(0)" ::: "memory");
}

DI void cvt_bf16_stream(const float* src, bf16* dst, size_t n8, size_t gtid, size_t nthr) {
    for (size_t i = gtid; i < n8; i += nthr) {
        const f32x4 a = *(const f32x4*)(src + i * 8), b = *(const f32x4*)(src + i * 8 + 4);
        u32x4 w; w.x = pk2(a[0], a[1]); w.y = pk2(a[2], a[3]); w.z = pk2(b[0], b[1]); w.w = pk2(b[2], b[3]);
        *(u32x4*)(dst + i * 8) = w;
    }
}

DI void phase_prologue(Frame& F) {
    LAS float* scr = (LAS float*)(F.lds + F.wave * 16384);
    constexpr int I_WIN = 32 * 312, I_WB = 16 * 64, I_WO = 32 * 64;
    constexpr int NITEMS = I_WIN + 2 * I_WB + 2 * I_WO;
#ifndef PRO_REP_T
#define PRO_REP_T 1
#endif
#ifndef PRO_REP_G
#define PRO_REP_G 1
#endif
#pragma nounroll
    for (int rep_t = 0; rep_t < PRO_REP_T; ++rep_t)
    for (int it = F.gw; it < NITEMS; it += F.NGW) {
        int r = it;
        if (r < I_WIN) { const int kb = r / 312, nb = r % 312; const int snb = nb < 176 ? nb : (nb < 304 ? nb + 1 : (nb == 304 ? 176 : -1));
            transpose_item_fp8(F.in[8], DM, INW, snb < 0 ? -1 : snb * 32, F.ws + WS_WIN, nb * 32, kb * 64, WIN_SCALE, scr, F.lane); continue; }
        r -= I_WIN;
        if (r < I_WB) {
            if (MERGE_F8_A) transpose_item_fp8(F.in[15], 1024, DM, (r % 64) * 32, F.ws + WS_WBA, (r % 64) * 32, (r / 64) * 64, WB_SCALE, scr, F.lane);
            else transpose_item(F.in[15], 1024, DM, (r % 64) * 32, (bf16*)(F.ws + WS_WBA), (r % 64) * 32, (r / 64) * 64, scr, F.lane);
            continue; }
        r -= I_WB;
        if (r < I_WB) {
            if (MERGE_F8_B) transpose_item_fp8(F.in[16], 1024, DM, (r % 64) * 32, F.ws + WS_WBD, (r % 64) * 32, (r / 64) * 64, WB_SCALE, scr, F.lane);
            else transpose_item(F.in[16], 1024, DM, (r % 64) * 32, (bf16*)(F.ws + WS_WBD), (r % 64) * 32, (r / 64) * 64, scr, F.lane);
            continue; }
        r -= I_WB;
        if (r < I_WO) { transpose_item(F.in[17], DM, DM, (r % 64) * 32, (bf16*)(F.ws + WS_WOUT), (r % 64) * 32, (r / 64) * 64, scr, F.lane); continue; }
        r -= I_WO;
        transpose_item(F.in[18], DM, DM, (r % 64) * 32, (bf16*)(F.ws + WS_WQ), (r % 64) * 32, (r / 64) * 64, scr, F.lane);
    }
    cvt_bf16_stream(F.in[19], (bf16*)(F.ws + WS_SUBK), (size_t)8 * 2 * 128 * 128 / 8, (size_t)blockIdx.x * 512 + F.tid, (size_t)F.G * 512);
    LAS float* sc = (LAS float*)(F.lds + 131072);
    const float* ada_w = F.in[4];
    float* MODP = (float*)(F.ws + WS_MODP);
#pragma nounroll
    for (int rep_g = 0; rep_g < PRO_REP_G; ++rep_g)
    for (int it = blockIdx.x; it < 32 * 24; it += F.G) {
        const int kc = it / 24, nb = it % 24, n = nb * 512 + F.tid;
        __syncthreads();
        if (F.tid < 320) { const int r = F.tid >> 6, kk = F.tid & 63, k = kc * 64 + kk; const float cv = (r < 4) ? F.in[1][r * DM + k] : F.in[3][k]; sc[r * 64 + kk] = silu(cv); }
        __syncthreads();
        float a0 = 0.f, a1 = 0.f, a2 = 0.f, a3 = 0.f, a4 = 0.f;
#pragma unroll 32
        for (int kk = 0; kk < 64; ++kk) {
            const float w = __builtin_nontemporal_load(&ada_w[(size_t)(kc * 64 + kk) * 12288 + n]);
            a0 += sc[kk] * w; a1 += sc[64 + kk] * w; a2 += sc[128 + kk] * w; a3 += sc[192 + kk] * w; a4 += sc[256 + kk] * w;
        }
        float* o = MODP + (size_t)kc * 5 * 12288 + n;
        o[0] = a0; o[12288] = a1; o[2 * 12288] = a2; o[3 * 12288] = a3; o[4 * 12288] = a4;
    }
}

DI void phase_modreduce(Frame& F) {
    const float* MODP = (const float*)(F.ws + WS_MODP); float* MOD = (float*)(F.ws + WS_MOD); const float* ada_b = F.in[5];
    for (int i = blockIdx.x * 512 + F.tid; i < 5 * 12288; i += F.G * 512) {
        const int n = i % 12288; float s = ada_b[n];
#pragma unroll 8
        for (int kc = 0; kc < 32; ++kc) s += MODP[(size_t)kc * 5 * 12288 + i];
        MOD[i] = s;
    }
}

DI void modnorm_row(const float* xrow, bf16* orow, const float* nw, const float* sc, const float* sh, int lane) {
    f32x4 v[8]; float ss = 0.f;
#pragma unroll
    for (int j = 0; j < 8; ++j) { v[j] = *((const f32x4*)xrow + lane + 64 * j); ss += (v[j][0] * v[j][0] + v[j][1] * v[j][1]) + (v[j][2] * v[j][2] + v[j][3] * v[j][3]); }
    const float rstd = rsqrtf(wave_sum(ss) * (1.f / DM) + EPS);
#pragma unroll
    for (int j = 0; j < 8; ++j) {
        const int c = (lane + 64 * j) * 4;
        const f32x4 w = *(const f32x4*)(nw + c), s = *(const f32x4*)(sc + c), h = *(const f32x4*)(sh + c);
        f32x4 o;
#pragma unroll
        for (int i = 0; i < 4; ++i) o[i] = (v[j][i] * rstd * w[i]) * (1.f + s[i]) + h[i];
        u32x2 p; p.x = pk2(o[0], o[1]); p.y = pk2(o[2], o[3]);
        *(u32x2*)(orow + c) = p;
    }
}

DI void modnorm_row_bf(const bf16* xrow, bf16* orow, const float* nw, const float* sc, const float* sh, int lane) {
    f32x4 v[8]; float ss = 0.f;
#pragma unroll
    for (int j = 0; j < 8; ++j) { const u32x2 w = *((const u32x2*)xrow + lane + 64 * j); v[j] = (f32x4){bflo(w.x), bfhi(w.x), bflo(w.y), bfhi(w.y)}; ss += (v[j][0] * v[j][0] + v[j][1] * v[j][1]) + (v[j][2] * v[j][2] + v[j][3] * v[j][3]); }
    const float rstd = rsqrtf(wave_sum(ss) * (1.f / DM) + EPS);
#pragma unroll
    for (int j = 0; j < 8; ++j) {
        const int c = (lane + 64 * j) * 4;
        const f32x4 w = *(const f32x4*)(nw + c), s = *(const f32x4*)(sc + c), h = *(const f32x4*)(sh + c);
        f32x4 o;
#pragma unroll
        for (int i = 0; i < 4; ++i) o[i] = (v[j][i] * rstd * w[i]) * (1.f + s[i]) + h[i];
        u32x2 p; p.x = pk2(o[0], o[1]); p.y = pk2(o[2], o[3]);
        *(u32x2*)(orow + c) = p;
    }
}

DI void modnorm_row_fp8(const float* xrow, unsigned char* orow, const float* nw, const float* sc, const float* sh, int lane) {
    f32x4 v[8]; float ss = 0.f;
#pragma unroll
    for (int j = 0; j < 8; ++j) { v[j] = __builtin_nontemporal_load((const f32x4*)xrow + lane + 64 * j); ss += (v[j][0] * v[j][0] + v[j][1] * v[j][1]) + (v[j][2] * v[j][2] + v[j][3] * v[j][3]); }
    const float rstd = rsqrtf(wave_sum(ss) * (1.f / DM) + EPS);
#pragma unroll
    for (int j = 0; j < 8; ++j) {
        const int c = (lane + 64 * j) * 4;
        const f32x4 w = *(const f32x4*)(nw + c), s = *(const f32x4*)(sc + c), h = *(const f32x4*)(sh + c);
        f32x4 o;
#pragma unroll
        for (int i = 0; i < 4; ++i) o[i] = (v[j][i] * rstd * w[i]) * (1.f + s[i]) + h[i];
        *(unsigned*)(orow + c) = pk4_fp8(o[0], o[1], o[2], o[3]);
    }
}

struct ModPar { f32x4 a[8], h[8]; };
DI void modpar_load(ModPar& P, const float* nw, const float* sc, const float* sh, int lane) {
#pragma unroll
    for (int j = 0; j < 8; ++j) { const int c = (lane + 64 * j) * 4; const f32x4 w = *(const f32x4*)(nw + c), s = *(const f32x4*)(sc + c); P.a[j] = w * (1.f + s); P.h[j] = *(const f32x4*)(sh + c); }
}
DI void modnorm_rows_fp8(const float* x0, unsigned char* o0, int nrows, const ModPar& P, int lane) {
    f32x4 v[8];
#pragma unroll
    for (int j = 0; j < 8; ++j) v[j] = __builtin_nontemporal_load((const f32x4*)x0 + lane + 64 * j);
    for (int r = 0; r < nrows; ++r) {
        float ss = 0.f;
#pragma unroll
        for (int j = 0; j < 8; ++j) ss += (v[j][0] * v[j][0] + v[j][1] * v[j][1]) + (v[j][2] * v[j][2] + v[j][3] * v[j][3]);
        const float rstd = rsqrtf(wave_sum(ss) * (1.f / DM) + EPS);
        unsigned char* orow = o0 + (size_t)r * DM;
        const float* xn = x0 + (size_t)(r + 1 < nrows ? r + 1 : r) * DM;
#pragma unroll
        for (int j = 0; j < 8; ++j) {
            const f32x4 o = (v[j] * rstd) * P.a[j] + P.h[j];
            v[j] = __builtin_nontemporal_load((const f32x4*)xn + lane + 64 * j);
            *(unsigned*)(orow + (lane + 64 * j) * 4) = pk4_fp8(o[0], o[1], o[2], o[3]);
        }
    }
}
DI void modnorm_rows_bf(const bf16* x0, bf16* o0, int nrows, const ModPar& P, int lane) {
    u32x2 w[8];
#pragma unroll
    for (int j = 0; j < 8; ++j) w[j] = *((const u32x2*)x0 + lane + 64 * j);
    for (int r = 0; r < nrows; ++r) {
        f32x4 v[8]; float ss = 0.f;
#pragma unroll
        for (int j = 0; j < 8; ++j) { v[j] = (f32x4){bflo(w[j].x), bfhi(w[j].x), bflo(w[j].y), bfhi(w[j].y)}; ss += (v[j][0] * v[j][0] + v[j][1] * v[j][1]) + (v[j][2] * v[j][2] + v[j][3] * v[j][3]); }
        const float rstd = rsqrtf(wave_sum(ss) * (1.f / DM) + EPS);
        bf16* orow = o0 + (size_t)r * DM;
        const bf16* xn = x0 + (size_t)(r + 1 < nrows ? r + 1 : r) * DM;
#pragma unroll
        for (int j = 0; j < 8; ++j) {
            const f32x4 o = (v[j] * rstd) * P.a[j] + P.h[j];
            w[j] = *((const u32x2*)xn + lane + 64 * j);
            u32x2 p; p.x = pk2(o[0], o[1]); p.y = pk2(o[2], o[3]);
            *(u32x2*)(orow + (lane + 64 * j) * 4) = p;
        }
    }
}

DI void phase_h1(Frame& F) {
    const float* MOD = (const float*)(F.ws + WS_MOD); unsigned char* H = F.ws + WS_H;
    ModPar P;
    {
        constexpr int RPW = NT / (256 * NWAVES);
        const int m0 = F.gw * RPW, r = m0 >> 12;
        if (F.NGW == 256 * NWAVES) {
            modpar_load(P, F.in[6], MOD + (size_t)r * 12288 + 2048, MOD + (size_t)r * 12288, F.lane);
            modnorm_rows_fp8(F.in[0] + (size_t)m0 * DM, H + (size_t)m0 * DM, RPW, P, F.lane);
        } else {
            for (int m = F.gw; m < NT; m += F.NGW) { modpar_load(P, F.in[6], MOD + (size_t)(m >> 12) * 12288 + 2048, MOD + (size_t)(m >> 12) * 12288, F.lane); modnorm_rows_fp8(F.in[0] + (size_t)m * DM, H + (size_t)m * DM, 1, P, F.lane); }
        }
    }
    if (F.gw < NC) {
        modpar_load(P, F.in[6], MOD + (size_t)4 * 12288 + 2048, MOD + (size_t)4 * 12288, F.lane);
        for (int m = F.gw; m < NC; m += F.NGW) modnorm_rows_fp8(F.in[2] + (size_t)m * DM, H + (size_t)(NT + m) * DM, 1, P, F.lane);
    }
}

DI void phase_postproj(Frame& F) {
    const int lane = F.lane, tid = F.tid;
    LAS float* tcs = (LAS float*)F.lds;
    for (int i = tid; i < 2048; i += 512) { const int pos = i >> 5, f = i & 31; float sn, cs; sincosf((float)pos * exp2f(-(float)f * (13.287712379549449f / 32.f)), &sn, &cs); tcs[i] = cs; tcs[2048 + i] = sn; }
    __syncthreads();
    {
        bf16* QN = (bf16*)(F.ws + WS_QN); bf16* KB = (bf16*)(F.ws + WS_KB);
        const int j = lane & 7, axis = j >> 2, fg = j & 3, d1 = axis * 64 + 8 * fg;
        f32x4 qw[4], kw[4];
        qw[0] = *(const f32x4*)(F.in[9] + d1); qw[1] = *(const f32x4*)(F.in[9] + d1 + 4); qw[2] = *(const f32x4*)(F.in[9] + d1 + 32); qw[3] = *(const f32x4*)(F.in[9] + d1 + 36);
        kw[0] = *(const f32x4*)(F.in[10] + d1); kw[1] = *(const f32x4*)(F.in[10] + d1 + 4); kw[2] = *(const f32x4*)(F.in[10] + d1 + 32); kw[3] = *(const f32x4*)(F.in[10] + d1 + 36);
        constexpr int NQI = NT, NKI = NB * LKV / 4;
        for (int it = F.gw; it < NQI + NKI; it += F.NGW) {
            bf16* p; int t; bool rope; const bool isq = it < NQI;
            if (isq) { p = QN + (size_t)it * 1024 + (lane >> 3) * 128; t = it & 4095; rope = true; }
            else { const int row = (it - NQI) * 4 + (lane >> 4), pp = row % LKV; p = KB + (size_t)row * 256 + ((lane >> 3) & 1) * 128; t = pp; rope = pp < TS; }
            const u32x4 w1 = *(const u32x4*)(p + d1), w2 = *(const u32x4*)(p + d1 + 32);
            float x1[8], x2[8];
            x1[0] = bflo(w1.x); x1[1] = bfhi(w1.x); x1[2] = bflo(w1.y); x1[3] = bfhi(w1.y); x1[4] = bflo(w1.z); x1[5] = bfhi(w1.z); x1[6] = bflo(w1.w); x1[7] = bfhi(w1.w);
            x2[0] = bflo(w2.x); x2[1] = bfhi(w2.x); x2[2] = bflo(w2.y); x2[3] = bfhi(w2.y); x2[4] = bflo(w2.z); x2[5] = bfhi(w2.z); x2[6] = bflo(w2.w); x2[7] = bfhi(w2.w);
            float ss = 0.f;
#pragma unroll
            for (int i = 0; i < 8; ++i) ss += x1[i] * x1[i] + x2[i] * x2[i];
            ss += __shfl_xor(ss, 1); ss += __shfl_xor(ss, 2); ss += __shfl_xor(ss, 4);
            const float rstd = rsqrtf(ss * (1.f / 128.f) + EPS);
            const int pos = axis == 0 ? (t >> 6) : (t & 63);
            float o1[8], o2[8];
#pragma unroll
            for (int i = 0; i < 8; ++i) {
                const float wa = isq ? qw[i >> 2][i & 3] : kw[i >> 2][i & 3], wb = isq ? qw[2 + (i >> 2)][i & 3] : kw[2 + (i >> 2)][i & 3];
                const float y1 = x1[i] * rstd * wa, y2 = x2[i] * rstd * wb;
                const float cs0 = tcs[(pos & 63) * 32 + 8 * fg + i], sn0 = tcs[2048 + (pos & 63) * 32 + 8 * fg + i];
                const float cs = rope ? cs0 : 1.f, sn = rope ? sn0 : 0.f;
                o1[i] = y1 * cs - y2 * sn; o2[i] = y2 * cs + y1 * sn;
            }
            u32x4 r1, r2;
            r1.x = pk2(o1[0], o1[1]); r1.y = pk2(o1[2], o1[3]); r1.z = pk2(o1[4], o1[5]); r1.w = pk2(o1[6], o1[7]);
            r2.x = pk2(o2[0], o2[1]); r2.y = pk2(o2[2], o2[3]); r2.z = pk2(o2[4], o2[5]); r2.w = pk2(o2[6], o2[7]);
            *(u32x4*)(p + d1) = r1; *(u32x4*)(p + d1 + 32) = r2;
        }
    }
    {
        const bf16* RAW = (const bf16*)(F.ws + WS_DNRAW); const float* cw = F.in[11];
        for (int it = F.gw; it < (MTOT / 16) * 6; it += F.NGW) {
            const int tc = it / 6, grp = it % 6, m0 = tc * 16, part = grp >> 1;
            int start, len; if (m0 < NT) { start = m0 & ~4095; len = TS; } else { start = NT + ((m0 - NT) & ~255); len = CL; }
            const int pos0 = m0 - start, c = grp * 512 + 8 * lane;
            float wv[5][8];
#pragma unroll
            for (int jj = 0; jj < 5; ++jj) { const f32x4 a = *(const f32x4*)(cw + jj * 3072 + c), b = *(const f32x4*)(cw + jj * 3072 + c + 4);
                wv[jj][0] = a[0]; wv[jj][1] = a[1]; wv[jj][2] = a[2]; wv[jj][3] = a[3]; wv[jj][4] = b[0]; wv[jj][5] = b[1]; wv[jj][6] = b[2]; wv[jj][7] = b[3]; }
            u32x4 rows[20];
#pragma unroll
            for (int r = 0; r < 20; ++r) { const int pp = pos0 + r - 2; const bool ok = pp >= 0 && pp < len;
                const u32x4 v = *(const u32x4*)(RAW + (size_t)(start + (ok ? pp : pos0)) * 3072 + c); rows[r] = ok ? v : (u32x4){0u, 0u, 0u, 0u}; }
            bf16* dst = (bf16*)(F.ws + (part == 0 ? WS_DQ : (part == 1 ? WS_DK : WS_DV))) + dn_off(m0, (grp & 1) * 4 + (lane >> 4)) + 8 * (lane & 15);
#pragma unroll
            for (int th = 0; th < 2; ++th) {
                float a[8][8], ss[8];
#pragma unroll
                for (int t8 = 0; t8 < 8; ++t8) {
                    const int tk = th * 8 + t8;
#pragma unroll
                    for (int i = 0; i < 8; ++i) a[t8][i] = 0.f;
#pragma unroll
                    for (int jj = 0; jj < 5; ++jj) { const u32x4 w = rows[tk + jj];
                        a[t8][0] += wv[jj][0] * bflo(w.x); a[t8][1] += wv[jj][1] * bfhi(w.x); a[t8][2] += wv[jj][2] * bflo(w.y); a[t8][3] += wv[jj][3] * bfhi(w.y);
                        a[t8][4] += wv[jj][4] * bflo(w.z); a[t8][5] += wv[jj][5] * bfhi(w.z); a[t8][6] += wv[jj][6] * bflo(w.w); a[t8][7] += wv[jj][7] * bfhi(w.w); }
                    ss[t8] = 0.f;
#pragma unroll
                    for (int i = 0; i < 8; ++i) { a[t8][i] = silu(a[t8][i]); ss[t8] += a[t8][i] * a[t8][i]; }
                }
                if (part < 2) {
#pragma unroll
                    for (int o = 1; o < 16; o <<= 1)
#pragma unroll
                        for (int t8 = 0; t8 < 8; ++t8) ss[t8] += __shfl_xor(ss[t8], o);
#pragma unroll
                    for (int t8 = 0; t8 < 8; ++t8) {
                        const float r = rsqrtf(ss[t8] + EPS) * (part == 0 ? 0.088388347648318440f : 1.f);
#pragma unroll
                        for (int i = 0; i < 8; ++i) a[t8][i] *= r;
                    }
                }
#pragma unroll
                for (int t8 = 0; t8 < 8; ++t8) {
                    u32x4 o; o.x = pk2(a[t8][0], a[t8][1]); o.y = pk2(a[t8][2], a[t8][3]); o.z = pk2(a[t8][4], a[t8][5]); o.w = pk2(a[t8][6], a[t8][7]);
                    *(u32x4*)(dst + (th * 8 + t8) * 128) = o;
                }
            }
        }
    }
}

DI void phase_dn_naive(Frame& F) {
    if (F.wave != 0 || blockIdx.x >= 128) return;
    const int item = blockIdx.x, dir = item >> 6, b = (item >> 4) & 3, h = (item >> 1) & 7, half = item & 1, lane = F.lane;
    const bf16* DQ = (const bf16*)(F.ws + WS_DQ); const bf16* DK = (const bf16*)(F.ws + WS_DK); const bf16* DV = (const bf16*)(F.ws + WS_DV);
    const float* BETA = (const float*)(F.ws + WS_BETA); const float* LOGA = (const float*)(F.ws + WS_LOGA);
    bf16* ODN = (bf16*)(F.ws + WS_ODN);
    float S[128];
#pragma unroll
    for (int i = 0; i < 128; ++i) S[i] = 0.f;
    for (int step = 0; step < LKV; ++step) {
        const bool isl = step >= CL; const int p = isl ? step - CL : step, len = isl ? TS : CL, pos = dir ? len - 1 - p : p;
        const int m = isl ? b * TS + pos : NT + b * CL + pos;
        const unsigned kw = *(const unsigned*)(DK + dn_off(m, h) + 2 * lane);
        const unsigned qw = *(const unsigned*)(DQ + dn_off(m, h) + 2 * lane);
        const float vj = bf2f(DV[dn_off(m, h) + half * 64 + lane]);
        const float a = __expf(LOGA[(size_t)m * 16 + dir * 8 + h]), bt = BETA[(size_t)m * 16 + dir * 8 + h];
        float k0 = 0.f, k1 = 0.f, k2 = 0.f, k3 = 0.f;
#pragma unroll
        for (int i = 0; i < 64; i += 2) {
            const unsigned w0 = rdlane(kw, i), w1 = rdlane(kw, i + 1);
            k0 += bflo(w0) * S[2 * i]; k1 += bfhi(w0) * S[2 * i + 1]; k2 += bflo(w1) * S[2 * i + 2]; k3 += bfhi(w1) * S[2 * i + 3];
        }
        const float kS = (k0 + k1) + (k2 + k3);
        const float coef = bt * (vj - a * kS);
#pragma unroll
        for (int i = 0; i < 64; ++i) { const unsigned w0 = rdlane(kw, i); S[2 * i] = a * S[2 * i] + coef * bflo(w0); S[2 * i + 1] = a * S[2 * i + 1] + coef * bfhi(w0); }
        if (isl) {
            float o0 = 0.f, o1 = 0.f, o2 = 0.f, o3 = 0.f;
#pragma unroll
            for (int i = 0; i < 64; i += 2) {
                const unsigned w0 = rdlane(qw, i), w1 = rdlane(qw, i + 1);
                o0 += bflo(w0) * S[2 * i]; o1 += bfhi(w0) * S[2 * i + 1]; o2 += bflo(w1) * S[2 * i + 2]; o3 += bfhi(w1) * S[2 * i + 3];
            }
            ODN[((size_t)dir * NT + m) * 1024 + h * 128 + half * 64 + lane] = (bf16)f2bf((o0 + o1) + (o2 + o3));
        }
    }
}

DI int dn_row0(int b, int cc) { return cc < 4 ? NT + b * CL + 64 * cc : b * TS + 64 * (cc - 4); }
typedef short bf16x8_t __attribute__((ext_vector_type(8)));
#define MFMA16(a, b, c) __builtin_amdgcn_mfma_f32_16x16x32_bf16((a), (b), (c), 0, 0, 0)

DI bf16x8_t dn_afrag(const LAS unsigned char* p) {
    const u32x2 lo = *(const LAS u32x2*)p, hi = *(const LAS u32x2*)(p + 32);
    u32x4 v; v.x = lo.x; v.y = lo.y; v.z = hi.x; v.w = hi.y; return __builtin_bit_cast(bf16x8_t, v);
}
DI bf16x8_t dn_bpack(const f32x4 t0, const f32x4 t1) {
    u32x4 v; v.x = pk2(t0[0], t0[1]); v.y = pk2(t0[2], t0[3]); v.z = pk2(t1[0], t1[1]); v.w = pk2(t1[2], t1[3]); return __builtin_bit_cast(bf16x8_t, v);
}
DI void phase_dn_prep(Frame& F) {
    LAS unsigned char* L = F.lds;
    constexpr int KS = 0, QS = 17408, VC = 34816, AP = 35840;
    constexpr int NITEM = NB * 8 * 68, NBATCH = (NITEM + 2) / 3;
    const bf16* DQ = (const bf16*)(F.ws + WS_DQ); const bf16* DK = (const bf16*)(F.ws + WS_DK);
    const float* BETA = (const float*)(F.ws + WS_BETA); const float* LOGA = (const float*)(F.ws + WS_LOGA);
    bf16* KT = (bf16*)(F.ws + WS_KT); bf16* TINV = (bf16*)(F.ws + WS_TINV); bf16* QKO = (bf16*)(F.ws + WS_QKO); float* VEC = (float*)(F.ws + WS_VEC);
    const int tid = F.tid, wave = F.wave;
    LAS float* vg = (LAS float*)(L + VC); LAS float* vb = vg + 128;
    for (int batch = F.vcu; batch < NBATCH; batch += F.G) {
        int lane = F.lane; asm volatile("" : "+v"(lane));
        const int fr = lane & 15, fq = lane >> 4;
#pragma unroll 1
        for (int c3 = 0; c3 < 3; ++c3) {
            const int item = batch * 3 + c3;
            if (item >= NITEM) break;
            const int b = item / 544, h = (item % 544) / 68, cc = item % 68, row0 = dn_row0(b, cc);
#pragma unroll
            for (int k = 0; k < 4; ++k) {
                const int c = tid + 512 * k, which = c >> 10, c2 = c & 1023, row = c2 >> 4, c16 = c2 & 15;
                const u32x4 v = *(const u32x4*)((which ? DQ : DK) + (size_t)item * 8192 + c2 * 8);
                *(LAS u32x4*)(L + (which ? QS : KS) + row * 272 + c16 * 16) = v;
            }
            if (wave < 2) {
                const int d = wave, i = lane;
                const float la = LOGA[(size_t)(row0 + i) * 16 + d * 8 + h], bt = BETA[(size_t)(row0 + i) * 16 + d * 8 + h];
                float x = la;
                if (d == 0) {
#pragma unroll
                    for (int o = 1; o < 64; o <<= 1) { const float y = __shfl_up(x, o); if (i >= o) x += y; }
                } else {
#pragma unroll
                    for (int o = 1; o < 64; o <<= 1) { const float y = __shfl_down(x, o); if (i + o < 64) x += y; }
                }
                const float glast = __shfl(x, d == 0 ? 63 : 0);
                vg[d * 64 + i] = x; vb[d * 64 + i] = bt;
                float* ve = VEC + (size_t)(item * 2 + d) * 320;
                const float eg = __expf(x);
                ve[i] = bt; ve[64 + i] = eg; ve[128 + i] = bt * eg; ve[192 + i] = __expf(glast - x); ve[256 + i] = __expf(glast);
            }
            __syncthreads();
            {
                bf16* kt = KT + (size_t)item * 8192;
#pragma unroll
                for (int k = 0; k < 2; ++k) {
                    const int c = tid + 512 * k, dk = c >> 3, t8 = c & 7;
                    unsigned short e[8];
#pragma unroll
                    for (int q = 0; q < 8; ++q) e[q] = *(const LAS unsigned short*)(L + KS + (8 * t8 + q) * 272 + dk * 2);
                    u32x4 w; w.x = e[0] | ((unsigned)e[1] << 16); w.y = e[2] | ((unsigned)e[3] << 16); w.z = e[4] | ((unsigned)e[5] << 16); w.w = e[6] | ((unsigned)e[7] << 16);
                    *(u32x4*)(kt + dk * 64 + 8 * t8) = w;
                }
            }
            {
                const int it = wave & 3, mat = wave >> 2;
                f32x4 acc[4];
#pragma unroll
                for (int j = 0; j < 4; ++j) acc[j] = (f32x4){0.f, 0.f, 0.f, 0.f};
#pragma unroll
                for (int s = 0; s < 4; ++s) {
                    const bf16x8_t a = *(const LAS bf16x8_t*)(L + (mat ? QS : KS) + (16 * it + fr) * 272 + (32 * s + 8 * fq) * 2);
#pragma unroll
                    for (int jt = 0; jt < 4; ++jt) {
                        const bf16x8_t bb = *(const LAS bf16x8_t*)(L + KS + (16 * jt + fr) * 272 + (32 * s + 8 * fq) * 2);
                        acc[jt] = MFMA16(a, bb, acc[jt]);
                    }
                }
                f32x4 gi[2], bi[2]; float gj[2][4];
#pragma unroll
                for (int d = 0; d < 2; ++d) {
                    gi[d] = *(const LAS f32x4*)(vg + d * 64 + 16 * it + 4 * fq); bi[d] = *(const LAS f32x4*)(vb + d * 64 + 16 * it + 4 * fq);
#pragma unroll
                    for (int jt = 0; jt < 4; ++jt) gj[d][jt] = vg[d * 64 + 16 * jt + fr];
                }
                if (mat == 0) {
#pragma unroll
                    for (int d = 0; d < 2; ++d) {
                        LAS float* ap = (LAS float*)(L + AP + (c3 * 2 + d) * 17408);
#pragma unroll
                        for (int jt = 0; jt < 4; ++jt)
#pragma unroll
                            for (int r = 0; r < 4; ++r) {
                                const int i = 16 * it + 4 * fq + r, j = 16 * jt + fr, ip = d ? 63 - i : i, jp = d ? 63 - j : j;
                                ap[ip * 68 + jp] = (jp < ip) ? bi[d][r] * acc[jt][r] * __expf(gi[d][r] - gj[d][jt]) : 0.f;
                            }
                    }
                } else {
#pragma unroll
                    for (int d = 0; d < 2; ++d) {
                        bf16* qo = QKO + (size_t)(item * 2 + d) * 4096;
#pragma unroll
                        for (int jt = 0; jt < 4; ++jt)
#pragma unroll
                            for (int r = 0; r < 4; ++r) {
                                const int i = 16 * it + 4 * fq + r, j = 16 * jt + fr, ip = d ? 63 - i : i, jp = d ? 63 - j : j;
                                qo[i * 64 + j] = (bf16)f2bf((jp <= ip) ? acc[jt][r] * __expf(gi[d][r] - gj[d][jt]) : 0.f);
                            }
                    }
                }
            }
            __syncthreads();
        }
        if (wave < 6 && batch * 3 + (wave >> 1) < NITEM) {
            const int item = batch * 3 + (wave >> 1), d = wave & 1, c = lane;
            const LAS float* ap = (const LAS float*)(L + AP + wave * 17408);
            float x[64];
            f32x4 nx[16];
            x[0] = (c == 0) ? 1.f : 0.f;
            nx[0] = *(const LAS f32x4*)(ap + 68);
            __builtin_amdgcn_sched_barrier(0);
#pragma unroll
            for (int ip = 1; ip < 64; ++ip) {
                f32x4 cur[16];
#pragma unroll
                for (int q = 0; q < (ip + 3) / 4; ++q) cur[q] = nx[q];
                if (ip + 1 < 64) {
#pragma unroll
                    for (int q = 0; q < (ip + 4) / 4; ++q) nx[q] = *(const LAS f32x4*)(ap + (ip + 1) * 68 + 4 * q);
                }
                float a0 = (ip == c) ? 1.f : 0.f, a1 = 0.f;
#pragma unroll
                for (int q = 0; q < (ip + 3) / 4; ++q) {
#pragma unroll
                    for (int e = 0; e < 4; ++e) { const int jp = 4 * q + e; if (jp < ip) { if (e & 1) a1 -= cur[q][e] * x[jp]; else a0 -= cur[q][e] * x[jp]; } }
                }
                x[ip] = a0 + a1;
                __builtin_amdgcn_sched_barrier(0);
            }
            bf16* ti = TINV + (size_t)(item * 2 + d) * 4096;
            const int j = d ? 63 - c : c;
#pragma unroll
            for (int ip = 0; ip < 64; ++ip) { const int i = d ? 63 - ip : ip; ti[i * 64 + j] = (bf16)f2bf(x[ip]); }
        }
        __syncthreads();
    }
}

DI int dn_perm(int m, int t) { return 32 * (t >> 1) + 8 * (m >> 2) + 4 * (t & 1) + (m & 3); }
DI int dn_swz16(int row, int chunk) { return row * 272 + (chunk << 4); }
DI int dn_swz8(int row, int chunk) { return row * 144 + (chunk << 4); }
#define DN_BAR() do { asm volatile("s_waitcnt lgkmcnt(0)" ::: "memory"); __builtin_amdgcn_s_barrier(); asm volatile("" ::: "memory"); } while (0)
DI void phase_dn_scan(Frame& F) {
    LAS unsigned char* L = F.lds;
    constexpr int KS = 0, QS = 17408, KTS = 34816, TIS = 53248, VS = 62464, VCS = 66560, BUF = 68096;
    constexpr int PUBS = 2 * BUF, PUBV = PUBS + 16384;
    static_assert(PUBV + 8192 <= LDS_BYTES - 64, "scan LDS map");
    const int G8 = F.G >> 3;
    const int li = blockIdx.x >> 3, chain = (blockIdx.x & 7) * (G8 >> 2) + (li >> 2), qd = li & 3;
    if (F.G != 256 || chain >= 64) return;
    const int dir = chain >> 5, b = (chain >> 3) & 3, h = chain & 7;
    const bf16* DQ = (const bf16*)(F.ws + WS_DQ); const bf16* DK = (const bf16*)(F.ws + WS_DK); const bf16* DV = (const bf16*)(F.ws + WS_DV);
    const bf16* KT = (const bf16*)(F.ws + WS_KT); const bf16* TINV = (const bf16*)(F.ws + WS_TINV); const bf16* QKO = (const bf16*)(F.ws + WS_QKO); const float* VEC = (const float*)(F.ws + WS_VEC);
    bf16* ODN = (bf16*)(F.ws + WS_ODN);
    const int tid = F.tid, lane = F.lane, w = F.wave, fr = lane & 15, fq = lane >> 4;
#ifndef DN_NSTEP
#define DN_NSTEP 68
#endif
#define DN_CC1(st) (dir == 0 ? (st) : ((st) < 4 ? 3 - (st) : 71 - (st)))
#define DN_CC(step) DN_CC1((step) % 68)
#define AF16(base, row, kchunk) (*(const LAS bf16x8_t*)(Lb + (base) + dn_swz16((row), (kchunk))))
#define AF8(base, row, kchunk) (*(const LAS bf16x8_t*)(Lb + (base) + dn_swz8((row), (kchunk))))
    if (w >= 4) {
        const int lt = tid - 256;
        u32x4 preA[16], preB[16];
#define DN_LOAD(pre, cc_) do { const int cc__ = (cc_); const int item__ = (b * 8 + h) * 68 + cc__, cd__ = item__ * 2 + dir; \
        _Pragma("unroll") for (int k = 0; k < 16; ++k) { const bf16* src; \
            if (k < 4)       { const int q = lt + 256 * k;        src = DK + (size_t)item__ * 8192 + q * 8; } \
            else if (k < 8)  { const int q = lt + 256 * (k - 4);  src = DQ + (size_t)item__ * 8192 + q * 8; } \
            else if (k < 12) { const int q = lt + 256 * (k - 8);  src = KT + (size_t)item__ * 8192 + q * 8; } \
            else if (k < 14) { const int q = lt + 256 * (k - 12); src = TINV + (size_t)cd__ * 4096 + q * 8; } \
            else if (k == 14) { src = DV + (size_t)item__ * 8192 + (lt >> 2) * 128 + qd * 32 + (lt & 3) * 8; } \
            else { src = (const bf16*)(VEC + (size_t)cd__ * 320 + (lt < 80 ? lt : 0) * 4); } \
            pre[k] = *(const u32x4*)src; } } while (0)
#define DN_STORE(pre, bufo_) do { const int bo__ = (bufo_); _Pragma("unroll") for (int k = 0; k < 16; ++k) { int dst; \
            if (k < 4)       { const int q = lt + 256 * k;        dst = KS + dn_swz16(q >> 4, q & 15); } \
            else if (k < 8)  { const int q = lt + 256 * (k - 4);  dst = QS + dn_swz16(q >> 4, q & 15); } \
            else if (k < 12) { const int q = lt + 256 * (k - 8);  dst = KTS + dn_swz8(q >> 3, q & 7); } \
            else if (k < 14) { const int q = lt + 256 * (k - 12); dst = TIS + dn_swz8(q >> 3, q & 7); } \
            else if (k == 14) { dst = VS + lt * 16; } \
            else { dst = VCS + (lt < 80 ? lt : 0) * 16; } \
            *(LAS u32x4*)(L + bo__ + dst) = pre[k]; } } while (0)
#ifdef DN_SKIP_LOAD
#define DN_CLAMP(ds) ((ds) < DN_NSTEP - 70 ? 0 : (ds) < DN_NSTEP ? (ds) : DN_NSTEP - 1)
#else
#define DN_CLAMP(ds) ((ds) < DN_NSTEP ? (ds) : DN_NSTEP - 1)
#endif
#ifndef DN_SLEEP
#define DN_SLEEP 8
#endif
#define DN_LDELAY() __builtin_amdgcn_s_sleep(DN_SLEEP)
        DN_LOAD(preA, DN_CC(0)); DN_STORE(preA, 0); DN_LOAD(preA, DN_CC(1)); DN_LOAD(preB, DN_CC(2));
        DN_BAR();
        for (int step = 0; step < DN_NSTEP; step += 2) {
            DN_LDELAY(); DN_STORE(preA, BUF); DN_LOAD(preA, DN_CC(DN_CLAMP(step + 3)));
            DN_BAR();
            DN_LDELAY(); DN_STORE(preB, 0); DN_LOAD(preB, DN_CC(DN_CLAMP(step + 4)));
            DN_BAR();
        }
#undef DN_CLAMP
#undef DN_LOAD
#undef DN_STORE
    } else if (w >= 2) {
        const int pw = w - 2;
        bf16x8_t qkA[2][4], qkB[2][4];
        f32x4 O[4];
#define DN_QKLOAD(dst, st_) do { const int cd__ = ((b * 8 + h) * 68 + DN_CC(st_)) * 2 + dir; \
        _Pragma("unroll") for (int s = 0; s < 2; ++s) _Pragma("unroll") for (int mt = 0; mt < 4; ++mt) \
            dst[s][mt] = *(const bf16x8_t*)(QKO + (size_t)cd__ * 4096 + dn_perm(fr, mt) * 64 + (4 * s + fq) * 8); } while (0)
#define DN_OFIN(qk, st_) do { const int st__ = (st_); const LAS unsigned char* pv = L + PUBV + (st__ & 1) * 4096 + pw * 2048 + lane * 16; \
        const bf16x8_t vb0 = *(const LAS bf16x8_t*)pv, vb1 = *(const LAS bf16x8_t*)(pv + 1024); \
        _Pragma("unroll") for (int mt = 0; mt < 4; ++mt) { O[mt] = MFMA16(vb0, qk[0][mt], O[mt]); O[mt] = MFMA16(vb1, qk[1][mt], O[mt]); } \
        const int cc__ = DN_CC(st__); \
        if (cc__ >= 4) { bf16* orow = ODN + ((size_t)dir * NT + dn_row0(b, cc__)) * 1024 + h * 128 + qd * 32 + 16 * pw + 4 * fq; \
            _Pragma("unroll") for (int mt = 0; mt < 4; ++mt) { u32x2 w2; w2.x = pk2(O[mt][0], O[mt][1]); w2.y = pk2(O[mt][2], O[mt][3]); \
                *(u32x2*)(orow + (size_t)dn_perm(fr, mt) * 1024) = w2; } } } while (0)
#define DN_OBEG(st_) do { const int st__ = (st_); const LAS unsigned char* Lb = L + (st__ & 1) * BUF; const LAS unsigned char* ps = L + PUBS + (st__ & 1) * 8192 + pw * 4096 + lane * 16; \
        bf16x8_t sb[4], qa[4][4]; \
        _Pragma("unroll") for (int s = 0; s < 4; ++s) sb[s] = *(const LAS bf16x8_t*)(ps + s * 1024); \
        _Pragma("unroll") for (int s = 0; s < 4; ++s) _Pragma("unroll") for (int mt = 0; mt < 4; ++mt) qa[s][mt] = AF16(QS, dn_perm(fr, mt), 4 * s + fq); \
        _Pragma("unroll") for (int mt = 0; mt < 4; ++mt) O[mt] = (f32x4){0.f, 0.f, 0.f, 0.f}; \
        _Pragma("unroll") for (int s = 0; s < 4; ++s) _Pragma("unroll") for (int mt = 0; mt < 4; ++mt) O[mt] = MFMA16(sb[s], qa[s][mt], O[mt]); \
        const LAS float* vc = (const LAS float*)(Lb + VCS); \
        _Pragma("unroll") for (int mt = 0; mt < 4; ++mt) { const float eg = vc[64 + dn_perm(fr, mt)]; O[mt] = O[mt] * eg; } } while (0)
        DN_QKLOAD(qkA, 0); DN_QKLOAD(qkB, 1);
        DN_BAR();
        DN_OBEG(0);
        DN_BAR();
        for (int step = 0; step < DN_NSTEP - 2; step += 2) {
#ifdef DN_SKIP_OUT
            if (step < DN_NSTEP - 70) { DN_BAR(); DN_BAR(); continue; }
#endif
            DN_OFIN(qkA, step); DN_QKLOAD(qkA, step + 2);
            DN_OBEG(step + 1);
            DN_BAR();
            DN_OFIN(qkB, step + 1); DN_QKLOAD(qkB, step + 3);
            DN_OBEG(step + 2);
            DN_BAR();
        }
        DN_OFIN(qkA, DN_NSTEP - 2);
        DN_OBEG(DN_NSTEP - 1);
        DN_BAR();
        DN_OFIN(qkB, DN_NSTEP - 1);
#undef DN_QKLOAD
#undef DN_OFIN
#undef DN_OBEG
    } else {
        f32x4 S[8];
#pragma unroll
        for (int j = 0; j < 8; ++j) S[j] = (f32x4){0.f, 0.f, 0.f, 0.f};
        bf16x8_t sb[4];
#pragma unroll
        for (int s = 0; s < 4; ++s) { sb[s] = dn_bpack(S[2 * s], S[2 * s + 1]); *(LAS bf16x8_t*)(L + PUBS + w * 4096 + s * 1024 + lane * 16) = sb[s]; }
        DN_BAR();
        for (int step = 0; step < DN_NSTEP; ++step) {
#ifdef DN_SKIP_COMP
            if (step < DN_NSTEP - 69) { DN_BAR(); continue; }
#endif
            const LAS unsigned char* Lb = L + (step & 1) * BUF;
            f32x4 P[4];
#pragma unroll
            for (int mt = 0; mt < 4; ++mt) P[mt] = (f32x4){0.f, 0.f, 0.f, 0.f};
            {
                bf16x8_t ka[4][4];
#pragma unroll
                for (int s = 0; s < 4; ++s)
#pragma unroll
                    for (int mt = 0; mt < 4; ++mt) ka[s][mt] = AF16(KS, dn_perm(fr, mt), 4 * s + fq);
                __builtin_amdgcn_sched_barrier(0);
#pragma unroll
                for (int s = 0; s < 4; ++s)
#pragma unroll
                    for (int mt = 0; mt < 4; ++mt) P[mt] = MFMA16(ka[s][mt], sb[s], P[mt]);
            }
            bf16x8_t tia[2][4];
#pragma unroll
            for (int s = 0; s < 2; ++s)
#pragma unroll
                for (int mt = 0; mt < 4; ++mt) tia[s][mt] = AF8(TIS, dn_perm(fr, mt), 4 * s + fq);
            const LAS float* vc = (const LAS float*)(Lb + VCS);
            f32x4 R[4];
#pragma unroll
            for (int mt = 0; mt < 4; ++mt) {
                const int tk0 = 32 * (mt >> 1) + 8 * fq + 4 * (mt & 1);
                const f32x4 bt = *(const LAS f32x4*)(vc + tk0), bg = *(const LAS f32x4*)(vc + 128 + tk0);
#pragma unroll
                for (int r = 0; r < 4; ++r) {
                    const float v = bf2f(*(const LAS unsigned short*)(Lb + VS + (tk0 + r) * 64 + (16 * w + fr) * 2));
                    R[mt][r] = v * bt[r] - bg[r] * P[mt][r];
                }
            }
            const bf16x8_t rb0 = dn_bpack(R[0], R[1]), rb1 = dn_bpack(R[2], R[3]);
            f32x4 VN[4];
#pragma unroll
            for (int mt = 0; mt < 4; ++mt) {
                VN[mt] = (f32x4){0.f, 0.f, 0.f, 0.f};
                VN[mt] = MFMA16(tia[0][mt], rb0, VN[mt]);
                VN[mt] = MFMA16(tia[1][mt], rb1, VN[mt]);
            }
            bf16x8_t kta[2][8];
#pragma unroll
            for (int s = 0; s < 2; ++s)
#pragma unroll
                for (int jt = 0; jt < 8; ++jt) kta[s][jt] = AF8(KTS, dn_perm(fr, jt), 4 * s + fq);
            {
                const bf16x8_t vb0 = dn_bpack(VN[0], VN[1]), vb1 = dn_bpack(VN[2], VN[3]);
                LAS unsigned char* pv = L + PUBV + (step & 1) * 4096 + w * 2048 + lane * 16;
                *(LAS bf16x8_t*)pv = vb0; *(LAS bf16x8_t*)(pv + 1024) = vb1;
            }
#pragma unroll
            for (int mt = 0; mt < 4; ++mt) { const f32x4 ek = *(const LAS f32x4*)(vc + 192 + 32 * (mt >> 1) + 8 * fq + 4 * (mt & 1)); VN[mt] = VN[mt] * ek; }
            const bf16x8_t vs0 = dn_bpack(VN[0], VN[1]), vs1 = dn_bpack(VN[2], VN[3]);
            const float egl = vc[256];
#pragma unroll
            for (int jt = 0; jt < 8; ++jt) {
                S[jt] = S[jt] * egl;
                S[jt] = MFMA16(kta[0][jt], vs0, S[jt]);
                S[jt] = MFMA16(kta[1][jt], vs1, S[jt]);
            }
            if (DN_NSTEP > 68 && step % 68 == 67) {
#pragma unroll
                for (int j = 0; j < 8; ++j) S[j] = (f32x4){0.f, 0.f, 0.f, 0.f};
            }
#pragma unroll
            for (int s = 0; s < 4; ++s) { sb[s] = dn_bpack(S[2 * s], S[2 * s + 1]); *(LAS bf16x8_t*)(L + PUBS + ((step + 1) & 1) * 8192 + w * 4096 + s * 1024 + lane * 16) = sb[s]; }
            DN_BAR();
        }
    }
#undef AF16
#undef AF8
#undef DN_CC
#undef DN_CC1
}

DI void phase_attention(Frame& F, char* lds_generic) {
    bf16* QN = (bf16*)(F.ws + WS_QN); const bf16* KB = (const bf16*)(F.ws + WS_KB); const bf16* VB = (const bf16*)(F.ws + WS_VB);
    for (int it = F.vcu; it < 512; it += F.G) {
        const int b = it >> 7, kvh = (it >> 6) & 1, g = (it >> 4) & 3, qb = it & 15, h = kvh * 4 + g;
        bf16* Qb = QN + ((size_t)(b * TS + qb * 256) * 1024 + h * 128);
        const bf16* Kh = KB + ((size_t)b * LKV * 256 + kvh * 128); const bf16* Vh = VB + ((size_t)b * LKV * 256 + kvh * 128);
#ifdef ATTN_PROBE
#pragma nounroll
        for (int rep_ = 0; rep_ < 2; ++rep_) {
            bf16* Ob = rep_ == 0 ? (bf16*)(F.ws + WS_END) + ((size_t)(b * TS + qb * 256) * 1024 + h * 128) : Qb;
            attn::attn_dense_body<attn::bf16>(Qb, Kh, Vh, Ob, LKV, lds_generic);
            __syncthreads();
        }
#else
        attn::attn_dense_body<attn::bf16>(Qb, Kh, Vh, Qb, LKV, lds_generic);
        __syncthreads();
#endif
    }
}

DI void phase_mergeprep(Frame& F) {
    const bf16* ODN = (const bf16*)(F.ws + WS_ODN); bf16* Z = (bf16*)(F.ws + WS_Z); const int lane = F.lane;
    float nw[16];
#pragma unroll
    for (int k = 0; k < 4; ++k) { const f32x4 v = *(const f32x4*)(F.in[14] + (lane & 7) * 16 + 4 * k); nw[4 * k] = v[0]; nw[4 * k + 1] = v[1]; nw[4 * k + 2] = v[2]; nw[4 * k + 3] = v[3]; }
    for (int t = F.gw; t < NT; t += F.NGW) {
        const size_t off = (size_t)t * 1024 + 16 * lane;
        u32x4 a[2], c[2], z[2];
#pragma unroll
        for (int k = 0; k < 2; ++k) { a[k] = __builtin_nontemporal_load((const u32x4*)(ODN + off + 8 * k)); c[k] = __builtin_nontemporal_load((const u32x4*)(ODN + (size_t)NT * 1024 + off + 8 * k)); z[k] = __builtin_nontemporal_load((const u32x4*)(Z + off + 8 * k)); }
        float o[16]; float ss = 0.f;
#pragma unroll
        for (int k = 0; k < 2; ++k)
#pragma unroll
            for (int i = 0; i < 4; ++i) { o[8 * k + 2 * i] = bflo(a[k][i]) + bflo(c[k][i]); o[8 * k + 2 * i + 1] = bfhi(a[k][i]) + bfhi(c[k][i]); }
#pragma unroll
        for (int i = 0; i < 16; ++i) ss += o[i] * o[i];
        ss += __shfl_xor(ss, 1); ss += __shfl_xor(ss, 2); ss += __shfl_xor(ss, 4);
        const float rstd = rsqrtf(ss * (1.f / 128.f) + EPS);
        if (MERGE_F8_B) {
            float y[16];
#pragma unroll
            for (int k = 0; k < 2; ++k)
#pragma unroll
                for (int i = 0; i < 4; ++i) { y[8 * k + 2 * i] = o[8 * k + 2 * i] * rstd * nw[8 * k + 2 * i] * silu(bflo(z[k][i])); y[8 * k + 2 * i + 1] = o[8 * k + 2 * i + 1] * rstd * nw[8 * k + 2 * i + 1] * silu(bfhi(z[k][i])); }
            u32x4 w;
#pragma unroll
            for (int q = 0; q < 4; ++q) w[q] = pk4_fp8(fp8c(y[4 * q] * ODNN_SCALE), fp8c(y[4 * q + 1] * ODNN_SCALE), fp8c(y[4 * q + 2] * ODNN_SCALE), fp8c(y[4 * q + 3] * ODNN_SCALE));
            *(u32x4*)(F.ws + WS_ODNN8 + off) = w;
        } else {
#pragma unroll
        for (int k = 0; k < 2; ++k) {
            u32x4 w;
#pragma unroll
            for (int i = 0; i < 4; ++i) w[i] = pk2(o[8 * k + 2 * i] * rstd * nw[8 * k + 2 * i] * silu(bflo(z[k][i])), o[8 * k + 2 * i + 1] * rstd * nw[8 * k + 2 * i + 1] * silu(bfhi(z[k][i])));
            *(u32x4*)(Z + off + 8 * k) = w;
        }
        }
        if (MERGE_F8_A) {
            const bf16* OA = (const bf16*)(F.ws + WS_QN);
            const u32x4 a0 = __builtin_nontemporal_load((const u32x4*)(OA + off)), a1 = __builtin_nontemporal_load((const u32x4*)(OA + off + 8));
            u32x4 w;
            w[0] = pk4_fp8(fp8c(bflo(a0.x) * OATT_SCALE), fp8c(bfhi(a0.x) * OATT_SCALE), fp8c(bflo(a0.y) * OATT_SCALE), fp8c(bfhi(a0.y) * OATT_SCALE));
            w[1] = pk4_fp8(fp8c(bflo(a0.z) * OATT_SCALE), fp8c(bfhi(a0.z) * OATT_SCALE), fp8c(bflo(a0.w) * OATT_SCALE), fp8c(bfhi(a0.w) * OATT_SCALE));
            w[2] = pk4_fp8(fp8c(bflo(a1.x) * OATT_SCALE), fp8c(bfhi(a1.x) * OATT_SCALE), fp8c(bflo(a1.y) * OATT_SCALE), fp8c(bfhi(a1.y) * OATT_SCALE));
            w[3] = pk4_fp8(fp8c(bflo(a1.z) * OATT_SCALE), fp8c(bfhi(a1.z) * OATT_SCALE), fp8c(bflo(a1.w) * OATT_SCALE), fp8c(bfhi(a1.w) * OATT_SCALE));
            *(u32x4*)(F.ws + WS_OATT8 + off) = w;
        }
    }
}

DI void tk_insert(unsigned (&a)[16], unsigned x) {
#pragma unroll
    for (int i = 0; i < 16; ++i) { const unsigned hi = a[i] > x ? a[i] : x; x = a[i] > x ? x : a[i]; a[i] = hi; }
}
template <int N> DI void tk_sort_desc(unsigned (&a)[N]) {
#pragma unroll
    for (int k = 2; k <= N; k <<= 1)
#pragma unroll
        for (int j = k >> 1; j > 0; j >>= 1)
#pragma unroll
            for (int i = 0; i < N; ++i) {
                const int l = i ^ j;
                if (l > i) {
                    const unsigned lo = a[i] < a[l] ? a[i] : a[l], hi = a[i] < a[l] ? a[l] : a[i];
                    if ((i & k) == 0) { a[i] = hi; a[l] = lo; } else { a[i] = lo; a[l] = hi; }
                }
            }
}
DI void tk_sort_bitonic(unsigned (&c)[16]) {
#pragma unroll
    for (int s = 8; s >= 1; s >>= 1)
#pragma unroll
        for (int i = 0; i < 16; ++i) if ((i & s) == 0) { const unsigned lo = c[i] < c[i + s] ? c[i] : c[i + s], hi = c[i] < c[i + s] ? c[i + s] : c[i]; c[i] = hi; c[i + s] = lo; }
}
template <bool SORT> DI void tk_merge(unsigned (&a)[16], int m) {
    unsigned b[16];
#pragma unroll
    for (int i = 0; i < 16; ++i) b[i] = (unsigned)__shfl_xor((int)a[15 - i], m);
#pragma unroll
    for (int i = 0; i < 16; ++i) a[i] = a[i] > b[i] ? a[i] : b[i];
    if (SORT) tk_sort_bitonic(a);
}
DI float tk_unkey(unsigned k) { const unsigned u = (k & 0x80000000u) ? (k & 0x7fffffffu) : ~k; return __uint_as_float(u); }

DI void phase_peer_topk(Frame& F) {
    LAS unsigned char* L = F.lds;
    constexpr int KS = 0, QS = 69632, SC = 69632, TOP = 137216, FIN = 139264, PT = 140288;
    const bf16* PQ = (const bf16*)(F.ws + WS_PQ); const bf16* SUBK = (const bf16*)(F.ws + WS_SUBK);
    int* EXPI = (int*)(F.ws + WS_EXPI); float* EXPG = (float*)(F.ws + WS_EXPG);
    const int tid = F.tid, lane = F.lane, w = F.wave, fr = lane & 15, fq = lane >> 4;
    LAS float* sc = (LAS float*)(L + SC); LAS unsigned char* top = L + TOP; LAS unsigned char* finb = L + FIN; LAS int* pt = (LAS int*)(L + PT);
    if (tid < 56) {
        int n = tid, pi = -1;
#pragma unroll
        for (int i = 0; i < 16; ++i) { const int cnt = 16 / (i + 1); if (pi < 0) { if (n < cnt) pi = i * 16 + n; else n -= cnt; } }
        pt[tid] = tid < 50 ? pi : -1;
    }
    int hcur = -1;
    u32x4 qpre[4];
    if (F.vcu < (NT / 64) * 8) {
        const int h0 = F.vcu & 7, tq = (F.vcu >> 3) * 64;
#pragma unroll
        for (int k = 0; k < 4; ++k) { const int c = tid + 512 * k; qpre[k] = __builtin_nontemporal_load((const u32x4*)(PQ + (size_t)(tq + (c >> 5)) * 2048 + h0 * 256 + (c & 31) * 8)); }
    }
    for (int it = F.vcu; it < (NT / 64) * 8; it += F.G) {
        const int h = it & 7, tile = it >> 3, t0 = tile * 64;
        RAW_BAR();
        if (h != hcur) {
#pragma unroll
            for (int k = 0; k < 8; ++k) { const int c = tid + 512 * k, row = c >> 4, c16 = c & 15;
                *(LAS u32x4*)(L + KS + row * 272 + c16 * 16) = *(const u32x4*)(SUBK + (size_t)h * 32768 + row * 128 + c16 * 8); }
            hcur = h;
        }
#pragma unroll
        for (int k = 0; k < 4; ++k) { const int c = tid + 512 * k, row = c >> 5, c16 = c & 31; *(LAS u32x4*)(L + QS + row * 528 + c16 * 16) = qpre[k]; }
        if (it + F.G < (NT / 64) * 8) {
            const int itn = it + F.G, hn = itn & 7, tn = (itn >> 3) * 64;
#pragma unroll
            for (int k = 0; k < 4; ++k) { const int c = tid + 512 * k; qpre[k] = __builtin_nontemporal_load((const u32x4*)(PQ + (size_t)(tn + (c >> 5)) * 2048 + hn * 256 + (c & 31) * 8)); }
        }
        RAW_BAR();
        const int p = w >> 2, n0 = (w & 3) * 32;
        f32x4 acc[4][2];
#pragma unroll
        for (int mt = 0; mt < 4; ++mt) { acc[mt][0] = (f32x4){0.f, 0.f, 0.f, 0.f}; acc[mt][1] = (f32x4){0.f, 0.f, 0.f, 0.f}; }
#pragma unroll
        for (int s = 0; s < 4; ++s) {
            const bf16x8_t b0 = *(const LAS bf16x8_t*)(L + KS + (p * 128 + n0 + fr) * 272 + (32 * s + 8 * fq) * 2);
            const bf16x8_t b1 = *(const LAS bf16x8_t*)(L + KS + (p * 128 + n0 + 16 + fr) * 272 + (32 * s + 8 * fq) * 2);
#pragma unroll
            for (int mt = 0; mt < 4; ++mt) {
                const bf16x8_t a = *(const LAS bf16x8_t*)(L + QS + (16 * mt + fr) * 528 + (p * 128 + 32 * s + 8 * fq) * 2);
                acc[mt][0] = MFMA16(a, b0, acc[mt][0]); acc[mt][1] = MFMA16(a, b1, acc[mt][1]);
            }
        }
        RAW_BAR();
#pragma unroll
        for (int mt = 0; mt < 4; ++mt)
#pragma unroll
            for (int nt = 0; nt < 2; ++nt)
#pragma unroll
                for (int r = 0; r < 4; ++r) sc[((16 * mt + 4 * fq + r) * 2 + p) * 132 + (w & 3) * 33 + 16 * nt + fr] = acc[mt][nt][r];
        RAW_BAR();
        {
            const int list = tid >> 2, q = tid & 3;
            unsigned a32[32];
            const LAS float* sp = sc + list * 132 + q * 33;
#pragma unroll
            for (int i = 0; i < 32; ++i) a32[i] = (okey(sp[i]) & ~0x7Fu) | (unsigned)(q * 32 + i);
            tk_sort_desc<32>(a32);
            unsigned a[16];
#pragma unroll
            for (int i = 0; i < 16; ++i) a[i] = a32[i];
            tk_merge<true>(a, 1); tk_merge<true>(a, 2);
            if (q == 0) {
                u32x4 v;
#pragma unroll
                for (int k = 0; k < 4; ++k) v[k] = (a[4 * k] & 127u) | ((a[4 * k + 1] & 127u) << 8) | ((a[4 * k + 2] & 127u) << 16) | ((a[4 * k + 3] & 127u) << 24);
                *(LAS u32x4*)(top + list * 16) = v;
            }
        }
        RAW_BAR();
        {
            const int tok = tid >> 3, r8 = tid & 7;
            unsigned c8[8]; c8[7] = 0u;
#pragma unroll
            for (int m = 0; m < 7; ++m) {
                const int pr = pt[r8 + 8 * m];
                unsigned ck = 0u;
                if (pr >= 0) {
                    const int ia = top[(tok * 2) * 16 + (pr >> 4)], ib = top[(tok * 2 + 1) * 16 + (pr & 15)];
                    const float cs = sc[(tok * 2) * 132 + (ia >> 5) * 33 + (ia & 31)] + sc[(tok * 2 + 1) * 132 + (ib >> 5) * 33 + (ib & 31)];
                    ck = (okey(cs) & ~0xFFu) | (unsigned)pr;
                }
                c8[m] = ck;
            }
            tk_sort_desc<8>(c8);
            unsigned a[16];
#pragma unroll
            for (int i = 0; i < 16; ++i) a[i] = i < 8 ? c8[i] : 0u;
            tk_merge<true>(a, 1); tk_merge<true>(a, 2); tk_merge<true>(a, 4);
            LAS unsigned char* fin = finb + tok * 16;
            if (r8 == 0) {
                u32x4 v;
#pragma unroll
                for (int k = 0; k < 4; ++k) v[k] = (a[4 * k] & 255u) | ((a[4 * k + 1] & 255u) << 8) | ((a[4 * k + 2] & 255u) << 16) | ((a[4 * k + 3] & 255u) << 24);
                *(LAS u32x4*)fin = v;
            }
            asm volatile("s_waitcnt lgkmcnt(0)" ::: "memory");
            float bs[2]; int ex[2];
#pragma unroll
            for (int e = 0; e < 2; ++e) {
                const unsigned pr = fin[2 * r8 + e];
                const int ia = top[(tok * 2) * 16 + (pr >> 4)], ib = top[(tok * 2 + 1) * 16 + (pr & 15u)];
                bs[e] = sc[(tok * 2) * 132 + (ia >> 5) * 33 + (ia & 31)] + sc[(tok * 2 + 1) * 132 + (ib >> 5) * 33 + (ib & 31)];
                ex[e] = ia * 128 + ib;
            }
            float mx = fmaxf(bs[0], bs[1]);
            mx = fmaxf(mx, __shfl_xor(mx, 1)); mx = fmaxf(mx, __shfl_xor(mx, 2)); mx = fmaxf(mx, __shfl_xor(mx, 4));
            const float e0 = __expf(bs[0] - mx), e1 = __expf(bs[1] - mx);
            float sm = e0 + e1; sm += __shfl_xor(sm, 1); sm += __shfl_xor(sm, 2); sm += __shfl_xor(sm, 4);
            const float rs = 1.f / sm;
            const size_t o = (size_t)(t0 + tok) * 128 + h * 16 + 2 * r8;
            *(int2*)(EXPI + o) = make_int2(ex[0], ex[1]);
            *(float2*)(EXPG + o) = make_float2(e0 * rs, e1 * rs);
        }
    }
}

DI float ub0(unsigned w) { float r; asm("v_cvt_f32_ubyte0 %0, %1" : "=v"(r) : "v"(w)); return r; }
DI float ub1(unsigned w) { float r; asm("v_cvt_f32_ubyte1 %0, %1" : "=v"(r) : "v"(w)); return r; }
DI float ub2(unsigned w) { float r; asm("v_cvt_f32_ubyte2 %0, %1" : "=v"(r) : "v"(w)); return r; }
DI float ub3(unsigned w) { float r; asm("v_cvt_f32_ubyte3 %0, %1" : "=v"(r) : "v"(w)); return r; }
DI float wave_maxf(float v) {
#pragma unroll
    for (int o = 1; o < 64; o <<= 1) v = fmaxf(v, __shfl_xor(v, o));
    return v;
}
template <int BIAS> DI void quant_rows(const float* src, unsigned char* dst, float* scale, int gw, int NGW, int lane) {
    for (int row = gw; row < NEXP; row += NGW) {
        f32x4 v[8]; float am = 0.f;
#pragma unroll
        for (int j = 0; j < 8; ++j) { v[j] = __builtin_nontemporal_load((const f32x4*)(src + (size_t)row * DM) + lane + 64 * j); am = fmaxf(am, fmaxf(fmaxf(fabsf(v[j][0]), fabsf(v[j][1])), fmaxf(fabsf(v[j][2]), fabsf(v[j][3])))); }
        am = wave_maxf(am);
        const float inv = am > 0.f ? 127.f / am : 0.f;
#pragma unroll
        for (int j = 0; j < 8; ++j) {
            unsigned w = 0;
#pragma unroll
            for (int i = 0; i < 4; ++i) { const int q = (int)rintf(v[j][i] * inv) + BIAS; w |= ((unsigned)q & 0xffu) << (8 * i); }
            *((unsigned*)(dst + (size_t)row * DM) + lane + 64 * j) = w;
        }
        if (lane == 0) scale[row] = am * (1.f / 127.f);
    }
}


constexpr int V4_ROW = 1152;
DI void quant_rows_i4(const float* __restrict__ src, unsigned char* __restrict__ dst, int gw, int NGW, int lane) {
#pragma unroll 2
    for (int row = gw; row < NEXP; row += NGW) {
        f32x4 vv[8];
#pragma unroll
        for (int j = 0; j < 8; ++j) vv[j] = __builtin_nontemporal_load((const f32x4*)(src + (size_t)row * DM) + lane + 64 * j);
#pragma unroll
        for (int j = 0; j < 8; ++j) {
            const f32x4 v = vv[j];
            float am = fmaxf(fmaxf(fabsf(v[0]), fabsf(v[1])), fmaxf(fabsf(v[2]), fabsf(v[3])));
            am = fmaxf(am, __shfl_xor(am, 1)); am = fmaxf(am, __shfl_xor(am, 2)); am = fmaxf(am, __shfl_xor(am, 4));
            const unsigned sb = f2bf(am * (1.f / 7.f)); const float s = __uint_as_float(sb << 16), inv = s > 0.f ? __builtin_amdgcn_rcpf(s) : 0.f;
            unsigned w = 0;
#pragma unroll
            for (int i = 0; i < 4; ++i) { const int q = (int)fminf(fmaxf(rintf(v[i] * inv), -7.f), 7.f) + 8; w |= (unsigned)q << (4 * i); }
            const int grp = j * 8 + (lane >> 3);
            *(unsigned short*)(dst + (size_t)row * V4_ROW + grp * 16 + (lane & 7) * 2) = (unsigned short)w;
            *(unsigned short*)(dst + (size_t)row * V4_ROW + 1024 + grp * 2) = (unsigned short)sb;
        }
    }
}

DI void quant_u_both(const float* __restrict__ src, unsigned char* __restrict__ d8, float* __restrict__ scale, unsigned char* __restrict__ d4, int gw, int NGW, int lane) {
#pragma unroll 2
    for (int row = gw; row < NEXP; row += NGW) {
        f32x4 v[8]; float am = 0.f;
#pragma unroll
        for (int j = 0; j < 8; ++j) { v[j] = __builtin_nontemporal_load((const f32x4*)(src + (size_t)row * DM) + lane + 64 * j); am = fmaxf(am, fmaxf(fmaxf(fabsf(v[j][0]), fabsf(v[j][1])), fmaxf(fabsf(v[j][2]), fabsf(v[j][3])))); }
        const float rowmax = wave_maxf(am), inv8 = rowmax > 0.f ? 127.f / rowmax : 0.f;
#pragma unroll
        for (int j = 0; j < 8; ++j) {
            unsigned w8 = 0;
#pragma unroll
            for (int i = 0; i < 4; ++i) { const int q = (int)rintf(v[j][i] * inv8); w8 |= ((unsigned)q & 0xffu) << (8 * i); }
            *((unsigned*)(d8 + (size_t)row * DM) + lane + 64 * j) = w8;
            float gm = fmaxf(fmaxf(fabsf(v[j][0]), fabsf(v[j][1])), fmaxf(fabsf(v[j][2]), fabsf(v[j][3])));
            gm = fmaxf(gm, __shfl_xor(gm, 1)); gm = fmaxf(gm, __shfl_xor(gm, 2)); gm = fmaxf(gm, __shfl_xor(gm, 4));
            const unsigned sb = f2bf(gm * (1.f / 7.f)); const float s = __uint_as_float(sb << 16), inv = s > 0.f ? __builtin_amdgcn_rcpf(s) : 0.f;
            unsigned w = 0;
#pragma unroll
            for (int i = 0; i < 4; ++i) { const int q = (int)fminf(fmaxf(rintf(v[j][i] * inv), -7.f), 7.f) + 8; w |= (unsigned)q << (4 * i); }
            const int grp = j * 8 + (lane >> 3);
            *(unsigned short*)(d4 + (size_t)row * V4_ROW + grp * 16 + (lane & 7) * 2) = (unsigned short)w;
            *(unsigned short*)(d4 + (size_t)row * V4_ROW + 1024 + grp * 2) = (unsigned short)sb;
        }
        if (lane == 0) scale[row] = rowmax * (1.f / 127.f);
    }
}

DI void phase_peer_gather(Frame& F, int emask = 0x3fff, int vmask = 0x3fff) {
    const bf16* H2 = (const bf16*)(F.ws + WS_H2);
    const unsigned char* U8 = F.ws + WS_U8; const unsigned char* U4 = F.ws + WS_U4; const unsigned char* V4 = F.ws + WS_V8; const float* SU = (const float*)(F.ws + WS_SU);
    const int* EXPI = (const int*)(F.ws + WS_EXPI); const float* EXPG = (const float*)(F.ws + WS_EXPG);
    const bf16* X1 = (const bf16*)(F.ws + WS_X1); const float* MOD = (const float*)(F.ws + WS_MOD); const int lane = F.lane;
    LAS float* la = (LAS float*)(F.lds + F.wave * 1024);
    LAS int* li = (LAS int*)(F.lds + F.wave * 1024 + 512);
    const int eloc = ((lane >> 5) & 1) * 4 + ((lane >> 4) & 1) * 2 + ((lane >> 3) & 1);
#ifdef GATHER_SUBSET
    if ((blockIdx.x >> 3) % GATHER_SUBSET != 0) return;
    const int gw_ = ((blockIdx.x >> 3) / GATHER_SUBSET * 8 + (blockIdx.x & 7)) * NWAVES + F.wave, ngw_ = F.NGW / GATHER_SUBSET;
#else
    const int gw_ = F.gw, ngw_ = F.NGW;
#endif
    for (int t = gw_; t < NT; t += ngw_) {
        float xf[2][16]; float am = 0.f;
#pragma unroll
        for (int j = 0; j < 2; ++j) {
            const u32x4 w0 = *((const u32x4*)(H2 + (size_t)t * DM) + 2 * (lane + 64 * j)), w1 = *((const u32x4*)(H2 + (size_t)t * DM) + 2 * (lane + 64 * j) + 1);
            xf[j][0] = bflo(w0.x); xf[j][1] = bfhi(w0.x); xf[j][2] = bflo(w0.y); xf[j][3] = bfhi(w0.y); xf[j][4] = bflo(w0.z); xf[j][5] = bfhi(w0.z); xf[j][6] = bflo(w0.w); xf[j][7] = bfhi(w0.w);
            xf[j][8] = bflo(w1.x); xf[j][9] = bfhi(w1.x); xf[j][10] = bflo(w1.y); xf[j][11] = bfhi(w1.y); xf[j][12] = bflo(w1.z); xf[j][13] = bfhi(w1.z); xf[j][14] = bflo(w1.w); xf[j][15] = bfhi(w1.w);
#pragma unroll
            for (int i = 0; i < 16; ++i) am = fmaxf(am, fabsf(xf[j][i]));
        }
        am = wave_maxf(am);
        const float inv = am > 0.f ? 127.f / am : 0.f, sx = am * (1.f / 127.f);
        int xq[2][4];
#pragma unroll
        for (int j = 0; j < 2; ++j)
#pragma unroll
            for (int k = 0; k < 4; ++k) {
                unsigned w = 0;
#pragma unroll
                for (int i = 0; i < 4; ++i) w |= ((unsigned)(int)rintf(xf[j][4 * k + i] * inv) & 0xffu) << (8 * i);
                xq[j][k] = (int)w;
            }
        int xe[4], xo[4], xsum4 = 0;
#pragma unroll
        for (int d = 0; d < 4; ++d) {
            const u32x4 w = *((const u32x4*)(H2 + (size_t)t * DM + 32 * lane) + d);
            int q[8];
#pragma unroll
            for (int i = 0; i < 4; ++i) { q[2 * i] = (int)rintf(bflo(w[i]) * inv); q[2 * i + 1] = (int)rintf(bfhi(w[i]) * inv); }
            xe[d] = (int)(((unsigned)q[0] & 0xffu) | (((unsigned)q[2] & 0xffu) << 8) | (((unsigned)q[4] & 0xffu) << 16) | (((unsigned)q[6] & 0xffu) << 24));
            xo[d] = (int)(((unsigned)q[1] & 0xffu) | (((unsigned)q[3] & 0xffu) << 8) | (((unsigned)q[5] & 0xffu) << 16) | (((unsigned)q[7] & 0xffu) << 24));
#pragma unroll
            for (int i = 0; i < 8; ++i) xsum4 += q[i];
        }
        float asum = 0.f;
        const int ei0 = EXPI[(size_t)t * 128 + lane] & emask, ei1 = EXPI[(size_t)t * 128 + 64 + lane] & emask;
        const float eg0 = EXPG[(size_t)t * 128 + lane], eg1 = EXPG[(size_t)t * 128 + 64 + lane];
        u32x4 wa0[8], wa1[8], wb[8]; unsigned short sbh[8];
#define ULOADA(hd_) do { const int eis_ = (hd_) < 4 ? ei0 : ei1, base_ = ((hd_) & 3) * 16; \
            _Pragma("unroll") for (int e = 0; e < 8; ++e) { const int idx_ = __builtin_amdgcn_readlane(eis_, base_ + e); const u32x4* ur_ = (const u32x4*)(U8 + (size_t)idx_ * DM); wa0[e] = ur_[lane]; wa1[e] = ur_[lane + 64]; } } while (0)
#define ULOADB(hd_) do { const int eis_ = (hd_) < 4 ? ei0 : ei1, base_ = ((hd_) & 3) * 16 + 8; \
            _Pragma("unroll") for (int e = 0; e < 8; ++e) { const int idx_ = __builtin_amdgcn_readlane(eis_, base_ + e); const unsigned char* u4_ = U4 + (size_t)idx_ * V4_ROW; wb[e] = *(const u32x4*)(u4_ + 16 * lane); sbh[e] = *(const unsigned short*)(u4_ + 1024 + 2 * lane); } } while (0)
#define ULOADA_NEXT(hd_) do { const int h_ = (hd_); const int eis_ = (h_ & 4) ? ei1 : ei0, base_ = (h_ & 3) * 16, msk_ = h_ < 8 ? -1 : 0; \
            _Pragma("unroll") for (int e = 0; e < 8; ++e) { const int idx_ = __builtin_amdgcn_readlane(eis_, base_ + e) & msk_; const u32x4* ur_ = (const u32x4*)(U8 + (size_t)idx_ * DM); wa0[e] = ur_[lane]; wa1[e] = ur_[lane + 64]; } } while (0)
        ULOADA(0);
#pragma unroll 1
        for (int hd = 0; hd < 8; ++hd) {
            const int eisel = hd < 4 ? ei0 : ei1; const float egsel = hd < 4 ? eg0 : eg1;
            const int base = (hd & 3) * 16;
            const int myidxA = __shfl(eisel, base + eloc), myidxB = __shfl(eisel, base + 8 + eloc);
            const float mygA = __shfl(egsel, base + eloc), mygB = __shfl(egsel, base + 8 + eloc);
            const float mysu = SU[myidxA];
            ULOADB(hd);
            float accA[8], accB[8];
#pragma unroll
            for (int e = 0; e < 8; ++e) {
                int a = __builtin_amdgcn_sdot4((int)wa0[e].x, xq[0][0], 0, false); a = __builtin_amdgcn_sdot4((int)wa0[e].y, xq[0][1], a, false);
                a = __builtin_amdgcn_sdot4((int)wa0[e].z, xq[0][2], a, false); a = __builtin_amdgcn_sdot4((int)wa0[e].w, xq[0][3], a, false);
                a = __builtin_amdgcn_sdot4((int)wa1[e].x, xq[1][0], a, false); a = __builtin_amdgcn_sdot4((int)wa1[e].y, xq[1][1], a, false);
                a = __builtin_amdgcn_sdot4((int)wa1[e].z, xq[1][2], a, false); a = __builtin_amdgcn_sdot4((int)wa1[e].w, xq[1][3], a, false);
                accA[e] = (float)a;
            }
            __builtin_amdgcn_sched_barrier(0);
            ULOADA_NEXT(hd + 1);
#pragma unroll
            for (int e = 0; e < 8; ++e) {
                int b = 0;
#pragma unroll
                for (int d = 0; d < 4; ++d) { b = __builtin_amdgcn_sdot4((int)(wb[e][d] & 0x0F0F0F0Fu), xe[d], b, false); b = __builtin_amdgcn_sdot4((int)((wb[e][d] >> 4) & 0x0F0F0F0Fu), xo[d], b, false); }
                accB[e] = (float)(b - 8 * xsum4) * bf2f(sbh[e]);
            }
            float rA, rB;
            {
                float r4[4], r2[2], s4[4], s2[2];
#pragma unroll
                for (int i = 0; i < 4; ++i) {
                    const float sndA = (lane & 32) ? accA[i] : accA[i + 4], kpA = (lane & 32) ? accA[i + 4] : accA[i]; r4[i] = kpA + __shfl_xor(sndA, 32);
                    const float sndB = (lane & 32) ? accB[i] : accB[i + 4], kpB = (lane & 32) ? accB[i + 4] : accB[i]; s4[i] = kpB + __shfl_xor(sndB, 32); }
#pragma unroll
                for (int i = 0; i < 2; ++i) {
                    const float sndA = (lane & 16) ? r4[i] : r4[i + 2], kpA = (lane & 16) ? r4[i + 2] : r4[i]; r2[i] = kpA + __shfl_xor(sndA, 16);
                    const float sndB = (lane & 16) ? s4[i] : s4[i + 2], kpB = (lane & 16) ? s4[i + 2] : s4[i]; s2[i] = kpB + __shfl_xor(sndB, 16); }
                { const float sndA = (lane & 8) ? r2[0] : r2[1], kpA = (lane & 8) ? r2[1] : r2[0]; rA = kpA + __shfl_xor(sndA, 8);
                  const float sndB = (lane & 8) ? s2[0] : s2[1], kpB = (lane & 8) ? s2[1] : s2[0]; rB = kpB + __shfl_xor(sndB, 8); }
                rA += __shfl_xor(rA, 4); rA += __shfl_xor(rA, 2); rA += __shfl_xor(rA, 1);
                rB += __shfl_xor(rB, 4); rB += __shfl_xor(rB, 2); rB += __shfl_xor(rB, 1);
            }
            const float aA = gelu_erf(rA * mysu * sx) * mygA, aB = gelu_erf(rB * sx) * mygB;
            if ((lane & 7) == 0) { la[hd * 16 + eloc] = aA; li[hd * 16 + eloc] = myidxA & vmask; la[hd * 16 + 8 + eloc] = aB; li[hd * 16 + 8 + eloc] = myidxB & vmask; asum += aA + aB; }
        }
#undef ULOADA
#undef ULOADA_NEXT
#undef ULOADB
        asum = wave_sum(asum);
        asm volatile("s_waitcnt lgkmcnt(0)" ::: "memory");
        f32x2 o2[16]; float csum = 0.f;
#pragma unroll
        for (int i = 0; i < 16; ++i) o2[i] = (f32x2){0.f, 0.f};
#pragma unroll 16
        for (int e = 0; e < 128; ++e) {
            const int idx = __builtin_amdgcn_readfirstlane(li[e]); const float a = __uint_as_float((unsigned)__builtin_amdgcn_readfirstlane((int)__float_as_uint(la[e])));
            const unsigned char* vr = V4 + (size_t)idx * V4_ROW;
            const u32x4 w = *(const u32x4*)(vr + 16 * lane);
            const float as = a * bf2f(*(const unsigned short*)(vr + 1024 + 2 * lane));
            csum += as;
            const f32x2 as2 = {as, as};
#pragma unroll
            for (int d = 0; d < 4; ++d) {
                const unsigned lo = w[d] & 0x0F0F0F0Fu, hi = (w[d] >> 4) & 0x0F0F0F0Fu;
                o2[4 * d + 0] = __builtin_elementwise_fma(as2, (f32x2){ub0(lo), ub0(hi)}, o2[4 * d + 0]); o2[4 * d + 1] = __builtin_elementwise_fma(as2, (f32x2){ub1(lo), ub1(hi)}, o2[4 * d + 1]);
                o2[4 * d + 2] = __builtin_elementwise_fma(as2, (f32x2){ub2(lo), ub2(hi)}, o2[4 * d + 2]); o2[4 * d + 3] = __builtin_elementwise_fma(as2, (f32x2){ub3(lo), ub3(hi)}, o2[4 * d + 3]);
            }
        }
        float o[32];
#pragma unroll
        for (int i = 0; i < 16; ++i) { o[2 * i] = o2[i][0]; o[2 * i + 1] = o2[i][1]; }
        LAS float* tp = (LAS float*)(F.lds + 8192 + F.wave * 9216);
        const float corr = 8.f * csum;
#pragma unroll
        for (int k = 0; k < 8; ++k) { f32x4 v; v[0] = o[4 * k] - corr; v[1] = o[4 * k + 1] - corr; v[2] = o[4 * k + 2] - corr; v[3] = o[4 * k + 3] - corr; *(LAS f32x4*)(tp + lane * 36 + 4 * k) = v; }
        asm volatile("s_waitcnt lgkmcnt(0)" ::: "memory");
        const float* g2 = MOD + (size_t)(t >> 12) * 12288 + 5 * 2048;
        f32x4 x2[8]; float ss = 0.f;
#pragma unroll
        for (int j = 0; j < 8; ++j) {
            const int ch = lane + 64 * j;
            const f32x4 pv = *(const LAS f32x4*)(tp + (ch >> 3) * 36 + 4 * (ch & 7));
            const u32x2 xw = __builtin_nontemporal_load((const u32x2*)(X1 + (size_t)t * DM) + ch); const f32x4 xa = {bflo(xw.x), bfhi(xw.x), bflo(xw.y), bfhi(xw.y)}, ga = *((const f32x4*)g2 + ch);
            x2[j] = xa + ga * pv;
            ss += (x2[j][0] * x2[j][0] + x2[j][1] * x2[j][1]) + (x2[j][2] * x2[j][2] + x2[j][3] * x2[j][3]);
        }
        const float rstd = rsqrtf(wave_sum(ss) * (1.f / DM) + EPS);
        const float* fw = F.in[22];
#pragma unroll
        for (int j = 0; j < 8; ++j) { const int ch = lane + 64 * j; const f32x4 wa = *((const f32x4*)fw + ch); __builtin_nontemporal_store(x2[j] * rstd * wa, (f32x4*)(F.out + (size_t)t * DM) + ch); }
        asm volatile("s_waitcnt lgkmcnt(0)" ::: "memory");
    }
}

DI void phase_h2(Frame& F) {
    const float* MOD = (const float*)(F.ws + WS_MOD); bf16* H2 = (bf16*)(F.ws + WS_H2); const bf16* X1 = (const bf16*)(F.ws + WS_X1);
    ModPar P;
    constexpr int RPW = NT / (256 * NWAVES);
    if (F.NGW == 256 * NWAVES) {
        const int m0 = F.gw * RPW, r = m0 >> 12;
        modpar_load(P, F.in[7], MOD + (size_t)r * 12288 + 4 * 2048, MOD + (size_t)r * 12288 + 3 * 2048, F.lane);
        modnorm_rows_bf(X1 + (size_t)m0 * DM, H2 + (size_t)m0 * DM, RPW, P, F.lane);
    } else {
        for (int m = F.gw; m < NT; m += F.NGW) { const int r = m >> 12; modpar_load(P, F.in[7], MOD + (size_t)r * 12288 + 4 * 2048, MOD + (size_t)r * 12288 + 3 * 2048, F.lane); modnorm_rows_bf(X1 + (size_t)m * DM, H2 + (size_t)m * DM, 1, P, F.lane); }
    }
}


DI void phase_quant(Frame& F) {
#ifndef REP_QUANT
#define REP_QUANT 1
#endif
#pragma nounroll
    for (int rq = 0; rq < REP_QUANT; ++rq) {
    quant_u_both(F.in[20], F.ws + WS_U8, (float*)(F.ws + WS_SU), F.ws + WS_U4, F.gw, F.NGW, F.lane);
    quant_rows_i4(F.in[21], F.ws + WS_V8, F.gw, F.NGW, F.lane);
    }
}

struct Args { const float* in[23]; float* out; unsigned char* ws; int ph_lo, ph_hi; };
static_assert(sizeof(Args) == 23 * 8 + 8 + 8 + 8, "Args has no padding");

__global__ void __launch_bounds__(NWAVES * 64, 2) mk_fwd(Args args) {
    extern __shared__ __attribute__((aligned(16))) unsigned char lds[];
    Frame F;
    F.lds = (LAS unsigned char*)lds; F.ws = args.ws; F.out = args.out;
#pragma unroll
    for (int i = 0; i < 23; ++i) F.in[i] = args.in[i];
    F.tid = threadIdx.x; F.lane = F.tid & 63; F.wave = __builtin_amdgcn_readfirstlane(F.tid >> 6);
    F.G = gridDim.x; { const int bx = blockIdx.x; F.vcu = (F.G % 8 == 0) ? (bx % 8) * (F.G / 8) + bx / 8 : bx; }
    F.gw = F.vcu * NWAVES + F.wave; F.NGW = F.G * NWAVES;
    const int lo = args.ph_lo, hi = args.ph_hi;
#ifndef REP_PHASE
#define REP_PHASE (-1)
#endif
#define IN(k) (lo <= (k) && (k) < hi)
#ifndef REP_MASK
#define REP_MASK 0
#endif
#define RP(k) _Pragma("nounroll") for (int rep_ = 0; rep_ < ((REP_PHASE == (k) || ((REP_MASK >> (k)) & 1)) ? 2 : 1); ++rep_)
    constexpr int CW_BAR = 4096;
    volatile LAS unsigned* bst = (volatile LAS unsigned*)(F.lds + LDS_BYTES - 64);
    if (F.tid < 16) bst[F.tid] = 0u;
    __syncthreads();
    XcdBarrier bar; bar.bar = (unsigned*)(F.ws + WS_CTL) + CW_BAR; bar.x = 0; bar.st = nullptr;
    if (hi - lo > 1) bar = xcd_barrier_post((unsigned*)(F.ws + WS_CTL) + CW_BAR, bst);
#define SEAM(k) do { if (IN(k) && IN((k) + 1)) { if ((k) == 0) cg::this_grid().sync(); else xcd_barrier(bar); } } while (0)

    if (IN(0)) RP(0) { phase_prologue(F); __syncthreads(); }
    SEAM(0);
    if (IN(1)) RP(1) phase_modreduce(F);
    SEAM(1);
    if (IN(2)) RP(2) phase_h1(F);
    SEAM(2);
    if (IN(3)) RP(3) {
        pg8::Gemm g{(const bf16*)(F.ws + WS_H), (const bf16*)(F.ws + WS_WIN), MTOT, NPROJ, DM / 2}; InProjOrder S; S.init(F.G, (int)blockIdx.x);
        EpiInProj E{F.ws, F.in[12], F.in[13]};
        pg8::gemm_phase<EpiInProj, InProjOrder, true, true, true>(F.lds, g, S, E);
    }
    SEAM(3);
    if (IN(4)) phase_postproj(F);
    SEAM(4);
#ifdef DN_NAIVE
    if (IN(5)) phase_dn_naive(F);
    SEAM(5);
    if (IN(6)) phase_attention(F, (char*)lds);
#else
    if (IN(5)) RP(5) phase_dn_prep(F);
    SEAM(5);
    if (IN(6)) { RP(14) { phase_dn_scan(F); __syncthreads(); } phase_attention(F, (char*)lds); }
#endif
    SEAM(6);
    if (IN(7)) phase_mergeprep(F);
    SEAM(7);
    if (IN(8)) RP(8) {
#if MERGE_F8_A || MERGE_F8_B || defined(MERGE_TWO_PASS)
        pg8::StaticOrder S; S.init(NT, DM, F.G, (int)blockIdx.x);
        { pg8::Gemm g{(const bf16*)(F.ws + (MERGE_F8_A ? WS_OATT8 : WS_QN)), (const bf16*)(F.ws + WS_WBA), NT, DM, MERGE_F8_A ? 512 : 1024};
          EpiMerge<false> E{(bf16*)(F.ws + WS_Y), (const unsigned char*)(F.ws + WS_G), 0, MERGE_F8_A ? 1.f / (255.f * WB_SCALE * OATT_SCALE) : 1.f / 255.f};
          pg8::gemm_phase<EpiMerge<false>, pg8::StaticOrder, true, true, MERGE_F8_A != 0>(F.lds, g, S, E); }
        __syncthreads();
        { pg8::Gemm g{(const bf16*)(F.ws + (MERGE_F8_B ? WS_ODNN8 : WS_Z)), (const bf16*)(F.ws + WS_WBD), NT, DM, MERGE_F8_B ? 512 : 1024};
          EpiMerge<true> E{(bf16*)(F.ws + WS_Y), (const unsigned char*)(F.ws + WS_G), 2048, MERGE_F8_B ? 1.f / (255.f * WB_SCALE * ODNN_SCALE) : 1.f / 255.f};
          pg8::gemm_phase<EpiMerge<true>, pg8::StaticOrder, true, true, MERGE_F8_B != 0>(F.lds, g, S, E); }
#else
        pg8::TwoStageOrder S; S.init(NT, DM, F.G, (int)blockIdx.x);
        pg8::Gemm g{(const bf16*)(F.ws + WS_QN), (const bf16*)(F.ws + WS_WBA), NT, DM, 1024, (const bf16*)(F.ws + WS_Z), (const bf16*)(F.ws + WS_WBD)};
        EpiMerge2 E{(bf16*)(F.ws + WS_Y), (const unsigned char*)(F.ws + WS_G)};
        pg8::gemm_phase<EpiMerge2, pg8::TwoStageOrder, true, true>(F.lds, g, S, E);
#endif
    }
    SEAM(8);
    if (IN(9)) RP(9) {
        pg8::Gemm g{(const bf16*)(F.ws + WS_Y), (const bf16*)(F.ws + WS_WOUT), NT, DM, DM}; pg8::StaticOrder S; S.init(NT, DM, F.G, (int)blockIdx.x);
        EpiResid E{F.in[0], (bf16*)(F.ws + WS_X1), (const float*)(F.ws + WS_MOD)};
        pg8::gemm_phase<EpiResid, pg8::StaticOrder, true, true>(F.lds, g, S, E);
    }
    SEAM(9);
    if (IN(10)) RP(10) phase_h2(F);
    SEAM(10);
    if (IN(11)) RP(11) {
        pg8::Gemm g{(const bf16*)(F.ws + WS_H2), (const bf16*)(F.ws + WS_WQ), NT, DM, DM}; pg8::StaticOrder S; S.init(NT, DM, F.G, (int)blockIdx.x);
        EpiPlain E{(bf16*)(F.ws + WS_PQ), 2048};
        pg8::gemm_phase<EpiPlain, pg8::StaticOrder, true, true>(F.lds, g, S, E);
    }
    SEAM(11);
    if (IN(12)) { RP(12) { phase_peer_topk(F); __syncthreads(); } phase_quant(F); }
    SEAM(12);
#ifdef GATHER_PROBE_MASK
    if (IN(13)) {
#pragma nounroll
        for (int rep_ = 0; rep_ < 2; ++rep_) { phase_peer_gather(F, rep_ == 0 ? GATHER_PROBE_MASK : 0x3fff, rep_ == 0 ? GATHER_PROBE_VMASK : 0x3fff); __syncthreads(); }
    }
#else
    if (IN(13)) RP(13) phase_peer_gather(F);
#endif
#undef IN
#undef SEAM
}

extern "C" void kernel_launch(void* const* d_in, const int* in_sizes, int n_in, void* d_out, int out_size, void* d_ws, size_t ws_size, hipStream_t stream) {
    static int grid = 0;
    if (grid == 0) {
        if (n_in != 23 || in_sizes[0] != NT * DM || out_size != NT * DM || ws_size < WS_END) {
            fprintf(stderr, "kernel_launch: unexpected shapes (n_in %d, in0 %d, out %d, ws %zu < %zu); nothing launched\n", n_in, n_in > 0 ? in_sizes[0] : -1, out_size, ws_size, (size_t)WS_END);
            grid = -1; return; }
        int dev = 0, cus = 0, per_cu = 0;
        if (hipGetDevice(&dev) != hipSuccess || hipDeviceGetAttribute(&cus, hipDeviceAttributeMultiprocessorCount, dev) != hipSuccess) { grid = -1; return; }
        if (hipFuncSetAttribute((const void*)mk_fwd, hipFuncAttributeMaxDynamicSharedMemorySize, LDS_BYTES) != hipSuccess) { fprintf(stderr, "kernel_launch: hipFuncSetAttribute failed\n"); grid = -1; return; }
        if (hipOccupancyMaxActiveBlocksPerMultiprocessor(&per_cu, (const void*)mk_fwd, NWAVES * 64, LDS_BYTES) != hipSuccess || per_cu < 1) { fprintf(stderr, "kernel_launch: occupancy query says %d blocks per CU\n", per_cu); (void)hipGetLastError(); grid = -1; return; }
        grid = cus;
    }
    if (grid < 0) return;
    (void)hipMemsetAsync((char*)d_ws + WS_CTL, 0, 1 * MiB, stream);
    Args a{};
    for (int i = 0; i < 23; ++i) a.in[i] = (const float*)d_in[i];
    a.out = (float*)d_out; a.ws = (unsigned char*)d_ws;
#if MK_N_LAUNCHES == 1
    a.ph_lo = 0; a.ph_hi = NPHASE;
    void* kargs[] = {(void*)&a};
    const hipError_t e = hipLaunchCooperativeKernel((const void*)mk_fwd, dim3(grid), dim3(NWAVES * 64), kargs, LDS_BYTES, stream);
    if (e != hipSuccess) fprintf(stderr, "kernel_launch: cooperative launch failed: %s (grid %d)\n", hipGetErrorString(e), grid);
#else
    for (int p = 0; p < NPHASE; ++p) {
        a.ph_lo = p; a.ph_hi = p + 1;
        hipLaunchKernelGGL(mk_fwd, dim3(grid), dim3(NWAVES * 64), LDS_BYTES, stream, a);
    }
    const hipError_t le = hipPeekAtLastError();
    if (le != hipSuccess) fprintf(stderr, "kernel_launch: launch failed: %s\n", hipGetErrorName(le));
#endif
}
```

```cpp
#define MERGE_F8_2S 1
#define OUT_F8 1

#include <hip/hip_runtime.h>
#include <hip/hip_cooperative_groups.h>
#include <cstdio>
#include <cstdint>
namespace cg = cooperative_groups;

#ifndef MK_N_LAUNCHES
#define MK_N_LAUNCHES 1
#endif
namespace pg8 {
#define PG8_LAS __attribute__((address_space(3)))
typedef unsigned short bf16_t;
typedef short bf16x8 __attribute__((ext_vector_type(8)));
typedef float f32x4 __attribute__((ext_vector_type(4)));
typedef int pg8_v4i __attribute__((ext_vector_type(4)));
typedef int pg8_v8i __attribute__((ext_vector_type(8)));
typedef unsigned u32x4 __attribute__((ext_vector_type(4)));
constexpr int BM = 256, BK = 64, HALF = 128, HTB = HALF * BK * 2  , STAGE_BYTES = 8 * HTB, NXCD = 8, WGM = 8;

__host__ __device__ __forceinline__ int lds_byte(int r, int c) { const int st = (r >> 4) * 2 + (c >> 5), rr = r & 15, cc = c & 31, ob = rr * 64 + cc * 2; return st * 1024 + (ob ^ (((ob >> 9) & 1) << 5)); }
__host__ __device__ __forceinline__ void stage_rc(int b, int& R, int& C) { const int st = b / 1024, sb = b % 1024, swz = sb ^ (((sb >> 9) & 1) << 5); R = (st >> 1) * 16 + swz / 64; C = (st & 1) * 32 + (swz % 64) / 2; }
__host__ __device__ __forceinline__ int perm32(int rho) { const int n = rho >> 4, i = rho & 15; return 8 * (i >> 2) + 4 * n + (i & 3); }

struct Unit { int pm, pn, sel; };
struct Gemm { const bf16_t* A; const bf16_t* Bt; int M, N, K; const bf16_t* A2 = nullptr; const bf16_t* Bt2 = nullptr; size_t selB = 0; };

struct StaticOrder {
    int nM, nN, nwg, G, c;
    __host__ __device__ void init(int M, int N, int G_, int c_) { nM = M / BM; nN = N / BM; nwg = nM * nN; G = G_; c = c_; }
    __host__ __device__ bool next(int i, Unit& u) const {
        const long L = (long)i * G + c; if (L >= nwg) return false;
        int wgid = (int)L; { const int q = nwg / NXCD, r = nwg % NXCD, xcd = wgid % NXCD, off = wgid / NXCD; wgid = (xcd < r ? xcd * (q + 1) : r * (q + 1) + (xcd - r) * q) + off; }
        const int nig = WGM * nN, gid = wgid / nig, fm = gid * WGM, gsz = (nM - fm) < WGM ? (nM - fm) : WGM;
        u.pm = fm + ((wgid % nig) % gsz); u.pn = (wgid % nig) / gsz; return true;
    }
    __device__ __forceinline__ void a_ready(const Unit&) const {}
    __device__ __forceinline__ void done(const Unit&) const {}
};
struct BatchOrder {
    StaticOrder base;
    __host__ __device__ void init(int M, int N, int G_, int c_) { base.init(M, N, G_, c_); }
    __host__ __device__ bool next(int i, Unit& u) const { if (!base.next(i, u)) return false; u.sel = u.pm >> 4; return true; }
    __device__ __forceinline__ void a_ready(const Unit&) const {}
    __device__ __forceinline__ void done(const Unit&) const {}
};
struct TwoStageOrder {
    StaticOrder base;
    __host__ __device__ void init(int M, int N, int G_, int c_) { base.init(M, N, G_, c_); }
    __host__ __device__ bool next(int i, Unit& u) const { if (!base.next(i >> 1, u)) return false; u.sel = i & 1; return true; }
    __device__ __forceinline__ void a_ready(const Unit&) const {}
    __device__ __forceinline__ void done(const Unit&) const {}
};

__device__ __forceinline__ unsigned cvt_pk_bf16(float lo, float hi) { unsigned r; asm volatile("v_cvt_pk_bf16_f32 %0, %1, %2" : "=v"(r) : "v"(lo), "v"(hi)); return r; }
typedef float f32x2 __attribute__((ext_vector_type(2)));
template <class Epi, class Sched, bool ALIGN_EPI = false, bool SP2 = false, bool F8 = false>
__device__ __forceinline__ void gemm_phase(PG8_LAS unsigned char* lds, const Gemm g, const Sched& S, const Epi& E) {
    const int tid = threadIdx.x, wid = __builtin_amdgcn_readfirstlane(tid >> 6), lane = tid & 63, wr = wid >> 2, wc = wid & 3, fr = lane & 15, fq = lane >> 4;
    const int K = g.K, nt = K / BK;
    unsigned voffA[2], voffB[2];
#pragma unroll
    for (int i = 0; i < 2; ++i) { int R, C; stage_rc(tid * 16 + i * 8192, R, C); const int Rb = Epi::PERM ? ((R & ~31) + perm32(R & 31)) : R;
        voffA[i] = (unsigned)(R * K + C) * 2u; voffB[i] = (unsigned)(Rb * K + C) * 2u; }
    const size_t kstep = (size_t)(BK * 2);
    const size_t hstep = (size_t)HALF * K * 2;
    const size_t tstep = 2 * hstep;
    const unsigned ldsw = (unsigned)wid * 1024u;
    const int aoff = lds_byte(wr * 64 + fr, fq * 8), boff = lds_byte(wc * 32 + fr, fq * 8);
#define PG8_SA(b, h) (((b) * 2 + (h)) * HTB)
#define PG8_SB(b, h) ((4 + (b) * 2 + (h)) * HTB)
#define PG8_STAGE(bufoff, gbase, voff) do { _Pragma("unroll") for (int _i = 0; _i < 2; ++_i) \
        __builtin_amdgcn_global_load_lds((const unsigned*)((const char*)(gbase) + (voff)[_i]), (PG8_LAS unsigned*)(lds + (bufoff) + ldsw + _i * 8192), 16, 0, 0); } while (0)
#define PG8_LDA(dst, b, h) do { _Pragma("unroll") for (int m = 0; m < 4; ++m) { \
        if constexpr (F8) { const pg8_v4i t0_ = *(const PG8_LAS pg8_v4i*)(lds + PG8_SA(b, h) + aoff + m * 2048), t1_ = *(const PG8_LAS pg8_v4i*)(lds + PG8_SA(b, h) + aoff + m * 2048 + 1024); \
            dst##8[m] = __builtin_shufflevector(t0_, t1_, 0, 1, 2, 3, 4, 5, 6, 7); } \
        else { _Pragma("unroll") for (int k = 0; k < 2; ++k) dst[m][k] = *(const PG8_LAS bf16x8*)(lds + PG8_SA(b, h) + aoff + m * 2048 + k * 1024); } } } while (0)
#define PG8_LDB(dst, b, h) do { _Pragma("unroll") for (int n = 0; n < 2; ++n) { \
        if constexpr (F8) { const pg8_v4i t0_ = *(const PG8_LAS pg8_v4i*)(lds + PG8_SB(b, h) + boff + n * 2048), t1_ = *(const PG8_LAS pg8_v4i*)(lds + PG8_SB(b, h) + boff + n * 2048 + 1024); \
            dst##8[n] = __builtin_shufflevector(t0_, t1_, 0, 1, 2, 3, 4, 5, 6, 7); } \
        else { _Pragma("unroll") for (int k = 0; k < 2; ++k) dst[n][k] = *(const PG8_LAS bf16x8*)(lds + PG8_SB(b, h) + boff + n * 2048 + k * 1024); } } } while (0)
#define PG8_MMA(ai, bj, At, Bt) do { __builtin_amdgcn_s_setprio(1); _Pragma("unroll") for (int m = 0; m < 4; ++m) _Pragma("unroll") for (int n = 0; n < 2; ++n) { \
        if constexpr (F8) { asm volatile("v_mfma_scale_f32_16x16x128_f8f6f4 %0, %1, %2, %0, %3, %3 op_sel_hi:[0,0,0]" : "+v"(acc[ai][bj][m][n]) : "v"(Bt##8[n]), "v"(At##8[m]), "v"(0x7F7F7F7F)); } \
        else { _Pragma("unroll") for (int k = 0; k < 2; ++k) acc[ai][bj][m][n] = __builtin_amdgcn_mfma_f32_16x16x32_bf16(Bt[n][k], At[m][k], acc[ai][bj][m][n], 0, 0, 0); } } \
        __builtin_amdgcn_s_setprio(0); } while (0)
#define PG8_WAIT_V(n) asm volatile("s_waitcnt vmcnt(" #n ")" ::: "memory")
#define PG8_WAIT_L(n) asm volatile("s_waitcnt lgkmcnt(" #n ")" ::: "memory")
#define PG8_BAR __builtin_amdgcn_s_barrier()
#define PG8_SCHED __builtin_amdgcn_sched_barrier(0)
    Unit cur, nxt; int ui = 0;
    if (!S.next(0, cur)) return;
    f32x4 acc[2][2][4][2];
#pragma unroll
    for (int a = 0; a < 2; ++a)
#pragma unroll
        for (int b = 0; b < 2; ++b)
#pragma unroll
            for (int m = 0; m < 4; ++m)
#pragma unroll
                for (int n = 0; n < 2; ++n) acc[a][b][m][n] = (f32x4){0.f, 0.f, 0.f, 0.f};
    bf16x8 At[4][2], B0[2][2], B1[2][2];
    pg8_v8i At8[4], B08[2], B18[2];
    const char* cA = (const char*)g.A + (size_t)cur.pm * tstep; const char* cB = (const char*)g.Bt + (size_t)cur.pn * tstep;
    if constexpr (Epi::SEL_B) cB += (size_t)cur.sel * g.selB;
    S.a_ready(cur);
    if constexpr (SP2) {
        PG8_STAGE(PG8_SB(0, 0), cB, voffB); PG8_STAGE(PG8_SB(0, 1), cB + hstep, voffB); PG8_STAGE(PG8_SA(0, 0), cA, voffA); PG8_STAGE(PG8_SA(0, 1), cA + hstep, voffA);
        if (wr == 1) PG8_BAR;
        PG8_WAIT_V(2); PG8_BAR;
        PG8_STAGE(PG8_SB(1, 0), cB + kstep, voffB); PG8_STAGE(PG8_SA(1, 0), cA + kstep, voffA); PG8_STAGE(PG8_SB(1, 1), cB + hstep + kstep, voffB);
        PG8_WAIT_V(6); PG8_BAR;
    } else {
        PG8_STAGE(PG8_SB(0, 0), cB, voffB); PG8_STAGE(PG8_SA(0, 0), cA, voffA); PG8_STAGE(PG8_SB(0, 1), cB + hstep, voffB); PG8_STAGE(PG8_SA(0, 1), cA + hstep, voffA);
        if (wr == 1) PG8_BAR;
        PG8_WAIT_V(4); PG8_BAR;
        PG8_STAGE(PG8_SB(1, 0), cB + kstep, voffB); PG8_STAGE(PG8_SA(1, 0), cA + kstep, voffA); PG8_STAGE(PG8_SB(1, 1), cB + hstep + kstep, voffB);
        PG8_WAIT_V(6); PG8_BAR;
    }
    for (;;) {
        const bool has_next = S.next(ui + 1, nxt);
        const bf16_t* gA = g.A; const bf16_t* gB = g.Bt;
        if constexpr (Epi::TWO_STAGE) { if (has_next && nxt.sel) { gA = g.A2; gB = g.Bt2; } }
        const char* nA = has_next ? (const char*)gA + (size_t)nxt.pm * tstep : cA; const char* nB = has_next ? (const char*)gB + (size_t)nxt.pn * tstep : cB;
        if constexpr (Epi::SEL_B) { if (has_next) nB += (size_t)nxt.sel * g.selB; }
        for (int t = 0; t < nt; t += 2) {
            const bool last = (t == nt - 2);
            const char* a1 = cA + (size_t)(t + 1) * kstep;
            const char* a2 = last ? nA : cA + (size_t)(t + 2) * kstep; const char* b2 = last ? nB : cB + (size_t)(t + 2) * kstep;
            const char* a3 = a2 + kstep; const char* b3 = b2 + kstep;
            if (last && has_next) S.a_ready(nxt);
            if constexpr (SP2) {
            PG8_LDB(B0, 0, 0); PG8_LDB(B1, 0, 1); PG8_SCHED; PG8_LDA(At, 0, 0); PG8_STAGE(PG8_SA(1, 1), a1 + hstep, voffA);
            PG8_WAIT_V(8); PG8_WAIT_L(0); PG8_BAR; PG8_MMA(0, 0, At, B0); PG8_MMA(0, 1, At, B1); PG8_BAR; PG8_SCHED;
            PG8_LDA(At, 0, 1); PG8_STAGE(PG8_SB(0, 0), b2, voffB); PG8_STAGE(PG8_SB(0, 1), b2 + hstep, voffB); PG8_STAGE(PG8_SA(0, 0), a2, voffA);
            PG8_WAIT_V(8); PG8_WAIT_L(0); PG8_BAR; PG8_MMA(1, 0, At, B0); PG8_MMA(1, 1, At, B1); PG8_BAR; PG8_SCHED;
            PG8_LDB(B0, 1, 0); PG8_LDB(B1, 1, 1); PG8_SCHED; PG8_LDA(At, 1, 0); PG8_STAGE(PG8_SA(0, 1), a2 + hstep, voffA);
            PG8_WAIT_V(8); PG8_WAIT_L(0); PG8_BAR; PG8_MMA(0, 0, At, B0); PG8_MMA(0, 1, At, B1); PG8_BAR; PG8_SCHED;
            PG8_LDA(At, 1, 1); PG8_STAGE(PG8_SB(1, 0), b3, voffB); PG8_STAGE(PG8_SB(1, 1), b3 + hstep, voffB); PG8_STAGE(PG8_SA(1, 0), a3, voffA);
            PG8_WAIT_V(8); PG8_WAIT_L(0); PG8_BAR; PG8_MMA(1, 0, At, B0); PG8_MMA(1, 1, At, B1); PG8_BAR; PG8_SCHED;
            } else {
            PG8_LDB(B0, 0, 0); PG8_SCHED; PG8_LDA(At, 0, 0); PG8_STAGE(PG8_SA(1, 1), a1 + hstep, voffA);
            PG8_WAIT_L(8); PG8_BAR; PG8_WAIT_L(0); PG8_MMA(0, 0, At, B0); PG8_BAR; PG8_SCHED;
            PG8_LDB(B1, 0, 1); PG8_STAGE(PG8_SB(0, 0), b2, voffB);
            PG8_BAR; PG8_WAIT_L(0); PG8_MMA(0, 1, At, B1); PG8_BAR;
            PG8_LDA(At, 0, 1); PG8_STAGE(PG8_SA(0, 0), a2, voffA);
            PG8_BAR; PG8_WAIT_L(0); PG8_MMA(1, 0, At, B0); PG8_BAR; PG8_SCHED;
            PG8_STAGE(PG8_SB(0, 1), b2 + hstep, voffB);
            PG8_WAIT_V(6); PG8_BAR; PG8_MMA(1, 1, At, B1); PG8_BAR;
            PG8_LDB(B0, 1, 0); PG8_SCHED; PG8_LDA(At, 1, 0); PG8_STAGE(PG8_SA(0, 1), a2 + hstep, voffA);
            PG8_WAIT_L(8); PG8_BAR; PG8_WAIT_L(0); PG8_MMA(0, 0, At, B0); PG8_BAR; PG8_SCHED;
            PG8_LDB(B1, 1, 1); PG8_STAGE(PG8_SB(1, 0), b3, voffB);
            PG8_BAR; PG8_WAIT_L(0); PG8_MMA(0, 1, At, B1); PG8_BAR;
            PG8_LDA(At, 1, 1); PG8_STAGE(PG8_SA(1, 0), a3, voffA);
            PG8_BAR; PG8_WAIT_L(0); PG8_MMA(1, 0, At, B0); PG8_BAR; PG8_SCHED;
            PG8_STAGE(PG8_SB(1, 1), b3 + hstep, voffB);
            PG8_WAIT_V(6); PG8_BAR; PG8_MMA(1, 1, At, B1); PG8_BAR;
            }
        }
        if constexpr (ALIGN_EPI) { if (wr == 0) PG8_BAR; }
        bool keep = false;
        if constexpr (Epi::TWO_STAGE) keep = (cur.sel == 0);
        if constexpr (!Epi::AFTER_DRAIN) {
            if constexpr (Epi::TWO_STAGE) { if (keep) E.mid(acc, cur, wr, wc, fr, fq); else E(acc, cur, wr, wc, fr, fq); }
            else E(acc, cur, wr, wc, fr, fq);
            S.done(cur); }
        if (!has_next) break;
        if (!keep)
#pragma unroll
        for (int a = 0; a < 2; ++a)
#pragma unroll
            for (int b = 0; b < 2; ++b)
#pragma unroll
                for (int m = 0; m < 4; ++m)
#pragma unroll
                    for (int n = 0; n < 2; ++n) acc[a][b][m][n] = (f32x4){0.f, 0.f, 0.f, 0.f};
        cur = nxt; cA = nA; cB = nB; ++ui;
        if constexpr (ALIGN_EPI) { if (wr == 1) PG8_BAR; }
    }
    PG8_WAIT_V(0);
    if constexpr (!ALIGN_EPI) { if (wr == 0) PG8_BAR; }
    PG8_BAR;
    if constexpr (Epi::AFTER_DRAIN) { E.fused(acc, cur, wr, wc, fr, fq, lds, wid, lane); S.done(cur); }
#undef PG8_SA
#undef PG8_SB
#undef PG8_STAGE
#undef PG8_LDA
#undef PG8_LDB
#undef PG8_MMA
#undef PG8_WAIT_V
#undef PG8_WAIT_L
#undef PG8_BAR
#undef PG8_SCHED
}
}
namespace attn {
using bf16 = unsigned short;
constexpr int D = 128, NW = 8, QBLK = 32, KVBLK = 64;
constexpr float SCALE = 0.088388347648318440f;
constexpr float THR = 8.f;
constexpr int SDEPTH = 2;
constexpr int LDQ = 1024, LDK = 256, LDO = 1024;
constexpr size_t SHM_V = KVBLK * D * 2, SHM_K = KVBLK * D * 2, SHM_ATTN = 2 * SHM_V + 2 * SHM_K + NW * 64 * 4;
__device__ __forceinline__ unsigned short f2bf_rne(float f) { unsigned u = __float_as_uint(f); return (unsigned short)((u + 0x7fffu + ((u >> 16) & 1u)) >> 16); }
using bf16x8 = __attribute__((ext_vector_type(8))) short;
using s16x4  = __attribute__((ext_vector_type(4))) short;
using f32x16 = __attribute__((ext_vector_type(16))) float;
using f32x8  = __attribute__((ext_vector_type(8))) float;
using u32x4  = __attribute__((ext_vector_type(4))) unsigned;
#define KSWZ(row, colB) ((row) * 256 + ((colB) ^ (((row) & 7) << 4)))
#define SBAR() __builtin_amdgcn_sched_barrier(0)
__device__ __forceinline__ int crow(int r, int hi) { return (r & 3) + 8 * (r >> 2) + 4 * hi; }
__device__ __forceinline__ unsigned cvtpk(float lo, float hi) {
  unsigned r; asm volatile("v_cvt_pk_bf16_f32 %0, %1, %2" : "=v"(r) : "v"(lo), "v"(hi)); return r;
}
template <typename TIn> struct Stage;
template <> struct Stage<bf16>  { using T = bf16x8;
  __device__ static __forceinline__ T ld8(const bf16* p) { return *reinterpret_cast<const bf16x8*>(p); }
  __device__ static __forceinline__ bf16x8 tobf(T x) { return x; } };
template <> struct Stage<float> { using T = f32x8;
  __device__ static __forceinline__ T ld8(const float* p) { return *reinterpret_cast<const f32x8*>(p); }
  __device__ static __forceinline__ bf16x8 tobf(T x) {
    u32x4 w = {cvtpk(x[0], x[1]), cvtpk(x[2], x[3]), cvtpk(x[4], x[5]), cvtpk(x[6], x[7])}; return *reinterpret_cast<bf16x8*>(&w); } };

__device__ __forceinline__ void partialSM(f32x16& p0, f32x16& p1, float& m_reg, float& mn, float& alpha) {
  constexpr float C = SCALE * 1.4426950408889634f;
  float pmax = p0[0]; for (int r = 1; r < 16; ++r) pmax = fmaxf(pmax, p0[r]); for (int r = 0; r < 16; ++r) pmax = fmaxf(pmax, p1[r]);
  { auto rr = __builtin_amdgcn_permlane32_swap(__float_as_uint(pmax), __float_as_uint(pmax), false, false);
    pmax = fmaxf(__uint_as_float(rr[0]), __uint_as_float(rr[1])); }
  if (__builtin_expect(__all(pmax - m_reg <= THR / SCALE), 1)) { mn = m_reg; alpha = 1.f; }
  else { mn = fmaxf(m_reg, pmax); alpha = __builtin_amdgcn_exp2f((m_reg - mn) * C); m_reg = mn; }
  float mnC = -mn * C;
  for (int r = 0; r < 16; ++r) p0[r] = fmaf(p0[r], C, mnC); for (int r = 0; r < 16; ++r) p1[r] = fmaf(p1[r], C, mnC);
  for (int r = 0; r < 16; ++r) p0[r] = __builtin_amdgcn_exp2f(p0[r]);
}
__device__ __forceinline__ void finishSM(f32x16& p0, f32x16& p1, float alpha, float& l_reg, bf16x8& pa0, bf16x8& pa1, bf16x8& pa2, bf16x8& pa3) {
  for (int r = 0; r < 16; ++r) p1[r] = __builtin_amdgcn_exp2f(p1[r]);
  float ps = 0; for (int r = 0; r < 16; ++r) ps += p0[r]; for (int r = 0; r < 16; ++r) ps += p1[r];
  { auto rr = __builtin_amdgcn_permlane32_swap(__float_as_uint(ps), __float_as_uint(ps), false, false);
    ps = __uint_as_float(rr[0]) + __uint_as_float(rr[1]); }
  l_reg = l_reg * alpha + ps;
#define PK4(P, BASE, OUT) do { unsigned a0 = cvtpk(P[BASE + 0], P[BASE + 1]), a1 = cvtpk(P[BASE + 2], P[BASE + 3]);   \
    unsigned b0 = cvtpk(P[BASE + 4], P[BASE + 5]), b1 = cvtpk(P[BASE + 6], P[BASE + 7]);                              \
    auto r0 = __builtin_amdgcn_permlane32_swap(a0, b0, false, false); auto r1 = __builtin_amdgcn_permlane32_swap(a1, b1, false, false); \
    u32x4 w = {r0[0], r1[0], r0[1], r1[1]}; OUT = *reinterpret_cast<bf16x8*>(&w); } while (0)
  PK4(p0, 0, pa0); PK4(p0, 8, pa1); PK4(p1, 0, pa2); PK4(p1, 8, pa3);
#undef PK4
}
__device__ __forceinline__ void qkt(f32x16& p0, f32x16& p1, const bf16* Ks, const bf16x8* qr, int r32, int hi) {
  p0 = f32x16{}; p1 = f32x16{};
  for (int d0 = 0; d0 < 8; ++d0) { int cb = (d0 * 16 + hi * 8) * 2;
    bf16x8 b0 = *reinterpret_cast<const bf16x8*>((const char*)Ks + KSWZ(r32, cb));
    bf16x8 b1 = *reinterpret_cast<const bf16x8*>((const char*)Ks + KSWZ(32 + r32, cb));
    p0 = __builtin_amdgcn_mfma_f32_32x32x16_bf16(b0, qr[d0], p0, 0, 0, 0);
    p1 = __builtin_amdgcn_mfma_f32_32x32x16_bf16(b1, qr[d0], p1, 0, 0, 0); }
}
__device__ __forceinline__ int v_st(int k, int c) { const int kk = (k & ~0xC) | ((k & 4) << 1) | ((k & 8) >> 1); return ((kk >> 3) * 4 + (c >> 5)) * 512 + ((kk & 7) * 32 + (c & 31)) * 2; }
__device__ __forceinline__ int v_rd_base(int lane) { return ((lane & 3) << 3) | (((lane >> 2) & 3) << 6) | (((lane >> 4) & 1) << 5) | (((lane >> 5) & 1) << 8); }
constexpr int v_rd_off(int d0, int ks, int half) { return d0 * 512 + ks * 4096 + half * 2048; }
template <int OFF> __device__ __forceinline__ s16x4 tr_read(int vb) {
  s16x4 r; asm volatile("ds_read_b64_tr_b16 %0, %1 offset:%2" : "=&v"(r) : "v"(vb), "i"(OFF) : "memory"); return r;
}
template <int D0> __device__ __forceinline__ void pv_one(f32x16& od, int vb, bf16x8 pa0, bf16x8 pa1, bf16x8 pa2, bf16x8 pa3) {
  const s16x4 l0 = tr_read<v_rd_off(D0, 0, 0)>(vb), h0 = tr_read<v_rd_off(D0, 0, 1)>(vb), l1 = tr_read<v_rd_off(D0, 1, 0)>(vb), h1 = tr_read<v_rd_off(D0, 1, 1)>(vb);
  const s16x4 l2 = tr_read<v_rd_off(D0, 2, 0)>(vb), h2 = tr_read<v_rd_off(D0, 2, 1)>(vb), l3 = tr_read<v_rd_off(D0, 3, 0)>(vb), h3 = tr_read<v_rd_off(D0, 3, 1)>(vb);
  asm volatile("s_waitcnt lgkmcnt(0)" ::: "memory"); SBAR();
#define PK(L, H) (bf16x8){L[0], L[1], L[2], L[3], H[0], H[1], H[2], H[3]}
  od = __builtin_amdgcn_mfma_f32_32x32x16_bf16(pa0, PK(l0, h0), od, 0, 0, 0);
  od = __builtin_amdgcn_mfma_f32_32x32x16_bf16(pa1, PK(l1, h1), od, 0, 0, 0);
  od = __builtin_amdgcn_mfma_f32_32x32x16_bf16(pa2, PK(l2, h2), od, 0, 0, 0);
  od = __builtin_amdgcn_mfma_f32_32x32x16_bf16(pa3, PK(l3, h3), od, 0, 0, 0);
#undef PK
}
__device__ __forceinline__ void pv_d0(f32x16* o, int vb, bf16x8 pa0, bf16x8 pa1, bf16x8 pa2, bf16x8 pa3) {
  pv_one<0>(o[0], vb, pa0, pa1, pa2, pa3); pv_one<1>(o[1], vb, pa0, pa1, pa2, pa3); pv_one<2>(o[2], vb, pa0, pa1, pa2, pa3); pv_one<3>(o[3], vb, pa0, pa1, pa2, pa3);
}

template <typename TQ>
__device__ __forceinline__ void attn_dense_body(const TQ* __restrict__ Qb, const bf16* __restrict__ Kh, const bf16* __restrict__ Vh,
                                                bf16* __restrict__ Ob, int seq, char* lds) {
  using St = Stage<bf16>; using SQ = Stage<TQ>;
  const int tid = threadIdx.x, wid = tid >> 6, lane = tid & 63, r32 = lane & 31, hi = lane >> 5;
  bf16* V_lds = (bf16*)lds; bf16* K_lds = (bf16*)(lds + 2 * SHM_V);
  float* ws = (float*)(lds + 2 * SHM_V + 2 * SHM_K) + wid * 64; float* li_l = ws; float* al_l = ws + 32;
  float m_reg = -1e30f, l_reg = 0; f32x16 o[4] = {}; bf16x8 qr[8];
  const TQ* Qw = Qb + (long)(wid * QBLK + r32) * LDQ + hi * 8;
#pragma unroll
  for (int d0 = 0; d0 < 8; ++d0) qr[d0] = SQ::tobf(SQ::ld8(Qw + d0 * 16));
  const int sr = tid >> 4, sc = (tid & 15) * 8, vst0 = v_st(sr, sc), vst1 = v_st(32 + sr, sc);
  const int vb0 = (int)(uintptr_t)V_lds + v_rd_base(lane);
  struct { typename St::T vs0, vs1, ks0, ks1; } sr_[SDEPTH];
#define SLOAD(i, k0) do { sr_[i].vs0 = St::ld8(&Vh[(long)((k0) + sr) * LDK + sc]); sr_[i].vs1 = St::ld8(&Vh[(long)((k0) + 32 + sr) * LDK + sc]); \
    sr_[i].ks0 = St::ld8(&Kh[(long)((k0) + sr) * LDK + sc]); sr_[i].ks1 = St::ld8(&Kh[(long)((k0) + 32 + sr) * LDK + sc]); } while (0)
#define SWRITE(b, i) do { *(bf16x8*)((char*)V_lds + (b) * SHM_V + vst0) = St::tobf(sr_[i].vs0);          \
    *(bf16x8*)((char*)V_lds + (b) * SHM_V + vst1) = St::tobf(sr_[i].vs1); int kc = sc * 2;               \
    *(bf16x8*)((char*)K_lds + (b) * SHM_K + KSWZ(sr, kc)) = St::tobf(sr_[i].ks0);                       \
    *(bf16x8*)((char*)K_lds + (b) * SHM_K + KSWZ(32 + sr, kc)) = St::tobf(sr_[i].ks1); } while (0)
#define SWAIT() do { if constexpr (SDEPTH == 2) asm volatile("s_waitcnt vmcnt(4)" ::: "memory"); else asm volatile("s_waitcnt vmcnt(0)" ::: "memory"); } while (0)
#define RESC(a) do { if (__any((a) < 1.f)) { if (hi == 0) al_l[r32] = (a); asm volatile("s_waitcnt lgkmcnt(0)" ::: "memory"); \
    for (int d = 0; d < 4; ++d) for (int r = 0; r < 16; ++r) o[d][r] *= al_l[crow(r, hi)]; } } while (0)
  f32x16 pA0, pA1, pB0, pB1; float mnA, mnB, alA, alB; bf16x8 pa0, pa1, pa2, pa3; const int NT = seq / KVBLK;
  constexpr int SE = 0, SO = SDEPTH - 1;
  SLOAD(SE, 0); asm volatile("s_waitcnt vmcnt(0)" ::: "memory"); SWRITE(0, SE); __syncthreads();
  qkt(pA0, pA1, K_lds, qr, r32, hi); partialSM(pA0, pA1, m_reg, mnA, alA);
  SLOAD(SO, KVBLK); if constexpr (SDEPTH == 2) { if (2 < NT) SLOAD(SE, 2 * KVBLK); }
  SWAIT(); SWRITE(1, SO); __syncthreads();
  for (int j = 1; j + 1 < NT; j += 2) {
    SBAR(); qkt(pB0, pB1, (bf16*)((char*)K_lds + SHM_K), qr, r32, hi);
    finishSM(pA0, pA1, alA, l_reg, pa0, pa1, pa2, pa3); SBAR();
    SLOAD(SO, (j + SDEPTH) * KVBLK); SBAR();
    pv_d0(o, vb0, pa0, pa1, pa2, pa3); partialSM(pB0, pB1, m_reg, mnB, alB);
    __syncthreads(); SWAIT(); SWRITE(0, SE);
    RESC(alB); __syncthreads();
    SBAR(); qkt(pA0, pA1, K_lds, qr, r32, hi);
    finishSM(pB0, pB1, alB, l_reg, pa0, pa1, pa2, pa3); SBAR();
    if (SDEPTH == 1 || j + 3 < NT) SLOAD(SE, (j + 1 + SDEPTH) * KVBLK); SBAR();
    pv_d0(o, vb0 + (int)SHM_V, pa0, pa1, pa2, pa3); partialSM(pA0, pA1, m_reg, mnA, alA);
    __syncthreads(); SWAIT(); SWRITE(1, SO);
    RESC(alA); __syncthreads();
  }
  SBAR(); qkt(pB0, pB1, (bf16*)((char*)K_lds + SHM_K), qr, r32, hi);
  finishSM(pA0, pA1, alA, l_reg, pa0, pa1, pa2, pa3); SBAR();
  pv_d0(o, vb0, pa0, pa1, pa2, pa3); partialSM(pB0, pB1, m_reg, mnB, alB);
  __syncthreads(); RESC(alB);
  finishSM(pB0, pB1, alB, l_reg, pa0, pa1, pa2, pa3); SBAR();
  pv_d0(o, vb0 + (int)SHM_V, pa0, pa1, pa2, pa3);
  if (hi == 0) li_l[r32] = l_reg; asm volatile("s_waitcnt lgkmcnt(0)" ::: "memory");
  float rli[16];
#pragma unroll
  for (int r = 0; r < 16; ++r) rli[r] = __builtin_amdgcn_rcpf(li_l[crow(r, hi)]);
  bf16* Ow = Ob + (long)(wid * QBLK) * LDO;
#pragma unroll
  for (int r = 0; r < 16; ++r) { int orow = crow(r, hi);
#if defined(ATT_O8) && ATT_O8
    for (int d0 = 0; d0 < 4; ++d0) ((unsigned char*)Ob)[((long)(wid * QBLK + orow)) * LDO + d0 * 32 + r32] = (unsigned char)(__builtin_amdgcn_cvt_pk_fp8_f32(o[d0][r] * rli[r] * ATT_O8_SCALE, 0.f, 0, false) & 0xff); }
#else
    for (int d0 = 0; d0 < 4; ++d0) Ow[(long)orow * LDO + d0 * 32 + r32] = f2bf_rne(o[d0][r] * rli[r]); }
#endif
#undef SLOAD
#undef SWRITE
#undef SWAIT
#undef RESC
}
#undef KSWZ
#undef SBAR
}

constexpr int DM = 2048, NB = 4, TS = 4096, NT = NB * TS, CL = 256, NC = NB * CL, MTOT = NT + NC, LKV = TS + CL;
constexpr int NPROJ = 9984;
constexpr int INW = 9760;
constexpr int NEXP = 16384;
constexpr float EPS = 1e-6f;
constexpr int NWAVES = 8;
constexpr int NPHASE = 14;

constexpr size_t MiB = 1u << 20;
constexpr size_t WS_CTL = 0, WS_MOD = 1 * MiB, WS_MODP = 2 * MiB, WS_SUBK = 10 * MiB, WS_WBA = 11 * MiB, WS_WBD = 15 * MiB, WS_WOUT = 19 * MiB, WS_WQ = 27 * MiB;
constexpr size_t WS_BETA = 35 * MiB, WS_LOGA = 37 * MiB, WS_EXPI = 39 * MiB, WS_EXPG = 47 * MiB;
constexpr size_t WS_A = 56 * MiB;
constexpr size_t WS_WIN = WS_A, WS_H = WS_A + 39 * MiB;
constexpr size_t WS_DQ = WS_A, WS_DK = WS_A + 34 * MiB, WS_DV = WS_A + 68 * MiB;
constexpr size_t WS_Y = WS_A, WS_H2 = WS_A;
constexpr size_t WS_B = 164 * MiB;
constexpr size_t WS_QN = WS_B, WS_Z = WS_B + 32 * MiB, WS_PQ = WS_B;
constexpr size_t WS_KB = 228 * MiB, WS_VB = 237 * MiB;
constexpr size_t WS_C = 246 * MiB;
constexpr size_t WS_DNRAW = WS_C, WS_U8 = WS_C, WS_V8 = WS_C + 32 * MiB, WS_SU = WS_C + 64 * MiB, WS_SV = WS_C + 65 * MiB, WS_U4 = WS_C + 66 * MiB;
constexpr size_t WS_KT = WS_C, WS_TINV = WS_C + 34 * MiB, WS_QKO = WS_C + 68 * MiB, WS_VEC = WS_C + 102 * MiB;
constexpr size_t WS_D = 374 * MiB;
constexpr size_t WS_G = WS_D, WS_X1 = WS_D;
constexpr size_t WS_AB2 = WS_MODP, WS_SH2 = WS_MODP + 32 * 1024, WS_BIASQ = WS_MODP + 64 * 1024, WS_SSQ = WS_MODP + 1 * MiB;
constexpr size_t WS_RSTD2 = WS_MODP + 4 * MiB;
constexpr size_t WS_WQB = WS_C;
constexpr size_t WS_OATT8 = WS_D + 64 * MiB, WS_ODNN8 = WS_D + 80 * MiB;
#if defined(ATT_O8) && ATT_O8
#define ATT_O8_ON 1
#else
#define ATT_O8_ON 0
#endif
#ifndef PQ_F8
#define PQ_F8 0
#endif
constexpr float X8_SCALE = 8.f, WQ8_SCALE = 64.f;
constexpr size_t WS_X18 = WS_A + 68 * MiB;
#ifndef OUT_F8
#define OUT_F8 0
#endif
constexpr float Y_SCALE = 16.f;
#ifndef MERGE_F8_2S
#define MERGE_F8_2S 0
#endif
#if MERGE_F8_2S
#define MERGE_F8_A 1
#define MERGE_F8_B 1
#endif
#ifndef MERGE_F8_A
#define MERGE_F8_A 0
#endif
#ifndef MERGE_F8_B
#define MERGE_F8_B 0
#endif
#ifndef U_ALL4
#define U_ALL4 1
#endif
constexpr float WB_SCALE = 64.f, OATT_SCALE = 16.f, ODNN_SCALE = 2.f;
constexpr size_t WS_ODN = 502 * MiB;
constexpr size_t WS_TABV = 566 * MiB, WS_TABU = 586 * MiB;
constexpr size_t WS_END = 606 * MiB;
static_assert((size_t)NPROJ * DM * 2 <= 39 * MiB && (size_t)MTOT * DM * 2 <= 69 * MiB && (size_t)MTOT * 1024 * 2 <= 34 * MiB && (size_t)MTOT * 3072 * 2 <= 128 * MiB, "ws map");
static_assert((size_t)NB * LKV * 256 * 2 <= 9 * MiB && (size_t)NT * 4096 * 2 <= 128 * MiB && (size_t)NEXP * DM * 2 <= 64 * MiB, "ws map");

constexpr int LDS_BYTES = 163840;

#define DI __device__ __forceinline__
#define LAS __attribute__((address_space(3)))
typedef unsigned short bf16;
typedef float f32x4 __attribute__((ext_vector_type(4)));
typedef float f32x2 __attribute__((ext_vector_type(2)));
typedef unsigned u32x4 __attribute__((ext_vector_type(4)));
typedef unsigned u32x2 __attribute__((ext_vector_type(2)));

typedef __bf16 bf16x2_n __attribute__((ext_vector_type(2)));
DI unsigned pk2(float lo, float hi) { const f32x2 v = {lo, hi}; return __builtin_bit_cast(unsigned, __builtin_convertvector(v, bf16x2_n)); }
DI unsigned f2bf(float f) { return pk2(f, f) & 0xffffu; }
DI float bflo(unsigned w) { return __uint_as_float(w << 16); }
DI float bfhi(unsigned w) { return __uint_as_float(w & 0xffff0000u); }
DI float bf2f(bf16 h) { return __uint_as_float((unsigned)h << 16); }
DI float wave_sum(float v) {
#pragma unroll
    for (int o = 1; o < 64; o <<= 1) v += __shfl_xor(v, o);
    return v;
}
DI unsigned wave_max_u32(unsigned v) {
#pragma unroll
    for (int o = 1; o < 64; o <<= 1) { const unsigned t = (unsigned)__shfl_xor((int)v, o); v = t > v ? t : v; }
    return v;
}
DI float sigm(float x) { return __builtin_amdgcn_rcpf(1.f + __expf(-x)); }
DI float silu(float x) { return x * __builtin_amdgcn_rcpf(1.f + __expf(-x)); }
DI float softplus(float x) { return x > 20.f ? x : log1pf(__expf(x)); }
DI float gelu_erf(float v) {
    const float av = fabsf(v), t = __builtin_amdgcn_rcpf(av * 0.2316418882f + 1.0f);
    float q = t * 0.5307027145f + (-0.7265760135f); q = q * t + 0.7107068705f; q = q * t + (-0.142248368f); q = q * t + 0.127414796f; q = q * t;
    const float e = __builtin_amdgcn_exp2f((v * v) * (-0.72134752044f));
    const float mm = v * (q * e);
    return v < 0.f ? mm : v - mm;
}
DI unsigned okey(float f) { const unsigned u = __float_as_uint(f); return (u & 0x80000000u) ? ~u : (u | 0x80000000u); }
DI unsigned rdlane(unsigned v, int l) { return (unsigned)__builtin_amdgcn_readlane((int)v, l); }
DI float rdlanef(float v, int l) { return __uint_as_float((unsigned)__builtin_amdgcn_readlane((int)__float_as_uint(v), l)); }

#define XB_TMO      128
#define XB_XCNT(j)  (256  + 64 * (j))
#define XB_XSUB(j)  (1280 + 64 * (j))
#define XB_XGEN(j)  (2304 + 64 * (j))
#define XB_TOP      3328
#define XB_TOPGEN   3392
#define XCD_BAR_WORDS 3456
#define XB_SPIN_CAP (1u << 18)

__device__ __forceinline__ unsigned xb_ld(unsigned* p)              { return __hip_atomic_load(p, __ATOMIC_RELAXED, __HIP_MEMORY_SCOPE_AGENT); }
__device__ __forceinline__ unsigned xb_add(unsigned* p, unsigned v) { return __hip_atomic_fetch_add(p, v, __ATOMIC_RELAXED, __HIP_MEMORY_SCOPE_AGENT); }
__device__ __forceinline__ unsigned xb_xcc_id() { return (unsigned)__builtin_amdgcn_s_getreg((3 << 11) | 20) & 0xFu; }
#define XB_SPIN(cond, bar) do { unsigned _sp = 0; while (cond) { __builtin_amdgcn_s_sleep(1); \
    if ((++_sp & 255u) == 0u) { if (xb_ld(&(bar)[XB_TMO])) break; if (_sp > XB_SPIN_CAP) { atomicAdd(&(bar)[XB_TMO], 1u); break; } } } } while (0)

struct XcdBarrier {
    unsigned* bar; unsigned x;
    volatile LAS unsigned* st;
};

__device__ __forceinline__ XcdBarrier xcd_barrier_post(unsigned* bar, volatile LAS unsigned* st) {
    XcdBarrier b; b.bar = bar; b.x = xb_xcc_id(); b.st = st;
    if (threadIdx.x == 0) (void)xb_add(&bar[XB_XCNT(b.x)], 1u);
    return b;
}
__device__ __forceinline__ void xcd_barrier_complete(unsigned* bar, unsigned x, unsigned& nloc, unsigned& nx) {
    const unsigned G = gridDim.x * gridDim.y * gridDim.z;
    unsigned sum, cnt, mine, sp = 0u;
    for (;;) {
        sum = 0u; cnt = 0u; mine = 0u;
#pragma unroll
        for (unsigned j = 0; j < 16; ++j) { const unsigned c = xb_ld(&bar[XB_XCNT(j)]); sum += c; cnt += (c > 0u) ? 1u : 0u; mine = (j == x) ? c : mine; }
        if (sum == G) break;
        __builtin_amdgcn_s_sleep(1);
        if ((++sp & 255u) == 0u) { if (xb_ld(&bar[XB_TMO])) break; if (sp > XB_SPIN_CAP) { atomicAdd(&bar[XB_TMO], 1u); break; } }
    }
    nloc = mine > 0u ? mine : 1u; nx = cnt > 0u ? cnt : 1u;
}

template <class W> __device__ __forceinline__ void xcd_barrier_w(const XcdBarrier& b, const W& work) {
    asm volatile("s_waitcnt vmcnt(0)" ::: "memory");
    __syncthreads();
    if (threadIdx.x == 0) {
        unsigned* bar = b.bar;
        __builtin_amdgcn_s_waitcnt(0);
        unsigned nloc = b.st[0], nx = b.st[1];
        if (nloc == 0u) { xcd_barrier_complete(bar, b.x, nloc, nx); b.st[0] = nloc; b.st[1] = nx; }
        const unsigned old = xb_add(&bar[XB_XSUB(b.x)], 1u);
        const unsigned gen = old / nloc;
        if (old + 1u == (gen + 1u) * nloc) {
            __builtin_amdgcn_fence(__ATOMIC_RELEASE, "agent");
            asm volatile("s_waitcnt vmcnt(0)" ::: "memory");
            const unsigned og = xb_add(&bar[XB_TOP], 1u);
            const unsigned tg = og / nx;
            if (og + 1u == (tg + 1u) * nx) xb_add(&bar[XB_TOPGEN], 1u);
            else XB_SPIN(xb_ld(&bar[XB_TOPGEN]) == tg, bar);
            __builtin_amdgcn_fence(__ATOMIC_ACQUIRE, "agent");
            xb_add(&bar[XB_XGEN(b.x)], 1u);
            asm volatile("s_waitcnt vmcnt(0)" ::: "memory");
        } else {
            XB_SPIN(xb_ld(&bar[XB_XGEN(b.x)]) == gen, bar);
            __builtin_amdgcn_fence(__ATOMIC_ACQUIRE, "agent");
            asm volatile("s_waitcnt vmcnt(0)" ::: "memory");
        }
    } else if (threadIdx.x >= 64) work();
    __syncthreads();
}
struct NoShadowWork { __device__ __forceinline__ void operator()() const {} };
__device__ __forceinline__ void xcd_barrier(const XcdBarrier& b) { xcd_barrier_w(b, NoShadowWork{}); }

#define RAW_BAR() do { asm volatile("s_waitcnt lgkmcnt(0)" ::: "memory"); __builtin_amdgcn_s_barrier(); asm volatile("" ::: "memory"); } while (0)

DI unsigned pk4_fp8(float a, float b, float c, float d) { int w = __builtin_amdgcn_cvt_pk_fp8_f32(a, b, 0, false); w = __builtin_amdgcn_cvt_pk_fp8_f32(c, d, w, true); return (unsigned)w; }
DI float fp8c(float x) { return fminf(fmaxf(x, -448.f), 448.f); }
constexpr float WIN_SCALE = 64.f;

struct Frame {
    LAS unsigned char* lds;
    unsigned char* ws;
    const float* in[23];
    float* out;
    int tid, lane, wave, vcu, G, gw, NGW;
};

DI size_t dn_off(int m, int h) {
    int b, pos; if (m < NT) { b = m >> 12; pos = 256 + (m & 4095); } else { const int mm = m - NT; b = mm >> 8; pos = mm & 255; }
    return ((size_t)(b * 8 + h) * 4352 + pos) * 128;
}

struct EpiInProj {
    static constexpr bool PERM = true, AFTER_DRAIN = false, TWO_STAGE = false, SEL_B = false;
    unsigned char* ws; const float* a_log; const float* dt_bias;
    DI void operator()(const pg8::f32x4 (&acc)[2][2][4][2], const pg8::Unit& u, int wr, int wc, int fr, int fq) const {
        asm volatile("" : "+v"(fr), "+v"(fq));
        const int pn = u.pn, pm = u.pm; const bool isctx = pm >= 64;
        if (pn == 38) {
            if (wc != 0) return;
            float* dstf = (float*)(ws + (fq < 2 ? WS_BETA : WS_LOGA));
            const int c8 = (fq & 1) * 8;
            f32x4 na[2], db[2];
#pragma unroll
            for (int n = 0; n < 2; ++n) { const f32x4 al = *(const f32x4*)(a_log + c8 + 4 * n); db[n] = *(const f32x4*)(dt_bias + c8 + 4 * n);
#pragma unroll
                for (int i = 0; i < 4; ++i) na[n][i] = -__expf(al[i]); }
#pragma unroll
            for (int ai = 0; ai < 2; ++ai)
#pragma unroll
                for (int m = 0; m < 4; ++m) {
                    const int row = pm * 256 + ai * 128 + wr * 64 + m * 16 + fr;
#pragma unroll
                    for (int n = 0; n < 2; ++n) {
                        f32x4 v = acc[ai][0][m][n] * (1.f / WIN_SCALE), o;
#pragma unroll
                        for (int i = 0; i < 4; ++i) {
                            const float xs = v[i] + db[n][i];
                            const float sp = fmaxf(xs, 0.f) + __logf(1.f + __expf(-fabsf(xs)));
                            const float sgm = sigm(v[i]);
                            o[i] = (fq < 2) ? sgm : na[n][i] * sp;
                        }
                        *(f32x4*)(dstf + (size_t)row * 16 + c8 + 4 * n) = o;
                    }
                }
            return;
        }
        bf16* dst; int ld, coloff, rowoff = 0; bool sg = false;
        if (pn < 4) { if (isctx) return; dst = (bf16*)(ws + WS_QN); ld = 1024; coloff = pn * 256; }
        else if (pn < 6) { dst = (bf16*)(ws + (pn == 4 ? WS_KB : WS_VB)); ld = 256; coloff = 0; rowoff = isctx ? (-12288 + (pm - 64) * 4096) : (pm >> 4) * 256; }
        else if (pn < 18) { dst = (bf16*)(ws + WS_DNRAW); ld = 3072; coloff = (pn - 6) * 256; }
        else if (pn < 22) { if (isctx) return; dst = (bf16*)(ws + WS_Z); ld = 1024; coloff = (pn - 18) * 256; }
        else { if (isctx) return; dst = (bf16*)(ws + WS_G); ld = 4096; coloff = (pn - 22) * 256; sg = true; }
        const int row0 = pm * 256 + rowoff + wr * 64 + fr, col0 = coloff + wc * 32 + 8 * fq;
#pragma unroll
        for (int ai = 0; ai < 2; ++ai)
#pragma unroll
            for (int m = 0; m < 4; ++m) {
                bf16* rowp = dst + (size_t)(row0 + ai * 128 + m * 16) * ld + col0;
#pragma unroll
                for (int bj = 0; bj < 2; ++bj) {
                    f32x4 v0 = acc[ai][bj][m][0] * (1.f / WIN_SCALE), v1 = acc[ai][bj][m][1] * (1.f / WIN_SCALE);
                    if (sg) {
                        u32x2 gb; gb.x = 0u; gb.y = 0u;
#pragma unroll
                        for (int i = 0; i < 4; ++i) { gb.x |= (unsigned)(sigm(v0[i]) * 255.f + 0.5f) << (8 * i); gb.y |= (unsigned)(sigm(v1[i]) * 255.f + 0.5f) << (8 * i); }
                        __builtin_nontemporal_store(gb, (u32x2*)((unsigned char*)dst + (size_t)(row0 + ai * 128 + m * 16) * 4096 + col0 + bj * 128));
                        continue;
                    }
                    u32x4 w; w.x = pg8::cvt_pk_bf16(v0[0], v0[1]); w.y = pg8::cvt_pk_bf16(v0[2], v0[3]); w.z = pg8::cvt_pk_bf16(v1[0], v1[1]); w.w = pg8::cvt_pk_bf16(v1[2], v1[3]);
                    __builtin_nontemporal_store(w, (u32x4*)(rowp + bj * 128));
                }
            }
    }
};


struct InProjOrder {
    pg8::StaticOrder lat; int G, c;
    static constexpr int NLAT = 64 * 39, NCTX = 4 * 15;
    DI void init(int G_, int c_) { lat.init(NT, NPROJ, G_, c_); G = G_; c = c_; }
    DI bool next(int i, pg8::Unit& u) const {
        const int L = i * G + c;
        if (L < NLAT) return lat.next(i, u);
        const int x = L - NLAT; if (x >= NCTX) return false;
        const int j = x % 15; u.pm = 64 + x / 15; u.pn = j < 2 ? 4 + j : (j < 14 ? 4 + j : 38); return true;
    }
    DI void a_ready(const pg8::Unit&) const {}
    DI void done(const pg8::Unit&) const {}
};

struct EpiPlain {
    static constexpr bool PERM = true, AFTER_DRAIN = false, TWO_STAGE = false, SEL_B = false;
    bf16* O; int ldc;
    DI void operator()(const pg8::f32x4 (&acc)[2][2][4][2], const pg8::Unit& u, int wr, int wc, int fr, int fq) const {
        const int row0 = u.pm * 256 + wr * 64 + fr, col0 = u.pn * 256 + wc * 32 + 8 * fq;
#pragma unroll
        for (int ai = 0; ai < 2; ++ai)
#pragma unroll
            for (int m = 0; m < 4; ++m) {
                bf16* rowp = O + (size_t)(row0 + ai * 128 + m * 16) * ldc + col0;
#pragma unroll
                for (int bj = 0; bj < 2; ++bj) {
                    const f32x4 v0 = acc[ai][bj][m][0], v1 = acc[ai][bj][m][1];
                    u32x4 w; w.x = pg8::cvt_pk_bf16(v0[0], v0[1]); w.y = pg8::cvt_pk_bf16(v0[2], v0[3]); w.z = pg8::cvt_pk_bf16(v1[0], v1[1]); w.w = pg8::cvt_pk_bf16(v1[2], v1[3]);
                    *(u32x4*)(rowp + bj * 128) = w;
                }
            }
    }
};

struct EpiPQ {
    static constexpr bool PERM = true, AFTER_DRAIN = false, TWO_STAGE = false, SEL_B = true;
    bf16* O; const float* bias; const float* ssq;
    DI void operator()(const pg8::f32x4 (&acc)[2][2][4][2], const pg8::Unit& u, int wr, int wc, int fr, int fq) const {
        const int row0 = u.pm * 256 + wr * 64 + fr, col0 = u.pn * 256 + wc * 32 + 8 * fq;
        const float* bp = bias + (size_t)(u.pm >> 4) * 2048 + col0;
        float rr[2][4];
        {
            f32x4 s0[2][4], s1[2][4];
#pragma unroll
            for (int ai = 0; ai < 2; ++ai)
#pragma unroll
                for (int m = 0; m < 4; ++m) { const f32x4* sp = (const f32x4*)(ssq + (size_t)(row0 + ai * 128 + m * 16) * 32 + 8 * fq); s0[ai][m] = sp[0]; s1[ai][m] = sp[1]; }
            __builtin_amdgcn_sched_barrier(0);
#pragma unroll
            for (int ai = 0; ai < 2; ++ai)
#pragma unroll
                for (int m = 0; m < 4; ++m) rr[ai][m] = ((s0[ai][m][0] + s0[ai][m][1]) + (s0[ai][m][2] + s0[ai][m][3])) + ((s1[ai][m][0] + s1[ai][m][1]) + (s1[ai][m][2] + s1[ai][m][3]));
#pragma unroll
            for (int o = 16; o < 64; o <<= 1)
#pragma unroll
                for (int ai = 0; ai < 2; ++ai)
#pragma unroll
                    for (int m = 0; m < 4; ++m) rr[ai][m] += __shfl_xor(rr[ai][m], o);
#pragma unroll
            for (int ai = 0; ai < 2; ++ai)
#pragma unroll
                for (int m = 0; m < 4; ++m) rr[ai][m] = rsqrtf(rr[ai][m] * (1.f / DM) + EPS);
        }
        f32x4 bv[2][2];
#pragma unroll
        for (int bj = 0; bj < 2; ++bj) { bv[bj][0] = *(const f32x4*)(bp + bj * 128); bv[bj][1] = *(const f32x4*)(bp + bj * 128 + 4); }
#pragma unroll
        for (int ai = 0; ai < 2; ++ai)
#pragma unroll
            for (int m = 0; m < 4; ++m) {
                bf16* rowp = O + (size_t)(row0 + ai * 128 + m * 16) * 2048 + col0;
#pragma unroll
                for (int bj = 0; bj < 2; ++bj) {
                    const float rq = rr[ai][m] * (PQ_F8 ? 1.f / (X8_SCALE * WQ8_SCALE) : 1.f);
                    const f32x4 v0 = acc[ai][bj][m][0] * rq + bv[bj][0], v1 = acc[ai][bj][m][1] * rq + bv[bj][1];
                    u32x4 w; w.x = pg8::cvt_pk_bf16(v0[0], v0[1]); w.y = pg8::cvt_pk_bf16(v0[2], v0[3]); w.z = pg8::cvt_pk_bf16(v1[0], v1[1]); w.w = pg8::cvt_pk_bf16(v1[2], v1[3]);
                    *(u32x4*)(rowp + bj * 128) = w;
                }
            }
    }
};

template <bool ADD> struct EpiMerge {
    static constexpr bool PERM = true, AFTER_DRAIN = false, TWO_STAGE = false, SEL_B = false;
    bf16* Y; const unsigned char* G; int goff; float gs;
    DI void operator()(const pg8::f32x4 (&acc)[2][2][4][2], const pg8::Unit& u, int wr, int wc, int fr, int fq) const {
        const int row0 = u.pm * 256 + wr * 64 + fr, col0 = u.pn * 256 + wc * 32 + 8 * fq;
#pragma unroll
        for (int ai = 0; ai < 2; ++ai)
#pragma unroll
            for (int m = 0; m < 4; ++m) {
                const size_t row = (size_t)(row0 + ai * 128 + m * 16);
#pragma unroll
                for (int bj = 0; bj < 2; ++bj) {
                    const f32x4 v0 = acc[ai][bj][m][0], v1 = acc[ai][bj][m][1];
                    const u32x2 g = __builtin_nontemporal_load((const u32x2*)(G + row * 4096 + goff + col0 + bj * 128));
                    float r[8];
#pragma unroll
                    for (int i = 0; i < 4; ++i) { r[i] = (float)((g.x >> (8 * i)) & 0xffu) * gs * v0[i]; r[4 + i] = (float)((g.y >> (8 * i)) & 0xffu) * gs * v1[i]; }
                    bf16* yp = Y + row * 2048 + col0 + bj * 128;
                    if (ADD) {
                        const u32x4 y = *(const u32x4*)yp;
                        r[0] += bflo(y.x); r[1] += bfhi(y.x); r[2] += bflo(y.y); r[3] += bfhi(y.y); r[4] += bflo(y.z); r[5] += bfhi(y.z); r[6] += bflo(y.w); r[7] += bfhi(y.w);
                    }
                    u32x4 w; w.x = pg8::cvt_pk_bf16(r[0], r[1]); w.y = pg8::cvt_pk_bf16(r[2], r[3]); w.z = pg8::cvt_pk_bf16(r[4], r[5]); w.w = pg8::cvt_pk_bf16(r[6], r[7]);
                    *(u32x4*)yp = w;
                }
            }
    }
};

struct EpiMerge2 {
    static constexpr bool PERM = true, AFTER_DRAIN = false, TWO_STAGE = true, SEL_B = false;
    bf16* Y; const unsigned char* G; float rmid, rfin;
    DI void mid(pg8::f32x4 (&acc)[2][2][4][2], const pg8::Unit& u, int wr, int wc, int fr, int fq) const {
        const int row0 = u.pm * 256 + wr * 64 + fr, col0 = u.pn * 256 + wc * 32 + 8 * fq;
#pragma unroll
        for (int ai = 0; ai < 2; ++ai)
#pragma unroll
            for (int m = 0; m < 4; ++m) {
                const size_t row = (size_t)(row0 + ai * 128 + m * 16);
#pragma unroll
                for (int bj = 0; bj < 2; ++bj) {
                    const u32x2 ga = __builtin_nontemporal_load((const u32x2*)(G + row * 4096 + col0 + bj * 128));
                    const u32x2 gd = *(const u32x2*)(G + row * 4096 + 2048 + col0 + bj * 128);
#pragma unroll
                    for (int i = 0; i < 4; ++i) {
                        acc[ai][bj][m][0][i] *= (float)((ga.x >> (8 * i)) & 0xffu) * rmid * __builtin_amdgcn_rcpf(fmaxf((float)((gd.x >> (8 * i)) & 0xffu), 1.f));
                        acc[ai][bj][m][1][i] *= (float)((ga.y >> (8 * i)) & 0xffu) * rmid * __builtin_amdgcn_rcpf(fmaxf((float)((gd.y >> (8 * i)) & 0xffu), 1.f));
                    }
                }
            }
    }
    DI void operator()(const pg8::f32x4 (&acc)[2][2][4][2], const pg8::Unit& u, int wr, int wc, int fr, int fq) const {
        const int row0 = u.pm * 256 + wr * 64 + fr, col0 = u.pn * 256 + wc * 32 + 8 * fq;
#pragma unroll
        for (int ai = 0; ai < 2; ++ai)
#pragma unroll
            for (int m = 0; m < 4; ++m) {
                const size_t row = (size_t)(row0 + ai * 128 + m * 16);
#pragma unroll
                for (int bj = 0; bj < 2; ++bj) {
                    const f32x4 v0 = acc[ai][bj][m][0], v1 = acc[ai][bj][m][1];
                    const u32x2 g = __builtin_nontemporal_load((const u32x2*)(G + row * 4096 + 2048 + col0 + bj * 128));
                    float r[8];
#pragma unroll
                    for (int i = 0; i < 4; ++i) { r[i] = fmaxf((float)((g.x >> (8 * i)) & 0xffu), 1.f) * rfin * v0[i]; r[4 + i] = fmaxf((float)((g.y >> (8 * i)) & 0xffu), 1.f) * rfin * v1[i]; }
                    if (OUT_F8) { u32x2 w8; w8.x = pk4_fp8(fp8c(r[0] * Y_SCALE), fp8c(r[1] * Y_SCALE), fp8c(r[2] * Y_SCALE), fp8c(r[3] * Y_SCALE)); w8.y = pk4_fp8(fp8c(r[4] * Y_SCALE), fp8c(r[5] * Y_SCALE), fp8c(r[6] * Y_SCALE), fp8c(r[7] * Y_SCALE));
                        *(u32x2*)((unsigned char*)Y + row * 2048 + col0 + bj * 128) = w8; }
                    else {
                    u32x4 w; w.x = pg8::cvt_pk_bf16(r[0], r[1]); w.y = pg8::cvt_pk_bf16(r[2], r[3]); w.z = pg8::cvt_pk_bf16(r[4], r[5]); w.w = pg8::cvt_pk_bf16(r[6], r[7]);
                    *(u32x4*)(Y + row * 2048 + col0 + bj * 128) = w; }
                }
            }
    }
};

struct EpiResid {
    static constexpr bool PERM = true, AFTER_DRAIN = false, TWO_STAGE = false, SEL_B = false;
    const float* x; bf16* X1; const float* mod; float* ssq; unsigned char* x8;
    DI void operator()(const pg8::f32x4 (&acc)[2][2][4][2], const pg8::Unit& u, int wr, int wc, int fr, int fq) const {
        const int row0 = u.pm * 256 + wr * 64 + fr, col0 = u.pn * 256 + wc * 32 + 8 * fq;
        const float* g1 = mod + (size_t)(u.pm >> 4) * 12288 + 2 * 2048;
        f32x4 gv[2][2];
#pragma unroll
        for (int bj = 0; bj < 2; ++bj)
#pragma unroll
            for (int n = 0; n < 2; ++n) gv[bj][n] = *(const f32x4*)(g1 + col0 + bj * 128 + n * 4) * (OUT_F8 ? 1.f / (WB_SCALE * Y_SCALE) : 1.f);
#pragma unroll
        for (int ai = 0; ai < 2; ++ai)
#pragma unroll
            for (int m = 0; m < 4; ++m) {
                const size_t off = (size_t)(row0 + ai * 128 + m * 16) * 2048 + col0;
                float ssr = 0.f;
#pragma unroll
                for (int bj = 0; bj < 2; ++bj) {
                    const f32x4 x0 = __builtin_nontemporal_load((const f32x4*)(x + off + bj * 128)), x1 = __builtin_nontemporal_load((const f32x4*)(x + off + bj * 128 + 4));
                    const f32x4 v0 = x0 + gv[bj][0] * acc[ai][bj][m][0], v1 = x1 + gv[bj][1] * acc[ai][bj][m][1];
                    u32x4 w; w.x = pk2(v0[0], v0[1]); w.y = pk2(v0[2], v0[3]); w.z = pk2(v1[0], v1[1]); w.w = pk2(v1[2], v1[3]);
                    *(u32x4*)(X1 + off + bj * 128) = w;
                    if (PQ_F8) { u32x2 w8; w8.x = pk4_fp8(fp8c(v0[0] * X8_SCALE), fp8c(v0[1] * X8_SCALE), fp8c(v0[2] * X8_SCALE), fp8c(v0[3] * X8_SCALE)); w8.y = pk4_fp8(fp8c(v1[0] * X8_SCALE), fp8c(v1[1] * X8_SCALE), fp8c(v1[2] * X8_SCALE), fp8c(v1[3] * X8_SCALE));
                        *(u32x2*)(x8 + off + bj * 128) = w8; }
                    ssr += (v0[0] * v0[0] + v0[1] * v0[1]) + (v0[2] * v0[2] + v0[3] * v0[3]) + (v1[0] * v1[0] + v1[1] * v1[1]) + (v1[2] * v1[2] + v1[3] * v1[3]);
                }
                ssr += __shfl_xor(ssr, 16); ssr += __shfl_xor(ssr, 32);
                if (fq == 0) ssq[(size_t)(row0 + ai * 128 + m * 16) * 32 + u.pn * 4 + wc] = ssr;
            }
    }
};

DI void transpose_item(const float* W, int K, int Nsrc, int sn0, bf16* WT, int dn0, int k0, LAS float* scr, int lane) {
    if (sn0 >= 0) {
        float t[32];
#pragma unroll
        for (int i = 0; i < 32; ++i) t[i] = __builtin_nontemporal_load(&W[(size_t)(k0 + 2 * i + (lane >> 5)) * Nsrc + sn0 + (lane & 31)]);
#pragma unroll
        for (int i = 0; i < 32; ++i) scr[(2 * i + (lane >> 5)) * 33 + (lane & 31)] = t[i];
    } else {
#pragma unroll 8
        for (int i = 0; i < 32; ++i) { const int kk = 2 * i + (lane >> 5); scr[kk * 33 + (lane & 31)] = 0.f; }
    }
    asm volatile("s_waitcnt lgkmcnt(0)" ::: "memory");
    const int c = lane & 7;
#pragma unroll
    for (int j = 0; j < 4; ++j) {
        const int n = (lane >> 3) + 8 * j; const LAS float* s = scr + (8 * c) * 33 + n;
        u32x4 o; o.x = pk2(s[0 * 33], s[1 * 33]); o.y = pk2(s[2 * 33], s[3 * 33]); o.z = pk2(s[4 * 33], s[5 * 33]); o.w = pk2(s[6 * 33], s[7 * 33]);
        *(u32x4*)(WT + (size_t)(dn0 + n) * K + k0 + 8 * c) = o;
    }
    asm volatile("s_waitcnt lgkmcnt(0)" ::: "memory");
}

DI void transpose_item_fp8(const float* W, int K, int Nsrc, int sn0, unsigned char* WT, int dn0, int k0, float scale, LAS float* scr, int lane) {
    if (sn0 >= 0) {
        float t[32];
#pragma unroll
        for (int i = 0; i < 32; ++i) t[i] = __builtin_nontemporal_load(&W[(size_t)(k0 + 2 * i + (lane >> 5)) * Nsrc + sn0 + (lane & 31)]);
#pragma unroll
        for (int i = 0; i < 32; ++i) scr[(2 * i + (lane >> 5)) * 33 + (lane & 31)] = t[i] * scale;
    } else {
#pragma unroll 8
        for (int i = 0; i < 32; ++i) { const int kk = 2 * i + (lane >> 5); scr[kk * 33 + (lane & 31)] = 0.f; }
    }
    asm volatile("s_waitcnt lgkmcnt(0)" ::: "memory");
    const int c = lane & 7;
#pragma unroll
    for (int j = 0; j < 4; ++j) {
        const int n = (lane >> 3) + 8 * j; const LAS float* s = scr + (8 * c) * 33 + n;
        u32x2 o; o.x = pk4_fp8(s[0 * 33], s[1 * 33], s[2 * 33], s[3 * 33]); o.y = pk4_fp8(s[4 * 33], s[5 * 33], s[6 * 33], s[7 * 33]);
        *(u32x2*)(WT + (size_t)(dn0 + n) * K + k0 + 8 * c) = o;
    }
    asm volatile("s_waitcnt lgkmcnt(0)" ::: "memory");
}

DI void cvt_bf16_stream(const float* src, bf16* dst, size_t n8, size_t gtid, size_t nthr) {
    for (size_t i = gtid; i < n8; i += nthr) {
        const f32x4 a = *(const f32x4*)(src + i * 8), b = *(const f32x4*)(src + i * 8 + 4);
        u32x4 w; w.x = pk2(a[0], a[1]); w.y = pk2(a[2], a[3]); w.z = pk2(b[0], b[1]); w.w = pk2(b[2], b[3]);
        *(u32x4*)(dst + i * 8) = w;
    }
}

DI void transpose_late(const Frame& F, int r, LAS float* scr) {
    constexpr int I_WB = 16 * 64, I_WO = 32 * 64;
    if (r < I_WB) {
        if (MERGE_F8_A) transpose_item_fp8(F.in[15], 1024, DM, (r % 64) * 32, F.ws + WS_WBA, (r % 64) * 32, (r / 64) * 64, WB_SCALE, scr, F.lane);
        else transpose_item(F.in[15], 1024, DM, (r % 64) * 32, (bf16*)(F.ws + WS_WBA), (r % 64) * 32, (r / 64) * 64, scr, F.lane);
        return; }
    r -= I_WB;
    if (r < I_WB) {
        if (MERGE_F8_B) transpose_item_fp8(F.in[16], 1024, DM, (r % 64) * 32, F.ws + WS_WBD, (r % 64) * 32, (r / 64) * 64, WB_SCALE, scr, F.lane);
        else transpose_item(F.in[16], 1024, DM, (r % 64) * 32, (bf16*)(F.ws + WS_WBD), (r % 64) * 32, (r / 64) * 64, scr, F.lane);
        return; }
    r -= I_WB;
    if (r < I_WO) {
        if (OUT_F8) transpose_item_fp8(F.in[17], DM, DM, (r % 64) * 32, F.ws + WS_WOUT, (r % 64) * 32, (r / 64) * 64, WB_SCALE, scr, F.lane);
        else transpose_item(F.in[17], DM, DM, (r % 64) * 32, (bf16*)(F.ws + WS_WOUT), (r % 64) * 32, (r / 64) * 64, scr, F.lane);
        return; }
    r -= I_WO;
    transpose_item(F.in[18], DM, DM, (r % 64) * 32, (bf16*)(F.ws + WS_WQ), (r % 64) * 32, (r / 64) * 64, scr, F.lane);
}

DI void phase_prologue(Frame& F) {
    LAS float* scr = (LAS float*)(F.lds + F.wave * 16384);
    constexpr int I_WIN = 32 * 312, I_WB = 16 * 64, I_WO = 32 * 64;
    constexpr int NITEMS = I_WIN + 2 * I_WB + 2 * I_WO;
#ifndef PRO_REP_T
#define PRO_REP_T 1
#endif
#ifndef PRO_REP_G
#define PRO_REP_G 1
#endif
#pragma nounroll
    for (int rep_t = 0; rep_t < PRO_REP_T; ++rep_t)
    for (int it = F.gw; it < (F.G == 256 ? I_WIN : NITEMS); it += F.NGW) {
        int r = it;
        if (r < I_WIN) { const int kb = r / 312, nb = r % 312; const int snb = nb < 176 ? nb : (nb < 304 ? nb + 1 : (nb == 304 ? 176 : -1));
            transpose_item_fp8(F.in[8], DM, INW, snb < 0 ? -1 : snb * 32, F.ws + WS_WIN, nb * 32, kb * 64, WIN_SCALE, scr, F.lane); continue; }
        transpose_late(F, r - I_WIN, scr);
    }
    cvt_bf16_stream(F.in[19], (bf16*)(F.ws + WS_SUBK), (size_t)8 * 2 * 128 * 128 / 8, (size_t)blockIdx.x * 512 + F.tid, (size_t)F.G * 512);
    LAS float* sc = (LAS float*)(F.lds + 131072);
    const float* ada_w = F.in[4];
    float* MODP = (float*)(F.ws + WS_MODP);
#pragma nounroll
    for (int rep_g = 0; rep_g < PRO_REP_G; ++rep_g)
    for (int it = blockIdx.x; it < 32 * 24; it += F.G) {
        const int kc = it / 24, nb = it % 24, n = nb * 512 + F.tid;
        __syncthreads();
        if (F.tid < 320) { const int r = F.tid >> 6, kk = F.tid & 63, k = kc * 64 + kk; const float cv = (r < 4) ? F.in[1][r * DM + k] : F.in[3][k]; sc[r * 64 + kk] = silu(cv); }
        __syncthreads();
        float a0 = 0.f, a1 = 0.f, a2 = 0.f, a3 = 0.f, a4 = 0.f;
#pragma unroll 32
        for (int kk = 0; kk < 64; ++kk) {
            const float w = __builtin_nontemporal_load(&ada_w[(size_t)(kc * 64 + kk) * 12288 + n]);
            a0 += sc[kk] * w; a1 += sc[64 + kk] * w; a2 += sc[128 + kk] * w; a3 += sc[192 + kk] * w; a4 += sc[256 + kk] * w;
        }
        float* o = MODP + (size_t)kc * 5 * 12288 + n;
        o[0] = a0; o[12288] = a1; o[2 * 12288] = a2; o[3 * 12288] = a3; o[4 * 12288] = a4;
    }
}

DI void phase_modreduce(Frame& F) {
    const float* MODP = (const float*)(F.ws + WS_MODP); float* MOD = (float*)(F.ws + WS_MOD); const float* ada_b = F.in[5];
    for (int i = blockIdx.x * 512 + F.tid; i < 5 * 12288; i += F.G * 512) {
        const int n = i % 12288; float s = ada_b[n];
#pragma unroll 8
        for (int kc = 0; kc < 32; ++kc) s += MODP[(size_t)kc * 5 * 12288 + i];
        MOD[i] = s;
    }
}

DI void modnorm_row(const float* xrow, bf16* orow, const float* nw, const float* sc, const float* sh, int lane) {
    f32x4 v[8]; float ss = 0.f;
#pragma unroll
    for (int j = 0; j < 8; ++j) { v[j] = *((const f32x4*)xrow + lane + 64 * j); ss += (v[j][0] * v[j][0] + v[j][1] * v[j][1]) + (v[j][2] * v[j][2] + v[j][3] * v[j][3]); }
    const float rstd = rsqrtf(wave_sum(ss) * (1.f / DM) + EPS);
#pragma unroll
    for (int j = 0; j < 8; ++j) {
        const int c = (lane + 64 * j) * 4;
        const f32x4 w = *(const f32x4*)(nw + c), s = *(const f32x4*)(sc + c), h = *(const f32x4*)(sh + c);
        f32x4 o;
#pragma unroll
        for (int i = 0; i < 4; ++i) o[i] = (v[j][i] * rstd * w[i]) * (1.f + s[i]) + h[i];
        u32x2 p; p.x = pk2(o[0], o[1]); p.y = pk2(o[2], o[3]);
        *(u32x2*)(orow + c) = p;
    }
}

DI void modnorm_row_bf(const bf16* xrow, bf16* orow, const float* nw, const float* sc, const float* sh, int lane) {
    f32x4 v[8]; float ss = 0.f;
#pragma unroll
    for (int j = 0; j < 8; ++j) { const u32x2 w = *((const u32x2*)xrow + lane + 64 * j); v[j] = (f32x4){bflo(w.x), bfhi(w.x), bflo(w.y), bfhi(w.y)}; ss += (v[j][0] * v[j][0] + v[j][1] * v[j][1]) + (v[j][2] * v[j][2] + v[j][3] * v[j][3]); }
    const float rstd = rsqrtf(wave_sum(ss) * (1.f / DM) + EPS);
#pragma unroll
    for (int j = 0; j < 8; ++j) {
        const int c = (lane + 64 * j) * 4;
        const f32x4 w = *(const f32x4*)(nw + c), s = *(const f32x4*)(sc + c), h = *(const f32x4*)(sh + c);
        f32x4 o;
#pragma unroll
        for (int i = 0; i < 4; ++i) o[i] = (v[j][i] * rstd * w[i]) * (1.f + s[i]) + h[i];
        u32x2 p; p.x = pk2(o[0], o[1]); p.y = pk2(o[2], o[3]);
        *(u32x2*)(orow + c) = p;
    }
}

DI void modnorm_row_fp8(const float* xrow, unsigned char* orow, const float* nw, const float* sc, const float* sh, int lane) {
    f32x4 v[8]; float ss = 0.f;
#pragma unroll
    for (int j = 0; j < 8; ++j) { v[j] = __builtin_nontemporal_load((const f32x4*)xrow + lane + 64 * j); ss += (v[j][0] * v[j][0] + v[j][1] * v[j][1]) + (v[j][2] * v[j][2] + v[j][3] * v[j][3]); }
    const float rstd = rsqrtf(wave_sum(ss) * (1.f / DM) + EPS);
#pragma unroll
    for (int j = 0; j < 8; ++j) {
        const int c = (lane + 64 * j) * 4;
        const f32x4 w = *(const f32x4*)(nw + c), s = *(const f32x4*)(sc + c), h = *(const f32x4*)(sh + c);
        f32x4 o;
#pragma unroll
        for (int i = 0; i < 4; ++i) o[i] = (v[j][i] * rstd * w[i]) * (1.f + s[i]) + h[i];
        *(unsigned*)(orow + c) = pk4_fp8(o[0], o[1], o[2], o[3]);
    }
}

struct ModPar { f32x4 a[8], h[8]; };
DI void modpar_load(ModPar& P, const float* nw, const float* sc, const float* sh, int lane) {
#pragma unroll
    for (int j = 0; j < 8; ++j) { const int c = (lane + 64 * j) * 4; const f32x4 w = *(const f32x4*)(nw + c), s = *(const f32x4*)(sc + c); P.a[j] = w * (1.f + s); P.h[j] = *(const f32x4*)(sh + c); }
}
DI void modnorm_rows_fp8(const float* x0, unsigned char* o0, int nrows, const ModPar& P, int lane) {
    f32x4 v[8];
#pragma unroll
    for (int j = 0; j < 8; ++j) v[j] = __builtin_nontemporal_load((const f32x4*)x0 + lane + 64 * j);
    for (int r = 0; r < nrows; ++r) {
        float ss = 0.f;
#pragma unroll
        for (int j = 0; j < 8; ++j) ss += (v[j][0] * v[j][0] + v[j][1] * v[j][1]) + (v[j][2] * v[j][2] + v[j][3] * v[j][3]);
        const float rstd = rsqrtf(wave_sum(ss) * (1.f / DM) + EPS);
        unsigned char* orow = o0 + (size_t)r * DM;
        const float* xn = x0 + (size_t)(r + 1 < nrows ? r + 1 : r) * DM;
#pragma unroll
        for (int j = 0; j < 8; ++j) {
            const f32x4 o = (v[j] * rstd) * P.a[j] + P.h[j];
            v[j] = __builtin_nontemporal_load((const f32x4*)xn + lane + 64 * j);
            *(unsigned*)(orow + (lane + 64 * j) * 4) = pk4_fp8(o[0], o[1], o[2], o[3]);
        }
    }
}
DI void modnorm_rows_bf(const bf16* x0, bf16* o0, int nrows, const ModPar& P, int lane) {
    u32x2 w[8];
#pragma unroll
    for (int j = 0; j < 8; ++j) w[j] = *((const u32x2*)x0 + lane + 64 * j);
    for (int r = 0; r < nrows; ++r) {
        f32x4 v[8]; float ss = 0.f;
#pragma unroll
        for (int j = 0; j < 8; ++j) { v[j] = (f32x4){bflo(w[j].x), bfhi(w[j].x), bflo(w[j].y), bfhi(w[j].y)}; ss += (v[j][0] * v[j][0] + v[j][1] * v[j][1]) + (v[j][2] * v[j][2] + v[j][3] * v[j][3]); }
        const float rstd = rsqrtf(wave_sum(ss) * (1.f / DM) + EPS);
        bf16* orow = o0 + (size_t)r * DM;
        const bf16* xn = x0 + (size_t)(r + 1 < nrows ? r + 1 : r) * DM;
#pragma unroll
        for (int j = 0; j < 8; ++j) {
            const f32x4 o = (v[j] * rstd) * P.a[j] + P.h[j];
            w[j] = *((const u32x2*)xn + lane + 64 * j);
            u32x2 p; p.x = pk2(o[0], o[1]); p.y = pk2(o[2], o[3]);
            *(u32x2*)(orow + (lane + 64 * j) * 4) = p;
        }
    }
}

DI void phase_h1(Frame& F) {
    const float* MOD = (const float*)(F.ws + WS_MOD); unsigned char* H = F.ws + WS_H;
    ModPar P;
    {
        constexpr int RPW = NT / (256 * NWAVES);
        const int m0 = F.gw * RPW, r = m0 >> 12;
        if (F.NGW == 256 * NWAVES) {
            modpar_load(P, F.in[6], MOD + (size_t)r * 12288 + 2048, MOD + (size_t)r * 12288, F.lane);
            modnorm_rows_fp8(F.in[0] + (size_t)m0 * DM, H + (size_t)m0 * DM, RPW, P, F.lane);
        } else {
            for (int m = F.gw; m < NT; m += F.NGW) { modpar_load(P, F.in[6], MOD + (size_t)(m >> 12) * 12288 + 2048, MOD + (size_t)(m >> 12) * 12288, F.lane); modnorm_rows_fp8(F.in[0] + (size_t)m * DM, H + (size_t)m * DM, 1, P, F.lane); }
        }
    }
    {
        float* AB = (float*)(F.ws + WS_AB2); float* SH = (float*)(F.ws + WS_SH2);
        for (int i = blockIdx.x * (NWAVES * 64) + F.tid; i < 4 * DM; i += F.G * NWAVES * 64) { const int b = i >> 11, k = i & 2047;
            AB[i] = F.in[7][k] * (1.f + MOD[(size_t)b * 12288 + 4 * 2048 + k]); SH[i] = MOD[(size_t)b * 12288 + 3 * 2048 + k]; }
    }
    if (F.gw < NC) {
        modpar_load(P, F.in[6], MOD + (size_t)4 * 12288 + 2048, MOD + (size_t)4 * 12288, F.lane);
        for (int m = F.gw; m < NC; m += F.NGW) modnorm_rows_fp8(F.in[2] + (size_t)m * DM, H + (size_t)(NT + m) * DM, 1, P, F.lane);
    }
}

DI void phase_postproj(Frame& F) {
    const int lane = F.lane, tid = F.tid;
    LAS float* tcs = (LAS float*)F.lds;
    for (int i = tid; i < 2048; i += 512) { const int pos = i >> 5, f = i & 31; float sn, cs; sincosf((float)pos * exp2f(-(float)f * (13.287712379549449f / 32.f)), &sn, &cs); tcs[i] = cs; tcs[2048 + i] = sn; }
    __syncthreads();
    {
        bf16* QN = (bf16*)(F.ws + WS_QN); bf16* KB = (bf16*)(F.ws + WS_KB);
        const int j = lane & 7, axis = j >> 2, fg = j & 3, d1 = axis * 64 + 8 * fg;
        f32x4 qw[4], kw[4];
        qw[0] = *(const f32x4*)(F.in[9] + d1); qw[1] = *(const f32x4*)(F.in[9] + d1 + 4); qw[2] = *(const f32x4*)(F.in[9] + d1 + 32); qw[3] = *(const f32x4*)(F.in[9] + d1 + 36);
        kw[0] = *(const f32x4*)(F.in[10] + d1); kw[1] = *(const f32x4*)(F.in[10] + d1 + 4); kw[2] = *(const f32x4*)(F.in[10] + d1 + 32); kw[3] = *(const f32x4*)(F.in[10] + d1 + 36);
        constexpr int NQI = NT, NKI = NB * LKV / 4;
        for (int it = F.gw; it < NQI + NKI; it += F.NGW) {
            bf16* p; int t; bool rope; const bool isq = it < NQI;
            if (isq) { p = QN + (size_t)it * 1024 + (lane >> 3) * 128; t = it & 4095; rope = true; }
            else { const int row = (it - NQI) * 4 + (lane >> 4), pp = row % LKV; p = KB + (size_t)row * 256 + ((lane >> 3) & 1) * 128; t = pp; rope = pp < TS; }
            const u32x4 w1 = *(const u32x4*)(p + d1), w2 = *(const u32x4*)(p + d1 + 32);
            float x1[8], x2[8];
            x1[0] = bflo(w1.x); x1[1] = bfhi(w1.x); x1[2] = bflo(w1.y); x1[3] = bfhi(w1.y); x1[4] = bflo(w1.z); x1[5] = bfhi(w1.z); x1[6] = bflo(w1.w); x1[7] = bfhi(w1.w);
            x2[0] = bflo(w2.x); x2[1] = bfhi(w2.x); x2[2] = bflo(w2.y); x2[3] = bfhi(w2.y); x2[4] = bflo(w2.z); x2[5] = bfhi(w2.z); x2[6] = bflo(w2.w); x2[7] = bfhi(w2.w);
            float ss = 0.f;
#pragma unroll
            for (int i = 0; i < 8; ++i) ss += x1[i] * x1[i] + x2[i] * x2[i];
            ss += __shfl_xor(ss, 1); ss += __shfl_xor(ss, 2); ss += __shfl_xor(ss, 4);
            const float rstd = rsqrtf(ss * (1.f / 128.f) + EPS);
            const int pos = axis == 0 ? (t >> 6) : (t & 63);
            float o1[8], o2[8];
#pragma unroll
            for (int i = 0; i < 8; ++i) {
                const float wa = isq ? qw[i >> 2][i & 3] : kw[i >> 2][i & 3], wb = isq ? qw[2 + (i >> 2)][i & 3] : kw[2 + (i >> 2)][i & 3];
                const float y1 = x1[i] * rstd * wa, y2 = x2[i] * rstd * wb;
                const float cs0 = tcs[(pos & 63) * 32 + 8 * fg + i], sn0 = tcs[2048 + (pos & 63) * 32 + 8 * fg + i];
                const float cs = rope ? cs0 : 1.f, sn = rope ? sn0 : 0.f;
                o1[i] = y1 * cs - y2 * sn; o2[i] = y2 * cs + y1 * sn;
            }
            u32x4 r1, r2;
            r1.x = pk2(o1[0], o1[1]); r1.y = pk2(o1[2], o1[3]); r1.z = pk2(o1[4], o1[5]); r1.w = pk2(o1[6], o1[7]);
            r2.x = pk2(o2[0], o2[1]); r2.y = pk2(o2[2], o2[3]); r2.z = pk2(o2[4], o2[5]); r2.w = pk2(o2[6], o2[7]);
            *(u32x4*)(p + d1) = r1; *(u32x4*)(p + d1 + 32) = r2;
        }
    }
    {
        const bf16* RAW = (const bf16*)(F.ws + WS_DNRAW); const float* cw = F.in[11];
        for (int it = F.gw; it < (MTOT / 16) * 6; it += F.NGW) {
            const int tc = it / 6, grp = it % 6, m0 = tc * 16, part = grp >> 1;
            int start, len; if (m0 < NT) { start = m0 & ~4095; len = TS; } else { start = NT + ((m0 - NT) & ~255); len = CL; }
            const int pos0 = m0 - start, c = grp * 512 + 8 * lane;
            float wv[5][8];
#pragma unroll
            for (int jj = 0; jj < 5; ++jj) { const f32x4 a = *(const f32x4*)(cw + jj * 3072 + c), b = *(const f32x4*)(cw + jj * 3072 + c + 4);
                wv[jj][0] = a[0]; wv[jj][1] = a[1]; wv[jj][2] = a[2]; wv[jj][3] = a[3]; wv[jj][4] = b[0]; wv[jj][5] = b[1]; wv[jj][6] = b[2]; wv[jj][7] = b[3]; }
            u32x4 rows[20];
#pragma unroll
            for (int r = 0; r < 20; ++r) { const int pp = pos0 + r - 2; const bool ok = pp >= 0 && pp < len;
                const u32x4 v = *(const u32x4*)(RAW + (size_t)(start + (ok ? pp : pos0)) * 3072 + c); rows[r] = ok ? v : (u32x4){0u, 0u, 0u, 0u}; }
            bf16* dst = (bf16*)(F.ws + (part == 0 ? WS_DQ : (part == 1 ? WS_DK : WS_DV))) + dn_off(m0, (grp & 1) * 4 + (lane >> 4)) + 8 * (lane & 15);
#pragma unroll
            for (int th = 0; th < 2; ++th) {
                float a[8][8], ss[8];
#pragma unroll
                for (int t8 = 0; t8 < 8; ++t8) {
                    const int tk = th * 8 + t8;
#pragma unroll
                    for (int i = 0; i < 8; ++i) a[t8][i] = 0.f;
#pragma unroll
                    for (int jj = 0; jj < 5; ++jj) { const u32x4 w = rows[tk + jj];
                        a[t8][0] += wv[jj][0] * bflo(w.x); a[t8][1] += wv[jj][1] * bfhi(w.x); a[t8][2] += wv[jj][2] * bflo(w.y); a[t8][3] += wv[jj][3] * bfhi(w.y);
                        a[t8][4] += wv[jj][4] * bflo(w.z); a[t8][5] += wv[jj][5] * bfhi(w.z); a[t8][6] += wv[jj][6] * bflo(w.w); a[t8][7] += wv[jj][7] * bfhi(w.w); }
                    ss[t8] = 0.f;
#pragma unroll
                    for (int i = 0; i < 8; ++i) { a[t8][i] = silu(a[t8][i]); ss[t8] += a[t8][i] * a[t8][i]; }
                }
                if (part < 2) {
#pragma unroll
                    for (int o = 1; o < 16; o <<= 1)
#pragma unroll
                        for (int t8 = 0; t8 < 8; ++t8) ss[t8] += __shfl_xor(ss[t8], o);
#pragma unroll
                    for (int t8 = 0; t8 < 8; ++t8) {
                        const float r = rsqrtf(ss[t8] + EPS) * (part == 0 ? 0.088388347648318440f : 1.f);
#pragma unroll
                        for (int i = 0; i < 8; ++i) a[t8][i] *= r;
                    }
                }
#pragma unroll
                for (int t8 = 0; t8 < 8; ++t8) {
                    u32x4 o; o.x = pk2(a[t8][0], a[t8][1]); o.y = pk2(a[t8][2], a[t8][3]); o.z = pk2(a[t8][4], a[t8][5]); o.w = pk2(a[t8][6], a[t8][7]);
                    *(u32x4*)(dst + (th * 8 + t8) * 128) = o;
                }
            }
        }
    }
}

DI void phase_dn_naive(Frame& F) {
    if (F.wave != 0 || blockIdx.x >= 128) return;
    const int item = blockIdx.x, dir = item >> 6, b = (item >> 4) & 3, h = (item >> 1) & 7, half = item & 1, lane = F.lane;
    const bf16* DQ = (const bf16*)(F.ws + WS_DQ); const bf16* DK = (const bf16*)(F.ws + WS_DK); const bf16* DV = (const bf16*)(F.ws + WS_DV);
    const float* BETA = (const float*)(F.ws + WS_BETA); const float* LOGA = (const float*)(F.ws + WS_LOGA);
    bf16* ODN = (bf16*)(F.ws + WS_ODN);
    float S[128];
#pragma unroll
    for (int i = 0; i < 128; ++i) S[i] = 0.f;
    for (int step = 0; step < LKV; ++step) {
        const bool isl = step >= CL; const int p = isl ? step - CL : step, len = isl ? TS : CL, pos = dir ? len - 1 - p : p;
        const int m = isl ? b * TS + pos : NT + b * CL + pos;
        const unsigned kw = *(const unsigned*)(DK + dn_off(m, h) + 2 * lane);
        const unsigned qw = *(const unsigned*)(DQ + dn_off(m, h) + 2 * lane);
        const float vj = bf2f(DV[dn_off(m, h) + half * 64 + lane]);
        const float a = __expf(LOGA[(size_t)m * 16 + dir * 8 + h]), bt = BETA[(size_t)m * 16 + dir * 8 + h];
        float k0 = 0.f, k1 = 0.f, k2 = 0.f, k3 = 0.f;
#pragma unroll
        for (int i = 0; i < 64; i += 2) {
            const unsigned w0 = rdlane(kw, i), w1 = rdlane(kw, i + 1);
            k0 += bflo(w0) * S[2 * i]; k1 += bfhi(w0) * S[2 * i + 1]; k2 += bflo(w1) * S[2 * i + 2]; k3 += bfhi(w1) * S[2 * i + 3];
        }
        const float kS = (k0 + k1) + (k2 + k3);
        const float coef = bt * (vj - a * kS);
#pragma unroll
        for (int i = 0; i < 64; ++i) { const unsigned w0 = rdlane(kw, i); S[2 * i] = a * S[2 * i] + coef * bflo(w0); S[2 * i + 1] = a * S[2 * i + 1] + coef * bfhi(w0); }
        if (isl) {
            float o0 = 0.f, o1 = 0.f, o2 = 0.f, o3 = 0.f;
#pragma unroll
            for (int i = 0; i < 64; i += 2) {
                const unsigned w0 = rdlane(qw, i), w1 = rdlane(qw, i + 1);
                o0 += bflo(w0) * S[2 * i]; o1 += bfhi(w0) * S[2 * i + 1]; o2 += bflo(w1) * S[2 * i + 2]; o3 += bfhi(w1) * S[2 * i + 3];
            }
            ODN[((size_t)dir * NT + m) * 1024 + h * 128 + half * 64 + lane] = (bf16)f2bf((o0 + o1) + (o2 + o3));
        }
    }
}

DI int dn_row0(int b, int cc) { return cc < 4 ? NT + b * CL + 64 * cc : b * TS + 64 * (cc - 4); }
typedef short bf16x8_t __attribute__((ext_vector_type(8)));
#define MFMA16(a, b, c) __builtin_amdgcn_mfma_f32_16x16x32_bf16((a), (b), (c), 0, 0, 0)

DI bf16x8_t dn_afrag(const LAS unsigned char* p) {
    const u32x2 lo = *(const LAS u32x2*)p, hi = *(const LAS u32x2*)(p + 32);
    u32x4 v; v.x = lo.x; v.y = lo.y; v.z = hi.x; v.w = hi.y; return __builtin_bit_cast(bf16x8_t, v);
}
DI bf16x8_t dn_bpack(const f32x4 t0, const f32x4 t1) {
    u32x4 v; v.x = pk2(t0[0], t0[1]); v.y = pk2(t0[2], t0[3]); v.z = pk2(t1[0], t1[1]); v.w = pk2(t1[2], t1[3]); return __builtin_bit_cast(bf16x8_t, v);
}
DI void phase_dn_prep(Frame& F) {
    LAS unsigned char* L = F.lds;
    constexpr int KS = 0, QS = 17408, VC = 34816, AP = 35840, QKL = 140288;
    constexpr int NITEM = NB * 8 * 68, NBATCH = (NITEM + 2) / 3;
    const bf16* DQ = (const bf16*)(F.ws + WS_DQ); const bf16* DK = (const bf16*)(F.ws + WS_DK);
    const float* BETA = (const float*)(F.ws + WS_BETA); const float* LOGA = (const float*)(F.ws + WS_LOGA);
    bf16* KT = (bf16*)(F.ws + WS_KT); bf16* TINV = (bf16*)(F.ws + WS_TINV); bf16* QKO = (bf16*)(F.ws + WS_QKO); float* VEC = (float*)(F.ws + WS_VEC);
    const int tid = F.tid, wave = F.wave;
    LAS float* vg = (LAS float*)(L + VC); LAS float* vb = vg + 128;
    for (int batch = F.vcu; batch < NBATCH; batch += F.G) {
        int lane = F.lane; asm volatile("" : "+v"(lane));
        const int fr = lane & 15, fq = lane >> 4;
#pragma unroll 1
        for (int c3 = 0; c3 < 3; ++c3) {
            const int item = batch * 3 + c3;
            if (item >= NITEM) break;
            const int b = item / 544, h = (item % 544) / 68, cc = item % 68, row0 = dn_row0(b, cc);
#pragma unroll
            for (int k = 0; k < 4; ++k) {
                const int c = tid + 512 * k, which = c >> 10, c2 = c & 1023, row = c2 >> 4, c16 = c2 & 15;
                const u32x4 v = *(const u32x4*)((which ? DQ : DK) + (size_t)item * 8192 + c2 * 8);
                *(LAS u32x4*)(L + (which ? QS : KS) + row * 272 + c16 * 16) = v;
            }
            if (wave < 2) {
                const int d = wave, i = lane;
                const float la = LOGA[(size_t)(row0 + i) * 16 + d * 8 + h], bt = BETA[(size_t)(row0 + i) * 16 + d * 8 + h];
                float x = la;
                if (d == 0) {
#pragma unroll
                    for (int o = 1; o < 64; o <<= 1) { const float y = __shfl_up(x, o); if (i >= o) x += y; }
                } else {
#pragma unroll
                    for (int o = 1; o < 64; o <<= 1) { const float y = __shfl_down(x, o); if (i + o < 64) x += y; }
                }
                const float glast = __shfl(x, d == 0 ? 63 : 0);
                vg[d * 64 + i] = x; vb[d * 64 + i] = bt;
                float* ve = VEC + (size_t)(item * 2 + d) * 320;
                const float eg = __expf(x);
                ve[i] = bt; ve[64 + i] = eg; ve[128 + i] = bt * eg; ve[192 + i] = __expf(glast - x); ve[256 + i] = __expf(glast);
            }
            __syncthreads();
            {
                bf16* kt = KT + (size_t)item * 8192;
#pragma unroll
                for (int k = 0; k < 2; ++k) {
                    const int c = tid + 512 * k, dk = c >> 3, t8 = c & 7;
                    unsigned short e[8];
#pragma unroll
                    for (int q = 0; q < 8; ++q) e[q] = *(const LAS unsigned short*)(L + KS + (8 * t8 + q) * 272 + dk * 2);
                    u32x4 w; w.x = e[0] | ((unsigned)e[1] << 16); w.y = e[2] | ((unsigned)e[3] << 16); w.z = e[4] | ((unsigned)e[5] << 16); w.w = e[6] | ((unsigned)e[7] << 16);
                    *(u32x4*)(kt + dk * 64 + 8 * t8) = w;
                }
            }
            {
                const int it = wave & 3, mat = wave >> 2;
                f32x4 acc[4];
#pragma unroll
                for (int j = 0; j < 4; ++j) acc[j] = (f32x4){0.f, 0.f, 0.f, 0.f};
#pragma unroll
                for (int s = 0; s < 4; ++s) {
                    const bf16x8_t a = *(const LAS bf16x8_t*)(L + (mat ? QS : KS) + (16 * it + fr) * 272 + (32 * s + 8 * fq) * 2);
#pragma unroll
                    for (int jt = 0; jt < 4; ++jt) {
                        const bf16x8_t bb = *(const LAS bf16x8_t*)(L + KS + (16 * jt + fr) * 272 + (32 * s + 8 * fq) * 2);
                        acc[jt] = MFMA16(a, bb, acc[jt]);
                    }
                }
                f32x4 gi[2], bi[2]; float gj[2][4];
#pragma unroll
                for (int d = 0; d < 2; ++d) {
                    gi[d] = *(const LAS f32x4*)(vg + d * 64 + 16 * it + 4 * fq); bi[d] = *(const LAS f32x4*)(vb + d * 64 + 16 * it + 4 * fq);
#pragma unroll
                    for (int jt = 0; jt < 4; ++jt) gj[d][jt] = vg[d * 64 + 16 * jt + fr];
                }
                if (mat == 0) {
#pragma unroll
                    for (int d = 0; d < 2; ++d) {
                        LAS float* ap = (LAS float*)(L + AP + (c3 * 2 + d) * 17408);
#pragma unroll
                        for (int jt = 0; jt < 4; ++jt)
#pragma unroll
                            for (int r = 0; r < 4; ++r) {
                                const int i = 16 * it + 4 * fq + r, j = 16 * jt + fr, ip = d ? 63 - i : i, jp = d ? 63 - j : j;
                                ap[ip * 68 + jp] = (jp < ip) ? bi[d][r] * acc[jt][r] * __expf(gi[d][r] - gj[d][jt]) : 0.f;
                            }
                    }
                } else {
#pragma unroll
                    for (int d = 0; d < 2; ++d) {
#pragma unroll
                        for (int jt = 0; jt < 4; ++jt)
#pragma unroll
                            for (int r = 0; r < 4; ++r) {
                                const int i = 16 * it + 4 * fq + r, j = 16 * jt + fr, ip = d ? 63 - i : i, jp = d ? 63 - j : j;
                                *(LAS bf16*)(L + QKL + d * 8192 + (i * 64 + j) * 2) = (bf16)f2bf((jp <= ip) ? acc[jt][r] * __expf(gi[d][r] - gj[d][jt]) : 0.f);
                            }
                    }
                }
            }
            __syncthreads();
            {
                bf16* qo = QKO + (size_t)(item * 2) * 4096;
#pragma unroll
                for (int k = 0; k < 2; ++k) { const int c = tid + 512 * k; *((u32x4*)qo + c) = *(const LAS u32x4*)(L + QKL + c * 16); }
            }
        }
        if (wave < 6 && batch * 3 + (wave >> 1) < NITEM) {
            const int item = batch * 3 + (wave >> 1), d = wave & 1, c = lane;
            const LAS float* ap = (const LAS float*)(L + AP + wave * 17408);
            float x[64];
            f32x4 nx[16];
            x[0] = (c == 0) ? 1.f : 0.f;
            nx[0] = *(const LAS f32x4*)(ap + 68);
            __builtin_amdgcn_sched_barrier(0);
#pragma unroll
            for (int ip = 1; ip < 64; ++ip) {
                f32x4 cur[16];
#pragma unroll
                for (int q = 0; q < (ip + 3) / 4; ++q) cur[q] = nx[q];
                if (ip + 1 < 64) {
#pragma unroll
                    for (int q = 0; q < (ip + 4) / 4; ++q) nx[q] = *(const LAS f32x4*)(ap + (ip + 1) * 68 + 4 * q);
                }
                float a0 = (ip == c) ? 1.f : 0.f, a1 = 0.f;
#pragma unroll
                for (int q = 0; q < (ip + 3) / 4; ++q) {
#pragma unroll
                    for (int e = 0; e < 4; ++e) { const int jp = 4 * q + e; if (jp < ip) { if (e & 1) a1 -= cur[q][e] * x[jp]; else a0 -= cur[q][e] * x[jp]; } }
                }
                x[ip] = a0 + a1;
                __builtin_amdgcn_sched_barrier(0);
            }
            bf16* ti = TINV + (size_t)(item * 2 + d) * 4096;
            const int j = d ? 63 - c : c;
#pragma unroll
            for (int ip = 0; ip < 64; ++ip) { const int i = d ? 63 - ip : ip; ti[i * 64 + j] = (bf16)f2bf(x[ip]); }
        }
        __syncthreads();
    }
}

DI int dn_perm(int m, int t) { return 32 * (t >> 1) + 8 * (m >> 2) + 4 * (t & 1) + (m & 3); }
DI int dn_swz16(int row, int chunk) { return row * 272 + (chunk << 4); }
DI int dn_swz8(int row, int chunk) { return row * 144 + (chunk << 4); }
#define DN_BAR() do { asm volatile("s_waitcnt lgkmcnt(0)" ::: "memory"); __builtin_amdgcn_s_barrier(); asm volatile("" ::: "memory"); } while (0)
DI void phase_dn_scan(Frame& F) {
    LAS unsigned char* L = F.lds;
    constexpr int KS = 0, QS = 17408, KTS = 34816, TIS = 53248, VS = 62464, VCS = 66560, BUF = 68096;
    constexpr int PUBS = 2 * BUF, PUBV = PUBS + 16384;
    static_assert(PUBV + 8192 <= LDS_BYTES - 64, "scan LDS map");
    const int G8 = F.G >> 3;
    const int li = blockIdx.x >> 3, chain = (blockIdx.x & 7) * (G8 >> 2) + (li >> 2), qd = li & 3;
    if (F.G != 256 || chain >= 64) return;
    const int dir = chain >> 5, b = (chain >> 3) & 3, h = chain & 7;
    const bf16* DQ = (const bf16*)(F.ws + WS_DQ); const bf16* DK = (const bf16*)(F.ws + WS_DK); const bf16* DV = (const bf16*)(F.ws + WS_DV);
    const bf16* KT = (const bf16*)(F.ws + WS_KT); const bf16* TINV = (const bf16*)(F.ws + WS_TINV); const bf16* QKO = (const bf16*)(F.ws + WS_QKO); const float* VEC = (const float*)(F.ws + WS_VEC);
    bf16* ODN = (bf16*)(F.ws + WS_ODN);
    const int tid = F.tid, lane = F.lane, w = F.wave, fr = lane & 15, fq = lane >> 4;
#ifndef DN_NSTEP
#define DN_NSTEP 68
#endif
#define DN_CC1(st) (dir == 0 ? (st) : ((st) < 4 ? 3 - (st) : 71 - (st)))
#define DN_CC(step) DN_CC1((step) % 68)
#define AF16(base, row, kchunk) (*(const LAS bf16x8_t*)(Lb + (base) + dn_swz16((row), (kchunk))))
#define AF8(base, row, kchunk) (*(const LAS bf16x8_t*)(Lb + (base) + dn_swz8((row), (kchunk))))
    if (w >= 4) {
        const int lt = tid - 256;
        u32x4 preA[16], preB[16];
#define DN_LOAD(pre, cc_) do { const int cc__ = (cc_); const int item__ = (b * 8 + h) * 68 + cc__, cd__ = item__ * 2 + dir; \
        _Pragma("unroll") for (int k = 0; k < 16; ++k) { const bf16* src; \
            if (k < 4)       { const int q = lt + 256 * k;        src = DK + (size_t)item__ * 8192 + q * 8; } \
            else if (k < 8)  { const int q = lt + 256 * (k - 4);  src = DQ + (size_t)item__ * 8192 + q * 8; } \
            else if (k < 12) { const int q = lt + 256 * (k - 8);  src = KT + (size_t)item__ * 8192 + q * 8; } \
            else if (k < 14) { const int q = lt + 256 * (k - 12); src = TINV + (size_t)cd__ * 4096 + q * 8; } \
            else if (k == 14) { src = DV + (size_t)item__ * 8192 + (lt >> 2) * 128 + qd * 32 + (lt & 3) * 8; } \
            else { src = (const bf16*)(VEC + (size_t)cd__ * 320 + (lt < 80 ? lt : 0) * 4); } \
            pre[k] = *(const u32x4*)src; } } while (0)
#define DN_STORE(pre, bufo_) do { const int bo__ = (bufo_); _Pragma("unroll") for (int k = 0; k < 16; ++k) { int dst; \
            if (k < 4)       { const int q = lt + 256 * k;        dst = KS + dn_swz16(q >> 4, q & 15); } \
            else if (k < 8)  { const int q = lt + 256 * (k - 4);  dst = QS + dn_swz16(q >> 4, q & 15); } \
            else if (k < 12) { const int q = lt + 256 * (k - 8);  dst = KTS + dn_swz8(q >> 3, q & 7); } \
            else if (k < 14) { const int q = lt + 256 * (k - 12); dst = TIS + dn_swz8(q >> 3, q & 7); } \
            else if (k == 14) { dst = VS + lt * 16; } \
            else { dst = VCS + (lt < 80 ? lt : 0) * 16; } \
            *(LAS u32x4*)(L + bo__ + dst) = pre[k]; } } while (0)
#ifdef DN_SKIP_LOAD
#define DN_CLAMP(ds) ((ds) < DN_NSTEP - 70 ? 0 : (ds) < DN_NSTEP ? (ds) : DN_NSTEP - 1)
#else
#define DN_CLAMP(ds) ((ds) < DN_NSTEP ? (ds) : DN_NSTEP - 1)
#endif
#ifndef DN_SLEEP
#define DN_SLEEP 0
#endif
#define DN_LDELAY() __builtin_amdgcn_s_sleep(DN_SLEEP)
        DN_LOAD(preA, DN_CC(0)); DN_STORE(preA, 0); DN_LOAD(preA, DN_CC(1)); DN_LOAD(preB, DN_CC(2));
        DN_BAR();
        for (int step = 0; step < DN_NSTEP; step += 2) {
            DN_LDELAY(); DN_STORE(preA, BUF); DN_LOAD(preA, DN_CC(DN_CLAMP(step + 3)));
            DN_BAR();
            DN_LDELAY(); DN_STORE(preB, 0); DN_LOAD(preB, DN_CC(DN_CLAMP(step + 4)));
            DN_BAR();
        }
#undef DN_CLAMP
#undef DN_LOAD
#undef DN_STORE
    } else if (w >= 2) {
        const int pw = w - 2;
        bf16x8_t qkA[2][4], qkB[2][4];
        f32x4 O[4];
#define DN_QKLOAD(dst, st_) do { const int cd__ = ((b * 8 + h) * 68 + DN_CC(st_)) * 2 + dir; \
        _Pragma("unroll") for (int s = 0; s < 2; ++s) _Pragma("unroll") for (int mt = 0; mt < 4; ++mt) \
            dst[s][mt] = *(const bf16x8_t*)(QKO + (size_t)cd__ * 4096 + dn_perm(fr, mt) * 64 + (4 * s + fq) * 8); } while (0)
#define DN_OFIN(qk, st_) do { const int st__ = (st_); const LAS unsigned char* pv = L + PUBV + (st__ & 1) * 4096 + pw * 2048 + lane * 16; \
        const bf16x8_t vb0 = *(const LAS bf16x8_t*)pv, vb1 = *(const LAS bf16x8_t*)(pv + 1024); \
        _Pragma("unroll") for (int mt = 0; mt < 4; ++mt) { O[mt] = MFMA16(vb0, qk[0][mt], O[mt]); O[mt] = MFMA16(vb1, qk[1][mt], O[mt]); } \
        const int cc__ = DN_CC(st__); \
        if (cc__ >= 4) { bf16* orow = ODN + ((size_t)dir * NT + dn_row0(b, cc__)) * 1024 + h * 128 + qd * 32 + 16 * pw + 4 * fq; \
            _Pragma("unroll") for (int mt = 0; mt < 4; ++mt) { u32x2 w2; w2.x = pk2(O[mt][0], O[mt][1]); w2.y = pk2(O[mt][2], O[mt][3]); \
                *(u32x2*)(orow + (size_t)dn_perm(fr, mt) * 1024) = w2; } } } while (0)
#define DN_OBEG(st_) do { const int st__ = (st_); const LAS unsigned char* Lb = L + (st__ & 1) * BUF; const LAS unsigned char* ps = L + PUBS + (st__ & 1) * 8192 + pw * 4096 + lane * 16; \
        bf16x8_t sb[4], qa[4][4]; \
        _Pragma("unroll") for (int s = 0; s < 4; ++s) sb[s] = *(const LAS bf16x8_t*)(ps + s * 1024); \
        _Pragma("unroll") for (int s = 0; s < 4; ++s) _Pragma("unroll") for (int mt = 0; mt < 4; ++mt) qa[s][mt] = AF16(QS, dn_perm(fr, mt), 4 * s + fq); \
        _Pragma("unroll") for (int mt = 0; mt < 4; ++mt) O[mt] = (f32x4){0.f, 0.f, 0.f, 0.f}; \
        _Pragma("unroll") for (int s = 0; s < 4; ++s) _Pragma("unroll") for (int mt = 0; mt < 4; ++mt) O[mt] = MFMA16(sb[s], qa[s][mt], O[mt]); \
        const LAS float* vc = (const LAS float*)(Lb + VCS); \
        _Pragma("unroll") for (int mt = 0; mt < 4; ++mt) { const float eg = vc[64 + dn_perm(fr, mt)]; O[mt] = O[mt] * eg; } } while (0)
        DN_QKLOAD(qkA, 0); DN_QKLOAD(qkB, 1);
        DN_BAR();
        DN_OBEG(0);
        DN_BAR();
        for (int step = 0; step < DN_NSTEP - 2; step += 2) {
#ifdef DN_SKIP_OUT
            if (step < DN_NSTEP - 70) { DN_BAR(); DN_BAR(); continue; }
#endif
            DN_OFIN(qkA, step); DN_QKLOAD(qkA, step + 2);
            DN_OBEG(step + 1);
            DN_BAR();
            DN_OFIN(qkB, step + 1); DN_QKLOAD(qkB, step + 3);
            DN_OBEG(step + 2);
            DN_BAR();
        }
        DN_OFIN(qkA, DN_NSTEP - 2);
        DN_OBEG(DN_NSTEP - 1);
        DN_BAR();
        DN_OFIN(qkB, DN_NSTEP - 1);
#undef DN_QKLOAD
#undef DN_OFIN
#undef DN_OBEG
    } else {
        f32x4 S[8];
#pragma unroll
        for (int j = 0; j < 8; ++j) S[j] = (f32x4){0.f, 0.f, 0.f, 0.f};
        bf16x8_t sb[4];
#pragma unroll
        for (int s = 0; s < 4; ++s) { sb[s] = dn_bpack(S[2 * s], S[2 * s + 1]); *(LAS bf16x8_t*)(L + PUBS + w * 4096 + s * 1024 + lane * 16) = sb[s]; }
        DN_BAR();
        for (int step = 0; step < DN_NSTEP; ++step) {
#ifdef DN_SKIP_COMP
            if (step < DN_NSTEP - 69) { DN_BAR(); continue; }
#endif
            const LAS unsigned char* Lb = L + (step & 1) * BUF;
            f32x4 P[4];
#pragma unroll
            for (int mt = 0; mt < 4; ++mt) P[mt] = (f32x4){0.f, 0.f, 0.f, 0.f};
            {
                bf16x8_t ka[4][4];
#pragma unroll
                for (int s = 0; s < 4; ++s)
#pragma unroll
                    for (int mt = 0; mt < 4; ++mt) ka[s][mt] = AF16(KS, dn_perm(fr, mt), 4 * s + fq);
                __builtin_amdgcn_sched_barrier(0);
#pragma unroll
                for (int s = 0; s < 4; ++s)
#pragma unroll
                    for (int mt = 0; mt < 4; ++mt) P[mt] = MFMA16(ka[s][mt], sb[s], P[mt]);
            }
            bf16x8_t tia[2][4];
#pragma unroll
            for (int s = 0; s < 2; ++s)
#pragma unroll
                for (int mt = 0; mt < 4; ++mt) tia[s][mt] = AF8(TIS, dn_perm(fr, mt), 4 * s + fq);
            const LAS float* vc = (const LAS float*)(Lb + VCS);
            f32x4 R[4];
#pragma unroll
            for (int mt = 0; mt < 4; ++mt) {
                const int tk0 = 32 * (mt >> 1) + 8 * fq + 4 * (mt & 1);
                const f32x4 bt = *(const LAS f32x4*)(vc + tk0), bg = *(const LAS f32x4*)(vc + 128 + tk0);
#pragma unroll
                for (int r = 0; r < 4; ++r) {
                    const float v = bf2f(*(const LAS unsigned short*)(Lb + VS + (tk0 + r) * 64 + (16 * w + fr) * 2));
                    R[mt][r] = v * bt[r] - bg[r] * P[mt][r];
                }
            }
            const bf16x8_t rb0 = dn_bpack(R[0], R[1]), rb1 = dn_bpack(R[2], R[3]);
            f32x4 VN[4];
#pragma unroll
            for (int mt = 0; mt < 4; ++mt) {
                VN[mt] = (f32x4){0.f, 0.f, 0.f, 0.f};
                VN[mt] = MFMA16(tia[0][mt], rb0, VN[mt]);
                VN[mt] = MFMA16(tia[1][mt], rb1, VN[mt]);
            }
            bf16x8_t kta[2][8];
#pragma unroll
            for (int s = 0; s < 2; ++s)
#pragma unroll
                for (int jt = 0; jt < 8; ++jt) kta[s][jt] = AF8(KTS, dn_perm(fr, jt), 4 * s + fq);
            {
                const bf16x8_t vb0 = dn_bpack(VN[0], VN[1]), vb1 = dn_bpack(VN[2], VN[3]);
                LAS unsigned char* pv = L + PUBV + (step & 1) * 4096 + w * 2048 + lane * 16;
                *(LAS bf16x8_t*)pv = vb0; *(LAS bf16x8_t*)(pv + 1024) = vb1;
            }
#pragma unroll
            for (int mt = 0; mt < 4; ++mt) { const f32x4 ek = *(const LAS f32x4*)(vc + 192 + 32 * (mt >> 1) + 8 * fq + 4 * (mt & 1)); VN[mt] = VN[mt] * ek; }
            const bf16x8_t vs0 = dn_bpack(VN[0], VN[1]), vs1 = dn_bpack(VN[2], VN[3]);
            const float egl = vc[256];
#pragma unroll
            for (int jt = 0; jt < 8; ++jt) {
                S[jt] = S[jt] * egl;
                S[jt] = MFMA16(kta[0][jt], vs0, S[jt]);
                S[jt] = MFMA16(kta[1][jt], vs1, S[jt]);
            }
            if (DN_NSTEP > 68 && step % 68 == 67) {
#pragma unroll
                for (int j = 0; j < 8; ++j) S[j] = (f32x4){0.f, 0.f, 0.f, 0.f};
            }
#pragma unroll
            for (int s = 0; s < 4; ++s) { sb[s] = dn_bpack(S[2 * s], S[2 * s + 1]); *(LAS bf16x8_t*)(L + PUBS + ((step + 1) & 1) * 8192 + w * 4096 + s * 1024 + lane * 16) = sb[s]; }
            DN_BAR();
        }
    }
#undef AF16
#undef AF8
#undef DN_CC
#undef DN_CC1
}

DI void phase_attention(Frame& F, char* lds_generic) {
    bf16* QN = (bf16*)(F.ws + WS_QN); const bf16* KB = (const bf16*)(F.ws + WS_KB); const bf16* VB = (const bf16*)(F.ws + WS_VB);
    for (int it = F.vcu; it < 512; it += F.G) {
        const int b = it >> 7, kvh = (it >> 6) & 1, g = (it >> 4) & 3, qb = it & 15, h = kvh * 4 + g;
        bf16* Qb = QN + ((size_t)(b * TS + qb * 256) * 1024 + h * 128);
        const bf16* Kh = KB + ((size_t)b * LKV * 256 + kvh * 128); const bf16* Vh = VB + ((size_t)b * LKV * 256 + kvh * 128);
#ifdef ATTN_PROBE
#pragma nounroll
        for (int rep_ = 0; rep_ < 2; ++rep_) {
            bf16* Ob = rep_ == 0 ? (bf16*)(F.ws + WS_END) + ((size_t)(b * TS + qb * 256) * 1024 + h * 128) : Qb;
            attn::attn_dense_body<attn::bf16>(Qb, Kh, Vh, Ob, LKV, lds_generic);
            __syncthreads();
        }
#else
#if defined(ATT_O8) && ATT_O8
        attn::attn_dense_body<attn::bf16>(Qb, Kh, Vh, (bf16*)(F.ws + WS_OATT8 + ((size_t)(b * TS + qb * 256) * 1024 + h * 128)), LKV, lds_generic);
#else
        attn::attn_dense_body<attn::bf16>(Qb, Kh, Vh, Qb, LKV, lds_generic);
#endif
        __syncthreads();
#endif
    }
}

DI void phase_mergeprep(Frame& F) {
    const bf16* ODN = (const bf16*)(F.ws + WS_ODN); bf16* Z = (bf16*)(F.ws + WS_Z); const int lane = F.lane;
    float nw[16];
#pragma unroll
    for (int k = 0; k < 4; ++k) { const f32x4 v = *(const f32x4*)(F.in[14] + (lane & 7) * 16 + 4 * k); nw[4 * k] = v[0]; nw[4 * k + 1] = v[1]; nw[4 * k + 2] = v[2]; nw[4 * k + 3] = v[3]; }
    for (int t = F.gw; t < NT; t += F.NGW) {
        const size_t off = (size_t)t * 1024 + 16 * lane;
        u32x4 a[2], c[2], z[2];
#pragma unroll
        for (int k = 0; k < 2; ++k) { a[k] = __builtin_nontemporal_load((const u32x4*)(ODN + off + 8 * k)); c[k] = __builtin_nontemporal_load((const u32x4*)(ODN + (size_t)NT * 1024 + off + 8 * k)); z[k] = __builtin_nontemporal_load((const u32x4*)(Z + off + 8 * k)); }
        float o[16]; float ss = 0.f;
#pragma unroll
        for (int k = 0; k < 2; ++k)
#pragma unroll
            for (int i = 0; i < 4; ++i) { o[8 * k + 2 * i] = bflo(a[k][i]) + bflo(c[k][i]); o[8 * k + 2 * i + 1] = bfhi(a[k][i]) + bfhi(c[k][i]); }
#pragma unroll
        for (int i = 0; i < 16; ++i) ss += o[i] * o[i];
        ss += __shfl_xor(ss, 1); ss += __shfl_xor(ss, 2); ss += __shfl_xor(ss, 4);
        const float rstd = rsqrtf(ss * (1.f / 128.f) + EPS);
        if (MERGE_F8_B) {
            float y[16];
#pragma unroll
            for (int k = 0; k < 2; ++k)
#pragma unroll
                for (int i = 0; i < 4; ++i) { y[8 * k + 2 * i] = o[8 * k + 2 * i] * rstd * nw[8 * k + 2 * i] * silu(bflo(z[k][i])); y[8 * k + 2 * i + 1] = o[8 * k + 2 * i + 1] * rstd * nw[8 * k + 2 * i + 1] * silu(bfhi(z[k][i])); }
            u32x4 w;
#pragma unroll
            for (int q = 0; q < 4; ++q) w[q] = pk4_fp8(fp8c(y[4 * q] * ODNN_SCALE), fp8c(y[4 * q + 1] * ODNN_SCALE), fp8c(y[4 * q + 2] * ODNN_SCALE), fp8c(y[4 * q + 3] * ODNN_SCALE));
            *(u32x4*)(F.ws + WS_ODNN8 + off) = w;
        } else {
#pragma unroll
        for (int k = 0; k < 2; ++k) {
            u32x4 w;
#pragma unroll
            for (int i = 0; i < 4; ++i) w[i] = pk2(o[8 * k + 2 * i] * rstd * nw[8 * k + 2 * i] * silu(bflo(z[k][i])), o[8 * k + 2 * i + 1] * rstd * nw[8 * k + 2 * i + 1] * silu(bfhi(z[k][i])));
            *(u32x4*)(Z + off + 8 * k) = w;
        }
        }
        if (MERGE_F8_A && !ATT_O8_ON) {
            const bf16* OA = (const bf16*)(F.ws + WS_QN);
            const u32x4 a0 = __builtin_nontemporal_load((const u32x4*)(OA + off)), a1 = __builtin_nontemporal_load((const u32x4*)(OA + off + 8));
            u32x4 w;
            w[0] = pk4_fp8(fp8c(bflo(a0.x) * OATT_SCALE), fp8c(bfhi(a0.x) * OATT_SCALE), fp8c(bflo(a0.y) * OATT_SCALE), fp8c(bfhi(a0.y) * OATT_SCALE));
            w[1] = pk4_fp8(fp8c(bflo(a0.z) * OATT_SCALE), fp8c(bfhi(a0.z) * OATT_SCALE), fp8c(bflo(a0.w) * OATT_SCALE), fp8c(bfhi(a0.w) * OATT_SCALE));
            w[2] = pk4_fp8(fp8c(bflo(a1.x) * OATT_SCALE), fp8c(bfhi(a1.x) * OATT_SCALE), fp8c(bflo(a1.y) * OATT_SCALE), fp8c(bfhi(a1.y) * OATT_SCALE));
            w[3] = pk4_fp8(fp8c(bflo(a1.z) * OATT_SCALE), fp8c(bfhi(a1.z) * OATT_SCALE), fp8c(bflo(a1.w) * OATT_SCALE), fp8c(bfhi(a1.w) * OATT_SCALE));
            *(u32x4*)(F.ws + WS_OATT8 + off) = w;
        }
    }
}

DI void wqb_unit(const Frame& F, int it) {
    const bf16* WQ = (const bf16*)(F.ws + WS_WQ); bf16* WQB = (bf16*)(F.ws + WS_WQB);
    const float* AB = (const float*)(F.ws + WS_AB2); const float* SH = (const float*)(F.ws + WS_SH2); float* BQ = (float*)(F.ws + WS_BIASQ);
    const int lane = F.lane;
    {
        const int b = it & 3, n0 = (it >> 2) * 4;
        u32x4 wr[4][4];
#pragma unroll
        for (int r = 0; r < 4; ++r)
#pragma unroll
            for (int q = 0; q < 4; ++q) wr[r][q] = *((const u32x4*)(WQ + (size_t)(n0 + r) * DM + 32 * lane) + q);
        f32x4 av[8], hv[8];
#pragma unroll
        for (int q = 0; q < 8; ++q) { av[q] = *((const f32x4*)(AB + (size_t)b * DM + 32 * lane) + q); hv[q] = *((const f32x4*)(SH + (size_t)b * DM + 32 * lane) + q); }
#pragma unroll
        for (int r = 0; r < 4; ++r) {
            float bs = 0.f;
#pragma unroll
            for (int q = 0; q < 4; ++q) {
                const u32x4 w = wr[r][q];
                const float w0 = bflo(w.x), w1 = bfhi(w.x), w2 = bflo(w.y), w3 = bfhi(w.y), w4 = bflo(w.z), w5 = bfhi(w.z), w6 = bflo(w.w), w7 = bfhi(w.w);
                const f32x4 a0 = av[2 * q], a1 = av[2 * q + 1], h0 = hv[2 * q], h1 = hv[2 * q + 1];
                if (PQ_F8) { u32x2 o8; o8.x = pk4_fp8(w0 * a0[0] * WQ8_SCALE, w1 * a0[1] * WQ8_SCALE, w2 * a0[2] * WQ8_SCALE, w3 * a0[3] * WQ8_SCALE); o8.y = pk4_fp8(w4 * a1[0] * WQ8_SCALE, w5 * a1[1] * WQ8_SCALE, w6 * a1[2] * WQ8_SCALE, w7 * a1[3] * WQ8_SCALE);
                    *((u32x2*)((unsigned char*)WQB + ((size_t)b * DM + n0 + r) * DM + 32 * lane) + q) = o8; }
                else {
                u32x4 o; o.x = pk2(w0 * a0[0], w1 * a0[1]); o.y = pk2(w2 * a0[2], w3 * a0[3]); o.z = pk2(w4 * a1[0], w5 * a1[1]); o.w = pk2(w6 * a1[2], w7 * a1[3]);
                *((u32x4*)(WQB + ((size_t)b * DM + n0 + r) * DM + 32 * lane) + q) = o; }
                bs += (w0 * h0[0] + w1 * h0[1]) + (w2 * h0[2] + w3 * h0[3]) + (w4 * h1[0] + w5 * h1[1]) + (w6 * h1[2] + w7 * h1[3]);
            }
            bs = wave_sum(bs);
            if (lane == 0) BQ[b * DM + n0 + r] = bs;
        }
    }
}
DI void phase_wqb(Frame& F) { for (int it = F.gw; it < NB * (DM / 4); it += F.NGW) wqb_unit(F, it); }

DI void tk_insert(unsigned (&a)[16], unsigned x) {
#pragma unroll
    for (int i = 0; i < 16; ++i) { const unsigned hi = a[i] > x ? a[i] : x; x = a[i] > x ? x : a[i]; a[i] = hi; }
}
template <int N> DI void tk_sort_desc(unsigned (&a)[N]) {
#pragma unroll
    for (int k = 2; k <= N; k <<= 1)
#pragma unroll
        for (int j = k >> 1; j > 0; j >>= 1)
#pragma unroll
            for (int i = 0; i < N; ++i) {
                const int l = i ^ j;
                if (l > i) {
                    const unsigned lo = a[i] < a[l] ? a[i] : a[l], hi = a[i] < a[l] ? a[l] : a[i];
                    if ((i & k) == 0) { a[i] = hi; a[l] = lo; } else { a[i] = lo; a[l] = hi; }
                }
            }
}
DI void tk_sort_bitonic(unsigned (&c)[16]) {
#pragma unroll
    for (int s = 8; s >= 1; s >>= 1)
#pragma unroll
        for (int i = 0; i < 16; ++i) if ((i & s) == 0) { const unsigned lo = c[i] < c[i + s] ? c[i] : c[i + s], hi = c[i] < c[i + s] ? c[i + s] : c[i]; c[i] = hi; c[i + s] = lo; }
}
template <bool SORT> DI void tk_merge(unsigned (&a)[16], int m) {
    unsigned b[16];
#pragma unroll
    for (int i = 0; i < 16; ++i) b[i] = (unsigned)__shfl_xor((int)a[15 - i], m);
#pragma unroll
    for (int i = 0; i < 16; ++i) a[i] = a[i] > b[i] ? a[i] : b[i];
    if (SORT) tk_sort_bitonic(a);
}
DI float tk_unkey(unsigned k) { const unsigned u = (k & 0x80000000u) ? (k & 0x7fffffffu) : ~k; return __uint_as_float(u); }

DI void phase_peer_topk(Frame& F) {
    LAS unsigned char* L = F.lds;
    constexpr int KS = 0, QS = 69632, SC = 69632, TOP = 137216, FIN = 139264, PT = 140288;
    const bf16* PQ = (const bf16*)(F.ws + WS_PQ); const bf16* SUBK = (const bf16*)(F.ws + WS_SUBK);
    int* EXPI = (int*)(F.ws + WS_EXPI); float* EXPG = (float*)(F.ws + WS_EXPG);
    const int tid = F.tid, lane = F.lane, w = F.wave, fr = lane & 15, fq = lane >> 4;
    LAS float* sc = (LAS float*)(L + SC); LAS unsigned char* top = L + TOP; LAS unsigned char* finb = L + FIN; LAS int* pt = (LAS int*)(L + PT);
    if (tid < 56) {
        int n = tid, pi = -1;
#pragma unroll
        for (int i = 0; i < 16; ++i) { const int cnt = 16 / (i + 1); if (pi < 0) { if (n < cnt) pi = i * 16 + n; else n -= cnt; } }
        pt[tid] = tid < 50 ? pi : -1;
    }
    int hcur = -1;
    u32x4 qpre[4];
    if (F.vcu < (NT / 64) * 8) {
        const int h0 = F.vcu & 7, tq = (F.vcu >> 3) * 64;
#pragma unroll
        for (int k = 0; k < 4; ++k) { const int c = tid + 512 * k; qpre[k] = __builtin_nontemporal_load((const u32x4*)(PQ + (size_t)(tq + (c >> 5)) * 2048 + h0 * 256 + (c & 31) * 8)); }
    }
    for (int it = F.vcu; it < (NT / 64) * 8; it += F.G) {
        const int h = it & 7, tile = it >> 3, t0 = tile * 64;
        RAW_BAR();
        if (h != hcur) {
#pragma unroll
            for (int k = 0; k < 8; ++k) { const int c = tid + 512 * k, row = c >> 4, c16 = c & 15;
                *(LAS u32x4*)(L + KS + row * 272 + c16 * 16) = *(const u32x4*)(SUBK + (size_t)h * 32768 + row * 128 + c16 * 8); }
            hcur = h;
        }
#pragma unroll
        for (int k = 0; k < 4; ++k) { const int c = tid + 512 * k, row = c >> 5, c16 = c & 31; *(LAS u32x4*)(L + QS + row * 528 + c16 * 16) = qpre[k]; }
        if (it + F.G < (NT / 64) * 8) {
            const int itn = it + F.G, hn = itn & 7, tn = (itn >> 3) * 64;
#pragma unroll
            for (int k = 0; k < 4; ++k) { const int c = tid + 512 * k; qpre[k] = __builtin_nontemporal_load((const u32x4*)(PQ + (size_t)(tn + (c >> 5)) * 2048 + hn * 256 + (c & 31) * 8)); }
        }
        RAW_BAR();
        const int p = w >> 2, n0 = (w & 3) * 32;
        f32x4 acc[4][2];
#pragma unroll
        for (int mt = 0; mt < 4; ++mt) { acc[mt][0] = (f32x4){0.f, 0.f, 0.f, 0.f}; acc[mt][1] = (f32x4){0.f, 0.f, 0.f, 0.f}; }
#pragma unroll
        for (int s = 0; s < 4; ++s) {
            const bf16x8_t b0 = *(const LAS bf16x8_t*)(L + KS + (p * 128 + n0 + fr) * 272 + (32 * s + 8 * fq) * 2);
            const bf16x8_t b1 = *(const LAS bf16x8_t*)(L + KS + (p * 128 + n0 + 16 + fr) * 272 + (32 * s + 8 * fq) * 2);
#pragma unroll
            for (int mt = 0; mt < 4; ++mt) {
                const bf16x8_t a = *(const LAS bf16x8_t*)(L + QS + (16 * mt + fr) * 528 + (p * 128 + 32 * s + 8 * fq) * 2);
                acc[mt][0] = MFMA16(a, b0, acc[mt][0]); acc[mt][1] = MFMA16(a, b1, acc[mt][1]);
            }
        }
        RAW_BAR();
#pragma unroll
        for (int mt = 0; mt < 4; ++mt)
#pragma unroll
            for (int nt = 0; nt < 2; ++nt)
#pragma unroll
                for (int r = 0; r < 4; ++r) sc[((16 * mt + 4 * fq + r) * 2 + p) * 132 + (w & 3) * 33 + 16 * nt + fr] = acc[mt][nt][r];
        RAW_BAR();
        {
            const int list = tid >> 2, q = tid & 3;
            unsigned a32[32];
            const LAS float* sp = sc + list * 132 + q * 33;
#pragma unroll
            for (int i = 0; i < 32; ++i) a32[i] = (okey(sp[i]) & ~0x7Fu) | (unsigned)(q * 32 + i);
            tk_sort_desc<32>(a32);
            unsigned a[16];
#pragma unroll
            for (int i = 0; i < 16; ++i) a[i] = a32[i];
            tk_merge<true>(a, 1); tk_merge<true>(a, 2);
            if (q == 0) {
                u32x4 v;
#pragma unroll
                for (int k = 0; k < 4; ++k) v[k] = (a[4 * k] & 127u) | ((a[4 * k + 1] & 127u) << 8) | ((a[4 * k + 2] & 127u) << 16) | ((a[4 * k + 3] & 127u) << 24);
                *(LAS u32x4*)(top + list * 16) = v;
            }
        }
        RAW_BAR();
        {
            const int tok = tid >> 3, r8 = tid & 7;
            unsigned c8[8]; c8[7] = 0u;
#pragma unroll
            for (int m = 0; m < 7; ++m) {
                const int pr = pt[r8 + 8 * m], prc = pr >= 0 ? pr : 0;
                const int ia = top[(tok * 2) * 16 + (prc >> 4)], ib = top[(tok * 2 + 1) * 16 + (prc & 15)];
                const float cs = sc[(tok * 2) * 132 + (ia >> 5) * 33 + (ia & 31)] + sc[(tok * 2 + 1) * 132 + (ib >> 5) * 33 + (ib & 31)];
                c8[m] = pr >= 0 ? ((okey(cs) & ~0xFFu) | (unsigned)pr) : 0u;
            }
            tk_sort_desc<8>(c8);
            unsigned a[16];
#pragma unroll
            for (int i = 0; i < 16; ++i) a[i] = i < 8 ? c8[i] : 0u;
            tk_merge<true>(a, 1); tk_merge<true>(a, 2); tk_merge<true>(a, 4);
            LAS unsigned char* fin = finb + tok * 16;
            if (r8 == 0) {
                u32x4 v;
#pragma unroll
                for (int k = 0; k < 4; ++k) v[k] = (a[4 * k] & 255u) | ((a[4 * k + 1] & 255u) << 8) | ((a[4 * k + 2] & 255u) << 16) | ((a[4 * k + 3] & 255u) << 24);
                *(LAS u32x4*)fin = v;
            }
            asm volatile("s_waitcnt lgkmcnt(0)" ::: "memory");
            float bs[2]; int ex[2];
#pragma unroll
            for (int e = 0; e < 2; ++e) {
                const unsigned pr = fin[2 * r8 + e];
                const int ia = top[(tok * 2) * 16 + (pr >> 4)], ib = top[(tok * 2 + 1) * 16 + (pr & 15u)];
                bs[e] = sc[(tok * 2) * 132 + (ia >> 5) * 33 + (ia & 31)] + sc[(tok * 2 + 1) * 132 + (ib >> 5) * 33 + (ib & 31)];
                ex[e] = ia * 128 + ib;
            }
            float mx = fmaxf(bs[0], bs[1]);
            mx = fmaxf(mx, __shfl_xor(mx, 1)); mx = fmaxf(mx, __shfl_xor(mx, 2)); mx = fmaxf(mx, __shfl_xor(mx, 4));
            const float e0 = __expf(bs[0] - mx), e1 = __expf(bs[1] - mx);
            float sm = e0 + e1; sm += __shfl_xor(sm, 1); sm += __shfl_xor(sm, 2); sm += __shfl_xor(sm, 4);
            const float rs = 1.f / sm;
            const size_t o = (size_t)(t0 + tok) * 128 + h * 16 + 2 * r8;
            *(int2*)(EXPI + o) = make_int2(ex[0], ex[1]);
            *(float2*)(EXPG + o) = make_float2(e0 * rs, e1 * rs);
        }
    }
}

DI float ub0(unsigned w) { float r; asm("v_cvt_f32_ubyte0 %0, %1" : "=v"(r) : "v"(w)); return r; }
DI float ub1(unsigned w) { float r; asm("v_cvt_f32_ubyte1 %0, %1" : "=v"(r) : "v"(w)); return r; }
DI float ub2(unsigned w) { float r; asm("v_cvt_f32_ubyte2 %0, %1" : "=v"(r) : "v"(w)); return r; }
DI float ub3(unsigned w) { float r; asm("v_cvt_f32_ubyte3 %0, %1" : "=v"(r) : "v"(w)); return r; }
DI float wave_maxf(float v) {
#pragma unroll
    for (int o = 1; o < 64; o <<= 1) v = fmaxf(v, __shfl_xor(v, o));
    return v;
}
template <int BIAS> DI void quant_rows(const float* src, unsigned char* dst, float* scale, int gw, int NGW, int lane) {
    for (int row = gw; row < NEXP; row += NGW) {
        f32x4 v[8]; float am = 0.f;
#pragma unroll
        for (int j = 0; j < 8; ++j) { v[j] = __builtin_nontemporal_load((const f32x4*)(src + (size_t)row * DM) + lane + 64 * j); am = fmaxf(am, fmaxf(fmaxf(fabsf(v[j][0]), fabsf(v[j][1])), fmaxf(fabsf(v[j][2]), fabsf(v[j][3])))); }
        am = wave_maxf(am);
        const float inv = am > 0.f ? 127.f / am : 0.f;
#pragma unroll
        for (int j = 0; j < 8; ++j) {
            unsigned w = 0;
#pragma unroll
            for (int i = 0; i < 4; ++i) { const int q = (int)rintf(v[j][i] * inv) + BIAS; w |= ((unsigned)q & 0xffu) << (8 * i); }
            *((unsigned*)(dst + (size_t)row * DM) + lane + 64 * j) = w;
        }
        if (lane == 0) scale[row] = am * (1.f / 127.f);
    }
}


constexpr int V4_ROW = 1280;
DI void quant_rows_i4(const float* __restrict__ src, unsigned char* __restrict__ dst, int gw, int NGW, int lane) {
#pragma unroll 2
    for (int row = gw; row < NEXP; row += NGW) {
        f32x4 vv[8];
#pragma unroll
        for (int j = 0; j < 8; ++j) vv[j] = __builtin_nontemporal_load((const f32x4*)(src + (size_t)row * DM) + lane + 64 * j);
#pragma unroll
        for (int j = 0; j < 8; ++j) {
            const f32x4 v = vv[j];
            float am = fmaxf(fmaxf(fabsf(v[0]), fabsf(v[1])), fmaxf(fabsf(v[2]), fabsf(v[3])));
            am = fmaxf(am, __shfl_xor(am, 1)); am = fmaxf(am, __shfl_xor(am, 2)); am = fmaxf(am, __shfl_xor(am, 4));
            const unsigned sb = f2bf(am * (1.f / 7.f)); const float s = __uint_as_float(sb << 16), inv = s > 0.f ? __builtin_amdgcn_rcpf(s) : 0.f;
            unsigned w = 0;
#pragma unroll
            for (int i = 0; i < 4; ++i) { const int q = (int)fminf(fmaxf(rintf(v[i] * inv), -7.f), 7.f) + 8; w |= (unsigned)q << (4 * i); }
            const int grp = j * 8 + (lane >> 3);
            *(unsigned short*)(dst + (size_t)row * V4_ROW + grp * 16 + (lane & 7) * 2) = (unsigned short)w;
            *(unsigned short*)(dst + (size_t)row * V4_ROW + 1024 + grp * 2) = (unsigned short)sb;
        }
    }
}

DI void quant_u_both(const float* __restrict__ src, unsigned char* __restrict__ d8, float* __restrict__ scale, unsigned char* __restrict__ d4, int gw, int NGW, int lane) {
#pragma unroll 2
    for (int row = gw; row < NEXP; row += NGW) {
        f32x4 v[8]; float am = 0.f;
#pragma unroll
        for (int j = 0; j < 8; ++j) { v[j] = __builtin_nontemporal_load((const f32x4*)(src + (size_t)row * DM) + lane + 64 * j); am = fmaxf(am, fmaxf(fmaxf(fabsf(v[j][0]), fabsf(v[j][1])), fmaxf(fabsf(v[j][2]), fabsf(v[j][3])))); }
#if !U_ALL4
        const float rowmax = wave_maxf(am), inv8 = rowmax > 0.f ? 127.f / rowmax : 0.f;
#endif
#pragma unroll
        for (int j = 0; j < 8; ++j) {
#if !U_ALL4
            unsigned w8 = 0;
#pragma unroll
            for (int i = 0; i < 4; ++i) { const int q = (int)rintf(v[j][i] * inv8); w8 |= ((unsigned)q & 0xffu) << (8 * i); }
            { const int e0 = 4 * (lane + 64 * j);
              *(unsigned*)(d8 + (size_t)row * DM + (e0 & 15) + 16 * (e0 >> 5) + 1024 * ((e0 >> 4) & 1)) = w8; }
#endif
            float gm = fmaxf(fmaxf(fabsf(v[j][0]), fabsf(v[j][1])), fmaxf(fabsf(v[j][2]), fabsf(v[j][3])));
            gm = fmaxf(gm, __shfl_xor(gm, 1)); gm = fmaxf(gm, __shfl_xor(gm, 2)); gm = fmaxf(gm, __shfl_xor(gm, 4));
            const unsigned sb = f2bf(gm * (1.f / 7.f)); const float s = __uint_as_float(sb << 16), inv = s > 0.f ? __builtin_amdgcn_rcpf(s) : 0.f;
            unsigned w = 0;
#pragma unroll
#if U_ALL4
            for (int i = 0; i < 4; ++i) { const int q = (int)fminf(fmaxf(rintf(v[j][i] * inv), -7.f), 7.f); w |= ((unsigned)q & 15u) << (4 * i); }
#else
            for (int i = 0; i < 4; ++i) { const int q = (int)fminf(fmaxf(rintf(v[j][i] * inv), -7.f), 7.f) + 8; w |= (unsigned)q << (4 * i); }
#endif
            const int grp = j * 8 + (lane >> 3);
            *(unsigned short*)(d4 + (size_t)row * V4_ROW + grp * 16 + (lane & 7) * 2) = (unsigned short)w;
            *(unsigned short*)(d4 + (size_t)row * V4_ROW + 1024 + grp * 2) = (unsigned short)sb;
        }
#if !U_ALL4
        if (lane == 0) scale[row] = rowmax * (1.f / 127.f);
#endif
    }
}

DI void phase_peer_gather(Frame& F, int emask = 0x3fff, int vmask = 0x3fff) {
    const float* AB2 = (const float*)(F.ws + WS_AB2); const float* SH2 = (const float*)(F.ws + WS_SH2);
    const unsigned char* U8 = F.ws + WS_U8; const unsigned char* U4 = F.ws + WS_TABU; const unsigned char* V4 = F.ws + WS_TABV; const float* SU = (const float*)(F.ws + WS_SU);
    const int* EXPI = (const int*)(F.ws + WS_EXPI); const float* EXPG = (const float*)(F.ws + WS_EXPG);
    const bf16* X1 = (const bf16*)(F.ws + WS_X1); const float* MOD = (const float*)(F.ws + WS_MOD); const int lane = F.lane;
    LAS float* la = (LAS float*)(F.lds + F.wave * 1024);
    LAS int* li = (LAS int*)(F.lds + F.wave * 1024 + 512);
    const int eloc = ((lane >> 5) & 1) * 4 + ((lane >> 4) & 1) * 2 + ((lane >> 3) & 1);
#ifdef GATHER_SUBSET
    if ((blockIdx.x >> 3) % GATHER_SUBSET != 0) return;
    const int gw_ = ((blockIdx.x >> 3) / GATHER_SUBSET * 8 + (blockIdx.x & 7)) * NWAVES + F.wave, ngw_ = F.NGW / GATHER_SUBSET;
#else
    const int gw_ = F.gw, ngw_ = F.NGW;
#endif
    for (int t = gw_; t < NT; t += ngw_) {
        const bf16* XR = X1 + (size_t)t * DM; const float* ABb = AB2 + (size_t)(t >> 12) * DM; const float* SHb = SH2 + (size_t)(t >> 12) * DM;
        float hvv[32]; float am = 0.f, ssx = 0.f;
#pragma unroll
        for (int d = 0; d < 4; ++d) {
            const u32x4 w = *((const u32x4*)(XR + 32 * lane) + d);
#pragma unroll
            for (int i = 0; i < 4; ++i) { hvv[8 * d + 2 * i] = bflo(w[i]); hvv[8 * d + 2 * i + 1] = bfhi(w[i]); }
        }
#pragma unroll
        for (int i = 0; i < 32; ++i) ssx += hvv[i] * hvv[i];
        const float rstd2 = rsqrtf(wave_sum(ssx) * (1.f / DM) + EPS);
#pragma unroll
        for (int q = 0; q < 8; ++q) {
            const f32x4 a = *((const f32x4*)(ABb + 32 * lane) + q), h = *((const f32x4*)(SHb + 32 * lane) + q);
#pragma unroll
            for (int i = 0; i < 4; ++i) { hvv[4 * q + i] = hvv[4 * q + i] * rstd2 * a[i] + h[i]; am = fmaxf(am, fabsf(hvv[4 * q + i])); }
        }
        am = wave_maxf(am);
#if U_ALL4
        const float inv = am > 0.f ? 119.f / am : 0.f, sx = am * (1.f / 119.f);
        unsigned XL[4], XH[4];
#pragma unroll
        for (int d = 0; d < 4; ++d) { unsigned pl = 0u, ph = 0u;
#pragma unroll
            for (int k = 0; k < 8; ++k) { const int q = (int)rintf(hvv[8 * d + k] * inv); const int xl = ((q + 8) & 15) - 8, xh = (q - xl) >> 4; pl |= ((unsigned)xl & 15u) << (4 * k); ph |= ((unsigned)xh & 15u) << (4 * k); }
            XL[d] = pl; XH[d] = ph; }
        int xq[2][4] = {{0, 0, 0, 0}, {0, 0, 0, 0}}, xe[4] = {0, 0, 0, 0}, xo[4] = {0, 0, 0, 0}; const int xsum4 = 0; (void)xq; (void)xe; (void)xo; (void)xsum4;
#else
        const float inv = am > 0.f ? 127.f / am : 0.f, sx = am * (1.f / 127.f);
        int qv[32], xsum4 = 0;
#pragma unroll
        for (int i = 0; i < 32; ++i) { qv[i] = (int)rintf(hvv[i] * inv); xsum4 += qv[i]; }
        int xq[2][4], xe[4], xo[4];
#pragma unroll
        for (int j = 0; j < 2; ++j)
#pragma unroll
            for (int k = 0; k < 4; ++k) { const int e = 16 * j + 4 * k;
                xq[j][k] = (int)(((unsigned)qv[e] & 0xffu) | (((unsigned)qv[e + 1] & 0xffu) << 8) | (((unsigned)qv[e + 2] & 0xffu) << 16) | (((unsigned)qv[e + 3] & 0xffu) << 24)); }
#pragma unroll
        for (int d = 0; d < 4; ++d) {
            xe[d] = (int)(((unsigned)qv[8 * d] & 0xffu) | (((unsigned)qv[8 * d + 2] & 0xffu) << 8) | (((unsigned)qv[8 * d + 4] & 0xffu) << 16) | (((unsigned)qv[8 * d + 6] & 0xffu) << 24));
            xo[d] = (int)(((unsigned)qv[8 * d + 1] & 0xffu) | (((unsigned)qv[8 * d + 3] & 0xffu) << 8) | (((unsigned)qv[8 * d + 5] & 0xffu) << 16) | (((unsigned)qv[8 * d + 7] & 0xffu) << 24));
        }
#endif
        float asum = 0.f;
        const int ei0 = EXPI[(size_t)t * 128 + lane] & emask, ei1 = EXPI[(size_t)t * 128 + 64 + lane] & emask;
        const float eg0 = EXPG[(size_t)t * 128 + lane], eg1 = EXPG[(size_t)t * 128 + 64 + lane];
        u32x4 wa0[8], wa1[8], wb[8]; unsigned short sbh[8], sah[8];
#if U_ALL4
#define U_A_LOAD { const unsigned char* u4a_ = U4 + (size_t)idx_ * V4_ROW; wa0[e] = *(const u32x4*)(u4a_ + 16 * lane); sah[e] = *(const unsigned short*)(u4a_ + 1024 + 2 * lane); (void)ur_; }
#else
#define U_A_LOAD wa0[e] = ur_[lane]; wa1[e] = ur_[lane + 64];
#endif
#define ULOADA(hd_) do { const int eis_ = (hd_) < 4 ? ei0 : ei1, base_ = ((hd_) & 3) * 16; \
            _Pragma("unroll") for (int e = 0; e < 8; ++e) { const int idx_ = __builtin_amdgcn_readlane(eis_, base_ + e); const u32x4* ur_ = (const u32x4*)(U8 + (size_t)idx_ * DM); U_A_LOAD } } while (0)
#define ULOADB(hd_) do { const int eis_ = (hd_) < 4 ? ei0 : ei1, base_ = ((hd_) & 3) * 16 + 8; \
            _Pragma("unroll") for (int e = 0; e < 8; ++e) { const int idx_ = __builtin_amdgcn_readlane(eis_, base_ + e); const unsigned char* u4_ = U4 + (size_t)idx_ * V4_ROW; wb[e] = *(const u32x4*)(u4_ + 16 * lane); sbh[e] = *(const unsigned short*)(u4_ + 1024 + 2 * lane); } } while (0)
#define ULOADA_NEXT(hd_) do { const int h_ = (hd_); const int eis_ = (h_ & 4) ? ei1 : ei0, base_ = (h_ & 3) * 16, msk_ = h_ < 8 ? -1 : 0; \
            _Pragma("unroll") for (int e = 0; e < 8; ++e) { const int idx_ = __builtin_amdgcn_readlane(eis_, base_ + e) & msk_; const u32x4* ur_ = (const u32x4*)(U8 + (size_t)idx_ * DM); U_A_LOAD } } while (0)
        ULOADA(0);
#pragma unroll 1
        for (int hd = 0; hd < 8; ++hd) {
            const int eisel = hd < 4 ? ei0 : ei1; const float egsel = hd < 4 ? eg0 : eg1;
            const int base = (hd & 3) * 16;
            const int myidxA = __shfl(eisel, base + eloc), myidxB = __shfl(eisel, base + 8 + eloc);
            const float mygA = __shfl(egsel, base + eloc), mygB = __shfl(egsel, base + 8 + eloc);
#if !U_ALL4
            const float mysu = SU[myidxA];
#endif
            ULOADB(hd);
            float accA[8], accB[8];
#pragma unroll
            for (int e = 0; e < 8; ++e) {
#if U_ALL4
                int bl = 0, bh = 0;
#pragma unroll
                for (int d = 0; d < 4; ++d) { bl = __builtin_amdgcn_sdot8((int)wa0[e][d], (int)XL[d], bl, false); bh = __builtin_amdgcn_sdot8((int)wa0[e][d], (int)XH[d], bh, false); }
                accA[e] = (float)(16 * bh + bl) * bf2f(sah[e]);
                continue;
#endif
                int a = __builtin_amdgcn_sdot4((int)wa0[e].x, xq[0][0], 0, false); a = __builtin_amdgcn_sdot4((int)wa0[e].y, xq[0][1], a, false);
                a = __builtin_amdgcn_sdot4((int)wa0[e].z, xq[0][2], a, false); a = __builtin_amdgcn_sdot4((int)wa0[e].w, xq[0][3], a, false);
                a = __builtin_amdgcn_sdot4((int)wa1[e].x, xq[1][0], a, false); a = __builtin_amdgcn_sdot4((int)wa1[e].y, xq[1][1], a, false);
                a = __builtin_amdgcn_sdot4((int)wa1[e].z, xq[1][2], a, false); a = __builtin_amdgcn_sdot4((int)wa1[e].w, xq[1][3], a, false);
                accA[e] = (float)a;
            }
            __builtin_amdgcn_sched_barrier(0);
            ULOADA_NEXT(hd + 1);
#pragma unroll
            for (int e = 0; e < 8; ++e) {
#if U_ALL4
                int bl = 0, bh = 0;
#pragma unroll
                for (int d = 0; d < 4; ++d) { bl = __builtin_amdgcn_sdot8((int)wb[e][d], (int)XL[d], bl, false); bh = __builtin_amdgcn_sdot8((int)wb[e][d], (int)XH[d], bh, false); }
                accB[e] = (float)(16 * bh + bl) * bf2f(sbh[e]);
#else
                int b = 0;
#pragma unroll
                for (int d = 0; d < 4; ++d) { b = __builtin_amdgcn_sdot4((int)(wb[e][d] & 0x0F0F0F0Fu), xe[d], b, false); b = __builtin_amdgcn_sdot4((int)((wb[e][d] >> 4) & 0x0F0F0F0Fu), xo[d], b, false); }
                accB[e] = (float)(b - 8 * xsum4) * bf2f(sbh[e]);
#endif
            }
            float rA, rB;
            {
                float r4[4], r2[2], s4[4], s2[2];
#pragma unroll
                for (int i = 0; i < 4; ++i) {
                    const float sndA = (lane & 32) ? accA[i] : accA[i + 4], kpA = (lane & 32) ? accA[i + 4] : accA[i]; r4[i] = kpA + __shfl_xor(sndA, 32);
                    const float sndB = (lane & 32) ? accB[i] : accB[i + 4], kpB = (lane & 32) ? accB[i + 4] : accB[i]; s4[i] = kpB + __shfl_xor(sndB, 32); }
#pragma unroll
                for (int i = 0; i < 2; ++i) {
                    const float sndA = (lane & 16) ? r4[i] : r4[i + 2], kpA = (lane & 16) ? r4[i + 2] : r4[i]; r2[i] = kpA + __shfl_xor(sndA, 16);
                    const float sndB = (lane & 16) ? s4[i] : s4[i + 2], kpB = (lane & 16) ? s4[i + 2] : s4[i]; s2[i] = kpB + __shfl_xor(sndB, 16); }
                { const float sndA = (lane & 8) ? r2[0] : r2[1], kpA = (lane & 8) ? r2[1] : r2[0]; rA = kpA + __shfl_xor(sndA, 8);
                  const float sndB = (lane & 8) ? s2[0] : s2[1], kpB = (lane & 8) ? s2[1] : s2[0]; rB = kpB + __shfl_xor(sndB, 8); }
                rA += __shfl_xor(rA, 4); rA += __shfl_xor(rA, 2); rA += __shfl_xor(rA, 1);
                rB += __shfl_xor(rB, 4); rB += __shfl_xor(rB, 2); rB += __shfl_xor(rB, 1);
            }
#if U_ALL4
            const float aA = gelu_erf(rA * sx) * mygA, aB = gelu_erf(rB * sx) * mygB;
#else
            const float aA = gelu_erf(rA * mysu * sx) * mygA, aB = gelu_erf(rB * sx) * mygB;
#endif
            if ((lane & 7) == 0) { la[hd * 16 + eloc] = aA; li[hd * 16 + eloc] = myidxA & vmask; la[hd * 16 + 8 + eloc] = aB; li[hd * 16 + 8 + eloc] = myidxB & vmask; asum += aA + aB; }
        }
#undef ULOADA
#undef U_A_LOAD
#undef ULOADA_NEXT
#undef ULOADB
        asum = wave_sum(asum);
        asm volatile("s_waitcnt lgkmcnt(0)" ::: "memory");
        f32x2 o2[16]; float csum = 0.f;
#pragma unroll
        for (int i = 0; i < 16; ++i) o2[i] = (f32x2){0.f, 0.f};
#ifndef GV_UNROLL
#define GV_UNROLL 16
#endif
#pragma unroll GV_UNROLL
        for (int e = 0; e < 128; ++e) {
            const int idx = __builtin_amdgcn_readfirstlane(li[e]); const float a = __uint_as_float((unsigned)__builtin_amdgcn_readfirstlane((int)__float_as_uint(la[e])));
            const unsigned char* vr = V4 + (size_t)idx * V4_ROW;
            const u32x4 w = *(const u32x4*)(vr + 16 * lane);
            const float as = a * bf2f(*(const unsigned short*)(vr + 1024 + 2 * lane));
            csum += as;
            const float as9 = as * 512.f; const f32x2 as2 = {as9, as9};
#pragma unroll
            for (int d = 0; d < 4; ++d) {
                const unsigned lo = w[d] & 0x0F0F0F0Fu, hi = (w[d] >> 4) & 0x0F0F0F0Fu;
                o2[4 * d + 0] = __builtin_elementwise_fma(as2, __builtin_amdgcn_cvt_pk_f32_fp8((int)lo, false), o2[4 * d + 0]); o2[4 * d + 1] = __builtin_elementwise_fma(as2, __builtin_amdgcn_cvt_pk_f32_fp8((int)lo, true), o2[4 * d + 1]);
                o2[4 * d + 2] = __builtin_elementwise_fma(as2, __builtin_amdgcn_cvt_pk_f32_fp8((int)hi, false), o2[4 * d + 2]); o2[4 * d + 3] = __builtin_elementwise_fma(as2, __builtin_amdgcn_cvt_pk_f32_fp8((int)hi, true), o2[4 * d + 3]);
            }
        }
        float o[32];
#pragma unroll
        for (int d = 0; d < 4; ++d) {
            o[8 * d + 0] = o2[4 * d][0]; o[8 * d + 2] = o2[4 * d][1]; o[8 * d + 4] = o2[4 * d + 1][0]; o[8 * d + 6] = o2[4 * d + 1][1];
            o[8 * d + 1] = o2[4 * d + 2][0]; o[8 * d + 3] = o2[4 * d + 2][1]; o[8 * d + 5] = o2[4 * d + 3][0]; o[8 * d + 7] = o2[4 * d + 3][1];
        }
        LAS float* tp = (LAS float*)(F.lds + 8192 + F.wave * 9216);
        const float corr = 8.f * csum;
#pragma unroll
        for (int k = 0; k < 8; ++k) { f32x4 v; v[0] = o[4 * k] - corr; v[1] = o[4 * k + 1] - corr; v[2] = o[4 * k + 2] - corr; v[3] = o[4 * k + 3] - corr; *(LAS f32x4*)(tp + lane * 36 + 4 * k) = v; }
        asm volatile("s_waitcnt lgkmcnt(0)" ::: "memory");
        const float* g2 = MOD + (size_t)(t >> 12) * 12288 + 5 * 2048;
        f32x4 x2[8]; float ss = 0.f;
#pragma unroll
        for (int j = 0; j < 8; ++j) {
            const int ch = lane + 64 * j;
            const f32x4 pv = *(const LAS f32x4*)(tp + (ch >> 3) * 36 + 4 * (ch & 7));
            const u32x2 xw = __builtin_nontemporal_load((const u32x2*)(X1 + (size_t)t * DM) + ch); const f32x4 xa = {bflo(xw.x), bfhi(xw.x), bflo(xw.y), bfhi(xw.y)}, ga = *((const f32x4*)g2 + ch);
            x2[j] = xa + ga * pv;
            ss += (x2[j][0] * x2[j][0] + x2[j][1] * x2[j][1]) + (x2[j][2] * x2[j][2] + x2[j][3] * x2[j][3]);
        }
        const float rstd = rsqrtf(wave_sum(ss) * (1.f / DM) + EPS);
        const float* fw = F.in[22];
#pragma unroll
        for (int j = 0; j < 8; ++j) { const int ch = lane + 64 * j; const f32x4 wa = *((const f32x4*)fw + ch); __builtin_nontemporal_store(x2[j] * rstd * wa, (f32x4*)(F.out + (size_t)t * DM) + ch); }
        asm volatile("s_waitcnt lgkmcnt(0)" ::: "memory");
    }
}

DI void phase_h2(Frame& F) {
    const float* MOD = (const float*)(F.ws + WS_MOD); bf16* H2 = (bf16*)(F.ws + WS_H2); const bf16* X1 = (const bf16*)(F.ws + WS_X1);
    ModPar P;
    constexpr int RPW = NT / (256 * NWAVES);
    if (F.NGW == 256 * NWAVES) {
        const int m0 = F.gw * RPW, r = m0 >> 12;
        modpar_load(P, F.in[7], MOD + (size_t)r * 12288 + 4 * 2048, MOD + (size_t)r * 12288 + 3 * 2048, F.lane);
        modnorm_rows_bf(X1 + (size_t)m0 * DM, H2 + (size_t)m0 * DM, RPW, P, F.lane);
    } else {
        for (int m = F.gw; m < NT; m += F.NGW) { const int r = m >> 12; modpar_load(P, F.in[7], MOD + (size_t)r * 12288 + 4 * 2048, MOD + (size_t)r * 12288 + 3 * 2048, F.lane); modnorm_rows_bf(X1 + (size_t)m * DM, H2 + (size_t)m * DM, 1, P, F.lane); }
    }
}


template <bool SIGNED> DI void quant_row4(const f32x4 (&v)[8], unsigned char* drow, int lane) {
    float gm[8];
#pragma unroll
    for (int j = 0; j < 8; ++j) gm[j] = fmaxf(fmaxf(fabsf(v[j][0]), fabsf(v[j][1])), fmaxf(fabsf(v[j][2]), fabsf(v[j][3])));
#pragma unroll
    for (int o = 1; o < 8; o <<= 1)
#pragma unroll
        for (int j = 0; j < 8; ++j) gm[j] = fmaxf(gm[j], __shfl_xor(gm[j], o));
#pragma unroll
    for (int j = 0; j < 8; ++j) {
        const unsigned sb = f2bf(gm[j] * (1.f / 7.f)); const float s = __uint_as_float(sb << 16), inv = s > 0.f ? __builtin_amdgcn_rcpf(s) : 0.f;
        unsigned w = 0;
#pragma unroll
        for (int i = 0; i < 4; ++i) { const int q = (int)fminf(fmaxf(rintf(v[j][i] * inv), -7.f), 7.f); w |= (SIGNED ? ((unsigned)q & 15u) : (unsigned)(q + 8)) << (4 * i); }
        const int grp = j * 8 + (lane >> 3);
        __builtin_nontemporal_store((unsigned short)w, (unsigned short*)(drow + grp * 16 + (lane & 7) * 2));
        __builtin_nontemporal_store((unsigned short)sb, (unsigned short*)(drow + 1024 + grp * 2));
    }
}
DI void quant_any_row(const Frame& F, int r, int lane) {
    const bool isv = r >= NEXP; const int row = isv ? r - NEXP : r;
    const float* src = (isv ? F.in[21] : F.in[20]) + (size_t)row * DM;
    f32x4 v[8];
#pragma unroll
    for (int j = 0; j < 8; ++j) v[j] = __builtin_nontemporal_load((const f32x4*)src + lane + 64 * j);
    if (isv) quant_row4<false>(v, F.ws + WS_TABV + (size_t)row * V4_ROW, lane); else quant_row4<true>(v, F.ws + WS_TABU + (size_t)row * V4_ROW, lane);
}
#ifndef SHADOW_RPW
#define SHADOW_RPW 3
#endif
constexpr int SHADOW_TSLOTS = 4;
#ifndef SHADOW_PLAN
#define SHADOW_PLAN {0, 0, 0, 0, 2, 2, 4, 0, 3, 4, 3}
#endif
struct ShadowPlan { int n[11]; };
constexpr ShadowPlan SPLAN = {SHADOW_PLAN};
constexpr int shadow_off(int slot) { int o = 0; for (int i = 0; i < slot; ++i) o += SPLAN.n[i] * 7 * 256; return o; }
constexpr int SHADOW_S3 = 1024;
constexpr int SHADOW_ROWS = (shadow_off(11) + SHADOW_S3 < 2 * NEXP) ? shadow_off(11) + SHADOW_S3 : 2 * NEXP;
struct QuantShadow {
    const Frame* F; int slot;
    DI void operator()() const {
        if (slot < 0 || slot > 10 || F->G != 256) return;
        const int wi = (int)blockIdx.x * 7 + F->wave - 1;
        if (slot < SHADOW_TSLOTS) { const int t = slot * 7 * 256 + wi; if (t < 6144) transpose_late(*F, t, (LAS float*)(F->lds + F->wave * 16384));
            else { const int r = shadow_off(11) + (t - 6144); if (r < SHADOW_ROWS) quant_any_row(*F, r, F->lane); }
            return; }
        if (slot == 7) { wqb_unit(*F, wi); return; }
        if (slot == 8 && wi < NB * (DM / 4) - 7 * 256) wqb_unit(*F, 7 * 256 + wi);
        int off = 0, cnt = 0;
#pragma unroll
        for (int i = 4; i < 11; ++i) if (i == slot) { off = shadow_off(i); cnt = SPLAN.n[i]; }
        const int r0 = off + wi * cnt;
        for (int k = 0; k < cnt; ++k) if (r0 + k < SHADOW_ROWS) quant_any_row(*F, r0 + k, F->lane);
    }
};

DI void phase_quant(Frame& F) {
    for (int r = (F.G == 256 ? SHADOW_ROWS : 0) + F.gw; r < 2 * NEXP; r += F.NGW) quant_any_row(F, r, F.lane);
}

struct Args { const float* in[23]; float* out; unsigned char* ws; int ph_lo, ph_hi; };
static_assert(sizeof(Args) == 23 * 8 + 8 + 8 + 8, "Args has no padding");

__global__ void __launch_bounds__(NWAVES * 64, 2) mk_fwd(Args args) {
    extern __shared__ __attribute__((aligned(16))) unsigned char lds[];
    Frame F;
    F.lds = (LAS unsigned char*)lds; F.ws = args.ws; F.out = args.out;
#pragma unroll
    for (int i = 0; i < 23; ++i) F.in[i] = args.in[i];
    F.tid = threadIdx.x; F.lane = F.tid & 63; F.wave = __builtin_amdgcn_readfirstlane(F.tid >> 6);
    F.G = gridDim.x; { const int bx = blockIdx.x; F.vcu = (F.G % 8 == 0) ? (bx % 8) * (F.G / 8) + bx / 8 : bx; }
    F.gw = F.vcu * NWAVES + F.wave; F.NGW = F.G * NWAVES;
    const int lo = args.ph_lo, hi = args.ph_hi;
#ifndef REP_PHASE
#define REP_PHASE (-1)
#endif
#define IN(k) (lo <= (k) && (k) < hi)
#ifndef REP_MASK
#define REP_MASK 0
#endif
#define RP(k) _Pragma("nounroll") for (int rep_ = 0; rep_ < ((REP_PHASE == (k) || ((REP_MASK >> (k)) & 1)) ? 2 : 1); ++rep_)
    constexpr int CW_BAR = 4096;
    volatile LAS unsigned* bst = (volatile LAS unsigned*)(F.lds + LDS_BYTES - 64);
    if (F.tid < 16) bst[F.tid] = 0u;
    __syncthreads();
    XcdBarrier bar; bar.bar = (unsigned*)(F.ws + WS_CTL) + CW_BAR; bar.x = 0; bar.st = nullptr;
#ifndef CG_FIRST_SEAM
#define CG_FIRST_SEAM 0
#endif
#if MK_N_LAUNCHES == 1 && CG_FIRST_SEAM
    if (blockIdx.x == 0) { for (int i = F.tid; i < 4096; i += NWAVES * 64) __hip_atomic_store(bar.bar + i, 0u, __ATOMIC_RELAXED, __HIP_MEMORY_SCOPE_AGENT); __threadfence(); }
#else
    if (hi - lo > 1) bar = xcd_barrier_post((unsigned*)(F.ws + WS_CTL) + CW_BAR, bst);
    if (lo < 0) cg::this_grid().sync();
#endif
#ifdef CG_REP
#define CG_EXTRA cg::this_grid().sync(); cg::this_grid().sync();
#else
#define CG_EXTRA
#endif
#ifndef SEAM_REP
#define SEAM_REP 1
#endif
#define SEAM(k) do { if (IN(k) && IN((k) + 1)) { if ((k) == 0 && MK_N_LAUNCHES == 1 && CG_FIRST_SEAM) { cg::this_grid().sync(); CG_EXTRA } else { _Pragma("nounroll") for (int sr_ = 0; sr_ < SEAM_REP; ++sr_) xcd_barrier_w(bar, QuantShadow{&F, (sr_ == 0 && MK_N_LAUNCHES == 1) ? ((k) < 10 ? (k) : ((k) == 11 ? 10 : -1)) : -1}); } } } while (0)

    if (IN(0)) RP(0) { phase_prologue(F); __syncthreads(); }
    SEAM(0);
#if MK_N_LAUNCHES == 1 && CG_FIRST_SEAM
    bar = xcd_barrier_post((unsigned*)(F.ws + WS_CTL) + CW_BAR, bst);
#endif
    if (IN(1)) RP(1) phase_modreduce(F);
    SEAM(1);
    if (IN(2)) RP(2) phase_h1(F);
    SEAM(2);
    if (IN(3)) RP(3) {
        pg8::Gemm g{(const bf16*)(F.ws + WS_H), (const bf16*)(F.ws + WS_WIN), MTOT, NPROJ, DM / 2}; InProjOrder S; S.init(F.G, (int)blockIdx.x);
        EpiInProj E{F.ws, F.in[12], F.in[13]};
        pg8::gemm_phase<EpiInProj, InProjOrder, true, true, true>(F.lds, g, S, E);
    }
    SEAM(3);
    if (IN(4)) phase_postproj(F);
    SEAM(4);
#ifdef DN_NAIVE
    if (IN(5)) phase_dn_naive(F);
    SEAM(5);
    if (IN(6)) phase_attention(F, (char*)lds);
#else
    if (IN(5)) RP(5) phase_dn_prep(F);
    SEAM(5);
    if (IN(6)) { RP(14) { phase_dn_scan(F); __syncthreads(); } phase_attention(F, (char*)lds); }
#endif
    SEAM(6);
#ifndef WQB_REP
#define WQB_REP 1
#endif
    if (IN(7)) { phase_mergeprep(F); if (F.G != 256 || MK_N_LAUNCHES != 1) phase_wqb(F); }
    SEAM(7);
    if (IN(8)) RP(8) {
#if (MERGE_F8_A || MERGE_F8_B || defined(MERGE_TWO_PASS)) && !MERGE_F8_2S
        pg8::StaticOrder S; S.init(NT, DM, F.G, (int)blockIdx.x);
        { pg8::Gemm g{(const bf16*)(F.ws + (MERGE_F8_A ? WS_OATT8 : WS_QN)), (const bf16*)(F.ws + WS_WBA), NT, DM, MERGE_F8_A ? 512 : 1024};
          EpiMerge<false> E{(bf16*)(F.ws + WS_Y), (const unsigned char*)(F.ws + WS_G), 0, MERGE_F8_A ? 1.f / (255.f * WB_SCALE * OATT_SCALE) : 1.f / 255.f};
          pg8::gemm_phase<EpiMerge<false>, pg8::StaticOrder, true, true, MERGE_F8_A != 0>(F.lds, g, S, E); }
        __syncthreads();
        { pg8::Gemm g{(const bf16*)(F.ws + (MERGE_F8_B ? WS_ODNN8 : WS_Z)), (const bf16*)(F.ws + WS_WBD), NT, DM, MERGE_F8_B ? 512 : 1024};
          EpiMerge<true> E{(bf16*)(F.ws + WS_Y), (const unsigned char*)(F.ws + WS_G), 2048, MERGE_F8_B ? 1.f / (255.f * WB_SCALE * ODNN_SCALE) : 1.f / 255.f};
          pg8::gemm_phase<EpiMerge<true>, pg8::StaticOrder, true, true, MERGE_F8_B != 0>(F.lds, g, S, E); }
#else
        pg8::TwoStageOrder S; S.init(NT, DM, F.G, (int)blockIdx.x);
#if MERGE_F8_2S
        pg8::Gemm g{(const bf16*)(F.ws + WS_OATT8), (const bf16*)(F.ws + WS_WBA), NT, DM, 512, (const bf16*)(F.ws + WS_ODNN8), (const bf16*)(F.ws + WS_WBD)};
        EpiMerge2 E{(bf16*)(F.ws + WS_Y), (const unsigned char*)(F.ws + WS_G), ODNN_SCALE / OATT_SCALE, 1.f / (255.f * WB_SCALE * ODNN_SCALE)};
        pg8::gemm_phase<EpiMerge2, pg8::TwoStageOrder, true, true, true>(F.lds, g, S, E);
#else
        pg8::Gemm g{(const bf16*)(F.ws + WS_QN), (const bf16*)(F.ws + WS_WBA), NT, DM, 1024, (const bf16*)(F.ws + WS_Z), (const bf16*)(F.ws + WS_WBD)};
        EpiMerge2 E{(bf16*)(F.ws + WS_Y), (const unsigned char*)(F.ws + WS_G), 1.f, 1.f / 255.f};
        pg8::gemm_phase<EpiMerge2, pg8::TwoStageOrder, true, true>(F.lds, g, S, E);
#endif
#endif
    }
    SEAM(8);
    if (IN(9)) RP(9) {
        pg8::Gemm g{(const bf16*)(F.ws + WS_Y), (const bf16*)(F.ws + WS_WOUT), NT, DM, OUT_F8 ? DM / 2 : DM}; pg8::StaticOrder S; S.init(NT, DM, F.G, (int)blockIdx.x);
        EpiResid E{F.in[0], (bf16*)(F.ws + WS_X1), (const float*)(F.ws + WS_MOD), (float*)(F.ws + WS_SSQ), F.ws + WS_X18};
        pg8::gemm_phase<EpiResid, pg8::StaticOrder, true, true, OUT_F8 != 0>(F.lds, g, S, E);
    }
    SEAM(9);
    if (IN(11)) RP(11) {
        pg8::BatchOrder S; S.init(NT, DM, F.G, (int)blockIdx.x);
        pg8::Gemm g{(const bf16*)(F.ws + (PQ_F8 ? WS_X18 : WS_X1)), (const bf16*)(F.ws + WS_WQB), NT, DM, PQ_F8 ? DM / 2 : DM, nullptr, nullptr, (size_t)DM * DM * (PQ_F8 ? 1 : 2)};
        EpiPQ E{(bf16*)(F.ws + WS_PQ), (const float*)(F.ws + WS_BIASQ), (const float*)(F.ws + WS_SSQ)};
        pg8::gemm_phase<EpiPQ, pg8::BatchOrder, true, true, PQ_F8 != 0>(F.lds, g, S, E);
    }
    SEAM(11);
    if (IN(12)) { RP(12) { phase_peer_topk(F); __syncthreads(); } phase_quant(F); }
    SEAM(12);
#ifdef GATHER_PROBE_MASK
    if (IN(13)) {
#pragma nounroll
        for (int rep_ = 0; rep_ < 2; ++rep_) { phase_peer_gather(F, rep_ == 0 ? GATHER_PROBE_MASK : 0x3fff, rep_ == 0 ? GATHER_PROBE_VMASK : 0x3fff); __syncthreads(); }
    }
#else
    if (IN(13)) RP(13) phase_peer_gather(F);
#endif
#undef IN
#undef SEAM
}

extern "C" void kernel_launch(void* const* d_in, const int* in_sizes, int n_in, void* d_out, int out_size, void* d_ws, size_t ws_size, hipStream_t stream) {
    static int grid = 0;
    if (grid == 0) {
        if (n_in != 23 || in_sizes[0] != NT * DM || out_size != NT * DM || ws_size < WS_END) {
            fprintf(stderr, "kernel_launch: unexpected shapes (n_in %d, in0 %d, out %d, ws %zu < %zu); nothing launched\n", n_in, n_in > 0 ? in_sizes[0] : -1, out_size, ws_size, (size_t)WS_END);
            grid = -1; return; }
        int dev = 0, cus = 0, per_cu = 0;
        if (hipGetDevice(&dev) != hipSuccess || hipDeviceGetAttribute(&cus, hipDeviceAttributeMultiprocessorCount, dev) != hipSuccess) { grid = -1; return; }
        if (hipFuncSetAttribute((const void*)mk_fwd, hipFuncAttributeMaxDynamicSharedMemorySize, LDS_BYTES) != hipSuccess) { fprintf(stderr, "kernel_launch: hipFuncSetAttribute failed\n"); grid = -1; return; }
        if (hipOccupancyMaxActiveBlocksPerMultiprocessor(&per_cu, (const void*)mk_fwd, NWAVES * 64, LDS_BYTES) != hipSuccess || per_cu < 1) { fprintf(stderr, "kernel_launch: occupancy query says %d blocks per CU\n", per_cu); (void)hipGetLastError(); grid = -1; return; }
        grid = cus;
    }
    if (grid < 0) return;
#if MK_N_LAUNCHES != 1 || !CG_FIRST_SEAM
    (void)hipMemsetAsync((char*)d_ws + WS_CTL + 4096 * 4, 0, 4096 * 4, stream);
#endif
    Args a{};
    for (int i = 0; i < 23; ++i) a.in[i] = (const float*)d_in[i];
    a.out = (float*)d_out; a.ws = (unsigned char*)d_ws;
#if MK_N_LAUNCHES == 1
    a.ph_lo = 0; a.ph_hi = NPHASE;
    void* kargs[] = {(void*)&a};
    const hipError_t e = hipLaunchCooperativeKernel((const void*)mk_fwd, dim3(grid), dim3(NWAVES * 64), kargs, LDS_BYTES, stream);
    if (e != hipSuccess) fprintf(stderr, "kernel_launch: cooperative launch failed: %s (grid %d)\n", hipGetErrorString(e), grid);
#else
    for (int p = 0; p < NPHASE; ++p) {
        a.ph_lo = p; a.ph_hi = p + 1;
        hipLaunchKernelGGL(mk_fwd, dim3(grid), dim3(NWAVES * 64), LDS_BYTES, stream, a);
    }
    const hipError_t le = hipPeekAtLastError();
    if (le != hipSuccess) fprintf(stderr, "kernel_launch: launch failed: %s\n", hipGetErrorName(le));
#endif
}
```
